# Optimizing an MI355X kernel written in HIP

```python
import math
import jax
import jax.numpy as jnp
from jax import lax
import numpy as np

D_MODEL = 1024
BATCH = 2
SEQ = 8192
DEPTH = 2

GRID_W = 64
CTX_LEN = 256
HEAD_DIM = 64
Q_BLOCK = 128
ROPE_THETA = 10000.0
EPS = 1e-6
N_EVEN = (DEPTH + 1) // 2
N_ODD = DEPTH // 2
A_WIDTH = D_MODEL // 2
A_GROUPS = A_WIDTH // HEAD_DIM
CHUNK = 128
B_HEADS = D_MODEL // (4 * HEAD_DIM)
B_WIDTH = B_HEADS * 2 * HEAD_DIM
E_SPLITS = (A_WIDTH, 2 * A_WIDTH, 2 * A_WIDTH + B_WIDTH, 2 * A_WIDTH + 2 * B_WIDTH)
E_IN = 2 * A_WIDTH + 3 * B_WIDTH
C_HEADS = (D_MODEL // 2) // HEAD_DIM
C_KV_HEADS = 2
C_GROUP = C_HEADS // C_KV_HEADS
C_WIDTH = C_HEADS * HEAD_DIM
C_KV_WIDTH = C_KV_HEADS * HEAD_DIM
D_WIDTH = D_MODEL // 2
D_BLOCKS = D_WIDTH // HEAD_DIM
CONV_W = 4
LRU_C = 8.0
O_SPLITS = (C_WIDTH, C_WIDTH + C_KV_WIDTH, C_WIDTH + 2 * C_KV_WIDTH, C_WIDTH + 2 * C_KV_WIDTH + D_WIDTH)
O_IN = C_WIDTH + 2 * C_KV_WIDTH + 2 * D_WIDTH
FFN_DIM = 2816
N_EXPERTS = 8
TOP_K = 2

kernel_name = 'hybrid_diffusion_gmlp_diffattn_gqa_rglru_moe'


def rms_norm(x, g):
    xf = x.astype(jnp.float32)
    y = xf * lax.rsqrt(jnp.mean(xf * xf, axis=-1, keepdims=True) + EPS)
    return (y * g.astype(jnp.float32)).astype(x.dtype)


def rope_1d(x, pos):
    half = x.shape[-1] // 2
    freqs = ROPE_THETA ** (-jnp.arange(half, dtype=jnp.float32) / half)
    ang = pos.astype(jnp.float32)[:, None] * freqs[None, :]
    cos = jnp.cos(ang)[None, :, None, :]
    sin = jnp.sin(ang)[None, :, None, :]
    xf = x.astype(jnp.float32)
    x1, x2 = xf[..., :half], xf[..., half:]
    return jnp.concatenate([x1 * cos - x2 * sin, x1 * sin + x2 * cos], axis=-1).astype(x.dtype)


def axial_rope(x, row, col):
    h = x.shape[-1] // 2
    return jnp.concatenate([rope_1d(x[..., :h], row), rope_1d(x[..., h:], col)], axis=-1)


def sweep_query_blocks(fn, q):
    b, l = q.shape[:2]
    nb = l // Q_BLOCK
    qb = jnp.moveaxis(q.reshape(b, nb, Q_BLOCK, *q.shape[2:]), 1, 0)
    out = lax.map(fn, qb)
    return jnp.moveaxis(out, 0, 1).reshape(b, l, *out.shape[3:])


def diff_attention(q, k, v, lam):
    s = jnp.einsum('bqhcd,bkhcd->bhcqk', q, k, preferred_element_type=jnp.float32) * (HEAD_DIM ** -0.5)
    p = jax.nn.softmax(s, axis=-1)
    w = p[:, :, 0] - lam * p[:, :, 1]
    return jnp.einsum('bhqk,bkhe->bqhe', w.astype(v.dtype), v)


def gqa_attention(q, k, v):
    s = jnp.einsum('bqngd,bknd->bngqk', q, k, preferred_element_type=jnp.float32) * (HEAD_DIM ** -0.5)
    p = jax.nn.softmax(s, axis=-1).astype(v.dtype)
    return jnp.einsum('bngqk,bknd->bqngd', p, v)


def chunk_gmlp(ua, va, norm_g, ws, bs):
    b, l, _ = ua.shape
    u = jax.nn.gelu(ua).reshape(b, l // CHUNK, CHUNK, A_GROUPS, HEAD_DIM)
    v = rms_norm(jax.nn.gelu(va), norm_g).reshape(b, l // CHUNK, CHUNK, A_GROUPS, HEAD_DIM)
    mixed = jnp.einsum('gpq,bnqgc->bnpgc', ws, v) + bs.T[:, :, None]
    return (u * mixed).reshape(b, l, A_WIDTH)


def depthwise_conv(x, w, b):
    left = CONV_W // 2
    out = lax.conv_general_dilated(x, w[:, None, :], window_strides=(1,), padding=[(left, CONV_W - 1 - left)],
                                   dimension_numbers=('NWC', 'WIO', 'NWC'), feature_group_count=x.shape[-1])
    return out + b


def block_diag(x, w, b):
    xb = x.reshape(*x.shape[:-1], D_BLOCKS, -1)
    return jnp.einsum('blnc,ncd->blnd', xb, w).reshape(x.shape) + b


def lru_coeffs(xd, wa, ba, wx, bx, lam):
    r = jax.nn.sigmoid(block_diag(xd, wa, ba).astype(jnp.float32))
    i = jax.nn.sigmoid(block_diag(xd, wx, bx).astype(jnp.float32))
    log_a = -LRU_C * r * jax.nn.softplus(-lam.astype(jnp.float32))
    a = jnp.exp(log_a)
    bterm = jnp.sqrt(-jnp.expm1(2.0 * log_a)) * (i * xd.astype(jnp.float32))
    return a, bterm


def linear_scan(a, b, h0, reverse):
    if h0 is not None:
        idx = -1 if reverse else 0
        b = b.at[:, idx].add(a[:, idx] * h0)

    def combine(left, right):
        a_l, b_l = left
        a_r, b_r = right
        return a_l * a_r, a_r * b_l + b_r

    _, h = lax.associative_scan(combine, (a, b), axis=1, reverse=reverse)
    return h


def swiglu(t, w1, w3, w2):
    return (jax.nn.silu(t @ w1) * (t @ w3)) @ w2


def moe_swiglu(t, wr, br, w1, w3, w2):
    shape = t.shape
    tf = t.reshape(-1, shape[-1])
    logits = (tf @ wr + br).astype(jnp.float32)
    top_v, top_i = lax.top_k(logits, TOP_K)
    gates = jax.nn.softmax(top_v, axis=-1)
    dense_gate = jnp.sum(jax.nn.one_hot(top_i, N_EXPERTS, dtype=jnp.float32) * gates[..., None], axis=1).astype(t.dtype)
    out = jnp.zeros_like(tf)
    for e in range(N_EXPERTS):
        out = out + dense_gate[:, e:e + 1] * swiglu(tf, w1[e], w3[e], w2[e])
    return out.reshape(shape)


def even_mixer(h, hc, row, col, w_in, a_norm_g, a_ws, a_bs, qn_g, kn_g, lq1, lk1, lq2, lk2, subln_g, lam_init, need_ctx):
    b, l, _ = h.shape
    lc = hc.shape[1]
    ua, va, q, k, v = jnp.split(h @ w_in, E_SPLITS, axis=-1)
    uac, vac, qc, kc, vc = jnp.split(hc @ w_in, E_SPLITS, axis=-1)

    def qk(t, g, n):
        return rms_norm(t.reshape(b, n, 2 * B_HEADS, HEAD_DIM), g)

    q = axial_rope(qk(q, qn_g, l), row, col).reshape(b, l, B_HEADS, 2, HEAD_DIM)
    k = axial_rope(qk(k, kn_g, l), row, col).reshape(b, l, B_HEADS, 2, HEAD_DIM)
    kc = qk(kc, kn_g, lc).reshape(b, lc, B_HEADS, 2, HEAD_DIM)
    vc = vc.reshape(b, lc, B_HEADS, 2 * HEAD_DIM)
    k_all = jnp.concatenate([kc, k], axis=1)
    v_all = jnp.concatenate([vc, v.reshape(b, l, B_HEADS, 2 * HEAD_DIM)], axis=1)
    lam = (jnp.exp(jnp.sum(lq1.astype(jnp.float32) * lk1.astype(jnp.float32)))
           - jnp.exp(jnp.sum(lq2.astype(jnp.float32) * lk2.astype(jnp.float32))) + lam_init)

    def diff_out(o):
        return (rms_norm(o, subln_g) * (1.0 - lam_init)).reshape(*o.shape[:2], B_WIDTH)

    yb = diff_out(sweep_query_blocks(lambda qb: diff_attention(qb, k_all, v_all, lam), q))
    ya = chunk_gmlp(ua, va, a_norm_g, a_ws, a_bs)
    y = jnp.concatenate([ya, yb], axis=-1)
    if not need_ctx:
        return y, None
    qc = qk(qc, qn_g, lc).reshape(b, lc, B_HEADS, 2, HEAD_DIM)
    ybc = diff_out(diff_attention(qc, kc, vc, lam))
    yac = chunk_gmlp(uac, vac, a_norm_g, a_ws, a_bs)
    return y, jnp.concatenate([yac, ybc], axis=-1)


def odd_mixer(h, hc, row, col, w_in, qn_g, kn_g, conv_w, conv_b, wa, ba, wx, bx, lam, need_ctx):
    b, l, _ = h.shape
    lc = hc.shape[1]
    q, k, v, gate, xr = jnp.split(h @ w_in, O_SPLITS, axis=-1)
    qc, kc, vc, gatec, xrc = jnp.split(hc @ w_in, O_SPLITS, axis=-1)
    q = axial_rope(rms_norm(q.reshape(b, l, C_HEADS, HEAD_DIM), qn_g), row, col).reshape(b, l, C_KV_HEADS, C_GROUP, HEAD_DIM)
    k = axial_rope(rms_norm(k.reshape(b, l, C_KV_HEADS, HEAD_DIM), kn_g), row, col)
    kc = rms_norm(kc.reshape(b, lc, C_KV_HEADS, HEAD_DIM), kn_g)
    vc = vc.reshape(b, lc, C_KV_HEADS, HEAD_DIM)
    k_all = jnp.concatenate([kc, k], axis=1)
    v_all = jnp.concatenate([vc, v.reshape(b, l, C_KV_HEADS, HEAD_DIM)], axis=1)
    y_attn = sweep_query_blocks(lambda qb: gqa_attention(qb, k_all, v_all), q).reshape(b, l, C_WIDTH)
    xd = depthwise_conv(xr, conv_w, conv_b)
    xdc = depthwise_conv(xrc, conv_w, conv_b)
    h_lat, h_ctx = [], []
    for d, rev in enumerate((False, True)):
        a_c, b_c = lru_coeffs(xdc, wa[d], ba[d], wx[d], bx[d], lam[d])
        hs_c = linear_scan(a_c, b_c, None, rev)
        a_l, b_l = lru_coeffs(xd, wa[d], ba[d], wx[d], bx[d], lam[d])
        h_lat.append(linear_scan(a_l, b_l, hs_c[:, 0] if rev else hs_c[:, -1], rev))
        h_ctx.append(hs_c)
    y_rec = (h_lat[0] + h_lat[1]).astype(h.dtype) * jax.nn.gelu(gate)
    y = jnp.concatenate([y_attn, y_rec], axis=-1)
    if not need_ctx:
        return y, None
    qc = rms_norm(qc.reshape(b, lc, C_HEADS, HEAD_DIM), qn_g).reshape(b, lc, C_KV_HEADS, C_GROUP, HEAD_DIM)
    yc_attn = gqa_attention(qc, kc, vc).reshape(b, lc, C_WIDTH)
    yc_rec = (h_ctx[0] + h_ctx[1]).astype(hc.dtype) * jax.nn.gelu(gatec)
    return y, jnp.concatenate([yc_attn, yc_rec], axis=-1)


def setup_inputs(seed: int = 0) -> dict:
    key = jax.random.key(seed)
    ks = iter(jax.random.split(key, 64))

    def nrm(shape, scale=1.0):
        return jax.random.normal(next(ks), shape, jnp.float32) * scale

    def gain(shape):
        return 1.0 + 0.05 * nrm(shape)

    D, F, E, NE, NO = D_MODEL, FFN_DIM, N_EXPERTS, N_EVEN, N_ODD
    bs = D_WIDTH // D_BLOCKS
    u = jax.random.uniform(next(ks), (NO, 2, D_WIDTH), jnp.float32, 0.9, 0.999)
    p = u ** (1.0 / LRU_C)
    d_lambda = jnp.log(p) - jnp.log1p(-p)
    return {
        'x': nrm((BATCH, SEQ, D)),
        'c': nrm((BATCH, D)),
        'ctx': nrm((BATCH, CTX_LEN, D)),
        'c_ctx': nrm((D,)),
        'w_mod': nrm((DEPTH, D, 6 * D), 0.5 * D ** -0.5),
        'b_mod': nrm((DEPTH, 6 * D), 0.01),
        'norm_mix_g': gain((DEPTH, D)),
        'norm_ffn_g': gain((DEPTH, D)),
        'w_out': nrm((DEPTH, D, D), D ** -0.5),
        'e_w_in': nrm((NE, D, E_IN), D ** -0.5),
        'a_norm_g': gain((NE, A_WIDTH)),
        'a_ws': nrm((NE, A_GROUPS, CHUNK, CHUNK), CHUNK ** -0.5),
        'a_bs': 1.0 + nrm((NE, A_GROUPS, CHUNK), 0.02),
        'b_qnorm_g': gain((NE, HEAD_DIM)),
        'b_knorm_g': gain((NE, HEAD_DIM)),
        'b_lq1': nrm((NE, HEAD_DIM), 0.1),
        'b_lk1': nrm((NE, HEAD_DIM), 0.1),
        'b_lq2': nrm((NE, HEAD_DIM), 0.1),
        'b_lk2': nrm((NE, HEAD_DIM), 0.1),
        'b_subln_g': gain((NE, 2 * HEAD_DIM)),
        'ffn_w1': nrm((NE, D, F), D ** -0.5),
        'ffn_w3': nrm((NE, D, F), D ** -0.5),
        'ffn_w2': nrm((NE, F, D), F ** -0.5),
        'o_w_in': nrm((NO, D, O_IN), D ** -0.5),
        'c_qnorm_g': gain((NO, HEAD_DIM)),
        'c_knorm_g': gain((NO, HEAD_DIM)),
        'd_conv_w': nrm((NO, CONV_W, D_WIDTH), CONV_W ** -0.5),
        'd_conv_b': nrm((NO, D_WIDTH), 0.01),
        'd_wa': nrm((NO, 2, D_BLOCKS, bs, bs), bs ** -0.5),
        'd_ba': nrm((NO, 2, D_WIDTH), 0.01),
        'd_wx': nrm((NO, 2, D_BLOCKS, bs, bs), bs ** -0.5),
        'd_bx': nrm((NO, 2, D_WIDTH), 0.01),
        'd_lambda': d_lambda,
        'router_w': nrm((NO, D, E), D ** -0.5),
        'router_b': nrm((NO, E), 0.01),
        'moe_w1': nrm((NO, E, D, F), D ** -0.5),
        'moe_w3': nrm((NO, E, D, F), D ** -0.5),
        'moe_w2': nrm((NO, E, F, D), F ** -0.5),
    }


def reference(x, c, ctx, c_ctx, w_mod, b_mod, norm_mix_g, norm_ffn_g, w_out,
              e_w_in, a_norm_g, a_ws, a_bs, b_qnorm_g, b_knorm_g, b_lq1, b_lk1, b_lq2, b_lk2, b_subln_g,
              ffn_w1, ffn_w3, ffn_w2,
              o_w_in, c_qnorm_g, c_knorm_g, d_conv_w, d_conv_b, d_wa, d_ba, d_wx, d_bx, d_lambda,
              router_w, router_b, moe_w1, moe_w3, moe_w2):
    n_lat = x.shape[1]
    rows = n_lat // GRID_W
    row = jnp.repeat(jnp.arange(rows, dtype=jnp.int32), GRID_W)
    col = jnp.tile(jnp.arange(GRID_W, dtype=jnp.int32), rows)
    xc = ctx
    for layer in range(DEPTH):
        need_ctx = layer < DEPTH - 1
        j = layer // 2
        mod = jax.nn.silu(c) @ w_mod[layer] + b_mod[layer]
        modc = jax.nn.silu(c_ctx) @ w_mod[layer] + b_mod[layer]
        sh1, sc1, g1, sh2, sc2, g2 = jnp.split(mod[:, None, :], 6, axis=-1)
        sh1c, sc1c, g1c, sh2c, sc2c, g2c = jnp.split(modc, 6, axis=-1)
        h = rms_norm(x, norm_mix_g[layer]) * (1.0 + sc1) + sh1
        hc = rms_norm(xc, norm_mix_g[layer]) * (1.0 + sc1c) + sh1c
        if layer % 2 == 0:
            lam_init = 0.8 - 0.6 * math.exp(-0.3 * layer)
            y, yc = even_mixer(h, hc, row, col, e_w_in[j], a_norm_g[j], a_ws[j], a_bs[j], b_qnorm_g[j], b_knorm_g[j],
                               b_lq1[j], b_lk1[j], b_lq2[j], b_lk2[j], b_subln_g[j], lam_init, need_ctx)

            def channel(t):
                return swiglu(t, ffn_w1[j], ffn_w3[j], ffn_w2[j])
        else:
            y, yc = odd_mixer(h, hc, row, col, o_w_in[j], c_qnorm_g[j], c_knorm_g[j], d_conv_w[j], d_conv_b[j],
                              d_wa[j], d_ba[j], d_wx[j], d_bx[j], d_lambda[j], need_ctx)

            def channel(t):
                return moe_swiglu(t, router_w[j], router_b[j], moe_w1[j], moe_w3[j], moe_w2[j])
        x = x + g1 * (y @ w_out[layer])
        x = x + g2 * channel(rms_norm(x, norm_ffn_g[layer]) * (1.0 + sc2) + sh2)
        if need_ctx:
            xc = xc + g1c * (yc @ w_out[layer])
            xc = xc + g2c * channel(rms_norm(xc, norm_ffn_g[layer]) * (1.0 + sc2c) + sh2c)
    return x
```

```cpp
#include <hip/hip_runtime.h>
#include <cstdio>
#include <cstdint>
#include <cmath>
namespace pg8 {
#define PG8_LAS __attribute__((address_space(3)))
typedef unsigned short bf16_t;
typedef short bf16x8 __attribute__((ext_vector_type(8)));
typedef float f32x4 __attribute__((ext_vector_type(4)));
typedef unsigned u32x4 __attribute__((ext_vector_type(4)));
constexpr int BM = 256, BK = 64, HALF = 128, HTB = HALF * BK * 2  , STAGE_BYTES = 8 * HTB, NXCD = 8, WGM = 8;

__host__ __device__ __forceinline__ int lds_byte(int r, int c) { const int st = (r >> 4) * 2 + (c >> 5), rr = r & 15, cc = c & 31, ob = rr * 64 + cc * 2; return st * 1024 + (ob ^ (((ob >> 9) & 1) << 5)); }
__host__ __device__ __forceinline__ void stage_rc(int b, int& R, int& C) { const int st = b / 1024, sb = b % 1024, swz = sb ^ (((sb >> 9) & 1) << 5); R = (st >> 1) * 16 + swz / 64; C = (st & 1) * 32 + (swz % 64) / 2; }
__host__ __device__ __forceinline__ int perm32(int rho) { const int n = rho >> 4, i = rho & 15; return 8 * (i >> 2) + 4 * n + (i & 3); }

struct Unit { int pm, pn; };
struct Gemm { const bf16_t* A; const bf16_t* Bt; int M, N, K; };

struct StaticOrder {
    int nM, nN, nwg, G, c;
    __host__ __device__ void init(int M, int N, int G_, int c_) { nM = M / BM; nN = N / BM; nwg = nM * nN; G = G_; c = c_; }
    __host__ __device__ bool next(int i, Unit& u) const {
        const long L = (long)i * G + c; if (L >= nwg) return false;
        int wgid = (int)L; { const int q = nwg / NXCD, r = nwg % NXCD, xcd = wgid % NXCD, off = wgid / NXCD; wgid = (xcd < r ? xcd * (q + 1) : r * (q + 1) + (xcd - r) * q) + off; }
        const int nig = WGM * nN, gid = wgid / nig, fm = gid * WGM, gsz = (nM - fm) < WGM ? (nM - fm) : WGM;
        u.pm = fm + ((wgid % nig) % gsz); u.pn = (wgid % nig) / gsz; return true;
    }
    __device__ __forceinline__ void a_ready(const Unit&) const {}
    __device__ __forceinline__ void done(const Unit&) const {}
};

__device__ __forceinline__ unsigned cvt_pk_bf16(float lo, float hi) { unsigned r; asm volatile("v_cvt_pk_bf16_f32 %0, %1, %2" : "=v"(r) : "v"(lo), "v"(hi)); return r; }
typedef float f32x2 __attribute__((ext_vector_type(2)));
__device__ __forceinline__ f32x2 gelu_pk(f32x2 v) {
    const f32x2 av = __builtin_elementwise_abs(v), d = av * 0.2316418882f + 1.0f;
    f32x2 t; t.x = __builtin_amdgcn_rcpf(d.x); t.y = __builtin_amdgcn_rcpf(d.y);
    f32x2 q = t * 0.5307027145f + (-0.7265760135f); q = q * t + 0.7107068705f; q = q * t + (-0.142248368f); q = q * t + 0.127414796f; q = q * t;
    const f32x2 s = (v * v) * (-0.72134752044f);
    f32x2 e; e.x = __builtin_amdgcn_exp2f(s.x); e.y = __builtin_amdgcn_exp2f(s.y);
    const f32x2 m = v * (q * e), r = v - m;
    f32x2 o; o.x = v.x < 0.f ? m.x : r.x; o.y = v.y < 0.f ? m.y : r.y; return o;
}

template <int ACT  > struct EpiBf16 {
    static constexpr bool PERM = true, AFTER_DRAIN = false; static_assert(ACT == 0 || ACT == 1, "EpiBf16: ACT is 0 (none) or 1 (gelu_pk)");
    bf16_t* O; int ldc; const float* bias; int split_cols; size_t split_stride; float scale0;
    __device__ __forceinline__ void operator()(const f32x4 (&acc)[2][2][4][2], const Unit& u, int wr, int wc, int fr, int fq) const {
        const int row0 = u.pm * BM + wr * 64 + fr; int colt = u.pn * BM; bf16_t* base = O;
        float sc = 1.f; if (split_cols) { const int t = colt / split_cols; base += (size_t)t * split_stride; colt -= t * split_cols; if (t == 0) sc = scale0; }
        const int col0 = colt + wc * 32 + 8 * fq, bcol0 = u.pn * BM + wc * 32 + 8 * fq;
        f32x4 bv[2][2];
#pragma unroll
        for (int bj = 0; bj < 2; ++bj)
#pragma unroll
            for (int n = 0; n < 2; ++n) bv[bj][n] = bias ? *(const f32x4*)(bias + bcol0 + bj * HALF + 4 * n) : (f32x4){0.f, 0.f, 0.f, 0.f};
#pragma unroll
        for (int ai = 0; ai < 2; ++ai)
#pragma unroll
            for (int m = 0; m < 4; ++m) { bf16_t* rowp = base + (size_t)(row0 + ai * HALF + m * 16) * ldc + col0;
#pragma unroll
                for (int bj = 0; bj < 2; ++bj) { f32x4 v0 = acc[ai][bj][m][0] + bv[bj][0], v1 = acc[ai][bj][m][1] + bv[bj][1];
                    if (ACT == 1) { f32x2 a = gelu_pk((f32x2){v0[0], v0[1]}), b = gelu_pk((f32x2){v0[2], v0[3]}), c = gelu_pk((f32x2){v1[0], v1[1]}), d = gelu_pk((f32x2){v1[2], v1[3]});
                        v0 = (f32x4){a.x, a.y, b.x, b.y}; v1 = (f32x4){c.x, c.y, d.x, d.y}; }
                    v0 = v0 * sc; v1 = v1 * sc; u32x4 w; w.x = cvt_pk_bf16(v0[0], v0[1]); w.y = cvt_pk_bf16(v0[2], v0[3]); w.z = cvt_pk_bf16(v1[0], v1[1]); w.w = cvt_pk_bf16(v1[2], v1[3]);
                    *(u32x4*)(rowp + bj * HALF) = w; } }
    }
};
struct EpiResGate {
    static constexpr bool PERM = false, AFTER_DRAIN = false;
    const float* baseL; const float* baseC; float* out; const float* gate;
    __device__ __forceinline__ void operator()(const f32x4 (&acc)[2][2][4][2], const Unit& u, int wr, int wc, int fr, int fq) const {
        const int s = u.pm < 32 ? 0 : (u.pm < 64 ? 1 : 2);
        const float* gp = gate + s * 6144;
        const float* base = u.pm < 64 ? baseL + (size_t)u.pm * BM * 1024 : baseC + (size_t)(u.pm - 64) * BM * 1024;
        float* o = out + (size_t)u.pm * BM * 1024;
        const int col0 = u.pn * BM + wc * 32 + 4 * fq;
        f32x4 gv[2][2];
#pragma unroll
        for (int bj = 0; bj < 2; ++bj)
#pragma unroll
            for (int n = 0; n < 2; ++n) gv[bj][n] = *(const f32x4*)(gp + col0 + bj * HALF + n * 16);
#pragma unroll
        for (int ai = 0; ai < 2; ++ai)
#pragma unroll
            for (int m = 0; m < 4; ++m) { const size_t off = (size_t)(ai * HALF + wr * 64 + m * 16 + fr) * 1024 + col0;
#pragma unroll
                for (int bj = 0; bj < 2; ++bj)
#pragma unroll
                    for (int n = 0; n < 2; ++n) { const f32x4 bs = *(const f32x4*)(base + off + bj * HALF + n * 16); *(f32x4*)(o + off + bj * HALF + n * 16) = bs + gv[bj][n] * acc[ai][bj][m][n]; }
                if (m & 1) asm volatile("" ::: "memory"); }
    }
};
struct EpiSwiGLU {
    static constexpr bool PERM = true, AFTER_DRAIN = false;
    bf16_t* H; int ldh; int ntl;
    __device__ __forceinline__ void operator()(const f32x4 (&acc)[2][2][4][2], const Unit& u, int wr, int wc, int fr, int fq) const {
        const int row0 = u.pm * BM + wr * 64 + fr; const int ct = u.pn % ntl; const int col0 = ct * HALF + wc * 32 + 8 * fq;
#pragma unroll
        for (int ai = 0; ai < 2; ++ai)
#pragma unroll
            for (int m = 0; m < 4; ++m) { bf16_t* rowp = H + (size_t)(row0 + ai * HALF + m * 16) * ldh + col0;
                float hv[8];
#pragma unroll
                for (int n = 0; n < 2; ++n)
#pragma unroll
                    for (int j = 0; j < 4; ++j) { const float a = acc[ai][0][m][n][j], b = acc[ai][1][m][n][j];
                        const float e = __builtin_amdgcn_exp2f(a * -1.4426950408889634f); hv[n * 4 + j] = a * __builtin_amdgcn_rcpf(1.0f + e) * b; }
                u32x4 w; w.x = cvt_pk_bf16(hv[0], hv[1]); w.y = cvt_pk_bf16(hv[2], hv[3]); w.z = cvt_pk_bf16(hv[4], hv[5]); w.w = cvt_pk_bf16(hv[6], hv[7]);
                *(u32x4*)rowp = w; }
    }
};
struct MoeOrder {
    int npan, ntl, G, c; const PG8_LAS int* pexp;
    __device__ __forceinline__ bool next(int i, Unit& u) const {
        const long L = (long)i * G + c; if (L >= (long)npan * ntl) return false;
        const int pm = (int)(L / ntl), j = (int)(L % ntl); u.pm = pm; u.pn = pexp[pm] * ntl + j; return true;
    }
    __device__ __forceinline__ void a_ready(const Unit&) const {}
    __device__ __forceinline__ void done(const Unit&) const {}
};
template <class Epi, class Sched, bool ALIGN_EPI = false, bool SP2 = false>
__device__ __forceinline__ void gemm_phase(PG8_LAS unsigned char* lds, const Gemm g, const Sched& S, const Epi& E) {
    const int tid = threadIdx.x, wid = __builtin_amdgcn_readfirstlane(tid >> 6), lane = tid & 63, wr = wid >> 2, wc = wid & 3, fr = lane & 15, fq = lane >> 4;
    const int K = g.K, nt = K / BK;
    unsigned voffA[2], voffB[2];
#pragma unroll
    for (int i = 0; i < 2; ++i) { int R, C; stage_rc(tid * 16 + i * 8192, R, C); const int Rb = Epi::PERM ? ((R & ~31) + perm32(R & 31)) : R;
        voffA[i] = (unsigned)(R * K + C) * 2u; voffB[i] = (unsigned)(Rb * K + C) * 2u; }
    const size_t kstep = (size_t)(BK * 2);
    const size_t hstep = (size_t)HALF * K * 2;
    const size_t tstep = 2 * hstep;
    const unsigned ldsw = (unsigned)wid * 1024u;
    const int aoff = lds_byte(wr * 64 + fr, fq * 8), boff = lds_byte(wc * 32 + fr, fq * 8);
#define PG8_SA(b, h) (((b) * 2 + (h)) * HTB)
#define PG8_SB(b, h) ((4 + (b) * 2 + (h)) * HTB)
#define PG8_STAGE(bufoff, gbase, voff) do { _Pragma("unroll") for (int _i = 0; _i < 2; ++_i) \
        __builtin_amdgcn_global_load_lds((const unsigned*)((const char*)(gbase) + (voff)[_i]), (PG8_LAS unsigned*)(lds + (bufoff) + ldsw + _i * 8192), 16, 0, 0); } while (0)
#define PG8_LDA(dst, b, h) do { _Pragma("unroll") for (int m = 0; m < 4; ++m) _Pragma("unroll") for (int k = 0; k < 2; ++k) dst[m][k] = *(const PG8_LAS bf16x8*)(lds + PG8_SA(b, h) + aoff + m * 2048 + k * 1024); } while (0)
#define PG8_LDB(dst, b, h) do { _Pragma("unroll") for (int n = 0; n < 2; ++n) _Pragma("unroll") for (int k = 0; k < 2; ++k) dst[n][k] = *(const PG8_LAS bf16x8*)(lds + PG8_SB(b, h) + boff + n * 2048 + k * 1024); } while (0)
#define PG8_MMA(ai, bj, At, Bt) do { __builtin_amdgcn_s_setprio(1); _Pragma("unroll") for (int m = 0; m < 4; ++m) _Pragma("unroll") for (int n = 0; n < 2; ++n) _Pragma("unroll") for (int k = 0; k < 2; ++k) \
        acc[ai][bj][m][n] = __builtin_amdgcn_mfma_f32_16x16x32_bf16(Bt[n][k], At[m][k], acc[ai][bj][m][n], 0, 0, 0); __builtin_amdgcn_s_setprio(0); } while (0)
#define PG8_WAIT_V(n) asm volatile("s_waitcnt vmcnt(" #n ")" ::: "memory")
#define PG8_WAIT_L(n) asm volatile("s_waitcnt lgkmcnt(" #n ")" ::: "memory")
#define PG8_BAR __builtin_amdgcn_s_barrier()
#define PG8_SCHED __builtin_amdgcn_sched_barrier(0)
    Unit cur, nxt; int ui = 0;
    if (!S.next(0, cur)) return;
    f32x4 acc[2][2][4][2];
#pragma unroll
    for (int a = 0; a < 2; ++a)
#pragma unroll
        for (int b = 0; b < 2; ++b)
#pragma unroll
            for (int m = 0; m < 4; ++m)
#pragma unroll
                for (int n = 0; n < 2; ++n) acc[a][b][m][n] = (f32x4){0.f, 0.f, 0.f, 0.f};
    bf16x8 At[4][2], B0[2][2], B1[2][2];
    const char* cA = (const char*)g.A + (size_t)cur.pm * tstep; const char* cB = (const char*)g.Bt + (size_t)cur.pn * tstep;
    S.a_ready(cur);
    if constexpr (SP2) {
        PG8_STAGE(PG8_SB(0, 0), cB, voffB); PG8_STAGE(PG8_SB(0, 1), cB + hstep, voffB); PG8_STAGE(PG8_SA(0, 0), cA, voffA); PG8_STAGE(PG8_SA(0, 1), cA + hstep, voffA);
        if (wr == 1) PG8_BAR;
        PG8_WAIT_V(2); PG8_BAR;
        PG8_STAGE(PG8_SB(1, 0), cB + kstep, voffB); PG8_STAGE(PG8_SA(1, 0), cA + kstep, voffA); PG8_STAGE(PG8_SB(1, 1), cB + hstep + kstep, voffB);
        PG8_WAIT_V(6); PG8_BAR;
    } else {
        PG8_STAGE(PG8_SB(0, 0), cB, voffB); PG8_STAGE(PG8_SA(0, 0), cA, voffA); PG8_STAGE(PG8_SB(0, 1), cB + hstep, voffB); PG8_STAGE(PG8_SA(0, 1), cA + hstep, voffA);
        if (wr == 1) PG8_BAR;
        PG8_WAIT_V(4); PG8_BAR;
        PG8_STAGE(PG8_SB(1, 0), cB + kstep, voffB); PG8_STAGE(PG8_SA(1, 0), cA + kstep, voffA); PG8_STAGE(PG8_SB(1, 1), cB + hstep + kstep, voffB);
        PG8_WAIT_V(6); PG8_BAR;
    }
    for (;;) {
        const bool has_next = S.next(ui + 1, nxt);
        const char* nA = has_next ? (const char*)g.A + (size_t)nxt.pm * tstep : cA; const char* nB = has_next ? (const char*)g.Bt + (size_t)nxt.pn * tstep : cB;
        for (int t = 0; t < nt; t += 2) {
            const bool last = (t == nt - 2);
            const char* a1 = cA + (size_t)(t + 1) * kstep;
            const char* a2 = last ? nA : cA + (size_t)(t + 2) * kstep; const char* b2 = last ? nB : cB + (size_t)(t + 2) * kstep;
            const char* a3 = a2 + kstep; const char* b3 = b2 + kstep;
            if (last && has_next) S.a_ready(nxt);
            if constexpr (SP2) {
            PG8_LDB(B0, 0, 0); PG8_LDB(B1, 0, 1); PG8_SCHED; PG8_LDA(At, 0, 0); PG8_STAGE(PG8_SA(1, 1), a1 + hstep, voffA);
            PG8_WAIT_V(8); PG8_WAIT_L(0); PG8_BAR; PG8_MMA(0, 0, At, B0); PG8_MMA(0, 1, At, B1); PG8_BAR; PG8_SCHED;
            PG8_LDA(At, 0, 1); PG8_STAGE(PG8_SB(0, 0), b2, voffB); PG8_STAGE(PG8_SB(0, 1), b2 + hstep, voffB); PG8_STAGE(PG8_SA(0, 0), a2, voffA);
            PG8_WAIT_V(8); PG8_WAIT_L(0); PG8_BAR; PG8_MMA(1, 0, At, B0); PG8_MMA(1, 1, At, B1); PG8_BAR; PG8_SCHED;
            PG8_LDB(B0, 1, 0); PG8_LDB(B1, 1, 1); PG8_SCHED; PG8_LDA(At, 1, 0); PG8_STAGE(PG8_SA(0, 1), a2 + hstep, voffA);
            PG8_WAIT_V(8); PG8_WAIT_L(0); PG8_BAR; PG8_MMA(0, 0, At, B0); PG8_MMA(0, 1, At, B1); PG8_BAR; PG8_SCHED;
            PG8_LDA(At, 1, 1); PG8_STAGE(PG8_SB(1, 0), b3, voffB); PG8_STAGE(PG8_SB(1, 1), b3 + hstep, voffB); PG8_STAGE(PG8_SA(1, 0), a3, voffA);
            PG8_WAIT_V(8); PG8_WAIT_L(0); PG8_BAR; PG8_MMA(1, 0, At, B0); PG8_MMA(1, 1, At, B1); PG8_BAR; PG8_SCHED;
            } else {
            PG8_LDB(B0, 0, 0); PG8_SCHED; PG8_LDA(At, 0, 0); PG8_STAGE(PG8_SA(1, 1), a1 + hstep, voffA);
            PG8_WAIT_L(8); PG8_BAR; PG8_WAIT_L(0); PG8_MMA(0, 0, At, B0); PG8_BAR; PG8_SCHED;
            PG8_LDB(B1, 0, 1); PG8_STAGE(PG8_SB(0, 0), b2, voffB);
            PG8_BAR; PG8_WAIT_L(0); PG8_MMA(0, 1, At, B1); PG8_BAR;
            PG8_LDA(At, 0, 1); PG8_STAGE(PG8_SA(0, 0), a2, voffA);
            PG8_BAR; PG8_WAIT_L(0); PG8_MMA(1, 0, At, B0); PG8_BAR; PG8_SCHED;
            PG8_STAGE(PG8_SB(0, 1), b2 + hstep, voffB);
            PG8_WAIT_V(6); PG8_BAR; PG8_MMA(1, 1, At, B1); PG8_BAR;
            PG8_LDB(B0, 1, 0); PG8_SCHED; PG8_LDA(At, 1, 0); PG8_STAGE(PG8_SA(0, 1), a2 + hstep, voffA);
            PG8_WAIT_L(8); PG8_BAR; PG8_WAIT_L(0); PG8_MMA(0, 0, At, B0); PG8_BAR; PG8_SCHED;
            PG8_LDB(B1, 1, 1); PG8_STAGE(PG8_SB(1, 0), b3, voffB);
            PG8_BAR; PG8_WAIT_L(0); PG8_MMA(0, 1, At, B1); PG8_BAR;
            PG8_LDA(At, 1, 1); PG8_STAGE(PG8_SA(1, 0), a3, voffA);
            PG8_BAR; PG8_WAIT_L(0); PG8_MMA(1, 0, At, B0); PG8_BAR; PG8_SCHED;
            PG8_STAGE(PG8_SB(1, 1), b3 + hstep, voffB);
            PG8_WAIT_V(6); PG8_BAR; PG8_MMA(1, 1, At, B1); PG8_BAR;
            }
        }
        if constexpr (ALIGN_EPI) { if (wr == 0) PG8_BAR; }
        if constexpr (!Epi::AFTER_DRAIN) { E(acc, cur, wr, wc, fr, fq); S.done(cur); }
        if (!has_next) break;
#pragma unroll
        for (int a = 0; a < 2; ++a)
#pragma unroll
            for (int b = 0; b < 2; ++b)
#pragma unroll
                for (int m = 0; m < 4; ++m)
#pragma unroll
                    for (int n = 0; n < 2; ++n) acc[a][b][m][n] = (f32x4){0.f, 0.f, 0.f, 0.f};
        cur = nxt; cA = nA; cB = nB; ++ui;
        if constexpr (ALIGN_EPI) { if (wr == 1) PG8_BAR; }
    }
    PG8_WAIT_V(0);
    if constexpr (!ALIGN_EPI) { if (wr == 0) PG8_BAR; }
    PG8_BAR;
    if constexpr (Epi::AFTER_DRAIN) { E.fused(acc, cur, wr, wc, fr, fq, lds, wid, lane); S.done(cur); }
#undef PG8_SA
#undef PG8_SB
#undef PG8_STAGE
#undef PG8_LDA
#undef PG8_LDB
#undef PG8_MMA
#undef PG8_WAIT_V
#undef PG8_WAIT_L
#undef PG8_BAR
#undef PG8_SCHED
}
}

#ifndef PG8_SP2
#define PG8_SP2 true
#endif
#ifndef PG8_ALIGN
#define PG8_ALIGN true
#endif
#include <hip/hip_bf16.h>
#include <cmath>
namespace attn_body {
using bf16=__hip_bfloat16;
using bf16x8=__attribute__((ext_vector_type(8)))short;
using s16x4=__attribute__((ext_vector_type(4)))short;
using f32x16=__attribute__((ext_vector_type(16)))float;
using u32x4=__attribute__((ext_vector_type(4)))unsigned;
constexpr int D=64;
constexpr int NW=8,QBLK=32,QB=QBLK*NW,KVBLK=64;
constexpr int ATTN_UNIT_ROWS=QB;
__device__ __forceinline__ int crow(int r,int hi){return (r&3)+8*(r>>2)+4*hi;}
#define SBAR() __builtin_amdgcn_sched_barrier(0)
__device__ __forceinline__ void cmask(f32x16&p0,f32x16&p1,int jb,int qrel,int hi){
  const float NEG=-INFINITY; int kb=64*jb+4*hi;
  #pragma unroll
  for(int r=0;r<16;++r){int kv=kb+(r&3)+8*(r>>2); if(kv>qrel)p0[r]=NEG; if(kv+32>qrel)p1[r]=NEG;}
}

constexpr int NSLOT=3, SLOTB=8192;
constexpr int LDS_K=0, LDS_V=NSLOT*SLOTB, LDS_WS=2*NSLOT*SLOTB, LDS_OST=LDS_WS+NW*64*4, LDS_BYTES=LDS_OST+NW*4096;
constexpr float C2=0.125f*1.4426950408889634f;
__device__ __forceinline__ void glds16(const void*gsrc,unsigned lds_dst){unsigned keep;
  asm volatile("s_mov_b32 %0, m0\n\ts_mov_b32 m0, %2\n\ts_nop 0\n\tglobal_load_lds_dwordx4 %1, off\n\ts_mov_b32 m0, %0":"=&s"(keep):"v"(gsrc),"s"(lds_dst):"memory");}
__device__ __forceinline__ float max3f(float a,float b,float c){float r;asm("v_max3_f32 %0, %1, %2, %3":"=v"(r):"v"(a),"v"(b),"v"(c));return r;}
__device__ __forceinline__ float max2f(float a,float b){float r;asm("v_max_f32_e32 %0, %1, %2":"=v"(r):"v"(a),"v"(b));return r;}
__device__ __forceinline__ float fadd_s(float a,float b){float r;asm("v_add_f32_e32 %0, %1, %2":"=v"(r):"v"(a),"v"(b));return r;}
__device__ __forceinline__ float fsub_s(float a,float b){float r;asm("v_sub_f32_e32 %0, %1, %2":"=v"(r):"v"(a),"v"(b));return r;}
typedef float f32x2_t __attribute__((ext_vector_type(2))); typedef __bf16 bf16x2_t __attribute__((ext_vector_type(2)));
__device__ __forceinline__ unsigned cvtpk_s(float lo,float hi){f32x2_t v={lo,hi};bf16x2_t b=__builtin_convertvector(v,bf16x2_t);return __builtin_bit_cast(unsigned,b);}
#define WAIT_BAR(N) asm volatile("s_waitcnt vmcnt(" #N ") lgkmcnt(0)\n\ts_barrier":::"memory")

__device__ __forceinline__ void qkt(f32x16&p0,f32x16&p1,const char*Kslot,const bf16x8*qr,const f32x16&negm,int r32,int hi){
  const char*kb=Kslot+hi*1024+r32*16;
  #pragma unroll
  for(int d0=0;d0<4;++d0){
    const bf16x8 b0=*reinterpret_cast<const bf16x8*>(kb+d0*2048);
    const bf16x8 b1=*reinterpret_cast<const bf16x8*>(kb+d0*2048+512);
    if(d0==0){p0=__builtin_amdgcn_mfma_f32_32x32x16_bf16(b0,qr[0],negm,0,0,0);p1=__builtin_amdgcn_mfma_f32_32x32x16_bf16(b1,qr[0],negm,0,0,0);}
    else{p0=__builtin_amdgcn_mfma_f32_32x32x16_bf16(b0,qr[d0],p0,0,0,0);p1=__builtin_amdgcn_mfma_f32_32x32x16_bf16(b1,qr[d0],p1,0,0,0);}}
}
typedef __attribute__((address_space(3))) const char* lds_cptr;
typedef short v4i16_t __attribute__((ext_vector_type(4)));
__device__ __forceinline__ void kload8(bf16x8*kf,lds_cptr kp){
  kf[0]=*(const __attribute__((address_space(3))) bf16x8*)(kp);      kf[1]=*(const __attribute__((address_space(3))) bf16x8*)(kp+512);
  kf[2]=*(const __attribute__((address_space(3))) bf16x8*)(kp+2048); kf[3]=*(const __attribute__((address_space(3))) bf16x8*)(kp+2560);
  kf[4]=*(const __attribute__((address_space(3))) bf16x8*)(kp+4096); kf[5]=*(const __attribute__((address_space(3))) bf16x8*)(kp+4608);
  kf[6]=*(const __attribute__((address_space(3))) bf16x8*)(kp+6144); kf[7]=*(const __attribute__((address_space(3))) bf16x8*)(kp+6656);
}
__device__ __forceinline__ void kload2(bf16x8*kf,lds_cptr kp,int j){ kf[2*j]=*(const __attribute__((address_space(3))) bf16x8*)(kp+j*2048); kf[2*j+1]=*(const __attribute__((address_space(3))) bf16x8*)(kp+j*2048+512); }
__device__ __forceinline__ s16x4 vtr(lds_cptr p){ return __builtin_bit_cast(s16x4,__builtin_amdgcn_ds_read_tr16_b64_v4i16((__attribute__((address_space(3))) v4i16_t*)p)); }
__device__ __forceinline__ float rowmax(const f32x16&p0,const f32x16&p1){
  float a=max3f(p0[0],p0[1],p1[0]),b=max3f(p0[2],p0[3],p1[1]);a=max3f(a,p1[2],p1[3]);
  #pragma unroll
  for(int r=4;r<16;r+=4){a=max3f(a,p0[r],p0[r+1]);b=max3f(b,p0[r+2],p0[r+3]);a=max3f(a,p1[r],p1[r+1]);b=max3f(b,p1[r+2],p1[r+3]);}
  const float m=max2f(a,b);
  auto rr=__builtin_amdgcn_permlane32_swap(__float_as_uint(m),__float_as_uint(m),false,false);
  return max2f(__uint_as_float(rr[0]),__uint_as_float(rr[1]));
}
__device__ __forceinline__ void pv(f32x16*o,int vb,bf16x8 pa0,bf16x8 pa1,bf16x8 pa2,bf16x8 pa3){
  #pragma unroll
  for(int d0=0;d0<2;++d0){s16x4 lo[4],hi[4];
    #pragma unroll
    for(int ks=0;ks<4;++ks){
      asm volatile("ds_read_b64_tr_b16 %0,%1 offset:%c2":"=&v"(lo[ks]):"v"(vb),"i"(d0*4096+ks*1024):"memory");
      asm volatile("ds_read_b64_tr_b16 %0,%1 offset:%c2":"=&v"(hi[ks]):"v"(vb),"i"(d0*4096+ks*1024+512):"memory");}
    asm volatile("s_waitcnt lgkmcnt(0)":::"memory");SBAR();
    #define PK(k) (bf16x8){lo[k][0],lo[k][1],lo[k][2],lo[k][3],hi[k][0],hi[k][1],hi[k][2],hi[k][3]}
    o[d0]=__builtin_amdgcn_mfma_f32_32x32x16_bf16(pa0,PK(0),o[d0],0,0,0);
    o[d0]=__builtin_amdgcn_mfma_f32_32x32x16_bf16(pa1,PK(1),o[d0],0,0,0);
    o[d0]=__builtin_amdgcn_mfma_f32_32x32x16_bf16(pa2,PK(2),o[d0],0,0,0);
    o[d0]=__builtin_amdgcn_mfma_f32_32x32x16_bf16(pa3,PK(3),o[d0],0,0,0);
    #undef PK
  }
}

#ifndef ATTN_STORE16
#define ATTN_STORE16(p,v) (*(u32x4*)(p)=(v))
#endif
template<int THRL> __device__ __forceinline__ void attn_unit(const bf16*Qu,int qp,const bf16*__restrict__ Kc,const bf16*__restrict__ Kl,int kp,const bf16*__restrict__ Vc,const bf16*__restrict__ Vl,int vp,bf16*Ou,int op,int NT,int NCT,char*shm){
  const int tid=threadIdx.x,lane=tid&63,r32=lane&31,hi=lane>>5; const int wid=__builtin_amdgcn_readfirstlane(tid>>6);
  const bf16*Qw=Qu+(long)(wid*QBLK)*qp;
  const unsigned lds0=(unsigned)(uintptr_t)shm;
  float*wsf=(float*)(shm+LDS_WS)+wid*64;
  const bf16*ksrc_c=Kc+(long)lane*kp+wid*8; const bf16*ksrc_l=Kl+(long)lane*kp+wid*8-(long)NCT*KVBLK*kp;
  const bf16*vsrc_c=Vc+(long)(16*(wid&3)+(lane>>2))*vp+(wid>>2)*32+(lane&3)*8; const bf16*vsrc_l=Vl+(long)(16*(wid&3)+(lane>>2))*vp+(wid>>2)*32+(lane&3)*8-(long)NCT*KVBLK*vp;
  const unsigned kdst=lds0+LDS_K+wid*1024, vdst=lds0+LDS_V+wid*1024;
  #define DMA_K(t,slot) glds16(((t)<NCT?ksrc_c:ksrc_l)+(long)(t)*KVBLK*kp,(unsigned)__builtin_amdgcn_readfirstlane(kdst+(slot)))
  #define DMA_V(t,slot) glds16(((t)<NCT?vsrc_c:vsrc_l)+(long)(t)*KVBLK*vp,(unsigned)__builtin_amdgcn_readfirstlane(vdst+(slot)))
  const int vb0=(int)(lds0+LDS_V)+((lane>>4)&1)*32+(lane&3)*8+(4*hi+((lane&15)>>2))*64;
  const char*Kbase=shm+LDS_K; bf16x8 kf[8];
  const lds_cptr shm3=(lds_cptr)shm; const lds_cptr kp0=shm3+LDS_K+hi*1024+r32*16; const lds_cptr vp0=shm3+LDS_V+((lane>>4)&1)*32+(lane&3)*8+(4*hi+((lane&15)>>2))*64;
  DMA_K(0,0);DMA_V(0,0);DMA_K(1,SLOTB);
  bf16x8 qr[4];
  #pragma unroll
  for(int d0=0;d0<4;++d0)qr[d0]=*reinterpret_cast<const bf16x8*>(&Qw[(long)r32*qp+d0*16+hi*8]);
  float mhat=0.f,l_reg=0.f;f32x16 o[2];o[0]=f32x16{};o[1]=f32x16{};f32x16 negm=f32x16{};asm volatile("":"+v"(negm));
  #define CMASK(P0,P1,t) do{}while(0)
  bool resc=false;
  #define START(P0,P1) do{ const float rm=rowmax(P0,P1); resc=false; \
    { const float dl=rm; mhat=fadd_s(mhat,dl); \
      _Pragma("unroll") for(int r=0;r<16;++r){P0[r]=fsub_s(P0[r],dl);P1[r]=fsub_s(P1[r],dl);} \
      _Pragma("unroll") for(int r=0;r<16;++r)negm[r]=-mhat; asm volatile("":"+v"(negm)); } \
    _Pragma("unroll") for(int r=0;r<16;++r)P0[r]=__builtin_amdgcn_exp2f(P0[r]); }while(0)
  #define RESC() do{ if(resc){ asm volatile("s_waitcnt lgkmcnt(0)":::"memory"); \
      _Pragma("unroll") for(int d_=0;d_<2;++d_) _Pragma("unroll") for(int r=0;r<16;++r)o[d_][r]*=wsf[crow(r,hi)]; } }while(0)
  f32x16 pA0,pA1,pB0,pB1;
  int sl_prev=0,sl_cur=0,sl_next=SLOTB;
  #define ROT() do{sl_prev=sl_cur;sl_cur=sl_next;sl_next=(sl_next==(NSLOT-1)*SLOTB)?0:sl_next+SLOTB;}while(0)
  DMA_K(2,2*SLOTB);
  WAIT_BAR(3);
  qkt(pA0,pA1,Kbase,qr,negm,r32,hi);asm volatile("s_nop 15\n\ts_nop 7":"+v"(pA0),"+v"(pA1));CMASK(pA0,pA1,0);
  START(pA0,pA1);
  _Pragma("unroll") for(int r=0;r<16;++r)pA1[r]=__builtin_amdgcn_exp2f(pA1[r]);
  WAIT_BAR(0);
  DMA_K(3,0);DMA_V(1,SLOTB);
  ROT();
  kload8(kf,kp0+sl_cur);
  WAIT_BAR(2);
  s16x4 vlo[8],vhi[8]; u32x4 pw0,pw1,pw2,pw3;
  #define PKW(P,B) cvtpk_s(P[B],P[B+1])
  #define PAF(k) __builtin_bit_cast(bf16x8,pw##k)
  #define VFR(i) (bf16x8){vlo[i][0],vlo[i][1],vlo[i][2],vlo[i][3],vhi[i][0],vhi[i][1],vhi[i][2],vhi[i][3]}
  #define PIN(x) asm volatile("":"+v"(x))
  #define MX3(a,b,c) __builtin_fmaxf(__builtin_fmaxf((a),(b)),(c))
  #define GAPA(MF,A0,A1,A2,A3,W0,W1,PW) do{ MF; sacc+=A0; sacc+=A1; sacc+=A2; sacc+=A3; PIN(sacc); W0; W1; PIN(PW); SBAR(); }while(0)
  #define EX(v) __builtin_amdgcn_exp2f(v)
  #define GAPB(MF,X,B) do{ MF; X[B]=EX(X[B]); X[B+1]=EX(X[B+1]); X[B+2]=EX(X[B+2]); X[B+3]=EX(X[B+3]); PIN(X); SBAR(); }while(0)
  #define VRD(i) do{ vlo[i]=vtr(vp_+(((i)>>2)*4096+((i)&3)*1024)); vhi[i]=vtr(vp_+(((i)>>2)*4096+((i)&3)*1024+512)); }while(0)
  #define KRD(G,j) do{ if(G){ kload2(kf,kp0+sl_next,j); SBAR(); } }while(0)
  #define STEP(C0,C1,P0,P1,t,GK,GV,GL) do{ SBAR(); \
    const lds_cptr vp_=vp0+sl_prev; \
    VRD(0); SBAR(); float sacc=(P0[0]+P0[1]); \
    GAPA(C0=__builtin_amdgcn_mfma_f32_32x32x16_bf16(kf[0],qr[0],negm,0,0,0), P0[2],P0[3],P0[4],P0[5],     pw0[0]=PKW(P0,0), pw0[1]=PKW(P0,2), pw0); \
    VRD(4); SBAR(); GAPA(C1=__builtin_amdgcn_mfma_f32_32x32x16_bf16(kf[1],qr[0],negm,0,0,0), P0[6],P0[7],P0[8],P0[9],     pw0[2]=PKW(P0,4), pw0[3]=PKW(P0,6), pw0); \
    VRD(1); SBAR(); GAPA(C0=__builtin_amdgcn_mfma_f32_32x32x16_bf16(kf[2],qr[1],C0,0,0,0),   P0[10],P0[11],P0[12],P0[13], pw1[0]=PKW(P0,8), pw1[1]=PKW(P0,10), pw1); \
    VRD(5); SBAR(); GAPA(C1=__builtin_amdgcn_mfma_f32_32x32x16_bf16(kf[3],qr[1],C1,0,0,0),   P0[14],P0[15],P1[0],P1[1],   pw1[2]=PKW(P0,12),pw1[3]=PKW(P0,14), pw1); \
    VRD(2); SBAR(); GAPA(C0=__builtin_amdgcn_mfma_f32_32x32x16_bf16(kf[4],qr[2],C0,0,0,0),   P1[2],P1[3],P1[4],P1[5],     pw2[0]=PKW(P1,0), pw2[1]=PKW(P1,2), pw2); \
    VRD(6); SBAR(); GAPA(C1=__builtin_amdgcn_mfma_f32_32x32x16_bf16(kf[5],qr[2],C1,0,0,0),   P1[6],P1[7],P1[8],P1[9],     pw2[2]=PKW(P1,4), pw2[3]=PKW(P1,6), pw2); \
    VRD(3); SBAR(); GAPA(C0=__builtin_amdgcn_mfma_f32_32x32x16_bf16(kf[6],qr[3],C0,0,0,0),   P1[10],P1[11],P1[12],P1[13], pw3[0]=PKW(P1,8), pw3[1]=PKW(P1,10), pw3); \
    VRD(7); SBAR(); GAPA(C1=__builtin_amdgcn_mfma_f32_32x32x16_bf16(kf[7],qr[3],C1,0,0,0),   P1[14],P1[15],0.f,0.f,       pw3[2]=PKW(P1,12),pw3[3]=PKW(P1,14), pw3); \
    l_reg+=sacc; \
    if(GK){DMA_K((t)+3,sl_cur);} if(GV){DMA_V((t)+1,sl_next);} \
    CMASK(C0,C1,t); \
    { float a=MX3(C0[0],C0[1],C1[0]),b=MX3(C0[2],C0[3],C1[1]); a=MX3(a,C1[2],C1[3]); \
      _Pragma("unroll") for(int r=4;r<16;r+=4){a=MX3(a,C0[r],C0[r+1]);b=MX3(b,C0[r+2],C0[r+3]);a=MX3(a,C1[r],C1[r+1]);b=MX3(b,C1[r+2],C1[r+3]);} \
      float rm=__builtin_fmaxf(a,b); { auto rr=__builtin_amdgcn_permlane32_swap(__float_as_uint(rm),__float_as_uint(rm),false,false); rm=__builtin_fmaxf(__uint_as_float(rr[0]),__uint_as_float(rr[1])); } \
      resc=false; \
      if(__builtin_expect(__any(rm>(float)THRL),0)){ const float dl=__builtin_fmaxf(rm,0.f); mhat+=dl; \
        _Pragma("unroll") for(int r=0;r<16;++r){C0[r]-=dl;C1[r]-=dl;} \
        _Pragma("unroll") for(int r=0;r<16;++r)negm[r]=-mhat; asm volatile("":"+v"(negm)); \
        const float f=__builtin_amdgcn_exp2f(-dl); l_reg*=f; if(hi==0)wsf[r32]=f; resc=true; } } \
    SBAR(); \
    GAPB(o[0]=__builtin_amdgcn_mfma_f32_32x32x16_bf16(PAF(0),VFR(0),o[0],0,0,0), C0,0); \
    GAPB(o[1]=__builtin_amdgcn_mfma_f32_32x32x16_bf16(PAF(0),VFR(4),o[1],0,0,0), C0,4); \
    KRD(GL,0); GAPB(o[0]=__builtin_amdgcn_mfma_f32_32x32x16_bf16(PAF(1),VFR(1),o[0],0,0,0), C0,8); \
    KRD(GL,1); GAPB(o[1]=__builtin_amdgcn_mfma_f32_32x32x16_bf16(PAF(1),VFR(5),o[1],0,0,0), C0,12); \
    KRD(GL,2); GAPB(o[0]=__builtin_amdgcn_mfma_f32_32x32x16_bf16(PAF(2),VFR(2),o[0],0,0,0), C1,0); \
    KRD(GL,3); GAPB(o[1]=__builtin_amdgcn_mfma_f32_32x32x16_bf16(PAF(2),VFR(6),o[1],0,0,0), C1,4); \
    GAPB(o[0]=__builtin_amdgcn_mfma_f32_32x32x16_bf16(PAF(3),VFR(3),o[0],0,0,0), C1,8); \
    GAPB(o[1]=__builtin_amdgcn_mfma_f32_32x32x16_bf16(PAF(3),VFR(7),o[1],0,0,0), C1,12); \
    }while(0)
  int t=1;
  #undef CMASK
  #define CMASK(P0,P1,t) do{}while(0)
  for(;t+5<NT;t+=2){
    STEP(pB0,pB1,pA0,pA1,t,true,true,true);     WAIT_BAR(2); RESC(); ROT();
    STEP(pA0,pA1,pB0,pB1,t+1,true,true,true);   WAIT_BAR(2); RESC(); ROT();
  }
  #undef CMASK
  #define CMASK(P0,P1,t) do{}while(0)
  #define ENDW(tt) do{ if((tt)+3<NT){WAIT_BAR(2);} else if((tt)+2<NT){WAIT_BAR(1);} else {WAIT_BAR(0);} }while(0)
  for(;t+1<NT;t+=2){
    STEP(pB0,pB1,pA0,pA1,t,(t+3<NT),(t+1<NT),(t+1<NT));       ENDW(t);   RESC(); ROT();
    STEP(pA0,pA1,pB0,pB1,t+1,(t+4<NT),(t+2<NT),(t+2<NT));     ENDW(t+1); RESC(); ROT();
  }
  STEP(pB0,pB1,pA0,pA1,NT-1,false,false,false); RESC();
  { float sacc=pB0[0]+pB0[1]; _Pragma("unroll") for(int r=2;r<16;++r)sacc+=pB0[r]; _Pragma("unroll") for(int r=0;r<16;++r)sacc+=pB1[r]; l_reg+=sacc;
    pw0=(u32x4){PKW(pB0,0),PKW(pB0,2),PKW(pB0,4),PKW(pB0,6)};pw1=(u32x4){PKW(pB0,8),PKW(pB0,10),PKW(pB0,12),PKW(pB0,14)};pw2=(u32x4){PKW(pB1,0),PKW(pB1,2),PKW(pB1,4),PKW(pB1,6)};pw3=(u32x4){PKW(pB1,8),PKW(pB1,10),PKW(pB1,12),PKW(pB1,14)};
    SBAR(); pv(o,vb0+sl_cur,PAF(0),PAF(1),PAF(2),PAF(3)); }
  #undef PKW
  #undef PAF
  #undef VFR
  #undef PIN
  #undef MX3
  #undef GAPA
  #undef GAPB
  #undef EX
  #undef VRD
  #undef KRD
  #undef STEP
  #undef ENDW
  {auto rr=__builtin_amdgcn_permlane32_swap(__float_as_uint(l_reg),__float_as_uint(l_reg),false,false);l_reg=__uint_as_float(rr[0])+__uint_as_float(rr[1]);}
  if(hi==0)wsf[32+r32]=l_reg;asm volatile("s_waitcnt lgkmcnt(0)":::"memory");
  float rli[16];
  #pragma unroll
  for(int r=0;r<16;++r)rli[r]=__builtin_amdgcn_rcpf(wsf[32+crow(r,hi)]);
  bf16*Ow=Ou+(long)(wid*QBLK)*op;
  { bf16*stg=(bf16*)(shm+LDS_OST)+wid*2048;
    #pragma unroll
    for(int r=0;r<16;++r){const int orow=crow(r,hi);
      #pragma unroll
      for(int d0=0;d0<2;++d0)stg[orow*64+d0*32+r32]=__float2bfloat16(o[d0][r]*rli[r]);}
    asm volatile("s_waitcnt lgkmcnt(0)":::"memory");
    #pragma unroll
    for(int i=0;i<4;++i){const int row=i*8+(lane>>3),ch=lane&7; const u32x4 v=*(const u32x4*)(stg+row*64+ch*8); ATTN_STORE16(Ow+(long)row*op+ch*8,v);} }
  asm volatile("s_waitcnt lgkmcnt(0)\n\ts_barrier":::"memory");
  #undef DMA_K
  #undef DMA_V
  #undef CMASK
  #undef START
  #undef RESC
  #undef ROT
}
constexpr int ATTN_LDS_BYTES=LDS_BYTES;
#undef SBAR
#undef WAIT_BAR
}
constexpr int NWAVES = 8;
#ifndef MK_ONE_LAUNCH
#define MK_ONE_LAUNCH 1
#endif
constexpr int NPH = 20;

constexpr int D = 1024, NB = 2, SEQ = 8192, CTXL = 256;
constexpr int ML = NB * SEQ, MC = NB * CTXL, MR = ML + MC;
constexpr int E_IN = 2560, O_IN = 1792, FF = 2816, FF2 = 2 * FF, NEXP = 8;
constexpr int MOE_ROWS = 2 * ML + NEXP * 256, MOE_PAN = MOE_ROWS / 256;
constexpr int NCHUNK = MR / 64;
constexpr float EPS = 1e-6f;
constexpr float QSCALE = 0.125f * 1.4426950408889634f;

constexpr size_t MiB = 1u << 20, KiB = 1u << 10;
constexpr size_t WS_CTL = 0, CTL_ZERO_BYTES = 1 * MiB;
constexpr size_t WS_MOD = 1 * MiB;
constexpr size_t WS_WG = 1 * MiB + 256 * KiB;
constexpr size_t WS_TOK = 2 * MiB;
constexpr size_t WS_AGG = 4 * MiB;
constexpr size_t WS_WM13 = 8 * MiB, WS_WM2 = 96 * MiB;
constexpr size_t WS_WE = 140 * MiB, WS_WO0 = 145 * MiB, WS_WO1 = 147 * MiB, WS_WF13 = 149 * MiB, WS_WF2 = 160 * MiB, WS_WOI = 166 * MiB;
constexpr size_t WS_XR = 170 * MiB;
constexpr size_t WS_XN = 236 * MiB;
constexpr size_t WS_Y = 269 * MiB;
constexpr size_t WS_P0 = 302 * MiB;
constexpr size_t WS_OATT = 385 * MiB;
constexpr size_t WS_H = 302 * MiB;
constexpr size_t WS_P1 = 302 * MiB;
constexpr size_t WS_RI = 360 * MiB;
constexpr size_t WS_XG = 368 * MiB;
constexpr size_t WS_HG = 140 * MiB;
constexpr size_t WS_YG = 368 * MiB;
constexpr size_t WS_END = 436 * MiB;
static_assert(WS_WM13 + (size_t)NEXP * FF2 * D * 2 <= WS_WM2 && WS_WM2 + (size_t)NEXP * D * FF * 2 <= WS_WE && WS_WE + (size_t)E_IN * D * 2 <= WS_WO0 && WS_WF13 + (size_t)FF2 * D * 2 <= WS_WF2 &&
              WS_WF2 + (size_t)D * FF * 2 <= WS_WOI && WS_WOI + (size_t)O_IN * D * 2 <= WS_XR && WS_XR + (size_t)MR * D * 4 <= WS_XN && WS_XN + (size_t)MR * D * 2 <= WS_Y && WS_Y + (size_t)MR * D * 2 <= WS_P0 &&
              WS_P0 + (size_t)MR * E_IN * 2 <= WS_OATT && WS_OATT + (size_t)MR * D * 2 <= WS_END && WS_H + (size_t)MR * FF * 2 <= WS_END && WS_P1 + (size_t)MR * O_IN * 2 <= WS_RI &&
              WS_RI + (size_t)4 * MR * 512 * 2 <= WS_END && WS_XG + (size_t)MOE_ROWS * D * 2 <= WS_END && WS_HG + (size_t)MOE_ROWS * FF * 2 <= WS_XG && WS_AGG + (size_t)2 * NCHUNK * 2 * 512 * 4 <= WS_WM13, "d_ws map");
constexpr int CW_TMO = 0, CW_CODE = 1;
constexpr int CW_BAR = 4096;
constexpr int CW_CNT = 8192;
constexpr int RING_OFF = 0, RING_BYTES = 131072;
constexpr int LDSCTL_OFF = RING_BYTES, MISC_OFF = LDSCTL_OFF + 320;
constexpr int PEXP_OFF = LDSCTL_OFF + 1024;
constexpr int LDS_BYTES = 147456;
#define GAS __attribute__((address_space(1)))
#define LAS __attribute__((address_space(3)))
typedef unsigned short bf16;
typedef unsigned v4u __attribute__((ext_vector_type(4)));
typedef float f32x4 __attribute__((ext_vector_type(4)));
typedef short bf16x8 __attribute__((ext_vector_type(8)));
typedef GAS unsigned gu32;
typedef GAS unsigned long long gu64;
#define RLX_AGENT __ATOMIC_RELAXED, __HIP_MEMORY_SCOPE_AGENT
#define LDS_WAIT() asm volatile("s_waitcnt lgkmcnt(0)" ::: "memory")
#define VM_WAIT() asm volatile("s_waitcnt vmcnt(0)" ::: "memory")
__device__ __forceinline__ unsigned long long rt() { return __builtin_amdgcn_s_memrealtime(); }
__device__ __forceinline__ unsigned f2bf(float f) { unsigned u = __builtin_bit_cast(unsigned, f); return (u + 0x7fffu + ((u >> 16) & 1u)) >> 16; }
__device__ __forceinline__ unsigned pk2(float lo, float hi) { return f2bf(lo) | (f2bf(hi) << 16); }

#define XB_TMO      128
#define XB_XCNT(j)  (256  + 64 * (j))
#define XB_XSUB(j)  (1280 + 64 * (j))
#define XB_XGEN(j)  (2304 + 64 * (j))
#define XB_TOP      3328
#define XB_TOPGEN   3392
#define XCD_BAR_WORDS 3456
#define XB_SPIN_CAP (1u << 18)

__device__ __forceinline__ unsigned xb_ld(unsigned* p)              { return __hip_atomic_load(p, __ATOMIC_RELAXED, __HIP_MEMORY_SCOPE_AGENT); }
__device__ __forceinline__ unsigned xb_add(unsigned* p, unsigned v) { return __hip_atomic_fetch_add(p, v, __ATOMIC_RELAXED, __HIP_MEMORY_SCOPE_AGENT); }
__device__ __forceinline__ unsigned xb_xcc_id() { return (unsigned)__builtin_amdgcn_s_getreg((3 << 11) | 20) & 0xFu; }
#define XB_SPIN(cond, bar) do { unsigned _sp = 0; while (cond) { __builtin_amdgcn_s_sleep(1); \
    if ((++_sp & 255u) == 0u) { if (xb_ld(&(bar)[XB_TMO])) break; if (_sp > XB_SPIN_CAP) { atomicAdd(&(bar)[XB_TMO], 1u); break; } } } } while (0)

struct XcdBarrier {
    unsigned* bar; unsigned x;
    volatile LAS unsigned* st;
};

__device__ __forceinline__ XcdBarrier xcd_barrier_post(unsigned* bar, volatile LAS unsigned* st) {
    XcdBarrier b; b.bar = bar; b.x = xb_xcc_id(); b.st = st;
    if (threadIdx.x == 0) (void)xb_add(&bar[XB_XCNT(b.x)], 1u);
    return b;
}
__device__ __forceinline__ void xcd_barrier_complete(unsigned* bar, unsigned x, unsigned& nloc, unsigned& nx) {
    const unsigned G = gridDim.x * gridDim.y * gridDim.z;
    unsigned sum, cnt, mine, sp = 0u;
    for (;;) {
        sum = 0u; cnt = 0u; mine = 0u;
#pragma unroll
        for (unsigned j = 0; j < 16; ++j) { const unsigned c = xb_ld(&bar[XB_XCNT(j)]); sum += c; cnt += (c > 0u) ? 1u : 0u; mine = (j == x) ? c : mine; }
        if (sum == G) break;
        __builtin_amdgcn_s_sleep(1);
        if ((++sp & 255u) == 0u) { if (xb_ld(&bar[XB_TMO])) break; if (sp > XB_SPIN_CAP) { atomicAdd(&bar[XB_TMO], 1u); break; } }
    }
    nloc = mine > 0u ? mine : 1u; nx = cnt > 0u ? cnt : 1u;
}

__device__ __forceinline__ void xcd_barrier(const XcdBarrier& b) {
    asm volatile("s_waitcnt vmcnt(0)" ::: "memory");
    __syncthreads();
    if (threadIdx.x == 0) {
        unsigned* bar = b.bar;
        __builtin_amdgcn_s_waitcnt(0);
        unsigned nloc = b.st[0], nx = b.st[1];
        if (nloc == 0u) { xcd_barrier_complete(bar, b.x, nloc, nx); b.st[0] = nloc; b.st[1] = nx; }
        const unsigned old = xb_add(&bar[XB_XSUB(b.x)], 1u);
        const unsigned gen = old / nloc;
        if (old + 1u == (gen + 1u) * nloc) {
            __builtin_amdgcn_fence(__ATOMIC_RELEASE, "agent");
            asm volatile("s_waitcnt vmcnt(0)" ::: "memory");
            const unsigned og = xb_add(&bar[XB_TOP], 1u);
            const unsigned tg = og / nx;
            if (og + 1u == (tg + 1u) * nx) xb_add(&bar[XB_TOPGEN], 1u);
            else XB_SPIN(xb_ld(&bar[XB_TOPGEN]) == tg, bar);
            __builtin_amdgcn_fence(__ATOMIC_ACQUIRE, "agent");
            xb_add(&bar[XB_XGEN(b.x)], 1u);
            asm volatile("s_waitcnt vmcnt(0)" ::: "memory");
        } else {
            XB_SPIN(xb_ld(&bar[XB_XGEN(b.x)]) == gen, bar);
            __builtin_amdgcn_fence(__ATOMIC_ACQUIRE, "agent");
            asm volatile("s_waitcnt vmcnt(0)" ::: "memory");
        }
    }
    __syncthreads();
}
typedef _Float16 f16;
typedef unsigned v2u __attribute__((ext_vector_type(2)));
typedef float f32x16 __attribute__((ext_vector_type(16)));
struct Frame {
    LAS unsigned char* lds;
    volatile LAS unsigned* MISC;
    gu32* ctl;
    int tid, lane, wave;
    int vcu, G;
    const float* in[38]; float* out; unsigned char* ws;
};
enum { I_X = 0, I_C, I_CTX, I_CCTX, I_WMOD, I_BMOD, I_NMIXG, I_NFFNG, I_WOUT, I_EWIN, I_ANORMG, I_AWS, I_ABS, I_BQNG, I_BKNG, I_LQ1, I_LK1, I_LQ2, I_LK2, I_SUBLNG,
       I_FW1, I_FW3, I_FW2, I_OWIN, I_CQNG, I_CKNG, I_CONVW, I_CONVB, I_DWA, I_DBA, I_DWX, I_DBX, I_DLAM, I_RW, I_RB, I_MW1, I_MW3, I_MW2 };

__device__ __forceinline__ float wave_sum(float v) {
#pragma unroll
    for (int o = 1; o < 64; o <<= 1) v += __shfl_xor(v, o);
    return v;
}
__device__ __forceinline__ float bf_lo(unsigned u) { return __uint_as_float(u << 16); }
__device__ __forceinline__ float bf_hi(unsigned u) { return __uint_as_float(u & 0xffff0000u); }
__device__ __forceinline__ float bf2f(bf16 h) { return __uint_as_float((unsigned)h << 16); }
__device__ __forceinline__ unsigned cvtpk(float lo, float hi) { return pg8::cvt_pk_bf16(lo, hi); }
__device__ __forceinline__ bf16 f2bf16(float f) { return (bf16)(cvtpk(f, 0.f) & 0xffffu); }
__device__ __forceinline__ void unpack8(const v4u u, float (&f)[8]) { f[0] = bf_lo(u.x); f[1] = bf_hi(u.x); f[2] = bf_lo(u.y); f[3] = bf_hi(u.y); f[4] = bf_lo(u.z); f[5] = bf_hi(u.z); f[6] = bf_lo(u.w); f[7] = bf_hi(u.w); }
__device__ __forceinline__ v4u pack8(const float (&f)[8]) { v4u o; o.x = cvtpk(f[0], f[1]); o.y = cvtpk(f[2], f[3]); o.z = cvtpk(f[4], f[5]); o.w = cvtpk(f[6], f[7]); return o; }
__device__ __forceinline__ float gelu_tanh(float x) { const float z = 0.7978845608028654f * (x + 0.044715f * x * x * x); return x * __builtin_amdgcn_rcpf(1.0f + __builtin_amdgcn_exp2f(-2.885390081777927f * z)); }
__device__ __forceinline__ float sigmoid_f(float x) { return __builtin_amdgcn_rcpf(1.0f + __builtin_amdgcn_exp2f(-1.4426950408889634f * x)); }
__device__ __forceinline__ int crow16(int r, int hi) { return (r & 3) + 8 * (r >> 2) + 4 * hi; }

__device__ __forceinline__ void tr_item(const float* W, int K, int N, bf16* WT, int ilv, LAS float* scr, int item, int lane) {
    const int nblk = N / 32, kb = item / nblk, nb = item % nblk, k0 = 64 * kb, n0 = 32 * nb;
    const int r0 = ilv ? ((n0 >> 7) * 256 + (n0 & 127) + (ilv == 2 ? 128 : 0)) : n0;
#pragma unroll 8
    for (int i = 0; i < 32; ++i) { const int kk = 2 * i + (lane >> 5); scr[kk * 33 + (lane & 31)] = W[(size_t)(k0 + kk) * N + n0 + (lane & 31)]; }
    LDS_WAIT(); asm volatile("" ::: "memory");
    const int c = lane & 7;
#pragma unroll
    for (int j = 0; j < 4; ++j) { const int n = (lane >> 3) + 8 * j; const LAS float* s = scr + (8 * c) * 33 + n;
        v4u o; o.x = cvtpk(s[0 * 33], s[1 * 33]); o.y = cvtpk(s[2 * 33], s[3 * 33]); o.z = cvtpk(s[4 * 33], s[5 * 33]); o.w = cvtpk(s[6 * 33], s[7 * 33]);
        *(GAS v4u*)(WT + (size_t)(r0 + n) * K + k0 + 8 * c) = o; }
    LDS_WAIT(); asm volatile("" ::: "memory");
}
__device__ __forceinline__ void ph0_prologue(Frame& F) {
    LAS float* scr = (LAS float*)(F.lds + RING_OFF + F.wave * 16384);
    const int gw = F.vcu * NWAVES + F.wave, NGW = F.G * NWAVES, lane = F.lane;
    bf16* WE = (bf16*)(F.ws + WS_WE); bf16* WO0 = (bf16*)(F.ws + WS_WO0); bf16* WO1 = (bf16*)(F.ws + WS_WO1); bf16* WF13 = (bf16*)(F.ws + WS_WF13); bf16* WF2 = (bf16*)(F.ws + WS_WF2);
    bf16* WOI = (bf16*)(F.ws + WS_WOI); bf16* WM13 = (bf16*)(F.ws + WS_WM13); bf16* WM2 = (bf16*)(F.ws + WS_WM2);
    constexpr int I_E = 16 * 80, I_O = 16 * 32, I_F = 16 * 88, I_F2 = 44 * 32, I_OI = 16 * 56, I_EXP = 3 * I_F;
    static_assert(I_F == I_F2, "item counts");
    constexpr int NITEMS = I_E + 2 * I_O + 2 * I_F + I_F2 + I_OI + NEXP * I_EXP;
    for (int it = gw; it < NITEMS; it += NGW) {
        int r = it;
        if (r < I_E) { tr_item(F.in[I_EWIN], D, E_IN, WE, 0, scr, r, lane); continue; } r -= I_E;
        if (r < I_O) { tr_item(F.in[I_WOUT], D, D, WO0, 0, scr, r, lane); continue; } r -= I_O;
        if (r < I_O) { tr_item(F.in[I_WOUT] + (size_t)D * D, D, D, WO1, 0, scr, r, lane); continue; } r -= I_O;
        if (r < I_F) { tr_item(F.in[I_FW1], D, FF, WF13, 1, scr, r, lane); continue; } r -= I_F;
        if (r < I_F) { tr_item(F.in[I_FW3], D, FF, WF13, 2, scr, r, lane); continue; } r -= I_F;
        if (r < I_F2) { tr_item(F.in[I_FW2], FF, D, WF2, 0, scr, r, lane); continue; } r -= I_F2;
        if (r < I_OI) { tr_item(F.in[I_OWIN], D, O_IN, WOI, 0, scr, r, lane); continue; } r -= I_OI;
        { const int e = r / I_EXP, q = r % I_EXP;
          if (q < I_F) tr_item(F.in[I_MW1] + (size_t)e * D * FF, D, FF, WM13 + (size_t)e * FF2 * D, 1, scr, q, lane);
          else if (q < 2 * I_F) tr_item(F.in[I_MW3] + (size_t)e * D * FF, D, FF, WM13 + (size_t)e * FF2 * D, 2, scr, q - I_F, lane);
          else tr_item(F.in[I_MW2] + (size_t)e * FF * D, FF, D, WM2 + (size_t)e * D * FF, 0, scr, q - 2 * I_F, lane); }
    }
    { bf16* WG = (bf16*)(F.ws + WS_WG);
      for (int i = (int)blockIdx.x * 512 + F.tid; i < 2 * 2 * 8 * 64 * 64; i += F.G * 512) {
          const int k = i & 63, o = (i >> 6) & 63, n = (i >> 12) & 7, mat = (i >> 15) & 1, d = (i >> 16) & 1;
          const float* W = mat ? F.in[I_DWX] : F.in[I_DWA];
          WG[i] = f2bf16(W[((size_t)(d * 8 + n) * 64 + k) * 64 + o]); } }
    __syncthreads();
    { float* MOD = (float*)(F.ws + WS_MOD); LAS float* red = (LAS float*)(F.lds + RING_OFF);
      for (int cg = (int)blockIdx.x; cg < 2 * 96; cg += F.G) {
          const int layer = cg / 96, n0 = (cg % 96) * 64, kr = lane >> 4, c4 = lane & 15;
          f32x4 acc[3]; acc[0] = acc[1] = acc[2] = (f32x4){0.f, 0.f, 0.f, 0.f};
          const float* Wl = F.in[I_WMOD] + (size_t)layer * D * 6 * D;
#pragma unroll 4
          for (int it = 0; it < 32; ++it) { const int k = F.wave * 128 + 4 * it + kr;
              const f32x4 w = *(const GAS f32x4*)(Wl + (size_t)k * 6 * D + n0 + 4 * c4);
              const float c0 = F.in[I_C][k], c1 = F.in[I_C][D + k], c2 = F.in[I_CCTX][k];
              acc[0] += (c0 * sigmoid_f(c0)) * w; acc[1] += (c1 * sigmoid_f(c1)) * w; acc[2] += (c2 * sigmoid_f(c2)) * w; }
#pragma unroll
          for (int s = 0; s < 3; ++s)
#pragma unroll
              for (int j = 0; j < 4; ++j) { float v = acc[s][j]; v += __shfl_xor(v, 16); v += __shfl_xor(v, 32); acc[s][j] = v; }
          if (lane < 16) {
#pragma unroll
              for (int s = 0; s < 3; ++s)
#pragma unroll
                  for (int j = 0; j < 4; ++j) red[(F.wave * 3 + s) * 64 + 4 * c4 + j] = acc[s][j]; }
          __syncthreads();
          if (F.tid < 192) { const int s = F.tid >> 6, col = F.tid & 63; float v = F.in[I_BMOD][layer * 6 * D + n0 + col];
#pragma unroll
              for (int w = 0; w < 8; ++w) v += red[(w * 3 + s) * 64 + col];
              MOD[(size_t)(layer * 3 + s) * 6 * D + n0 + col] = v; }
          __syncthreads();
      } }
}
__device__ __forceinline__ void normmod_row(const float* src, const float* g, const float* sc, const float* sh, bf16* dst, int lane, f32x4 (&t)[4]) {
    const GAS f32x4* xr = (const GAS f32x4*)src + lane; float s = 0.f;
#pragma unroll
    for (int j = 0; j < 4; ++j) { t[j] = xr[64 * j]; s += (t[j].x * t[j].x + t[j].y * t[j].y) + (t[j].z * t[j].z + t[j].w * t[j].w); }
    const float rstd = 1.0f / sqrtf(wave_sum(s) * (1.f / D) + EPS);
    GAS v2u* o8 = (GAS v2u*)dst + lane;
#pragma unroll
    for (int j = 0; j < 4; ++j) { const f32x4 gg = ((const GAS f32x4*)g)[lane + 64 * j], cc = ((const GAS f32x4*)sc)[lane + 64 * j], hh = ((const GAS f32x4*)sh)[lane + 64 * j];
        t[j] = t[j] * rstd * gg * (1.0f + cc) + hh; v2u w; w.x = cvtpk(t[j].x, t[j].y); w.y = cvtpk(t[j].z, t[j].w); o8[64 * j] = w; }
}
__device__ __forceinline__ void ph_normmod(Frame& F, const float* srcL, const float* srcC, int nrows, const float* g, int layer, int sh_off, int sc_off) {
    const int gw = F.vcu * NWAVES + F.wave, NGW = F.G * NWAVES; const float* MOD = (const float*)(F.ws + WS_MOD) + (size_t)layer * 3 * 6 * D; bf16* XN = (bf16*)(F.ws + WS_XN);
    for (int m = gw; m < nrows; m += NGW) { const int s = m < SEQ ? 0 : (m < ML ? 1 : 2); const float* src = m < ML ? srcL + (size_t)m * D : srcC + (size_t)(m - ML) * D; f32x4 t[4];
        normmod_row(src, g, MOD + s * 6 * D + sc_off, MOD + s * 6 * D + sh_off, XN + (size_t)m * D, F.lane, t); }
}
__device__ __forceinline__ void qknorm_rope(float (&f)[8], const float* g, bool rope, int prow, int pcol, float outscale, int lane) {
    float ss = 0.f;
#pragma unroll
    for (int e = 0; e < 8; ++e) ss += f[e] * f[e];
    ss += __shfl_xor(ss, 1); ss += __shfl_xor(ss, 2); ss += __shfl_xor(ss, 4);
    const float rstd = 1.0f / sqrtf(ss * (1.f / 64.f) + EPS); const int j = lane & 7;
    const f32x4 g0 = *(const GAS f32x4*)(g + 8 * j), g1 = *(const GAS f32x4*)(g + 8 * j + 4);
    const float gg[8] = {g0.x, g0.y, g0.z, g0.w, g1.x, g1.y, g1.z, g1.w};
#pragma unroll
    for (int e = 0; e < 8; ++e) f[e] = f[e] * rstd * gg[e];
    if (rope) {
        const float pos = (float)((j < 4) ? prow : pcol), sgn = (j & 2) ? 1.f : -1.f;
#pragma unroll
        for (int e = 0; e < 8; ++e) { const float p = __shfl_xor(f[e], 2); const int i = (j & 1) * 8 + e;
            const float fr = __builtin_amdgcn_exp2f(-(float)i * (13.287712379549449f / 16.f)); float rev = pos * fr * 0.15915494309189535f; rev = rev - floorf(rev);
            f[e] = f[e] * __builtin_amdgcn_cosf(rev) + sgn * p * __builtin_amdgcn_sinf(rev); }
    }
#pragma unroll
    for (int e = 0; e < 8; ++e) f[e] *= outscale;
}
__device__ __forceinline__ void ph3_post0(Frame& F) {
    const int gw = F.vcu * NWAVES + F.wave, NGW = F.G * NWAVES, lane = F.lane; bf16* P0 = (bf16*)(F.ws + WS_P0);
    for (int m = gw; m < MR; m += NGW) {
        GAS v4u* rowp = (GAS v4u*)(P0 + (size_t)m * E_IN) + lane;
        const v4u u0 = rowp[0], u1 = rowp[64], u2 = rowp[128], u3 = rowp[192];
        float f[8];
        unpack8(u0, f);
#pragma unroll
        for (int e = 0; e < 8; ++e) f[e] = gelu_tanh(f[e]);
        rowp[0] = pack8(f);
        unpack8(u1, f); float ss = 0.f;
#pragma unroll
        for (int e = 0; e < 8; ++e) { f[e] = gelu_tanh(f[e]); ss += f[e] * f[e]; }
        { const float rstd = 1.0f / sqrtf(wave_sum(ss) * (1.f / 512.f) + EPS); const float* g = F.in[I_ANORMG] + 8 * lane;
          const f32x4 g0 = *(const GAS f32x4*)g, g1 = *(const GAS f32x4*)(g + 4); const float gg[8] = {g0.x, g0.y, g0.z, g0.w, g1.x, g1.y, g1.z, g1.w};
#pragma unroll
          for (int e = 0; e < 8; ++e) f[e] = f[e] * rstd * gg[e]; }
        rowp[64] = pack8(f);
        const bool lat = m < ML; const int t = m & (SEQ - 1), prow = t >> 6, pcol = t & 63;
        unpack8(u2, f); qknorm_rope(f, F.in[I_BQNG], lat, prow, pcol, QSCALE, lane); rowp[128] = pack8(f);
        unpack8(u3, f); qknorm_rope(f, F.in[I_BKNG], lat, prow, pcol, 1.0f, lane); rowp[192] = pack8(f);
    }
}
__device__ __forceinline__ void gmlp_unit(Frame& F, int chunk) {
    const int lane = F.lane, r32 = lane & 31, hi = lane >> 5, g = F.wave, r0 = chunk * 128;
    const bf16* P0 = (const bf16*)(F.ws + WS_P0); bf16* Y = (bf16*)(F.ws + WS_Y);
    const float* ws = F.in[I_AWS] + (size_t)g * 128 * 128; const float* bs = F.in[I_ABS] + g * 128;
    bf16x8 afr[2][8];
#pragma unroll
    for (int ct = 0; ct < 2; ++ct)
#pragma unroll
        for (int ks = 0; ks < 8; ++ks)
#pragma unroll
            for (int e = 0; e < 8; ++e) afr[ct][ks][e] = (short)P0[(size_t)(r0 + 16 * ks + 8 * hi + e) * E_IN + 512 + 64 * g + 32 * ct + r32];
#pragma unroll 1
    for (int pt = 0; pt < 4; ++pt) {
        f32x16 acc[2]; acc[0] = f32x16{}; acc[1] = f32x16{};
        const float* wp = ws + (size_t)(32 * pt + r32) * 128 + 8 * hi;
#pragma unroll
        for (int ks = 0; ks < 8; ++ks) { const f32x4 w0 = *(const GAS f32x4*)(wp + 16 * ks), w1 = *(const GAS f32x4*)(wp + 16 * ks + 4);
            v4u pk; pk.x = cvtpk(w0.x, w0.y); pk.y = cvtpk(w0.z, w0.w); pk.z = cvtpk(w1.x, w1.y); pk.w = cvtpk(w1.z, w1.w); const bf16x8 bfr = __builtin_bit_cast(bf16x8, pk);
            acc[0] = __builtin_amdgcn_mfma_f32_32x32x16_bf16(afr[0][ks], bfr, acc[0], 0, 0, 0); acc[1] = __builtin_amdgcn_mfma_f32_32x32x16_bf16(afr[1][ks], bfr, acc[1], 0, 0, 0); }
        const int p = 32 * pt + r32; const float bias = bs[p];
#pragma unroll
        for (int ct = 0; ct < 2; ++ct)
#pragma unroll
            for (int rq = 0; rq < 4; ++rq) { const int c0 = 64 * g + 32 * ct + 8 * rq + 4 * hi;
                const v2u uu = *(const GAS v2u*)(P0 + (size_t)(r0 + p) * E_IN + c0);
                v2u o; o.x = cvtpk(bf_lo(uu.x) * (acc[ct][4 * rq + 0] + bias), bf_hi(uu.x) * (acc[ct][4 * rq + 1] + bias)); o.y = cvtpk(bf_lo(uu.y) * (acc[ct][4 * rq + 2] + bias), bf_hi(uu.y) * (acc[ct][4 * rq + 3] + bias));
                *(GAS v2u*)(Y + (size_t)(r0 + p) * D + c0) = o; }
    }
}
__device__ __forceinline__ void ph5_diffout(Frame& F) {
    const int gw = F.vcu * NWAVES + F.wave, NGW = F.G * NWAVES, lane = F.lane; const bf16* OA = (const bf16*)(F.ws + WS_OATT); bf16* Y = (bf16*)(F.ws + WS_Y);
    const float s1 = wave_sum(F.in[I_LQ1][lane] * F.in[I_LK1][lane]), s2 = wave_sum(F.in[I_LQ2][lane] * F.in[I_LK2][lane]);
    const float lam_init = 0.2f, lam = expf(s1) - expf(s2) + lam_init;
    const int h = lane >> 4, comp = (lane >> 3) & 1, i0 = (lane & 7) * 16;
    float gg[16];
#pragma unroll
    for (int q = 0; q < 4; ++q) { const f32x4 gv = *(const GAS f32x4*)(F.in[I_SUBLNG] + i0 + 4 * q); gg[4 * q] = gv.x; gg[4 * q + 1] = gv.y; gg[4 * q + 2] = gv.z; gg[4 * q + 3] = gv.w; }
    for (int m = gw; m < MR; m += NGW) {
        const GAS v4u* rp = (const GAS v4u*)(OA + (size_t)m * D + 16 * lane);
        const v4u a = rp[0], b = rp[1]; float own[16], d[16];
        { float t8[8]; unpack8(a, t8);
#pragma unroll
          for (int e = 0; e < 8; ++e) own[e] = t8[e];
          unpack8(b, t8);
#pragma unroll
          for (int e = 0; e < 8; ++e) own[8 + e] = t8[e]; }
        float ss = 0.f;
#pragma unroll
        for (int e = 0; e < 16; ++e) { const float oth = __shfl_xor(own[e], 8); const float o1 = comp ? oth : own[e], o2 = comp ? own[e] : oth; d[e] = o1 - lam * o2; ss += d[e] * d[e]; }
        ss += __shfl_xor(ss, 1); ss += __shfl_xor(ss, 2); ss += __shfl_xor(ss, 4);
        const float rstd = (1.0f - lam_init) / sqrtf(ss * (1.f / 128.f) + EPS);
        if (comp == 0) { float o8[8]; GAS v4u* yp = (GAS v4u*)(Y + (size_t)m * D + 512 + 128 * h + i0);
#pragma unroll
            for (int e = 0; e < 8; ++e) o8[e] = d[e] * rstd * gg[e];
            yp[0] = pack8(o8);
#pragma unroll
            for (int e = 0; e < 8; ++e) o8[e] = d[8 + e] * rstd * gg[8 + e];
            yp[1] = pack8(o8); }
    }
}
__device__ __forceinline__ void ph12_post1(Frame& F) {
    const int gw = F.vcu * NWAVES + F.wave, NGW = F.G * NWAVES, lane = F.lane; bf16* P1 = (bf16*)(F.ws + WS_P1);
    for (int m = gw; m < MR; m += NGW) {
        GAS v4u* rowp = (GAS v4u*)(P1 + (size_t)m * O_IN) + lane;
        const v4u u0 = rowp[0], u1 = rowp[64];
        const bool lat = m < ML; const int t = m & (SEQ - 1), prow = t >> 6, pcol = t & 63; float f[8];
        unpack8(u0, f); qknorm_rope(f, F.in[I_CQNG], lat, prow, pcol, QSCALE, lane); if (lat) rowp[0] = pack8(f);
        unpack8(u1, f); qknorm_rope(f, F.in[I_CKNG], lat, prow, pcol, 1.0f, lane); if (lane < 16) rowp[64] = pack8(f);
    }
}
__device__ __forceinline__ void lru_ab(float r, float ix, float sp8, float& a, float& b) {
    const float la = -r * sp8; a = __builtin_amdgcn_exp2f(la * 1.4426950408889634f); b = sqrtf(-expm1f(2.0f * la)) * ix;
}
__device__ __forceinline__ bool seq_start(int r) { return r < ML ? (r & (SEQ - 1)) == 0 : ((r - ML) & (CTXL - 1)) == 0; }
__device__ __forceinline__ void scan_prep_unit(Frame& F, int cid) {
    constexpr int XDS = 520;
    const int r0 = cid * 64, tid = F.tid, lane = F.lane, r32 = lane & 31, hi = lane >> 5;
    const bf16* P1 = (const bf16*)(F.ws + WS_P1); LAS bf16* XD = (LAS bf16*)(F.lds + RING_OFF);
    f16* PL = (f16*)(F.ws + WS_RI);
    { const int ch = tid; const float* cw = F.in[I_CONVW]; const float w0 = cw[ch], w1 = cw[512 + ch], w2 = cw[1024 + ch], w3 = cw[1536 + ch], cb = F.in[I_CONVB][ch];
      const bool st = seq_start(r0), en = seq_start(r0 + 64) || (r0 + 64 == MR);
      const bf16* xp = P1 + (size_t)r0 * O_IN + 1280 + ch;
      float xm2 = st ? 0.f : bf2f(xp[-2 * O_IN]), xm1 = st ? 0.f : bf2f(xp[-O_IN]), x0 = bf2f(xp[0]);
#pragma unroll 8
      for (int t = 0; t < 64; ++t) { const float xn = (t == 63) ? (en ? 0.f : bf2f(xp[(size_t)64 * O_IN])) : bf2f(xp[(size_t)(t + 1) * O_IN]);
          XD[t * XDS + ch] = f2bf16(w0 * xm2 + w1 * xm1 + w2 * x0 + w3 * xn + cb); xm2 = xm1; xm1 = x0; x0 = xn; } }
    __syncthreads();
    { const int n = F.wave; const bf16* WG = (const bf16*)(F.ws + WS_WG);
      bf16x8 afr[2][4];
#pragma unroll
      for (int mt = 0; mt < 2; ++mt)
#pragma unroll
          for (int ks = 0; ks < 4; ++ks) afr[mt][ks] = *(const LAS bf16x8*)(XD + (32 * mt + r32) * XDS + 64 * n + 16 * ks + 8 * hi);
#pragma unroll 1
      for (int ct = 0; ct < 8; ++ct) { const int d = ct >> 2, mat = (ct >> 1) & 1, half = ct & 1;
          f32x16 acc[2]; acc[0] = f32x16{}; acc[1] = f32x16{};
          const bf16* wp = WG + ((size_t)(((d * 2 + mat) * 8 + n) * 64 + 32 * half + r32)) * 64 + 8 * hi;
#pragma unroll
          for (int ks = 0; ks < 4; ++ks) { const bf16x8 bfr = *(const GAS bf16x8*)(wp + 16 * ks);
              acc[0] = __builtin_amdgcn_mfma_f32_32x32x16_bf16(afr[0][ks], bfr, acc[0], 0, 0, 0); acc[1] = __builtin_amdgcn_mfma_f32_32x32x16_bf16(afr[1][ks], bfr, acc[1], 0, 0, 0); }
          const int ch = 64 * n + 32 * half + r32; const float bias = (mat ? F.in[I_DBX] : F.in[I_DBA])[d * 512 + ch];
          f16* pl = PL + (size_t)(mat * 2 + d) * MR * 512 + (size_t)r0 * 512 + ch;
#pragma unroll
          for (int mt = 0; mt < 2; ++mt)
#pragma unroll
              for (int r = 0; r < 16; ++r) { const int row = 32 * mt + crow16(r, hi); float s = sigmoid_f(acc[mt][r] + bias); if (mat) s *= bf2f(XD[row * XDS + ch]); pl[(size_t)row * 512] = (f16)s; }
      } }
    VM_WAIT(); __syncthreads();
    { const int ch = tid; float* AGG = (float*)(F.ws + WS_AGG);
#pragma unroll
      for (int d = 0; d < 2; ++d) { const float lam = F.in[I_DLAM][d * 512 + ch]; const float sp8 = 8.0f * log1pf(expf(-lam));
          const f16* pr = PL + (size_t)d * MR * 512 + (size_t)r0 * 512 + ch; const f16* pi = PL + (size_t)(2 + d) * MR * 512 + (size_t)r0 * 512 + ch;
          float A = 1.f, h = 0.f;
#pragma unroll 8
          for (int tt = 0; tt < 64; ++tt) { const int t = d ? 63 - tt : tt; float a, b; lru_ab((float)pr[(size_t)t * 512], (float)pi[(size_t)t * 512], sp8, a, b); h = a * h + b; A *= a; }
          AGG[((size_t)(d * NCHUNK + cid) * 2 + 0) * 512 + ch] = A; AGG[((size_t)(d * NCHUNK + cid) * 2 + 1) * 512 + ch] = h; } }
    __syncthreads();
}
__device__ __forceinline__ void scan_fix_unit(Frame& F, int cid) {
    const int ch = F.tid, b = cid >> 7, j = cid & 127, r0 = cid * 64;
    const float* AGG = (const float*)(F.ws + WS_AGG); const f16* PL = (const f16*)(F.ws + WS_RI); const bf16* P1 = (const bf16*)(F.ws + WS_P1); bf16* Y = (bf16*)(F.ws + WS_Y);
    LAS float* HF = (LAS float*)(F.lds + RING_OFF);
    const float* A0 = AGG + ch; const float* A1 = AGG + (size_t)NCHUNK * 1024 + ch;
    float hf = 0.f, hb = 0.f;
#pragma unroll
    for (int q = 0; q < 4; ++q) { const int c = 256 + 4 * b + q; hf = A0[(size_t)c * 1024] * hf + A0[(size_t)c * 1024 + 512]; }
#pragma unroll 8
    for (int q = 0; q < j; ++q) { const int c = 128 * b + q; hf = A0[(size_t)c * 1024] * hf + A0[(size_t)c * 1024 + 512]; }
#pragma unroll
    for (int q = 3; q >= 0; --q) { const int c = 256 + 4 * b + q; hb = A1[(size_t)c * 1024] * hb + A1[(size_t)c * 1024 + 512]; }
#pragma unroll 8
    for (int q = 127; q > j; --q) { const int c = 128 * b + q; hb = A1[(size_t)c * 1024] * hb + A1[(size_t)c * 1024 + 512]; }
    const float sp0 = 8.0f * log1pf(expf(-F.in[I_DLAM][ch])), sp1 = 8.0f * log1pf(expf(-F.in[I_DLAM][512 + ch]));
    { const f16* pr = PL + (size_t)r0 * 512 + ch; const f16* pi = PL + (size_t)2 * MR * 512 + (size_t)r0 * 512 + ch;
#pragma unroll 8
      for (int t = 0; t < 64; ++t) { float a, bb; lru_ab((float)pr[(size_t)t * 512], (float)pi[(size_t)t * 512], sp0, a, bb); hf = a * hf + bb; HF[t * 512 + ch] = hf; } }
    { const f16* pr = PL + (size_t)MR * 512 + (size_t)r0 * 512 + ch; const f16* pi = PL + (size_t)3 * MR * 512 + (size_t)r0 * 512 + ch;
#pragma unroll 8
      for (int t = 63; t >= 0; --t) { float a, bb; lru_ab((float)pr[(size_t)t * 512], (float)pi[(size_t)t * 512], sp1, a, bb); hb = a * hb + bb;
          const float gt = bf2f(P1[(size_t)(r0 + t) * O_IN + 768 + ch]); Y[(size_t)(r0 + t) * D + 512 + ch] = f2bf16((HF[t * 512 + ch] + hb) * gelu_tanh(gt)); } }
    LDS_WAIT(); __syncthreads();
}
__device__ __forceinline__ void ph15_router(Frame& F) {
    LAS float* WR = (LAS float*)(F.lds + RING_OFF);
    LAS int* lcnt = (LAS int*)(F.lds + RING_OFF + 32768); LAS int* lbase = lcnt + 8; LAS int* rec = lcnt + 16;
    const int lane = F.lane; const float* MOD = (const float*)(F.ws + WS_MOD) + (size_t)3 * 6 * D; bf16* XN = (bf16*)(F.ws + WS_XN); int* TOK = (int*)(F.ws + WS_TOK);
    for (int i = F.tid; i < 1024 * 8 / 4; i += NWAVES * 64) ((LAS f32x4*)WR)[i] = ((const GAS f32x4*)F.in[I_RW])[i];
    __syncthreads();
    for (int rb = F.vcu; rb < ML / 64; rb += F.G) {
        if (F.tid < 8) lcnt[F.tid] = 0;
        __syncthreads();
#pragma unroll 1
        for (int i = 0; i < 8; ++i) { const int m = rb * 64 + F.wave * 8 + i, s = m >> 13; f32x4 t[4];
            normmod_row(F.out + (size_t)m * D, F.in[I_NFFNG] + D, MOD + s * 6 * D + 4 * D, MOD + s * 6 * D + 3 * D, XN + (size_t)m * D, lane, t);
            float lg[8];
#pragma unroll
            for (int e = 0; e < 8; ++e) lg[e] = 0.f;
#pragma unroll
            for (int j = 0; j < 4; ++j)
#pragma unroll
                for (int k = 0; k < 4; ++k) { const int c = 4 * lane + 256 * j + k; const f32x4 w0 = *(const LAS f32x4*)(WR + c * 8), w1 = *(const LAS f32x4*)(WR + c * 8 + 4); const float tv = t[j][k];
                    lg[0] += tv * w0.x; lg[1] += tv * w0.y; lg[2] += tv * w0.z; lg[3] += tv * w0.w; lg[4] += tv * w1.x; lg[5] += tv * w1.y; lg[6] += tv * w1.z; lg[7] += tv * w1.w; }
#pragma unroll
            for (int e = 0; e < 8; ++e) lg[e] = wave_sum(lg[e]) + F.in[I_RB][e];
            int e1 = 0; float v1 = lg[0];
#pragma unroll
            for (int e = 1; e < 8; ++e) if (lg[e] > v1) { v1 = lg[e]; e1 = e; }
            int e2 = -1; float v2 = -INFINITY;
#pragma unroll
            for (int e = 0; e < 8; ++e) if (e != e1 && lg[e] > v2) { v2 = lg[e]; e2 = e; }
            const float g1 = 1.0f / (1.0f + expf(v2 - v1)), g2 = 1.0f - g1;
            if (lane == 0) { LAS int* rc = rec + (F.wave * 8 + i) * 6; rc[0] = e1; rc[1] = e2; rc[2] = atomicAdd((int*)(lcnt + e1), 1); rc[3] = atomicAdd((int*)(lcnt + e2), 1); rc[4] = __float_as_int(g1); rc[5] = __float_as_int(g2); }
        }
        __syncthreads();
        if (F.tid < 8) lbase[F.tid] = (int)__hip_atomic_fetch_add((unsigned*)(F.ctl + CW_CNT + 64 * F.tid), (unsigned)lcnt[F.tid], __ATOMIC_RELAXED, __HIP_MEMORY_SCOPE_AGENT);
        __syncthreads();
        if (F.tid < 64) { const LAS int* rc = rec + F.tid * 6; int* tk = TOK + (size_t)(rb * 64 + F.tid) * 6;
            tk[0] = rc[0]; tk[1] = rc[1]; tk[2] = lbase[rc[0]] + rc[2]; tk[3] = lbase[rc[1]] + rc[3]; tk[4] = rc[4]; tk[5] = rc[5]; }
        __syncthreads();
    }
}
__device__ __forceinline__ void moe_offsets(Frame& F, int (&off)[9]) {
    int o = 0;
#pragma unroll
    for (int e = 0; e < 8; ++e) { off[e] = o; const int c = (int)__hip_atomic_load((unsigned*)(F.ctl + CW_CNT + 64 * e), __ATOMIC_RELAXED, __HIP_MEMORY_SCOPE_AGENT); o += (c + 255) & ~255; }
    off[8] = o;
}
__device__ __forceinline__ void ph16_gather(Frame& F) {
    int off[9]; moe_offsets(F, off);
    const int gw = F.vcu * NWAVES + F.wave, NGW = F.G * NWAVES, lane = F.lane; const bf16* XN = (const bf16*)(F.ws + WS_XN); bf16* XG = (bf16*)(F.ws + WS_XG); const int* TOK = (const int*)(F.ws + WS_TOK);
    for (int p = gw; p < 2 * ML; p += NGW) { const int tok = p >> 1, k = p & 1; const int e = TOK[(size_t)tok * 6 + k], pos = TOK[(size_t)tok * 6 + 2 + k];
        int base = 0;
#pragma unroll
        for (int q = 0; q < 8; ++q) base = (e == q) ? off[q] : base;
        const GAS v4u* src = (const GAS v4u*)(XN + (size_t)tok * D) + lane; GAS v4u* dst = (GAS v4u*)(XG + (size_t)(base + pos) * D) + lane;
        const v4u a = src[0], b = src[64]; dst[0] = a; dst[64] = b; }
}
__device__ __forceinline__ int moe_tables(Frame& F) {
    int off[9]; moe_offsets(F, off); LAS int* pexp = (LAS int*)(F.lds + PEXP_OFF);
    if (F.tid < MOE_PAN) { const int r = F.tid * 256; int e = 0;
#pragma unroll
        for (int q = 1; q < 8; ++q) e = (r >= off[q]) ? q : e;
        pexp[F.tid] = e; }
    __syncthreads();
    return off[8] / 256;
}
__device__ __forceinline__ void ph19_combine(Frame& F) {
    int off[9]; moe_offsets(F, off);
    const int gw = F.vcu * NWAVES + F.wave, NGW = F.G * NWAVES, lane = F.lane; const bf16* YG = (const bf16*)(F.ws + WS_YG); const int* TOK = (const int*)(F.ws + WS_TOK);
    const float* MOD = (const float*)(F.ws + WS_MOD) + (size_t)3 * 6 * D;
    for (int m = gw; m < ML; m += NGW) { const int* tk = TOK + (size_t)m * 6; const int e1 = tk[0], e2 = tk[1]; int b1 = 0, b2 = 0;
#pragma unroll
        for (int q = 0; q < 8; ++q) { b1 = (e1 == q) ? off[q] : b1; b2 = (e2 == q) ? off[q] : b2; }
        const float g1 = __int_as_float(tk[4]), g2 = __int_as_float(tk[5]); const float* gp = MOD + (m >> 13) * 6 * D + 5 * D;
        const GAS v2u* y1 = (const GAS v2u*)(YG + (size_t)(b1 + tk[2]) * D) + lane; const GAS v2u* y2 = (const GAS v2u*)(YG + (size_t)(b2 + tk[3]) * D) + lane;
        GAS f32x4* o = (GAS f32x4*)(F.out + (size_t)m * D) + lane;
#pragma unroll
        for (int j = 0; j < 4; ++j) { const v2u a = y1[64 * j], b = y2[64 * j]; const f32x4 gv = ((const GAS f32x4*)gp)[lane + 64 * j]; f32x4 x = o[64 * j];
            x.x += gv.x * (g1 * bf_lo(a.x) + g2 * bf_lo(b.x)); x.y += gv.y * (g1 * bf_hi(a.x) + g2 * bf_hi(b.x)); x.z += gv.z * (g1 * bf_lo(a.y) + g2 * bf_lo(b.y)); x.w += gv.w * (g1 * bf_hi(a.y) + g2 * bf_hi(b.y));
            o[64 * j] = x; } }
}
struct Args { const float* in[38]; float* out; unsigned char* ws; int ph_lo, ph_hi; };
__global__ void __launch_bounds__(NWAVES * 64, 2) mk_fwd(Args args) {
    extern __shared__ __attribute__((aligned(16))) unsigned char lds[];
    Frame F;
    F.lds = (LAS unsigned char*)lds;
    F.MISC = (volatile LAS unsigned*)(F.lds + MISC_OFF);
    F.tid = threadIdx.x; F.lane = F.tid & 63; F.wave = __builtin_amdgcn_readfirstlane(F.tid >> 6);
    F.G = gridDim.x; { const int bx = blockIdx.x; F.vcu = (F.G % 8 == 0) ? (bx % 8) * (F.G / 8) + bx / 8 : bx; }
    F.ws = args.ws; F.out = args.out; F.ctl = (gu32*)(args.ws + WS_CTL);
#pragma unroll
    for (int i = 0; i < 38; ++i) F.in[i] = args.in[i];
    for (int u = F.tid; u < (LDS_BYTES - LDSCTL_OFF) / 4; u += NWAVES * 64) ((LAS unsigned*)(F.lds + LDSCTL_OFF))[u] = 0u;
    __syncthreads();
    XcdBarrier bar; bar.bar = (unsigned*)(F.ctl + CW_BAR); bar.x = 0; bar.st = nullptr;
    if (MK_ONE_LAUNCH) bar = xcd_barrier_post((unsigned*)(F.ctl + CW_BAR), F.MISC + 8);
#define GRID_BAR() do { if (MK_ONE_LAUNCH) xcd_barrier(bar); } while (0)
    const int lo = args.ph_lo, hi = args.ph_hi;
#define IN(k) (lo <= (k) && (k) < hi)
#define BOTH(k) (IN(k) && IN((k) + 1))
    unsigned char* ws = args.ws;
    bf16* XN = (bf16*)(ws + WS_XN); bf16* Y = (bf16*)(ws + WS_Y); bf16* P0 = (bf16*)(ws + WS_P0); bf16* P1 = (bf16*)(ws + WS_P1); bf16* OA = (bf16*)(ws + WS_OATT); bf16* Hb = (bf16*)(ws + WS_H);
    float* XR = (float*)(ws + WS_XR); const float* MOD = (const float*)(ws + WS_MOD);
    using ABF = attn_body::bf16;

    if (IN(0)) { ph0_prologue(F); if (BOTH(0)) GRID_BAR(); }
    if (IN(1)) { ph_normmod(F, F.in[I_X], F.in[I_CTX], MR, F.in[I_NMIXG], 0, 0, D); if (BOTH(1)) GRID_BAR(); }
    if (IN(2)) {
        pg8::Gemm g{XN, (const bf16*)(ws + WS_WE), MR, E_IN, D}; pg8::StaticOrder S; S.init(MR, E_IN, F.G, (int)blockIdx.x);
        pg8::EpiBf16<0> E{P0, E_IN, nullptr, 0, 0, 1.f};
        pg8::gemm_phase<pg8::EpiBf16<0>, pg8::StaticOrder, PG8_ALIGN, PG8_SP2>(F.lds + RING_OFF, g, S, E);
        if (BOTH(2)) GRID_BAR();
    }
    if (IN(3)) { ph3_post0(F); if (BOTH(3)) GRID_BAR(); }
    if (IN(4)) {
        for (int i = 0;; ++i) { const int L = i * F.G + F.vcu; if (L >= 1024 + 32) break;
            const bool lat = L < 1024; const int bh = lat ? (L >> 5) : (L - 1024), qb = lat ? (L & 31) : 0, b = bh >> 4, vh = bh & 15, h = vh >> 2, hq = vh >> 1, vhalf = vh & 1;
            const size_t crow0 = (size_t)(ML + b * CTXL), lrow0 = (size_t)b * SEQ, qrow0 = lat ? lrow0 + (size_t)qb * 256 : crow0;
            attn_body::attn_unit<8>((const ABF*)(P0 + qrow0 * E_IN + 1024 + 64 * hq), E_IN,
                                    (const ABF*)(P0 + crow0 * E_IN + 1536 + 64 * hq), (const ABF*)(P0 + lrow0 * E_IN + 1536 + 64 * hq), E_IN,
                                    (const ABF*)(P0 + crow0 * E_IN + 2048 + 128 * h + 64 * vhalf), (const ABF*)(P0 + lrow0 * E_IN + 2048 + 128 * h + 64 * vhalf), E_IN,
                                    (ABF*)(OA + qrow0 * D + 64 * vh), D, lat ? 132 : 4, 4, (char*)lds + RING_OFF); }
        for (int c = F.vcu - 32; c >= 0 && c < MR / 128; c += F.G) gmlp_unit(F, c);
        if (BOTH(4)) GRID_BAR();
    }
    if (IN(5)) { ph5_diffout(F); if (BOTH(5)) GRID_BAR(); }
    if (IN(6)) {
        pg8::Gemm g{Y, (const bf16*)(ws + WS_WO0), MR, D, D}; pg8::StaticOrder S; S.init(MR, D, F.G, (int)blockIdx.x);
        pg8::EpiResGate E{F.in[I_X], F.in[I_CTX], XR, MOD + 2 * D};
        pg8::gemm_phase<pg8::EpiResGate, pg8::StaticOrder, PG8_ALIGN, PG8_SP2>(F.lds + RING_OFF, g, S, E);
        if (BOTH(6)) GRID_BAR();
    }
    if (IN(7)) { ph_normmod(F, XR, XR + (size_t)ML * D, MR, F.in[I_NFFNG], 0, 3 * D, 4 * D); if (BOTH(7)) GRID_BAR(); }
    if (IN(8)) {
        pg8::Gemm g{XN, (const bf16*)(ws + WS_WF13), MR, FF2, D}; pg8::StaticOrder S; S.init(MR, FF2, F.G, (int)blockIdx.x);
        pg8::EpiSwiGLU E{Hb, FF, FF2 / 256};
        pg8::gemm_phase<pg8::EpiSwiGLU, pg8::StaticOrder, PG8_ALIGN, PG8_SP2>(F.lds + RING_OFF, g, S, E);
        if (BOTH(8)) GRID_BAR();
    }
    if (IN(9)) {
        pg8::Gemm g{Hb, (const bf16*)(ws + WS_WF2), MR, D, FF}; pg8::StaticOrder S; S.init(MR, D, F.G, (int)blockIdx.x);
        pg8::EpiResGate E{XR, XR + (size_t)ML * D, XR, MOD + 5 * D};
        pg8::gemm_phase<pg8::EpiResGate, pg8::StaticOrder, PG8_ALIGN, PG8_SP2>(F.lds + RING_OFF, g, S, E);
        if (BOTH(9)) GRID_BAR();
    }
    if (IN(10)) { ph_normmod(F, XR, XR + (size_t)ML * D, MR, F.in[I_NMIXG] + D, 1, 0, D); if (BOTH(10)) GRID_BAR(); }
    if (IN(11)) {
        pg8::Gemm g{XN, (const bf16*)(ws + WS_WOI), MR, O_IN, D}; pg8::StaticOrder S; S.init(MR, O_IN, F.G, (int)blockIdx.x);
        pg8::EpiBf16<0> E{P1, O_IN, nullptr, 0, 0, 1.f};
        pg8::gemm_phase<pg8::EpiBf16<0>, pg8::StaticOrder, PG8_ALIGN, PG8_SP2>(F.lds + RING_OFF, g, S, E);
        if (BOTH(11)) GRID_BAR();
    }
    if (IN(12)) {
        ph12_post1(F);
        for (int c = F.vcu; c < NCHUNK; c += F.G) scan_prep_unit(F, c);
        if (BOTH(12)) GRID_BAR();
    }
    if (IN(13)) {
        for (int c = F.vcu; c < ML / 64; c += F.G) scan_fix_unit(F, c);
        for (int i = 0;; ++i) { const int L = i * F.G + F.vcu; if (L >= 512) break;
            const int bh = L >> 5, qb = L & 31, b = bh >> 3, hq = bh & 7, kv = hq >> 2;
            const size_t crow0 = (size_t)(ML + b * CTXL), lrow0 = (size_t)b * SEQ, qrow0 = lrow0 + (size_t)qb * 256;
            attn_body::attn_unit<8>((const ABF*)(P1 + qrow0 * O_IN + 64 * hq), O_IN,
                                    (const ABF*)(P1 + crow0 * O_IN + 512 + 64 * kv), (const ABF*)(P1 + lrow0 * O_IN + 512 + 64 * kv), O_IN,
                                    (const ABF*)(P1 + crow0 * O_IN + 640 + 64 * kv), (const ABF*)(P1 + lrow0 * O_IN + 640 + 64 * kv), O_IN,
                                    (ABF*)(Y + qrow0 * D + 64 * hq), D, 132, 4, (char*)lds + RING_OFF); }
        if (BOTH(13)) GRID_BAR();
    }
    if (IN(14)) {
        pg8::Gemm g{Y, (const bf16*)(ws + WS_WO1), ML, D, D}; pg8::StaticOrder S; S.init(ML, D, F.G, (int)blockIdx.x);
        pg8::EpiResGate E{XR, XR, F.out, MOD + 3 * 6 * D + 2 * D};
        pg8::gemm_phase<pg8::EpiResGate, pg8::StaticOrder, PG8_ALIGN, PG8_SP2>(F.lds + RING_OFF, g, S, E);
        if (BOTH(14)) GRID_BAR();
    }
    if (IN(15)) { ph15_router(F); if (BOTH(15)) GRID_BAR(); }
    if (IN(16)) { ph16_gather(F); if (BOTH(16)) GRID_BAR(); }
    if (IN(17)) {
        const int npan = moe_tables(F);
        pg8::Gemm g{(const bf16*)(ws + WS_XG), (const bf16*)(ws + WS_WM13), MOE_ROWS, NEXP * FF2, D}; pg8::MoeOrder S{npan, FF2 / 256, F.G, F.vcu, (const LAS int*)(F.lds + PEXP_OFF)};
        pg8::EpiSwiGLU E{(bf16*)(ws + WS_HG), FF, FF2 / 256};
        pg8::gemm_phase<pg8::EpiSwiGLU, pg8::MoeOrder, PG8_ALIGN, PG8_SP2>(F.lds + RING_OFF, g, S, E);
        if (BOTH(17)) GRID_BAR();
    }
    if (IN(18)) {
        const int npan = moe_tables(F);
        pg8::Gemm g{(const bf16*)(ws + WS_HG), (const bf16*)(ws + WS_WM2), MOE_ROWS, NEXP * D, FF}; pg8::MoeOrder S{npan, D / 256, F.G, F.vcu, (const LAS int*)(F.lds + PEXP_OFF)};
        pg8::EpiBf16<0> E{(bf16*)(ws + WS_YG), D, nullptr, D, 0, 1.f};
        pg8::gemm_phase<pg8::EpiBf16<0>, pg8::MoeOrder, PG8_ALIGN, PG8_SP2>(F.lds + RING_OFF, g, S, E);
        if (BOTH(18)) GRID_BAR();
    }
    if (IN(19)) { ph19_combine(F); }
#undef IN
#undef BOTH
#undef GRID_BAR
}

extern "C" void kernel_launch(void* const* d_in, const int* in_sizes, int n_in, void* d_out, int out_size, void* d_ws, size_t ws_size, hipStream_t stream) {
    static int grid = 0;
    if (grid == 0) {
        if (n_in != 38 || in_sizes[0] != ML * D || out_size != ML * D || ws_size < WS_END) { fprintf(stderr, "kernel_launch: built for 38 inputs, x/out of %d floats, >= %zu bytes of workspace; got n_in %d, in0 %d, out %d, ws %zu; nothing launched\n", ML * D, (size_t)WS_END, n_in, n_in > 0 ? in_sizes[0] : -1, out_size, ws_size); grid = -1; return; }
        int dev = 0, cus = 0, per_cu = 0;
        if (hipGetDevice(&dev) != hipSuccess || hipDeviceGetAttribute(&cus, hipDeviceAttributeMultiprocessorCount, dev) != hipSuccess) { fprintf(stderr, "kernel_launch: device query failed\n"); grid = -1; return; }
        if (hipFuncSetAttribute((const void*)mk_fwd, hipFuncAttributeMaxDynamicSharedMemorySize, LDS_BYTES) != hipSuccess) { fprintf(stderr, "kernel_launch: hipFuncSetAttribute failed\n"); grid = -1; return; }
        if (hipOccupancyMaxActiveBlocksPerMultiprocessor(&per_cu, (const void*)mk_fwd, NWAVES * 64, LDS_BYTES) != hipSuccess || per_cu < 1) fprintf(stderr, "kernel_launch: note: occupancy query reports %d workgroups per CU\n", per_cu);
        (void)hipGetLastError();
        grid = cus;
    }
    if (grid < 0) return;
    if (hipMemsetAsync((char*)d_ws + WS_CTL, 0, CTL_ZERO_BYTES, stream) != hipSuccess) { fprintf(stderr, "kernel_launch: hipMemsetAsync failed\n"); return; }
    Args a{};
    for (int i = 0; i < 38; ++i) a.in[i] = (const float*)d_in[i];
    a.out = (float*)d_out; a.ws = (unsigned char*)d_ws;
#if MK_ONE_LAUNCH
    a.ph_lo = 0; a.ph_hi = NPH;
    hipLaunchKernelGGL(mk_fwd, dim3(grid), dim3(NWAVES * 64), LDS_BYTES, stream, a);
#else
    for (int ph = 0; ph < NPH; ++ph) { a.ph_lo = ph; a.ph_hi = ph + 1; hipLaunchKernelGGL(mk_fwd, dim3(grid), dim3(NWAVES * 64), LDS_BYTES, stream, a); }
#endif
    const hipError_t le = hipPeekAtLastError();
    if (le != hipSuccess) fprintf(stderr, "kernel_launch: launch failed: %s\n", hipGetErrorName(le));
}
```

```cpp
#include <hip/hip_runtime.h>
#include <cstdio>
#include <cstdint>
#include <cmath>
namespace pg8 {
#define PG8_LAS __attribute__((address_space(3)))
typedef unsigned short bf16_t;
typedef short bf16x8 __attribute__((ext_vector_type(8)));
typedef float f32x4 __attribute__((ext_vector_type(4)));
typedef unsigned u32x4 __attribute__((ext_vector_type(4)));
constexpr int BM = 256, BK = 64, HALF = 128, HTB = HALF * BK * 2  , STAGE_BYTES = 8 * HTB, NXCD = 8, WGM = 8;

__host__ __device__ __forceinline__ int lds_byte(int r, int c) { const int st = (r >> 4) * 2 + (c >> 5), rr = r & 15, cc = c & 31, ob = rr * 64 + cc * 2; return st * 1024 + (ob ^ (((ob >> 9) & 1) << 5)); }
__host__ __device__ __forceinline__ void stage_rc(int b, int& R, int& C) { const int st = b / 1024, sb = b % 1024, swz = sb ^ (((sb >> 9) & 1) << 5); R = (st >> 1) * 16 + swz / 64; C = (st & 1) * 32 + (swz % 64) / 2; }
__host__ __device__ __forceinline__ int perm32(int rho) { const int n = rho >> 4, i = rho & 15; return 8 * (i >> 2) + 4 * n + (i & 3); }

struct Unit { int pm, pn; };
struct Gemm { const bf16_t* A; const bf16_t* Bt; int M, N, K; };

struct StaticOrder {
    int nM, nN, nwg, G, c;
    __host__ __device__ void init(int M, int N, int G_, int c_) { nM = M / BM; nN = N / BM; nwg = nM * nN; G = G_; c = c_; }
    __host__ __device__ bool next(int i, Unit& u) const {
        const long L = (long)i * G + c; if (L >= nwg) return false;
        int wgid = (int)L; { const int q = nwg / NXCD, r = nwg % NXCD, xcd = wgid % NXCD, off = wgid / NXCD; wgid = (xcd < r ? xcd * (q + 1) : r * (q + 1) + (xcd - r) * q) + off; }
        const int nig = WGM * nN, gid = wgid / nig, fm = gid * WGM, gsz = (nM - fm) < WGM ? (nM - fm) : WGM;
        u.pm = fm + ((wgid % nig) % gsz); u.pn = (wgid % nig) / gsz; return true;
    }
    __device__ __forceinline__ void a_ready(const Unit&) const {}
    __device__ __forceinline__ void done(const Unit&) const {}
};

__device__ __forceinline__ unsigned cvt_pk_bf16(float lo, float hi) { unsigned r; asm volatile("v_cvt_pk_bf16_f32 %0, %1, %2" : "=v"(r) : "v"(lo), "v"(hi)); return r; }
typedef float f32x2 __attribute__((ext_vector_type(2)));
__device__ __forceinline__ f32x2 gelu_pk(f32x2 v) {
    const f32x2 av = __builtin_elementwise_abs(v), d = av * 0.2316418882f + 1.0f;
    f32x2 t; t.x = __builtin_amdgcn_rcpf(d.x); t.y = __builtin_amdgcn_rcpf(d.y);
    f32x2 q = t * 0.5307027145f + (-0.7265760135f); q = q * t + 0.7107068705f; q = q * t + (-0.142248368f); q = q * t + 0.127414796f; q = q * t;
    const f32x2 s = (v * v) * (-0.72134752044f);
    f32x2 e; e.x = __builtin_amdgcn_exp2f(s.x); e.y = __builtin_amdgcn_exp2f(s.y);
    const f32x2 m = v * (q * e), r = v - m;
    f32x2 o; o.x = v.x < 0.f ? m.x : r.x; o.y = v.y < 0.f ? m.y : r.y; return o;
}

template <int ACT  > struct EpiBf16 {
    static constexpr bool PERM = true, AFTER_DRAIN = false; static_assert(ACT == 0 || ACT == 1, "EpiBf16: ACT is 0 (none) or 1 (gelu_pk)");
    bf16_t* O; int ldc; const float* bias; int split_cols; size_t split_stride; float scale0;
    __device__ __forceinline__ void operator()(const f32x4 (&acc)[2][2][4][2], const Unit& u, int wr, int wc, int fr, int fq) const {
        const int row0 = u.pm * BM + wr * 64 + fr; int colt = u.pn * BM; bf16_t* base = O;
        float sc = 1.f; if (split_cols) { const int t = colt / split_cols; base += (size_t)t * split_stride; colt -= t * split_cols; if (t == 0) sc = scale0; }
        const int col0 = colt + wc * 32 + 8 * fq, bcol0 = u.pn * BM + wc * 32 + 8 * fq;
        f32x4 bv[2][2];
#pragma unroll
        for (int bj = 0; bj < 2; ++bj)
#pragma unroll
            for (int n = 0; n < 2; ++n) bv[bj][n] = bias ? *(const f32x4*)(bias + bcol0 + bj * HALF + 4 * n) : (f32x4){0.f, 0.f, 0.f, 0.f};
#pragma unroll
        for (int ai = 0; ai < 2; ++ai)
#pragma unroll
            for (int m = 0; m < 4; ++m) { bf16_t* rowp = base + (size_t)(row0 + ai * HALF + m * 16) * ldc + col0;
#pragma unroll
                for (int bj = 0; bj < 2; ++bj) { f32x4 v0 = acc[ai][bj][m][0] + bv[bj][0], v1 = acc[ai][bj][m][1] + bv[bj][1];
                    if (ACT == 1) { f32x2 a = gelu_pk((f32x2){v0[0], v0[1]}), b = gelu_pk((f32x2){v0[2], v0[3]}), c = gelu_pk((f32x2){v1[0], v1[1]}), d = gelu_pk((f32x2){v1[2], v1[3]});
                        v0 = (f32x4){a.x, a.y, b.x, b.y}; v1 = (f32x4){c.x, c.y, d.x, d.y}; }
                    v0 = v0 * sc; v1 = v1 * sc; u32x4 w; w.x = cvt_pk_bf16(v0[0], v0[1]); w.y = cvt_pk_bf16(v0[2], v0[3]); w.z = cvt_pk_bf16(v1[0], v1[1]); w.w = cvt_pk_bf16(v1[2], v1[3]);
                    *(u32x4*)(rowp + bj * HALF) = w; } }
    }
};
struct EpiResGate {
    static constexpr bool PERM = false, AFTER_DRAIN = false;
    const float* baseL; const float* baseC; float* out; const float* gate;
    __device__ __forceinline__ void operator()(const f32x4 (&acc)[2][2][4][2], const Unit& u, int wr, int wc, int fr, int fq) const {
        const int s = u.pm < 32 ? 0 : (u.pm < 64 ? 1 : 2);
        const float* gp = gate + s * 6144;
        const float* base = u.pm < 64 ? baseL + (size_t)u.pm * BM * 1024 : baseC + (size_t)(u.pm - 64) * BM * 1024;
        float* o = out + (size_t)u.pm * BM * 1024;
        const int col0 = u.pn * BM + wc * 32 + 4 * fq;
        f32x4 gv[2][2];
#pragma unroll
        for (int bj = 0; bj < 2; ++bj)
#pragma unroll
            for (int n = 0; n < 2; ++n) gv[bj][n] = *(const f32x4*)(gp + col0 + bj * HALF + n * 16);
#pragma unroll
        for (int ai = 0; ai < 2; ++ai)
#pragma unroll
            for (int m = 0; m < 4; ++m) { const size_t off = (size_t)(ai * HALF + wr * 64 + m * 16 + fr) * 1024 + col0;
#pragma unroll
                for (int bj = 0; bj < 2; ++bj)
#pragma unroll
                    for (int n = 0; n < 2; ++n) { const f32x4 bs = *(const f32x4*)(base + off + bj * HALF + n * 16); *(f32x4*)(o + off + bj * HALF + n * 16) = bs + gv[bj][n] * acc[ai][bj][m][n]; }
                if (m & 1) asm volatile("" ::: "memory"); }
    }
};
struct EpiSwiGLU {
    static constexpr bool PERM = true, AFTER_DRAIN = false;
    bf16_t* H; int ldh; int ntl;
    __device__ __forceinline__ void operator()(const f32x4 (&acc)[2][2][4][2], const Unit& u, int wr, int wc, int fr, int fq) const {
        const int row0 = u.pm * BM + wr * 64 + fr; const int ct = u.pn % ntl; const int col0 = ct * HALF + wc * 32 + 8 * fq;
#pragma unroll
        for (int ai = 0; ai < 2; ++ai)
#pragma unroll
            for (int m = 0; m < 4; ++m) { bf16_t* rowp = H + (size_t)(row0 + ai * HALF + m * 16) * ldh + col0;
                float hv[8];
#pragma unroll
                for (int n = 0; n < 2; ++n)
#pragma unroll
                    for (int j = 0; j < 4; ++j) { const float a = acc[ai][0][m][n][j], b = acc[ai][1][m][n][j];
                        const float e = __builtin_amdgcn_exp2f(a * -1.4426950408889634f); hv[n * 4 + j] = a * __builtin_amdgcn_rcpf(1.0f + e) * b; }
                u32x4 w; w.x = cvt_pk_bf16(hv[0], hv[1]); w.y = cvt_pk_bf16(hv[2], hv[3]); w.z = cvt_pk_bf16(hv[4], hv[5]); w.w = cvt_pk_bf16(hv[6], hv[7]);
                *(u32x4*)rowp = w; }
    }
};
struct MoeOrder {
    int npan, ntl, G, c; const PG8_LAS int* pexp;
    __device__ __forceinline__ bool next(int i, Unit& u) const {
        const long L = (long)i * G + c; if (L >= (long)npan * ntl) return false;
        const int pm = (int)(L / ntl), j = (int)(L % ntl); u.pm = pm; u.pn = pexp[pm] * ntl + j; return true;
    }
    __device__ __forceinline__ void a_ready(const Unit&) const {}
    __device__ __forceinline__ void done(const Unit&) const {}
};
template <class Epi, class Sched, bool ALIGN_EPI = false, bool SP2 = false>
__device__ __forceinline__ void gemm_phase(PG8_LAS unsigned char* lds, const Gemm g, const Sched& S, const Epi& E) {
    const int tid = threadIdx.x, wid = __builtin_amdgcn_readfirstlane(tid >> 6), lane = tid & 63, wr = wid >> 2, wc = wid & 3, fr = lane & 15, fq = lane >> 4;
    const int K = g.K, nt = K / BK;
    unsigned voffA[2], voffB[2];
#pragma unroll
    for (int i = 0; i < 2; ++i) { int R, C; stage_rc(tid * 16 + i * 8192, R, C); const int Rb = Epi::PERM ? ((R & ~31) + perm32(R & 31)) : R;
        voffA[i] = (unsigned)(R * K + C) * 2u; voffB[i] = (unsigned)(Rb * K + C) * 2u; }
    const size_t kstep = (size_t)(BK * 2);
    const size_t hstep = (size_t)HALF * K * 2;
    const size_t tstep = 2 * hstep;
    const unsigned ldsw = (unsigned)wid * 1024u;
    const int aoff = lds_byte(wr * 64 + fr, fq * 8), boff = lds_byte(wc * 32 + fr, fq * 8);
#define PG8_SA(b, h) (((b) * 2 + (h)) * HTB)
#define PG8_SB(b, h) ((4 + (b) * 2 + (h)) * HTB)
#define PG8_STAGE(bufoff, gbase, voff) do { _Pragma("unroll") for (int _i = 0; _i < 2; ++_i) \
        __builtin_amdgcn_global_load_lds((const unsigned*)((const char*)(gbase) + (voff)[_i]), (PG8_LAS unsigned*)(lds + (bufoff) + ldsw + _i * 8192), 16, 0, 0); } while (0)
#define PG8_LDA(dst, b, h) do { _Pragma("unroll") for (int m = 0; m < 4; ++m) _Pragma("unroll") for (int k = 0; k < 2; ++k) dst[m][k] = *(const PG8_LAS bf16x8*)(lds + PG8_SA(b, h) + aoff + m * 2048 + k * 1024); } while (0)
#define PG8_LDB(dst, b, h) do { _Pragma("unroll") for (int n = 0; n < 2; ++n) _Pragma("unroll") for (int k = 0; k < 2; ++k) dst[n][k] = *(const PG8_LAS bf16x8*)(lds + PG8_SB(b, h) + boff + n * 2048 + k * 1024); } while (0)
#define PG8_MMA(ai, bj, At, Bt) do { __builtin_amdgcn_s_setprio(1); _Pragma("unroll") for (int m = 0; m < 4; ++m) _Pragma("unroll") for (int n = 0; n < 2; ++n) _Pragma("unroll") for (int k = 0; k < 2; ++k) \
        acc[ai][bj][m][n] = __builtin_amdgcn_mfma_f32_16x16x32_bf16(Bt[n][k], At[m][k], acc[ai][bj][m][n], 0, 0, 0); __builtin_amdgcn_s_setprio(0); } while (0)
#define PG8_WAIT_V(n) asm volatile("s_waitcnt vmcnt(" #n ")" ::: "memory")
#define PG8_WAIT_L(n) asm volatile("s_waitcnt lgkmcnt(" #n ")" ::: "memory")
#define PG8_BAR __builtin_amdgcn_s_barrier()
#define PG8_SCHED __builtin_amdgcn_sched_barrier(0)
    Unit cur, nxt; int ui = 0;
    if (!S.next(0, cur)) return;
    f32x4 acc[2][2][4][2];
#pragma unroll
    for (int a = 0; a < 2; ++a)
#pragma unroll
        for (int b = 0; b < 2; ++b)
#pragma unroll
            for (int m = 0; m < 4; ++m)
#pragma unroll
                for (int n = 0; n < 2; ++n) acc[a][b][m][n] = (f32x4){0.f, 0.f, 0.f, 0.f};
    bf16x8 At[4][2], B0[2][2], B1[2][2];
    const char* cA = (const char*)g.A + (size_t)cur.pm * tstep; const char* cB = (const char*)g.Bt + (size_t)cur.pn * tstep;
    S.a_ready(cur);
    if constexpr (SP2) {
        PG8_STAGE(PG8_SB(0, 0), cB, voffB); PG8_STAGE(PG8_SB(0, 1), cB + hstep, voffB); PG8_STAGE(PG8_SA(0, 0), cA, voffA); PG8_STAGE(PG8_SA(0, 1), cA + hstep, voffA);
        if (wr == 1) PG8_BAR;
        PG8_WAIT_V(2); PG8_BAR;
        PG8_STAGE(PG8_SB(1, 0), cB + kstep, voffB); PG8_STAGE(PG8_SA(1, 0), cA + kstep, voffA); PG8_STAGE(PG8_SB(1, 1), cB + hstep + kstep, voffB);
        PG8_WAIT_V(6); PG8_BAR;
    } else {
        PG8_STAGE(PG8_SB(0, 0), cB, voffB); PG8_STAGE(PG8_SA(0, 0), cA, voffA); PG8_STAGE(PG8_SB(0, 1), cB + hstep, voffB); PG8_STAGE(PG8_SA(0, 1), cA + hstep, voffA);
        if (wr == 1) PG8_BAR;
        PG8_WAIT_V(4); PG8_BAR;
        PG8_STAGE(PG8_SB(1, 0), cB + kstep, voffB); PG8_STAGE(PG8_SA(1, 0), cA + kstep, voffA); PG8_STAGE(PG8_SB(1, 1), cB + hstep + kstep, voffB);
        PG8_WAIT_V(6); PG8_BAR;
    }
    for (;;) {
        const bool has_next = S.next(ui + 1, nxt);
        const char* nA = has_next ? (const char*)g.A + (size_t)nxt.pm * tstep : cA; const char* nB = has_next ? (const char*)g.Bt + (size_t)nxt.pn * tstep : cB;
        for (int t = 0; t < nt; t += 2) {
            const bool last = (t == nt - 2);
            const char* a1 = cA + (size_t)(t + 1) * kstep;
            const char* a2 = last ? nA : cA + (size_t)(t + 2) * kstep; const char* b2 = last ? nB : cB + (size_t)(t + 2) * kstep;
            const char* a3 = a2 + kstep; const char* b3 = b2 + kstep;
            if (last && has_next) S.a_ready(nxt);
            if constexpr (SP2) {
            PG8_LDB(B0, 0, 0); PG8_LDB(B1, 0, 1); PG8_SCHED; PG8_LDA(At, 0, 0); PG8_STAGE(PG8_SA(1, 1), a1 + hstep, voffA);
            PG8_WAIT_V(8); PG8_WAIT_L(0); PG8_BAR; PG8_MMA(0, 0, At, B0); PG8_MMA(0, 1, At, B1); PG8_BAR; PG8_SCHED;
            PG8_LDA(At, 0, 1); PG8_STAGE(PG8_SB(0, 0), b2, voffB); PG8_STAGE(PG8_SB(0, 1), b2 + hstep, voffB); PG8_STAGE(PG8_SA(0, 0), a2, voffA);
            PG8_WAIT_V(8); PG8_WAIT_L(0); PG8_BAR; PG8_MMA(1, 0, At, B0); PG8_MMA(1, 1, At, B1); PG8_BAR; PG8_SCHED;
            PG8_LDB(B0, 1, 0); PG8_LDB(B1, 1, 1); PG8_SCHED; PG8_LDA(At, 1, 0); PG8_STAGE(PG8_SA(0, 1), a2 + hstep, voffA);
            PG8_WAIT_V(8); PG8_WAIT_L(0); PG8_BAR; PG8_MMA(0, 0, At, B0); PG8_MMA(0, 1, At, B1); PG8_BAR; PG8_SCHED;
            PG8_LDA(At, 1, 1); PG8_STAGE(PG8_SB(1, 0), b3, voffB); PG8_STAGE(PG8_SB(1, 1), b3 + hstep, voffB); PG8_STAGE(PG8_SA(1, 0), a3, voffA);
            PG8_WAIT_V(8); PG8_WAIT_L(0); PG8_BAR; PG8_MMA(1, 0, At, B0); PG8_MMA(1, 1, At, B1); PG8_BAR; PG8_SCHED;
            } else {
            PG8_LDB(B0, 0, 0); PG8_SCHED; PG8_LDA(At, 0, 0); PG8_STAGE(PG8_SA(1, 1), a1 + hstep, voffA);
            PG8_WAIT_L(8); PG8_BAR; PG8_WAIT_L(0); PG8_MMA(0, 0, At, B0); PG8_BAR; PG8_SCHED;
            PG8_LDB(B1, 0, 1); PG8_STAGE(PG8_SB(0, 0), b2, voffB);
            PG8_BAR; PG8_WAIT_L(0); PG8_MMA(0, 1, At, B1); PG8_BAR;
            PG8_LDA(At, 0, 1); PG8_STAGE(PG8_SA(0, 0), a2, voffA);
            PG8_BAR; PG8_WAIT_L(0); PG8_MMA(1, 0, At, B0); PG8_BAR; PG8_SCHED;
            PG8_STAGE(PG8_SB(0, 1), b2 + hstep, voffB);
            PG8_WAIT_V(6); PG8_BAR; PG8_MMA(1, 1, At, B1); PG8_BAR;
            PG8_LDB(B0, 1, 0); PG8_SCHED; PG8_LDA(At, 1, 0); PG8_STAGE(PG8_SA(0, 1), a2 + hstep, voffA);
            PG8_WAIT_L(8); PG8_BAR; PG8_WAIT_L(0); PG8_MMA(0, 0, At, B0); PG8_BAR; PG8_SCHED;
            PG8_LDB(B1, 1, 1); PG8_STAGE(PG8_SB(1, 0), b3, voffB);
            PG8_BAR; PG8_WAIT_L(0); PG8_MMA(0, 1, At, B1); PG8_BAR;
            PG8_LDA(At, 1, 1); PG8_STAGE(PG8_SA(1, 0), a3, voffA);
            PG8_BAR; PG8_WAIT_L(0); PG8_MMA(1, 0, At, B0); PG8_BAR; PG8_SCHED;
            PG8_STAGE(PG8_SB(1, 1), b3 + hstep, voffB);
            PG8_WAIT_V(6); PG8_BAR; PG8_MMA(1, 1, At, B1); PG8_BAR;
            }
        }
        if constexpr (ALIGN_EPI) { if (wr == 0) PG8_BAR; }
        if constexpr (!Epi::AFTER_DRAIN) { E(acc, cur, wr, wc, fr, fq); S.done(cur); }
        if (!has_next) break;
#pragma unroll
        for (int a = 0; a < 2; ++a)
#pragma unroll
            for (int b = 0; b < 2; ++b)
#pragma unroll
                for (int m = 0; m < 4; ++m)
#pragma unroll
                    for (int n = 0; n < 2; ++n) acc[a][b][m][n] = (f32x4){0.f, 0.f, 0.f, 0.f};
        cur = nxt; cA = nA; cB = nB; ++ui;
        if constexpr (ALIGN_EPI) { if (wr == 1) PG8_BAR; }
    }
    PG8_WAIT_V(0);
    if constexpr (!ALIGN_EPI) { if (wr == 0) PG8_BAR; }
    PG8_BAR;
    if constexpr (Epi::AFTER_DRAIN) { E.fused(acc, cur, wr, wc, fr, fq, lds, wid, lane); S.done(cur); }
#undef PG8_SA
#undef PG8_SB
#undef PG8_STAGE
#undef PG8_LDA
#undef PG8_LDB
#undef PG8_MMA
#undef PG8_WAIT_V
#undef PG8_WAIT_L
#undef PG8_BAR
#undef PG8_SCHED
}
}

#ifndef PG8_SP2
#define PG8_SP2 true
#endif
#ifndef PG8_ALIGN
#define PG8_ALIGN true
#endif
#include <hip/hip_bf16.h>
#include <cmath>
namespace attn_body {
using bf16=__hip_bfloat16;
using bf16x8=__attribute__((ext_vector_type(8)))short;
using s16x4=__attribute__((ext_vector_type(4)))short;
using f32x16=__attribute__((ext_vector_type(16)))float;
using u32x4=__attribute__((ext_vector_type(4)))unsigned;
constexpr int D=64;
constexpr int NW=8,QBLK=32,QB=QBLK*NW,KVBLK=64;
constexpr int ATTN_UNIT_ROWS=QB;
__device__ __forceinline__ int crow(int r,int hi){return (r&3)+8*(r>>2)+4*hi;}
#define SBAR() __builtin_amdgcn_sched_barrier(0)
__device__ __forceinline__ void cmask(f32x16&p0,f32x16&p1,int jb,int qrel,int hi){
  const float NEG=-INFINITY; int kb=64*jb+4*hi;
  #pragma unroll
  for(int r=0;r<16;++r){int kv=kb+(r&3)+8*(r>>2); if(kv>qrel)p0[r]=NEG; if(kv+32>qrel)p1[r]=NEG;}
}

constexpr int NSLOT=3, SLOTB=8192;
constexpr int LDS_K=0, LDS_V=NSLOT*SLOTB, LDS_WS=2*NSLOT*SLOTB, LDS_OST=LDS_WS+NW*64*4, LDS_BYTES=LDS_OST+NW*4096;
constexpr float C2=0.125f*1.4426950408889634f;
__device__ __forceinline__ void glds16(const void*gsrc,unsigned lds_dst){unsigned keep;
  asm volatile("s_mov_b32 %0, m0\n\ts_mov_b32 m0, %2\n\ts_nop 0\n\tglobal_load_lds_dwordx4 %1, off\n\ts_mov_b32 m0, %0":"=&s"(keep):"v"(gsrc),"s"(lds_dst):"memory");}
__device__ __forceinline__ float max3f(float a,float b,float c){float r;asm("v_max3_f32 %0, %1, %2, %3":"=v"(r):"v"(a),"v"(b),"v"(c));return r;}
__device__ __forceinline__ float max2f(float a,float b){float r;asm("v_max_f32_e32 %0, %1, %2":"=v"(r):"v"(a),"v"(b));return r;}
__device__ __forceinline__ float fadd_s(float a,float b){float r;asm("v_add_f32_e32 %0, %1, %2":"=v"(r):"v"(a),"v"(b));return r;}
__device__ __forceinline__ float fsub_s(float a,float b){float r;asm("v_sub_f32_e32 %0, %1, %2":"=v"(r):"v"(a),"v"(b));return r;}
typedef float f32x2_t __attribute__((ext_vector_type(2))); typedef __bf16 bf16x2_t __attribute__((ext_vector_type(2)));
__device__ __forceinline__ unsigned cvtpk_s(float lo,float hi){f32x2_t v={lo,hi};bf16x2_t b=__builtin_convertvector(v,bf16x2_t);return __builtin_bit_cast(unsigned,b);}
#define WAIT_BAR(N) asm volatile("s_waitcnt vmcnt(" #N ") lgkmcnt(0)\n\ts_barrier":::"memory")

__device__ __forceinline__ void qkt(f32x16&p0,f32x16&p1,const char*Kslot,const bf16x8*qr,const f32x16&negm,int r32,int hi){
  const char*kb=Kslot+hi*1024+r32*16;
  #pragma unroll
  for(int d0=0;d0<4;++d0){
    const bf16x8 b0=*reinterpret_cast<const bf16x8*>(kb+d0*2048);
    const bf16x8 b1=*reinterpret_cast<const bf16x8*>(kb+d0*2048+512);
    if(d0==0){p0=__builtin_amdgcn_mfma_f32_32x32x16_bf16(b0,qr[0],negm,0,0,0);p1=__builtin_amdgcn_mfma_f32_32x32x16_bf16(b1,qr[0],negm,0,0,0);}
    else{p0=__builtin_amdgcn_mfma_f32_32x32x16_bf16(b0,qr[d0],p0,0,0,0);p1=__builtin_amdgcn_mfma_f32_32x32x16_bf16(b1,qr[d0],p1,0,0,0);}}
}
typedef __attribute__((address_space(3))) const char* lds_cptr;
typedef short v4i16_t __attribute__((ext_vector_type(4)));
__device__ __forceinline__ void kload8(bf16x8*kf,lds_cptr kp){
  kf[0]=*(const __attribute__((address_space(3))) bf16x8*)(kp);      kf[1]=*(const __attribute__((address_space(3))) bf16x8*)(kp+512);
  kf[2]=*(const __attribute__((address_space(3))) bf16x8*)(kp+2048); kf[3]=*(const __attribute__((address_space(3))) bf16x8*)(kp+2560);
  kf[4]=*(const __attribute__((address_space(3))) bf16x8*)(kp+4096); kf[5]=*(const __attribute__((address_space(3))) bf16x8*)(kp+4608);
  kf[6]=*(const __attribute__((address_space(3))) bf16x8*)(kp+6144); kf[7]=*(const __attribute__((address_space(3))) bf16x8*)(kp+6656);
}
__device__ __forceinline__ void kload2(bf16x8*kf,lds_cptr kp,int j){ kf[2*j]=*(const __attribute__((address_space(3))) bf16x8*)(kp+j*2048); kf[2*j+1]=*(const __attribute__((address_space(3))) bf16x8*)(kp+j*2048+512); }
__device__ __forceinline__ s16x4 vtr(lds_cptr p){ return __builtin_bit_cast(s16x4,__builtin_amdgcn_ds_read_tr16_b64_v4i16((__attribute__((address_space(3))) v4i16_t*)p)); }
__device__ __forceinline__ float rowmax(const f32x16&p0,const f32x16&p1){
  float a=max3f(p0[0],p0[1],p1[0]),b=max3f(p0[2],p0[3],p1[1]);a=max3f(a,p1[2],p1[3]);
  #pragma unroll
  for(int r=4;r<16;r+=4){a=max3f(a,p0[r],p0[r+1]);b=max3f(b,p0[r+2],p0[r+3]);a=max3f(a,p1[r],p1[r+1]);b=max3f(b,p1[r+2],p1[r+3]);}
  const float m=max2f(a,b);
  auto rr=__builtin_amdgcn_permlane32_swap(__float_as_uint(m),__float_as_uint(m),false,false);
  return max2f(__uint_as_float(rr[0]),__uint_as_float(rr[1]));
}
__device__ __forceinline__ void pv(f32x16*o,int vb,bf16x8 pa0,bf16x8 pa1,bf16x8 pa2,bf16x8 pa3){
  #pragma unroll
  for(int d0=0;d0<2;++d0){s16x4 lo[4],hi[4];
    #pragma unroll
    for(int ks=0;ks<4;++ks){
      asm volatile("ds_read_b64_tr_b16 %0,%1 offset:%c2":"=&v"(lo[ks]):"v"(vb),"i"(d0*4096+ks*1024):"memory");
      asm volatile("ds_read_b64_tr_b16 %0,%1 offset:%c2":"=&v"(hi[ks]):"v"(vb),"i"(d0*4096+ks*1024+512):"memory");}
    asm volatile("s_waitcnt lgkmcnt(0)":::"memory");SBAR();
    #define PK(k) (bf16x8){lo[k][0],lo[k][1],lo[k][2],lo[k][3],hi[k][0],hi[k][1],hi[k][2],hi[k][3]}
    o[d0]=__builtin_amdgcn_mfma_f32_32x32x16_bf16(pa0,PK(0),o[d0],0,0,0);
    o[d0]=__builtin_amdgcn_mfma_f32_32x32x16_bf16(pa1,PK(1),o[d0],0,0,0);
    o[d0]=__builtin_amdgcn_mfma_f32_32x32x16_bf16(pa2,PK(2),o[d0],0,0,0);
    o[d0]=__builtin_amdgcn_mfma_f32_32x32x16_bf16(pa3,PK(3),o[d0],0,0,0);
    #undef PK
  }
}

#ifndef ATTN_STORE16
#define ATTN_STORE16(p,v) (*(u32x4*)(p)=(v))
#endif
template<int THRL,bool TILED> __device__ __forceinline__ void attn_unit(const bf16*Qu,int qp,const bf16*__restrict__ Kc,const bf16*__restrict__ Kl,int kp,const bf16*__restrict__ Vc,const bf16*__restrict__ Vl,int vp,bf16*Ou,int op,int NT,int NCT,int rot,char*shm){
  const int tid=threadIdx.x,lane=tid&63,r32=lane&31,hi=lane>>5; const int wid=__builtin_amdgcn_readfirstlane(tid>>6);
  const bf16*Qw=Qu+(long)(wid*QBLK)*qp;
  const unsigned lds0=(unsigned)(uintptr_t)shm;
  float*wsf=(float*)(shm+LDS_WS)+wid*64;
  const long koff=TILED?(long)(wid*512+lane*8):((long)lane*kp+wid*8); const bf16*ksrc_c=Kc+koff; const bf16*ksrc_l=Kl+koff-(long)NCT*KVBLK*kp;
  const long voff=TILED?(long)(wid*512+lane*8):((long)(16*(wid&3)+(lane>>2))*vp+(wid>>2)*32+(lane&3)*8); const bf16*vsrc_c=Vc+voff; const bf16*vsrc_l=Vl+voff-(long)NCT*KVBLK*vp;
  const unsigned kdst=lds0+LDS_K+wid*1024, vdst=lds0+LDS_V+wid*1024;
  #define ROTT(t) (((t)+rot>=NT)?((t)+rot-NT):((t)+rot))
  #define DMA_K(t,slot) glds16((ROTT(t)<NCT?ksrc_c:ksrc_l)+(long)ROTT(t)*KVBLK*kp,(unsigned)__builtin_amdgcn_readfirstlane(kdst+(slot)))
  #define DMA_V(t,slot) glds16((ROTT(t)<NCT?vsrc_c:vsrc_l)+(long)ROTT(t)*KVBLK*vp,(unsigned)__builtin_amdgcn_readfirstlane(vdst+(slot)))
  const int vb0=(int)(lds0+LDS_V)+((lane>>4)&1)*32+(lane&3)*8+(4*hi+((lane&15)>>2))*64;
  const char*Kbase=shm+LDS_K; bf16x8 kf[8];
  const lds_cptr shm3=(lds_cptr)shm; const lds_cptr kp0=shm3+LDS_K+hi*1024+r32*16; const lds_cptr vp0=shm3+LDS_V+((lane>>4)&1)*32+(lane&3)*8+(4*hi+((lane&15)>>2))*64;
  DMA_K(0,0);DMA_V(0,0);DMA_K(1,SLOTB);
  bf16x8 qr[4];
  #pragma unroll
  for(int d0=0;d0<4;++d0)qr[d0]=*reinterpret_cast<const bf16x8*>(&Qw[(long)r32*qp+d0*16+hi*8]);
  float mhat=0.f,l_reg=0.f;f32x16 o[2];o[0]=f32x16{};o[1]=f32x16{};f32x16 negm=f32x16{};asm volatile("":"+v"(negm));
  #define CMASK(P0,P1,t) do{}while(0)
  bool resc=false;
  #define START(P0,P1) do{ const float rm=rowmax(P0,P1); resc=false; \
    { const float dl=rm; mhat=fadd_s(mhat,dl); \
      _Pragma("unroll") for(int r=0;r<16;++r){P0[r]=fsub_s(P0[r],dl);P1[r]=fsub_s(P1[r],dl);} \
      _Pragma("unroll") for(int r=0;r<16;++r)negm[r]=-mhat; asm volatile("":"+v"(negm)); } \
    _Pragma("unroll") for(int r=0;r<16;++r)P0[r]=__builtin_amdgcn_exp2f(P0[r]); }while(0)
  #define RESC() do{ if(resc){ asm volatile("s_waitcnt lgkmcnt(0)":::"memory"); \
      _Pragma("unroll") for(int d_=0;d_<2;++d_) _Pragma("unroll") for(int r=0;r<16;++r)o[d_][r]*=wsf[crow(r,hi)]; } }while(0)
  f32x16 pA0,pA1,pB0,pB1;
  int sl_prev=0,sl_cur=0,sl_next=SLOTB;
  #define ROT() do{sl_prev=sl_cur;sl_cur=sl_next;sl_next=(sl_next==(NSLOT-1)*SLOTB)?0:sl_next+SLOTB;}while(0)
  DMA_K(2,2*SLOTB);
  WAIT_BAR(3);
  qkt(pA0,pA1,Kbase,qr,negm,r32,hi);asm volatile("s_nop 15\n\ts_nop 7":"+v"(pA0),"+v"(pA1));CMASK(pA0,pA1,0);
  START(pA0,pA1);
  _Pragma("unroll") for(int r=0;r<16;++r)pA1[r]=__builtin_amdgcn_exp2f(pA1[r]);
  WAIT_BAR(0);
  DMA_K(3,0);DMA_V(1,SLOTB);
  ROT();
  kload8(kf,kp0+sl_cur);
  WAIT_BAR(2);
  s16x4 vlo[8],vhi[8]; u32x4 pw0,pw1,pw2,pw3;
  #define PKW(P,B) cvtpk_s(P[B],P[B+1])
  #define PAF(k) __builtin_bit_cast(bf16x8,pw##k)
  #define VFR(i) (bf16x8){vlo[i][0],vlo[i][1],vlo[i][2],vlo[i][3],vhi[i][0],vhi[i][1],vhi[i][2],vhi[i][3]}
  #define PIN(x) asm volatile("":"+v"(x))
  #define MX3(a,b,c) __builtin_fmaxf(__builtin_fmaxf((a),(b)),(c))
  #define GAPA(MF,A0,A1,A2,A3,W0,W1,PW) do{ MF; sacc+=A0; sacc+=A1; sacc+=A2; sacc+=A3; PIN(sacc); W0; W1; PIN(PW); SBAR(); }while(0)
  #define EX(v) __builtin_amdgcn_exp2f(v)
  #define GAPB(MF,X,B) do{ MF; X[B]=EX(X[B]); X[B+1]=EX(X[B+1]); X[B+2]=EX(X[B+2]); X[B+3]=EX(X[B+3]); PIN(X); SBAR(); }while(0)
  #define VRD(i) do{ vlo[i]=vtr(vp_+(((i)>>2)*4096+((i)&3)*1024)); vhi[i]=vtr(vp_+(((i)>>2)*4096+((i)&3)*1024+512)); }while(0)
  #define KRD(G,j) do{ if(G){ kload2(kf,kp0+sl_next,j); SBAR(); } }while(0)
  #define STEP(C0,C1,P0,P1,t,GK,GV,GL) do{ SBAR(); \
    const lds_cptr vp_=vp0+sl_prev; \
    VRD(0); SBAR(); float sacc=(P0[0]+P0[1]); \
    GAPA(C0=__builtin_amdgcn_mfma_f32_32x32x16_bf16(kf[0],qr[0],negm,0,0,0), P0[2],P0[3],P0[4],P0[5],     pw0[0]=PKW(P0,0), pw0[1]=PKW(P0,2), pw0); \
    VRD(4); SBAR(); GAPA(C1=__builtin_amdgcn_mfma_f32_32x32x16_bf16(kf[1],qr[0],negm,0,0,0), P0[6],P0[7],P0[8],P0[9],     pw0[2]=PKW(P0,4), pw0[3]=PKW(P0,6), pw0); \
    VRD(1); SBAR(); GAPA(C0=__builtin_amdgcn_mfma_f32_32x32x16_bf16(kf[2],qr[1],C0,0,0,0),   P0[10],P0[11],P0[12],P0[13], pw1[0]=PKW(P0,8), pw1[1]=PKW(P0,10), pw1); \
    VRD(5); SBAR(); GAPA(C1=__builtin_amdgcn_mfma_f32_32x32x16_bf16(kf[3],qr[1],C1,0,0,0),   P0[14],P0[15],P1[0],P1[1],   pw1[2]=PKW(P0,12),pw1[3]=PKW(P0,14), pw1); \
    VRD(2); SBAR(); GAPA(C0=__builtin_amdgcn_mfma_f32_32x32x16_bf16(kf[4],qr[2],C0,0,0,0),   P1[2],P1[3],P1[4],P1[5],     pw2[0]=PKW(P1,0), pw2[1]=PKW(P1,2), pw2); \
    VRD(6); SBAR(); GAPA(C1=__builtin_amdgcn_mfma_f32_32x32x16_bf16(kf[5],qr[2],C1,0,0,0),   P1[6],P1[7],P1[8],P1[9],     pw2[2]=PKW(P1,4), pw2[3]=PKW(P1,6), pw2); \
    VRD(3); SBAR(); GAPA(C0=__builtin_amdgcn_mfma_f32_32x32x16_bf16(kf[6],qr[3],C0,0,0,0),   P1[10],P1[11],P1[12],P1[13], pw3[0]=PKW(P1,8), pw3[1]=PKW(P1,10), pw3); \
    VRD(7); SBAR(); GAPA(C1=__builtin_amdgcn_mfma_f32_32x32x16_bf16(kf[7],qr[3],C1,0,0,0),   P1[14],P1[15],0.f,0.f,       pw3[2]=PKW(P1,12),pw3[3]=PKW(P1,14), pw3); \
    l_reg+=sacc; \
    if(GK){DMA_K((t)+3,sl_cur);} if(GV){DMA_V((t)+1,sl_next);} \
    CMASK(C0,C1,t); \
    { float a=MX3(C0[0],C0[1],C1[0]),b=MX3(C0[2],C0[3],C1[1]); a=MX3(a,C1[2],C1[3]); \
      _Pragma("unroll") for(int r=4;r<16;r+=4){a=MX3(a,C0[r],C0[r+1]);b=MX3(b,C0[r+2],C0[r+3]);a=MX3(a,C1[r],C1[r+1]);b=MX3(b,C1[r+2],C1[r+3]);} \
      float rm=__builtin_fmaxf(a,b); { auto rr=__builtin_amdgcn_permlane32_swap(__float_as_uint(rm),__float_as_uint(rm),false,false); rm=__builtin_fmaxf(__uint_as_float(rr[0]),__uint_as_float(rr[1])); } \
      resc=false; \
      if(__builtin_expect(__any(rm>(float)THRL),0)){ const float dl=__builtin_fmaxf(rm,0.f); mhat+=dl; \
        _Pragma("unroll") for(int r=0;r<16;++r){C0[r]-=dl;C1[r]-=dl;} \
        _Pragma("unroll") for(int r=0;r<16;++r)negm[r]=-mhat; asm volatile("":"+v"(negm)); \
        const float f=__builtin_amdgcn_exp2f(-dl); l_reg*=f; if(hi==0)wsf[r32]=f; resc=true; } } \
    SBAR(); \
    GAPB(o[0]=__builtin_amdgcn_mfma_f32_32x32x16_bf16(PAF(0),VFR(0),o[0],0,0,0), C0,0); \
    GAPB(o[1]=__builtin_amdgcn_mfma_f32_32x32x16_bf16(PAF(0),VFR(4),o[1],0,0,0), C0,4); \
    KRD(GL,0); GAPB(o[0]=__builtin_amdgcn_mfma_f32_32x32x16_bf16(PAF(1),VFR(1),o[0],0,0,0), C0,8); \
    KRD(GL,1); GAPB(o[1]=__builtin_amdgcn_mfma_f32_32x32x16_bf16(PAF(1),VFR(5),o[1],0,0,0), C0,12); \
    KRD(GL,2); GAPB(o[0]=__builtin_amdgcn_mfma_f32_32x32x16_bf16(PAF(2),VFR(2),o[0],0,0,0), C1,0); \
    KRD(GL,3); GAPB(o[1]=__builtin_amdgcn_mfma_f32_32x32x16_bf16(PAF(2),VFR(6),o[1],0,0,0), C1,4); \
    GAPB(o[0]=__builtin_amdgcn_mfma_f32_32x32x16_bf16(PAF(3),VFR(3),o[0],0,0,0), C1,8); \
    GAPB(o[1]=__builtin_amdgcn_mfma_f32_32x32x16_bf16(PAF(3),VFR(7),o[1],0,0,0), C1,12); \
    }while(0)
  int t=1;
  #undef CMASK
  #define CMASK(P0,P1,t) do{}while(0)
  for(;t+5<NT;t+=2){
    STEP(pB0,pB1,pA0,pA1,t,true,true,true);     WAIT_BAR(2); RESC(); ROT();
    STEP(pA0,pA1,pB0,pB1,t+1,true,true,true);   WAIT_BAR(2); RESC(); ROT();
  }
  #undef CMASK
  #define CMASK(P0,P1,t) do{}while(0)
  #define ENDW(tt) do{ if((tt)+3<NT){WAIT_BAR(2);} else if((tt)+2<NT){WAIT_BAR(1);} else {WAIT_BAR(0);} }while(0)
  for(;t+1<NT;t+=2){
    STEP(pB0,pB1,pA0,pA1,t,(t+3<NT),(t+1<NT),(t+1<NT));       ENDW(t);   RESC(); ROT();
    STEP(pA0,pA1,pB0,pB1,t+1,(t+4<NT),(t+2<NT),(t+2<NT));     ENDW(t+1); RESC(); ROT();
  }
  STEP(pB0,pB1,pA0,pA1,NT-1,false,false,false); RESC();
  { float sacc=pB0[0]+pB0[1]; _Pragma("unroll") for(int r=2;r<16;++r)sacc+=pB0[r]; _Pragma("unroll") for(int r=0;r<16;++r)sacc+=pB1[r]; l_reg+=sacc;
    pw0=(u32x4){PKW(pB0,0),PKW(pB0,2),PKW(pB0,4),PKW(pB0,6)};pw1=(u32x4){PKW(pB0,8),PKW(pB0,10),PKW(pB0,12),PKW(pB0,14)};pw2=(u32x4){PKW(pB1,0),PKW(pB1,2),PKW(pB1,4),PKW(pB1,6)};pw3=(u32x4){PKW(pB1,8),PKW(pB1,10),PKW(pB1,12),PKW(pB1,14)};
    SBAR(); pv(o,vb0+sl_cur,PAF(0),PAF(1),PAF(2),PAF(3)); }
  #undef PKW
  #undef PAF
  #undef VFR
  #undef PIN
  #undef MX3
  #undef GAPA
  #undef GAPB
  #undef EX
  #undef VRD
  #undef KRD
  #undef STEP
  #undef ENDW
  {auto rr=__builtin_amdgcn_permlane32_swap(__float_as_uint(l_reg),__float_as_uint(l_reg),false,false);l_reg=__uint_as_float(rr[0])+__uint_as_float(rr[1]);}
  if(hi==0)wsf[32+r32]=l_reg;asm volatile("s_waitcnt lgkmcnt(0)":::"memory");
  float rli[16];
  #pragma unroll
  for(int r=0;r<16;++r)rli[r]=__builtin_amdgcn_rcpf(wsf[32+crow(r,hi)]);
  bf16*Ow=Ou+(long)(wid*QBLK)*op;
  { bf16*stg=(bf16*)(shm+LDS_OST)+wid*2048;
    #pragma unroll
    for(int r=0;r<16;++r){const int orow=crow(r,hi);
      #pragma unroll
      for(int d0=0;d0<2;++d0)stg[orow*64+d0*32+r32]=__float2bfloat16(o[d0][r]*rli[r]);}
    asm volatile("s_waitcnt lgkmcnt(0)":::"memory");
    #pragma unroll
    for(int i=0;i<4;++i){const int row=i*8+(lane>>3),ch=lane&7; const u32x4 v=*(const u32x4*)(stg+row*64+ch*8); ATTN_STORE16(Ow+(long)row*op+ch*8,v);} }
  asm volatile("s_waitcnt lgkmcnt(0)\n\ts_barrier":::"memory");
  #undef DMA_K
  #undef ROTT
  #undef DMA_V
  #undef CMASK
  #undef START
  #undef RESC
  #undef ROT
}
constexpr int LDS2_V=NSLOT*SLOTB, LDS2_WS=LDS2_V+NSLOT*2*SLOTB, LDS2_OST=LDS2_WS+NW*64*4, LDS2_BYTES=LDS2_OST+NW*4096;
template<int THRL> __device__ __forceinline__ void attn_unit2(const bf16*Qu,int qp,const bf16*__restrict__ Ks,const bf16*__restrict__ Va,const bf16*__restrict__ Vb,bf16*Ou,int op,int NT,int rot,char*shm){
  const int tid=threadIdx.x,lane=tid&63,r32=lane&31,hi=lane>>5; const int wid=__builtin_amdgcn_readfirstlane(tid>>6);
  const bf16*Qw=Qu+(long)(wid*QBLK)*qp;
  const unsigned lds0=(unsigned)(uintptr_t)shm;
  float*wsf=(float*)(shm+LDS2_WS)+wid*64;
  const long koff=(long)(wid*512+lane*8); const bf16*ksrc=Ks+koff; const bf16*vsrca=Va+koff; const bf16*vsrcb=Vb+koff;
  const unsigned kdst=lds0+LDS_K+wid*1024, vdst=lds0+LDS2_V+wid*1024;
  #define ROTT(t) (((t)+rot>=NT)?((t)+rot-NT):((t)+rot))
  #define DMA_K(t,slot) glds16(ksrc+(long)ROTT(t)*4096,(unsigned)__builtin_amdgcn_readfirstlane(kdst+(slot)))
  #define DMA_V(t,slot) do{ glds16(vsrca+(long)ROTT(t)*4096,(unsigned)__builtin_amdgcn_readfirstlane(vdst+2*(slot))); glds16(vsrcb+(long)ROTT(t)*4096,(unsigned)__builtin_amdgcn_readfirstlane(vdst+2*(slot)+8192)); }while(0)
  const int vb0=(int)(lds0+LDS2_V)+((lane>>4)&1)*32+(lane&3)*8+(4*hi+((lane&15)>>2))*64;
  const char*Kbase=shm+LDS_K; bf16x8 kf[8];
  const lds_cptr shm3=(lds_cptr)shm; const lds_cptr kp0=shm3+LDS_K+hi*1024+r32*16; const lds_cptr vp0=shm3+LDS2_V+((lane>>4)&1)*32+(lane&3)*8+(4*hi+((lane&15)>>2))*64;
  DMA_K(0,0);DMA_V(0,0);DMA_K(1,SLOTB);
  bf16x8 qr[4];
  #pragma unroll
  for(int d0=0;d0<4;++d0)qr[d0]=*reinterpret_cast<const bf16x8*>(&Qw[(long)r32*qp+d0*16+hi*8]);
  float mhat=0.f,l_reg=0.f;f32x16 o[4];o[0]=f32x16{};o[1]=f32x16{};o[2]=f32x16{};o[3]=f32x16{};const f32x16 zero16=f32x16{};
  #define CMASK(P0,P1,t) do{}while(0)
  bool resc=false;
  #define START(P0,P1) do{ const float rm=rowmax(P0,P1); resc=false; mhat=rm; \
    _Pragma("unroll") for(int r=0;r<16;++r)P0[r]=__builtin_amdgcn_exp2f(P0[r]-mhat); }while(0)
  #define RESC() do{ if(resc){ asm volatile("s_waitcnt lgkmcnt(0)":::"memory"); \
      _Pragma("unroll") for(int d_=0;d_<4;++d_) _Pragma("unroll") for(int r=0;r<16;++r)o[d_][r]*=wsf[crow(r,hi)]; } }while(0)
  f32x16 pA0,pA1,pB0,pB1;
  int sl_prev=0,sl_cur=0,sl_next=SLOTB;
  #define ROT() do{sl_prev=sl_cur;sl_cur=sl_next;sl_next=(sl_next==(NSLOT-1)*SLOTB)?0:sl_next+SLOTB;}while(0)
  DMA_K(2,2*SLOTB);
  WAIT_BAR(4);
  qkt(pA0,pA1,Kbase,qr,zero16,r32,hi);asm volatile("s_nop 15\n\ts_nop 7":"+v"(pA0),"+v"(pA1));CMASK(pA0,pA1,0);
  START(pA0,pA1);
  _Pragma("unroll") for(int r=0;r<16;++r)pA1[r]=__builtin_amdgcn_exp2f(pA1[r]-mhat);
  WAIT_BAR(0);
  DMA_K(3,0);DMA_V(1,SLOTB);
  ROT();
  kload8(kf,kp0+sl_cur);
  WAIT_BAR(3);
  s16x4 vlo[8],vhi[8]; u32x4 pw0,pw1,pw2,pw3;
  #define PKW(P,B) cvtpk_s(P[B],P[B+1])
  #define PAF(k) __builtin_bit_cast(bf16x8,pw##k)
  #define VFR(i) (bf16x8){vlo[i][0],vlo[i][1],vlo[i][2],vlo[i][3],vhi[i][0],vhi[i][1],vhi[i][2],vhi[i][3]}
  #define PIN(x) asm volatile("":"+v"(x))
  #define MX3(a,b,c) __builtin_fmaxf(__builtin_fmaxf((a),(b)),(c))
  #define GAPA(MF,A0,A1,A2,A3,W0,W1,PW) do{ MF; sacc+=A0; sacc+=A1; sacc+=A2; sacc+=A3; PIN(sacc); W0; W1; PIN(PW); SBAR(); }while(0)
  #define EX(v) __builtin_amdgcn_exp2f(v)
  #define GAPB(MF,X,B) do{ MF; X[B]=EX(X[B]-mhat); X[B+1]=EX(X[B+1]-mhat); PIN(X); SBAR(); }while(0)
  #define VRD(i) do{ vlo[i]=vtr(vp_+(((i)>>2)*4096+((i)&3)*1024)); vhi[i]=vtr(vp_+(((i)>>2)*4096+((i)&3)*1024+512)); }while(0)
  #define VRD2(i) do{ vlo[i]=vtr(vp_+(8192+((i)>>2)*4096+((i)&3)*1024)); vhi[i]=vtr(vp_+(8192+((i)>>2)*4096+((i)&3)*1024+512)); SBAR(); }while(0)
  #define KRD(G,j) do{ if(G){ kload2(kf,kp0+sl_next,j); SBAR(); } }while(0)
  #define STEP(C0,C1,P0,P1,t,GK,GV,GL) do{ SBAR(); \
    const lds_cptr vp_=vp0+2*sl_prev; \
    VRD(0); SBAR(); float sacc=(P0[0]+P0[1]); \
    GAPA(C0=__builtin_amdgcn_mfma_f32_32x32x16_bf16(kf[0],qr[0],zero16,0,0,0), P0[2],P0[3],P0[4],P0[5],     pw0[0]=PKW(P0,0), pw0[1]=PKW(P0,2), pw0); \
    VRD(4); SBAR(); GAPA(C1=__builtin_amdgcn_mfma_f32_32x32x16_bf16(kf[1],qr[0],zero16,0,0,0), P0[6],P0[7],P0[8],P0[9],     pw0[2]=PKW(P0,4), pw0[3]=PKW(P0,6), pw0); \
    VRD(1); SBAR(); GAPA(C0=__builtin_amdgcn_mfma_f32_32x32x16_bf16(kf[2],qr[1],C0,0,0,0),   P0[10],P0[11],P0[12],P0[13], pw1[0]=PKW(P0,8), pw1[1]=PKW(P0,10), pw1); \
    VRD(5); SBAR(); GAPA(C1=__builtin_amdgcn_mfma_f32_32x32x16_bf16(kf[3],qr[1],C1,0,0,0),   P0[14],P0[15],P1[0],P1[1],   pw1[2]=PKW(P0,12),pw1[3]=PKW(P0,14), pw1); \
    VRD(2); SBAR(); GAPA(C0=__builtin_amdgcn_mfma_f32_32x32x16_bf16(kf[4],qr[2],C0,0,0,0),   P1[2],P1[3],P1[4],P1[5],     pw2[0]=PKW(P1,0), pw2[1]=PKW(P1,2), pw2); \
    VRD(6); SBAR(); GAPA(C1=__builtin_amdgcn_mfma_f32_32x32x16_bf16(kf[5],qr[2],C1,0,0,0),   P1[6],P1[7],P1[8],P1[9],     pw2[2]=PKW(P1,4), pw2[3]=PKW(P1,6), pw2); \
    VRD(3); SBAR(); GAPA(C0=__builtin_amdgcn_mfma_f32_32x32x16_bf16(kf[6],qr[3],C0,0,0,0),   P1[10],P1[11],P1[12],P1[13], pw3[0]=PKW(P1,8), pw3[1]=PKW(P1,10), pw3); \
    VRD(7); SBAR(); GAPA(C1=__builtin_amdgcn_mfma_f32_32x32x16_bf16(kf[7],qr[3],C1,0,0,0),   P1[14],P1[15],0.f,0.f,       pw3[2]=PKW(P1,12),pw3[3]=PKW(P1,14), pw3); \
    l_reg+=sacc; \
    if(GK){DMA_K((t)+3,sl_cur);} if(GV){DMA_V((t)+1,sl_next);} \
    CMASK(C0,C1,t); \
    { float a=MX3(C0[0],C0[1],C1[0]),b=MX3(C0[2],C0[3],C1[1]); a=MX3(a,C1[2],C1[3]); \
      _Pragma("unroll") for(int r=4;r<16;r+=4){a=MX3(a,C0[r],C0[r+1]);b=MX3(b,C0[r+2],C0[r+3]);a=MX3(a,C1[r],C1[r+1]);b=MX3(b,C1[r+2],C1[r+3]);} \
      float rm=__builtin_fmaxf(a,b); { auto rr=__builtin_amdgcn_permlane32_swap(__float_as_uint(rm),__float_as_uint(rm),false,false); rm=__builtin_fmaxf(__uint_as_float(rr[0]),__uint_as_float(rr[1])); } \
      resc=false; \
      rm-=mhat; \
      if(__builtin_expect(__any(rm>(float)THRL),0)){ const float dl=__builtin_fmaxf(rm,0.f); mhat+=dl; \
        const float f=__builtin_amdgcn_exp2f(-dl); l_reg*=f; if(hi==0)wsf[r32]=f; resc=true; } } \
    SBAR(); \
    GAPB(o[0]=__builtin_amdgcn_mfma_f32_32x32x16_bf16(PAF(0),VFR(0),o[0],0,0,0), C0,0); VRD2(0); \
    GAPB(o[1]=__builtin_amdgcn_mfma_f32_32x32x16_bf16(PAF(0),VFR(4),o[1],0,0,0), C0,2); VRD2(4); \
    KRD(GL,0); GAPB(o[0]=__builtin_amdgcn_mfma_f32_32x32x16_bf16(PAF(1),VFR(1),o[0],0,0,0), C0,4); VRD2(1); \
    KRD(GL,1); GAPB(o[1]=__builtin_amdgcn_mfma_f32_32x32x16_bf16(PAF(1),VFR(5),o[1],0,0,0), C0,6); VRD2(5); \
    KRD(GL,2); GAPB(o[0]=__builtin_amdgcn_mfma_f32_32x32x16_bf16(PAF(2),VFR(2),o[0],0,0,0), C0,8); VRD2(2); \
    KRD(GL,3); GAPB(o[1]=__builtin_amdgcn_mfma_f32_32x32x16_bf16(PAF(2),VFR(6),o[1],0,0,0), C0,10); VRD2(6); \
    GAPB(o[0]=__builtin_amdgcn_mfma_f32_32x32x16_bf16(PAF(3),VFR(3),o[0],0,0,0), C0,12); VRD2(3); \
    GAPB(o[1]=__builtin_amdgcn_mfma_f32_32x32x16_bf16(PAF(3),VFR(7),o[1],0,0,0), C0,14); VRD2(7); \
    GAPB(o[2]=__builtin_amdgcn_mfma_f32_32x32x16_bf16(PAF(0),VFR(0),o[2],0,0,0), C1,0); \
    GAPB(o[3]=__builtin_amdgcn_mfma_f32_32x32x16_bf16(PAF(0),VFR(4),o[3],0,0,0), C1,2); \
    GAPB(o[2]=__builtin_amdgcn_mfma_f32_32x32x16_bf16(PAF(1),VFR(1),o[2],0,0,0), C1,4); \
    GAPB(o[3]=__builtin_amdgcn_mfma_f32_32x32x16_bf16(PAF(1),VFR(5),o[3],0,0,0), C1,6); \
    GAPB(o[2]=__builtin_amdgcn_mfma_f32_32x32x16_bf16(PAF(2),VFR(2),o[2],0,0,0), C1,8); \
    GAPB(o[3]=__builtin_amdgcn_mfma_f32_32x32x16_bf16(PAF(2),VFR(6),o[3],0,0,0), C1,10); \
    GAPB(o[2]=__builtin_amdgcn_mfma_f32_32x32x16_bf16(PAF(3),VFR(3),o[2],0,0,0), C1,12); \
    GAPB(o[3]=__builtin_amdgcn_mfma_f32_32x32x16_bf16(PAF(3),VFR(7),o[3],0,0,0), C1,14); \
    }while(0)
  int t=1;
  #undef CMASK
  #define CMASK(P0,P1,t) do{}while(0)
  for(;t+5<NT;t+=2){
    STEP(pB0,pB1,pA0,pA1,t,true,true,true);     WAIT_BAR(3); RESC(); ROT();
    STEP(pA0,pA1,pB0,pB1,t+1,true,true,true);   WAIT_BAR(3); RESC(); ROT();
  }
  #undef CMASK
  #define CMASK(P0,P1,t) do{}while(0)
  #define ENDW(tt) do{ if((tt)+3<NT){WAIT_BAR(3);} else if((tt)+2<NT){WAIT_BAR(2);} else {WAIT_BAR(0);} }while(0)
  for(;t+1<NT;t+=2){
    STEP(pB0,pB1,pA0,pA1,t,(t+3<NT),(t+1<NT),(t+1<NT));       ENDW(t);   RESC(); ROT();
    STEP(pA0,pA1,pB0,pB1,t+1,(t+4<NT),(t+2<NT),(t+2<NT));     ENDW(t+1); RESC(); ROT();
  }
  STEP(pB0,pB1,pA0,pA1,NT-1,false,false,false); RESC();
  { float sacc=pB0[0]+pB0[1]; _Pragma("unroll") for(int r=2;r<16;++r)sacc+=pB0[r]; _Pragma("unroll") for(int r=0;r<16;++r)sacc+=pB1[r]; l_reg+=sacc;
    pw0=(u32x4){PKW(pB0,0),PKW(pB0,2),PKW(pB0,4),PKW(pB0,6)};pw1=(u32x4){PKW(pB0,8),PKW(pB0,10),PKW(pB0,12),PKW(pB0,14)};pw2=(u32x4){PKW(pB1,0),PKW(pB1,2),PKW(pB1,4),PKW(pB1,6)};pw3=(u32x4){PKW(pB1,8),PKW(pB1,10),PKW(pB1,12),PKW(pB1,14)};
    SBAR(); pv(o,vb0+2*sl_cur,PAF(0),PAF(1),PAF(2),PAF(3)); pv(o+2,vb0+2*sl_cur+8192,PAF(0),PAF(1),PAF(2),PAF(3)); }
  #undef PKW
  #undef PAF
  #undef VFR
  #undef PIN
  #undef MX3
  #undef GAPA
  #undef GAPB
  #undef EX
  #undef VRD
  #undef VRD2
  #undef KRD
  #undef STEP
  #undef ENDW
  {auto rr=__builtin_amdgcn_permlane32_swap(__float_as_uint(l_reg),__float_as_uint(l_reg),false,false);l_reg=__uint_as_float(rr[0])+__uint_as_float(rr[1]);}
  if(hi==0)wsf[32+r32]=l_reg;asm volatile("s_waitcnt lgkmcnt(0)":::"memory");
  float rli[16];
  #pragma unroll
  for(int r=0;r<16;++r)rli[r]=__builtin_amdgcn_rcpf(wsf[32+crow(r,hi)]);
  bf16*Ow=Ou+(long)(wid*QBLK)*op;
  { bf16*stg=(bf16*)(shm+LDS2_OST)+wid*2048;
    #pragma unroll
    for(int hh=0;hh<2;++hh){
      #pragma unroll
      for(int r=0;r<16;++r){const int orow=crow(r,hi);
        #pragma unroll
        for(int d0=0;d0<2;++d0)stg[orow*64+d0*32+r32]=__float2bfloat16(o[2*hh+d0][r]*rli[r]);}
      asm volatile("s_waitcnt lgkmcnt(0)":::"memory");
      #pragma unroll
      for(int i=0;i<4;++i){const int row=i*8+(lane>>3),ch=lane&7; const u32x4 v=*(const u32x4*)(stg+row*64+ch*8); ATTN_STORE16(Ow+(long)row*op+hh*64+ch*8,v);}
      asm volatile("s_waitcnt lgkmcnt(0)":::"memory"); } }
  asm volatile("s_waitcnt lgkmcnt(0)\n\ts_barrier":::"memory");
  #undef DMA_K
  #undef ROTT
  #undef DMA_V
  #undef CMASK
  #undef START
  #undef RESC
  #undef ROT
}
constexpr int ATTN_LDS_BYTES=LDS_BYTES;
#undef SBAR
#undef WAIT_BAR
}
constexpr int NWAVES = 8;
#ifndef MK_ONE_LAUNCH
#define MK_ONE_LAUNCH 1
#endif
constexpr int NPH = 20;

constexpr int D = 1024, NB = 2, SEQ = 8192, CTXL = 256;
constexpr int ML = NB * SEQ, MC = NB * CTXL, MR = ML + MC;
constexpr int E_IN = 2560, O_IN = 1792, FF = 2816, FF2 = 2 * FF, NEXP = 8;
constexpr int MOE_ROWS = 2 * ML + NEXP * 256, MOE_PAN = MOE_ROWS / 256;
constexpr int NCHUNK = MR / 64;
constexpr float EPS = 1e-6f;
constexpr float QSCALE = 0.125f * 1.4426950408889634f;

constexpr size_t MiB = 1u << 20, KiB = 1u << 10;
constexpr size_t WS_CTL = 0, CTL_ZERO_BYTES = 1 * MiB;
constexpr size_t WS_MOD = 1 * MiB;
constexpr size_t WS_WG = 1 * MiB + 256 * KiB;
constexpr size_t WS_TOK = 2 * MiB;
constexpr size_t WS_AGG = 4 * MiB;
constexpr size_t WS_WM13 = 8 * MiB, WS_WM2 = 96 * MiB;
constexpr size_t WS_WE = 140 * MiB, WS_WO0 = 145 * MiB, WS_WO1 = 147 * MiB, WS_WF13 = 149 * MiB, WS_WF2 = 160 * MiB, WS_WOI = 166 * MiB;
constexpr size_t WS_XR = 170 * MiB;
constexpr size_t WS_KC0 = 170 * MiB, WS_VC0 = 187 * MiB;
constexpr size_t WS_KC1 = 427 * MiB, WS_VC1 = 432 * MiB;
constexpr int KEYS = CTXL + SEQ;
constexpr size_t WS_XN = 236 * MiB;
constexpr size_t WS_Y = 269 * MiB;
constexpr size_t WS_P0 = 302 * MiB;
constexpr size_t WS_OATT = 385 * MiB;
constexpr size_t WS_H = 302 * MiB;
constexpr size_t WS_P1 = 302 * MiB;
constexpr size_t WS_RI = 360 * MiB;
constexpr size_t WS_XG = 368 * MiB;
constexpr size_t WS_HG = 140 * MiB;
constexpr size_t WS_YG = 368 * MiB;
constexpr size_t WS_END = 436 * MiB;
static_assert(WS_WM13 + (size_t)NEXP * FF2 * D * 2 <= WS_WM2 && WS_WM2 + (size_t)NEXP * D * FF * 2 <= WS_WE && WS_WE + (size_t)E_IN * D * 2 <= WS_WO0 && WS_WF13 + (size_t)FF2 * D * 2 <= WS_WF2 &&
              WS_WF2 + (size_t)D * FF * 2 <= WS_WOI && WS_WOI + (size_t)O_IN * D * 2 <= WS_XR && WS_XR + (size_t)MR * D * 4 <= WS_XN && WS_XN + (size_t)MR * D * 2 <= WS_Y && WS_Y + (size_t)MR * D * 2 <= WS_P0 &&
              WS_P0 + (size_t)MR * E_IN * 2 <= WS_OATT && WS_OATT + (size_t)MR * D * 2 <= WS_END && WS_H + (size_t)MR * FF * 2 <= WS_END && WS_P1 + (size_t)MR * O_IN * 2 <= WS_RI &&
              WS_RI + (size_t)4 * MR * 512 * 2 <= WS_END && WS_XG + (size_t)MOE_ROWS * D * 2 <= WS_END && WS_HG + (size_t)MOE_ROWS * FF * 2 <= WS_XG && WS_AGG + (size_t)2 * NCHUNK * 2 * 512 * 4 <= WS_WM13, "d_ws map");
constexpr int CW_TMO = 0, CW_CODE = 1;
constexpr int CW_BAR = 4096;
constexpr int CW_CNT = 8192;
constexpr int RING_OFF = 0, RING_BYTES = 131072;
constexpr int LDSCTL_OFF = RING_BYTES, MISC_OFF = LDSCTL_OFF + 320;
constexpr int PEXP_OFF = LDSCTL_OFF + 1024;
constexpr int LDS_BYTES = 147456;
#define GAS __attribute__((address_space(1)))
#define LAS __attribute__((address_space(3)))
typedef unsigned short bf16;
typedef unsigned v4u __attribute__((ext_vector_type(4)));
typedef float f32x4 __attribute__((ext_vector_type(4)));
typedef short bf16x8 __attribute__((ext_vector_type(8)));
typedef GAS unsigned gu32;
typedef GAS unsigned long long gu64;
#define RLX_AGENT __ATOMIC_RELAXED, __HIP_MEMORY_SCOPE_AGENT
#define LDS_WAIT() asm volatile("s_waitcnt lgkmcnt(0)" ::: "memory")
#define VM_WAIT() asm volatile("s_waitcnt vmcnt(0)" ::: "memory")
__device__ __forceinline__ unsigned long long rt() { return __builtin_amdgcn_s_memrealtime(); }
__device__ __forceinline__ unsigned f2bf(float f) { unsigned u = __builtin_bit_cast(unsigned, f); return (u + 0x7fffu + ((u >> 16) & 1u)) >> 16; }
__device__ __forceinline__ unsigned pk2(float lo, float hi) { return f2bf(lo) | (f2bf(hi) << 16); }

#define XB_TMO      128
#define XB_XCNT(j)  (256  + 64 * (j))
#define XB_XSUB(j)  (1280 + 64 * (j))
#define XB_XGEN(j)  (2304 + 64 * (j))
#define XB_TOP      3328
#define XB_TOPGEN   3392
#define XCD_BAR_WORDS 3456
#define XB_SPIN_CAP (1u << 18)

__device__ __forceinline__ unsigned xb_ld(unsigned* p)              { return __hip_atomic_load(p, __ATOMIC_RELAXED, __HIP_MEMORY_SCOPE_AGENT); }
__device__ __forceinline__ unsigned xb_add(unsigned* p, unsigned v) { return __hip_atomic_fetch_add(p, v, __ATOMIC_RELAXED, __HIP_MEMORY_SCOPE_AGENT); }
__device__ __forceinline__ unsigned xb_xcc_id() { return (unsigned)__builtin_amdgcn_s_getreg((3 << 11) | 20) & 0xFu; }
#define XB_SPIN(cond, bar) do { unsigned _sp = 0; while (cond) { __builtin_amdgcn_s_sleep(1); \
    if ((++_sp & 255u) == 0u) { if (xb_ld(&(bar)[XB_TMO])) break; if (_sp > XB_SPIN_CAP) { atomicAdd(&(bar)[XB_TMO], 1u); break; } } } } while (0)

struct XcdBarrier {
    unsigned* bar; unsigned x;
    volatile LAS unsigned* st;
};

__device__ __forceinline__ XcdBarrier xcd_barrier_post(unsigned* bar, volatile LAS unsigned* st) {
    XcdBarrier b; b.bar = bar; b.x = xb_xcc_id(); b.st = st;
    if (threadIdx.x == 0) (void)xb_add(&bar[XB_XCNT(b.x)], 1u);
    return b;
}
__device__ __forceinline__ void xcd_barrier_complete(unsigned* bar, unsigned x, unsigned& nloc, unsigned& nx) {
    const unsigned G = gridDim.x * gridDim.y * gridDim.z;
    unsigned sum, cnt, mine, sp = 0u;
    for (;;) {
        sum = 0u; cnt = 0u; mine = 0u;
#pragma unroll
        for (unsigned j = 0; j < 16; ++j) { const unsigned c = xb_ld(&bar[XB_XCNT(j)]); sum += c; cnt += (c > 0u) ? 1u : 0u; mine = (j == x) ? c : mine; }
        if (sum == G) break;
        __builtin_amdgcn_s_sleep(1);
        if ((++sp & 255u) == 0u) { if (xb_ld(&bar[XB_TMO])) break; if (sp > XB_SPIN_CAP) { atomicAdd(&bar[XB_TMO], 1u); break; } }
    }
    nloc = mine > 0u ? mine : 1u; nx = cnt > 0u ? cnt : 1u;
}

__device__ __forceinline__ void xcd_barrier(const XcdBarrier& b) {
    asm volatile("s_waitcnt vmcnt(0)" ::: "memory");
    __syncthreads();
    if (threadIdx.x == 0) {
        unsigned* bar = b.bar;
        __builtin_amdgcn_s_waitcnt(0);
        unsigned nloc = b.st[0], nx = b.st[1];
        if (nloc == 0u) { xcd_barrier_complete(bar, b.x, nloc, nx); b.st[0] = nloc; b.st[1] = nx; }
        const unsigned old = xb_add(&bar[XB_XSUB(b.x)], 1u);
        const unsigned gen = old / nloc;
        if (old + 1u == (gen + 1u) * nloc) {
            __builtin_amdgcn_fence(__ATOMIC_RELEASE, "agent");
            asm volatile("s_waitcnt vmcnt(0)" ::: "memory");
            const unsigned og = xb_add(&bar[XB_TOP], 1u);
            const unsigned tg = og / nx;
            if (og + 1u == (tg + 1u) * nx) xb_add(&bar[XB_TOPGEN], 1u);
            else XB_SPIN(xb_ld(&bar[XB_TOPGEN]) == tg, bar);
            __builtin_amdgcn_fence(__ATOMIC_ACQUIRE, "agent");
            xb_add(&bar[XB_XGEN(b.x)], 1u);
            asm volatile("s_waitcnt vmcnt(0)" ::: "memory");
        } else {
            XB_SPIN(xb_ld(&bar[XB_XGEN(b.x)]) == gen, bar);
            __builtin_amdgcn_fence(__ATOMIC_ACQUIRE, "agent");
            asm volatile("s_waitcnt vmcnt(0)" ::: "memory");
        }
    }
    __syncthreads();
}
typedef _Float16 f16;
typedef unsigned v2u __attribute__((ext_vector_type(2)));
typedef float f32x16 __attribute__((ext_vector_type(16)));
struct Frame {
    LAS unsigned char* lds;
    volatile LAS unsigned* MISC;
    gu32* ctl;
    int tid, lane, wave;
    int vcu, G;
    const float* in[38]; float* out; unsigned char* ws;
};
enum { I_X = 0, I_C, I_CTX, I_CCTX, I_WMOD, I_BMOD, I_NMIXG, I_NFFNG, I_WOUT, I_EWIN, I_ANORMG, I_AWS, I_ABS, I_BQNG, I_BKNG, I_LQ1, I_LK1, I_LQ2, I_LK2, I_SUBLNG,
       I_FW1, I_FW3, I_FW2, I_OWIN, I_CQNG, I_CKNG, I_CONVW, I_CONVB, I_DWA, I_DBA, I_DWX, I_DBX, I_DLAM, I_RW, I_RB, I_MW1, I_MW3, I_MW2 };

__device__ __forceinline__ float wave_sum(float v) {
#pragma unroll
    for (int o = 1; o < 64; o <<= 1) v += __shfl_xor(v, o);
    return v;
}
__device__ __forceinline__ float bf_lo(unsigned u) { return __uint_as_float(u << 16); }
__device__ __forceinline__ float bf_hi(unsigned u) { return __uint_as_float(u & 0xffff0000u); }
__device__ __forceinline__ float bf2f(bf16 h) { return __uint_as_float((unsigned)h << 16); }
__device__ __forceinline__ unsigned cvtpk(float lo, float hi) { return pg8::cvt_pk_bf16(lo, hi); }
__device__ __forceinline__ bf16 f2bf16(float f) { return (bf16)(cvtpk(f, 0.f) & 0xffffu); }
__device__ __forceinline__ void unpack8(const v4u u, float (&f)[8]) { f[0] = bf_lo(u.x); f[1] = bf_hi(u.x); f[2] = bf_lo(u.y); f[3] = bf_hi(u.y); f[4] = bf_lo(u.z); f[5] = bf_hi(u.z); f[6] = bf_lo(u.w); f[7] = bf_hi(u.w); }
__device__ __forceinline__ v4u pack8(const float (&f)[8]) { v4u o; o.x = cvtpk(f[0], f[1]); o.y = cvtpk(f[2], f[3]); o.z = cvtpk(f[4], f[5]); o.w = cvtpk(f[6], f[7]); return o; }
__device__ __forceinline__ float gelu_tanh(float x) { const float z = 0.7978845608028654f * (x + 0.044715f * x * x * x); return x * __builtin_amdgcn_rcpf(1.0f + __builtin_amdgcn_exp2f(-2.885390081777927f * z)); }
__device__ __forceinline__ float sigmoid_f(float x) { return __builtin_amdgcn_rcpf(1.0f + __builtin_amdgcn_exp2f(-1.4426950408889634f * x)); }
__device__ __forceinline__ int crow16(int r, int hi) { return (r & 3) + 8 * (r >> 2) + 4 * hi; }

__device__ __forceinline__ void tr_item(const float* W, int K, int N, bf16* WT, int ilv, LAS float* scr, int item, int lane) {
    const int nblk = N / 32, kb = item / nblk, nb = item % nblk, k0 = 64 * kb, n0 = 32 * nb;
    const int r0 = ilv ? ((n0 >> 7) * 256 + (n0 & 127) + (ilv == 2 ? 128 : 0)) : n0;
#pragma unroll 8
    for (int i = 0; i < 32; ++i) { const int kk = 2 * i + (lane >> 5); scr[kk * 33 + (lane & 31)] = W[(size_t)(k0 + kk) * N + n0 + (lane & 31)]; }
    LDS_WAIT(); asm volatile("" ::: "memory");
    const int c = lane & 7;
#pragma unroll
    for (int j = 0; j < 4; ++j) { const int n = (lane >> 3) + 8 * j; const LAS float* s = scr + (8 * c) * 33 + n;
        v4u o; o.x = cvtpk(s[0 * 33], s[1 * 33]); o.y = cvtpk(s[2 * 33], s[3 * 33]); o.z = cvtpk(s[4 * 33], s[5 * 33]); o.w = cvtpk(s[6 * 33], s[7 * 33]);
        *(GAS v4u*)(WT + (size_t)(r0 + n) * K + k0 + 8 * c) = o; }
    LDS_WAIT(); asm volatile("" ::: "memory");
}
__device__ __forceinline__ void ph0_prologue(Frame& F) {
    LAS float* scr = (LAS float*)(F.lds + RING_OFF + F.wave * 16384);
    const int gw = F.vcu * NWAVES + F.wave, NGW = F.G * NWAVES, lane = F.lane;
    bf16* WE = (bf16*)(F.ws + WS_WE); bf16* WO0 = (bf16*)(F.ws + WS_WO0); bf16* WO1 = (bf16*)(F.ws + WS_WO1); bf16* WF13 = (bf16*)(F.ws + WS_WF13); bf16* WF2 = (bf16*)(F.ws + WS_WF2);
    bf16* WOI = (bf16*)(F.ws + WS_WOI); bf16* WM13 = (bf16*)(F.ws + WS_WM13); bf16* WM2 = (bf16*)(F.ws + WS_WM2);
    constexpr int I_E = 16 * 80, I_O = 16 * 32, I_F = 16 * 88, I_F2 = 44 * 32, I_OI = 16 * 56, I_EXP = 3 * I_F;
    static_assert(I_F == I_F2, "item counts");
    constexpr int NITEMS = I_E + 2 * I_O + 2 * I_F + I_F2 + I_OI + NEXP * I_EXP;
    for (int it = gw; it < NITEMS; it += NGW) {
        int r = it;
        if (r < I_E) { tr_item(F.in[I_EWIN], D, E_IN, WE, 0, scr, r, lane); continue; } r -= I_E;
        if (r < I_O) { tr_item(F.in[I_WOUT], D, D, WO0, 0, scr, r, lane); continue; } r -= I_O;
        if (r < I_O) { tr_item(F.in[I_WOUT] + (size_t)D * D, D, D, WO1, 0, scr, r, lane); continue; } r -= I_O;
        if (r < I_F) { tr_item(F.in[I_FW1], D, FF, WF13, 1, scr, r, lane); continue; } r -= I_F;
        if (r < I_F) { tr_item(F.in[I_FW3], D, FF, WF13, 2, scr, r, lane); continue; } r -= I_F;
        if (r < I_F2) { tr_item(F.in[I_FW2], FF, D, WF2, 0, scr, r, lane); continue; } r -= I_F2;
        if (r < I_OI) { tr_item(F.in[I_OWIN], D, O_IN, WOI, 0, scr, r, lane); continue; } r -= I_OI;
        { const int e = r / I_EXP, q = r % I_EXP;
          if (q < I_F) tr_item(F.in[I_MW1] + (size_t)e * D * FF, D, FF, WM13 + (size_t)e * FF2 * D, 1, scr, q, lane);
          else if (q < 2 * I_F) tr_item(F.in[I_MW3] + (size_t)e * D * FF, D, FF, WM13 + (size_t)e * FF2 * D, 2, scr, q - I_F, lane);
          else tr_item(F.in[I_MW2] + (size_t)e * FF * D, FF, D, WM2 + (size_t)e * D * FF, 0, scr, q - 2 * I_F, lane); }
    }
    { bf16* WG = (bf16*)(F.ws + WS_WG);
      for (int i = (int)blockIdx.x * 512 + F.tid; i < 2 * 2 * 8 * 64 * 64; i += F.G * 512) {
          const int k = i & 63, o = (i >> 6) & 63, n = (i >> 12) & 7, mat = (i >> 15) & 1, d = (i >> 16) & 1;
          const float* W = mat ? F.in[I_DWX] : F.in[I_DWA];
          WG[i] = f2bf16(W[((size_t)(d * 8 + n) * 64 + k) * 64 + o]); } }
    __syncthreads();
    { float* MOD = (float*)(F.ws + WS_MOD); LAS float* red = (LAS float*)(F.lds + RING_OFF);
      for (int cg = (int)blockIdx.x; cg < 2 * 96; cg += F.G) {
          const int layer = cg / 96, n0 = (cg % 96) * 64, kr = lane >> 4, c4 = lane & 15;
          f32x4 acc[3]; acc[0] = acc[1] = acc[2] = (f32x4){0.f, 0.f, 0.f, 0.f};
          const float* Wl = F.in[I_WMOD] + (size_t)layer * D * 6 * D;
#pragma unroll 4
          for (int it = 0; it < 32; ++it) { const int k = F.wave * 128 + 4 * it + kr;
              const f32x4 w = *(const GAS f32x4*)(Wl + (size_t)k * 6 * D + n0 + 4 * c4);
              const float c0 = F.in[I_C][k], c1 = F.in[I_C][D + k], c2 = F.in[I_CCTX][k];
              acc[0] += (c0 * sigmoid_f(c0)) * w; acc[1] += (c1 * sigmoid_f(c1)) * w; acc[2] += (c2 * sigmoid_f(c2)) * w; }
#pragma unroll
          for (int s = 0; s < 3; ++s)
#pragma unroll
              for (int j = 0; j < 4; ++j) { float v = acc[s][j]; v += __shfl_xor(v, 16); v += __shfl_xor(v, 32); acc[s][j] = v; }
          if (lane < 16) {
#pragma unroll
              for (int s = 0; s < 3; ++s)
#pragma unroll
                  for (int j = 0; j < 4; ++j) red[(F.wave * 3 + s) * 64 + 4 * c4 + j] = acc[s][j]; }
          __syncthreads();
          if (F.tid < 192) { const int s = F.tid >> 6, col = F.tid & 63; float v = F.in[I_BMOD][layer * 6 * D + n0 + col];
#pragma unroll
              for (int w = 0; w < 8; ++w) v += red[(w * 3 + s) * 64 + col];
              MOD[(size_t)(layer * 3 + s) * 6 * D + n0 + col] = v; }
          __syncthreads();
      } }
}
__device__ __forceinline__ void normmod_row(const float* src, const float* g, const float* sc, const float* sh, bf16* dst, int lane, f32x4 (&t)[4]) {
    const GAS f32x4* xr = (const GAS f32x4*)src + lane; float s = 0.f;
#pragma unroll
    for (int j = 0; j < 4; ++j) { t[j] = xr[64 * j]; s += (t[j].x * t[j].x + t[j].y * t[j].y) + (t[j].z * t[j].z + t[j].w * t[j].w); }
    const float rstd = 1.0f / sqrtf(wave_sum(s) * (1.f / D) + EPS);
    GAS v2u* o8 = (GAS v2u*)dst + lane;
#pragma unroll
    for (int j = 0; j < 4; ++j) { const f32x4 gg = ((const GAS f32x4*)g)[lane + 64 * j], cc = ((const GAS f32x4*)sc)[lane + 64 * j], hh = ((const GAS f32x4*)sh)[lane + 64 * j];
        t[j] = t[j] * rstd * gg * (1.0f + cc) + hh; v2u w; w.x = cvtpk(t[j].x, t[j].y); w.y = cvtpk(t[j].z, t[j].w); o8[64 * j] = w; }
}
__device__ __forceinline__ void ph_normmod(Frame& F, const float* srcL, const float* srcC, int nrows, const float* g, int layer, int sh_off, int sc_off) {
    const int gw = F.vcu * NWAVES + F.wave, NGW = F.G * NWAVES; const float* MOD = (const float*)(F.ws + WS_MOD) + (size_t)layer * 3 * 6 * D; bf16* XN = (bf16*)(F.ws + WS_XN);
    for (int m = gw; m < nrows; m += NGW) { const int s = m < SEQ ? 0 : (m < ML ? 1 : 2); const float* src = m < ML ? srcL + (size_t)m * D : srcC + (size_t)(m - ML) * D; f32x4 t[4];
        normmod_row(src, g, MOD + s * 6 * D + sc_off, MOD + s * 6 * D + sh_off, XN + (size_t)m * D, F.lane, t); }
}
__device__ __forceinline__ void qknorm_rope(float (&f)[8], const float* g, bool rope, int prow, int pcol, float outscale, int lane) {
    float ss = 0.f;
#pragma unroll
    for (int e = 0; e < 8; ++e) ss += f[e] * f[e];
    ss += __shfl_xor(ss, 1); ss += __shfl_xor(ss, 2); ss += __shfl_xor(ss, 4);
    const float rstd = 1.0f / sqrtf(ss * (1.f / 64.f) + EPS); const int j = lane & 7;
    const f32x4 g0 = *(const GAS f32x4*)(g + 8 * j), g1 = *(const GAS f32x4*)(g + 8 * j + 4);
    const float gg[8] = {g0.x, g0.y, g0.z, g0.w, g1.x, g1.y, g1.z, g1.w};
#pragma unroll
    for (int e = 0; e < 8; ++e) f[e] = f[e] * rstd * gg[e];
    if (rope) {
        const float pos = (float)((j < 4) ? prow : pcol), sgn = (j & 2) ? 1.f : -1.f;
#pragma unroll
        for (int e = 0; e < 8; ++e) { const float p = __shfl_xor(f[e], 2); const int i = (j & 1) * 8 + e;
            const float fr = __builtin_amdgcn_exp2f(-(float)i * (13.287712379549449f / 16.f)); float rev = pos * fr * 0.15915494309189535f; rev = rev - floorf(rev);
            f[e] = f[e] * __builtin_amdgcn_cosf(rev) + sgn * p * __builtin_amdgcn_sinf(rev); }
    }
#pragma unroll
    for (int e = 0; e < 8; ++e) f[e] *= outscale;
}
__device__ __forceinline__ void ph3_post0(Frame& F) {
    const int gw = F.vcu * NWAVES + F.wave, NGW = F.G * NWAVES, lane = F.lane; bf16* P0 = (bf16*)(F.ws + WS_P0); bf16* KC = (bf16*)(F.ws + WS_KC0); bf16* VC = (bf16*)(F.ws + WS_VC0);
    for (int m = gw; m < MR; m += NGW) {
        GAS v4u* rowp = (GAS v4u*)(P0 + (size_t)m * E_IN) + lane;
        const v4u u0 = rowp[0], u1 = rowp[64], u2 = rowp[128], u3 = rowp[192];
        float f[8];
        unpack8(u0, f);
#pragma unroll
        for (int e = 0; e < 8; ++e) f[e] = gelu_tanh(f[e]);
        rowp[0] = pack8(f);
        unpack8(u1, f); float ss = 0.f;
#pragma unroll
        for (int e = 0; e < 8; ++e) { f[e] = gelu_tanh(f[e]); ss += f[e] * f[e]; }
        { const float rstd = 1.0f / sqrtf(wave_sum(ss) * (1.f / 512.f) + EPS); const float* g = F.in[I_ANORMG] + 8 * lane;
          const f32x4 g0 = *(const GAS f32x4*)g, g1 = *(const GAS f32x4*)(g + 4); const float gg[8] = {g0.x, g0.y, g0.z, g0.w, g1.x, g1.y, g1.z, g1.w};
#pragma unroll
          for (int e = 0; e < 8; ++e) f[e] = f[e] * rstd * gg[e]; }
        rowp[64] = pack8(f);
        const bool lat = m < ML; const int t = m & (SEQ - 1), prow = t >> 6, pcol = t & 63;
        unpack8(u2, f); qknorm_rope(f, F.in[I_BQNG], lat, prow, pcol, QSCALE, lane); rowp[128] = pack8(f);
        unpack8(u3, f); qknorm_rope(f, F.in[I_BKNG], lat, prow, pcol, 1.0f, lane);
        { const int b = lat ? (m >> 13) : ((m - ML) >> 8), pos = lat ? CTXL + t : ((m - ML) & (CTXL - 1)); const size_t tb = (size_t)(pos >> 6) * 4096; const int pr = pos & 63;
          *(GAS v4u*)(KC + ((size_t)(b * 8 + (lane >> 3)) * KEYS * 64 + tb + (lane & 7) * 512 + pr * 8)) = pack8(f);
          const v4u u4 = rowp[256];
          *(GAS v4u*)(VC + ((size_t)(b * 8 + (lane >> 3)) * KEYS * 64 + tb + ((((lane & 7) >> 2) * 4 + (pr >> 4)) * 64 + (pr & 15) * 4 + (lane & 3)) * 8)) = u4; }
    }
}
__device__ __forceinline__ void gmlp_unit(Frame& F, int chunk) {
    const int lane = F.lane, r32 = lane & 31, hi = lane >> 5, g = F.wave, r0 = chunk * 128;
    const bf16* P0 = (const bf16*)(F.ws + WS_P0); bf16* Y = (bf16*)(F.ws + WS_Y);
    const float* ws = F.in[I_AWS] + (size_t)g * 128 * 128; const float* bs = F.in[I_ABS] + g * 128;
    bf16x8 afr[2][8];
#pragma unroll
    for (int ct = 0; ct < 2; ++ct)
#pragma unroll
        for (int ks = 0; ks < 8; ++ks)
#pragma unroll
            for (int e = 0; e < 8; ++e) afr[ct][ks][e] = (short)P0[(size_t)(r0 + 16 * ks + 8 * hi + e) * E_IN + 512 + 64 * g + 32 * ct + r32];
#pragma unroll 1
    for (int pt = 0; pt < 4; ++pt) {
        f32x16 acc[2]; acc[0] = f32x16{}; acc[1] = f32x16{};
        const float* wp = ws + (size_t)(32 * pt + r32) * 128 + 8 * hi;
#pragma unroll
        for (int ks = 0; ks < 8; ++ks) { const f32x4 w0 = *(const GAS f32x4*)(wp + 16 * ks), w1 = *(const GAS f32x4*)(wp + 16 * ks + 4);
            v4u pk; pk.x = cvtpk(w0.x, w0.y); pk.y = cvtpk(w0.z, w0.w); pk.z = cvtpk(w1.x, w1.y); pk.w = cvtpk(w1.z, w1.w); const bf16x8 bfr = __builtin_bit_cast(bf16x8, pk);
            acc[0] = __builtin_amdgcn_mfma_f32_32x32x16_bf16(afr[0][ks], bfr, acc[0], 0, 0, 0); acc[1] = __builtin_amdgcn_mfma_f32_32x32x16_bf16(afr[1][ks], bfr, acc[1], 0, 0, 0); }
        const int p = 32 * pt + r32; const float bias = bs[p];
#pragma unroll
        for (int ct = 0; ct < 2; ++ct)
#pragma unroll
            for (int rq = 0; rq < 4; ++rq) { const int c0 = 64 * g + 32 * ct + 8 * rq + 4 * hi;
                const v2u uu = *(const GAS v2u*)(P0 + (size_t)(r0 + p) * E_IN + c0);
                v2u o; o.x = cvtpk(bf_lo(uu.x) * (acc[ct][4 * rq + 0] + bias), bf_hi(uu.x) * (acc[ct][4 * rq + 1] + bias)); o.y = cvtpk(bf_lo(uu.y) * (acc[ct][4 * rq + 2] + bias), bf_hi(uu.y) * (acc[ct][4 * rq + 3] + bias));
                *(GAS v2u*)(Y + (size_t)(r0 + p) * D + c0) = o; }
    }
}
__device__ __forceinline__ void ph5_diffout(Frame& F) {
    const int gw = F.vcu * NWAVES + F.wave, NGW = F.G * NWAVES, lane = F.lane; const bf16* OA = (const bf16*)(F.ws + WS_OATT); bf16* Y = (bf16*)(F.ws + WS_Y);
    const float s1 = wave_sum(F.in[I_LQ1][lane] * F.in[I_LK1][lane]), s2 = wave_sum(F.in[I_LQ2][lane] * F.in[I_LK2][lane]);
    const float lam_init = 0.2f, lam = expf(s1) - expf(s2) + lam_init;
    const int h = lane >> 4, comp = (lane >> 3) & 1, i0 = (lane & 7) * 16;
    float gg[16];
#pragma unroll
    for (int q = 0; q < 4; ++q) { const f32x4 gv = *(const GAS f32x4*)(F.in[I_SUBLNG] + i0 + 4 * q); gg[4 * q] = gv.x; gg[4 * q + 1] = gv.y; gg[4 * q + 2] = gv.z; gg[4 * q + 3] = gv.w; }
    for (int m = gw; m < MR; m += NGW) {
        const GAS v4u* rp = (const GAS v4u*)(OA + (size_t)m * D + 16 * lane);
        const v4u a = rp[0], b = rp[1]; float own[16], d[16];
        { float t8[8]; unpack8(a, t8);
#pragma unroll
          for (int e = 0; e < 8; ++e) own[e] = t8[e];
          unpack8(b, t8);
#pragma unroll
          for (int e = 0; e < 8; ++e) own[8 + e] = t8[e]; }
        float ss = 0.f;
#pragma unroll
        for (int e = 0; e < 16; ++e) { const float oth = __shfl_xor(own[e], 8); const float o1 = comp ? oth : own[e], o2 = comp ? own[e] : oth; d[e] = o1 - lam * o2; ss += d[e] * d[e]; }
        ss += __shfl_xor(ss, 1); ss += __shfl_xor(ss, 2); ss += __shfl_xor(ss, 4);
        const float rstd = (1.0f - lam_init) / sqrtf(ss * (1.f / 128.f) + EPS);
        if (comp == 0) { float o8[8]; GAS v4u* yp = (GAS v4u*)(Y + (size_t)m * D + 512 + 128 * h + i0);
#pragma unroll
            for (int e = 0; e < 8; ++e) o8[e] = d[e] * rstd * gg[e];
            yp[0] = pack8(o8);
#pragma unroll
            for (int e = 0; e < 8; ++e) o8[e] = d[8 + e] * rstd * gg[8 + e];
            yp[1] = pack8(o8); }
    }
}
__device__ __forceinline__ void ph12_post1(Frame& F) {
    const int gw = F.vcu * NWAVES + F.wave, NGW = F.G * NWAVES, lane = F.lane; bf16* P1 = (bf16*)(F.ws + WS_P1); bf16* KC = (bf16*)(F.ws + WS_KC1); bf16* VC = (bf16*)(F.ws + WS_VC1);
    for (int m = gw; m < MR; m += NGW) {
        GAS v4u* rowp = (GAS v4u*)(P1 + (size_t)m * O_IN) + lane;
        const v4u u0 = rowp[0], u1 = rowp[64];
        const bool lat = m < ML; const int t = m & (SEQ - 1), prow = t >> 6, pcol = t & 63; float f[8];
        unpack8(u0, f); qknorm_rope(f, F.in[I_CQNG], lat, prow, pcol, QSCALE, lane); if (lat) rowp[0] = pack8(f);
        unpack8(u1, f); qknorm_rope(f, F.in[I_CKNG], lat, prow, pcol, 1.0f, lane);
        { const int b = lat ? (m >> 13) : ((m - ML) >> 8), pos = lat ? CTXL + t : ((m - ML) & (CTXL - 1)); const size_t tb = (size_t)(pos >> 6) * 4096; const int pr = pos & 63, l2 = lane & 15;
          if (lane < 16) *(GAS v4u*)(KC + ((size_t)(b * 2 + (l2 >> 3)) * KEYS * 64 + tb + (l2 & 7) * 512 + pr * 8)) = pack8(f);
          else if (lane < 32) *(GAS v4u*)(VC + ((size_t)(b * 2 + (l2 >> 3)) * KEYS * 64 + tb + ((((l2 & 7) >> 2) * 4 + (pr >> 4)) * 64 + (pr & 15) * 4 + (l2 & 3)) * 8)) = u1; }
    }
}
__device__ __forceinline__ void lru_ab(float r, float ix, float sp8, float& a, float& b) {
    const float la = -r * sp8; a = __builtin_amdgcn_exp2f(la * 1.4426950408889634f); b = sqrtf(-expm1f(2.0f * la)) * ix;
}
__device__ __forceinline__ bool seq_start(int r) { return r < ML ? (r & (SEQ - 1)) == 0 : ((r - ML) & (CTXL - 1)) == 0; }
__device__ __forceinline__ void scan_prep_unit(Frame& F, int cid) {
    constexpr int XDS = 520;
    const int r0 = cid * 64, tid = F.tid, lane = F.lane, r32 = lane & 31, hi = lane >> 5;
    const bf16* P1 = (const bf16*)(F.ws + WS_P1); LAS bf16* XD = (LAS bf16*)(F.lds + RING_OFF);
    f16* PL = (f16*)(F.ws + WS_RI);
    { const int ch = tid; const float* cw = F.in[I_CONVW]; const float w0 = cw[ch], w1 = cw[512 + ch], w2 = cw[1024 + ch], w3 = cw[1536 + ch], cb = F.in[I_CONVB][ch];
      const bool st = seq_start(r0), en = seq_start(r0 + 64) || (r0 + 64 == MR);
      const bf16* xp = P1 + (size_t)r0 * O_IN + 1280 + ch;
      float xm2 = st ? 0.f : bf2f(xp[-2 * O_IN]), xm1 = st ? 0.f : bf2f(xp[-O_IN]), x0 = bf2f(xp[0]);
#pragma unroll 8
      for (int t = 0; t < 64; ++t) { const float xn = (t == 63) ? (en ? 0.f : bf2f(xp[(size_t)64 * O_IN])) : bf2f(xp[(size_t)(t + 1) * O_IN]);
          XD[t * XDS + ch] = f2bf16(w0 * xm2 + w1 * xm1 + w2 * x0 + w3 * xn + cb); xm2 = xm1; xm1 = x0; x0 = xn; } }
    __syncthreads();
    { const int n = F.wave; const bf16* WG = (const bf16*)(F.ws + WS_WG);
      bf16x8 afr[2][4];
#pragma unroll
      for (int mt = 0; mt < 2; ++mt)
#pragma unroll
          for (int ks = 0; ks < 4; ++ks) afr[mt][ks] = *(const LAS bf16x8*)(XD + (32 * mt + r32) * XDS + 64 * n + 16 * ks + 8 * hi);
#pragma unroll 1
      for (int ct = 0; ct < 8; ++ct) { const int d = ct >> 2, mat = (ct >> 1) & 1, half = ct & 1;
          f32x16 acc[2]; acc[0] = f32x16{}; acc[1] = f32x16{};
          const bf16* wp = WG + ((size_t)(((d * 2 + mat) * 8 + n) * 64 + 32 * half + r32)) * 64 + 8 * hi;
#pragma unroll
          for (int ks = 0; ks < 4; ++ks) { const bf16x8 bfr = *(const GAS bf16x8*)(wp + 16 * ks);
              acc[0] = __builtin_amdgcn_mfma_f32_32x32x16_bf16(afr[0][ks], bfr, acc[0], 0, 0, 0); acc[1] = __builtin_amdgcn_mfma_f32_32x32x16_bf16(afr[1][ks], bfr, acc[1], 0, 0, 0); }
          const int ch = 64 * n + 32 * half + r32; const float bias = (mat ? F.in[I_DBX] : F.in[I_DBA])[d * 512 + ch];
          f16* pl = PL + (size_t)(mat * 2 + d) * MR * 512 + (size_t)r0 * 512 + ch;
#pragma unroll
          for (int mt = 0; mt < 2; ++mt)
#pragma unroll
              for (int r = 0; r < 16; ++r) { const int row = 32 * mt + crow16(r, hi); float s = sigmoid_f(acc[mt][r] + bias); if (mat) s *= bf2f(XD[row * XDS + ch]); pl[(size_t)row * 512] = (f16)s; }
      } }
    VM_WAIT(); __syncthreads();
    { const int ch = tid; float* AGG = (float*)(F.ws + WS_AGG);
#pragma unroll
      for (int d = 0; d < 2; ++d) { const float lam = F.in[I_DLAM][d * 512 + ch]; const float sp8 = 8.0f * log1pf(expf(-lam));
          const f16* pr = PL + (size_t)d * MR * 512 + (size_t)r0 * 512 + ch; const f16* pi = PL + (size_t)(2 + d) * MR * 512 + (size_t)r0 * 512 + ch;
          float A = 1.f, h = 0.f;
#pragma unroll 8
          for (int tt = 0; tt < 64; ++tt) { const int t = d ? 63 - tt : tt; float a, b; lru_ab((float)pr[(size_t)t * 512], (float)pi[(size_t)t * 512], sp8, a, b); h = a * h + b; A *= a; }
          AGG[((size_t)(d * NCHUNK + cid) * 2 + 0) * 512 + ch] = A; AGG[((size_t)(d * NCHUNK + cid) * 2 + 1) * 512 + ch] = h; } }
    __syncthreads();
}
__device__ __forceinline__ void scan_fix_unit(Frame& F, int cid) {
    const int ch = F.tid, b = cid >> 7, j = cid & 127, r0 = cid * 64;
    const float* AGG = (const float*)(F.ws + WS_AGG); const f16* PL = (const f16*)(F.ws + WS_RI); const bf16* P1 = (const bf16*)(F.ws + WS_P1); bf16* Y = (bf16*)(F.ws + WS_Y);
    LAS float* HF = (LAS float*)(F.lds + RING_OFF);
    const float* A0 = AGG + ch; const float* A1 = AGG + (size_t)NCHUNK * 1024 + ch;
    float hf = 0.f, hb = 0.f;
#pragma unroll
    for (int q = 0; q < 4; ++q) { const int c = 256 + 4 * b + q; hf = A0[(size_t)c * 1024] * hf + A0[(size_t)c * 1024 + 512]; }
#pragma unroll 8
    for (int q = 0; q < j; ++q) { const int c = 128 * b + q; hf = A0[(size_t)c * 1024] * hf + A0[(size_t)c * 1024 + 512]; }
#pragma unroll
    for (int q = 3; q >= 0; --q) { const int c = 256 + 4 * b + q; hb = A1[(size_t)c * 1024] * hb + A1[(size_t)c * 1024 + 512]; }
#pragma unroll 8
    for (int q = 127; q > j; --q) { const int c = 128 * b + q; hb = A1[(size_t)c * 1024] * hb + A1[(size_t)c * 1024 + 512]; }
    const float sp0 = 8.0f * log1pf(expf(-F.in[I_DLAM][ch])), sp1 = 8.0f * log1pf(expf(-F.in[I_DLAM][512 + ch]));
    { const f16* pr = PL + (size_t)r0 * 512 + ch; const f16* pi = PL + (size_t)2 * MR * 512 + (size_t)r0 * 512 + ch;
#pragma unroll 8
      for (int t = 0; t < 64; ++t) { float a, bb; lru_ab((float)pr[(size_t)t * 512], (float)pi[(size_t)t * 512], sp0, a, bb); hf = a * hf + bb; HF[t * 512 + ch] = hf; } }
    { const f16* pr = PL + (size_t)MR * 512 + (size_t)r0 * 512 + ch; const f16* pi = PL + (size_t)3 * MR * 512 + (size_t)r0 * 512 + ch;
#pragma unroll 8
      for (int t = 63; t >= 0; --t) { float a, bb; lru_ab((float)pr[(size_t)t * 512], (float)pi[(size_t)t * 512], sp1, a, bb); hb = a * hb + bb;
          const float gt = bf2f(P1[(size_t)(r0 + t) * O_IN + 768 + ch]); Y[(size_t)(r0 + t) * D + 512 + ch] = f2bf16((HF[t * 512 + ch] + hb) * gelu_tanh(gt)); } }
    LDS_WAIT(); __syncthreads();
}
__device__ __forceinline__ void ph15_router(Frame& F) {
    LAS float* WR = (LAS float*)(F.lds + RING_OFF);
    LAS int* lcnt = (LAS int*)(F.lds + RING_OFF + 32768); LAS int* lbase = lcnt + 8; LAS int* rec = lcnt + 16;
    const int lane = F.lane; const float* MOD = (const float*)(F.ws + WS_MOD) + (size_t)3 * 6 * D; bf16* XN = (bf16*)(F.ws + WS_XN); int* TOK = (int*)(F.ws + WS_TOK);
    for (int i = F.tid; i < 1024 * 8 / 4; i += NWAVES * 64) ((LAS f32x4*)WR)[i] = ((const GAS f32x4*)F.in[I_RW])[i];
    __syncthreads();
    for (int rb = F.vcu; rb < ML / 64; rb += F.G) {
        if (F.tid < 8) lcnt[F.tid] = 0;
        __syncthreads();
#pragma unroll 1
        for (int i = 0; i < 8; ++i) { const int m = rb * 64 + F.wave * 8 + i, s = m >> 13; f32x4 t[4];
            normmod_row(F.out + (size_t)m * D, F.in[I_NFFNG] + D, MOD + s * 6 * D + 4 * D, MOD + s * 6 * D + 3 * D, XN + (size_t)m * D, lane, t);
            float lg[8];
#pragma unroll
            for (int e = 0; e < 8; ++e) lg[e] = 0.f;
#pragma unroll
            for (int j = 0; j < 4; ++j)
#pragma unroll
                for (int k = 0; k < 4; ++k) { const int c = 4 * lane + 256 * j + k; const f32x4 w0 = *(const LAS f32x4*)(WR + c * 8), w1 = *(const LAS f32x4*)(WR + c * 8 + 4); const float tv = t[j][k];
                    lg[0] += tv * w0.x; lg[1] += tv * w0.y; lg[2] += tv * w0.z; lg[3] += tv * w0.w; lg[4] += tv * w1.x; lg[5] += tv * w1.y; lg[6] += tv * w1.z; lg[7] += tv * w1.w; }
#pragma unroll
            for (int e = 0; e < 8; ++e) lg[e] = wave_sum(lg[e]) + F.in[I_RB][e];
            int e1 = 0; float v1 = lg[0];
#pragma unroll
            for (int e = 1; e < 8; ++e) if (lg[e] > v1) { v1 = lg[e]; e1 = e; }
            int e2 = -1; float v2 = -INFINITY;
#pragma unroll
            for (int e = 0; e < 8; ++e) if (e != e1 && lg[e] > v2) { v2 = lg[e]; e2 = e; }
            const float g1 = 1.0f / (1.0f + expf(v2 - v1)), g2 = 1.0f - g1;
            if (lane == 0) { LAS int* rc = rec + (F.wave * 8 + i) * 6; rc[0] = e1; rc[1] = e2; rc[2] = atomicAdd((int*)(lcnt + e1), 1); rc[3] = atomicAdd((int*)(lcnt + e2), 1); rc[4] = __float_as_int(g1); rc[5] = __float_as_int(g2); }
        }
        __syncthreads();
        if (F.tid < 8) lbase[F.tid] = (int)__hip_atomic_fetch_add((unsigned*)(F.ctl + CW_CNT + 64 * F.tid), (unsigned)lcnt[F.tid], __ATOMIC_RELAXED, __HIP_MEMORY_SCOPE_AGENT);
        __syncthreads();
        if (F.tid < 64) { const LAS int* rc = rec + F.tid * 6; int* tk = TOK + (size_t)(rb * 64 + F.tid) * 6;
            tk[0] = rc[0]; tk[1] = rc[1]; tk[2] = lbase[rc[0]] + rc[2]; tk[3] = lbase[rc[1]] + rc[3]; tk[4] = rc[4]; tk[5] = rc[5]; }
        __syncthreads();
    }
}
__device__ __forceinline__ void moe_offsets(Frame& F, int (&off)[9]) {
    int o = 0;
#pragma unroll
    for (int e = 0; e < 8; ++e) { off[e] = o; const int c = (int)__hip_atomic_load((unsigned*)(F.ctl + CW_CNT + 64 * e), __ATOMIC_RELAXED, __HIP_MEMORY_SCOPE_AGENT); o += (c + 255) & ~255; }
    off[8] = o;
}
__device__ __forceinline__ void ph16_gather(Frame& F) {
    int off[9]; moe_offsets(F, off);
    const int gw = F.vcu * NWAVES + F.wave, NGW = F.G * NWAVES, lane = F.lane; const bf16* XN = (const bf16*)(F.ws + WS_XN); bf16* XG = (bf16*)(F.ws + WS_XG); const int* TOK = (const int*)(F.ws + WS_TOK);
    for (int p = gw; p < 2 * ML; p += NGW) { const int tok = p >> 1, k = p & 1; const int e = TOK[(size_t)tok * 6 + k], pos = TOK[(size_t)tok * 6 + 2 + k];
        int base = 0;
#pragma unroll
        for (int q = 0; q < 8; ++q) base = (e == q) ? off[q] : base;
        const GAS v4u* src = (const GAS v4u*)(XN + (size_t)tok * D) + lane; GAS v4u* dst = (GAS v4u*)(XG + (size_t)(base + pos) * D) + lane;
        const v4u a = src[0], b = src[64]; dst[0] = a; dst[64] = b; }
}
__device__ __forceinline__ int moe_tables(Frame& F) {
    int off[9]; moe_offsets(F, off); LAS int* pexp = (LAS int*)(F.lds + PEXP_OFF);
    if (F.tid < MOE_PAN) { const int r = F.tid * 256; int e = 0;
#pragma unroll
        for (int q = 1; q < 8; ++q) e = (r >= off[q]) ? q : e;
        pexp[F.tid] = e; }
    __syncthreads();
    return off[8] / 256;
}
__device__ __forceinline__ void ph19_combine(Frame& F) {
    int off[9]; moe_offsets(F, off);
    const int gw = F.vcu * NWAVES + F.wave, NGW = F.G * NWAVES, lane = F.lane; const bf16* YG = (const bf16*)(F.ws + WS_YG); const int* TOK = (const int*)(F.ws + WS_TOK);
    const float* MOD = (const float*)(F.ws + WS_MOD) + (size_t)3 * 6 * D;
    for (int m = gw; m < ML; m += NGW) { const int* tk = TOK + (size_t)m * 6; const int e1 = tk[0], e2 = tk[1]; int b1 = 0, b2 = 0;
#pragma unroll
        for (int q = 0; q < 8; ++q) { b1 = (e1 == q) ? off[q] : b1; b2 = (e2 == q) ? off[q] : b2; }
        const float g1 = __int_as_float(tk[4]), g2 = __int_as_float(tk[5]); const float* gp = MOD + (m >> 13) * 6 * D + 5 * D;
        const GAS v2u* y1 = (const GAS v2u*)(YG + (size_t)(b1 + tk[2]) * D) + lane; const GAS v2u* y2 = (const GAS v2u*)(YG + (size_t)(b2 + tk[3]) * D) + lane;
        GAS f32x4* o = (GAS f32x4*)(F.out + (size_t)m * D) + lane;
#pragma unroll
        for (int j = 0; j < 4; ++j) { const v2u a = y1[64 * j], b = y2[64 * j]; const f32x4 gv = ((const GAS f32x4*)gp)[lane + 64 * j]; f32x4 x = o[64 * j];
            x.x += gv.x * (g1 * bf_lo(a.x) + g2 * bf_lo(b.x)); x.y += gv.y * (g1 * bf_hi(a.x) + g2 * bf_hi(b.x)); x.z += gv.z * (g1 * bf_lo(a.y) + g2 * bf_lo(b.y)); x.w += gv.w * (g1 * bf_hi(a.y) + g2 * bf_hi(b.y));
            o[64 * j] = x; } }
}
struct Args { const float* in[38]; float* out; unsigned char* ws; int ph_lo, ph_hi; };
__global__ void __launch_bounds__(NWAVES * 64, 2) mk_fwd(Args args) {
    extern __shared__ __attribute__((aligned(16))) unsigned char lds[];
    Frame F;
    F.lds = (LAS unsigned char*)lds;
    F.MISC = (volatile LAS unsigned*)(F.lds + MISC_OFF);
    F.tid = threadIdx.x; F.lane = F.tid & 63; F.wave = __builtin_amdgcn_readfirstlane(F.tid >> 6);
    F.G = gridDim.x; { const int bx = blockIdx.x; F.vcu = (F.G % 8 == 0) ? (bx % 8) * (F.G / 8) + bx / 8 : bx; }
    F.ws = args.ws; F.out = args.out; F.ctl = (gu32*)(args.ws + WS_CTL);
#pragma unroll
    for (int i = 0; i < 38; ++i) F.in[i] = args.in[i];
    for (int u = F.tid; u < (LDS_BYTES - LDSCTL_OFF) / 4; u += NWAVES * 64) ((LAS unsigned*)(F.lds + LDSCTL_OFF))[u] = 0u;
    __syncthreads();
    XcdBarrier bar; bar.bar = (unsigned*)(F.ctl + CW_BAR); bar.x = 0; bar.st = nullptr;
    if (MK_ONE_LAUNCH) bar = xcd_barrier_post((unsigned*)(F.ctl + CW_BAR), F.MISC + 8);
#define GRID_BAR() do { if (MK_ONE_LAUNCH) xcd_barrier(bar); } while (0)
    const int lo = args.ph_lo, hi = args.ph_hi;
#define IN(k) (lo <= (k) && (k) < hi)
#define BOTH(k) (IN(k) && IN((k) + 1))
#ifndef MK_REP_MASK
#define MK_REP_MASK 0
#endif
#define REP(k) for (int rep_ = 0; rep_ < (((MK_REP_MASK >> (k)) & 1) ? 2 : 1); ++rep_)
    unsigned char* ws = args.ws;
    bf16* XN = (bf16*)(ws + WS_XN); bf16* Y = (bf16*)(ws + WS_Y); bf16* P0 = (bf16*)(ws + WS_P0); bf16* P1 = (bf16*)(ws + WS_P1); bf16* OA = (bf16*)(ws + WS_OATT); bf16* Hb = (bf16*)(ws + WS_H);
    float* XR = (float*)(ws + WS_XR); const float* MOD = (const float*)(ws + WS_MOD);
    using ABF = attn_body::bf16;

    if (IN(0)) { REP(0) { ph0_prologue(F); __syncthreads(); } if (BOTH(0)) GRID_BAR(); }
    if (IN(1)) { REP(1) ph_normmod(F, F.in[I_X], F.in[I_CTX], MR, F.in[I_NMIXG], 0, 0, D); if (BOTH(1)) GRID_BAR(); }
    if (IN(2)) {
        pg8::Gemm g{XN, (const bf16*)(ws + WS_WE), MR, E_IN, D}; pg8::StaticOrder S; S.init(MR, E_IN, F.G, (int)blockIdx.x);
        pg8::EpiBf16<0> E{P0, E_IN, nullptr, 0, 0, 1.f};
        REP(2) pg8::gemm_phase<pg8::EpiBf16<0>, pg8::StaticOrder, PG8_ALIGN, PG8_SP2>(F.lds + RING_OFF, g, S, E);
        if (BOTH(2)) GRID_BAR();
    }
    if (IN(3)) { ph3_post0(F); if (BOTH(3)) GRID_BAR(); }
    if (IN(4)) {
        REP(4) for (int i = 0;; ++i) { const int L = i * F.G + F.vcu; if (L >= 512 + 16) break;
            const bool lat = L < 512; const int bh = lat ? (L >> 5) : (L - 512), qb = lat ? (L & 31) : 0, b = bh >> 3, hq = bh & 7, h = hq >> 1;
            const size_t qrow0 = lat ? (size_t)b * SEQ + (size_t)qb * 256 : (size_t)(ML + b * CTXL);
            const ABF* Ks = (const ABF*)(ws + WS_KC0) + (size_t)(b * 8 + hq) * KEYS * 64; const ABF* Vs = (const ABF*)(ws + WS_VC0) + (size_t)(b * 8 + 2 * h) * KEYS * 64;
            attn_body::attn_unit2<8>((const ABF*)(P0 + qrow0 * E_IN + 1024 + 64 * hq), E_IN, Ks, Vs, Vs + (size_t)KEYS * 64, (ABF*)(OA + qrow0 * D + 128 * hq), D, lat ? 132 : 4, lat ? (F.vcu & 31) * 4 : 0, (char*)lds + RING_OFF); }
        REP(4) for (int c = F.vcu - 32; c >= 0 && c < MR / 128; c += F.G) gmlp_unit(F, c);
        if (BOTH(4)) GRID_BAR();
    }
    if (IN(5)) { REP(5) ph5_diffout(F); if (BOTH(5)) GRID_BAR(); }
    if (IN(6)) {
        pg8::Gemm g{Y, (const bf16*)(ws + WS_WO0), MR, D, D}; pg8::StaticOrder S; S.init(MR, D, F.G, (int)blockIdx.x);
        pg8::EpiResGate E{F.in[I_X], F.in[I_CTX], XR, MOD + 2 * D};
        REP(6) pg8::gemm_phase<pg8::EpiResGate, pg8::StaticOrder, PG8_ALIGN, PG8_SP2>(F.lds + RING_OFF, g, S, E);
        if (BOTH(6)) GRID_BAR();
    }
    if (IN(7)) { REP(7) ph_normmod(F, XR, XR + (size_t)ML * D, MR, F.in[I_NFFNG], 0, 3 * D, 4 * D); if (BOTH(7)) GRID_BAR(); }
    if (IN(8)) {
        pg8::Gemm g{XN, (const bf16*)(ws + WS_WF13), MR, FF2, D}; pg8::StaticOrder S; S.init(MR, FF2, F.G, (int)blockIdx.x);
        pg8::EpiSwiGLU E{Hb, FF, FF2 / 256};
        REP(8) pg8::gemm_phase<pg8::EpiSwiGLU, pg8::StaticOrder, PG8_ALIGN, PG8_SP2>(F.lds + RING_OFF, g, S, E);
        if (BOTH(8)) GRID_BAR();
    }
    if (IN(9)) {
        pg8::Gemm g{Hb, (const bf16*)(ws + WS_WF2), MR, D, FF}; pg8::StaticOrder S; S.init(MR, D, F.G, (int)blockIdx.x);
        pg8::EpiResGate E{XR, XR + (size_t)ML * D, XR, MOD + 5 * D};
        REP(9) pg8::gemm_phase<pg8::EpiResGate, pg8::StaticOrder, PG8_ALIGN, PG8_SP2>(F.lds + RING_OFF, g, S, E);
        if (BOTH(9)) GRID_BAR();
    }
    if (IN(10)) { REP(10) ph_normmod(F, XR, XR + (size_t)ML * D, MR, F.in[I_NMIXG] + D, 1, 0, D); if (BOTH(10)) GRID_BAR(); }
    if (IN(11)) {
        pg8::Gemm g{XN, (const bf16*)(ws + WS_WOI), MR, O_IN, D}; pg8::StaticOrder S; S.init(MR, O_IN, F.G, (int)blockIdx.x);
        pg8::EpiBf16<0> E{P1, O_IN, nullptr, 0, 0, 1.f};
        REP(11) pg8::gemm_phase<pg8::EpiBf16<0>, pg8::StaticOrder, PG8_ALIGN, PG8_SP2>(F.lds + RING_OFF, g, S, E);
        if (BOTH(11)) GRID_BAR();
    }
    if (IN(12)) {
        ph12_post1(F);
        REP(12) for (int c = F.vcu; c < NCHUNK; c += F.G) scan_prep_unit(F, c);
        if (BOTH(12)) GRID_BAR();
    }
    if (IN(13)) {
        REP(13) for (int c = F.vcu; c < ML / 64; c += F.G) scan_fix_unit(F, c);
        REP(13) for (int i = 0;; ++i) { const int L = i * F.G + F.vcu; if (L >= 512) break;
            const int bh = L >> 5, qb = L & 31, b = bh >> 3, hq = bh & 7, kv = hq >> 2;
            const size_t crow0 = (size_t)(ML + b * CTXL), lrow0 = (size_t)b * SEQ, qrow0 = lrow0 + (size_t)qb * 256;
            const ABF* Ks = (const ABF*)(ws + WS_KC1) + (size_t)(b * 2 + kv) * KEYS * 64; const ABF* Vs = (const ABF*)(ws + WS_VC1) + (size_t)(b * 2 + kv) * KEYS * 64;
            attn_body::attn_unit<8, true>((const ABF*)(P1 + qrow0 * O_IN + 64 * hq), O_IN, Ks, Ks + 4 * 4096, 64, Vs, Vs + 4 * 4096, 64,
                                          (ABF*)(Y + qrow0 * D + 64 * hq), D, 132, 4, (F.vcu & 31) * 4, (char*)lds + RING_OFF); }
        if (BOTH(13)) GRID_BAR();
    }
    if (IN(14)) {
        pg8::Gemm g{Y, (const bf16*)(ws + WS_WO1), ML, D, D}; pg8::StaticOrder S; S.init(ML, D, F.G, (int)blockIdx.x);
        pg8::EpiResGate E{XR, XR, F.out, MOD + 3 * 6 * D + 2 * D};
        REP(14) pg8::gemm_phase<pg8::EpiResGate, pg8::StaticOrder, PG8_ALIGN, PG8_SP2>(F.lds + RING_OFF, g, S, E);
        if (BOTH(14)) GRID_BAR();
    }
    if (IN(15)) { ph15_router(F); if (BOTH(15)) GRID_BAR(); }
    if (IN(16)) { REP(16) ph16_gather(F); if (BOTH(16)) GRID_BAR(); }
    if (IN(17)) {
        const int npan = moe_tables(F);
        pg8::Gemm g{(const bf16*)(ws + WS_XG), (const bf16*)(ws + WS_WM13), MOE_ROWS, NEXP * FF2, D}; pg8::MoeOrder S{npan, FF2 / 256, F.G, F.vcu, (const LAS int*)(F.lds + PEXP_OFF)};
        pg8::EpiSwiGLU E{(bf16*)(ws + WS_HG), FF, FF2 / 256};
        REP(17) pg8::gemm_phase<pg8::EpiSwiGLU, pg8::MoeOrder, PG8_ALIGN, PG8_SP2>(F.lds + RING_OFF, g, S, E);
        if (BOTH(17)) GRID_BAR();
    }
    if (IN(18)) {
        const int npan = moe_tables(F);
        pg8::Gemm g{(const bf16*)(ws + WS_HG), (const bf16*)(ws + WS_WM2), MOE_ROWS, NEXP * D, FF}; pg8::MoeOrder S{npan, D / 256, F.G, F.vcu, (const LAS int*)(F.lds + PEXP_OFF)};
        pg8::EpiBf16<0> E{(bf16*)(ws + WS_YG), D, nullptr, D, 0, 1.f};
        REP(18) pg8::gemm_phase<pg8::EpiBf16<0>, pg8::MoeOrder, PG8_ALIGN, PG8_SP2>(F.lds + RING_OFF, g, S, E);
        if (BOTH(18)) GRID_BAR();
    }
    if (IN(19)) { ph19_combine(F); }
#undef IN
#undef BOTH
#undef GRID_BAR
}

extern "C" void kernel_launch(void* const* d_in, const int* in_sizes, int n_in, void* d_out, int out_size, void* d_ws, size_t ws_size, hipStream_t stream) {
    static int grid = 0;
    if (grid == 0) {
        if (n_in != 38 || in_sizes[0] != ML * D || out_size != ML * D || ws_size < WS_END) { fprintf(stderr, "kernel_launch: built for 38 inputs, x/out of %d floats, >= %zu bytes of workspace; got n_in %d, in0 %d, out %d, ws %zu; nothing launched\n", ML * D, (size_t)WS_END, n_in, n_in > 0 ? in_sizes[0] : -1, out_size, ws_size); grid = -1; return; }
        int dev = 0, cus = 0, per_cu = 0;
        if (hipGetDevice(&dev) != hipSuccess || hipDeviceGetAttribute(&cus, hipDeviceAttributeMultiprocessorCount, dev) != hipSuccess) { fprintf(stderr, "kernel_launch: device query failed\n"); grid = -1; return; }
        if (hipFuncSetAttribute((const void*)mk_fwd, hipFuncAttributeMaxDynamicSharedMemorySize, LDS_BYTES) != hipSuccess) { fprintf(stderr, "kernel_launch: hipFuncSetAttribute failed\n"); grid = -1; return; }
        if (hipOccupancyMaxActiveBlocksPerMultiprocessor(&per_cu, (const void*)mk_fwd, NWAVES * 64, LDS_BYTES) != hipSuccess || per_cu < 1) fprintf(stderr, "kernel_launch: note: occupancy query reports %d workgroups per CU\n", per_cu);
        (void)hipGetLastError();
        grid = cus;
    }
    if (grid < 0) return;
    if (hipMemsetAsync((char*)d_ws + WS_CTL, 0, CTL_ZERO_BYTES, stream) != hipSuccess) { fprintf(stderr, "kernel_launch: hipMemsetAsync failed\n"); return; }
    Args a{};
    for (int i = 0; i < 38; ++i) a.in[i] = (const float*)d_in[i];
    a.out = (float*)d_out; a.ws = (unsigned char*)d_ws;
#if MK_ONE_LAUNCH
    a.ph_lo = 0; a.ph_hi = NPH;
    hipLaunchKernelGGL(mk_fwd, dim3(grid), dim3(NWAVES * 64), LDS_BYTES, stream, a);
#else
    for (int ph = 0; ph < NPH; ++ph) { a.ph_lo = ph; a.ph_hi = ph + 1; hipLaunchKernelGGL(mk_fwd, dim3(grid), dim3(NWAVES * 64), LDS_BYTES, stream, a); }
#endif
    const hipError_t le = hipPeekAtLastError();
    if (le != hipSuccess) fprintf(stderr, "kernel_launch: launch failed: %s\n", hipGetErrorName(le));
}
```

```cpp
#include <hip/hip_runtime.h>
#include <cstdio>
#include <cstdint>
#include <cmath>
namespace pg8 {
#define PG8_LAS __attribute__((address_space(3)))
typedef unsigned short bf16_t;
typedef short bf16x8 __attribute__((ext_vector_type(8)));
typedef float f32x4 __attribute__((ext_vector_type(4)));
typedef unsigned u32x4 __attribute__((ext_vector_type(4)));
typedef int i32x4 __attribute__((ext_vector_type(4)));
typedef int i32x8 __attribute__((ext_vector_type(8)));
typedef unsigned u32x2 __attribute__((ext_vector_type(2)));
constexpr int BM = 256, BK = 64, HALF = 128, HTB = HALF * BK * 2  , STAGE_BYTES = 8 * HTB, NXCD = 8, WGM = 8;

__host__ __device__ __forceinline__ int lds_byte(int r, int c) { const int st = (r >> 4) * 2 + (c >> 5), rr = r & 15, cc = c & 31, ob = rr * 64 + cc * 2; return st * 1024 + (ob ^ (((ob >> 9) & 1) << 5)); }
__host__ __device__ __forceinline__ void stage_rc(int b, int& R, int& C) { const int st = b / 1024, sb = b % 1024, swz = sb ^ (((sb >> 9) & 1) << 5); R = (st >> 1) * 16 + swz / 64; C = (st & 1) * 32 + (swz % 64) / 2; }
__host__ __device__ __forceinline__ int perm32(int rho) { const int n = rho >> 4, i = rho & 15; return 8 * (i >> 2) + 4 * n + (i & 3); }

struct Unit { int pm, pn; };
struct Gemm { const bf16_t* A; const bf16_t* Bt; int M, N, K; };

struct StaticOrder {
    int nM, nN, nwg, G, c;
    __host__ __device__ void init(int M, int N, int G_, int c_) { nM = M / BM; nN = N / BM; nwg = nM * nN; G = G_; c = c_; }
    __host__ __device__ bool next(int i, Unit& u) const {
        const long L = (long)i * G + c; if (L >= nwg) return false;
        int wgid = (int)L; { const int q = nwg / NXCD, r = nwg % NXCD, xcd = wgid % NXCD, off = wgid / NXCD; wgid = (xcd < r ? xcd * (q + 1) : r * (q + 1) + (xcd - r) * q) + off; }
        const int nig = WGM * nN, gid = wgid / nig, fm = gid * WGM, gsz = (nM - fm) < WGM ? (nM - fm) : WGM;
        u.pm = fm + ((wgid % nig) % gsz); u.pn = (wgid % nig) / gsz; return true;
    }
    __device__ __forceinline__ void a_ready(const Unit&) const {}
    __device__ __forceinline__ void done(const Unit&) const {}
};

__device__ __forceinline__ unsigned cvt_pk_bf16(float lo, float hi) { unsigned r; asm volatile("v_cvt_pk_bf16_f32 %0, %1, %2" : "=v"(r) : "v"(lo), "v"(hi)); return r; }
typedef float f32x2 __attribute__((ext_vector_type(2)));
__device__ __forceinline__ f32x2 gelu_pk(f32x2 v) {
    const f32x2 av = __builtin_elementwise_abs(v), d = av * 0.2316418882f + 1.0f;
    f32x2 t; t.x = __builtin_amdgcn_rcpf(d.x); t.y = __builtin_amdgcn_rcpf(d.y);
    f32x2 q = t * 0.5307027145f + (-0.7265760135f); q = q * t + 0.7107068705f; q = q * t + (-0.142248368f); q = q * t + 0.127414796f; q = q * t;
    const f32x2 s = (v * v) * (-0.72134752044f);
    f32x2 e; e.x = __builtin_amdgcn_exp2f(s.x); e.y = __builtin_amdgcn_exp2f(s.y);
    const f32x2 m = v * (q * e), r = v - m;
    f32x2 o; o.x = v.x < 0.f ? m.x : r.x; o.y = v.y < 0.f ? m.y : r.y; return o;
}

template <int ACT  > struct EpiBf16 {
    static constexpr bool PERM = true, AFTER_DRAIN = false; static_assert(ACT == 0 || ACT == 1, "EpiBf16: ACT is 0 (none) or 1 (gelu_pk)");
    bf16_t* O; int ldc; const float* bias; int split_cols; size_t split_stride; float scale0;
    __device__ __forceinline__ void operator()(const f32x4 (&acc)[2][2][4][2], const Unit& u, int wr, int wc, int fr, int fq) const {
        const int row0 = u.pm * BM + wr * 64 + fr; int colt = u.pn * BM; bf16_t* base = O;
        float sc = 1.f; if (split_cols) { const int t = colt / split_cols; base += (size_t)t * split_stride; colt -= t * split_cols; if (t == 0) sc = scale0; }
        const int col0 = colt + wc * 32 + 8 * fq, bcol0 = u.pn * BM + wc * 32 + 8 * fq;
        f32x4 bv[2][2];
#pragma unroll
        for (int bj = 0; bj < 2; ++bj)
#pragma unroll
            for (int n = 0; n < 2; ++n) bv[bj][n] = bias ? *(const f32x4*)(bias + bcol0 + bj * HALF + 4 * n) : (f32x4){0.f, 0.f, 0.f, 0.f};
#pragma unroll
        for (int ai = 0; ai < 2; ++ai)
#pragma unroll
            for (int m = 0; m < 4; ++m) { bf16_t* rowp = base + (size_t)(row0 + ai * HALF + m * 16) * ldc + col0;
#pragma unroll
                for (int bj = 0; bj < 2; ++bj) { f32x4 v0 = acc[ai][bj][m][0] + bv[bj][0], v1 = acc[ai][bj][m][1] + bv[bj][1];
                    if (ACT == 1) { f32x2 a = gelu_pk((f32x2){v0[0], v0[1]}), b = gelu_pk((f32x2){v0[2], v0[3]}), c = gelu_pk((f32x2){v1[0], v1[1]}), d = gelu_pk((f32x2){v1[2], v1[3]});
                        v0 = (f32x4){a.x, a.y, b.x, b.y}; v1 = (f32x4){c.x, c.y, d.x, d.y}; }
                    v0 = v0 * sc; v1 = v1 * sc; u32x4 w; w.x = cvt_pk_bf16(v0[0], v0[1]); w.y = cvt_pk_bf16(v0[2], v0[3]); w.z = cvt_pk_bf16(v1[0], v1[1]); w.w = cvt_pk_bf16(v1[2], v1[3]);
                    *(u32x4*)(rowp + bj * HALF) = w; } }
    }
};
struct EpiResGate {
    static constexpr bool PERM = false, AFTER_DRAIN = false;
    const float* baseL; const float* baseC; float* out; const float* gate;
    __device__ __forceinline__ void operator()(const f32x4 (&acc)[2][2][4][2], const Unit& u, int wr, int wc, int fr, int fq) const {
        const int s = u.pm < 32 ? 0 : (u.pm < 64 ? 1 : 2);
        const float* gp = gate + s * 6144;
        const float* base = u.pm < 64 ? baseL + (size_t)u.pm * BM * 1024 : baseC + (size_t)(u.pm - 64) * BM * 1024;
        float* o = out + (size_t)u.pm * BM * 1024;
        const int col0 = u.pn * BM + wc * 32 + 4 * fq;
        f32x4 gv[2][2];
#pragma unroll
        for (int bj = 0; bj < 2; ++bj)
#pragma unroll
            for (int n = 0; n < 2; ++n) gv[bj][n] = *(const f32x4*)(gp + col0 + bj * HALF + n * 16);
#pragma unroll
        for (int ai = 0; ai < 2; ++ai)
#pragma unroll
            for (int m = 0; m < 4; ++m) { const size_t off = (size_t)(ai * HALF + wr * 64 + m * 16 + fr) * 1024 + col0;
#pragma unroll
                for (int bj = 0; bj < 2; ++bj)
#pragma unroll
                    for (int n = 0; n < 2; ++n) { const f32x4 bs = *(const f32x4*)(base + off + bj * HALF + n * 16); *(f32x4*)(o + off + bj * HALF + n * 16) = bs + gv[bj][n] * acc[ai][bj][m][n]; }
                if (m & 1) asm volatile("" ::: "memory"); }
    }
};
struct EpiSwiGLU {
    static constexpr bool PERM = true, AFTER_DRAIN = false;
    bf16_t* H; int ldh; int ntl;
    __device__ __forceinline__ void operator()(const f32x4 (&acc)[2][2][4][2], const Unit& u, int wr, int wc, int fr, int fq) const {
        const int row0 = u.pm * BM + wr * 64 + fr; const int ct = u.pn % ntl; const int col0 = ct * HALF + wc * 32 + 8 * fq;
#pragma unroll
        for (int ai = 0; ai < 2; ++ai)
#pragma unroll
            for (int m = 0; m < 4; ++m) { bf16_t* rowp = H + (size_t)(row0 + ai * HALF + m * 16) * ldh + col0;
                float hv[8];
#pragma unroll
                for (int n = 0; n < 2; ++n)
#pragma unroll
                    for (int j = 0; j < 4; ++j) { const float a = acc[ai][0][m][n][j], b = acc[ai][1][m][n][j];
                        const float e = __builtin_amdgcn_exp2f(a * -1.4426950408889634f); hv[n * 4 + j] = a * __builtin_amdgcn_rcpf(1.0f + e) * b; }
                u32x4 w; w.x = cvt_pk_bf16(hv[0], hv[1]); w.y = cvt_pk_bf16(hv[2], hv[3]); w.z = cvt_pk_bf16(hv[4], hv[5]); w.w = cvt_pk_bf16(hv[6], hv[7]);
                *(u32x4*)rowp = w; }
    }
};
__device__ __forceinline__ unsigned cvt4_fp8(float a, float b, float c, float d) { unsigned w = 0u; w = (unsigned)__builtin_amdgcn_cvt_pk_fp8_f32(a, b, (int)w, false); w = (unsigned)__builtin_amdgcn_cvt_pk_fp8_f32(c, d, (int)w, true); return w; }
struct EpiSwiGLUF8 {
    static constexpr bool PERM = true, AFTER_DRAIN = false;
    unsigned char* H; int ldh; int ntl; float s;
    __device__ __forceinline__ void operator()(const f32x4 (&acc)[2][2][4][2], const Unit& u, int wr, int wc, int fr, int fq) const {
        const int row0 = u.pm * BM + wr * 64 + fr; const int ct = u.pn % ntl; const int col0 = ct * HALF + wc * 32 + 8 * fq;
#pragma unroll
        for (int ai = 0; ai < 2; ++ai)
#pragma unroll
            for (int m = 0; m < 4; ++m) { unsigned char* rowp = H + (size_t)(row0 + ai * HALF + m * 16) * ldh + col0;
                float hv[8];
#pragma unroll
                for (int n = 0; n < 2; ++n)
#pragma unroll
                    for (int j = 0; j < 4; ++j) { const float a = acc[ai][0][m][n][j] * s, b = acc[ai][1][m][n][j] * s;
                        const float e = __builtin_amdgcn_exp2f(a * -1.4426950408889634f); hv[n * 4 + j] = a * __builtin_amdgcn_rcpf(1.0f + e) * b; }
                u32x2 w; w.x = cvt4_fp8(hv[0], hv[1], hv[2], hv[3]); w.y = cvt4_fp8(hv[4], hv[5], hv[6], hv[7]);
                *(u32x2*)rowp = w; }
    }
};
struct EpiBf16S {
    static constexpr bool PERM = true, AFTER_DRAIN = false;
    bf16_t* O; int ldc; int ntl; float s;
    __device__ __forceinline__ void operator()(const f32x4 (&acc)[2][2][4][2], const Unit& u, int wr, int wc, int fr, int fq) const {
        const int row0 = u.pm * BM + wr * 64 + fr; const int col0 = (u.pn % ntl) * BM + wc * 32 + 8 * fq;
#pragma unroll
        for (int ai = 0; ai < 2; ++ai)
#pragma unroll
            for (int m = 0; m < 4; ++m) { bf16_t* rowp = O + (size_t)(row0 + ai * HALF + m * 16) * ldc + col0;
#pragma unroll
                for (int bj = 0; bj < 2; ++bj) { const f32x4 v0 = acc[ai][bj][m][0] * s, v1 = acc[ai][bj][m][1] * s;
                    u32x4 w; w.x = cvt_pk_bf16(v0[0], v0[1]); w.y = cvt_pk_bf16(v0[2], v0[3]); w.z = cvt_pk_bf16(v1[0], v1[1]); w.w = cvt_pk_bf16(v1[2], v1[3]);
                    *(u32x4*)(rowp + bj * HALF) = w; } }
    }
};
struct MoeOrder {
    int npan, ntl, G, c; const PG8_LAS int* pexp;
    __device__ __forceinline__ bool next(int i, Unit& u) const {
        const long L = (long)i * G + c; if (L >= (long)npan * ntl) return false;
        const int pm = (int)(L / ntl), j = (int)(L % ntl); u.pm = pm; u.pn = __builtin_amdgcn_readfirstlane(pexp[pm]) * ntl + j; return true;
    }
    __device__ __forceinline__ void a_ready(const Unit&) const {}
    __device__ __forceinline__ void done(const Unit&) const {}
};
template <class Epi, class Sched, bool ALIGN_EPI = false, bool SP2 = false, bool FP8 = false>
__device__ __forceinline__ void gemm_phase(PG8_LAS unsigned char* lds, const Gemm g, const Sched& S, const Epi& E) {
    const int tid = threadIdx.x, wid = __builtin_amdgcn_readfirstlane(tid >> 6), lane = tid & 63, wr = wid >> 2, wc = wid & 3, fr = lane & 15, fq = lane >> 4;
    const int K = g.K, nt = K / BK;
    unsigned voffA[2], voffB[2];
#pragma unroll
    for (int i = 0; i < 2; ++i) { int R, C; stage_rc(tid * 16 + i * 8192, R, C); const int Rb = Epi::PERM ? ((R & ~31) + perm32(R & 31)) : R;
        voffA[i] = (unsigned)(R * K + C) * 2u; voffB[i] = (unsigned)(Rb * K + C) * 2u; }
    const size_t kstep = (size_t)(BK * 2);
    const size_t hstep = (size_t)HALF * K * 2;
    const size_t tstep = 2 * hstep;
    const unsigned ldsw = (unsigned)wid * 1024u;
    const int aoff = lds_byte(wr * 64 + fr, fq * 8), boff = lds_byte(wc * 32 + fr, fq * 8);
#define PG8_SA(b, h) (((b) * 2 + (h)) * HTB)
#define PG8_SB(b, h) ((4 + (b) * 2 + (h)) * HTB)
#define PG8_STAGE(bufoff, gbase, voff) do { _Pragma("unroll") for (int _i = 0; _i < 2; ++_i) \
        __builtin_amdgcn_global_load_lds((const unsigned*)((const char*)(gbase) + (voff)[_i]), (PG8_LAS unsigned*)(lds + (bufoff) + ldsw + _i * 8192), 16, 0, 0); } while (0)
#define PG8_CAT(x, y) __builtin_shufflevector(__builtin_bit_cast(i32x4, x), __builtin_bit_cast(i32x4, y), 0, 1, 2, 3, 4, 5, 6, 7)
#define PG8_LDA(dst, b, h) do { if constexpr (FP8) { _Pragma("unroll") for (int m = 0; m < 4; ++m) dst##8[m] = PG8_CAT(*(const PG8_LAS bf16x8*)(lds + PG8_SA(b, h) + aoff + m * 2048), *(const PG8_LAS bf16x8*)(lds + PG8_SA(b, h) + aoff + m * 2048 + 1024)); } else { \
        _Pragma("unroll") for (int m = 0; m < 4; ++m) _Pragma("unroll") for (int k = 0; k < 2; ++k) dst[m][k] = *(const PG8_LAS bf16x8*)(lds + PG8_SA(b, h) + aoff + m * 2048 + k * 1024); } } while (0)
#define PG8_LDB(dst, b, h) do { if constexpr (FP8) { _Pragma("unroll") for (int n = 0; n < 2; ++n) dst##8[n] = PG8_CAT(*(const PG8_LAS bf16x8*)(lds + PG8_SB(b, h) + boff + n * 2048), *(const PG8_LAS bf16x8*)(lds + PG8_SB(b, h) + boff + n * 2048 + 1024)); } else { \
        _Pragma("unroll") for (int n = 0; n < 2; ++n) _Pragma("unroll") for (int k = 0; k < 2; ++k) dst[n][k] = *(const PG8_LAS bf16x8*)(lds + PG8_SB(b, h) + boff + n * 2048 + k * 1024); } } while (0)
#define PG8_MMA(ai, bj, At, Bt) do { __builtin_amdgcn_s_setprio(1); if constexpr (FP8) { _Pragma("unroll") for (int m = 0; m < 4; ++m) _Pragma("unroll") for (int n = 0; n < 2; ++n) \
        asm volatile("v_mfma_f32_16x16x128_f8f6f4 %0, %1, %2, %0" : "+v"(acc[ai][bj][m][n]) : "v"(Bt##8[n]), "v"(At##8[m]));   } else { \
        _Pragma("unroll") for (int m = 0; m < 4; ++m) _Pragma("unroll") for (int n = 0; n < 2; ++n) _Pragma("unroll") for (int k = 0; k < 2; ++k) \
        acc[ai][bj][m][n] = __builtin_amdgcn_mfma_f32_16x16x32_bf16(Bt[n][k], At[m][k], acc[ai][bj][m][n], 0, 0, 0); } __builtin_amdgcn_s_setprio(0); } while (0)
#define PG8_WAIT_V(n) asm volatile("s_waitcnt vmcnt(" #n ")" ::: "memory")
#define PG8_WAIT_L(n) asm volatile("s_waitcnt lgkmcnt(" #n ")" ::: "memory")
#define PG8_BAR __builtin_amdgcn_s_barrier()
#define PG8_SCHED __builtin_amdgcn_sched_barrier(0)
    Unit cur, nxt; int ui = 0;
    if (!S.next(0, cur)) return;
    f32x4 acc[2][2][4][2];
#pragma unroll
    for (int a = 0; a < 2; ++a)
#pragma unroll
        for (int b = 0; b < 2; ++b)
#pragma unroll
            for (int m = 0; m < 4; ++m)
#pragma unroll
                for (int n = 0; n < 2; ++n) acc[a][b][m][n] = (f32x4){0.f, 0.f, 0.f, 0.f};
    bf16x8 At[4][2], B0[2][2], B1[2][2]; i32x8 At8[4], B08[2], B18[2];
    const char* cA = (const char*)g.A + (size_t)cur.pm * tstep; const char* cB = (const char*)g.Bt + (size_t)cur.pn * tstep;
    S.a_ready(cur);
    if constexpr (SP2) {
        PG8_STAGE(PG8_SB(0, 0), cB, voffB); PG8_STAGE(PG8_SB(0, 1), cB + hstep, voffB); PG8_STAGE(PG8_SA(0, 0), cA, voffA); PG8_STAGE(PG8_SA(0, 1), cA + hstep, voffA);
        if (wr == 1) PG8_BAR;
        PG8_WAIT_V(2); PG8_BAR;
        PG8_STAGE(PG8_SB(1, 0), cB + kstep, voffB); PG8_STAGE(PG8_SA(1, 0), cA + kstep, voffA); PG8_STAGE(PG8_SB(1, 1), cB + hstep + kstep, voffB);
        PG8_WAIT_V(6); PG8_BAR;
    } else {
        PG8_STAGE(PG8_SB(0, 0), cB, voffB); PG8_STAGE(PG8_SA(0, 0), cA, voffA); PG8_STAGE(PG8_SB(0, 1), cB + hstep, voffB); PG8_STAGE(PG8_SA(0, 1), cA + hstep, voffA);
        if (wr == 1) PG8_BAR;
        PG8_WAIT_V(4); PG8_BAR;
        PG8_STAGE(PG8_SB(1, 0), cB + kstep, voffB); PG8_STAGE(PG8_SA(1, 0), cA + kstep, voffA); PG8_STAGE(PG8_SB(1, 1), cB + hstep + kstep, voffB);
        PG8_WAIT_V(6); PG8_BAR;
    }
    for (;;) {
        const bool has_next = S.next(ui + 1, nxt);
        const char* nA = has_next ? (const char*)g.A + (size_t)nxt.pm * tstep : cA; const char* nB = has_next ? (const char*)g.Bt + (size_t)nxt.pn * tstep : cB;
#pragma unroll 1
        for (int t = 0; t < nt; t += 2) {
            const bool last = (t == nt - 2);
            const char* a1 = cA + (size_t)(t + 1) * kstep;
            const char* a2 = last ? nA : cA + (size_t)(t + 2) * kstep; const char* b2 = last ? nB : cB + (size_t)(t + 2) * kstep;
            const char* a3 = a2 + kstep; const char* b3 = b2 + kstep;
            if (last && has_next) S.a_ready(nxt);
            if constexpr (SP2) {
            PG8_LDB(B0, 0, 0); PG8_LDB(B1, 0, 1); PG8_SCHED; PG8_LDA(At, 0, 0); PG8_STAGE(PG8_SA(1, 1), a1 + hstep, voffA);
            PG8_WAIT_V(8); PG8_WAIT_L(0); PG8_BAR; PG8_MMA(0, 0, At, B0); PG8_MMA(0, 1, At, B1); PG8_BAR; PG8_SCHED;
            PG8_LDA(At, 0, 1); PG8_STAGE(PG8_SB(0, 0), b2, voffB); PG8_STAGE(PG8_SB(0, 1), b2 + hstep, voffB); PG8_STAGE(PG8_SA(0, 0), a2, voffA);
            PG8_WAIT_V(8); PG8_WAIT_L(0); PG8_BAR; PG8_MMA(1, 0, At, B0); PG8_MMA(1, 1, At, B1); PG8_BAR; PG8_SCHED;
            PG8_LDB(B0, 1, 0); PG8_LDB(B1, 1, 1); PG8_SCHED; PG8_LDA(At, 1, 0); PG8_STAGE(PG8_SA(0, 1), a2 + hstep, voffA);
            PG8_WAIT_V(8); PG8_WAIT_L(0); PG8_BAR; PG8_MMA(0, 0, At, B0); PG8_MMA(0, 1, At, B1); PG8_BAR; PG8_SCHED;
            PG8_LDA(At, 1, 1); PG8_STAGE(PG8_SB(1, 0), b3, voffB); PG8_STAGE(PG8_SB(1, 1), b3 + hstep, voffB); PG8_STAGE(PG8_SA(1, 0), a3, voffA);
            PG8_WAIT_V(8); PG8_WAIT_L(0); PG8_BAR; PG8_MMA(1, 0, At, B0); PG8_MMA(1, 1, At, B1); PG8_BAR; PG8_SCHED;
            } else {
            PG8_LDB(B0, 0, 0); PG8_SCHED; PG8_LDA(At, 0, 0); PG8_STAGE(PG8_SA(1, 1), a1 + hstep, voffA);
            PG8_WAIT_L(8); PG8_BAR; PG8_WAIT_L(0); PG8_MMA(0, 0, At, B0); PG8_BAR; PG8_SCHED;
            PG8_LDB(B1, 0, 1); PG8_STAGE(PG8_SB(0, 0), b2, voffB);
            PG8_BAR; PG8_WAIT_L(0); PG8_MMA(0, 1, At, B1); PG8_BAR;
            PG8_LDA(At, 0, 1); PG8_STAGE(PG8_SA(0, 0), a2, voffA);
            PG8_BAR; PG8_WAIT_L(0); PG8_MMA(1, 0, At, B0); PG8_BAR; PG8_SCHED;
            PG8_STAGE(PG8_SB(0, 1), b2 + hstep, voffB);
            PG8_WAIT_V(6); PG8_BAR; PG8_MMA(1, 1, At, B1); PG8_BAR;
            PG8_LDB(B0, 1, 0); PG8_SCHED; PG8_LDA(At, 1, 0); PG8_STAGE(PG8_SA(0, 1), a2 + hstep, voffA);
            PG8_WAIT_L(8); PG8_BAR; PG8_WAIT_L(0); PG8_MMA(0, 0, At, B0); PG8_BAR; PG8_SCHED;
            PG8_LDB(B1, 1, 1); PG8_STAGE(PG8_SB(1, 0), b3, voffB);
            PG8_BAR; PG8_WAIT_L(0); PG8_MMA(0, 1, At, B1); PG8_BAR;
            PG8_LDA(At, 1, 1); PG8_STAGE(PG8_SA(1, 0), a3, voffA);
            PG8_BAR; PG8_WAIT_L(0); PG8_MMA(1, 0, At, B0); PG8_BAR; PG8_SCHED;
            PG8_STAGE(PG8_SB(1, 1), b3 + hstep, voffB);
            PG8_WAIT_V(6); PG8_BAR; PG8_MMA(1, 1, At, B1); PG8_BAR;
            }
        }
        if constexpr (FP8) asm volatile("s_nop 15\n\ts_nop 15" ::: "memory");
        if constexpr (ALIGN_EPI) { if (wr == 0) PG8_BAR; }
        if constexpr (!Epi::AFTER_DRAIN) { E(acc, cur, wr, wc, fr, fq); S.done(cur); }
        if (!has_next) break;
#pragma unroll
        for (int a = 0; a < 2; ++a)
#pragma unroll
            for (int b = 0; b < 2; ++b)
#pragma unroll
                for (int m = 0; m < 4; ++m)
#pragma unroll
                    for (int n = 0; n < 2; ++n) acc[a][b][m][n] = (f32x4){0.f, 0.f, 0.f, 0.f};
        cur = nxt; cA = nA; cB = nB; ++ui;
        if constexpr (ALIGN_EPI) { if (wr == 1) PG8_BAR; }
    }
    PG8_WAIT_V(0);
    if constexpr (!ALIGN_EPI) { if (wr == 0) PG8_BAR; }
    PG8_BAR;
    if constexpr (Epi::AFTER_DRAIN) { E.fused(acc, cur, wr, wc, fr, fq, lds, wid, lane); S.done(cur); }
#undef PG8_SA
#undef PG8_SB
#undef PG8_STAGE
#undef PG8_LDA
#undef PG8_LDB
#undef PG8_MMA
#undef PG8_CAT
#undef PG8_WAIT_V
#undef PG8_WAIT_L
#undef PG8_BAR
#undef PG8_SCHED
}
}

#ifndef PG8_SP2
#define PG8_SP2 true
#endif
#ifndef PG8_ALIGN
#define PG8_ALIGN true
#endif
#include <hip/hip_bf16.h>
#include <cmath>
namespace attn_body {
using bf16=__hip_bfloat16;
using bf16x8=__attribute__((ext_vector_type(8)))short;
using s16x4=__attribute__((ext_vector_type(4)))short;
using f32x16=__attribute__((ext_vector_type(16)))float;
using u32x4=__attribute__((ext_vector_type(4)))unsigned;
constexpr int D=64;
constexpr int NW=8,QBLK=32,QB=QBLK*NW,KVBLK=64;
constexpr int ATTN_UNIT_ROWS=QB;
__device__ __forceinline__ int crow(int r,int hi){return (r&3)+8*(r>>2)+4*hi;}
#define SBAR() __builtin_amdgcn_sched_barrier(0)
__device__ __forceinline__ void cmask(f32x16&p0,f32x16&p1,int jb,int qrel,int hi){
  const float NEG=-INFINITY; int kb=64*jb+4*hi;
  #pragma unroll
  for(int r=0;r<16;++r){int kv=kb+(r&3)+8*(r>>2); if(kv>qrel)p0[r]=NEG; if(kv+32>qrel)p1[r]=NEG;}
}

constexpr int NSLOT=3, SLOTB=8192;
constexpr int LDS_K=0, LDS_V=NSLOT*SLOTB, LDS_WS=2*NSLOT*SLOTB, LDS_OST=LDS_WS+NW*64*4, LDS_BYTES=LDS_OST+NW*4096;
constexpr float C2=0.125f*1.4426950408889634f;
__device__ __forceinline__ void glds16(const void*gsrc,unsigned lds_dst){unsigned keep;
  asm volatile("s_mov_b32 %0, m0\n\ts_mov_b32 m0, %2\n\ts_nop 0\n\tglobal_load_lds_dwordx4 %1, off\n\ts_mov_b32 m0, %0":"=&s"(keep):"v"(gsrc),"s"(lds_dst):"memory");}
__device__ __forceinline__ float max3f(float a,float b,float c){float r;asm("v_max3_f32 %0, %1, %2, %3":"=v"(r):"v"(a),"v"(b),"v"(c));return r;}
__device__ __forceinline__ float max2f(float a,float b){float r;asm("v_max_f32_e32 %0, %1, %2":"=v"(r):"v"(a),"v"(b));return r;}
__device__ __forceinline__ float fadd_s(float a,float b){float r;asm("v_add_f32_e32 %0, %1, %2":"=v"(r):"v"(a),"v"(b));return r;}
__device__ __forceinline__ float fsub_s(float a,float b){float r;asm("v_sub_f32_e32 %0, %1, %2":"=v"(r):"v"(a),"v"(b));return r;}
typedef float f32x2_t __attribute__((ext_vector_type(2))); typedef __bf16 bf16x2_t __attribute__((ext_vector_type(2)));
__device__ __forceinline__ unsigned cvtpk_s(float lo,float hi){f32x2_t v={lo,hi};bf16x2_t b=__builtin_convertvector(v,bf16x2_t);return __builtin_bit_cast(unsigned,b);}
#define WAIT_BAR(N) asm volatile("s_waitcnt vmcnt(" #N ") lgkmcnt(0)\n\ts_barrier":::"memory")

__device__ __forceinline__ void qkt(f32x16&p0,f32x16&p1,const char*Kslot,const bf16x8*qr,const f32x16&negm,int r32,int hi){
  const char*kb=Kslot+hi*1024+r32*16;
  #pragma unroll
  for(int d0=0;d0<4;++d0){
    const bf16x8 b0=*reinterpret_cast<const bf16x8*>(kb+d0*2048);
    const bf16x8 b1=*reinterpret_cast<const bf16x8*>(kb+d0*2048+512);
    if(d0==0){p0=__builtin_amdgcn_mfma_f32_32x32x16_bf16(b0,qr[0],negm,0,0,0);p1=__builtin_amdgcn_mfma_f32_32x32x16_bf16(b1,qr[0],negm,0,0,0);}
    else{p0=__builtin_amdgcn_mfma_f32_32x32x16_bf16(b0,qr[d0],p0,0,0,0);p1=__builtin_amdgcn_mfma_f32_32x32x16_bf16(b1,qr[d0],p1,0,0,0);}}
}
typedef __attribute__((address_space(3))) const char* lds_cptr;
typedef short v4i16_t __attribute__((ext_vector_type(4)));
__device__ __forceinline__ void kload8(bf16x8*kf,lds_cptr kp){
  kf[0]=*(const __attribute__((address_space(3))) bf16x8*)(kp);      kf[1]=*(const __attribute__((address_space(3))) bf16x8*)(kp+512);
  kf[2]=*(const __attribute__((address_space(3))) bf16x8*)(kp+2048); kf[3]=*(const __attribute__((address_space(3))) bf16x8*)(kp+2560);
  kf[4]=*(const __attribute__((address_space(3))) bf16x8*)(kp+4096); kf[5]=*(const __attribute__((address_space(3))) bf16x8*)(kp+4608);
  kf[6]=*(const __attribute__((address_space(3))) bf16x8*)(kp+6144); kf[7]=*(const __attribute__((address_space(3))) bf16x8*)(kp+6656);
}
__device__ __forceinline__ void kload2(bf16x8*kf,lds_cptr kp,int j){ kf[2*j]=*(const __attribute__((address_space(3))) bf16x8*)(kp+j*2048); kf[2*j+1]=*(const __attribute__((address_space(3))) bf16x8*)(kp+j*2048+512); }
__device__ __forceinline__ s16x4 vtr(lds_cptr p){ return __builtin_bit_cast(s16x4,__builtin_amdgcn_ds_read_tr16_b64_v4i16((__attribute__((address_space(3))) v4i16_t*)p)); }
__device__ __forceinline__ float rowmax(const f32x16&p0,const f32x16&p1){
  float a=max3f(p0[0],p0[1],p1[0]),b=max3f(p0[2],p0[3],p1[1]);a=max3f(a,p1[2],p1[3]);
  #pragma unroll
  for(int r=4;r<16;r+=4){a=max3f(a,p0[r],p0[r+1]);b=max3f(b,p0[r+2],p0[r+3]);a=max3f(a,p1[r],p1[r+1]);b=max3f(b,p1[r+2],p1[r+3]);}
  const float m=max2f(a,b);
  auto rr=__builtin_amdgcn_permlane32_swap(__float_as_uint(m),__float_as_uint(m),false,false);
  return max2f(__uint_as_float(rr[0]),__uint_as_float(rr[1]));
}
__device__ __forceinline__ void pv(f32x16*o,int vb,bf16x8 pa0,bf16x8 pa1,bf16x8 pa2,bf16x8 pa3){
  #pragma unroll
  for(int d0=0;d0<2;++d0){s16x4 lo[4],hi[4];
    #pragma unroll
    for(int ks=0;ks<4;++ks){
      asm volatile("ds_read_b64_tr_b16 %0,%1 offset:%c2":"=&v"(lo[ks]):"v"(vb),"i"(d0*4096+ks*1024):"memory");
      asm volatile("ds_read_b64_tr_b16 %0,%1 offset:%c2":"=&v"(hi[ks]):"v"(vb),"i"(d0*4096+ks*1024+512):"memory");}
    asm volatile("s_waitcnt lgkmcnt(0)":::"memory");SBAR();
    #define PK(k) (bf16x8){lo[k][0],lo[k][1],lo[k][2],lo[k][3],hi[k][0],hi[k][1],hi[k][2],hi[k][3]}
    o[d0]=__builtin_amdgcn_mfma_f32_32x32x16_bf16(pa0,PK(0),o[d0],0,0,0);
    o[d0]=__builtin_amdgcn_mfma_f32_32x32x16_bf16(pa1,PK(1),o[d0],0,0,0);
    o[d0]=__builtin_amdgcn_mfma_f32_32x32x16_bf16(pa2,PK(2),o[d0],0,0,0);
    o[d0]=__builtin_amdgcn_mfma_f32_32x32x16_bf16(pa3,PK(3),o[d0],0,0,0);
    #undef PK
  }
}

#ifndef ATTN_STORE16
#define ATTN_STORE16(p,v) (*(u32x4*)(p)=(v))
#endif
template<int THRL,bool TILED> __device__ __forceinline__ void attn_unit(const bf16*Qu,int qp,const bf16*__restrict__ Kc,const bf16*__restrict__ Kl,int kp,const bf16*__restrict__ Vc,const bf16*__restrict__ Vl,int vp,bf16*Ou,int op,int NT,int NCT,int rot,char*shm){
  const int tid=threadIdx.x,lane=tid&63,r32=lane&31,hi=lane>>5; const int wid=__builtin_amdgcn_readfirstlane(tid>>6);
  const bf16*Qw=Qu+(long)(wid*QBLK)*qp;
  const unsigned lds0=(unsigned)(uintptr_t)shm;
  float*wsf=(float*)(shm+LDS_WS)+wid*64;
  const long koff=TILED?(long)(wid*512+lane*8):((long)lane*kp+wid*8); const bf16*ksrc_c=Kc+koff; const bf16*ksrc_l=Kl+koff-(long)NCT*KVBLK*kp;
  const long voff=TILED?(long)(wid*512+lane*8):((long)(16*(wid&3)+(lane>>2))*vp+(wid>>2)*32+(lane&3)*8); const bf16*vsrc_c=Vc+voff; const bf16*vsrc_l=Vl+voff-(long)NCT*KVBLK*vp;
  const unsigned kdst=lds0+LDS_K+wid*1024, vdst=lds0+LDS_V+wid*1024;
  #define ROTT(t) (((t)+rot>=NT)?((t)+rot-NT):((t)+rot))
  #define DMA_K(t,slot) glds16((ROTT(t)<NCT?ksrc_c:ksrc_l)+(long)ROTT(t)*KVBLK*kp,(unsigned)__builtin_amdgcn_readfirstlane(kdst+(slot)))
  #define DMA_V(t,slot) glds16((ROTT(t)<NCT?vsrc_c:vsrc_l)+(long)ROTT(t)*KVBLK*vp,(unsigned)__builtin_amdgcn_readfirstlane(vdst+(slot)))
  const int vb0=(int)(lds0+LDS_V)+((lane>>4)&1)*32+(lane&3)*8+(4*hi+((lane&15)>>2))*64;
  const char*Kbase=shm+LDS_K; bf16x8 kf[8];
  const lds_cptr shm3=(lds_cptr)shm; const lds_cptr kp0=shm3+LDS_K+hi*1024+r32*16; const lds_cptr vp0=shm3+LDS_V+((lane>>4)&1)*32+(lane&3)*8+(4*hi+((lane&15)>>2))*64;
  DMA_K(0,0);DMA_V(0,0);DMA_K(1,SLOTB);
  bf16x8 qr[4];
  #pragma unroll
  for(int d0=0;d0<4;++d0)qr[d0]=*reinterpret_cast<const bf16x8*>(&Qw[(long)r32*qp+d0*16+hi*8]);
  float mhat=0.f,l_reg=0.f;f32x16 o[2];o[0]=f32x16{};o[1]=f32x16{};f32x16 negm=f32x16{};if constexpr(THRL>=0)asm volatile("":"+v"(negm));
  #define CMASK(P0,P1,t) do{}while(0)
  bool resc=false;
  #define START(P0,P1) do{ resc=false; if constexpr(THRL>=0) \
    { const float rm=rowmax(P0,P1); const float dl=rm; mhat=fadd_s(mhat,dl); \
      _Pragma("unroll") for(int r=0;r<16;++r){P0[r]=fsub_s(P0[r],dl);P1[r]=fsub_s(P1[r],dl);} \
      _Pragma("unroll") for(int r=0;r<16;++r)negm[r]=-mhat; asm volatile("":"+v"(negm)); } \
    _Pragma("unroll") for(int r=0;r<16;++r)P0[r]=__builtin_amdgcn_exp2f(P0[r]); }while(0)
  #define RESC() do{ if constexpr(THRL>=0) if(resc){ asm volatile("s_waitcnt lgkmcnt(0)":::"memory"); \
      _Pragma("unroll") for(int d_=0;d_<2;++d_) _Pragma("unroll") for(int r=0;r<16;++r)o[d_][r]*=wsf[crow(r,hi)]; } }while(0)
  f32x16 pA0,pA1,pB0,pB1;
  int sl_prev=0,sl_cur=0,sl_next=SLOTB;
  #define ROT() do{sl_prev=sl_cur;sl_cur=sl_next;sl_next=(sl_next==(NSLOT-1)*SLOTB)?0:sl_next+SLOTB;}while(0)
  DMA_K(2,2*SLOTB);
  WAIT_BAR(3);
  qkt(pA0,pA1,Kbase,qr,negm,r32,hi);asm volatile("s_nop 15\n\ts_nop 7":"+v"(pA0),"+v"(pA1));CMASK(pA0,pA1,0);
  START(pA0,pA1);
  _Pragma("unroll") for(int r=0;r<16;++r)pA1[r]=__builtin_amdgcn_exp2f(pA1[r]);
  WAIT_BAR(0);
  DMA_K(3,0);DMA_V(1,SLOTB);
  ROT();
  kload8(kf,kp0+sl_cur);
  WAIT_BAR(2);
  s16x4 vlo[8],vhi[8]; u32x4 pw0,pw1,pw2,pw3;
  #define PKW(P,B) cvtpk_s(P[B],P[B+1])
  #define PAF(k) __builtin_bit_cast(bf16x8,pw##k)
  #define VFR(i) (bf16x8){vlo[i][0],vlo[i][1],vlo[i][2],vlo[i][3],vhi[i][0],vhi[i][1],vhi[i][2],vhi[i][3]}
  #define PIN(x) asm volatile("":"+v"(x))
  #define MX3(a,b,c) __builtin_fmaxf(__builtin_fmaxf((a),(b)),(c))
  #define GAPA(MF,A0,A1,A2,A3,W0,W1,PW) do{ MF; sacc+=A0; sacc+=A1; sacc+=A2; sacc+=A3; PIN(sacc); W0; W1; PIN(PW); SBAR(); }while(0)
  #define EX(v) __builtin_amdgcn_exp2f(v)
  #define GAPB(MF,X,B) do{ MF; X[B]=EX(X[B]); X[B+1]=EX(X[B+1]); X[B+2]=EX(X[B+2]); X[B+3]=EX(X[B+3]); PIN(X); SBAR(); }while(0)
  #define VRD(i) do{ vlo[i]=vtr(vp_+(((i)>>2)*4096+((i)&3)*1024)); vhi[i]=vtr(vp_+(((i)>>2)*4096+((i)&3)*1024+512)); }while(0)
  #define KRD(G,j) do{ if(G){ kload2(kf,kp0+sl_next,j); SBAR(); } }while(0)
  #define STEP(C0,C1,P0,P1,t,GK,GV,GL) do{ SBAR(); \
    const lds_cptr vp_=vp0+sl_prev; \
    VRD(0); SBAR(); float sacc=(P0[0]+P0[1]); \
    GAPA(C0=__builtin_amdgcn_mfma_f32_32x32x16_bf16(kf[0],qr[0],negm,0,0,0), P0[2],P0[3],P0[4],P0[5],     pw0[0]=PKW(P0,0), pw0[1]=PKW(P0,2), pw0); \
    VRD(4); SBAR(); GAPA(C1=__builtin_amdgcn_mfma_f32_32x32x16_bf16(kf[1],qr[0],negm,0,0,0), P0[6],P0[7],P0[8],P0[9],     pw0[2]=PKW(P0,4), pw0[3]=PKW(P0,6), pw0); \
    VRD(1); SBAR(); GAPA(C0=__builtin_amdgcn_mfma_f32_32x32x16_bf16(kf[2],qr[1],C0,0,0,0),   P0[10],P0[11],P0[12],P0[13], pw1[0]=PKW(P0,8), pw1[1]=PKW(P0,10), pw1); \
    VRD(5); SBAR(); GAPA(C1=__builtin_amdgcn_mfma_f32_32x32x16_bf16(kf[3],qr[1],C1,0,0,0),   P0[14],P0[15],P1[0],P1[1],   pw1[2]=PKW(P0,12),pw1[3]=PKW(P0,14), pw1); \
    VRD(2); SBAR(); GAPA(C0=__builtin_amdgcn_mfma_f32_32x32x16_bf16(kf[4],qr[2],C0,0,0,0),   P1[2],P1[3],P1[4],P1[5],     pw2[0]=PKW(P1,0), pw2[1]=PKW(P1,2), pw2); \
    VRD(6); SBAR(); GAPA(C1=__builtin_amdgcn_mfma_f32_32x32x16_bf16(kf[5],qr[2],C1,0,0,0),   P1[6],P1[7],P1[8],P1[9],     pw2[2]=PKW(P1,4), pw2[3]=PKW(P1,6), pw2); \
    VRD(3); SBAR(); GAPA(C0=__builtin_amdgcn_mfma_f32_32x32x16_bf16(kf[6],qr[3],C0,0,0,0),   P1[10],P1[11],P1[12],P1[13], pw3[0]=PKW(P1,8), pw3[1]=PKW(P1,10), pw3); \
    VRD(7); SBAR(); GAPA(C1=__builtin_amdgcn_mfma_f32_32x32x16_bf16(kf[7],qr[3],C1,0,0,0),   P1[14],P1[15],0.f,0.f,       pw3[2]=PKW(P1,12),pw3[3]=PKW(P1,14), pw3); \
    l_reg+=sacc; \
    if(GK){DMA_K((t)+3,sl_cur);} if(GV){DMA_V((t)+1,sl_next);} \
    CMASK(C0,C1,t); \
    if constexpr(THRL>=0){ float a=MX3(C0[0],C0[1],C1[0]),b=MX3(C0[2],C0[3],C1[1]); a=MX3(a,C1[2],C1[3]); \
      _Pragma("unroll") for(int r=4;r<16;r+=4){a=MX3(a,C0[r],C0[r+1]);b=MX3(b,C0[r+2],C0[r+3]);a=MX3(a,C1[r],C1[r+1]);b=MX3(b,C1[r+2],C1[r+3]);} \
      float rm=__builtin_fmaxf(a,b); { auto rr=__builtin_amdgcn_permlane32_swap(__float_as_uint(rm),__float_as_uint(rm),false,false); rm=__builtin_fmaxf(__uint_as_float(rr[0]),__uint_as_float(rr[1])); } \
      resc=false; \
      if(__builtin_expect(__any(rm>(float)THRL),0)){ const float dl=__builtin_fmaxf(rm,0.f); mhat+=dl; \
        _Pragma("unroll") for(int r=0;r<16;++r){C0[r]-=dl;C1[r]-=dl;} \
        _Pragma("unroll") for(int r=0;r<16;++r)negm[r]=-mhat; asm volatile("":"+v"(negm)); \
        const float f=__builtin_amdgcn_exp2f(-dl); l_reg*=f; if(hi==0)wsf[r32]=f; resc=true; } } \
    SBAR(); \
    GAPB(o[0]=__builtin_amdgcn_mfma_f32_32x32x16_bf16(PAF(0),VFR(0),o[0],0,0,0), C0,0); \
    GAPB(o[1]=__builtin_amdgcn_mfma_f32_32x32x16_bf16(PAF(0),VFR(4),o[1],0,0,0), C0,4); \
    KRD(GL,0); GAPB(o[0]=__builtin_amdgcn_mfma_f32_32x32x16_bf16(PAF(1),VFR(1),o[0],0,0,0), C0,8); \
    KRD(GL,1); GAPB(o[1]=__builtin_amdgcn_mfma_f32_32x32x16_bf16(PAF(1),VFR(5),o[1],0,0,0), C0,12); \
    KRD(GL,2); GAPB(o[0]=__builtin_amdgcn_mfma_f32_32x32x16_bf16(PAF(2),VFR(2),o[0],0,0,0), C1,0); \
    KRD(GL,3); GAPB(o[1]=__builtin_amdgcn_mfma_f32_32x32x16_bf16(PAF(2),VFR(6),o[1],0,0,0), C1,4); \
    GAPB(o[0]=__builtin_amdgcn_mfma_f32_32x32x16_bf16(PAF(3),VFR(3),o[0],0,0,0), C1,8); \
    GAPB(o[1]=__builtin_amdgcn_mfma_f32_32x32x16_bf16(PAF(3),VFR(7),o[1],0,0,0), C1,12); \
    }while(0)
  int t=1;
  #undef CMASK
  #define CMASK(P0,P1,t) do{}while(0)
  for(;t+5<NT;t+=2){
    STEP(pB0,pB1,pA0,pA1,t,true,true,true);     WAIT_BAR(2); RESC(); ROT();
    STEP(pA0,pA1,pB0,pB1,t+1,true,true,true);   WAIT_BAR(2); RESC(); ROT();
  }
  #undef CMASK
  #define CMASK(P0,P1,t) do{}while(0)
  #define ENDW(tt) do{ if((tt)+3<NT){WAIT_BAR(2);} else if((tt)+2<NT){WAIT_BAR(1);} else {WAIT_BAR(0);} }while(0)
  for(;t+1<NT;t+=2){
    STEP(pB0,pB1,pA0,pA1,t,(t+3<NT),(t+1<NT),(t+1<NT));       ENDW(t);   RESC(); ROT();
    STEP(pA0,pA1,pB0,pB1,t+1,(t+4<NT),(t+2<NT),(t+2<NT));     ENDW(t+1); RESC(); ROT();
  }
  STEP(pB0,pB1,pA0,pA1,NT-1,false,false,false); RESC();
  { float sacc=pB0[0]+pB0[1]; _Pragma("unroll") for(int r=2;r<16;++r)sacc+=pB0[r]; _Pragma("unroll") for(int r=0;r<16;++r)sacc+=pB1[r]; l_reg+=sacc;
    pw0=(u32x4){PKW(pB0,0),PKW(pB0,2),PKW(pB0,4),PKW(pB0,6)};pw1=(u32x4){PKW(pB0,8),PKW(pB0,10),PKW(pB0,12),PKW(pB0,14)};pw2=(u32x4){PKW(pB1,0),PKW(pB1,2),PKW(pB1,4),PKW(pB1,6)};pw3=(u32x4){PKW(pB1,8),PKW(pB1,10),PKW(pB1,12),PKW(pB1,14)};
    SBAR(); pv(o,vb0+sl_cur,PAF(0),PAF(1),PAF(2),PAF(3)); }
  #undef PKW
  #undef PAF
  #undef VFR
  #undef PIN
  #undef MX3
  #undef GAPA
  #undef GAPB
  #undef EX
  #undef VRD
  #undef KRD
  #undef STEP
  #undef ENDW
  {auto rr=__builtin_amdgcn_permlane32_swap(__float_as_uint(l_reg),__float_as_uint(l_reg),false,false);l_reg=__uint_as_float(rr[0])+__uint_as_float(rr[1]);}
  if(hi==0)wsf[32+r32]=l_reg;asm volatile("s_waitcnt lgkmcnt(0)":::"memory");
  float rli[16];
  #pragma unroll
  for(int r=0;r<16;++r)rli[r]=__builtin_amdgcn_rcpf(wsf[32+crow(r,hi)]);
  bf16*Ow=Ou+(long)(wid*QBLK)*op;
  { bf16*stg=(bf16*)(shm+LDS_OST)+wid*2048;
    #pragma unroll
    for(int r=0;r<16;++r){const int orow=crow(r,hi);
      #pragma unroll
      for(int d0=0;d0<2;++d0)stg[orow*64+d0*32+r32]=__float2bfloat16(o[d0][r]*rli[r]);}
    asm volatile("s_waitcnt lgkmcnt(0)":::"memory");
    #pragma unroll
    for(int i=0;i<4;++i){const int row=i*8+(lane>>3),ch=lane&7; const u32x4 v=*(const u32x4*)(stg+row*64+ch*8); ATTN_STORE16(Ow+(long)row*op+ch*8,v);} }
  asm volatile("s_waitcnt lgkmcnt(0)\n\ts_barrier":::"memory");
  #undef DMA_K
  #undef ROTT
  #undef DMA_V
  #undef CMASK
  #undef START
  #undef RESC
  #undef ROT
}
constexpr int LDS2_V=NSLOT*SLOTB, LDS2_WS=LDS2_V+NSLOT*2*SLOTB, LDS2_OST=LDS2_WS+NW*64*4, LDS2_BYTES=LDS2_OST+NW*4096;
template<int THRL> __device__ __forceinline__ void attn_unit2(const bf16*Qu,int qp,const bf16*__restrict__ Ks,const bf16*__restrict__ Va,const bf16*__restrict__ Vb,bf16*Ou,int op,int NT,int rot,char*shm){
  const int tid=threadIdx.x,lane=tid&63,r32=lane&31,hi=lane>>5; const int wid=__builtin_amdgcn_readfirstlane(tid>>6);
  const bf16*Qw=Qu+(long)(wid*QBLK)*qp;
  const unsigned lds0=(unsigned)(uintptr_t)shm;
  float*wsf=(float*)(shm+LDS2_WS)+wid*64;
  const long koff=(long)(wid*512+lane*8); const bf16*ksrc=Ks+koff; const bf16*vsrca=Va+koff; const bf16*vsrcb=Vb+koff;
  const unsigned kdst=lds0+LDS_K+wid*1024, vdst=lds0+LDS2_V+wid*1024;
  #define ROTT(t) (((t)+rot>=NT)?((t)+rot-NT):((t)+rot))
  #define DMA_K(t,slot) glds16(ksrc+(long)ROTT(t)*4096,(unsigned)__builtin_amdgcn_readfirstlane(kdst+(slot)))
  #define DMA_V(t,slot) do{ glds16(vsrca+(long)ROTT(t)*4096,(unsigned)__builtin_amdgcn_readfirstlane(vdst+2*(slot))); glds16(vsrcb+(long)ROTT(t)*4096,(unsigned)__builtin_amdgcn_readfirstlane(vdst+2*(slot)+8192)); }while(0)
  const int vb0=(int)(lds0+LDS2_V)+((lane>>4)&1)*32+(lane&3)*8+(4*hi+((lane&15)>>2))*64;
  const char*Kbase=shm+LDS_K; bf16x8 kf[8];
  const lds_cptr shm3=(lds_cptr)shm; const lds_cptr kp0=shm3+LDS_K+hi*1024+r32*16; const lds_cptr vp0=shm3+LDS2_V+((lane>>4)&1)*32+(lane&3)*8+(4*hi+((lane&15)>>2))*64;
  DMA_K(0,0);DMA_V(0,0);DMA_K(1,SLOTB);
  bf16x8 qr[4];
  #pragma unroll
  for(int d0=0;d0<4;++d0)qr[d0]=*reinterpret_cast<const bf16x8*>(&Qw[(long)r32*qp+d0*16+hi*8]);
  float mhat=0.f,l_reg=0.f;f32x16 o[4];o[0]=f32x16{};o[1]=f32x16{};o[2]=f32x16{};o[3]=f32x16{};const f32x16 zero16=f32x16{};
  #define CMASK(P0,P1,t) do{}while(0)
  bool resc=false;
  #define SUBM(x) (THRL>=0?(x)-mhat:(x))
  #define START(P0,P1) do{ resc=false; if constexpr(THRL>=0){ mhat=rowmax(P0,P1); } \
    _Pragma("unroll") for(int r=0;r<16;++r)P0[r]=__builtin_amdgcn_exp2f(SUBM(P0[r])); }while(0)
  #define RESC() do{ if constexpr(THRL>=0) if(resc){ asm volatile("s_waitcnt lgkmcnt(0)":::"memory"); \
      _Pragma("unroll") for(int d_=0;d_<4;++d_) _Pragma("unroll") for(int r=0;r<16;++r)o[d_][r]*=wsf[crow(r,hi)]; } }while(0)
  f32x16 pA0,pA1,pB0,pB1;
  int sl_prev=0,sl_cur=0,sl_next=SLOTB;
  #define ROT() do{sl_prev=sl_cur;sl_cur=sl_next;sl_next=(sl_next==(NSLOT-1)*SLOTB)?0:sl_next+SLOTB;}while(0)
  DMA_K(2,2*SLOTB);
  WAIT_BAR(4);
  qkt(pA0,pA1,Kbase,qr,zero16,r32,hi);asm volatile("s_nop 15\n\ts_nop 7":"+v"(pA0),"+v"(pA1));CMASK(pA0,pA1,0);
  START(pA0,pA1);
  _Pragma("unroll") for(int r=0;r<16;++r)pA1[r]=__builtin_amdgcn_exp2f(SUBM(pA1[r]));
  WAIT_BAR(0);
  DMA_K(3,0);DMA_V(1,SLOTB);
  ROT();
  kload8(kf,kp0+sl_cur);
  WAIT_BAR(3);
  s16x4 vlo[8],vhi[8]; u32x4 pw0,pw1,pw2,pw3;
  #define PKW(P,B) cvtpk_s(P[B],P[B+1])
  #define PAF(k) __builtin_bit_cast(bf16x8,pw##k)
  #define VFR(i) (bf16x8){vlo[i][0],vlo[i][1],vlo[i][2],vlo[i][3],vhi[i][0],vhi[i][1],vhi[i][2],vhi[i][3]}
  #define PIN(x) asm volatile("":"+v"(x))
  #define MX3(a,b,c) __builtin_fmaxf(__builtin_fmaxf((a),(b)),(c))
  #define GAPA(MF,A0,A1,A2,A3,W0,W1,PW) do{ MF; sacc+=A0; sacc+=A1; sacc+=A2; sacc+=A3; PIN(sacc); W0; W1; PIN(PW); SBAR(); }while(0)
  #define EX(v) __builtin_amdgcn_exp2f(v)
  #define GAPB(MF,X,B) do{ MF; X[B]=EX(SUBM(X[B])); X[B+1]=EX(SUBM(X[B+1])); PIN(X); SBAR(); }while(0)
  #define VRD(i) do{ vlo[i]=vtr(vp_+(((i)>>2)*4096+((i)&3)*1024)); vhi[i]=vtr(vp_+(((i)>>2)*4096+((i)&3)*1024+512)); }while(0)
  #define VRD2(i) do{ vlo[i]=vtr(vp_+(8192+((i)>>2)*4096+((i)&3)*1024)); vhi[i]=vtr(vp_+(8192+((i)>>2)*4096+((i)&3)*1024+512)); SBAR(); }while(0)
  #define KRD(G,j) do{ if(G){ kload2(kf,kp0+sl_next,j); SBAR(); } }while(0)
  #define STEP(C0,C1,P0,P1,t,GK,GV,GL) do{ SBAR(); \
    const lds_cptr vp_=vp0+2*sl_prev; \
    VRD(0); SBAR(); float sacc=(P0[0]+P0[1]); \
    GAPA(C0=__builtin_amdgcn_mfma_f32_32x32x16_bf16(kf[0],qr[0],zero16,0,0,0), P0[2],P0[3],P0[4],P0[5],     pw0[0]=PKW(P0,0), pw0[1]=PKW(P0,2), pw0); \
    VRD(4); SBAR(); GAPA(C1=__builtin_amdgcn_mfma_f32_32x32x16_bf16(kf[1],qr[0],zero16,0,0,0), P0[6],P0[7],P0[8],P0[9],     pw0[2]=PKW(P0,4), pw0[3]=PKW(P0,6), pw0); \
    VRD(1); SBAR(); GAPA(C0=__builtin_amdgcn_mfma_f32_32x32x16_bf16(kf[2],qr[1],C0,0,0,0),   P0[10],P0[11],P0[12],P0[13], pw1[0]=PKW(P0,8), pw1[1]=PKW(P0,10), pw1); \
    VRD(5); SBAR(); GAPA(C1=__builtin_amdgcn_mfma_f32_32x32x16_bf16(kf[3],qr[1],C1,0,0,0),   P0[14],P0[15],P1[0],P1[1],   pw1[2]=PKW(P0,12),pw1[3]=PKW(P0,14), pw1); \
    VRD(2); SBAR(); GAPA(C0=__builtin_amdgcn_mfma_f32_32x32x16_bf16(kf[4],qr[2],C0,0,0,0),   P1[2],P1[3],P1[4],P1[5],     pw2[0]=PKW(P1,0), pw2[1]=PKW(P1,2), pw2); \
    VRD(6); SBAR(); GAPA(C1=__builtin_amdgcn_mfma_f32_32x32x16_bf16(kf[5],qr[2],C1,0,0,0),   P1[6],P1[7],P1[8],P1[9],     pw2[2]=PKW(P1,4), pw2[3]=PKW(P1,6), pw2); \
    VRD(3); SBAR(); GAPA(C0=__builtin_amdgcn_mfma_f32_32x32x16_bf16(kf[6],qr[3],C0,0,0,0),   P1[10],P1[11],P1[12],P1[13], pw3[0]=PKW(P1,8), pw3[1]=PKW(P1,10), pw3); \
    VRD(7); SBAR(); GAPA(C1=__builtin_amdgcn_mfma_f32_32x32x16_bf16(kf[7],qr[3],C1,0,0,0),   P1[14],P1[15],0.f,0.f,       pw3[2]=PKW(P1,12),pw3[3]=PKW(P1,14), pw3); \
    l_reg+=sacc; \
    if(GK){DMA_K((t)+3,sl_cur);} if(GV){DMA_V((t)+1,sl_next);} \
    CMASK(C0,C1,t); \
    if constexpr(THRL>=0){ float a=MX3(C0[0],C0[1],C1[0]),b=MX3(C0[2],C0[3],C1[1]); a=MX3(a,C1[2],C1[3]); \
      _Pragma("unroll") for(int r=4;r<16;r+=4){a=MX3(a,C0[r],C0[r+1]);b=MX3(b,C0[r+2],C0[r+3]);a=MX3(a,C1[r],C1[r+1]);b=MX3(b,C1[r+2],C1[r+3]);} \
      float rm=__builtin_fmaxf(a,b); { auto rr=__builtin_amdgcn_permlane32_swap(__float_as_uint(rm),__float_as_uint(rm),false,false); rm=__builtin_fmaxf(__uint_as_float(rr[0]),__uint_as_float(rr[1])); } \
      resc=false; \
      rm-=mhat; \
      if(__builtin_expect(__any(rm>(float)THRL),0)){ const float dl=__builtin_fmaxf(rm,0.f); mhat+=dl; \
        const float f=__builtin_amdgcn_exp2f(-dl); l_reg*=f; if(hi==0)wsf[r32]=f; resc=true; } } \
    SBAR(); \
    GAPB(o[0]=__builtin_amdgcn_mfma_f32_32x32x16_bf16(PAF(0),VFR(0),o[0],0,0,0), C0,0); VRD2(0); \
    GAPB(o[1]=__builtin_amdgcn_mfma_f32_32x32x16_bf16(PAF(0),VFR(4),o[1],0,0,0), C0,2); VRD2(4); \
    KRD(GL,0); GAPB(o[0]=__builtin_amdgcn_mfma_f32_32x32x16_bf16(PAF(1),VFR(1),o[0],0,0,0), C0,4); VRD2(1); \
    KRD(GL,1); GAPB(o[1]=__builtin_amdgcn_mfma_f32_32x32x16_bf16(PAF(1),VFR(5),o[1],0,0,0), C0,6); VRD2(5); \
    KRD(GL,2); GAPB(o[0]=__builtin_amdgcn_mfma_f32_32x32x16_bf16(PAF(2),VFR(2),o[0],0,0,0), C0,8); VRD2(2); \
    KRD(GL,3); GAPB(o[1]=__builtin_amdgcn_mfma_f32_32x32x16_bf16(PAF(2),VFR(6),o[1],0,0,0), C0,10); VRD2(6); \
    GAPB(o[0]=__builtin_amdgcn_mfma_f32_32x32x16_bf16(PAF(3),VFR(3),o[0],0,0,0), C0,12); VRD2(3); \
    GAPB(o[1]=__builtin_amdgcn_mfma_f32_32x32x16_bf16(PAF(3),VFR(7),o[1],0,0,0), C0,14); VRD2(7); \
    GAPB(o[2]=__builtin_amdgcn_mfma_f32_32x32x16_bf16(PAF(0),VFR(0),o[2],0,0,0), C1,0); \
    GAPB(o[3]=__builtin_amdgcn_mfma_f32_32x32x16_bf16(PAF(0),VFR(4),o[3],0,0,0), C1,2); \
    GAPB(o[2]=__builtin_amdgcn_mfma_f32_32x32x16_bf16(PAF(1),VFR(1),o[2],0,0,0), C1,4); \
    GAPB(o[3]=__builtin_amdgcn_mfma_f32_32x32x16_bf16(PAF(1),VFR(5),o[3],0,0,0), C1,6); \
    GAPB(o[2]=__builtin_amdgcn_mfma_f32_32x32x16_bf16(PAF(2),VFR(2),o[2],0,0,0), C1,8); \
    GAPB(o[3]=__builtin_amdgcn_mfma_f32_32x32x16_bf16(PAF(2),VFR(6),o[3],0,0,0), C1,10); \
    GAPB(o[2]=__builtin_amdgcn_mfma_f32_32x32x16_bf16(PAF(3),VFR(3),o[2],0,0,0), C1,12); \
    GAPB(o[3]=__builtin_amdgcn_mfma_f32_32x32x16_bf16(PAF(3),VFR(7),o[3],0,0,0), C1,14); \
    }while(0)
  int t=1;
  #undef CMASK
  #define CMASK(P0,P1,t) do{}while(0)
  for(;t+5<NT;t+=2){
    STEP(pB0,pB1,pA0,pA1,t,true,true,true);     WAIT_BAR(3); RESC(); ROT();
    STEP(pA0,pA1,pB0,pB1,t+1,true,true,true);   WAIT_BAR(3); RESC(); ROT();
  }
  #undef CMASK
  #define CMASK(P0,P1,t) do{}while(0)
  #define ENDW(tt) do{ if((tt)+3<NT){WAIT_BAR(3);} else if((tt)+2<NT){WAIT_BAR(2);} else {WAIT_BAR(0);} }while(0)
  for(;t+1<NT;t+=2){
    STEP(pB0,pB1,pA0,pA1,t,(t+3<NT),(t+1<NT),(t+1<NT));       ENDW(t);   RESC(); ROT();
    STEP(pA0,pA1,pB0,pB1,t+1,(t+4<NT),(t+2<NT),(t+2<NT));     ENDW(t+1); RESC(); ROT();
  }
  STEP(pB0,pB1,pA0,pA1,NT-1,false,false,false); RESC();
  { float sacc=pB0[0]+pB0[1]; _Pragma("unroll") for(int r=2;r<16;++r)sacc+=pB0[r]; _Pragma("unroll") for(int r=0;r<16;++r)sacc+=pB1[r]; l_reg+=sacc;
    pw0=(u32x4){PKW(pB0,0),PKW(pB0,2),PKW(pB0,4),PKW(pB0,6)};pw1=(u32x4){PKW(pB0,8),PKW(pB0,10),PKW(pB0,12),PKW(pB0,14)};pw2=(u32x4){PKW(pB1,0),PKW(pB1,2),PKW(pB1,4),PKW(pB1,6)};pw3=(u32x4){PKW(pB1,8),PKW(pB1,10),PKW(pB1,12),PKW(pB1,14)};
    SBAR(); pv(o,vb0+2*sl_cur,PAF(0),PAF(1),PAF(2),PAF(3)); pv(o+2,vb0+2*sl_cur+8192,PAF(0),PAF(1),PAF(2),PAF(3)); }
  #undef PKW
  #undef PAF
  #undef VFR
  #undef PIN
  #undef MX3
  #undef GAPA
  #undef GAPB
  #undef EX
  #undef VRD
  #undef VRD2
  #undef KRD
  #undef STEP
  #undef ENDW
  {auto rr=__builtin_amdgcn_permlane32_swap(__float_as_uint(l_reg),__float_as_uint(l_reg),false,false);l_reg=__uint_as_float(rr[0])+__uint_as_float(rr[1]);}
  if(hi==0)wsf[32+r32]=l_reg;asm volatile("s_waitcnt lgkmcnt(0)":::"memory");
  float rli[16];
  #pragma unroll
  for(int r=0;r<16;++r)rli[r]=__builtin_amdgcn_rcpf(wsf[32+crow(r,hi)]);
  bf16*Ow=Ou+(long)(wid*QBLK)*op;
  { bf16*stg=(bf16*)(shm+LDS2_OST)+wid*2048;
    #pragma unroll
    for(int hh=0;hh<2;++hh){
      #pragma unroll
      for(int r=0;r<16;++r){const int orow=crow(r,hi);
        #pragma unroll
        for(int d0=0;d0<2;++d0)stg[orow*64+d0*32+r32]=__float2bfloat16(o[2*hh+d0][r]*rli[r]);}
      asm volatile("s_waitcnt lgkmcnt(0)":::"memory");
      #pragma unroll
      for(int i=0;i<4;++i){const int row=i*8+(lane>>3),ch=lane&7; const u32x4 v=*(const u32x4*)(stg+row*64+ch*8); ATTN_STORE16(Ow+(long)row*op+hh*64+ch*8,v);}
      asm volatile("s_waitcnt lgkmcnt(0)":::"memory"); } }
  asm volatile("s_waitcnt lgkmcnt(0)\n\ts_barrier":::"memory");
  #undef DMA_K
  #undef ROTT
  #undef DMA_V
  #undef CMASK
  #undef START
  #undef RESC
  #undef ROT
}
constexpr int ATTN_LDS_BYTES=LDS_BYTES;
#undef SBAR
#undef WAIT_BAR
}
constexpr int NWAVES = 8;
#ifndef MK_ONE_LAUNCH
#define MK_ONE_LAUNCH 1
#endif
constexpr int NPH = 20;

constexpr int D = 1024, NB = 2, SEQ = 8192, CTXL = 256;
constexpr int ML = NB * SEQ, MC = NB * CTXL, MR = ML + MC;
constexpr int E_IN = 2560, O_IN = 1792, FF = 2816, FF2 = 2 * FF, NEXP = 8;
constexpr int MOE_ROWS = 2 * ML + NEXP * 256, MOE_PAN = MOE_ROWS / 256;
constexpr int NCHUNK = MR / 64;
constexpr float EPS = 1e-6f;
constexpr float MOE_S13 = 32.0f, MOE_S2 = 64.0f;
constexpr float QSCALE = 0.125f * 1.4426950408889634f;

constexpr size_t MiB = 1u << 20, KiB = 1u << 10;
constexpr size_t WS_CTL = 0, CTL_ZERO_BYTES = 1 * MiB;
constexpr size_t WS_MOD = 1 * MiB;
constexpr size_t WS_WG = 1 * MiB + 256 * KiB;
constexpr size_t WS_TOK = 2 * MiB;
constexpr size_t WS_AGG = 4 * MiB;
constexpr size_t WS_WM13 = 8 * MiB, WS_WM2 = 96 * MiB;
constexpr size_t WS_WE = 140 * MiB, WS_WO0 = 145 * MiB, WS_WO1 = 147 * MiB, WS_WF13 = 149 * MiB, WS_WF2 = 160 * MiB, WS_WOI = 166 * MiB;
constexpr size_t WS_XR = 170 * MiB;
constexpr size_t WS_KC0 = 170 * MiB, WS_VC0 = 187 * MiB;
constexpr size_t WS_KC1 = 427 * MiB, WS_VC1 = 432 * MiB;
constexpr int KEYS = CTXL + SEQ;
constexpr size_t WS_XN = 236 * MiB;
constexpr size_t WS_Y = 269 * MiB;
constexpr size_t WS_P0 = 302 * MiB;
constexpr size_t WS_OATT = 385 * MiB;
constexpr size_t WS_H = 302 * MiB;
constexpr size_t WS_P1 = 302 * MiB;
constexpr size_t WS_RI = 360 * MiB;
constexpr size_t WS_XG = 368 * MiB;
constexpr size_t WS_HG = 140 * MiB;
constexpr size_t WS_YG = 368 * MiB;
constexpr size_t WS_END = 436 * MiB;
static_assert(WS_WM13 + (size_t)NEXP * FF2 * D * 2 <= WS_WM2 && WS_WM2 + (size_t)NEXP * D * FF * 2 <= WS_WE && WS_WE + (size_t)E_IN * D * 2 <= WS_WO0 && WS_WF13 + (size_t)FF2 * D * 2 <= WS_WF2 &&
              WS_WF2 + (size_t)D * FF * 2 <= WS_WOI && WS_WOI + (size_t)O_IN * D * 2 <= WS_XR && WS_XR + (size_t)MR * D * 4 <= WS_XN && WS_XN + (size_t)MR * D * 2 <= WS_Y && WS_Y + (size_t)MR * D * 2 <= WS_P0 &&
              WS_P0 + (size_t)MR * E_IN * 2 <= WS_OATT && WS_OATT + (size_t)MR * D * 2 <= WS_END && WS_H + (size_t)MR * FF * 2 <= WS_END && WS_P1 + (size_t)MR * O_IN * 2 <= WS_RI &&
              WS_RI + (size_t)4 * MR * 512 * 2 <= WS_END && WS_XG + (size_t)MOE_ROWS * D * 2 <= WS_END && WS_HG + (size_t)MOE_ROWS * FF * 2 <= WS_XG && WS_AGG + (size_t)2 * NCHUNK * 2 * 512 * 4 <= WS_WM13, "d_ws map");
constexpr int CW_TMO = 0, CW_CODE = 1;
constexpr int CW_BAR = 4096;
constexpr int CW_CNT = 8192;
constexpr int RING_OFF = 0, RING_BYTES = 131072;
constexpr int LDSCTL_OFF = RING_BYTES, MISC_OFF = LDSCTL_OFF + 320;
constexpr int PEXP_OFF = LDSCTL_OFF + 1024;
constexpr int LDS_BYTES = 147456;
#define GAS __attribute__((address_space(1)))
#define LAS __attribute__((address_space(3)))
typedef unsigned short bf16;
typedef unsigned v4u __attribute__((ext_vector_type(4)));
typedef float f32x4 __attribute__((ext_vector_type(4)));
typedef short bf16x8 __attribute__((ext_vector_type(8)));
typedef GAS unsigned gu32;
typedef GAS unsigned long long gu64;
#define RLX_AGENT __ATOMIC_RELAXED, __HIP_MEMORY_SCOPE_AGENT
#define LDS_WAIT() asm volatile("s_waitcnt lgkmcnt(0)" ::: "memory")
#define VM_WAIT() asm volatile("s_waitcnt vmcnt(0)" ::: "memory")
__device__ __forceinline__ unsigned long long rt() { return __builtin_amdgcn_s_memrealtime(); }
__device__ __forceinline__ unsigned f2bf(float f) { unsigned u = __builtin_bit_cast(unsigned, f); return (u + 0x7fffu + ((u >> 16) & 1u)) >> 16; }
__device__ __forceinline__ unsigned pk2(float lo, float hi) { return f2bf(lo) | (f2bf(hi) << 16); }

#define XB_TMO      128
#define XB_XCNT(j)  (256  + 64 * (j))
#define XB_XSUB(j)  (1280 + 64 * (j))
#define XB_XGEN(j)  (2304 + 64 * (j))
#define XB_TOP      3328
#define XB_TOPGEN   3392
#define XCD_BAR_WORDS 3456
#define XB_SPIN_CAP (1u << 18)

__device__ __forceinline__ unsigned xb_ld(unsigned* p)              { return __hip_atomic_load(p, __ATOMIC_RELAXED, __HIP_MEMORY_SCOPE_AGENT); }
__device__ __forceinline__ unsigned xb_add(unsigned* p, unsigned v) { return __hip_atomic_fetch_add(p, v, __ATOMIC_RELAXED, __HIP_MEMORY_SCOPE_AGENT); }
__device__ __forceinline__ unsigned xb_xcc_id() { return (unsigned)__builtin_amdgcn_s_getreg((3 << 11) | 20) & 0xFu; }
#define XB_SPIN(cond, bar) do { unsigned _sp = 0; while (cond) { __builtin_amdgcn_s_sleep(1); \
    if ((++_sp & 255u) == 0u) { if (xb_ld(&(bar)[XB_TMO])) break; if (_sp > XB_SPIN_CAP) { atomicAdd(&(bar)[XB_TMO], 1u); break; } } } } while (0)

struct XcdBarrier {
    unsigned* bar; unsigned x;
    volatile LAS unsigned* st;
};

__device__ __forceinline__ XcdBarrier xcd_barrier_post(unsigned* bar, volatile LAS unsigned* st) {
    XcdBarrier b; b.bar = bar; b.x = xb_xcc_id(); b.st = st;
    if (threadIdx.x == 0) (void)xb_add(&bar[XB_XCNT(b.x)], 1u);
    return b;
}
__device__ __forceinline__ void xcd_barrier_complete(unsigned* bar, unsigned x, unsigned& nloc, unsigned& nx) {
    const unsigned G = gridDim.x * gridDim.y * gridDim.z;
    unsigned sum, cnt, mine, sp = 0u;
    for (;;) {
        sum = 0u; cnt = 0u; mine = 0u;
#pragma unroll
        for (unsigned j = 0; j < 16; ++j) { const unsigned c = xb_ld(&bar[XB_XCNT(j)]); sum += c; cnt += (c > 0u) ? 1u : 0u; mine = (j == x) ? c : mine; }
        if (sum == G) break;
        __builtin_amdgcn_s_sleep(1);
        if ((++sp & 255u) == 0u) { if (xb_ld(&bar[XB_TMO])) break; if (sp > XB_SPIN_CAP) { atomicAdd(&bar[XB_TMO], 1u); break; } }
    }
    nloc = mine > 0u ? mine : 1u; nx = cnt > 0u ? cnt : 1u;
}

__device__ __forceinline__ void xcd_barrier(const XcdBarrier& b) {
    asm volatile("s_waitcnt vmcnt(0)" ::: "memory");
    __syncthreads();
    if (threadIdx.x == 0) {
        unsigned* bar = b.bar;
        __builtin_amdgcn_s_waitcnt(0);
        unsigned nloc = b.st[0], nx = b.st[1];
        if (nloc == 0u) { xcd_barrier_complete(bar, b.x, nloc, nx); b.st[0] = nloc; b.st[1] = nx; }
        const unsigned old = xb_add(&bar[XB_XSUB(b.x)], 1u);
        const unsigned gen = old / nloc;
        if (old + 1u == (gen + 1u) * nloc) {
            __builtin_amdgcn_fence(__ATOMIC_RELEASE, "agent");
            asm volatile("s_waitcnt vmcnt(0)" ::: "memory");
            const unsigned og = xb_add(&bar[XB_TOP], 1u);
            const unsigned tg = og / nx;
            if (og + 1u == (tg + 1u) * nx) xb_add(&bar[XB_TOPGEN], 1u);
            else XB_SPIN(xb_ld(&bar[XB_TOPGEN]) == tg, bar);
            __builtin_amdgcn_fence(__ATOMIC_ACQUIRE, "agent");
            xb_add(&bar[XB_XGEN(b.x)], 1u);
            asm volatile("s_waitcnt vmcnt(0)" ::: "memory");
        } else {
            XB_SPIN(xb_ld(&bar[XB_XGEN(b.x)]) == gen, bar);
            __builtin_amdgcn_fence(__ATOMIC_ACQUIRE, "agent");
            asm volatile("s_waitcnt vmcnt(0)" ::: "memory");
        }
    }
    __syncthreads();
}
typedef _Float16 f16;
typedef unsigned v2u __attribute__((ext_vector_type(2)));
typedef float f32x16 __attribute__((ext_vector_type(16)));
struct InPtrs { __device__ __forceinline__ const float* operator[](int i) const { return ((const float* const __attribute__((address_space(4)))*)__builtin_amdgcn_kernarg_segment_ptr())[i]; } };
struct Frame {
    LAS unsigned char* lds;
    volatile LAS unsigned* MISC;
    gu32* ctl;
    int tid, lane, wave;
    int vcu, G;
    InPtrs in; float* out; unsigned char* ws;
};
enum { I_X = 0, I_C, I_CTX, I_CCTX, I_WMOD, I_BMOD, I_NMIXG, I_NFFNG, I_WOUT, I_EWIN, I_ANORMG, I_AWS, I_ABS, I_BQNG, I_BKNG, I_LQ1, I_LK1, I_LQ2, I_LK2, I_SUBLNG,
       I_FW1, I_FW3, I_FW2, I_OWIN, I_CQNG, I_CKNG, I_CONVW, I_CONVB, I_DWA, I_DBA, I_DWX, I_DBX, I_DLAM, I_RW, I_RB, I_MW1, I_MW3, I_MW2 };

__device__ __forceinline__ float wave_sum(float v) {
#pragma unroll
    for (int o = 1; o < 64; o <<= 1) v += __shfl_xor(v, o);
    return v;
}
__device__ __forceinline__ float bf_lo(unsigned u) { return __uint_as_float(u << 16); }
__device__ __forceinline__ float bf_hi(unsigned u) { return __uint_as_float(u & 0xffff0000u); }
__device__ __forceinline__ float bf2f(bf16 h) { return __uint_as_float((unsigned)h << 16); }
__device__ __forceinline__ unsigned cvtpk(float lo, float hi) { return pg8::cvt_pk_bf16(lo, hi); }
__device__ __forceinline__ bf16 f2bf16(float f) { return (bf16)(cvtpk(f, 0.f) & 0xffffu); }
__device__ __forceinline__ void unpack8(const v4u u, float (&f)[8]) { f[0] = bf_lo(u.x); f[1] = bf_hi(u.x); f[2] = bf_lo(u.y); f[3] = bf_hi(u.y); f[4] = bf_lo(u.z); f[5] = bf_hi(u.z); f[6] = bf_lo(u.w); f[7] = bf_hi(u.w); }
__device__ __forceinline__ v4u pack8(const float (&f)[8]) { v4u o; o.x = cvtpk(f[0], f[1]); o.y = cvtpk(f[2], f[3]); o.z = cvtpk(f[4], f[5]); o.w = cvtpk(f[6], f[7]); return o; }
__device__ __forceinline__ float gelu_tanh(float x) { const float z = 0.7978845608028654f * (x + 0.044715f * x * x * x); return x * __builtin_amdgcn_rcpf(1.0f + __builtin_amdgcn_exp2f(-2.885390081777927f * z)); }
__device__ __forceinline__ float sigmoid_f(float x) { return __builtin_amdgcn_rcpf(1.0f + __builtin_amdgcn_exp2f(-1.4426950408889634f * x)); }
__device__ __forceinline__ int crow16(int r, int hi) { return (r & 3) + 8 * (r >> 2) + 4 * hi; }

__device__ __forceinline__ bool qk_bounded(const float* gq, const float* gk, int lane) {
    float a = fabsf(gq[lane]), b = fabsf(gk[lane]);
#pragma unroll
    for (int o = 1; o < 64; o <<= 1) { a = fmaxf(a, __shfl_xor(a, o)); b = fmaxf(b, __shfl_xor(b, o)); }
    return __builtin_amdgcn_readfirstlane((int)(64.0f * QSCALE * a * b * 1.02f < 64.0f)) != 0;
}
__device__ __forceinline__ void tr_item(const float* W, int K, int N, bf16* WT, int ilv, LAS float* scr, int item, int lane) {
    const int nblk = N / 32, kb = item / nblk, nb = item % nblk, k0 = 64 * kb, n0 = 32 * nb;
    const int r0 = ilv ? ((n0 >> 7) * 256 + (n0 & 127) + (ilv == 2 ? 128 : 0)) : n0;
#pragma unroll 8
    for (int i = 0; i < 32; ++i) { const int kk = 2 * i + (lane >> 5); scr[kk * 33 + (lane & 31)] = W[(size_t)(k0 + kk) * N + n0 + (lane & 31)]; }
    LDS_WAIT(); asm volatile("" ::: "memory");
    const int c = lane & 7;
#pragma unroll
    for (int j = 0; j < 4; ++j) { const int n = (lane >> 3) + 8 * j; const LAS float* s = scr + (8 * c) * 33 + n;
        v4u o; o.x = cvtpk(s[0 * 33], s[1 * 33]); o.y = cvtpk(s[2 * 33], s[3 * 33]); o.z = cvtpk(s[4 * 33], s[5 * 33]); o.w = cvtpk(s[6 * 33], s[7 * 33]);
        *(GAS v4u*)(WT + (size_t)(r0 + n) * K + k0 + 8 * c) = o; }
    LDS_WAIT(); asm volatile("" ::: "memory");
}
__device__ __forceinline__ void tr_item_f8(const float* W, int K, int N, unsigned char* WT, int ilv, float scale, LAS float* scr, int item, int lane) {
    const int nblk = N / 32, kb = item / nblk, nb = item % nblk, k0 = 64 * kb, n0 = 32 * nb;
    const int r0 = ilv ? ((n0 >> 7) * 256 + (n0 & 127) + (ilv == 2 ? 128 : 0)) : n0;
#pragma unroll 8
    for (int i = 0; i < 32; ++i) { const int kk = 2 * i + (lane >> 5); scr[kk * 33 + (lane & 31)] = W[(size_t)(k0 + kk) * N + n0 + (lane & 31)] * scale; }
    LDS_WAIT(); asm volatile("" ::: "memory");
    const int c = lane & 3;
#pragma unroll
    for (int j = 0; j < 2; ++j) { const int n = (lane >> 2) + 16 * j; const LAS float* s = scr + (16 * c) * 33 + n;
        v4u o; o.x = pg8::cvt4_fp8(s[0 * 33], s[1 * 33], s[2 * 33], s[3 * 33]); o.y = pg8::cvt4_fp8(s[4 * 33], s[5 * 33], s[6 * 33], s[7 * 33]);
        o.z = pg8::cvt4_fp8(s[8 * 33], s[9 * 33], s[10 * 33], s[11 * 33]); o.w = pg8::cvt4_fp8(s[12 * 33], s[13 * 33], s[14 * 33], s[15 * 33]);
        *(GAS v4u*)(WT + (size_t)(r0 + n) * K + k0 + 16 * c) = o; }
    LDS_WAIT(); asm volatile("" ::: "memory");
}
__device__ __forceinline__ void ph0_prologue(Frame& F) {
    LAS float* scr = (LAS float*)(F.lds + RING_OFF + F.wave * 16384);
    const int gw = F.vcu * NWAVES + F.wave, NGW = F.G * NWAVES, lane = F.lane;
    bf16* WE = (bf16*)(F.ws + WS_WE); bf16* WO0 = (bf16*)(F.ws + WS_WO0); bf16* WO1 = (bf16*)(F.ws + WS_WO1); bf16* WF13 = (bf16*)(F.ws + WS_WF13); bf16* WF2 = (bf16*)(F.ws + WS_WF2);
    bf16* WOI = (bf16*)(F.ws + WS_WOI); unsigned char* WM13 = F.ws + WS_WM13; unsigned char* WM2 = F.ws + WS_WM2;
    constexpr int I_E = 16 * 80, I_O = 16 * 32, I_F = 16 * 88, I_F2 = 44 * 32, I_OI = 16 * 56, I_EXP = 3 * I_F;
    static_assert(I_F == I_F2, "item counts");
    constexpr int NITEMS = I_E + 2 * I_O + 2 * I_F + I_F2 + I_OI + NEXP * I_EXP;
    for (int it = gw; it < NITEMS; it += NGW) {
        int r = it;
        if (r < I_E) { tr_item(F.in[I_EWIN], D, E_IN, WE, 0, scr, r, lane); continue; } r -= I_E;
        if (r < I_O) { tr_item(F.in[I_WOUT], D, D, WO0, 0, scr, r, lane); continue; } r -= I_O;
        if (r < I_O) { tr_item(F.in[I_WOUT] + (size_t)D * D, D, D, WO1, 0, scr, r, lane); continue; } r -= I_O;
        if (r < I_F) { tr_item(F.in[I_FW1], D, FF, WF13, 1, scr, r, lane); continue; } r -= I_F;
        if (r < I_F) { tr_item(F.in[I_FW3], D, FF, WF13, 2, scr, r, lane); continue; } r -= I_F;
        if (r < I_F2) { tr_item(F.in[I_FW2], FF, D, WF2, 0, scr, r, lane); continue; } r -= I_F2;
        if (r < I_OI) { tr_item(F.in[I_OWIN], D, O_IN, WOI, 0, scr, r, lane); continue; } r -= I_OI;
        { const int e = r / I_EXP, q = r % I_EXP;
          if (q < I_F) tr_item_f8(F.in[I_MW1] + (size_t)e * D * FF, D, FF, WM13 + (size_t)e * FF2 * D, 1, MOE_S13, scr, q, lane);
          else if (q < 2 * I_F) tr_item_f8(F.in[I_MW3] + (size_t)e * D * FF, D, FF, WM13 + (size_t)e * FF2 * D, 2, MOE_S13, scr, q - I_F, lane);
          else tr_item_f8(F.in[I_MW2] + (size_t)e * FF * D, FF, D, WM2 + (size_t)e * D * FF, 0, MOE_S2, scr, q - 2 * I_F, lane); }
    }
    { bf16* WG = (bf16*)(F.ws + WS_WG);
      for (int i = (int)blockIdx.x * 512 + F.tid; i < 2 * 2 * 8 * 64 * 64; i += F.G * 512) {
          const int k = i & 63, o = (i >> 6) & 63, n = (i >> 12) & 7, mat = (i >> 15) & 1, d = (i >> 16) & 1;
          const float* W = mat ? F.in[I_DWX] : F.in[I_DWA];
          WG[i] = f2bf16(W[((size_t)(d * 8 + n) * 64 + k) * 64 + o]); } }
    __syncthreads();
    { float* MOD = (float*)(F.ws + WS_MOD); LAS float* red = (LAS float*)(F.lds + RING_OFF);
      for (int cg = (int)blockIdx.x; cg < 2 * 96; cg += F.G) {
          const int layer = cg / 96, n0 = (cg % 96) * 64, kr = lane >> 4, c4 = lane & 15;
          f32x4 acc[3]; acc[0] = acc[1] = acc[2] = (f32x4){0.f, 0.f, 0.f, 0.f};
          const float* Wl = F.in[I_WMOD] + (size_t)layer * D * 6 * D;
#pragma unroll 4
          for (int it = 0; it < 32; ++it) { const int k = F.wave * 128 + 4 * it + kr;
              const f32x4 w = *(const GAS f32x4*)(Wl + (size_t)k * 6 * D + n0 + 4 * c4);
              const float c0 = F.in[I_C][k], c1 = F.in[I_C][D + k], c2 = F.in[I_CCTX][k];
              acc[0] += (c0 * sigmoid_f(c0)) * w; acc[1] += (c1 * sigmoid_f(c1)) * w; acc[2] += (c2 * sigmoid_f(c2)) * w; }
#pragma unroll
          for (int s = 0; s < 3; ++s)
#pragma unroll
              for (int j = 0; j < 4; ++j) { float v = acc[s][j]; v += __shfl_xor(v, 16); v += __shfl_xor(v, 32); acc[s][j] = v; }
          if (lane < 16) {
#pragma unroll
              for (int s = 0; s < 3; ++s)
#pragma unroll
                  for (int j = 0; j < 4; ++j) red[(F.wave * 3 + s) * 64 + 4 * c4 + j] = acc[s][j]; }
          __syncthreads();
          if (F.tid < 192) { const int s = F.tid >> 6, col = F.tid & 63; float v = F.in[I_BMOD][layer * 6 * D + n0 + col];
#pragma unroll
              for (int w = 0; w < 8; ++w) v += red[(w * 3 + s) * 64 + col];
              MOD[(size_t)(layer * 3 + s) * 6 * D + n0 + col] = v; }
          __syncthreads();
      } }
}
__device__ __forceinline__ void normmod_row(const float* src, const float* g, const float* sc, const float* sh, bf16* dst, int lane, f32x4 (&t)[4]) {
    const GAS f32x4* xr = (const GAS f32x4*)src + lane; float s = 0.f;
#pragma unroll
    for (int j = 0; j < 4; ++j) { t[j] = xr[64 * j]; s += (t[j].x * t[j].x + t[j].y * t[j].y) + (t[j].z * t[j].z + t[j].w * t[j].w); }
    const float rstd = 1.0f / sqrtf(wave_sum(s) * (1.f / D) + EPS);
    GAS v2u* o8 = (GAS v2u*)dst + lane;
#pragma unroll
    for (int j = 0; j < 4; ++j) { const f32x4 gg = ((const GAS f32x4*)g)[lane + 64 * j], cc = ((const GAS f32x4*)sc)[lane + 64 * j], hh = ((const GAS f32x4*)sh)[lane + 64 * j];
        t[j] = t[j] * rstd * gg * (1.0f + cc) + hh; v2u w; w.x = cvtpk(t[j].x, t[j].y); w.y = cvtpk(t[j].z, t[j].w); o8[64 * j] = w; }
}
__device__ __forceinline__ void ph_normmod(Frame& F, const float* srcL, const float* srcC, int nrows, const float* g, int layer, int sh_off, int sc_off) {
    const int gw = F.vcu * NWAVES + F.wave, NGW = F.G * NWAVES; const float* MOD = (const float*)(F.ws + WS_MOD) + (size_t)layer * 3 * 6 * D; bf16* XN = (bf16*)(F.ws + WS_XN);
    for (int m = gw; m < nrows; m += NGW) { const int s = m < SEQ ? 0 : (m < ML ? 1 : 2); const float* src = m < ML ? srcL + (size_t)m * D : srcC + (size_t)(m - ML) * D; f32x4 t[4];
        normmod_row(src, g, MOD + s * 6 * D + sc_off, MOD + s * 6 * D + sh_off, XN + (size_t)m * D, F.lane, t); }
}
__device__ __forceinline__ void qknorm_rope(float (&f)[8], const float* g, bool rope, int prow, int pcol, float outscale, int lane) {
    float ss = 0.f;
#pragma unroll
    for (int e = 0; e < 8; ++e) ss += f[e] * f[e];
    ss += __shfl_xor(ss, 1); ss += __shfl_xor(ss, 2); ss += __shfl_xor(ss, 4);
    const float rstd = 1.0f / sqrtf(ss * (1.f / 64.f) + EPS); const int j = lane & 7;
    const f32x4 g0 = *(const GAS f32x4*)(g + 8 * j), g1 = *(const GAS f32x4*)(g + 8 * j + 4);
    const float gg[8] = {g0.x, g0.y, g0.z, g0.w, g1.x, g1.y, g1.z, g1.w};
#pragma unroll
    for (int e = 0; e < 8; ++e) f[e] = f[e] * rstd * gg[e];
    if (rope) {
        const float pos = (float)((j < 4) ? prow : pcol), sgn = (j & 2) ? 1.f : -1.f;
#pragma unroll
        for (int e = 0; e < 8; ++e) { const float p = __shfl_xor(f[e], 2); const int i = (j & 1) * 8 + e;
            const float fr = __builtin_amdgcn_exp2f(-(float)i * (13.287712379549449f / 16.f)); float rev = pos * fr * 0.15915494309189535f; rev = rev - floorf(rev);
            f[e] = f[e] * __builtin_amdgcn_cosf(rev) + sgn * p * __builtin_amdgcn_sinf(rev); }
    }
#pragma unroll
    for (int e = 0; e < 8; ++e) f[e] *= outscale;
}
__device__ __forceinline__ void ph3_post0(Frame& F) {
    const int gw = F.vcu * NWAVES + F.wave, NGW = F.G * NWAVES, lane = F.lane; bf16* P0 = (bf16*)(F.ws + WS_P0); bf16* KC = (bf16*)(F.ws + WS_KC0); bf16* VC = (bf16*)(F.ws + WS_VC0);
    for (int m = gw; m < MR; m += NGW) {
        GAS v4u* rowp = (GAS v4u*)(P0 + (size_t)m * E_IN) + lane;
        const v4u u0 = rowp[0], u1 = rowp[64], u2 = rowp[128], u3 = rowp[192];
        float f[8];
        unpack8(u0, f);
#pragma unroll
        for (int e = 0; e < 8; ++e) f[e] = gelu_tanh(f[e]);
        rowp[0] = pack8(f);
        unpack8(u1, f); float ss = 0.f;
#pragma unroll
        for (int e = 0; e < 8; ++e) { f[e] = gelu_tanh(f[e]); ss += f[e] * f[e]; }
        { const float rstd = 1.0f / sqrtf(wave_sum(ss) * (1.f / 512.f) + EPS); const float* g = F.in[I_ANORMG] + 8 * lane;
          const f32x4 g0 = *(const GAS f32x4*)g, g1 = *(const GAS f32x4*)(g + 4); const float gg[8] = {g0.x, g0.y, g0.z, g0.w, g1.x, g1.y, g1.z, g1.w};
#pragma unroll
          for (int e = 0; e < 8; ++e) f[e] = f[e] * rstd * gg[e]; }
        rowp[64] = pack8(f);
        const bool lat = m < ML; const int t = m & (SEQ - 1), prow = t >> 6, pcol = t & 63;
        unpack8(u2, f); qknorm_rope(f, F.in[I_BQNG], lat, prow, pcol, QSCALE, lane); rowp[128] = pack8(f);
        unpack8(u3, f); qknorm_rope(f, F.in[I_BKNG], lat, prow, pcol, 1.0f, lane);
        { const int b = lat ? (m >> 13) : ((m - ML) >> 8), pos = lat ? CTXL + t : ((m - ML) & (CTXL - 1)); const size_t tb = (size_t)(pos >> 6) * 4096; const int pr = pos & 63;
          *(GAS v4u*)(KC + ((size_t)(b * 8 + (lane >> 3)) * KEYS * 64 + tb + (lane & 7) * 512 + pr * 8)) = pack8(f);
          const v4u u4 = rowp[256];
          *(GAS v4u*)(VC + ((size_t)(b * 8 + (lane >> 3)) * KEYS * 64 + tb + ((((lane & 7) >> 2) * 4 + (pr >> 4)) * 64 + (pr & 15) * 4 + (lane & 3)) * 8)) = u4; }
    }
}
__device__ __forceinline__ void gmlp_unit(Frame& F, int chunk) {
    const int lane = F.lane, r32 = lane & 31, hi = lane >> 5, g = F.wave, r0 = chunk * 128;
    const bf16* P0 = (const bf16*)(F.ws + WS_P0); bf16* Y = (bf16*)(F.ws + WS_Y);
    const float* ws = F.in[I_AWS] + (size_t)g * 128 * 128; const float* bs = F.in[I_ABS] + g * 128;
    bf16x8 afr[2][8];
#pragma unroll
    for (int ct = 0; ct < 2; ++ct)
#pragma unroll
        for (int ks = 0; ks < 8; ++ks)
#pragma unroll
            for (int e = 0; e < 8; ++e) afr[ct][ks][e] = (short)P0[(size_t)(r0 + 16 * ks + 8 * hi + e) * E_IN + 512 + 64 * g + 32 * ct + r32];
#pragma unroll 1
    for (int pt = 0; pt < 4; ++pt) {
        f32x16 acc[2]; acc[0] = f32x16{}; acc[1] = f32x16{};
        const float* wp = ws + (size_t)(32 * pt + r32) * 128 + 8 * hi;
#pragma unroll
        for (int ks = 0; ks < 8; ++ks) { const f32x4 w0 = *(const GAS f32x4*)(wp + 16 * ks), w1 = *(const GAS f32x4*)(wp + 16 * ks + 4);
            v4u pk; pk.x = cvtpk(w0.x, w0.y); pk.y = cvtpk(w0.z, w0.w); pk.z = cvtpk(w1.x, w1.y); pk.w = cvtpk(w1.z, w1.w); const bf16x8 bfr = __builtin_bit_cast(bf16x8, pk);
            acc[0] = __builtin_amdgcn_mfma_f32_32x32x16_bf16(afr[0][ks], bfr, acc[0], 0, 0, 0); acc[1] = __builtin_amdgcn_mfma_f32_32x32x16_bf16(afr[1][ks], bfr, acc[1], 0, 0, 0); }
        const int p = 32 * pt + r32; const float bias = bs[p];
#pragma unroll
        for (int ct = 0; ct < 2; ++ct)
#pragma unroll
            for (int rq = 0; rq < 4; ++rq) { const int c0 = 64 * g + 32 * ct + 8 * rq + 4 * hi;
                const v2u uu = *(const GAS v2u*)(P0 + (size_t)(r0 + p) * E_IN + c0);
                v2u o; o.x = cvtpk(bf_lo(uu.x) * (acc[ct][4 * rq + 0] + bias), bf_hi(uu.x) * (acc[ct][4 * rq + 1] + bias)); o.y = cvtpk(bf_lo(uu.y) * (acc[ct][4 * rq + 2] + bias), bf_hi(uu.y) * (acc[ct][4 * rq + 3] + bias));
                *(GAS v2u*)(Y + (size_t)(r0 + p) * D + c0) = o; }
    }
}
__device__ __forceinline__ void ph5_diffout(Frame& F) {
    const int gw = F.vcu * NWAVES + F.wave, NGW = F.G * NWAVES, lane = F.lane; const bf16* OA = (const bf16*)(F.ws + WS_OATT); bf16* Y = (bf16*)(F.ws + WS_Y);
    const float s1 = wave_sum(F.in[I_LQ1][lane] * F.in[I_LK1][lane]), s2 = wave_sum(F.in[I_LQ2][lane] * F.in[I_LK2][lane]);
    const float lam_init = 0.2f, lam = expf(s1) - expf(s2) + lam_init;
    const int h = lane >> 4, comp = (lane >> 3) & 1, i0 = (lane & 7) * 16;
    float gg[16];
#pragma unroll
    for (int q = 0; q < 4; ++q) { const f32x4 gv = *(const GAS f32x4*)(F.in[I_SUBLNG] + i0 + 4 * q); gg[4 * q] = gv.x; gg[4 * q + 1] = gv.y; gg[4 * q + 2] = gv.z; gg[4 * q + 3] = gv.w; }
    for (int m = gw; m < MR; m += NGW) {
        const GAS v4u* rp = (const GAS v4u*)(OA + (size_t)m * D + 16 * lane);
        const v4u a = rp[0], b = rp[1]; float own[16], d[16];
        { float t8[8]; unpack8(a, t8);
#pragma unroll
          for (int e = 0; e < 8; ++e) own[e] = t8[e];
          unpack8(b, t8);
#pragma unroll
          for (int e = 0; e < 8; ++e) own[8 + e] = t8[e]; }
        float ss = 0.f;
#pragma unroll
        for (int e = 0; e < 16; ++e) { const float oth = __shfl_xor(own[e], 8); const float o1 = comp ? oth : own[e], o2 = comp ? own[e] : oth; d[e] = o1 - lam * o2; ss += d[e] * d[e]; }
        ss += __shfl_xor(ss, 1); ss += __shfl_xor(ss, 2); ss += __shfl_xor(ss, 4);
        const float rstd = (1.0f - lam_init) / sqrtf(ss * (1.f / 128.f) + EPS);
        if (comp == 0) { float o8[8]; GAS v4u* yp = (GAS v4u*)(Y + (size_t)m * D + 512 + 128 * h + i0);
#pragma unroll
            for (int e = 0; e < 8; ++e) o8[e] = d[e] * rstd * gg[e];
            yp[0] = pack8(o8);
#pragma unroll
            for (int e = 0; e < 8; ++e) o8[e] = d[8 + e] * rstd * gg[8 + e];
            yp[1] = pack8(o8); }
    }
}
__device__ __forceinline__ void ph12_post1(Frame& F) {
    const int gw = F.vcu * NWAVES + F.wave, NGW = F.G * NWAVES, lane = F.lane; bf16* P1 = (bf16*)(F.ws + WS_P1); bf16* KC = (bf16*)(F.ws + WS_KC1); bf16* VC = (bf16*)(F.ws + WS_VC1);
    for (int m = gw; m < MR; m += NGW) {
        GAS v4u* rowp = (GAS v4u*)(P1 + (size_t)m * O_IN) + lane;
        const v4u u0 = rowp[0], u1 = rowp[64];
        const bool lat = m < ML; const int t = m & (SEQ - 1), prow = t >> 6, pcol = t & 63; float f[8];
        unpack8(u0, f); qknorm_rope(f, F.in[I_CQNG], lat, prow, pcol, QSCALE, lane); if (lat) rowp[0] = pack8(f);
        unpack8(u1, f); qknorm_rope(f, F.in[I_CKNG], lat, prow, pcol, 1.0f, lane);
        { const int b = lat ? (m >> 13) : ((m - ML) >> 8), pos = lat ? CTXL + t : ((m - ML) & (CTXL - 1)); const size_t tb = (size_t)(pos >> 6) * 4096; const int pr = pos & 63, l2 = lane & 15;
          if (lane < 16) *(GAS v4u*)(KC + ((size_t)(b * 2 + (l2 >> 3)) * KEYS * 64 + tb + (l2 & 7) * 512 + pr * 8)) = pack8(f);
          else if (lane < 32) *(GAS v4u*)(VC + ((size_t)(b * 2 + (l2 >> 3)) * KEYS * 64 + tb + ((((l2 & 7) >> 2) * 4 + (pr >> 4)) * 64 + (pr & 15) * 4 + (l2 & 3)) * 8)) = u1; }
    }
}
__device__ __forceinline__ bool seq_start(int r) { return r < ML ? (r & (SEQ - 1)) == 0 : ((r - ML) & (CTXL - 1)) == 0; }
constexpr int XDS = 520;
__device__ __forceinline__ void conv_to_lds(Frame& F, int r0, LAS bf16* XD) {
    const int cg = F.lane, w = F.wave; const bf16* P1 = (const bf16*)(F.ws + WS_P1);
    const bool st = seq_start(r0), en = seq_start(r0 + 64) || (r0 + 64 == MR);
    float wj[4][8], cb[8];
#pragma unroll
    for (int j = 0; j < 4; ++j) { const f32x4 a = *(const GAS f32x4*)(F.in[I_CONVW] + j * 512 + 8 * cg), b = *(const GAS f32x4*)(F.in[I_CONVW] + j * 512 + 8 * cg + 4);
        wj[j][0] = a.x; wj[j][1] = a.y; wj[j][2] = a.z; wj[j][3] = a.w; wj[j][4] = b.x; wj[j][5] = b.y; wj[j][6] = b.z; wj[j][7] = b.w; }
    { const f32x4 a = *(const GAS f32x4*)(F.in[I_CONVB] + 8 * cg), b = *(const GAS f32x4*)(F.in[I_CONVB] + 8 * cg + 4); cb[0] = a.x; cb[1] = a.y; cb[2] = a.z; cb[3] = a.w; cb[4] = b.x; cb[5] = b.y; cb[6] = b.z; cb[7] = b.w; }
    v4u xr[11];
#pragma unroll
    for (int i = 0; i < 11; ++i) { const int rl = 8 * w + i - 2; const bool ok = !((st && rl < 0) || (en && rl >= 64));
        xr[i] = ok ? *(const GAS v4u*)(P1 + (size_t)(r0 + rl) * O_IN + 1280 + 8 * cg) : (v4u){0u, 0u, 0u, 0u}; }
    float acc[8][8];
#pragma unroll
    for (int o = 0; o < 8; ++o)
#pragma unroll
        for (int e = 0; e < 8; ++e) acc[o][e] = cb[e];
#pragma unroll
    for (int i = 0; i < 11; ++i) { float f[8]; unpack8(xr[i], f);
#pragma unroll
        for (int j = 0; j < 4; ++j) { const int o = i - j; if (o >= 0 && o < 8) {
#pragma unroll
            for (int e = 0; e < 8; ++e) acc[o][e] += wj[j][e] * f[e]; } } }
#pragma unroll
    for (int o = 0; o < 8; ++o) *(LAS v4u*)(XD + (8 * w + o) * XDS + 8 * cg) = pack8(acc[o]);
}
__device__ __forceinline__ void lru_gates(Frame& F, const LAS bf16* XD, int n, int d, int half, f32x16 (&a)[2], f32x16 (&b)[2]) {
    const int lane = F.lane, r32 = lane & 31, hi = lane >> 5; const bf16* WG = (const bf16*)(F.ws + WS_WG);
    f32x16 ai[2]; a[0] = f32x16{}; a[1] = f32x16{}; ai[0] = f32x16{}; ai[1] = f32x16{};
    const bf16* wpr = WG + ((size_t)(((d * 2 + 0) * 8 + n) * 64 + 32 * half + r32)) * 64 + 8 * hi; const bf16* wpi = WG + ((size_t)(((d * 2 + 1) * 8 + n) * 64 + 32 * half + r32)) * 64 + 8 * hi;
#pragma unroll
    for (int ks = 0; ks < 4; ++ks) { const bf16x8 br = *(const GAS bf16x8*)(wpr + 16 * ks), bi = *(const GAS bf16x8*)(wpi + 16 * ks);
#pragma unroll
        for (int mt = 0; mt < 2; ++mt) { const bf16x8 af = *(const LAS bf16x8*)(XD + (32 * mt + r32) * XDS + 64 * n + 16 * ks + 8 * hi);
            a[mt] = __builtin_amdgcn_mfma_f32_32x32x16_bf16(af, br, a[mt], 0, 0, 0); ai[mt] = __builtin_amdgcn_mfma_f32_32x32x16_bf16(af, bi, ai[mt], 0, 0, 0); } }
    __builtin_amdgcn_sched_barrier(0);
    const int ch = 64 * n + 32 * half + r32; const float ba = F.in[I_DBA][d * 512 + ch], bx = F.in[I_DBX][d * 512 + ch];
    const float sp8 = 8.0f * log1pf(expf(-F.in[I_DLAM][d * 512 + ch]));
#pragma unroll
    for (int mt = 0; mt < 2; ++mt)
#pragma unroll
        for (int r = 0; r < 16; ++r) { const int row = 32 * mt + crow16(r, hi); const float xd = bf2f(XD[row * XDS + ch]);
            const float rr = sigmoid_f(a[mt][r] + ba), ii = sigmoid_f(ai[mt][r] + bx); const float y = rr * sp8, av = __builtin_amdgcn_exp2f(y * -1.4426950408889634f);
            const float y2 = 2.0f * y, om = y2 < 0.03f ? y2 * (1.0f - y2 * (0.5f - y2 * (1.0f / 6.0f))) : fmaf(-av, av, 1.0f);
            a[mt][r] = av; b[mt][r] = sqrtf(om) * (ii * xd); if ((r & 3) == 3) __builtin_amdgcn_sched_barrier(0); }
}
template <bool REV, bool FULL> __device__ __forceinline__ void chunk_scan(f32x16 (&a)[2], f32x16 (&b)[2], int hi, float h0, float& Atot, float& Btot) {
    float GA[8], GB[8], pGA[8], pGB[8], carry[8];
#pragma unroll
    for (int j = 0; j < 8; ++j) { const int mt = j >> 2, q = j & 3;
#pragma unroll
        for (int p = 1; p < 4; ++p) { const int k = REV ? 3 - p : p, kp = REV ? k + 1 : k - 1; const float ak = a[mt][4 * q + k];
            b[mt][4 * q + k] = ak * b[mt][4 * q + kp] + b[mt][4 * q + k]; a[mt][4 * q + k] = ak * a[mt][4 * q + kp]; }
        GA[j] = a[mt][4 * q + (REV ? 0 : 3)]; GB[j] = b[mt][4 * q + (REV ? 0 : 3)]; }
#pragma unroll
    for (int j = 0; j < 8; ++j) { const auto ra = __builtin_amdgcn_permlane32_swap(__float_as_uint(GA[j]), __float_as_uint(GA[j]), false, false); pGA[j] = __uint_as_float(hi ? ra[0] : ra[1]);
        const auto rb = __builtin_amdgcn_permlane32_swap(__float_as_uint(GB[j]), __float_as_uint(GB[j]), false, false); pGB[j] = __uint_as_float(hi ? rb[0] : rb[1]); }
    float c = h0, At = 1.0f; const bool firstMine = REV ? (hi == 1) : (hi == 0);
#pragma unroll
    for (int jj = 0; jj < 8; ++jj) { const int j = REV ? 7 - jj : jj;
        const float A1 = firstMine ? GA[j] : pGA[j], B1 = firstMine ? GB[j] : pGB[j], A2 = firstMine ? pGA[j] : GA[j], B2 = firstMine ? pGB[j] : GB[j];
        const float c1 = A1 * c + B1; carry[j] = firstMine ? c : c1; c = A2 * c1 + B2; At *= GA[j] * pGA[j]; }
    Atot = At; Btot = c;
    if constexpr (FULL) {
#pragma unroll
        for (int j = 0; j < 8; ++j) { const int mt = j >> 2, q = j & 3;
#pragma unroll
            for (int k = 0; k < 4; ++k) b[mt][4 * q + k] = a[mt][4 * q + k] * carry[j] + b[mt][4 * q + k]; }
    }
}
__device__ __forceinline__ void scan_prep_unit(Frame& F, int cid) {
    const int r0 = cid * 64, lane = F.lane, r32 = lane & 31, hi = lane >> 5, n = F.wave; LAS bf16* XD = (LAS bf16*)(F.lds + RING_OFF); float* AGG = (float*)(F.ws + WS_AGG);
    conv_to_lds(F, r0, XD);
    LDS_WAIT(); __syncthreads();
#pragma unroll
    for (int d = 0; d < 2; ++d)
#pragma unroll
        for (int half = 0; half < 2; ++half) { f32x16 a[2], b[2]; lru_gates(F, XD, n, d, half, a, b); float At, Bt;
            if (d == 0) chunk_scan<false, false>(a, b, hi, 0.f, At, Bt); else chunk_scan<true, false>(a, b, hi, 0.f, At, Bt);
            if (hi == 0) { const int ch = 64 * n + 32 * half + r32; AGG[((size_t)(d * NCHUNK + cid) * 2 + 0) * 512 + ch] = At; AGG[((size_t)(d * NCHUNK + cid) * 2 + 1) * 512 + ch] = Bt; } }
    LDS_WAIT(); __syncthreads();
}
__device__ __forceinline__ void scan_fix_unit(Frame& F, int cid) {
    const int b = cid >> 7, j = cid & 127, r0 = cid * 64, lane = F.lane, r32 = lane & 31, hi = lane >> 5, n = F.wave;
    const float* AGG = (const float*)(F.ws + WS_AGG); const bf16* P1 = (const bf16*)(F.ws + WS_P1); bf16* Y = (bf16*)(F.ws + WS_Y);
    LAS bf16* XD = (LAS bf16*)(F.lds + RING_OFF); LAS float* CAR = (LAS float*)(F.lds + RING_OFF + 64 * XDS * 2);
    conv_to_lds(F, r0, XD);
    asm volatile("" ::: "memory"); __builtin_amdgcn_sched_barrier(0);
    { const int ch = F.tid; const float* A0 = AGG + ch; const float* A1 = AGG + (size_t)NCHUNK * 1024 + ch;
      float hf = 0.f, hb = 0.f;
#pragma unroll
      for (int q = 0; q < 4; ++q) { const int c = 256 + 4 * b + q; hf = A0[(size_t)c * 1024] * hf + A0[(size_t)c * 1024 + 512]; }
#pragma unroll 8
      for (int q = 0; q < j; ++q) { const int c = 128 * b + q; hf = A0[(size_t)c * 1024] * hf + A0[(size_t)c * 1024 + 512]; }
#pragma unroll
      for (int q = 3; q >= 0; --q) { const int c = 256 + 4 * b + q; hb = A1[(size_t)c * 1024] * hb + A1[(size_t)c * 1024 + 512]; }
#pragma unroll 8
      for (int q = 127; q > j; --q) { const int c = 128 * b + q; hb = A1[(size_t)c * 1024] * hb + A1[(size_t)c * 1024 + 512]; }
      CAR[ch] = hf; CAR[512 + ch] = hb; }
    LDS_WAIT(); __syncthreads();
#pragma unroll 1
    for (int half = 0; half < 2; ++half) { const int ch = 64 * n + 32 * half + r32; f32x16 a[2], hf[2], hb[2]; float At, Bt;
        lru_gates(F, XD, n, 0, half, a, hf); chunk_scan<false, true>(a, hf, hi, CAR[ch], At, Bt);
        __builtin_amdgcn_sched_barrier(0); lru_gates(F, XD, n, 1, half, a, hb); chunk_scan<true, true>(a, hb, hi, CAR[512 + ch], At, Bt);
        const bf16* gp = P1 + (size_t)r0 * O_IN + 768; bf16* yp = Y + (size_t)r0 * D + 512;
#pragma unroll
        for (int mt = 0; mt < 2; ++mt)
#pragma unroll
            for (int q = 0; q < 4; ++q) {
#pragma unroll
                for (int k = 0; k < 4; ++k) { const unsigned rl = (unsigned)(32 * mt + 8 * q + 4 * hi + k); const float gt = bf2f(gp[rl * (unsigned)O_IN + (unsigned)ch]);
                    yp[rl * (unsigned)D + (unsigned)ch] = f2bf16((hf[mt][4 * q + k] + hb[mt][4 * q + k]) * gelu_tanh(gt)); }
                asm volatile("" ::: "memory"); } }
    LDS_WAIT(); __syncthreads();
}
__device__ __forceinline__ void ph15_router(Frame& F) {
    LAS float* WR = (LAS float*)(F.lds + RING_OFF);
    LAS int* lcnt = (LAS int*)(F.lds + RING_OFF + 32768); LAS int* lbase = lcnt + 8; LAS int* rec = lcnt + 16;
    const int lane = F.lane; const float* MOD = (const float*)(F.ws + WS_MOD) + (size_t)3 * 6 * D; bf16* XN = (bf16*)(F.ws + WS_XN); int* TOK = (int*)(F.ws + WS_TOK);
    for (int i = F.tid; i < 1024 * 8 / 4; i += NWAVES * 64) ((LAS f32x4*)WR)[i] = ((const GAS f32x4*)F.in[I_RW])[i];
    __syncthreads();
    for (int rb = F.vcu; rb < ML / 64; rb += F.G) {
        if (F.tid < 8) lcnt[F.tid] = 0;
        __syncthreads();
#pragma unroll 1
        for (int i = 0; i < 8; ++i) { const int m = rb * 64 + F.wave * 8 + i, s = m >> 13; f32x4 t[4];
            normmod_row(F.out + (size_t)m * D, F.in[I_NFFNG] + D, MOD + s * 6 * D + 4 * D, MOD + s * 6 * D + 3 * D, XN + (size_t)m * D, lane, t);
            float lg[8];
#pragma unroll
            for (int e = 0; e < 8; ++e) lg[e] = 0.f;
#pragma unroll
            for (int j = 0; j < 4; ++j)
#pragma unroll
                for (int k = 0; k < 4; ++k) { const int c = 4 * lane + 256 * j + k; const f32x4 w0 = *(const LAS f32x4*)(WR + c * 8), w1 = *(const LAS f32x4*)(WR + c * 8 + 4); const float tv = t[j][k];
                    lg[0] += tv * w0.x; lg[1] += tv * w0.y; lg[2] += tv * w0.z; lg[3] += tv * w0.w; lg[4] += tv * w1.x; lg[5] += tv * w1.y; lg[6] += tv * w1.z; lg[7] += tv * w1.w; }
#pragma unroll
            for (int e = 0; e < 8; ++e) lg[e] = wave_sum(lg[e]) + F.in[I_RB][e];
            int e1 = 0; float v1 = lg[0];
#pragma unroll
            for (int e = 1; e < 8; ++e) if (lg[e] > v1) { v1 = lg[e]; e1 = e; }
            int e2 = -1; float v2 = -INFINITY;
#pragma unroll
            for (int e = 0; e < 8; ++e) if (e != e1 && lg[e] > v2) { v2 = lg[e]; e2 = e; }
            const float g1 = 1.0f / (1.0f + expf(v2 - v1)), g2 = 1.0f - g1;
            if (lane == 0) { LAS int* rc = rec + (F.wave * 8 + i) * 6; rc[0] = e1; rc[1] = e2; rc[2] = atomicAdd((int*)(lcnt + e1), 1); rc[3] = atomicAdd((int*)(lcnt + e2), 1); rc[4] = __float_as_int(g1); rc[5] = __float_as_int(g2); }
        }
        __syncthreads();
        if (F.tid < 8) lbase[F.tid] = (int)__hip_atomic_fetch_add((unsigned*)(F.ctl + CW_CNT + 64 * F.tid), (unsigned)lcnt[F.tid], __ATOMIC_RELAXED, __HIP_MEMORY_SCOPE_AGENT);
        __syncthreads();
        if (F.tid < 64) { const LAS int* rc = rec + F.tid * 6; int* tk = TOK + (size_t)(rb * 64 + F.tid) * 6;
            tk[0] = rc[0]; tk[1] = rc[1]; tk[2] = lbase[rc[0]] + rc[2]; tk[3] = lbase[rc[1]] + rc[3]; tk[4] = rc[4]; tk[5] = rc[5]; }
        __syncthreads();
    }
}
__device__ __forceinline__ void moe_offsets(Frame& F, int (&off)[9]) {
    int o = 0;
#pragma unroll
    for (int e = 0; e < 8; ++e) { off[e] = o; const int c = (int)__hip_atomic_load((unsigned*)(F.ctl + CW_CNT + 64 * e), __ATOMIC_RELAXED, __HIP_MEMORY_SCOPE_AGENT); o += (c + 255) & ~255; }
    off[8] = o;
}
__device__ __forceinline__ void ph16_gather(Frame& F) {
    int off[9]; moe_offsets(F, off);
    const int gw = F.vcu * NWAVES + F.wave, NGW = F.G * NWAVES, lane = F.lane; const bf16* XN = (const bf16*)(F.ws + WS_XN); unsigned char* XG = F.ws + WS_XG; const int* TOK = (const int*)(F.ws + WS_TOK);
    for (int p = gw; p < 2 * ML; p += NGW) { const int tok = p >> 1, k = p & 1; const int e = TOK[(size_t)tok * 6 + k], pos = TOK[(size_t)tok * 6 + 2 + k];
        int base = 0;
#pragma unroll
        for (int q = 0; q < 8; ++q) base = (e == q) ? off[q] : base;
        const GAS v4u* src = (const GAS v4u*)(XN + (size_t)tok * D + 16 * lane); const v4u a = src[0], b = src[1]; float f[8], g[8]; unpack8(a, f); unpack8(b, g);
        v4u o; o.x = pg8::cvt4_fp8(f[0], f[1], f[2], f[3]); o.y = pg8::cvt4_fp8(f[4], f[5], f[6], f[7]); o.z = pg8::cvt4_fp8(g[0], g[1], g[2], g[3]); o.w = pg8::cvt4_fp8(g[4], g[5], g[6], g[7]);
        *(GAS v4u*)(XG + (size_t)(base + pos) * D + 16 * lane) = o; }
}
__device__ __forceinline__ int moe_tables(Frame& F) {
    int off[9]; moe_offsets(F, off); LAS int* pexp = (LAS int*)(F.lds + PEXP_OFF);
    if (F.tid < MOE_PAN) { const int r = F.tid * 256; int e = 0;
#pragma unroll
        for (int q = 1; q < 8; ++q) e = (r >= off[q]) ? q : e;
        pexp[F.tid] = e; }
    __syncthreads();
    return off[8] / 256;
}
__device__ __forceinline__ void ph19_combine(Frame& F) {
    int off[9]; moe_offsets(F, off);
    const int gw = F.vcu * NWAVES + F.wave, NGW = F.G * NWAVES, lane = F.lane; const bf16* YG = (const bf16*)(F.ws + WS_YG); const int* TOK = (const int*)(F.ws + WS_TOK);
    const float* MOD = (const float*)(F.ws + WS_MOD) + (size_t)3 * 6 * D;
    for (int m = gw; m < ML; m += NGW) { const int* tk = TOK + (size_t)m * 6; const int e1 = tk[0], e2 = tk[1]; int b1 = 0, b2 = 0;
#pragma unroll
        for (int q = 0; q < 8; ++q) { b1 = (e1 == q) ? off[q] : b1; b2 = (e2 == q) ? off[q] : b2; }
        const float g1 = __int_as_float(tk[4]), g2 = __int_as_float(tk[5]); const float* gp = MOD + (m >> 13) * 6 * D + 5 * D;
        const GAS v2u* y1 = (const GAS v2u*)(YG + (size_t)(b1 + tk[2]) * D) + lane; const GAS v2u* y2 = (const GAS v2u*)(YG + (size_t)(b2 + tk[3]) * D) + lane;
        GAS f32x4* o = (GAS f32x4*)(F.out + (size_t)m * D) + lane;
#pragma unroll
        for (int j = 0; j < 4; ++j) { const v2u a = y1[64 * j], b = y2[64 * j]; const f32x4 gv = ((const GAS f32x4*)gp)[lane + 64 * j]; f32x4 x = o[64 * j];
            x.x += gv.x * (g1 * bf_lo(a.x) + g2 * bf_lo(b.x)); x.y += gv.y * (g1 * bf_hi(a.x) + g2 * bf_hi(b.x)); x.z += gv.z * (g1 * bf_lo(a.y) + g2 * bf_lo(b.y)); x.w += gv.w * (g1 * bf_hi(a.y) + g2 * bf_hi(b.y));
            o[64 * j] = x; } }
}
struct Args { const float* in[38]; float* out; unsigned char* ws; int ph_lo, ph_hi; };
__global__ void __launch_bounds__(NWAVES * 64, 2) mk_fwd(Args args) {
    extern __shared__ __attribute__((aligned(16))) unsigned char lds[];
    Frame F;
    F.lds = (LAS unsigned char*)lds;
    F.MISC = (volatile LAS unsigned*)(F.lds + MISC_OFF);
    F.tid = threadIdx.x; F.lane = F.tid & 63; F.wave = __builtin_amdgcn_readfirstlane(F.tid >> 6);
    F.G = gridDim.x; { const int bx = blockIdx.x; F.vcu = (F.G % 8 == 0) ? (bx % 8) * (F.G / 8) + bx / 8 : bx; }
    F.ws = args.ws; F.out = args.out; F.ctl = (gu32*)(args.ws + WS_CTL);
    for (int u = F.tid; u < (LDS_BYTES - LDSCTL_OFF) / 4; u += NWAVES * 64) ((LAS unsigned*)(F.lds + LDSCTL_OFF))[u] = 0u;
    __syncthreads();
    XcdBarrier bar; bar.bar = (unsigned*)(F.ctl + CW_BAR); bar.x = 0; bar.st = nullptr;
    if (MK_ONE_LAUNCH) bar = xcd_barrier_post((unsigned*)(F.ctl + CW_BAR), F.MISC + 8);
#define GRID_BAR() do { if (MK_ONE_LAUNCH) xcd_barrier(bar); } while (0)
    const int lo = args.ph_lo, hi = args.ph_hi;
#define IN(k) (lo <= (k) && (k) < hi)
#define BOTH(k) (IN(k) && IN((k) + 1))
#ifndef MK_REP_MASK
#define MK_REP_MASK 0
#endif
#define REP(k) for (int rep_ = 0; rep_ < (((MK_REP_MASK >> (k)) & 1) ? 2 : 1); ++rep_)
    unsigned char* ws = args.ws;
    bf16* XN = (bf16*)(ws + WS_XN); bf16* Y = (bf16*)(ws + WS_Y); bf16* P0 = (bf16*)(ws + WS_P0); bf16* P1 = (bf16*)(ws + WS_P1); bf16* OA = (bf16*)(ws + WS_OATT); bf16* Hb = (bf16*)(ws + WS_H);
    float* XR = (float*)(ws + WS_XR); const float* MOD = (const float*)(ws + WS_MOD);
    using ABF = attn_body::bf16;

    if (IN(0)) { REP(0) { ph0_prologue(F); __syncthreads(); } if (BOTH(0)) GRID_BAR(); }
    if (IN(1)) { REP(1) ph_normmod(F, F.in[I_X], F.in[I_CTX], MR, F.in[I_NMIXG], 0, 0, D); if (BOTH(1)) GRID_BAR(); }
    if (IN(2)) {
        pg8::Gemm g{XN, (const bf16*)(ws + WS_WE), MR, E_IN, D}; pg8::StaticOrder S; S.init(MR, E_IN, F.G, (int)blockIdx.x);
        pg8::EpiBf16<0> E{P0, E_IN, nullptr, 0, 0, 1.f};
        REP(2) pg8::gemm_phase<pg8::EpiBf16<0>, pg8::StaticOrder, PG8_ALIGN, PG8_SP2>(F.lds + RING_OFF, g, S, E);
        if (BOTH(2)) GRID_BAR();
    }
    if (IN(3)) { ph3_post0(F); if (BOTH(3)) GRID_BAR(); }
    if (IN(4)) {
        const bool nomax0 = qk_bounded(F.in[I_BQNG], F.in[I_BKNG], F.lane);
        REP(4) for (int i = 0;; ++i) { const int L = i * F.G + F.vcu; if (L >= 512 + 16) break;
            const bool lat = L < 512; const int bh = lat ? (L >> 5) : (L - 512), qb = lat ? (L & 31) : 0, b = bh >> 3, hq = bh & 7, h = hq >> 1;
            const size_t qrow0 = lat ? (size_t)b * SEQ + (size_t)qb * 256 : (size_t)(ML + b * CTXL);
            const ABF* Ks = (const ABF*)(ws + WS_KC0) + (size_t)(b * 8 + hq) * KEYS * 64; const ABF* Vs = (const ABF*)(ws + WS_VC0) + (size_t)(b * 8 + 2 * h) * KEYS * 64;
            if (nomax0) attn_body::attn_unit2<-1>((const ABF*)(P0 + qrow0 * E_IN + 1024 + 64 * hq), E_IN, Ks, Vs, Vs + (size_t)KEYS * 64, (ABF*)(OA + qrow0 * D + 128 * hq), D, lat ? 132 : 4, lat ? (F.vcu & 31) * 4 : 0, (char*)lds + RING_OFF);
            else attn_body::attn_unit2<8>((const ABF*)(P0 + qrow0 * E_IN + 1024 + 64 * hq), E_IN, Ks, Vs, Vs + (size_t)KEYS * 64, (ABF*)(OA + qrow0 * D + 128 * hq), D, lat ? 132 : 4, lat ? (F.vcu & 31) * 4 : 0, (char*)lds + RING_OFF); }
        REP(4) for (int c = F.vcu - 32; c >= 0 && c < MR / 128; c += F.G) gmlp_unit(F, c);
        if (BOTH(4)) GRID_BAR();
    }
    if (IN(5)) { REP(5) ph5_diffout(F); if (BOTH(5)) GRID_BAR(); }
    if (IN(6)) {
        pg8::Gemm g{Y, (const bf16*)(ws + WS_WO0), MR, D, D}; pg8::StaticOrder S; S.init(MR, D, F.G, (int)blockIdx.x);
        pg8::EpiResGate E{F.in[I_X], F.in[I_CTX], XR, MOD + 2 * D};
        REP(6) pg8::gemm_phase<pg8::EpiResGate, pg8::StaticOrder, PG8_ALIGN, PG8_SP2>(F.lds + RING_OFF, g, S, E);
        if (BOTH(6)) GRID_BAR();
    }
    if (IN(7)) { REP(7) ph_normmod(F, XR, XR + (size_t)ML * D, MR, F.in[I_NFFNG], 0, 3 * D, 4 * D); if (BOTH(7)) GRID_BAR(); }
    if (IN(8)) {
        pg8::Gemm g{XN, (const bf16*)(ws + WS_WF13), MR, FF2, D}; pg8::StaticOrder S; S.init(MR, FF2, F.G, (int)blockIdx.x);
        pg8::EpiSwiGLU E{Hb, FF, FF2 / 256};
        REP(8) pg8::gemm_phase<pg8::EpiSwiGLU, pg8::StaticOrder, PG8_ALIGN, PG8_SP2>(F.lds + RING_OFF, g, S, E);
        if (BOTH(8)) GRID_BAR();
    }
    if (IN(9)) {
        pg8::Gemm g{Hb, (const bf16*)(ws + WS_WF2), MR, D, FF}; pg8::StaticOrder S; S.init(MR, D, F.G, (int)blockIdx.x);
        pg8::EpiResGate E{XR, XR + (size_t)ML * D, XR, MOD + 5 * D};
        REP(9) pg8::gemm_phase<pg8::EpiResGate, pg8::StaticOrder, PG8_ALIGN, PG8_SP2>(F.lds + RING_OFF, g, S, E);
        if (BOTH(9)) GRID_BAR();
    }
    if (IN(10)) { REP(10) ph_normmod(F, XR, XR + (size_t)ML * D, MR, F.in[I_NMIXG] + D, 1, 0, D); if (BOTH(10)) GRID_BAR(); }
    if (IN(11)) {
        pg8::Gemm g{XN, (const bf16*)(ws + WS_WOI), MR, O_IN, D}; pg8::StaticOrder S; S.init(MR, O_IN, F.G, (int)blockIdx.x);
        pg8::EpiBf16<0> E{P1, O_IN, nullptr, 0, 0, 1.f};
        REP(11) pg8::gemm_phase<pg8::EpiBf16<0>, pg8::StaticOrder, PG8_ALIGN, PG8_SP2>(F.lds + RING_OFF, g, S, E);
        if (BOTH(11)) GRID_BAR();
    }
    if (IN(12)) {
        ph12_post1(F);
        REP(12) for (int c = F.vcu; c < NCHUNK; c += F.G) scan_prep_unit(F, c);
        if (BOTH(12)) GRID_BAR();
    }
    if (IN(13)) {
        REP(13) for (int c = F.vcu; c < ML / 64; c += F.G) scan_fix_unit(F, c);
        const bool nomax1 = qk_bounded(F.in[I_CQNG], F.in[I_CKNG], F.lane);
        REP(13) for (int i = 0;; ++i) { const int L = i * F.G + F.vcu; if (L >= 512) break;
            const int bh = L >> 5, qb = L & 31, b = bh >> 3, hq = bh & 7, kv = hq >> 2;
            const size_t crow0 = (size_t)(ML + b * CTXL), lrow0 = (size_t)b * SEQ, qrow0 = lrow0 + (size_t)qb * 256;
            const ABF* Ks = (const ABF*)(ws + WS_KC1) + (size_t)(b * 2 + kv) * KEYS * 64; const ABF* Vs = (const ABF*)(ws + WS_VC1) + (size_t)(b * 2 + kv) * KEYS * 64;
            if (nomax1) attn_body::attn_unit<-1, true>((const ABF*)(P1 + qrow0 * O_IN + 64 * hq), O_IN, Ks, Ks + 4 * 4096, 64, Vs, Vs + 4 * 4096, 64, (ABF*)(Y + qrow0 * D + 64 * hq), D, 132, 4, (F.vcu & 31) * 4, (char*)lds + RING_OFF);
            else attn_body::attn_unit<8, true>((const ABF*)(P1 + qrow0 * O_IN + 64 * hq), O_IN, Ks, Ks + 4 * 4096, 64, Vs, Vs + 4 * 4096, 64, (ABF*)(Y + qrow0 * D + 64 * hq), D, 132, 4, (F.vcu & 31) * 4, (char*)lds + RING_OFF); }
        if (BOTH(13)) GRID_BAR();
    }
    if (IN(14)) {
        pg8::Gemm g{Y, (const bf16*)(ws + WS_WO1), ML, D, D}; pg8::StaticOrder S; S.init(ML, D, F.G, (int)blockIdx.x);
        pg8::EpiResGate E{XR, XR, F.out, MOD + 3 * 6 * D + 2 * D};
        REP(14) pg8::gemm_phase<pg8::EpiResGate, pg8::StaticOrder, PG8_ALIGN, PG8_SP2>(F.lds + RING_OFF, g, S, E);
        if (BOTH(14)) GRID_BAR();
    }
    if (IN(15)) { ph15_router(F); if (BOTH(15)) GRID_BAR(); }
    if (IN(16)) { REP(16) ph16_gather(F); if (BOTH(16)) GRID_BAR(); }
    if (IN(17)) {
        const int npan = moe_tables(F);
        pg8::Gemm g{(const bf16*)(ws + WS_XG), (const bf16*)(ws + WS_WM13), MOE_ROWS, NEXP * FF2, D / 2}; pg8::MoeOrder S{npan, FF2 / 256, F.G, F.vcu, (const LAS int*)(F.lds + PEXP_OFF)};
        pg8::EpiSwiGLUF8 E{ws + WS_HG, FF, FF2 / 256, 1.0f / MOE_S13};
        REP(17) pg8::gemm_phase<pg8::EpiSwiGLUF8, pg8::MoeOrder, PG8_ALIGN, PG8_SP2, true>(F.lds + RING_OFF, g, S, E);
        if (BOTH(17)) GRID_BAR();
    }
    if (IN(18)) {
        const int npan = moe_tables(F);
        pg8::Gemm g{(const bf16*)(ws + WS_HG), (const bf16*)(ws + WS_WM2), MOE_ROWS, NEXP * D, FF / 2}; pg8::MoeOrder S{npan, D / 256, F.G, F.vcu, (const LAS int*)(F.lds + PEXP_OFF)};
        pg8::EpiBf16S E{(bf16*)(ws + WS_YG), D, D / 256, 1.0f / MOE_S2};
        REP(18) pg8::gemm_phase<pg8::EpiBf16S, pg8::MoeOrder, PG8_ALIGN, PG8_SP2, true>(F.lds + RING_OFF, g, S, E);
        if (BOTH(18)) GRID_BAR();
    }
    if (IN(19)) { ph19_combine(F); }
#undef IN
#undef BOTH
#undef GRID_BAR
}

extern "C" void kernel_launch(void* const* d_in, const int* in_sizes, int n_in, void* d_out, int out_size, void* d_ws, size_t ws_size, hipStream_t stream) {
    static int grid = 0;
    if (grid == 0) {
        if (n_in != 38 || in_sizes[0] != ML * D || out_size != ML * D || ws_size < WS_END) { fprintf(stderr, "kernel_launch: built for 38 inputs, x/out of %d floats, >= %zu bytes of workspace; got n_in %d, in0 %d, out %d, ws %zu; nothing launched\n", ML * D, (size_t)WS_END, n_in, n_in > 0 ? in_sizes[0] : -1, out_size, ws_size); grid = -1; return; }
        int dev = 0, cus = 0, per_cu = 0;
        if (hipGetDevice(&dev) != hipSuccess || hipDeviceGetAttribute(&cus, hipDeviceAttributeMultiprocessorCount, dev) != hipSuccess) { fprintf(stderr, "kernel_launch: device query failed\n"); grid = -1; return; }
        if (hipFuncSetAttribute((const void*)mk_fwd, hipFuncAttributeMaxDynamicSharedMemorySize, LDS_BYTES) != hipSuccess) { fprintf(stderr, "kernel_launch: hipFuncSetAttribute failed\n"); grid = -1; return; }
        if (hipOccupancyMaxActiveBlocksPerMultiprocessor(&per_cu, (const void*)mk_fwd, NWAVES * 64, LDS_BYTES) != hipSuccess || per_cu < 1) fprintf(stderr, "kernel_launch: note: occupancy query reports %d workgroups per CU\n", per_cu);
        (void)hipGetLastError();
        grid = cus;
    }
    if (grid < 0) return;
    if (hipMemsetAsync((char*)d_ws + WS_CTL, 0, CTL_ZERO_BYTES, stream) != hipSuccess) { fprintf(stderr, "kernel_launch: hipMemsetAsync failed\n"); return; }
    Args a{};
    for (int i = 0; i < 38; ++i) a.in[i] = (const float*)d_in[i];
    a.out = (float*)d_out; a.ws = (unsigned char*)d_ws;
#if MK_ONE_LAUNCH
    a.ph_lo = 0; a.ph_hi = NPH;
    hipLaunchKernelGGL(mk_fwd, dim3(grid), dim3(NWAVES * 64), LDS_BYTES, stream, a);
#else
    for (int ph = 0; ph < NPH; ++ph) { a.ph_lo = ph; a.ph_hi = ph + 1; hipLaunchKernelGGL(mk_fwd, dim3(grid), dim3(NWAVES * 64), LDS_BYTES, stream, a); }
#endif
    const hipError_t le = hipPeekAtLastError();
    if (le != hipSuccess) fprintf(stderr, "kernel_launch: launch failed: %s\n", hipGetErrorName(le));
}
```

```cpp
#include <hip/hip_runtime.h>
#include <cstdio>
#include <cstdint>
#include <cmath>
namespace pg8 {
#define PG8_LAS __attribute__((address_space(3)))
typedef unsigned short bf16_t;
typedef short bf16x8 __attribute__((ext_vector_type(8)));
typedef float f32x4 __attribute__((ext_vector_type(4)));
typedef unsigned u32x4 __attribute__((ext_vector_type(4)));
typedef int i32x4 __attribute__((ext_vector_type(4)));
typedef int i32x8 __attribute__((ext_vector_type(8)));
typedef unsigned u32x2 __attribute__((ext_vector_type(2)));
constexpr int BM = 256, BK = 64, HALF = 128, HTB = HALF * BK * 2  , STAGE_BYTES = 8 * HTB, NXCD = 8, WGM = 8;

__host__ __device__ __forceinline__ int lds_byte(int r, int c) { const int st = (r >> 4) * 2 + (c >> 5), rr = r & 15, cc = c & 31, ob = rr * 64 + cc * 2; return st * 1024 + (ob ^ (((ob >> 9) & 1) << 5)); }
__host__ __device__ __forceinline__ void stage_rc(int b, int& R, int& C) { const int st = b / 1024, sb = b % 1024, swz = sb ^ (((sb >> 9) & 1) << 5); R = (st >> 1) * 16 + swz / 64; C = (st & 1) * 32 + (swz % 64) / 2; }
__host__ __device__ __forceinline__ int perm32(int rho) { const int n = rho >> 4, i = rho & 15; return 8 * (i >> 2) + 4 * n + (i & 3); }

struct Unit { int pm, pn; };
struct Gemm { const bf16_t* A; const bf16_t* Bt; int M, N, K; };

struct StaticOrder {
    int nM, nN, nwg, G, c;
    __host__ __device__ void init(int M, int N, int G_, int c_) { nM = M / BM; nN = N / BM; nwg = nM * nN; G = G_; c = c_; }
    __host__ __device__ bool next(int i, Unit& u) const {
        const long L = (long)i * G + c; if (L >= nwg) return false;
        int wgid = (int)L; { const int q = nwg / NXCD, r = nwg % NXCD, xcd = wgid % NXCD, off = wgid / NXCD; wgid = (xcd < r ? xcd * (q + 1) : r * (q + 1) + (xcd - r) * q) + off; }
        const int nig = WGM * nN, gid = wgid / nig, fm = gid * WGM, gsz = (nM - fm) < WGM ? (nM - fm) : WGM;
        u.pm = fm + ((wgid % nig) % gsz); u.pn = (wgid % nig) / gsz; return true;
    }
    __device__ __forceinline__ void a_ready(const Unit&) const {}
    __device__ __forceinline__ void done(const Unit&) const {}
};

__device__ __forceinline__ unsigned cvt_pk_bf16(float lo, float hi) { unsigned r; asm volatile("v_cvt_pk_bf16_f32 %0, %1, %2" : "=v"(r) : "v"(lo), "v"(hi)); return r; }
typedef float f32x2 __attribute__((ext_vector_type(2)));
__device__ __forceinline__ f32x2 gelu_pk(f32x2 v) {
    const f32x2 av = __builtin_elementwise_abs(v), d = av * 0.2316418882f + 1.0f;
    f32x2 t; t.x = __builtin_amdgcn_rcpf(d.x); t.y = __builtin_amdgcn_rcpf(d.y);
    f32x2 q = t * 0.5307027145f + (-0.7265760135f); q = q * t + 0.7107068705f; q = q * t + (-0.142248368f); q = q * t + 0.127414796f; q = q * t;
    const f32x2 s = (v * v) * (-0.72134752044f);
    f32x2 e; e.x = __builtin_amdgcn_exp2f(s.x); e.y = __builtin_amdgcn_exp2f(s.y);
    const f32x2 m = v * (q * e), r = v - m;
    f32x2 o; o.x = v.x < 0.f ? m.x : r.x; o.y = v.y < 0.f ? m.y : r.y; return o;
}

template <int ACT  > struct EpiBf16 {
    static constexpr bool PERM = true, AFTER_DRAIN = false; static_assert(ACT == 0 || ACT == 1, "EpiBf16: ACT is 0 (none) or 1 (gelu_pk)");
    bf16_t* O; int ldc; const float* bias; int split_cols; size_t split_stride; float scale0;
    __device__ __forceinline__ void operator()(const f32x4 (&acc)[2][2][4][2], const Unit& u, int wr, int wc, int fr, int fq) const {
        const int row0 = u.pm * BM + wr * 64 + fr; int colt = u.pn * BM; bf16_t* base = O;
        float sc = 1.f; if (split_cols) { const int t = colt / split_cols; base += (size_t)t * split_stride; colt -= t * split_cols; if (t == 0) sc = scale0; }
        const int col0 = colt + wc * 32 + 8 * fq, bcol0 = u.pn * BM + wc * 32 + 8 * fq;
        f32x4 bv[2][2];
#pragma unroll
        for (int bj = 0; bj < 2; ++bj)
#pragma unroll
            for (int n = 0; n < 2; ++n) bv[bj][n] = bias ? *(const f32x4*)(bias + bcol0 + bj * HALF + 4 * n) : (f32x4){0.f, 0.f, 0.f, 0.f};
#pragma unroll
        for (int ai = 0; ai < 2; ++ai)
#pragma unroll
            for (int m = 0; m < 4; ++m) { bf16_t* rowp = base + (size_t)(row0 + ai * HALF + m * 16) * ldc + col0;
#pragma unroll
                for (int bj = 0; bj < 2; ++bj) { f32x4 v0 = acc[ai][bj][m][0] + bv[bj][0], v1 = acc[ai][bj][m][1] + bv[bj][1];
                    if (ACT == 1) { f32x2 a = gelu_pk((f32x2){v0[0], v0[1]}), b = gelu_pk((f32x2){v0[2], v0[3]}), c = gelu_pk((f32x2){v1[0], v1[1]}), d = gelu_pk((f32x2){v1[2], v1[3]});
                        v0 = (f32x4){a.x, a.y, b.x, b.y}; v1 = (f32x4){c.x, c.y, d.x, d.y}; }
                    v0 = v0 * sc; v1 = v1 * sc; u32x4 w; w.x = cvt_pk_bf16(v0[0], v0[1]); w.y = cvt_pk_bf16(v0[2], v0[3]); w.z = cvt_pk_bf16(v1[0], v1[1]); w.w = cvt_pk_bf16(v1[2], v1[3]);
                    *(u32x4*)(rowp + bj * HALF) = w; } }
    }
};
struct EpiResGate {
    static constexpr bool PERM = false, AFTER_DRAIN = false;
    const float* baseL; const float* baseC; float* out; const float* gate; float ascale;
    __device__ __forceinline__ void operator()(const f32x4 (&acc)[2][2][4][2], const Unit& u, int wr, int wc, int fr, int fq) const {
        const int s = u.pm < 32 ? 0 : (u.pm < 64 ? 1 : 2);
        const float* gp = gate + s * 6144;
        const float* base = u.pm < 64 ? baseL + (size_t)u.pm * BM * 1024 : baseC + (size_t)(u.pm - 64) * BM * 1024;
        float* o = out + (size_t)u.pm * BM * 1024;
        const int col0 = u.pn * BM + wc * 32 + 4 * fq;
        f32x4 gv[2][2];
#pragma unroll
        for (int bj = 0; bj < 2; ++bj)
#pragma unroll
            for (int n = 0; n < 2; ++n) gv[bj][n] = *(const f32x4*)(gp + col0 + bj * HALF + n * 16) * ascale;
#pragma unroll
        for (int ai = 0; ai < 2; ++ai)
#pragma unroll
            for (int m = 0; m < 4; ++m) { const size_t off = (size_t)(ai * HALF + wr * 64 + m * 16 + fr) * 1024 + col0;
#pragma unroll
                for (int bj = 0; bj < 2; ++bj)
#pragma unroll
                    for (int n = 0; n < 2; ++n) { const f32x4 bs = *(const f32x4*)(base + off + bj * HALF + n * 16); *(f32x4*)(o + off + bj * HALF + n * 16) = bs + gv[bj][n] * acc[ai][bj][m][n]; }
                if (m & 1) asm volatile("" ::: "memory"); }
    }
};
struct EpiSwiGLU {
    static constexpr bool PERM = true, AFTER_DRAIN = false;
    bf16_t* H; int ldh; int ntl;
    __device__ __forceinline__ void operator()(const f32x4 (&acc)[2][2][4][2], const Unit& u, int wr, int wc, int fr, int fq) const {
        const int row0 = u.pm * BM + wr * 64 + fr; const int ct = u.pn % ntl; const int col0 = ct * HALF + wc * 32 + 8 * fq;
#pragma unroll
        for (int ai = 0; ai < 2; ++ai)
#pragma unroll
            for (int m = 0; m < 4; ++m) { bf16_t* rowp = H + (size_t)(row0 + ai * HALF + m * 16) * ldh + col0;
                float hv[8];
#pragma unroll
                for (int n = 0; n < 2; ++n)
#pragma unroll
                    for (int j = 0; j < 4; ++j) { const float a = acc[ai][0][m][n][j], b = acc[ai][1][m][n][j];
                        const float e = __builtin_amdgcn_exp2f(a * -1.4426950408889634f); hv[n * 4 + j] = a * __builtin_amdgcn_rcpf(1.0f + e) * b; }
                u32x4 w; w.x = cvt_pk_bf16(hv[0], hv[1]); w.y = cvt_pk_bf16(hv[2], hv[3]); w.z = cvt_pk_bf16(hv[4], hv[5]); w.w = cvt_pk_bf16(hv[6], hv[7]);
                *(u32x4*)rowp = w; }
    }
};
__device__ __forceinline__ unsigned cvt4_fp8(float a, float b, float c, float d) { unsigned w = 0u; w = (unsigned)__builtin_amdgcn_cvt_pk_fp8_f32(a, b, (int)w, false); w = (unsigned)__builtin_amdgcn_cvt_pk_fp8_f32(c, d, (int)w, true); return w; }
struct EpiSwiGLUF8 {
    static constexpr bool PERM = true, AFTER_DRAIN = false;
    unsigned char* H; int ldh; int ntl; float s;
    __device__ __forceinline__ void operator()(const f32x4 (&acc)[2][2][4][2], const Unit& u, int wr, int wc, int fr, int fq) const {
        const int row0 = u.pm * BM + wr * 64 + fr; const int ct = u.pn % ntl; const int col0 = ct * HALF + wc * 32 + 8 * fq;
#pragma unroll
        for (int ai = 0; ai < 2; ++ai)
#pragma unroll
            for (int m = 0; m < 4; ++m) { unsigned char* rowp = H + (size_t)(row0 + ai * HALF + m * 16) * ldh + col0;
                float hv[8];
#pragma unroll
                for (int n = 0; n < 2; ++n)
#pragma unroll
                    for (int j = 0; j < 4; ++j) { const float a = acc[ai][0][m][n][j] * s, b = acc[ai][1][m][n][j] * s;
                        const float e = __builtin_amdgcn_exp2f(a * -1.4426950408889634f); hv[n * 4 + j] = a * __builtin_amdgcn_rcpf(1.0f + e) * b; }
                u32x2 w; w.x = cvt4_fp8(hv[0], hv[1], hv[2], hv[3]); w.y = cvt4_fp8(hv[4], hv[5], hv[6], hv[7]);
                *(u32x2*)rowp = w; }
    }
};
struct EpiBf16S {
    static constexpr bool PERM = true, AFTER_DRAIN = false;
    bf16_t* O; int ldc; int ntl; float s;
    __device__ __forceinline__ void operator()(const f32x4 (&acc)[2][2][4][2], const Unit& u, int wr, int wc, int fr, int fq) const {
        const int row0 = u.pm * BM + wr * 64 + fr; const int col0 = (u.pn % ntl) * BM + wc * 32 + 8 * fq;
#pragma unroll
        for (int ai = 0; ai < 2; ++ai)
#pragma unroll
            for (int m = 0; m < 4; ++m) { bf16_t* rowp = O + (size_t)(row0 + ai * HALF + m * 16) * ldc + col0;
#pragma unroll
                for (int bj = 0; bj < 2; ++bj) { const f32x4 v0 = acc[ai][bj][m][0] * s, v1 = acc[ai][bj][m][1] * s;
                    u32x4 w; w.x = cvt_pk_bf16(v0[0], v0[1]); w.y = cvt_pk_bf16(v0[2], v0[3]); w.z = cvt_pk_bf16(v1[0], v1[1]); w.w = cvt_pk_bf16(v1[2], v1[3]);
                    *(u32x4*)(rowp + bj * HALF) = w; } }
    }
};
struct MoeOrder {
    int npan, ntl, G, c; const PG8_LAS int* pexp;
    __device__ __forceinline__ bool next(int i, Unit& u) const {
        const long L = (long)i * G + c; if (L >= (long)npan * ntl) return false;
        const int pm = (int)(L / ntl), j = (int)(L % ntl); u.pm = pm; u.pn = __builtin_amdgcn_readfirstlane(pexp[pm]) * ntl + j; return true;
    }
    __device__ __forceinline__ void a_ready(const Unit&) const {}
    __device__ __forceinline__ void done(const Unit&) const {}
};
template <class Epi, class Sched, bool ALIGN_EPI = false, bool SP2 = false, bool FP8 = false>
__device__ __forceinline__ void gemm_phase(PG8_LAS unsigned char* lds, const Gemm g, const Sched& S, const Epi& E) {
    const int tid = threadIdx.x, wid = __builtin_amdgcn_readfirstlane(tid >> 6), lane = tid & 63, wr = wid >> 2, wc = wid & 3, fr = lane & 15, fq = lane >> 4;
    const int K = g.K, nt = K / BK;
    unsigned voffA[2], voffB[2];
#pragma unroll
    for (int i = 0; i < 2; ++i) { int R, C; stage_rc(tid * 16 + i * 8192, R, C); const int Rb = Epi::PERM ? ((R & ~31) + perm32(R & 31)) : R;
        voffA[i] = (unsigned)(R * K + C) * 2u; voffB[i] = (unsigned)(Rb * K + C) * 2u; }
    const size_t kstep = (size_t)(BK * 2);
    const size_t hstep = (size_t)HALF * K * 2;
    const size_t tstep = 2 * hstep;
    const unsigned ldsw = (unsigned)wid * 1024u;
    const int aoff = lds_byte(wr * 64 + fr, fq * 8), boff = lds_byte(wc * 32 + fr, fq * 8);
#define PG8_SA(b, h) (((b) * 2 + (h)) * HTB)
#define PG8_SB(b, h) ((4 + (b) * 2 + (h)) * HTB)
#define PG8_STAGE(bufoff, gbase, voff) do { _Pragma("unroll") for (int _i = 0; _i < 2; ++_i) \
        __builtin_amdgcn_global_load_lds((const unsigned*)((const char*)(gbase) + (voff)[_i]), (PG8_LAS unsigned*)(lds + (bufoff) + ldsw + _i * 8192), 16, 0, 0); } while (0)
#define PG8_CAT(x, y) __builtin_shufflevector(__builtin_bit_cast(i32x4, x), __builtin_bit_cast(i32x4, y), 0, 1, 2, 3, 4, 5, 6, 7)
#define PG8_LDA(dst, b, h) do { if constexpr (FP8) { _Pragma("unroll") for (int m = 0; m < 4; ++m) dst##8[m] = PG8_CAT(*(const PG8_LAS bf16x8*)(lds + PG8_SA(b, h) + aoff + m * 2048), *(const PG8_LAS bf16x8*)(lds + PG8_SA(b, h) + aoff + m * 2048 + 1024)); } else { \
        _Pragma("unroll") for (int m = 0; m < 4; ++m) _Pragma("unroll") for (int k = 0; k < 2; ++k) dst[m][k] = *(const PG8_LAS bf16x8*)(lds + PG8_SA(b, h) + aoff + m * 2048 + k * 1024); } } while (0)
#define PG8_LDB(dst, b, h) do { if constexpr (FP8) { _Pragma("unroll") for (int n = 0; n < 2; ++n) dst##8[n] = PG8_CAT(*(const PG8_LAS bf16x8*)(lds + PG8_SB(b, h) + boff + n * 2048), *(const PG8_LAS bf16x8*)(lds + PG8_SB(b, h) + boff + n * 2048 + 1024)); } else { \
        _Pragma("unroll") for (int n = 0; n < 2; ++n) _Pragma("unroll") for (int k = 0; k < 2; ++k) dst[n][k] = *(const PG8_LAS bf16x8*)(lds + PG8_SB(b, h) + boff + n * 2048 + k * 1024); } } while (0)
#define PG8_MMA(ai, bj, At, Bt) do { __builtin_amdgcn_s_setprio(1); if constexpr (FP8) { _Pragma("unroll") for (int m = 0; m < 4; ++m) _Pragma("unroll") for (int n = 0; n < 2; ++n) \
        asm volatile("v_mfma_f32_16x16x128_f8f6f4 %0, %1, %2, %0" : "+v"(acc[ai][bj][m][n]) : "v"(Bt##8[n]), "v"(At##8[m]));   } else { \
        _Pragma("unroll") for (int m = 0; m < 4; ++m) _Pragma("unroll") for (int n = 0; n < 2; ++n) _Pragma("unroll") for (int k = 0; k < 2; ++k) \
        acc[ai][bj][m][n] = __builtin_amdgcn_mfma_f32_16x16x32_bf16(Bt[n][k], At[m][k], acc[ai][bj][m][n], 0, 0, 0); } __builtin_amdgcn_s_setprio(0); } while (0)
#define PG8_WAIT_V(n) asm volatile("s_waitcnt vmcnt(" #n ")" ::: "memory")
#define PG8_WAIT_L(n) asm volatile("s_waitcnt lgkmcnt(" #n ")" ::: "memory")
#define PG8_BAR __builtin_amdgcn_s_barrier()
#define PG8_SCHED __builtin_amdgcn_sched_barrier(0)
    Unit cur, nxt; int ui = 0;
    if (!S.next(0, cur)) return;
    f32x4 acc[2][2][4][2];
#pragma unroll
    for (int a = 0; a < 2; ++a)
#pragma unroll
        for (int b = 0; b < 2; ++b)
#pragma unroll
            for (int m = 0; m < 4; ++m)
#pragma unroll
                for (int n = 0; n < 2; ++n) acc[a][b][m][n] = (f32x4){0.f, 0.f, 0.f, 0.f};
    bf16x8 At[4][2], B0[2][2], B1[2][2]; i32x8 At8[4], B08[2], B18[2];
    const char* cA = (const char*)g.A + (size_t)cur.pm * tstep; const char* cB = (const char*)g.Bt + (size_t)cur.pn * tstep;
    S.a_ready(cur);
    if constexpr (SP2) {
        PG8_STAGE(PG8_SB(0, 0), cB, voffB); PG8_STAGE(PG8_SB(0, 1), cB + hstep, voffB); PG8_STAGE(PG8_SA(0, 0), cA, voffA); PG8_STAGE(PG8_SA(0, 1), cA + hstep, voffA);
        if (wr == 1) PG8_BAR;
        PG8_WAIT_V(2); PG8_BAR;
        PG8_STAGE(PG8_SB(1, 0), cB + kstep, voffB); PG8_STAGE(PG8_SA(1, 0), cA + kstep, voffA); PG8_STAGE(PG8_SB(1, 1), cB + hstep + kstep, voffB);
        PG8_WAIT_V(6); PG8_BAR;
    } else {
        PG8_STAGE(PG8_SB(0, 0), cB, voffB); PG8_STAGE(PG8_SA(0, 0), cA, voffA); PG8_STAGE(PG8_SB(0, 1), cB + hstep, voffB); PG8_STAGE(PG8_SA(0, 1), cA + hstep, voffA);
        if (wr == 1) PG8_BAR;
        PG8_WAIT_V(4); PG8_BAR;
        PG8_STAGE(PG8_SB(1, 0), cB + kstep, voffB); PG8_STAGE(PG8_SA(1, 0), cA + kstep, voffA); PG8_STAGE(PG8_SB(1, 1), cB + hstep + kstep, voffB);
        PG8_WAIT_V(6); PG8_BAR;
    }
    for (;;) {
        const bool has_next = S.next(ui + 1, nxt);
        const char* nA = has_next ? (const char*)g.A + (size_t)nxt.pm * tstep : cA; const char* nB = has_next ? (const char*)g.Bt + (size_t)nxt.pn * tstep : cB;
#pragma unroll 1
        for (int t = 0; t < nt; t += 2) {
            const bool last = (t == nt - 2);
            const char* a1 = cA + (size_t)(t + 1) * kstep;
            const char* a2 = last ? nA : cA + (size_t)(t + 2) * kstep; const char* b2 = last ? nB : cB + (size_t)(t + 2) * kstep;
            const char* a3 = a2 + kstep; const char* b3 = b2 + kstep;
            if (last && has_next) S.a_ready(nxt);
            if constexpr (SP2) {
            PG8_LDB(B0, 0, 0); PG8_LDB(B1, 0, 1); PG8_SCHED; PG8_LDA(At, 0, 0); PG8_STAGE(PG8_SA(1, 1), a1 + hstep, voffA);
            PG8_WAIT_V(8); PG8_WAIT_L(0); PG8_BAR; PG8_MMA(0, 0, At, B0); PG8_MMA(0, 1, At, B1); PG8_BAR; PG8_SCHED;
            PG8_LDA(At, 0, 1); PG8_STAGE(PG8_SB(0, 0), b2, voffB); PG8_STAGE(PG8_SB(0, 1), b2 + hstep, voffB); PG8_STAGE(PG8_SA(0, 0), a2, voffA);
            PG8_WAIT_V(8); PG8_WAIT_L(0); PG8_BAR; PG8_MMA(1, 0, At, B0); PG8_MMA(1, 1, At, B1); PG8_BAR; PG8_SCHED;
            PG8_LDB(B0, 1, 0); PG8_LDB(B1, 1, 1); PG8_SCHED; PG8_LDA(At, 1, 0); PG8_STAGE(PG8_SA(0, 1), a2 + hstep, voffA);
            PG8_WAIT_V(8); PG8_WAIT_L(0); PG8_BAR; PG8_MMA(0, 0, At, B0); PG8_MMA(0, 1, At, B1); PG8_BAR; PG8_SCHED;
            PG8_LDA(At, 1, 1); PG8_STAGE(PG8_SB(1, 0), b3, voffB); PG8_STAGE(PG8_SB(1, 1), b3 + hstep, voffB); PG8_STAGE(PG8_SA(1, 0), a3, voffA);
            PG8_WAIT_V(8); PG8_WAIT_L(0); PG8_BAR; PG8_MMA(1, 0, At, B0); PG8_MMA(1, 1, At, B1); PG8_BAR; PG8_SCHED;
            } else {
            PG8_LDB(B0, 0, 0); PG8_SCHED; PG8_LDA(At, 0, 0); PG8_STAGE(PG8_SA(1, 1), a1 + hstep, voffA);
            PG8_WAIT_L(8); PG8_BAR; PG8_WAIT_L(0); PG8_MMA(0, 0, At, B0); PG8_BAR; PG8_SCHED;
            PG8_LDB(B1, 0, 1); PG8_STAGE(PG8_SB(0, 0), b2, voffB);
            PG8_BAR; PG8_WAIT_L(0); PG8_MMA(0, 1, At, B1); PG8_BAR;
            PG8_LDA(At, 0, 1); PG8_STAGE(PG8_SA(0, 0), a2, voffA);
            PG8_BAR; PG8_WAIT_L(0); PG8_MMA(1, 0, At, B0); PG8_BAR; PG8_SCHED;
            PG8_STAGE(PG8_SB(0, 1), b2 + hstep, voffB);
            PG8_WAIT_V(6); PG8_BAR; PG8_MMA(1, 1, At, B1); PG8_BAR;
            PG8_LDB(B0, 1, 0); PG8_SCHED; PG8_LDA(At, 1, 0); PG8_STAGE(PG8_SA(0, 1), a2 + hstep, voffA);
            PG8_WAIT_L(8); PG8_BAR; PG8_WAIT_L(0); PG8_MMA(0, 0, At, B0); PG8_BAR; PG8_SCHED;
            PG8_LDB(B1, 1, 1); PG8_STAGE(PG8_SB(1, 0), b3, voffB);
            PG8_BAR; PG8_WAIT_L(0); PG8_MMA(0, 1, At, B1); PG8_BAR;
            PG8_LDA(At, 1, 1); PG8_STAGE(PG8_SA(1, 0), a3, voffA);
            PG8_BAR; PG8_WAIT_L(0); PG8_MMA(1, 0, At, B0); PG8_BAR; PG8_SCHED;
            PG8_STAGE(PG8_SB(1, 1), b3 + hstep, voffB);
            PG8_WAIT_V(6); PG8_BAR; PG8_MMA(1, 1, At, B1); PG8_BAR;
            }
        }
        if constexpr (FP8) asm volatile("s_nop 15\n\ts_nop 15" ::: "memory");
        if constexpr (ALIGN_EPI) { if (wr == 0) PG8_BAR; }
        if constexpr (!Epi::AFTER_DRAIN) { E(acc, cur, wr, wc, fr, fq); S.done(cur); }
        if (!has_next) break;
#pragma unroll
        for (int a = 0; a < 2; ++a)
#pragma unroll
            for (int b = 0; b < 2; ++b)
#pragma unroll
                for (int m = 0; m < 4; ++m)
#pragma unroll
                    for (int n = 0; n < 2; ++n) acc[a][b][m][n] = (f32x4){0.f, 0.f, 0.f, 0.f};
        cur = nxt; cA = nA; cB = nB; ++ui;
        if constexpr (ALIGN_EPI) { if (wr == 1) PG8_BAR; }
    }
    PG8_WAIT_V(0);
    if constexpr (!ALIGN_EPI) { if (wr == 0) PG8_BAR; }
    PG8_BAR;
    if constexpr (Epi::AFTER_DRAIN) { E.fused(acc, cur, wr, wc, fr, fq, lds, wid, lane); S.done(cur); }
#undef PG8_SA
#undef PG8_SB
#undef PG8_STAGE
#undef PG8_LDA
#undef PG8_LDB
#undef PG8_MMA
#undef PG8_CAT
#undef PG8_WAIT_V
#undef PG8_WAIT_L
#undef PG8_BAR
#undef PG8_SCHED
}
}

#ifndef PG8_SP2
#define PG8_SP2 true
#endif
#ifndef PG8_ALIGN
#define PG8_ALIGN true
#endif
#include <hip/hip_bf16.h>
#include <cmath>
namespace attn_body {
using bf16=__hip_bfloat16;
using bf16x8=__attribute__((ext_vector_type(8)))short;
using s16x4=__attribute__((ext_vector_type(4)))short;
using f32x16=__attribute__((ext_vector_type(16)))float;
using u32x4=__attribute__((ext_vector_type(4)))unsigned;
constexpr int D=64;
constexpr int NW=8,QBLK=32,QB=QBLK*NW,KVBLK=64;
constexpr int ATTN_UNIT_ROWS=QB;
__device__ __forceinline__ int crow(int r,int hi){return (r&3)+8*(r>>2)+4*hi;}
#define SBAR() __builtin_amdgcn_sched_barrier(0)
__device__ __forceinline__ void cmask(f32x16&p0,f32x16&p1,int jb,int qrel,int hi){
  const float NEG=-INFINITY; int kb=64*jb+4*hi;
  #pragma unroll
  for(int r=0;r<16;++r){int kv=kb+(r&3)+8*(r>>2); if(kv>qrel)p0[r]=NEG; if(kv+32>qrel)p1[r]=NEG;}
}

constexpr int NSLOT=3, SLOTB=8192;
constexpr int LDS_K=0, LDS_V=NSLOT*SLOTB, LDS_WS=2*NSLOT*SLOTB, LDS_OST=LDS_WS+NW*64*4, LDS_BYTES=LDS_OST+NW*4096;
constexpr float C2=0.125f*1.4426950408889634f;
__device__ __forceinline__ void glds16(const void*gsrc,unsigned lds_dst){unsigned keep;
  asm volatile("s_mov_b32 %0, m0\n\ts_mov_b32 m0, %2\n\ts_nop 0\n\tglobal_load_lds_dwordx4 %1, off\n\ts_mov_b32 m0, %0":"=&s"(keep):"v"(gsrc),"s"(lds_dst):"memory");}
__device__ __forceinline__ float max3f(float a,float b,float c){float r;asm("v_max3_f32 %0, %1, %2, %3":"=v"(r):"v"(a),"v"(b),"v"(c));return r;}
__device__ __forceinline__ float max2f(float a,float b){float r;asm("v_max_f32_e32 %0, %1, %2":"=v"(r):"v"(a),"v"(b));return r;}
__device__ __forceinline__ float fadd_s(float a,float b){float r;asm("v_add_f32_e32 %0, %1, %2":"=v"(r):"v"(a),"v"(b));return r;}
__device__ __forceinline__ float fsub_s(float a,float b){float r;asm("v_sub_f32_e32 %0, %1, %2":"=v"(r):"v"(a),"v"(b));return r;}
typedef float f32x2_t __attribute__((ext_vector_type(2))); typedef __bf16 bf16x2_t __attribute__((ext_vector_type(2)));
__device__ __forceinline__ unsigned cvtpk_s(float lo,float hi){f32x2_t v={lo,hi};bf16x2_t b=__builtin_convertvector(v,bf16x2_t);return __builtin_bit_cast(unsigned,b);}
#define WAIT_BAR(N) asm volatile("s_waitcnt vmcnt(" #N ") lgkmcnt(0)\n\ts_barrier":::"memory")

__device__ __forceinline__ void qkt(f32x16&p0,f32x16&p1,const char*Kslot,const bf16x8*qr,const f32x16&negm,int r32,int hi){
  const char*kb=Kslot+hi*1024+r32*16;
  #pragma unroll
  for(int d0=0;d0<4;++d0){
    const bf16x8 b0=*reinterpret_cast<const bf16x8*>(kb+d0*2048);
    const bf16x8 b1=*reinterpret_cast<const bf16x8*>(kb+d0*2048+512);
    if(d0==0){p0=__builtin_amdgcn_mfma_f32_32x32x16_bf16(b0,qr[0],negm,0,0,0);p1=__builtin_amdgcn_mfma_f32_32x32x16_bf16(b1,qr[0],negm,0,0,0);}
    else{p0=__builtin_amdgcn_mfma_f32_32x32x16_bf16(b0,qr[d0],p0,0,0,0);p1=__builtin_amdgcn_mfma_f32_32x32x16_bf16(b1,qr[d0],p1,0,0,0);}}
}
typedef __attribute__((address_space(3))) const char* lds_cptr;
typedef short v4i16_t __attribute__((ext_vector_type(4)));
__device__ __forceinline__ void kload8(bf16x8*kf,lds_cptr kp){
  kf[0]=*(const __attribute__((address_space(3))) bf16x8*)(kp);      kf[1]=*(const __attribute__((address_space(3))) bf16x8*)(kp+512);
  kf[2]=*(const __attribute__((address_space(3))) bf16x8*)(kp+2048); kf[3]=*(const __attribute__((address_space(3))) bf16x8*)(kp+2560);
  kf[4]=*(const __attribute__((address_space(3))) bf16x8*)(kp+4096); kf[5]=*(const __attribute__((address_space(3))) bf16x8*)(kp+4608);
  kf[6]=*(const __attribute__((address_space(3))) bf16x8*)(kp+6144); kf[7]=*(const __attribute__((address_space(3))) bf16x8*)(kp+6656);
}
__device__ __forceinline__ void kload2(bf16x8*kf,lds_cptr kp,int j){ kf[2*j]=*(const __attribute__((address_space(3))) bf16x8*)(kp+j*2048); kf[2*j+1]=*(const __attribute__((address_space(3))) bf16x8*)(kp+j*2048+512); }
__device__ __forceinline__ s16x4 vtr(lds_cptr p){ return __builtin_bit_cast(s16x4,__builtin_amdgcn_ds_read_tr16_b64_v4i16((__attribute__((address_space(3))) v4i16_t*)p)); }
__device__ __forceinline__ float rowmax(const f32x16&p0,const f32x16&p1){
  float a=max3f(p0[0],p0[1],p1[0]),b=max3f(p0[2],p0[3],p1[1]);a=max3f(a,p1[2],p1[3]);
  #pragma unroll
  for(int r=4;r<16;r+=4){a=max3f(a,p0[r],p0[r+1]);b=max3f(b,p0[r+2],p0[r+3]);a=max3f(a,p1[r],p1[r+1]);b=max3f(b,p1[r+2],p1[r+3]);}
  const float m=max2f(a,b);
  auto rr=__builtin_amdgcn_permlane32_swap(__float_as_uint(m),__float_as_uint(m),false,false);
  return max2f(__uint_as_float(rr[0]),__uint_as_float(rr[1]));
}
__device__ __forceinline__ void pv(f32x16*o,int vb,bf16x8 pa0,bf16x8 pa1,bf16x8 pa2,bf16x8 pa3){
  #pragma unroll
  for(int d0=0;d0<2;++d0){s16x4 lo[4],hi[4];
    #pragma unroll
    for(int ks=0;ks<4;++ks){
      asm volatile("ds_read_b64_tr_b16 %0,%1 offset:%c2":"=&v"(lo[ks]):"v"(vb),"i"(d0*4096+ks*1024):"memory");
      asm volatile("ds_read_b64_tr_b16 %0,%1 offset:%c2":"=&v"(hi[ks]):"v"(vb),"i"(d0*4096+ks*1024+512):"memory");}
    asm volatile("s_waitcnt lgkmcnt(0)":::"memory");SBAR();
    #define PK(k) (bf16x8){lo[k][0],lo[k][1],lo[k][2],lo[k][3],hi[k][0],hi[k][1],hi[k][2],hi[k][3]}
    o[d0]=__builtin_amdgcn_mfma_f32_32x32x16_bf16(pa0,PK(0),o[d0],0,0,0);
    o[d0]=__builtin_amdgcn_mfma_f32_32x32x16_bf16(pa1,PK(1),o[d0],0,0,0);
    o[d0]=__builtin_amdgcn_mfma_f32_32x32x16_bf16(pa2,PK(2),o[d0],0,0,0);
    o[d0]=__builtin_amdgcn_mfma_f32_32x32x16_bf16(pa3,PK(3),o[d0],0,0,0);
    #undef PK
  }
}

#ifndef ATTN_STORE16
#define ATTN_STORE16(p,v) (*(u32x4*)(p)=(v))
#endif
template<int THRL,bool TILED> __device__ __forceinline__ void attn_unit(const bf16*Qu,int qp,const bf16*__restrict__ Kc,const bf16*__restrict__ Kl,int kp,const bf16*__restrict__ Vc,const bf16*__restrict__ Vl,int vp,bf16*Ou,int op,int NT,int NCT,int rot,char*shm){
  const int tid=threadIdx.x,lane=tid&63,r32=lane&31,hi=lane>>5; const int wid=__builtin_amdgcn_readfirstlane(tid>>6);
  const bf16*Qw=Qu+(long)(wid*QBLK)*qp;
  const unsigned lds0=(unsigned)(uintptr_t)shm;
  float*wsf=(float*)(shm+LDS_WS)+wid*64;
  const long koff=TILED?(long)(wid*512+lane*8):((long)lane*kp+wid*8); const bf16*ksrc_c=Kc+koff; const bf16*ksrc_l=Kl+koff-(long)NCT*KVBLK*kp;
  const long voff=TILED?(long)(wid*512+lane*8):((long)(16*(wid&3)+(lane>>2))*vp+(wid>>2)*32+(lane&3)*8); const bf16*vsrc_c=Vc+voff; const bf16*vsrc_l=Vl+voff-(long)NCT*KVBLK*vp;
  const unsigned kdst=lds0+LDS_K+wid*1024, vdst=lds0+LDS_V+wid*1024;
  #define ROTT(t) (((t)+rot>=NT)?((t)+rot-NT):((t)+rot))
  #define DMA_K(t,slot) glds16((ROTT(t)<NCT?ksrc_c:ksrc_l)+(long)ROTT(t)*KVBLK*kp,(unsigned)__builtin_amdgcn_readfirstlane(kdst+(slot)))
  #define DMA_V(t,slot) glds16((ROTT(t)<NCT?vsrc_c:vsrc_l)+(long)ROTT(t)*KVBLK*vp,(unsigned)__builtin_amdgcn_readfirstlane(vdst+(slot)))
  const int vb0=(int)(lds0+LDS_V)+((lane>>4)&1)*32+(lane&3)*8+(4*hi+((lane&15)>>2))*64;
  const char*Kbase=shm+LDS_K; bf16x8 kf[8];
  const lds_cptr shm3=(lds_cptr)shm; const lds_cptr kp0=shm3+LDS_K+hi*1024+r32*16; const lds_cptr vp0=shm3+LDS_V+((lane>>4)&1)*32+(lane&3)*8+(4*hi+((lane&15)>>2))*64;
  DMA_K(0,0);DMA_V(0,0);DMA_K(1,SLOTB);
  bf16x8 qr[4];
  #pragma unroll
  for(int d0=0;d0<4;++d0)qr[d0]=*reinterpret_cast<const bf16x8*>(&Qw[(long)r32*qp+d0*16+hi*8]);
  float mhat=0.f,l_reg=0.f;f32x16 o[2];o[0]=f32x16{};o[1]=f32x16{};f32x16 negm=f32x16{};if constexpr(THRL>=0)asm volatile("":"+v"(negm));
  #define CMASK(P0,P1,t) do{}while(0)
  bool resc=false;
  #define START(P0,P1) do{ resc=false; if constexpr(THRL>=0) \
    { const float rm=rowmax(P0,P1); const float dl=rm; mhat=fadd_s(mhat,dl); \
      _Pragma("unroll") for(int r=0;r<16;++r){P0[r]=fsub_s(P0[r],dl);P1[r]=fsub_s(P1[r],dl);} \
      _Pragma("unroll") for(int r=0;r<16;++r)negm[r]=-mhat; asm volatile("":"+v"(negm)); } \
    _Pragma("unroll") for(int r=0;r<16;++r)P0[r]=__builtin_amdgcn_exp2f(P0[r]); }while(0)
  #define RESC() do{ if constexpr(THRL>=0) if(resc){ asm volatile("s_waitcnt lgkmcnt(0)":::"memory"); \
      _Pragma("unroll") for(int d_=0;d_<2;++d_) _Pragma("unroll") for(int r=0;r<16;++r)o[d_][r]*=wsf[crow(r,hi)]; } }while(0)
  f32x16 pA0,pA1,pB0,pB1;
  int sl_prev=0,sl_cur=0,sl_next=SLOTB;
  #define ROT() do{sl_prev=sl_cur;sl_cur=sl_next;sl_next=(sl_next==(NSLOT-1)*SLOTB)?0:sl_next+SLOTB;}while(0)
  DMA_K(2,2*SLOTB);
  WAIT_BAR(3);
  qkt(pA0,pA1,Kbase,qr,negm,r32,hi);asm volatile("s_nop 15\n\ts_nop 7":"+v"(pA0),"+v"(pA1));CMASK(pA0,pA1,0);
  START(pA0,pA1);
  _Pragma("unroll") for(int r=0;r<16;++r)pA1[r]=__builtin_amdgcn_exp2f(pA1[r]);
  WAIT_BAR(0);
  DMA_K(3,0);DMA_V(1,SLOTB);
  ROT();
  kload8(kf,kp0+sl_cur);
  WAIT_BAR(2);
  s16x4 vlo[8],vhi[8]; u32x4 pw0,pw1,pw2,pw3;
  #define PKW(P,B) cvtpk_s(P[B],P[B+1])
  #define PAF(k) __builtin_bit_cast(bf16x8,pw##k)
  #define VFR(i) (bf16x8){vlo[i][0],vlo[i][1],vlo[i][2],vlo[i][3],vhi[i][0],vhi[i][1],vhi[i][2],vhi[i][3]}
  #define PIN(x) asm volatile("":"+v"(x))
  #define MX3(a,b,c) __builtin_fmaxf(__builtin_fmaxf((a),(b)),(c))
  #define GAPA(MF,A0,A1,A2,A3,W0,W1,PW) do{ MF; sacc+=A0; sacc+=A1; sacc+=A2; sacc+=A3; PIN(sacc); W0; W1; PIN(PW); SBAR(); }while(0)
  #define EX(v) __builtin_amdgcn_exp2f(v)
  #define GAPB(MF,X,B) do{ MF; X[B]=EX(X[B]); X[B+1]=EX(X[B+1]); X[B+2]=EX(X[B+2]); X[B+3]=EX(X[B+3]); PIN(X); SBAR(); }while(0)
  #define VRD(i) do{ vlo[i]=vtr(vp_+(((i)>>2)*4096+((i)&3)*1024)); vhi[i]=vtr(vp_+(((i)>>2)*4096+((i)&3)*1024+512)); }while(0)
  #define KRD(G,j) do{ if(G){ kload2(kf,kp0+sl_next,j); SBAR(); } }while(0)
  #define STEP(C0,C1,P0,P1,t,GK,GV,GL) do{ SBAR(); \
    const lds_cptr vp_=vp0+sl_prev; \
    VRD(0); SBAR(); float sacc=(P0[0]+P0[1]); \
    GAPA(C0=__builtin_amdgcn_mfma_f32_32x32x16_bf16(kf[0],qr[0],negm,0,0,0), P0[2],P0[3],P0[4],P0[5],     pw0[0]=PKW(P0,0), pw0[1]=PKW(P0,2), pw0); \
    VRD(4); SBAR(); GAPA(C1=__builtin_amdgcn_mfma_f32_32x32x16_bf16(kf[1],qr[0],negm,0,0,0), P0[6],P0[7],P0[8],P0[9],     pw0[2]=PKW(P0,4), pw0[3]=PKW(P0,6), pw0); \
    VRD(1); SBAR(); GAPA(C0=__builtin_amdgcn_mfma_f32_32x32x16_bf16(kf[2],qr[1],C0,0,0,0),   P0[10],P0[11],P0[12],P0[13], pw1[0]=PKW(P0,8), pw1[1]=PKW(P0,10), pw1); \
    VRD(5); SBAR(); GAPA(C1=__builtin_amdgcn_mfma_f32_32x32x16_bf16(kf[3],qr[1],C1,0,0,0),   P0[14],P0[15],P1[0],P1[1],   pw1[2]=PKW(P0,12),pw1[3]=PKW(P0,14), pw1); \
    VRD(2); SBAR(); GAPA(C0=__builtin_amdgcn_mfma_f32_32x32x16_bf16(kf[4],qr[2],C0,0,0,0),   P1[2],P1[3],P1[4],P1[5],     pw2[0]=PKW(P1,0), pw2[1]=PKW(P1,2), pw2); \
    VRD(6); SBAR(); GAPA(C1=__builtin_amdgcn_mfma_f32_32x32x16_bf16(kf[5],qr[2],C1,0,0,0),   P1[6],P1[7],P1[8],P1[9],     pw2[2]=PKW(P1,4), pw2[3]=PKW(P1,6), pw2); \
    VRD(3); SBAR(); GAPA(C0=__builtin_amdgcn_mfma_f32_32x32x16_bf16(kf[6],qr[3],C0,0,0,0),   P1[10],P1[11],P1[12],P1[13], pw3[0]=PKW(P1,8), pw3[1]=PKW(P1,10), pw3); \
    VRD(7); SBAR(); GAPA(C1=__builtin_amdgcn_mfma_f32_32x32x16_bf16(kf[7],qr[3],C1,0,0,0),   P1[14],P1[15],0.f,0.f,       pw3[2]=PKW(P1,12),pw3[3]=PKW(P1,14), pw3); \
    l_reg+=sacc; \
    if(GK){DMA_K((t)+3,sl_cur);} if(GV){DMA_V((t)+1,sl_next);} \
    CMASK(C0,C1,t); \
    if constexpr(THRL>=0){ float a=MX3(C0[0],C0[1],C1[0]),b=MX3(C0[2],C0[3],C1[1]); a=MX3(a,C1[2],C1[3]); \
      _Pragma("unroll") for(int r=4;r<16;r+=4){a=MX3(a,C0[r],C0[r+1]);b=MX3(b,C0[r+2],C0[r+3]);a=MX3(a,C1[r],C1[r+1]);b=MX3(b,C1[r+2],C1[r+3]);} \
      float rm=__builtin_fmaxf(a,b); { auto rr=__builtin_amdgcn_permlane32_swap(__float_as_uint(rm),__float_as_uint(rm),false,false); rm=__builtin_fmaxf(__uint_as_float(rr[0]),__uint_as_float(rr[1])); } \
      resc=false; \
      if(__builtin_expect(__any(rm>(float)THRL),0)){ const float dl=__builtin_fmaxf(rm,0.f); mhat+=dl; \
        _Pragma("unroll") for(int r=0;r<16;++r){C0[r]-=dl;C1[r]-=dl;} \
        _Pragma("unroll") for(int r=0;r<16;++r)negm[r]=-mhat; asm volatile("":"+v"(negm)); \
        const float f=__builtin_amdgcn_exp2f(-dl); l_reg*=f; if(hi==0)wsf[r32]=f; resc=true; } } \
    SBAR(); \
    GAPB(o[0]=__builtin_amdgcn_mfma_f32_32x32x16_bf16(PAF(0),VFR(0),o[0],0,0,0), C0,0); \
    GAPB(o[1]=__builtin_amdgcn_mfma_f32_32x32x16_bf16(PAF(0),VFR(4),o[1],0,0,0), C0,4); \
    KRD(GL,0); GAPB(o[0]=__builtin_amdgcn_mfma_f32_32x32x16_bf16(PAF(1),VFR(1),o[0],0,0,0), C0,8); \
    KRD(GL,1); GAPB(o[1]=__builtin_amdgcn_mfma_f32_32x32x16_bf16(PAF(1),VFR(5),o[1],0,0,0), C0,12); \
    KRD(GL,2); GAPB(o[0]=__builtin_amdgcn_mfma_f32_32x32x16_bf16(PAF(2),VFR(2),o[0],0,0,0), C1,0); \
    KRD(GL,3); GAPB(o[1]=__builtin_amdgcn_mfma_f32_32x32x16_bf16(PAF(2),VFR(6),o[1],0,0,0), C1,4); \
    GAPB(o[0]=__builtin_amdgcn_mfma_f32_32x32x16_bf16(PAF(3),VFR(3),o[0],0,0,0), C1,8); \
    GAPB(o[1]=__builtin_amdgcn_mfma_f32_32x32x16_bf16(PAF(3),VFR(7),o[1],0,0,0), C1,12); \
    }while(0)
  int t=1;
  #undef CMASK
  #define CMASK(P0,P1,t) do{}while(0)
  for(;t+5<NT;t+=2){
    STEP(pB0,pB1,pA0,pA1,t,true,true,true);     WAIT_BAR(2); RESC(); ROT();
    STEP(pA0,pA1,pB0,pB1,t+1,true,true,true);   WAIT_BAR(2); RESC(); ROT();
  }
  #undef CMASK
  #define CMASK(P0,P1,t) do{}while(0)
  #define ENDW(tt) do{ if((tt)+3<NT){WAIT_BAR(2);} else if((tt)+2<NT){WAIT_BAR(1);} else {WAIT_BAR(0);} }while(0)
  for(;t+1<NT;t+=2){
    STEP(pB0,pB1,pA0,pA1,t,(t+3<NT),(t+1<NT),(t+1<NT));       ENDW(t);   RESC(); ROT();
    STEP(pA0,pA1,pB0,pB1,t+1,(t+4<NT),(t+2<NT),(t+2<NT));     ENDW(t+1); RESC(); ROT();
  }
  STEP(pB0,pB1,pA0,pA1,NT-1,false,false,false); RESC();
  { float sacc=pB0[0]+pB0[1]; _Pragma("unroll") for(int r=2;r<16;++r)sacc+=pB0[r]; _Pragma("unroll") for(int r=0;r<16;++r)sacc+=pB1[r]; l_reg+=sacc;
    pw0=(u32x4){PKW(pB0,0),PKW(pB0,2),PKW(pB0,4),PKW(pB0,6)};pw1=(u32x4){PKW(pB0,8),PKW(pB0,10),PKW(pB0,12),PKW(pB0,14)};pw2=(u32x4){PKW(pB1,0),PKW(pB1,2),PKW(pB1,4),PKW(pB1,6)};pw3=(u32x4){PKW(pB1,8),PKW(pB1,10),PKW(pB1,12),PKW(pB1,14)};
    SBAR(); pv(o,vb0+sl_cur,PAF(0),PAF(1),PAF(2),PAF(3)); }
  #undef PKW
  #undef PAF
  #undef VFR
  #undef PIN
  #undef MX3
  #undef GAPA
  #undef GAPB
  #undef EX
  #undef VRD
  #undef KRD
  #undef STEP
  #undef ENDW
  {auto rr=__builtin_amdgcn_permlane32_swap(__float_as_uint(l_reg),__float_as_uint(l_reg),false,false);l_reg=__uint_as_float(rr[0])+__uint_as_float(rr[1]);}
  if(hi==0)wsf[32+r32]=l_reg;asm volatile("s_waitcnt lgkmcnt(0)":::"memory");
  float rli[16];
  #pragma unroll
  for(int r=0;r<16;++r)rli[r]=__builtin_amdgcn_rcpf(wsf[32+crow(r,hi)]);
  bf16*Ow=Ou+(long)(wid*QBLK)*op;
  { bf16*stg=(bf16*)(shm+LDS_OST)+wid*2048;
    #pragma unroll
    for(int r=0;r<16;++r){const int orow=crow(r,hi);
      #pragma unroll
      for(int d0=0;d0<2;++d0)stg[orow*64+d0*32+r32]=__float2bfloat16(o[d0][r]*rli[r]);}
    asm volatile("s_waitcnt lgkmcnt(0)":::"memory");
    #pragma unroll
    for(int i=0;i<4;++i){const int row=i*8+(lane>>3),ch=lane&7; const u32x4 v=*(const u32x4*)(stg+row*64+ch*8); ATTN_STORE16(Ow+(long)row*op+ch*8,v);} }
  asm volatile("s_waitcnt lgkmcnt(0)\n\ts_barrier":::"memory");
  #undef DMA_K
  #undef ROTT
  #undef DMA_V
  #undef CMASK
  #undef START
  #undef RESC
  #undef ROT
}
constexpr int LDS2_V=NSLOT*SLOTB, LDS2_WS=LDS2_V+NSLOT*2*SLOTB, LDS2_OST=LDS2_WS+NW*64*4, LDS2_BYTES=LDS2_OST+NW*4096;
template<int THRL> __device__ __forceinline__ void attn_unit2(const bf16*Qu,int qp,const bf16*__restrict__ Ks,const bf16*__restrict__ Va,const bf16*__restrict__ Vb,bf16*Ou,int op,int NT,int rot,char*shm){
  const int tid=threadIdx.x,lane=tid&63,r32=lane&31,hi=lane>>5; const int wid=__builtin_amdgcn_readfirstlane(tid>>6);
  const bf16*Qw=Qu+(long)(wid*QBLK)*qp;
  const unsigned lds0=(unsigned)(uintptr_t)shm;
  float*wsf=(float*)(shm+LDS2_WS)+wid*64;
  const long koff=(long)(wid*512+lane*8); const bf16*ksrc=Ks+koff; const bf16*vsrca=Va+koff; const bf16*vsrcb=Vb+koff;
  const unsigned kdst=lds0+LDS_K+wid*1024, vdst=lds0+LDS2_V+wid*1024;
  #define ROTT(t) (((t)+rot>=NT)?((t)+rot-NT):((t)+rot))
  #define DMA_K(t,slot) glds16(ksrc+(long)ROTT(t)*4096,(unsigned)__builtin_amdgcn_readfirstlane(kdst+(slot)))
  #define DMA_V(t,slot) do{ glds16(vsrca+(long)ROTT(t)*4096,(unsigned)__builtin_amdgcn_readfirstlane(vdst+2*(slot))); glds16(vsrcb+(long)ROTT(t)*4096,(unsigned)__builtin_amdgcn_readfirstlane(vdst+2*(slot)+8192)); }while(0)
  const int vb0=(int)(lds0+LDS2_V)+((lane>>4)&1)*32+(lane&3)*8+(4*hi+((lane&15)>>2))*64;
  const char*Kbase=shm+LDS_K; bf16x8 kf[8];
  const lds_cptr shm3=(lds_cptr)shm; const lds_cptr kp0=shm3+LDS_K+hi*1024+r32*16; const lds_cptr vp0=shm3+LDS2_V+((lane>>4)&1)*32+(lane&3)*8+(4*hi+((lane&15)>>2))*64;
  DMA_K(0,0);DMA_V(0,0);DMA_K(1,SLOTB);
  bf16x8 qr[4];
  #pragma unroll
  for(int d0=0;d0<4;++d0)qr[d0]=*reinterpret_cast<const bf16x8*>(&Qw[(long)r32*qp+d0*16+hi*8]);
  float mhat=0.f,l_reg=0.f;f32x16 o[4];o[0]=f32x16{};o[1]=f32x16{};o[2]=f32x16{};o[3]=f32x16{};const f32x16 zero16=f32x16{};
  #define CMASK(P0,P1,t) do{}while(0)
  bool resc=false;
  #define SUBM(x) (THRL>=0?(x)-mhat:(x))
  #define START(P0,P1) do{ resc=false; if constexpr(THRL>=0){ mhat=rowmax(P0,P1); } \
    _Pragma("unroll") for(int r=0;r<16;++r)P0[r]=__builtin_amdgcn_exp2f(SUBM(P0[r])); }while(0)
  #define RESC() do{ if constexpr(THRL>=0) if(resc){ asm volatile("s_waitcnt lgkmcnt(0)":::"memory"); \
      _Pragma("unroll") for(int d_=0;d_<4;++d_) _Pragma("unroll") for(int r=0;r<16;++r)o[d_][r]*=wsf[crow(r,hi)]; } }while(0)
  f32x16 pA0,pA1,pB0,pB1;
  int sl_prev=0,sl_cur=0,sl_next=SLOTB;
  #define ROT() do{sl_prev=sl_cur;sl_cur=sl_next;sl_next=(sl_next==(NSLOT-1)*SLOTB)?0:sl_next+SLOTB;}while(0)
  DMA_K(2,2*SLOTB);
  WAIT_BAR(4);
  qkt(pA0,pA1,Kbase,qr,zero16,r32,hi);asm volatile("s_nop 15\n\ts_nop 7":"+v"(pA0),"+v"(pA1));CMASK(pA0,pA1,0);
  START(pA0,pA1);
  _Pragma("unroll") for(int r=0;r<16;++r)pA1[r]=__builtin_amdgcn_exp2f(SUBM(pA1[r]));
  WAIT_BAR(0);
  DMA_K(3,0);DMA_V(1,SLOTB);
  ROT();
  kload8(kf,kp0+sl_cur);
  WAIT_BAR(3);
  s16x4 vlo[8],vhi[8]; u32x4 pw0,pw1,pw2,pw3;
  #define PKW(P,B) cvtpk_s(P[B],P[B+1])
  #define PAF(k) __builtin_bit_cast(bf16x8,pw##k)
  #define VFR(i) (bf16x8){vlo[i][0],vlo[i][1],vlo[i][2],vlo[i][3],vhi[i][0],vhi[i][1],vhi[i][2],vhi[i][3]}
  #define PIN(x) asm volatile("":"+v"(x))
  #define MX3(a,b,c) __builtin_fmaxf(__builtin_fmaxf((a),(b)),(c))
  #define GAPA(MF,A0,A1,A2,A3,W0,W1,PW) do{ MF; sacc+=A0; sacc+=A1; sacc+=A2; sacc+=A3; PIN(sacc); W0; W1; PIN(PW); SBAR(); }while(0)
  #define EX(v) __builtin_amdgcn_exp2f(v)
  #define GAPB(MF,X,B) do{ MF; X[B]=EX(SUBM(X[B])); X[B+1]=EX(SUBM(X[B+1])); PIN(X); SBAR(); }while(0)
  #define VRD(i) do{ vlo[i]=vtr(vp_+(((i)>>2)*4096+((i)&3)*1024)); vhi[i]=vtr(vp_+(((i)>>2)*4096+((i)&3)*1024+512)); }while(0)
  #define VRD2(i) do{ vlo[i]=vtr(vp_+(8192+((i)>>2)*4096+((i)&3)*1024)); vhi[i]=vtr(vp_+(8192+((i)>>2)*4096+((i)&3)*1024+512)); SBAR(); }while(0)
  #define KRD(G,j) do{ if(G){ kload2(kf,kp0+sl_next,j); SBAR(); } }while(0)
  #define STEP(C0,C1,P0,P1,t,GK,GV,GL) do{ SBAR(); \
    const lds_cptr vp_=vp0+2*sl_prev; \
    VRD(0); SBAR(); float sacc=(P0[0]+P0[1]); \
    GAPA(C0=__builtin_amdgcn_mfma_f32_32x32x16_bf16(kf[0],qr[0],zero16,0,0,0), P0[2],P0[3],P0[4],P0[5],     pw0[0]=PKW(P0,0), pw0[1]=PKW(P0,2), pw0); \
    VRD(4); SBAR(); GAPA(C1=__builtin_amdgcn_mfma_f32_32x32x16_bf16(kf[1],qr[0],zero16,0,0,0), P0[6],P0[7],P0[8],P0[9],     pw0[2]=PKW(P0,4), pw0[3]=PKW(P0,6), pw0); \
    VRD(1); SBAR(); GAPA(C0=__builtin_amdgcn_mfma_f32_32x32x16_bf16(kf[2],qr[1],C0,0,0,0),   P0[10],P0[11],P0[12],P0[13], pw1[0]=PKW(P0,8), pw1[1]=PKW(P0,10), pw1); \
    VRD(5); SBAR(); GAPA(C1=__builtin_amdgcn_mfma_f32_32x32x16_bf16(kf[3],qr[1],C1,0,0,0),   P0[14],P0[15],P1[0],P1[1],   pw1[2]=PKW(P0,12),pw1[3]=PKW(P0,14), pw1); \
    VRD(2); SBAR(); GAPA(C0=__builtin_amdgcn_mfma_f32_32x32x16_bf16(kf[4],qr[2],C0,0,0,0),   P1[2],P1[3],P1[4],P1[5],     pw2[0]=PKW(P1,0), pw2[1]=PKW(P1,2), pw2); \
    VRD(6); SBAR(); GAPA(C1=__builtin_amdgcn_mfma_f32_32x32x16_bf16(kf[5],qr[2],C1,0,0,0),   P1[6],P1[7],P1[8],P1[9],     pw2[2]=PKW(P1,4), pw2[3]=PKW(P1,6), pw2); \
    VRD(3); SBAR(); GAPA(C0=__builtin_amdgcn_mfma_f32_32x32x16_bf16(kf[6],qr[3],C0,0,0,0),   P1[10],P1[11],P1[12],P1[13], pw3[0]=PKW(P1,8), pw3[1]=PKW(P1,10), pw3); \
    VRD(7); SBAR(); GAPA(C1=__builtin_amdgcn_mfma_f32_32x32x16_bf16(kf[7],qr[3],C1,0,0,0),   P1[14],P1[15],0.f,0.f,       pw3[2]=PKW(P1,12),pw3[3]=PKW(P1,14), pw3); \
    l_reg+=sacc; \
    if(GK){DMA_K((t)+3,sl_cur);} if(GV){DMA_V((t)+1,sl_next);} \
    CMASK(C0,C1,t); \
    if constexpr(THRL>=0){ float a=MX3(C0[0],C0[1],C1[0]),b=MX3(C0[2],C0[3],C1[1]); a=MX3(a,C1[2],C1[3]); \
      _Pragma("unroll") for(int r=4;r<16;r+=4){a=MX3(a,C0[r],C0[r+1]);b=MX3(b,C0[r+2],C0[r+3]);a=MX3(a,C1[r],C1[r+1]);b=MX3(b,C1[r+2],C1[r+3]);} \
      float rm=__builtin_fmaxf(a,b); { auto rr=__builtin_amdgcn_permlane32_swap(__float_as_uint(rm),__float_as_uint(rm),false,false); rm=__builtin_fmaxf(__uint_as_float(rr[0]),__uint_as_float(rr[1])); } \
      resc=false; \
      rm-=mhat; \
      if(__builtin_expect(__any(rm>(float)THRL),0)){ const float dl=__builtin_fmaxf(rm,0.f); mhat+=dl; \
        const float f=__builtin_amdgcn_exp2f(-dl); l_reg*=f; if(hi==0)wsf[r32]=f; resc=true; } } \
    SBAR(); \
    GAPB(o[0]=__builtin_amdgcn_mfma_f32_32x32x16_bf16(PAF(0),VFR(0),o[0],0,0,0), C0,0); VRD2(0); \
    GAPB(o[1]=__builtin_amdgcn_mfma_f32_32x32x16_bf16(PAF(0),VFR(4),o[1],0,0,0), C0,2); VRD2(4); \
    KRD(GL,0); GAPB(o[0]=__builtin_amdgcn_mfma_f32_32x32x16_bf16(PAF(1),VFR(1),o[0],0,0,0), C0,4); VRD2(1); \
    KRD(GL,1); GAPB(o[1]=__builtin_amdgcn_mfma_f32_32x32x16_bf16(PAF(1),VFR(5),o[1],0,0,0), C0,6); VRD2(5); \
    KRD(GL,2); GAPB(o[0]=__builtin_amdgcn_mfma_f32_32x32x16_bf16(PAF(2),VFR(2),o[0],0,0,0), C0,8); VRD2(2); \
    KRD(GL,3); GAPB(o[1]=__builtin_amdgcn_mfma_f32_32x32x16_bf16(PAF(2),VFR(6),o[1],0,0,0), C0,10); VRD2(6); \
    GAPB(o[0]=__builtin_amdgcn_mfma_f32_32x32x16_bf16(PAF(3),VFR(3),o[0],0,0,0), C0,12); VRD2(3); \
    GAPB(o[1]=__builtin_amdgcn_mfma_f32_32x32x16_bf16(PAF(3),VFR(7),o[1],0,0,0), C0,14); VRD2(7); \
    GAPB(o[2]=__builtin_amdgcn_mfma_f32_32x32x16_bf16(PAF(0),VFR(0),o[2],0,0,0), C1,0); \
    GAPB(o[3]=__builtin_amdgcn_mfma_f32_32x32x16_bf16(PAF(0),VFR(4),o[3],0,0,0), C1,2); \
    GAPB(o[2]=__builtin_amdgcn_mfma_f32_32x32x16_bf16(PAF(1),VFR(1),o[2],0,0,0), C1,4); \
    GAPB(o[3]=__builtin_amdgcn_mfma_f32_32x32x16_bf16(PAF(1),VFR(5),o[3],0,0,0), C1,6); \
    GAPB(o[2]=__builtin_amdgcn_mfma_f32_32x32x16_bf16(PAF(2),VFR(2),o[2],0,0,0), C1,8); \
    GAPB(o[3]=__builtin_amdgcn_mfma_f32_32x32x16_bf16(PAF(2),VFR(6),o[3],0,0,0), C1,10); \
    GAPB(o[2]=__builtin_amdgcn_mfma_f32_32x32x16_bf16(PAF(3),VFR(3),o[2],0,0,0), C1,12); \
    GAPB(o[3]=__builtin_amdgcn_mfma_f32_32x32x16_bf16(PAF(3),VFR(7),o[3],0,0,0), C1,14); \
    }while(0)
  int t=1;
  #undef CMASK
  #define CMASK(P0,P1,t) do{}while(0)
  for(;t+5<NT;t+=2){
    STEP(pB0,pB1,pA0,pA1,t,true,true,true);     WAIT_BAR(3); RESC(); ROT();
    STEP(pA0,pA1,pB0,pB1,t+1,true,true,true);   WAIT_BAR(3); RESC(); ROT();
  }
  #undef CMASK
  #define CMASK(P0,P1,t) do{}while(0)
  #define ENDW(tt) do{ if((tt)+3<NT){WAIT_BAR(3);} else if((tt)+2<NT){WAIT_BAR(2);} else {WAIT_BAR(0);} }while(0)
  for(;t+1<NT;t+=2){
    STEP(pB0,pB1,pA0,pA1,t,(t+3<NT),(t+1<NT),(t+1<NT));       ENDW(t);   RESC(); ROT();
    STEP(pA0,pA1,pB0,pB1,t+1,(t+4<NT),(t+2<NT),(t+2<NT));     ENDW(t+1); RESC(); ROT();
  }
  STEP(pB0,pB1,pA0,pA1,NT-1,false,false,false); RESC();
  { float sacc=pB0[0]+pB0[1]; _Pragma("unroll") for(int r=2;r<16;++r)sacc+=pB0[r]; _Pragma("unroll") for(int r=0;r<16;++r)sacc+=pB1[r]; l_reg+=sacc;
    pw0=(u32x4){PKW(pB0,0),PKW(pB0,2),PKW(pB0,4),PKW(pB0,6)};pw1=(u32x4){PKW(pB0,8),PKW(pB0,10),PKW(pB0,12),PKW(pB0,14)};pw2=(u32x4){PKW(pB1,0),PKW(pB1,2),PKW(pB1,4),PKW(pB1,6)};pw3=(u32x4){PKW(pB1,8),PKW(pB1,10),PKW(pB1,12),PKW(pB1,14)};
    SBAR(); pv(o,vb0+2*sl_cur,PAF(0),PAF(1),PAF(2),PAF(3)); pv(o+2,vb0+2*sl_cur+8192,PAF(0),PAF(1),PAF(2),PAF(3)); }
  #undef PKW
  #undef PAF
  #undef VFR
  #undef PIN
  #undef MX3
  #undef GAPA
  #undef GAPB
  #undef EX
  #undef VRD
  #undef VRD2
  #undef KRD
  #undef STEP
  #undef ENDW
  {auto rr=__builtin_amdgcn_permlane32_swap(__float_as_uint(l_reg),__float_as_uint(l_reg),false,false);l_reg=__uint_as_float(rr[0])+__uint_as_float(rr[1]);}
  if(hi==0)wsf[32+r32]=l_reg;asm volatile("s_waitcnt lgkmcnt(0)":::"memory");
  float rli[16];
  #pragma unroll
  for(int r=0;r<16;++r)rli[r]=__builtin_amdgcn_rcpf(wsf[32+crow(r,hi)]);
  bf16*Ow=Ou+(long)(wid*QBLK)*op;
  { bf16*stg=(bf16*)(shm+LDS2_OST)+wid*2048;
    #pragma unroll
    for(int hh=0;hh<2;++hh){
      #pragma unroll
      for(int r=0;r<16;++r){const int orow=crow(r,hi);
        #pragma unroll
        for(int d0=0;d0<2;++d0)stg[orow*64+d0*32+r32]=__float2bfloat16(o[2*hh+d0][r]*rli[r]);}
      asm volatile("s_waitcnt lgkmcnt(0)":::"memory");
      #pragma unroll
      for(int i=0;i<4;++i){const int row=i*8+(lane>>3),ch=lane&7; const u32x4 v=*(const u32x4*)(stg+row*64+ch*8); ATTN_STORE16(Ow+(long)row*op+hh*64+ch*8,v);}
      asm volatile("s_waitcnt lgkmcnt(0)":::"memory"); } }
  asm volatile("s_waitcnt lgkmcnt(0)\n\ts_barrier":::"memory");
  #undef DMA_K
  #undef ROTT
  #undef DMA_V
  #undef CMASK
  #undef START
  #undef RESC
  #undef ROT
}
constexpr int ATTN_LDS_BYTES=LDS_BYTES;
#undef SBAR
#undef WAIT_BAR
}
constexpr int NWAVES = 8;
#ifndef MK_ONE_LAUNCH
#define MK_ONE_LAUNCH 1
#endif
constexpr int NPH = 20;

constexpr int D = 1024, NB = 2, SEQ = 8192, CTXL = 256;
constexpr int ML = NB * SEQ, MC = NB * CTXL, MR = ML + MC;
constexpr int E_IN = 2560, O_IN = 1792, FF = 2816, FF2 = 2 * FF, NEXP = 8;
constexpr int MOE_ROWS = 2 * ML + NEXP * 256, MOE_PAN = MOE_ROWS / 256;
constexpr int NCHUNK = MR / 64;
constexpr float EPS = 1e-6f;
constexpr float MOE_S13 = 32.0f, MOE_S2 = 64.0f;
constexpr float QSCALE = 0.125f * 1.4426950408889634f;

constexpr size_t MiB = 1u << 20, KiB = 1u << 10;
constexpr size_t WS_CTL = 0, CTL_ZERO_BYTES = 1 * MiB;
constexpr size_t WS_MOD = 1 * MiB;
constexpr size_t WS_WG = 1 * MiB + 256 * KiB;
constexpr size_t WS_TOK = 2 * MiB;
constexpr size_t WS_AGG = 4 * MiB;
constexpr size_t WS_WM13 = 8 * MiB, WS_WM2 = 96 * MiB;
constexpr size_t WS_WE = 140 * MiB, WS_WO0 = 145 * MiB, WS_WO1 = 147 * MiB, WS_WF13 = 149 * MiB, WS_WF2 = 160 * MiB, WS_WOI = 166 * MiB;
constexpr size_t WS_XR = 170 * MiB;
constexpr size_t WS_KC0 = 170 * MiB, WS_VC0 = 187 * MiB;
constexpr size_t WS_KC1 = 427 * MiB, WS_VC1 = 432 * MiB;
constexpr int KEYS = CTXL + SEQ;
constexpr size_t WS_XN = 236 * MiB;
constexpr size_t WS_Y = 269 * MiB;
constexpr size_t WS_P0 = 302 * MiB;
constexpr size_t WS_OATT = 385 * MiB;
constexpr size_t WS_H = 302 * MiB;
constexpr size_t WS_P1 = 302 * MiB;
constexpr size_t WS_RI = 360 * MiB;
constexpr size_t WS_XG = 368 * MiB;
constexpr size_t WS_HG = 140 * MiB;
constexpr size_t WS_YG = 368 * MiB;
constexpr size_t WS_END = 436 * MiB;
static_assert(WS_WM13 + (size_t)NEXP * FF2 * D * 2 <= WS_WM2 && WS_WM2 + (size_t)NEXP * D * FF * 2 <= WS_WE && WS_WE + (size_t)E_IN * D * 2 <= WS_WO0 && WS_WF13 + (size_t)FF2 * D * 2 <= WS_WF2 &&
              WS_WF2 + (size_t)D * FF * 2 <= WS_WOI && WS_WOI + (size_t)O_IN * D * 2 <= WS_XR && WS_XR + (size_t)MR * D * 4 <= WS_XN && WS_XN + (size_t)MR * D * 2 <= WS_Y && WS_Y + (size_t)MR * D * 2 <= WS_P0 &&
              WS_P0 + (size_t)MR * E_IN * 2 <= WS_OATT && WS_OATT + (size_t)MR * D * 2 <= WS_END && WS_H + (size_t)MR * FF * 2 <= WS_END && WS_P1 + (size_t)MR * O_IN * 2 <= WS_RI &&
              WS_RI + (size_t)4 * MR * 512 * 2 <= WS_END && WS_XG + (size_t)MOE_ROWS * D * 2 <= WS_END && WS_HG + (size_t)MOE_ROWS * FF * 2 <= WS_XG && WS_AGG + (size_t)2 * NCHUNK * 2 * 512 * 4 <= WS_WM13, "d_ws map");
constexpr int CW_TMO = 0, CW_CODE = 1;
constexpr int CW_BAR = 4096;
constexpr int CW_CNT = 8192;
constexpr int RING_OFF = 0, RING_BYTES = 131072;
constexpr int LDSCTL_OFF = RING_BYTES, MISC_OFF = LDSCTL_OFF + 320;
constexpr int PEXP_OFF = LDSCTL_OFF + 1024;
constexpr int LDS_BYTES = 147456;
#define GAS __attribute__((address_space(1)))
#define LAS __attribute__((address_space(3)))
typedef unsigned short bf16;
typedef unsigned v4u __attribute__((ext_vector_type(4)));
typedef float f32x4 __attribute__((ext_vector_type(4)));
typedef short bf16x8 __attribute__((ext_vector_type(8)));
typedef GAS unsigned gu32;
typedef GAS unsigned long long gu64;
#define RLX_AGENT __ATOMIC_RELAXED, __HIP_MEMORY_SCOPE_AGENT
#define LDS_WAIT() asm volatile("s_waitcnt lgkmcnt(0)" ::: "memory")
#define VM_WAIT() asm volatile("s_waitcnt vmcnt(0)" ::: "memory")
__device__ __forceinline__ unsigned long long rt() { return __builtin_amdgcn_s_memrealtime(); }
__device__ __forceinline__ unsigned f2bf(float f) { unsigned u = __builtin_bit_cast(unsigned, f); return (u + 0x7fffu + ((u >> 16) & 1u)) >> 16; }
__device__ __forceinline__ unsigned pk2(float lo, float hi) { return f2bf(lo) | (f2bf(hi) << 16); }

#define XB_TMO      128
#define XB_XCNT(j)  (256  + 64 * (j))
#define XB_XSUB(j)  (1280 + 64 * (j))
#define XB_XGEN(j)  (2304 + 64 * (j))
#define XB_TOP      3328
#define XB_TOPGEN   3392
#define XCD_BAR_WORDS 3456
#define XB_SPIN_CAP (1u << 18)

__device__ __forceinline__ unsigned xb_ld(unsigned* p)              { return __hip_atomic_load(p, __ATOMIC_RELAXED, __HIP_MEMORY_SCOPE_AGENT); }
__device__ __forceinline__ unsigned xb_add(unsigned* p, unsigned v) { return __hip_atomic_fetch_add(p, v, __ATOMIC_RELAXED, __HIP_MEMORY_SCOPE_AGENT); }
__device__ __forceinline__ unsigned xb_xcc_id() { return (unsigned)__builtin_amdgcn_s_getreg((3 << 11) | 20) & 0xFu; }
#define XB_SPIN(cond, bar) do { unsigned _sp = 0; while (cond) { __builtin_amdgcn_s_sleep(1); \
    if ((++_sp & 255u) == 0u) { if (xb_ld(&(bar)[XB_TMO])) break; if (_sp > XB_SPIN_CAP) { atomicAdd(&(bar)[XB_TMO], 1u); break; } } } } while (0)

struct XcdBarrier {
    unsigned* bar; unsigned x;
    volatile LAS unsigned* st;
};

__device__ __forceinline__ XcdBarrier xcd_barrier_post(unsigned* bar, volatile LAS unsigned* st) {
    XcdBarrier b; b.bar = bar; b.x = xb_xcc_id(); b.st = st;
    if (threadIdx.x == 0) (void)xb_add(&bar[XB_XCNT(b.x)], 1u);
    return b;
}
__device__ __forceinline__ void xcd_barrier_complete(unsigned* bar, unsigned x, unsigned& nloc, unsigned& nx) {
    const unsigned G = gridDim.x * gridDim.y * gridDim.z;
    unsigned sum, cnt, mine, sp = 0u;
    for (;;) {
        sum = 0u; cnt = 0u; mine = 0u;
#pragma unroll
        for (unsigned j = 0; j < 16; ++j) { const unsigned c = xb_ld(&bar[XB_XCNT(j)]); sum += c; cnt += (c > 0u) ? 1u : 0u; mine = (j == x) ? c : mine; }
        if (sum == G) break;
        __builtin_amdgcn_s_sleep(1);
        if ((++sp & 255u) == 0u) { if (xb_ld(&bar[XB_TMO])) break; if (sp > XB_SPIN_CAP) { atomicAdd(&bar[XB_TMO], 1u); break; } }
    }
    nloc = mine > 0u ? mine : 1u; nx = cnt > 0u ? cnt : 1u;
}

__device__ __forceinline__ void xcd_barrier(const XcdBarrier& b) {
    asm volatile("s_waitcnt vmcnt(0)" ::: "memory");
    __syncthreads();
    if (threadIdx.x == 0) {
        unsigned* bar = b.bar;
        __builtin_amdgcn_s_waitcnt(0);
        unsigned nloc = b.st[0], nx = b.st[1];
        if (nloc == 0u) { xcd_barrier_complete(bar, b.x, nloc, nx); b.st[0] = nloc; b.st[1] = nx; }
        const unsigned old = xb_add(&bar[XB_XSUB(b.x)], 1u);
        const unsigned gen = old / nloc;
        if (old + 1u == (gen + 1u) * nloc) {
            __builtin_amdgcn_fence(__ATOMIC_RELEASE, "agent");
            asm volatile("s_waitcnt vmcnt(0)" ::: "memory");
            const unsigned og = xb_add(&bar[XB_TOP], 1u);
            const unsigned tg = og / nx;
            if (og + 1u == (tg + 1u) * nx) xb_add(&bar[XB_TOPGEN], 1u);
            else XB_SPIN(xb_ld(&bar[XB_TOPGEN]) == tg, bar);
            __builtin_amdgcn_fence(__ATOMIC_ACQUIRE, "agent");
            xb_add(&bar[XB_XGEN(b.x)], 1u);
            asm volatile("s_waitcnt vmcnt(0)" ::: "memory");
        } else {
            XB_SPIN(xb_ld(&bar[XB_XGEN(b.x)]) == gen, bar);
            __builtin_amdgcn_fence(__ATOMIC_ACQUIRE, "agent");
            asm volatile("s_waitcnt vmcnt(0)" ::: "memory");
        }
    }
    __syncthreads();
}
typedef _Float16 f16;
typedef unsigned v2u __attribute__((ext_vector_type(2)));
typedef float f32x16 __attribute__((ext_vector_type(16)));
struct InPtrs { __device__ __forceinline__ const float* operator[](int i) const { return ((const float* const __attribute__((address_space(4)))*)__builtin_amdgcn_kernarg_segment_ptr())[i]; } };
struct Frame {
    LAS unsigned char* lds;
    volatile LAS unsigned* MISC;
    gu32* ctl;
    int tid, lane, wave;
    int vcu, G;
    InPtrs in; float* out; unsigned char* ws;
};
enum { I_X = 0, I_C, I_CTX, I_CCTX, I_WMOD, I_BMOD, I_NMIXG, I_NFFNG, I_WOUT, I_EWIN, I_ANORMG, I_AWS, I_ABS, I_BQNG, I_BKNG, I_LQ1, I_LK1, I_LQ2, I_LK2, I_SUBLNG,
       I_FW1, I_FW3, I_FW2, I_OWIN, I_CQNG, I_CKNG, I_CONVW, I_CONVB, I_DWA, I_DBA, I_DWX, I_DBX, I_DLAM, I_RW, I_RB, I_MW1, I_MW3, I_MW2 };

__device__ __forceinline__ float wave_sum(float v) {
#pragma unroll
    for (int o = 1; o < 64; o <<= 1) v += __shfl_xor(v, o);
    return v;
}
__device__ __forceinline__ float bf_lo(unsigned u) { return __uint_as_float(u << 16); }
__device__ __forceinline__ float bf_hi(unsigned u) { return __uint_as_float(u & 0xffff0000u); }
__device__ __forceinline__ float bf2f(bf16 h) { return __uint_as_float((unsigned)h << 16); }
__device__ __forceinline__ unsigned cvtpk(float lo, float hi) { return pg8::cvt_pk_bf16(lo, hi); }
__device__ __forceinline__ bf16 f2bf16(float f) { return (bf16)(cvtpk(f, 0.f) & 0xffffu); }
__device__ __forceinline__ void unpack8(const v4u u, float (&f)[8]) { f[0] = bf_lo(u.x); f[1] = bf_hi(u.x); f[2] = bf_lo(u.y); f[3] = bf_hi(u.y); f[4] = bf_lo(u.z); f[5] = bf_hi(u.z); f[6] = bf_lo(u.w); f[7] = bf_hi(u.w); }
__device__ __forceinline__ v4u pack8(const float (&f)[8]) { v4u o; o.x = cvtpk(f[0], f[1]); o.y = cvtpk(f[2], f[3]); o.z = cvtpk(f[4], f[5]); o.w = cvtpk(f[6], f[7]); return o; }
__device__ __forceinline__ float gelu_tanh(float x) { const float z = 0.7978845608028654f * (x + 0.044715f * x * x * x); return x * __builtin_amdgcn_rcpf(1.0f + __builtin_amdgcn_exp2f(-2.885390081777927f * z)); }
__device__ __forceinline__ float sigmoid_f(float x) { return __builtin_amdgcn_rcpf(1.0f + __builtin_amdgcn_exp2f(-1.4426950408889634f * x)); }
__device__ __forceinline__ int crow16(int r, int hi) { return (r & 3) + 8 * (r >> 2) + 4 * hi; }

__device__ __forceinline__ bool qk_bounded(const float* gq, const float* gk, int lane) {
    float a = fabsf(gq[lane]), b = fabsf(gk[lane]);
#pragma unroll
    for (int o = 1; o < 64; o <<= 1) { a = fmaxf(a, __shfl_xor(a, o)); b = fmaxf(b, __shfl_xor(b, o)); }
    return __builtin_amdgcn_readfirstlane((int)(64.0f * QSCALE * a * b * 1.02f < 64.0f)) != 0;
}
struct TrItem { const float* W; unsigned char* WT; int K, N, ilv, f8, item; float scale; };
__device__ __forceinline__ void tr_load(const TrItem& d, int lane, f32x4 (&v)[8]) {
    const int nblk = d.N / 32, kb = d.item / nblk, nb = d.item % nblk; const float* p = d.W + (size_t)(64 * kb + (lane >> 3)) * d.N + 32 * nb + 4 * (lane & 7);
#pragma unroll
    for (int i = 0; i < 8; ++i) v[i] = *(const GAS f32x4*)(p + (size_t)(8 * i) * d.N);
}
__device__ __forceinline__ void tr_store(const TrItem& d, int lane, const f32x4 (&v)[8], LAS float* scr) {
    const int nblk = d.N / 32, kb = d.item / nblk, nb = d.item % nblk, k0 = 64 * kb, n0 = 32 * nb;
    const int r0 = d.ilv ? ((n0 >> 7) * 256 + (n0 & 127) + (d.ilv == 2 ? 128 : 0)) : n0;
#pragma unroll
    for (int i = 0; i < 8; ++i) { LAS float* q = scr + (8 * i + (lane >> 3)) * 33 + 4 * (lane & 7); q[0] = v[i].x * d.scale; q[1] = v[i].y * d.scale; q[2] = v[i].z * d.scale; q[3] = v[i].w * d.scale; }
    LDS_WAIT(); asm volatile("" ::: "memory");
    if (d.f8) { const int c = lane & 3;
#pragma unroll
        for (int j = 0; j < 2; ++j) { const int n = (lane >> 2) + 16 * j; const LAS float* s = scr + (16 * c) * 33 + n;
            v4u o; o.x = pg8::cvt4_fp8(s[0 * 33], s[1 * 33], s[2 * 33], s[3 * 33]); o.y = pg8::cvt4_fp8(s[4 * 33], s[5 * 33], s[6 * 33], s[7 * 33]);
            o.z = pg8::cvt4_fp8(s[8 * 33], s[9 * 33], s[10 * 33], s[11 * 33]); o.w = pg8::cvt4_fp8(s[12 * 33], s[13 * 33], s[14 * 33], s[15 * 33]);
            *(GAS v4u*)(d.WT + (size_t)(r0 + n) * d.K + k0 + 16 * c) = o; }
    } else { const int c = lane & 7;
#pragma unroll
        for (int j = 0; j < 4; ++j) { const int n = (lane >> 3) + 8 * j; const LAS float* s = scr + (8 * c) * 33 + n;
            v4u o; o.x = cvtpk(s[0 * 33], s[1 * 33]); o.y = cvtpk(s[2 * 33], s[3 * 33]); o.z = cvtpk(s[4 * 33], s[5 * 33]); o.w = cvtpk(s[6 * 33], s[7 * 33]);
            *(GAS v4u*)((bf16*)d.WT + (size_t)(r0 + n) * d.K + k0 + 8 * c) = o; } }
    LDS_WAIT(); asm volatile("" ::: "memory");
}
constexpr int TR_I_E = 16 * 80, TR_I_O = 16 * 32, TR_I_F = 16 * 88, TR_I_OI = 16 * 56, TR_I_EXP = 3 * TR_I_F;
constexpr int TR_NITEMS = TR_I_E + 2 * TR_I_O + 3 * TR_I_F + TR_I_OI + NEXP * TR_I_EXP;
static_assert(TR_I_F == 44 * 32, "item counts of the [1024][2816] and [2816][1024] matrices match");
__device__ __forceinline__ TrItem tr_decode(Frame& F, int it) {
    unsigned char* ws = F.ws; int r = it; TrItem d; d.f8 = 0; d.scale = 1.0f; d.ilv = 0;
    if (r < TR_I_E) { d.W = F.in[I_EWIN]; d.K = D; d.N = E_IN; d.WT = ws + WS_WE; d.item = r; return d; } r -= TR_I_E;
    if (r < TR_I_O) { d.W = F.in[I_WOUT]; d.K = D; d.N = D; d.WT = ws + WS_WO0; d.item = r; return d; } r -= TR_I_O;
    if (r < TR_I_O) { d.W = F.in[I_WOUT] + (size_t)D * D; d.K = D; d.N = D; d.WT = ws + WS_WO1; d.item = r; return d; } r -= TR_I_O;
    if (r < TR_I_F) { d.W = F.in[I_FW1]; d.K = D; d.N = FF; d.WT = ws + WS_WF13; d.ilv = 1; d.f8 = 1; d.scale = MOE_S13; d.item = r; return d; } r -= TR_I_F;
    if (r < TR_I_F) { d.W = F.in[I_FW3]; d.K = D; d.N = FF; d.WT = ws + WS_WF13; d.ilv = 2; d.f8 = 1; d.scale = MOE_S13; d.item = r; return d; } r -= TR_I_F;
    if (r < TR_I_F) { d.W = F.in[I_FW2]; d.K = FF; d.N = D; d.WT = ws + WS_WF2; d.f8 = 1; d.scale = MOE_S2; d.item = r; return d; } r -= TR_I_F;
    if (r < TR_I_OI) { d.W = F.in[I_OWIN]; d.K = D; d.N = O_IN; d.WT = ws + WS_WOI; d.item = r; return d; } r -= TR_I_OI;
    const int e = r / TR_I_EXP, q = r % TR_I_EXP; d.f8 = 1;
    if (q < TR_I_F) { d.W = F.in[I_MW1] + (size_t)e * D * FF; d.K = D; d.N = FF; d.WT = ws + WS_WM13 + (size_t)e * FF2 * D; d.ilv = 1; d.scale = MOE_S13; d.item = q; }
    else if (q < 2 * TR_I_F) { d.W = F.in[I_MW3] + (size_t)e * D * FF; d.K = D; d.N = FF; d.WT = ws + WS_WM13 + (size_t)e * FF2 * D; d.ilv = 2; d.scale = MOE_S13; d.item = q - TR_I_F; }
    else { d.W = F.in[I_MW2] + (size_t)e * FF * D; d.K = FF; d.N = D; d.WT = ws + WS_WM2 + (size_t)e * D * FF; d.scale = MOE_S2; d.item = q - 2 * TR_I_F; }
    return d;
}
constexpr int TR_DENSE = TR_I_E + 2 * TR_I_O + 3 * TR_I_F + TR_I_OI;
__device__ __forceinline__ void tr_range(Frame& F, int lo, int hi) {
    LAS float* scr = (LAS float*)(F.lds + RING_OFF + F.wave * 16384);
    const int gw = F.vcu * NWAVES + F.wave, NGW = F.G * NWAVES, lane = F.lane;
    f32x4 v0[8], v1[8], v2[8], v3[8]; TrItem d0, d1, d2, d3; int it = lo + gw;
#define TR_ISSUE(d, v, idx) do { const int i_ = (idx); d = tr_decode(F, i_ < hi ? i_ : lo); if (i_ < hi) tr_load(d, lane, v); } while (0)
    TR_ISSUE(d0, v0, it); TR_ISSUE(d1, v1, it + NGW); TR_ISSUE(d2, v2, it + 2 * NGW);
    while (it < hi) {
        TR_ISSUE(d3, v3, it + 3 * NGW); tr_store(d0, lane, v0, scr); if (it + NGW >= hi) break;
        TR_ISSUE(d0, v0, it + 4 * NGW); tr_store(d1, lane, v1, scr); if (it + 2 * NGW >= hi) break;
        TR_ISSUE(d1, v1, it + 5 * NGW); tr_store(d2, lane, v2, scr); if (it + 3 * NGW >= hi) break;
        TR_ISSUE(d2, v2, it + 6 * NGW); tr_store(d3, lane, v3, scr);
        it += 4 * NGW; }
#undef TR_ISSUE
}
__device__ __forceinline__ void ph0_prologue(Frame& F) {
    const int lane = F.lane;
    tr_range(F, 0, TR_DENSE);
    { bf16* WG = (bf16*)(F.ws + WS_WG);
      for (int i = (int)blockIdx.x * 512 + F.tid; i < 2 * 2 * 8 * 64 * 64; i += F.G * 512) {
          const int k = i & 63, o = (i >> 6) & 63, n = (i >> 12) & 7, mat = (i >> 15) & 1, d = (i >> 16) & 1;
          const float* W = mat ? F.in[I_DWX] : F.in[I_DWA];
          WG[i] = f2bf16(W[((size_t)(d * 8 + n) * 64 + k) * 64 + o]); } }
    __syncthreads();
    { float* MOD = (float*)(F.ws + WS_MOD); LAS float* red = (LAS float*)(F.lds + RING_OFF);
      for (int cg = (int)blockIdx.x; cg < 2 * 96; cg += F.G) {
          const int layer = cg / 96, n0 = (cg % 96) * 64, kr = lane >> 4, c4 = lane & 15;
          f32x4 acc[3]; acc[0] = acc[1] = acc[2] = (f32x4){0.f, 0.f, 0.f, 0.f};
          const float* Wl = F.in[I_WMOD] + (size_t)layer * D * 6 * D;
#pragma unroll 4
          for (int it = 0; it < 32; ++it) { const int k = F.wave * 128 + 4 * it + kr;
              const f32x4 w = *(const GAS f32x4*)(Wl + (size_t)k * 6 * D + n0 + 4 * c4);
              const float c0 = F.in[I_C][k], c1 = F.in[I_C][D + k], c2 = F.in[I_CCTX][k];
              acc[0] += (c0 * sigmoid_f(c0)) * w; acc[1] += (c1 * sigmoid_f(c1)) * w; acc[2] += (c2 * sigmoid_f(c2)) * w; }
#pragma unroll
          for (int s = 0; s < 3; ++s)
#pragma unroll
              for (int j = 0; j < 4; ++j) { float v = acc[s][j]; v += __shfl_xor(v, 16); v += __shfl_xor(v, 32); acc[s][j] = v; }
          if (lane < 16) {
#pragma unroll
              for (int s = 0; s < 3; ++s)
#pragma unroll
                  for (int j = 0; j < 4; ++j) red[(F.wave * 3 + s) * 64 + 4 * c4 + j] = acc[s][j]; }
          __syncthreads();
          if (F.tid < 192) { const int s = F.tid >> 6, col = F.tid & 63; float v = F.in[I_BMOD][layer * 6 * D + n0 + col];
#pragma unroll
              for (int w = 0; w < 8; ++w) v += red[(w * 3 + s) * 64 + col];
              MOD[(size_t)(layer * 3 + s) * 6 * D + n0 + col] = v; }
          __syncthreads();
      } }
}
template <bool F8 = false> __device__ __forceinline__ void normmod_row(const float* src, const float* g, const float* sc, const float* sh, bf16* dst, int lane, f32x4 (&t)[4]) {
    const GAS f32x4* xr = (const GAS f32x4*)src + lane; float s = 0.f;
#pragma unroll
    for (int j = 0; j < 4; ++j) { t[j] = xr[64 * j]; s += (t[j].x * t[j].x + t[j].y * t[j].y) + (t[j].z * t[j].z + t[j].w * t[j].w); }
    const float rstd = 1.0f / sqrtf(wave_sum(s) * (1.f / D) + EPS);
    GAS v2u* o8 = (GAS v2u*)dst + lane;
#pragma unroll
    for (int j = 0; j < 4; ++j) { const f32x4 gg = ((const GAS f32x4*)g)[lane + 64 * j], cc = ((const GAS f32x4*)sc)[lane + 64 * j], hh = ((const GAS f32x4*)sh)[lane + 64 * j];
        t[j] = t[j] * rstd * gg * (1.0f + cc) + hh;
        if constexpr (F8) ((GAS unsigned*)dst)[lane + 64 * j] = pg8::cvt4_fp8(t[j].x, t[j].y, t[j].z, t[j].w); else { v2u w; w.x = cvtpk(t[j].x, t[j].y); w.y = cvtpk(t[j].z, t[j].w); o8[64 * j] = w; } }
}
template <bool F8 = false> __device__ __forceinline__ void ph_normmod(Frame& F, const float* srcL, const float* srcC, int nrows, const float* g, int layer, int sh_off, int sc_off) {
    const int gw = F.vcu * NWAVES + F.wave, NGW = F.G * NWAVES; const float* MOD = (const float*)(F.ws + WS_MOD) + (size_t)layer * 3 * 6 * D; bf16* XN = (bf16*)(F.ws + WS_XN);
    for (int m = gw; m < nrows; m += NGW) { const int s = m < SEQ ? 0 : (m < ML ? 1 : 2); const float* src = m < ML ? srcL + (size_t)m * D : srcC + (size_t)(m - ML) * D; f32x4 t[4];
        normmod_row<F8>(src, g, MOD + s * 6 * D + sc_off, MOD + s * 6 * D + sh_off, F8 ? (bf16*)((unsigned char*)XN + (size_t)m * D) : XN + (size_t)m * D, F.lane, t); }
}
__device__ __forceinline__ void qknorm_rope(float (&f)[8], const float* g, bool rope, int prow, int pcol, float outscale, int lane) {
    float ss = 0.f;
#pragma unroll
    for (int e = 0; e < 8; ++e) ss += f[e] * f[e];
    ss += __shfl_xor(ss, 1); ss += __shfl_xor(ss, 2); ss += __shfl_xor(ss, 4);
    const float rstd = 1.0f / sqrtf(ss * (1.f / 64.f) + EPS); const int j = lane & 7;
    const f32x4 g0 = *(const GAS f32x4*)(g + 8 * j), g1 = *(const GAS f32x4*)(g + 8 * j + 4);
    const float gg[8] = {g0.x, g0.y, g0.z, g0.w, g1.x, g1.y, g1.z, g1.w};
#pragma unroll
    for (int e = 0; e < 8; ++e) f[e] = f[e] * rstd * gg[e];
    if (rope) {
        const float pos = (float)((j < 4) ? prow : pcol), sgn = (j & 2) ? 1.f : -1.f;
#pragma unroll
        for (int e = 0; e < 8; ++e) { const float p = __shfl_xor(f[e], 2); const int i = (j & 1) * 8 + e;
            const float fr = __builtin_amdgcn_exp2f(-(float)i * (13.287712379549449f / 16.f)); float rev = pos * fr * 0.15915494309189535f; rev = rev - floorf(rev);
            f[e] = f[e] * __builtin_amdgcn_cosf(rev) + sgn * p * __builtin_amdgcn_sinf(rev); }
    }
#pragma unroll
    for (int e = 0; e < 8; ++e) f[e] *= outscale;
}
__device__ __forceinline__ void ph3_post0(Frame& F) {
    const int gw = F.vcu * NWAVES + F.wave, NGW = F.G * NWAVES, lane = F.lane; bf16* P0 = (bf16*)(F.ws + WS_P0); bf16* KC = (bf16*)(F.ws + WS_KC0); bf16* VC = (bf16*)(F.ws + WS_VC0);
    for (int m = gw; m < MR; m += NGW) {
        GAS v4u* rowp = (GAS v4u*)(P0 + (size_t)m * E_IN) + lane;
        const v4u u0 = rowp[0], u1 = rowp[64], u2 = rowp[128], u3 = rowp[192];
        float f[8];
        unpack8(u0, f);
#pragma unroll
        for (int e = 0; e < 8; ++e) f[e] = gelu_tanh(f[e]);
        rowp[0] = pack8(f);
        unpack8(u1, f); float ss = 0.f;
#pragma unroll
        for (int e = 0; e < 8; ++e) { f[e] = gelu_tanh(f[e]); ss += f[e] * f[e]; }
        { const float rstd = 1.0f / sqrtf(wave_sum(ss) * (1.f / 512.f) + EPS); const float* g = F.in[I_ANORMG] + 8 * lane;
          const f32x4 g0 = *(const GAS f32x4*)g, g1 = *(const GAS f32x4*)(g + 4); const float gg[8] = {g0.x, g0.y, g0.z, g0.w, g1.x, g1.y, g1.z, g1.w};
#pragma unroll
          for (int e = 0; e < 8; ++e) f[e] = f[e] * rstd * gg[e]; }
        rowp[64] = pack8(f);
        const bool lat = m < ML; const int t = m & (SEQ - 1), prow = t >> 6, pcol = t & 63;
        unpack8(u2, f); qknorm_rope(f, F.in[I_BQNG], lat, prow, pcol, QSCALE, lane); rowp[128] = pack8(f);
        unpack8(u3, f); qknorm_rope(f, F.in[I_BKNG], lat, prow, pcol, 1.0f, lane);
        { const int b = lat ? (m >> 13) : ((m - ML) >> 8), pos = lat ? CTXL + t : ((m - ML) & (CTXL - 1)); const size_t tb = (size_t)(pos >> 6) * 4096; const int pr = pos & 63;
          *(GAS v4u*)(KC + ((size_t)(b * 8 + (lane >> 3)) * KEYS * 64 + tb + (lane & 7) * 512 + pr * 8)) = pack8(f);
          const v4u u4 = rowp[256];
          *(GAS v4u*)(VC + ((size_t)(b * 8 + (lane >> 3)) * KEYS * 64 + tb + ((((lane & 7) >> 2) * 4 + (pr >> 4)) * 64 + (pr & 15) * 4 + (lane & 3)) * 8)) = u4; }
    }
}
__device__ __forceinline__ void gmlp_unit(Frame& F, int chunk) {
    const int lane = F.lane, r32 = lane & 31, hi = lane >> 5, g = F.wave, r0 = chunk * 128;
    const bf16* P0 = (const bf16*)(F.ws + WS_P0); bf16* Y = (bf16*)(F.ws + WS_Y);
    const float* ws = F.in[I_AWS] + (size_t)g * 128 * 128; const float* bs = F.in[I_ABS] + g * 128;
    bf16x8 afr[2][8];
#pragma unroll
    for (int ct = 0; ct < 2; ++ct)
#pragma unroll
        for (int ks = 0; ks < 8; ++ks)
#pragma unroll
            for (int e = 0; e < 8; ++e) afr[ct][ks][e] = (short)P0[(size_t)(r0 + 16 * ks + 8 * hi + e) * E_IN + 512 + 64 * g + 32 * ct + r32];
#pragma unroll 1
    for (int pt = 0; pt < 4; ++pt) {
        f32x16 acc[2]; acc[0] = f32x16{}; acc[1] = f32x16{};
        const float* wp = ws + (size_t)(32 * pt + r32) * 128 + 8 * hi;
#pragma unroll
        for (int ks = 0; ks < 8; ++ks) { const f32x4 w0 = *(const GAS f32x4*)(wp + 16 * ks), w1 = *(const GAS f32x4*)(wp + 16 * ks + 4);
            v4u pk; pk.x = cvtpk(w0.x, w0.y); pk.y = cvtpk(w0.z, w0.w); pk.z = cvtpk(w1.x, w1.y); pk.w = cvtpk(w1.z, w1.w); const bf16x8 bfr = __builtin_bit_cast(bf16x8, pk);
            acc[0] = __builtin_amdgcn_mfma_f32_32x32x16_bf16(afr[0][ks], bfr, acc[0], 0, 0, 0); acc[1] = __builtin_amdgcn_mfma_f32_32x32x16_bf16(afr[1][ks], bfr, acc[1], 0, 0, 0); }
        const int p = 32 * pt + r32; const float bias = bs[p];
#pragma unroll
        for (int ct = 0; ct < 2; ++ct)
#pragma unroll
            for (int rq = 0; rq < 4; ++rq) { const int c0 = 64 * g + 32 * ct + 8 * rq + 4 * hi;
                const v2u uu = *(const GAS v2u*)(P0 + (size_t)(r0 + p) * E_IN + c0);
                v2u o; o.x = cvtpk(bf_lo(uu.x) * (acc[ct][4 * rq + 0] + bias), bf_hi(uu.x) * (acc[ct][4 * rq + 1] + bias)); o.y = cvtpk(bf_lo(uu.y) * (acc[ct][4 * rq + 2] + bias), bf_hi(uu.y) * (acc[ct][4 * rq + 3] + bias));
                *(GAS v2u*)(Y + (size_t)(r0 + p) * D + c0) = o; }
    }
}
__device__ __forceinline__ void ph5_diffout(Frame& F) {
    const int gw = F.vcu * NWAVES + F.wave, NGW = F.G * NWAVES, lane = F.lane; const bf16* OA = (const bf16*)(F.ws + WS_OATT); bf16* Y = (bf16*)(F.ws + WS_Y);
    const float s1 = wave_sum(F.in[I_LQ1][lane] * F.in[I_LK1][lane]), s2 = wave_sum(F.in[I_LQ2][lane] * F.in[I_LK2][lane]);
    const float lam_init = 0.2f, lam = expf(s1) - expf(s2) + lam_init;
    const int h = lane >> 4, comp = (lane >> 3) & 1, i0 = (lane & 7) * 16;
    float gg[16];
#pragma unroll
    for (int q = 0; q < 4; ++q) { const f32x4 gv = *(const GAS f32x4*)(F.in[I_SUBLNG] + i0 + 4 * q); gg[4 * q] = gv.x; gg[4 * q + 1] = gv.y; gg[4 * q + 2] = gv.z; gg[4 * q + 3] = gv.w; }
    for (int m = gw; m < MR; m += NGW) {
        const GAS v4u* rp = (const GAS v4u*)(OA + (size_t)m * D + 16 * lane);
        const v4u a = rp[0], b = rp[1]; float own[16], d[16];
        { float t8[8]; unpack8(a, t8);
#pragma unroll
          for (int e = 0; e < 8; ++e) own[e] = t8[e];
          unpack8(b, t8);
#pragma unroll
          for (int e = 0; e < 8; ++e) own[8 + e] = t8[e]; }
        float ss = 0.f;
#pragma unroll
        for (int e = 0; e < 16; ++e) { const float oth = __shfl_xor(own[e], 8); const float o1 = comp ? oth : own[e], o2 = comp ? own[e] : oth; d[e] = o1 - lam * o2; ss += d[e] * d[e]; }
        ss += __shfl_xor(ss, 1); ss += __shfl_xor(ss, 2); ss += __shfl_xor(ss, 4);
        const float rstd = (1.0f - lam_init) / sqrtf(ss * (1.f / 128.f) + EPS);
        if (comp == 0) { float o8[8]; GAS v4u* yp = (GAS v4u*)(Y + (size_t)m * D + 512 + 128 * h + i0);
#pragma unroll
            for (int e = 0; e < 8; ++e) o8[e] = d[e] * rstd * gg[e];
            yp[0] = pack8(o8);
#pragma unroll
            for (int e = 0; e < 8; ++e) o8[e] = d[8 + e] * rstd * gg[8 + e];
            yp[1] = pack8(o8); }
    }
}
__device__ __forceinline__ void ph12_post1(Frame& F) {
    const int gw = F.vcu * NWAVES + F.wave, NGW = F.G * NWAVES, lane = F.lane; bf16* P1 = (bf16*)(F.ws + WS_P1); bf16* KC = (bf16*)(F.ws + WS_KC1); bf16* VC = (bf16*)(F.ws + WS_VC1);
    for (int m = gw; m < MR; m += NGW) {
        GAS v4u* rowp = (GAS v4u*)(P1 + (size_t)m * O_IN) + lane;
        const v4u u0 = rowp[0], u1 = rowp[64];
        const bool lat = m < ML; const int t = m & (SEQ - 1), prow = t >> 6, pcol = t & 63; float f[8];
        unpack8(u0, f); qknorm_rope(f, F.in[I_CQNG], lat, prow, pcol, QSCALE, lane); if (lat) rowp[0] = pack8(f);
        unpack8(u1, f); qknorm_rope(f, F.in[I_CKNG], lat, prow, pcol, 1.0f, lane);
        { const int b = lat ? (m >> 13) : ((m - ML) >> 8), pos = lat ? CTXL + t : ((m - ML) & (CTXL - 1)); const size_t tb = (size_t)(pos >> 6) * 4096; const int pr = pos & 63, l2 = lane & 15;
          if (lane < 16) *(GAS v4u*)(KC + ((size_t)(b * 2 + (l2 >> 3)) * KEYS * 64 + tb + (l2 & 7) * 512 + pr * 8)) = pack8(f);
          else if (lane < 32) *(GAS v4u*)(VC + ((size_t)(b * 2 + (l2 >> 3)) * KEYS * 64 + tb + ((((l2 & 7) >> 2) * 4 + (pr >> 4)) * 64 + (pr & 15) * 4 + (l2 & 3)) * 8)) = u1; }
    }
}
__device__ __forceinline__ bool seq_start(int r) { return r < ML ? (r & (SEQ - 1)) == 0 : ((r - ML) & (CTXL - 1)) == 0; }
constexpr int XDS = 520;
__device__ __forceinline__ void conv_to_lds(Frame& F, int r0, LAS bf16* XD) {
    const int cg = F.lane, w = F.wave; const bf16* P1 = (const bf16*)(F.ws + WS_P1);
    const bool st = seq_start(r0), en = seq_start(r0 + 64) || (r0 + 64 == MR);
    float wj[4][8], cb[8];
#pragma unroll
    for (int j = 0; j < 4; ++j) { const f32x4 a = *(const GAS f32x4*)(F.in[I_CONVW] + j * 512 + 8 * cg), b = *(const GAS f32x4*)(F.in[I_CONVW] + j * 512 + 8 * cg + 4);
        wj[j][0] = a.x; wj[j][1] = a.y; wj[j][2] = a.z; wj[j][3] = a.w; wj[j][4] = b.x; wj[j][5] = b.y; wj[j][6] = b.z; wj[j][7] = b.w; }
    { const f32x4 a = *(const GAS f32x4*)(F.in[I_CONVB] + 8 * cg), b = *(const GAS f32x4*)(F.in[I_CONVB] + 8 * cg + 4); cb[0] = a.x; cb[1] = a.y; cb[2] = a.z; cb[3] = a.w; cb[4] = b.x; cb[5] = b.y; cb[6] = b.z; cb[7] = b.w; }
    v4u xr[11];
#pragma unroll
    for (int i = 0; i < 11; ++i) { const int rl = 8 * w + i - 2; const bool ok = !((st && rl < 0) || (en && rl >= 64));
        xr[i] = ok ? *(const GAS v4u*)(P1 + (size_t)(r0 + rl) * O_IN + 1280 + 8 * cg) : (v4u){0u, 0u, 0u, 0u}; }
    float acc[8][8];
#pragma unroll
    for (int o = 0; o < 8; ++o)
#pragma unroll
        for (int e = 0; e < 8; ++e) acc[o][e] = cb[e];
#pragma unroll
    for (int i = 0; i < 11; ++i) { float f[8]; unpack8(xr[i], f);
#pragma unroll
        for (int j = 0; j < 4; ++j) { const int o = i - j; if (o >= 0 && o < 8) {
#pragma unroll
            for (int e = 0; e < 8; ++e) acc[o][e] += wj[j][e] * f[e]; } } }
#pragma unroll
    for (int o = 0; o < 8; ++o) *(LAS v4u*)(XD + (8 * w + o) * XDS + 8 * cg) = pack8(acc[o]);
}
__device__ __forceinline__ void lru_gates(Frame& F, const LAS bf16* XD, int n, int d, int half, f32x16 (&a)[2], f32x16 (&b)[2]) {
    const int lane = F.lane, r32 = lane & 31, hi = lane >> 5; const bf16* WG = (const bf16*)(F.ws + WS_WG);
    f32x16 ai[2]; a[0] = f32x16{}; a[1] = f32x16{}; ai[0] = f32x16{}; ai[1] = f32x16{};
    const bf16* wpr = WG + ((size_t)(((d * 2 + 0) * 8 + n) * 64 + 32 * half + r32)) * 64 + 8 * hi; const bf16* wpi = WG + ((size_t)(((d * 2 + 1) * 8 + n) * 64 + 32 * half + r32)) * 64 + 8 * hi;
#pragma unroll
    for (int ks = 0; ks < 4; ++ks) { const bf16x8 br = *(const GAS bf16x8*)(wpr + 16 * ks), bi = *(const GAS bf16x8*)(wpi + 16 * ks);
#pragma unroll
        for (int mt = 0; mt < 2; ++mt) { const bf16x8 af = *(const LAS bf16x8*)(XD + (32 * mt + r32) * XDS + 64 * n + 16 * ks + 8 * hi);
            a[mt] = __builtin_amdgcn_mfma_f32_32x32x16_bf16(af, br, a[mt], 0, 0, 0); ai[mt] = __builtin_amdgcn_mfma_f32_32x32x16_bf16(af, bi, ai[mt], 0, 0, 0); } }
    __builtin_amdgcn_sched_barrier(0);
    const int ch = 64 * n + 32 * half + r32; const float ba = F.in[I_DBA][d * 512 + ch], bx = F.in[I_DBX][d * 512 + ch];
    const float sp8 = 8.0f * log1pf(expf(-F.in[I_DLAM][d * 512 + ch]));
#pragma unroll
    for (int mt = 0; mt < 2; ++mt)
#pragma unroll
        for (int r = 0; r < 16; ++r) { const int row = 32 * mt + crow16(r, hi); const float xd = bf2f(XD[row * XDS + ch]);
            const float rr = sigmoid_f(a[mt][r] + ba), ii = sigmoid_f(ai[mt][r] + bx); const float y = rr * sp8, av = __builtin_amdgcn_exp2f(y * -1.4426950408889634f);
            const float y2 = 2.0f * y, om = y2 < 0.03f ? y2 * (1.0f - y2 * (0.5f - y2 * (1.0f / 6.0f))) : fmaf(-av, av, 1.0f);
            a[mt][r] = av; b[mt][r] = sqrtf(om) * (ii * xd); if ((r & 3) == 3) __builtin_amdgcn_sched_barrier(0); }
}
template <bool REV, bool FULL> __device__ __forceinline__ void chunk_scan(f32x16 (&a)[2], f32x16 (&b)[2], int hi, float h0, float& Atot, float& Btot) {
    float GA[8], GB[8], pGA[8], pGB[8], carry[8];
#pragma unroll
    for (int j = 0; j < 8; ++j) { const int mt = j >> 2, q = j & 3;
#pragma unroll
        for (int p = 1; p < 4; ++p) { const int k = REV ? 3 - p : p, kp = REV ? k + 1 : k - 1; const float ak = a[mt][4 * q + k];
            b[mt][4 * q + k] = ak * b[mt][4 * q + kp] + b[mt][4 * q + k]; a[mt][4 * q + k] = ak * a[mt][4 * q + kp]; }
        GA[j] = a[mt][4 * q + (REV ? 0 : 3)]; GB[j] = b[mt][4 * q + (REV ? 0 : 3)]; }
#pragma unroll
    for (int j = 0; j < 8; ++j) { const auto ra = __builtin_amdgcn_permlane32_swap(__float_as_uint(GA[j]), __float_as_uint(GA[j]), false, false); pGA[j] = __uint_as_float(hi ? ra[0] : ra[1]);
        const auto rb = __builtin_amdgcn_permlane32_swap(__float_as_uint(GB[j]), __float_as_uint(GB[j]), false, false); pGB[j] = __uint_as_float(hi ? rb[0] : rb[1]); }
    float c = h0, At = 1.0f; const bool firstMine = REV ? (hi == 1) : (hi == 0);
#pragma unroll
    for (int jj = 0; jj < 8; ++jj) { const int j = REV ? 7 - jj : jj;
        const float A1 = firstMine ? GA[j] : pGA[j], B1 = firstMine ? GB[j] : pGB[j], A2 = firstMine ? pGA[j] : GA[j], B2 = firstMine ? pGB[j] : GB[j];
        const float c1 = A1 * c + B1; carry[j] = firstMine ? c : c1; c = A2 * c1 + B2; At *= GA[j] * pGA[j]; }
    Atot = At; Btot = c;
    if constexpr (FULL) {
#pragma unroll
        for (int j = 0; j < 8; ++j) { const int mt = j >> 2, q = j & 3;
#pragma unroll
            for (int k = 0; k < 4; ++k) b[mt][4 * q + k] = a[mt][4 * q + k] * carry[j] + b[mt][4 * q + k]; }
    }
}
__device__ __forceinline__ void scan_prep_unit(Frame& F, int cid) {
    const int r0 = cid * 64, lane = F.lane, r32 = lane & 31, hi = lane >> 5, n = F.wave; LAS bf16* XD = (LAS bf16*)(F.lds + RING_OFF); float* AGG = (float*)(F.ws + WS_AGG);
    conv_to_lds(F, r0, XD);
    LDS_WAIT(); __syncthreads();
#pragma unroll
    for (int d = 0; d < 2; ++d)
#pragma unroll
        for (int half = 0; half < 2; ++half) { f32x16 a[2], b[2]; lru_gates(F, XD, n, d, half, a, b); float At, Bt;
            if (d == 0) chunk_scan<false, false>(a, b, hi, 0.f, At, Bt); else chunk_scan<true, false>(a, b, hi, 0.f, At, Bt);
            if (hi == 0) { const int ch = 64 * n + 32 * half + r32; AGG[((size_t)(d * NCHUNK + cid) * 2 + 0) * 512 + ch] = At; AGG[((size_t)(d * NCHUNK + cid) * 2 + 1) * 512 + ch] = Bt; } }
    LDS_WAIT(); __syncthreads();
}
__device__ __forceinline__ void scan_fix_unit(Frame& F, int cid) {
    const int b = cid >> 7, j = cid & 127, r0 = cid * 64, lane = F.lane, r32 = lane & 31, hi = lane >> 5, n = F.wave;
    const float* AGG = (const float*)(F.ws + WS_AGG); const bf16* P1 = (const bf16*)(F.ws + WS_P1); bf16* Y = (bf16*)(F.ws + WS_Y);
    LAS bf16* XD = (LAS bf16*)(F.lds + RING_OFF); LAS float* CAR = (LAS float*)(F.lds + RING_OFF + 64 * XDS * 2);
    conv_to_lds(F, r0, XD);
    asm volatile("" ::: "memory"); __builtin_amdgcn_sched_barrier(0);
    { const int ch = F.tid; const float* A0 = AGG + ch; const float* A1 = AGG + (size_t)NCHUNK * 1024 + ch;
      float hf = 0.f, hb = 0.f;
#pragma unroll
      for (int q = 0; q < 4; ++q) { const int c = 256 + 4 * b + q; hf = A0[(size_t)c * 1024] * hf + A0[(size_t)c * 1024 + 512]; }
#pragma unroll 8
      for (int q = 0; q < j; ++q) { const int c = 128 * b + q; hf = A0[(size_t)c * 1024] * hf + A0[(size_t)c * 1024 + 512]; }
#pragma unroll
      for (int q = 3; q >= 0; --q) { const int c = 256 + 4 * b + q; hb = A1[(size_t)c * 1024] * hb + A1[(size_t)c * 1024 + 512]; }
#pragma unroll 8
      for (int q = 127; q > j; --q) { const int c = 128 * b + q; hb = A1[(size_t)c * 1024] * hb + A1[(size_t)c * 1024 + 512]; }
      CAR[ch] = hf; CAR[512 + ch] = hb; }
    LDS_WAIT(); __syncthreads();
#pragma unroll 1
    for (int half = 0; half < 2; ++half) { const int ch = 64 * n + 32 * half + r32; f32x16 a[2], hf[2], hb[2]; float At, Bt;
        lru_gates(F, XD, n, 0, half, a, hf); chunk_scan<false, true>(a, hf, hi, CAR[ch], At, Bt);
        __builtin_amdgcn_sched_barrier(0); lru_gates(F, XD, n, 1, half, a, hb); chunk_scan<true, true>(a, hb, hi, CAR[512 + ch], At, Bt);
        const bf16* gp = P1 + (size_t)r0 * O_IN + 768; bf16* yp = Y + (size_t)r0 * D + 512;
#pragma unroll
        for (int mt = 0; mt < 2; ++mt)
#pragma unroll
            for (int q = 0; q < 4; ++q) {
#pragma unroll
                for (int k = 0; k < 4; ++k) { const unsigned rl = (unsigned)(32 * mt + 8 * q + 4 * hi + k); const float gt = bf2f(gp[rl * (unsigned)O_IN + (unsigned)ch]);
                    yp[rl * (unsigned)D + (unsigned)ch] = f2bf16((hf[mt][4 * q + k] + hb[mt][4 * q + k]) * gelu_tanh(gt)); }
                asm volatile("" ::: "memory"); } }
    LDS_WAIT(); __syncthreads();
}
__device__ __forceinline__ void ph15_router(Frame& F) {
    LAS float* WR = (LAS float*)(F.lds + RING_OFF);
    LAS int* lcnt = (LAS int*)(F.lds + RING_OFF + 32768); LAS int* lbase = lcnt + 8; LAS int* rec = lcnt + 16;
    const int lane = F.lane; const float* MOD = (const float*)(F.ws + WS_MOD) + (size_t)3 * 6 * D; bf16* XN = (bf16*)(F.ws + WS_XN); int* TOK = (int*)(F.ws + WS_TOK);
    for (int i = F.tid; i < 1024 * 8 / 4; i += NWAVES * 64) ((LAS f32x4*)WR)[i] = ((const GAS f32x4*)F.in[I_RW])[i];
    __syncthreads();
    for (int rb = F.vcu; rb < ML / 64; rb += F.G) {
        if (F.tid < 8) lcnt[F.tid] = 0;
        __syncthreads();
#pragma unroll 1
        for (int i = 0; i < 8; ++i) { const int m = rb * 64 + F.wave * 8 + i, s = m >> 13; f32x4 t[4];
            normmod_row(F.out + (size_t)m * D, F.in[I_NFFNG] + D, MOD + s * 6 * D + 4 * D, MOD + s * 6 * D + 3 * D, XN + (size_t)m * D, lane, t);
            float lg[8];
#pragma unroll
            for (int e = 0; e < 8; ++e) lg[e] = 0.f;
#pragma unroll
            for (int j = 0; j < 4; ++j)
#pragma unroll
                for (int k = 0; k < 4; ++k) { const int c = 4 * lane + 256 * j + k; const f32x4 w0 = *(const LAS f32x4*)(WR + c * 8), w1 = *(const LAS f32x4*)(WR + c * 8 + 4); const float tv = t[j][k];
                    lg[0] += tv * w0.x; lg[1] += tv * w0.y; lg[2] += tv * w0.z; lg[3] += tv * w0.w; lg[4] += tv * w1.x; lg[5] += tv * w1.y; lg[6] += tv * w1.z; lg[7] += tv * w1.w; }
#pragma unroll
            for (int e = 0; e < 8; ++e) lg[e] = wave_sum(lg[e]) + F.in[I_RB][e];
            int e1 = 0; float v1 = lg[0];
#pragma unroll
            for (int e = 1; e < 8; ++e) if (lg[e] > v1) { v1 = lg[e]; e1 = e; }
            int e2 = -1; float v2 = -INFINITY;
#pragma unroll
            for (int e = 0; e < 8; ++e) if (e != e1 && lg[e] > v2) { v2 = lg[e]; e2 = e; }
            const float g1 = 1.0f / (1.0f + expf(v2 - v1)), g2 = 1.0f - g1;
            if (lane == 0) { LAS int* rc = rec + (F.wave * 8 + i) * 6; rc[0] = e1; rc[1] = e2; rc[2] = atomicAdd((int*)(lcnt + e1), 1); rc[3] = atomicAdd((int*)(lcnt + e2), 1); rc[4] = __float_as_int(g1); rc[5] = __float_as_int(g2); }
        }
        __syncthreads();
        if (F.tid < 8) lbase[F.tid] = (int)__hip_atomic_fetch_add((unsigned*)(F.ctl + CW_CNT + 64 * F.tid), (unsigned)lcnt[F.tid], __ATOMIC_RELAXED, __HIP_MEMORY_SCOPE_AGENT);
        __syncthreads();
        if (F.tid < 64) { const LAS int* rc = rec + F.tid * 6; int* tk = TOK + (size_t)(rb * 64 + F.tid) * 6;
            tk[0] = rc[0]; tk[1] = rc[1]; tk[2] = lbase[rc[0]] + rc[2]; tk[3] = lbase[rc[1]] + rc[3]; tk[4] = rc[4]; tk[5] = rc[5]; }
        __syncthreads();
    }
}
__device__ __forceinline__ void moe_offsets(Frame& F, int (&off)[9]) {
    int o = 0;
#pragma unroll
    for (int e = 0; e < 8; ++e) { off[e] = o; const int c = (int)__hip_atomic_load((unsigned*)(F.ctl + CW_CNT + 64 * e), __ATOMIC_RELAXED, __HIP_MEMORY_SCOPE_AGENT); o += (c + 255) & ~255; }
    off[8] = o;
}
__device__ __forceinline__ void ph16_gather(Frame& F) {
    int off[9]; moe_offsets(F, off);
    const int gw = F.vcu * NWAVES + F.wave, NGW = F.G * NWAVES, lane = F.lane; const bf16* XN = (const bf16*)(F.ws + WS_XN); unsigned char* XG = F.ws + WS_XG; const int* TOK = (const int*)(F.ws + WS_TOK);
    for (int p = gw; p < 2 * ML; p += NGW) { const int tok = p >> 1, k = p & 1; const int e = TOK[(size_t)tok * 6 + k], pos = TOK[(size_t)tok * 6 + 2 + k];
        int base = 0;
#pragma unroll
        for (int q = 0; q < 8; ++q) base = (e == q) ? off[q] : base;
        const GAS v4u* src = (const GAS v4u*)(XN + (size_t)tok * D + 16 * lane); const v4u a = src[0], b = src[1]; float f[8], g[8]; unpack8(a, f); unpack8(b, g);
        v4u o; o.x = pg8::cvt4_fp8(f[0], f[1], f[2], f[3]); o.y = pg8::cvt4_fp8(f[4], f[5], f[6], f[7]); o.z = pg8::cvt4_fp8(g[0], g[1], g[2], g[3]); o.w = pg8::cvt4_fp8(g[4], g[5], g[6], g[7]);
        *(GAS v4u*)(XG + (size_t)(base + pos) * D + 16 * lane) = o; }
}
__device__ __forceinline__ int moe_tables(Frame& F) {
    int off[9]; moe_offsets(F, off); LAS int* pexp = (LAS int*)(F.lds + PEXP_OFF);
    if (F.tid < MOE_PAN) { const int r = F.tid * 256; int e = 0;
#pragma unroll
        for (int q = 1; q < 8; ++q) e = (r >= off[q]) ? q : e;
        pexp[F.tid] = e; }
    __syncthreads();
    return off[8] / 256;
}
__device__ __forceinline__ void ph19_combine(Frame& F) {
    int off[9]; moe_offsets(F, off);
    const int gw = F.vcu * NWAVES + F.wave, NGW = F.G * NWAVES, lane = F.lane; const bf16* YG = (const bf16*)(F.ws + WS_YG); const int* TOK = (const int*)(F.ws + WS_TOK);
    const float* MOD = (const float*)(F.ws + WS_MOD) + (size_t)3 * 6 * D;
    for (int m = gw; m < ML; m += NGW) { const int* tk = TOK + (size_t)m * 6; const int e1 = tk[0], e2 = tk[1]; int b1 = 0, b2 = 0;
#pragma unroll
        for (int q = 0; q < 8; ++q) { b1 = (e1 == q) ? off[q] : b1; b2 = (e2 == q) ? off[q] : b2; }
        const float g1 = __int_as_float(tk[4]), g2 = __int_as_float(tk[5]); const float* gp = MOD + (m >> 13) * 6 * D + 5 * D;
        const GAS v2u* y1 = (const GAS v2u*)(YG + (size_t)(b1 + tk[2]) * D) + lane; const GAS v2u* y2 = (const GAS v2u*)(YG + (size_t)(b2 + tk[3]) * D) + lane;
        GAS f32x4* o = (GAS f32x4*)(F.out + (size_t)m * D) + lane;
#pragma unroll
        for (int j = 0; j < 4; ++j) { const v2u a = y1[64 * j], b = y2[64 * j]; const f32x4 gv = ((const GAS f32x4*)gp)[lane + 64 * j]; f32x4 x = o[64 * j];
            x.x += gv.x * (g1 * bf_lo(a.x) + g2 * bf_lo(b.x)); x.y += gv.y * (g1 * bf_hi(a.x) + g2 * bf_hi(b.x)); x.z += gv.z * (g1 * bf_lo(a.y) + g2 * bf_lo(b.y)); x.w += gv.w * (g1 * bf_hi(a.y) + g2 * bf_hi(b.y));
            o[64 * j] = x; } }
}
struct Args { const float* in[38]; float* out; unsigned char* ws; int ph_lo, ph_hi; };
__global__ void __launch_bounds__(NWAVES * 64, 2) mk_fwd(Args args) {
    extern __shared__ __attribute__((aligned(16))) unsigned char lds[];
    Frame F;
    F.lds = (LAS unsigned char*)lds;
    F.MISC = (volatile LAS unsigned*)(F.lds + MISC_OFF);
    F.tid = threadIdx.x; F.lane = F.tid & 63; F.wave = __builtin_amdgcn_readfirstlane(F.tid >> 6);
    F.G = gridDim.x; { const int bx = blockIdx.x; F.vcu = (F.G % 8 == 0) ? (bx % 8) * (F.G / 8) + bx / 8 : bx; }
    F.ws = args.ws; F.out = args.out; F.ctl = (gu32*)(args.ws + WS_CTL);
    for (int u = F.tid; u < (LDS_BYTES - LDSCTL_OFF) / 4; u += NWAVES * 64) ((LAS unsigned*)(F.lds + LDSCTL_OFF))[u] = 0u;
    __syncthreads();
    XcdBarrier bar; bar.bar = (unsigned*)(F.ctl + CW_BAR); bar.x = 0; bar.st = nullptr;
    if (MK_ONE_LAUNCH) bar = xcd_barrier_post((unsigned*)(F.ctl + CW_BAR), F.MISC + 8);
#define GRID_BAR() do { if (MK_ONE_LAUNCH) xcd_barrier(bar); } while (0)
    const int lo = args.ph_lo, hi = args.ph_hi;
#define IN(k) (lo <= (k) && (k) < hi)
#define BOTH(k) (IN(k) && IN((k) + 1))
#ifndef MK_REP_MASK
#define MK_REP_MASK 0
#endif
#define REP(k) for (int rep_ = 0; rep_ < (((MK_REP_MASK >> (k)) & 1) ? 2 : 1); ++rep_)
    unsigned char* ws = args.ws;
    bf16* XN = (bf16*)(ws + WS_XN); bf16* Y = (bf16*)(ws + WS_Y); bf16* P0 = (bf16*)(ws + WS_P0); bf16* P1 = (bf16*)(ws + WS_P1); bf16* OA = (bf16*)(ws + WS_OATT); bf16* Hb = (bf16*)(ws + WS_H);
    float* XR = (float*)(ws + WS_XR); const float* MOD = (const float*)(ws + WS_MOD);
    using ABF = attn_body::bf16;

    if (IN(0)) { REP(0) { ph0_prologue(F); __syncthreads(); } if (BOTH(0)) GRID_BAR(); }
    if (IN(1)) { REP(1) ph_normmod(F, F.in[I_X], F.in[I_CTX], MR, F.in[I_NMIXG], 0, 0, D); if (BOTH(1)) GRID_BAR(); }
    if (IN(2)) {
        pg8::Gemm g{XN, (const bf16*)(ws + WS_WE), MR, E_IN, D}; pg8::StaticOrder S; S.init(MR, E_IN, F.G, (int)blockIdx.x);
        pg8::EpiBf16<0> E{P0, E_IN, nullptr, 0, 0, 1.f};
        REP(2) pg8::gemm_phase<pg8::EpiBf16<0>, pg8::StaticOrder, PG8_ALIGN, PG8_SP2>(F.lds + RING_OFF, g, S, E);
        if (BOTH(2)) GRID_BAR();
    }
    if (IN(3)) { ph3_post0(F); if (BOTH(3)) GRID_BAR(); }
    if (IN(4)) {
        const bool nomax0 = qk_bounded(F.in[I_BQNG], F.in[I_BKNG], F.lane);
        const int trslot = F.vcu % 3; bool tr_done = false;
        REP(4) for (int i = 0;; ++i) { const int L = i * F.G + F.vcu; if (L >= 512 + 16) break;
            if (i == trslot && !tr_done) { tr_range(F, TR_DENSE, TR_NITEMS); LDS_WAIT(); __syncthreads(); tr_done = true; }
            const bool lat = L < 512; const int bh = lat ? (L >> 5) : (L - 512), qb = lat ? (L & 31) : 0, b = bh >> 3, hq = bh & 7, h = hq >> 1;
            const size_t qrow0 = lat ? (size_t)b * SEQ + (size_t)qb * 256 : (size_t)(ML + b * CTXL);
            const ABF* Ks = (const ABF*)(ws + WS_KC0) + (size_t)(b * 8 + hq) * KEYS * 64; const ABF* Vs = (const ABF*)(ws + WS_VC0) + (size_t)(b * 8 + 2 * h) * KEYS * 64;
            if (nomax0) attn_body::attn_unit2<-1>((const ABF*)(P0 + qrow0 * E_IN + 1024 + 64 * hq), E_IN, Ks, Vs, Vs + (size_t)KEYS * 64, (ABF*)(OA + qrow0 * D + 128 * hq), D, lat ? 132 : 4, lat ? (F.vcu & 31) * 4 : 0, (char*)lds + RING_OFF);
            else attn_body::attn_unit2<8>((const ABF*)(P0 + qrow0 * E_IN + 1024 + 64 * hq), E_IN, Ks, Vs, Vs + (size_t)KEYS * 64, (ABF*)(OA + qrow0 * D + 128 * hq), D, lat ? 132 : 4, lat ? (F.vcu & 31) * 4 : 0, (char*)lds + RING_OFF); }
        if (!tr_done) { tr_range(F, TR_DENSE, TR_NITEMS); LDS_WAIT(); __syncthreads(); }
        REP(4) for (int c = F.vcu - 32; c >= 0 && c < MR / 128; c += F.G) gmlp_unit(F, c);
        if (BOTH(4)) GRID_BAR();
    }
    if (IN(5)) { REP(5) ph5_diffout(F); if (BOTH(5)) GRID_BAR(); }
    if (IN(6)) {
        pg8::Gemm g{Y, (const bf16*)(ws + WS_WO0), MR, D, D}; pg8::StaticOrder S; S.init(MR, D, F.G, (int)blockIdx.x);
        pg8::EpiResGate E{F.in[I_X], F.in[I_CTX], XR, MOD + 2 * D, 1.0f};
        REP(6) pg8::gemm_phase<pg8::EpiResGate, pg8::StaticOrder, PG8_ALIGN, PG8_SP2>(F.lds + RING_OFF, g, S, E);
        if (BOTH(6)) GRID_BAR();
    }
    if (IN(7)) { REP(7) ph_normmod<true>(F, XR, XR + (size_t)ML * D, MR, F.in[I_NFFNG], 0, 3 * D, 4 * D); if (BOTH(7)) GRID_BAR(); }
    if (IN(8)) {
        pg8::Gemm g{XN, (const bf16*)(ws + WS_WF13), MR, FF2, D / 2}; pg8::StaticOrder S; S.init(MR, FF2, F.G, (int)blockIdx.x);
        pg8::EpiSwiGLUF8 E{(unsigned char*)Hb, FF, FF2 / 256, 1.0f / MOE_S13};
        REP(8) pg8::gemm_phase<pg8::EpiSwiGLUF8, pg8::StaticOrder, PG8_ALIGN, PG8_SP2, true>(F.lds + RING_OFF, g, S, E);
        if (BOTH(8)) GRID_BAR();
    }
    if (IN(9)) {
        pg8::Gemm g{Hb, (const bf16*)(ws + WS_WF2), MR, D, FF / 2}; pg8::StaticOrder S; S.init(MR, D, F.G, (int)blockIdx.x);
        pg8::EpiResGate E{XR, XR + (size_t)ML * D, XR, MOD + 5 * D, 1.0f / MOE_S2};
        REP(9) pg8::gemm_phase<pg8::EpiResGate, pg8::StaticOrder, PG8_ALIGN, PG8_SP2, true>(F.lds + RING_OFF, g, S, E);
        if (BOTH(9)) GRID_BAR();
    }
    if (IN(10)) { REP(10) ph_normmod(F, XR, XR + (size_t)ML * D, MR, F.in[I_NMIXG] + D, 1, 0, D); if (BOTH(10)) GRID_BAR(); }
    if (IN(11)) {
        pg8::Gemm g{XN, (const bf16*)(ws + WS_WOI), MR, O_IN, D}; pg8::StaticOrder S; S.init(MR, O_IN, F.G, (int)blockIdx.x);
        pg8::EpiBf16<0> E{P1, O_IN, nullptr, 0, 0, 1.f};
        REP(11) pg8::gemm_phase<pg8::EpiBf16<0>, pg8::StaticOrder, PG8_ALIGN, PG8_SP2>(F.lds + RING_OFF, g, S, E);
        if (BOTH(11)) GRID_BAR();
    }
    if (IN(12)) {
        ph12_post1(F);
        REP(12) for (int c = F.vcu; c < NCHUNK; c += F.G) scan_prep_unit(F, c);
        if (BOTH(12)) GRID_BAR();
    }
    if (IN(13)) {
        REP(13) for (int c = F.vcu; c < ML / 64; c += F.G) scan_fix_unit(F, c);
        const bool nomax1 = qk_bounded(F.in[I_CQNG], F.in[I_CKNG], F.lane);
        REP(13) for (int i = 0;; ++i) { const int L = i * F.G + F.vcu; if (L >= 512) break;
            const int bh = L >> 5, qb = L & 31, b = bh >> 3, hq = bh & 7, kv = hq >> 2;
            const size_t crow0 = (size_t)(ML + b * CTXL), lrow0 = (size_t)b * SEQ, qrow0 = lrow0 + (size_t)qb * 256;
            const ABF* Ks = (const ABF*)(ws + WS_KC1) + (size_t)(b * 2 + kv) * KEYS * 64; const ABF* Vs = (const ABF*)(ws + WS_VC1) + (size_t)(b * 2 + kv) * KEYS * 64;
            if (nomax1) attn_body::attn_unit<-1, true>((const ABF*)(P1 + qrow0 * O_IN + 64 * hq), O_IN, Ks, Ks + 4 * 4096, 64, Vs, Vs + 4 * 4096, 64, (ABF*)(Y + qrow0 * D + 64 * hq), D, 132, 4, (F.vcu & 31) * 4, (char*)lds + RING_OFF);
            else attn_body::attn_unit<8, true>((const ABF*)(P1 + qrow0 * O_IN + 64 * hq), O_IN, Ks, Ks + 4 * 4096, 64, Vs, Vs + 4 * 4096, 64, (ABF*)(Y + qrow0 * D + 64 * hq), D, 132, 4, (F.vcu & 31) * 4, (char*)lds + RING_OFF); }
        if (BOTH(13)) GRID_BAR();
    }
    if (IN(14)) {
        pg8::Gemm g{Y, (const bf16*)(ws + WS_WO1), ML, D, D}; pg8::StaticOrder S; S.init(ML, D, F.G, (int)blockIdx.x);
        pg8::EpiResGate E{XR, XR, F.out, MOD + 3 * 6 * D + 2 * D, 1.0f};
        REP(14) pg8::gemm_phase<pg8::EpiResGate, pg8::StaticOrder, PG8_ALIGN, PG8_SP2>(F.lds + RING_OFF, g, S, E);
        if (BOTH(14)) GRID_BAR();
    }
    if (IN(15)) { ph15_router(F); if (BOTH(15)) GRID_BAR(); }
    if (IN(16)) { REP(16) ph16_gather(F); if (BOTH(16)) GRID_BAR(); }
    if (IN(17)) {
        const int npan = moe_tables(F);
        pg8::Gemm g{(const bf16*)(ws + WS_XG), (const bf16*)(ws + WS_WM13), MOE_ROWS, NEXP * FF2, D / 2}; pg8::MoeOrder S{npan, FF2 / 256, F.G, F.vcu, (const LAS int*)(F.lds + PEXP_OFF)};
        pg8::EpiSwiGLUF8 E{ws + WS_HG, FF, FF2 / 256, 1.0f / MOE_S13};
        REP(17) pg8::gemm_phase<pg8::EpiSwiGLUF8, pg8::MoeOrder, PG8_ALIGN, PG8_SP2, true>(F.lds + RING_OFF, g, S, E);
        if (BOTH(17)) GRID_BAR();
    }
    if (IN(18)) {
        const int npan = moe_tables(F);
        pg8::Gemm g{(const bf16*)(ws + WS_HG), (const bf16*)(ws + WS_WM2), MOE_ROWS, NEXP * D, FF / 2}; pg8::MoeOrder S{npan, D / 256, F.G, F.vcu, (const LAS int*)(F.lds + PEXP_OFF)};
        pg8::EpiBf16S E{(bf16*)(ws + WS_YG), D, D / 256, 1.0f / MOE_S2};
        REP(18) pg8::gemm_phase<pg8::EpiBf16S, pg8::MoeOrder, PG8_ALIGN, PG8_SP2, true>(F.lds + RING_OFF, g, S, E);
        if (BOTH(18)) GRID_BAR();
    }
    if (IN(19)) { ph19_combine(F); }
#undef IN
#undef BOTH
#undef GRID_BAR
}

extern "C" void kernel_launch(void* const* d_in, const int* in_sizes, int n_in, void* d_out, int out_size, void* d_ws, size_t ws_size, hipStream_t stream) {
    static int grid = 0;
    if (grid == 0) {
        if (n_in != 38 || in_sizes[0] != ML * D || out_size != ML * D || ws_size < WS_END) { fprintf(stderr, "kernel_launch: built for 38 inputs, x/out of %d floats, >= %zu bytes of workspace; got n_in %d, in0 %d, out %d, ws %zu; nothing launched\n", ML * D, (size_t)WS_END, n_in, n_in > 0 ? in_sizes[0] : -1, out_size, ws_size); grid = -1; return; }
        int dev = 0, cus = 0, per_cu = 0;
        if (hipGetDevice(&dev) != hipSuccess || hipDeviceGetAttribute(&cus, hipDeviceAttributeMultiprocessorCount, dev) != hipSuccess) { fprintf(stderr, "kernel_launch: device query failed\n"); grid = -1; return; }
        if (hipFuncSetAttribute((const void*)mk_fwd, hipFuncAttributeMaxDynamicSharedMemorySize, LDS_BYTES) != hipSuccess) { fprintf(stderr, "kernel_launch: hipFuncSetAttribute failed\n"); grid = -1; return; }
        if (hipOccupancyMaxActiveBlocksPerMultiprocessor(&per_cu, (const void*)mk_fwd, NWAVES * 64, LDS_BYTES) != hipSuccess || per_cu < 1) fprintf(stderr, "kernel_launch: note: occupancy query reports %d workgroups per CU\n", per_cu);
        (void)hipGetLastError();
        grid = cus;
    }
    if (grid < 0) return;
    if (hipMemsetAsync((char*)d_ws + WS_CTL, 0, CTL_ZERO_BYTES, stream) != hipSuccess) { fprintf(stderr, "kernel_launch: hipMemsetAsync failed\n"); return; }
    Args a{};
    for (int i = 0; i < 38; ++i) a.in[i] = (const float*)d_in[i];
    a.out = (float*)d_out; a.ws = (unsigned char*)d_ws;
#if MK_ONE_LAUNCH
    a.ph_lo = 0; a.ph_hi = NPH;
    hipLaunchKernelGGL(mk_fwd, dim3(grid), dim3(NWAVES * 64), LDS_BYTES, stream, a);
#else
    for (int ph = 0; ph < NPH; ++ph) { a.ph_lo = ph; a.ph_hi = ph + 1; hipLaunchKernelGGL(mk_fwd, dim3(grid), dim3(NWAVES * 64), LDS_BYTES, stream, a); }
#endif
    const hipError_t le = hipPeekAtLastError();
    if (le != hipSuccess) fprintf(stderr, "kernel_launch: launch failed: %s\n", hipGetErrorName(le));
}
```

```cpp
#include <hip/hip_runtime.h>
#include <cstdio>
#include <cstdint>
#include <cmath>
namespace pg8 {
#define PG8_LAS __attribute__((address_space(3)))
typedef unsigned short bf16_t;
typedef short bf16x8 __attribute__((ext_vector_type(8)));
typedef float f32x4 __attribute__((ext_vector_type(4)));
typedef unsigned u32x4 __attribute__((ext_vector_type(4)));
typedef int i32x4 __attribute__((ext_vector_type(4)));
typedef int i32x8 __attribute__((ext_vector_type(8)));
typedef unsigned u32x2 __attribute__((ext_vector_type(2)));
constexpr int BM = 256, BK = 64, HALF = 128, HTB = HALF * BK * 2  , STAGE_BYTES = 8 * HTB, NXCD = 8, WGM = 8;

__host__ __device__ __forceinline__ int lds_byte(int r, int c) { const int st = (r >> 4) * 2 + (c >> 5), rr = r & 15, cc = c & 31, ob = rr * 64 + cc * 2; return st * 1024 + (ob ^ (((ob >> 9) & 1) << 5)); }
__host__ __device__ __forceinline__ void stage_rc(int b, int& R, int& C) { const int st = b / 1024, sb = b % 1024, swz = sb ^ (((sb >> 9) & 1) << 5); R = (st >> 1) * 16 + swz / 64; C = (st & 1) * 32 + (swz % 64) / 2; }
__host__ __device__ __forceinline__ int perm32(int rho) { const int n = rho >> 4, i = rho & 15; return 8 * (i >> 2) + 4 * n + (i & 3); }

struct Unit { int pm, pn; };
struct Gemm { const bf16_t* A; const bf16_t* Bt; int M, N, K; };

struct StaticOrder {
    int nM, nN, nwg, G, c;
    __host__ __device__ void init(int M, int N, int G_, int c_) { nM = M / BM; nN = N / BM; nwg = nM * nN; G = G_; c = c_; }
    __host__ __device__ bool next(int i, Unit& u) const {
        const long L = (long)i * G + c; if (L >= nwg) return false;
        int wgid = (int)L; { const int q = nwg / NXCD, r = nwg % NXCD, xcd = wgid % NXCD, off = wgid / NXCD; wgid = (xcd < r ? xcd * (q + 1) : r * (q + 1) + (xcd - r) * q) + off; }
        const int nig = WGM * nN, gid = wgid / nig, fm = gid * WGM, gsz = (nM - fm) < WGM ? (nM - fm) : WGM;
        u.pm = fm + ((wgid % nig) % gsz); u.pn = (wgid % nig) / gsz; return true;
    }
    __device__ __forceinline__ void a_ready(const Unit&) const {}
    __device__ __forceinline__ void done(const Unit&) const {}
};

__device__ __forceinline__ unsigned cvt_pk_bf16(float lo, float hi) { unsigned r; asm volatile("v_cvt_pk_bf16_f32 %0, %1, %2" : "=v"(r) : "v"(lo), "v"(hi)); return r; }
typedef float f32x2 __attribute__((ext_vector_type(2)));
__device__ __forceinline__ f32x2 gelu_pk(f32x2 v) {
    const f32x2 av = __builtin_elementwise_abs(v), d = av * 0.2316418882f + 1.0f;
    f32x2 t; t.x = __builtin_amdgcn_rcpf(d.x); t.y = __builtin_amdgcn_rcpf(d.y);
    f32x2 q = t * 0.5307027145f + (-0.7265760135f); q = q * t + 0.7107068705f; q = q * t + (-0.142248368f); q = q * t + 0.127414796f; q = q * t;
    const f32x2 s = (v * v) * (-0.72134752044f);
    f32x2 e; e.x = __builtin_amdgcn_exp2f(s.x); e.y = __builtin_amdgcn_exp2f(s.y);
    const f32x2 m = v * (q * e), r = v - m;
    f32x2 o; o.x = v.x < 0.f ? m.x : r.x; o.y = v.y < 0.f ? m.y : r.y; return o;
}

template <int ACT  > struct EpiBf16 {
    static constexpr bool PERM = true, AFTER_DRAIN = false; static_assert(ACT == 0 || ACT == 1, "EpiBf16: ACT is 0 (none) or 1 (gelu_pk)");
    bf16_t* O; int ldc; const float* bias; int split_cols; size_t split_stride; float scale0;
    __device__ __forceinline__ void operator()(const f32x4 (&acc)[2][2][4][2], const Unit& u, int wr, int wc, int fr, int fq) const {
        const int row0 = u.pm * BM + wr * 64 + fr; int colt = u.pn * BM; bf16_t* base = O;
        float sc = 1.f; if (split_cols) { const int t = colt / split_cols; base += (size_t)t * split_stride; colt -= t * split_cols; if (t == 0) sc = scale0; }
        const int col0 = colt + wc * 32 + 8 * fq, bcol0 = u.pn * BM + wc * 32 + 8 * fq;
        f32x4 bv[2][2];
#pragma unroll
        for (int bj = 0; bj < 2; ++bj)
#pragma unroll
            for (int n = 0; n < 2; ++n) bv[bj][n] = bias ? *(const f32x4*)(bias + bcol0 + bj * HALF + 4 * n) : (f32x4){0.f, 0.f, 0.f, 0.f};
#pragma unroll
        for (int ai = 0; ai < 2; ++ai)
#pragma unroll
            for (int m = 0; m < 4; ++m) { bf16_t* rowp = base + (size_t)(row0 + ai * HALF + m * 16) * ldc + col0;
#pragma unroll
                for (int bj = 0; bj < 2; ++bj) { f32x4 v0 = acc[ai][bj][m][0] + bv[bj][0], v1 = acc[ai][bj][m][1] + bv[bj][1];
                    if (ACT == 1) { f32x2 a = gelu_pk((f32x2){v0[0], v0[1]}), b = gelu_pk((f32x2){v0[2], v0[3]}), c = gelu_pk((f32x2){v1[0], v1[1]}), d = gelu_pk((f32x2){v1[2], v1[3]});
                        v0 = (f32x4){a.x, a.y, b.x, b.y}; v1 = (f32x4){c.x, c.y, d.x, d.y}; }
                    v0 = v0 * sc; v1 = v1 * sc; u32x4 w; w.x = cvt_pk_bf16(v0[0], v0[1]); w.y = cvt_pk_bf16(v0[2], v0[3]); w.z = cvt_pk_bf16(v1[0], v1[1]); w.w = cvt_pk_bf16(v1[2], v1[3]);
                    *(u32x4*)(rowp + bj * HALF) = w; } }
    }
};
struct EpiResGate {
    static constexpr bool PERM = false, AFTER_DRAIN = false;
    const float* baseL; const float* baseC; float* out; const float* gate; float ascale;
    __device__ __forceinline__ void operator()(const f32x4 (&acc)[2][2][4][2], const Unit& u, int wr, int wc, int fr, int fq) const {
        const int s = u.pm < 32 ? 0 : (u.pm < 64 ? 1 : 2);
        const float* gp = gate + s * 6144;
        const float* base = u.pm < 64 ? baseL + (size_t)u.pm * BM * 1024 : baseC + (size_t)(u.pm - 64) * BM * 1024;
        float* o = out + (size_t)u.pm * BM * 1024;
        const int col0 = u.pn * BM + wc * 32 + 4 * fq;
        f32x4 gv[2][2];
#pragma unroll
        for (int bj = 0; bj < 2; ++bj)
#pragma unroll
            for (int n = 0; n < 2; ++n) gv[bj][n] = *(const f32x4*)(gp + col0 + bj * HALF + n * 16) * ascale;
#pragma unroll
        for (int ai = 0; ai < 2; ++ai)
#pragma unroll
            for (int m = 0; m < 4; ++m) { const size_t off = (size_t)(ai * HALF + wr * 64 + m * 16 + fr) * 1024 + col0;
#pragma unroll
                for (int bj = 0; bj < 2; ++bj)
#pragma unroll
                    for (int n = 0; n < 2; ++n) { const f32x4 bs = *(const f32x4*)(base + off + bj * HALF + n * 16); *(f32x4*)(o + off + bj * HALF + n * 16) = bs + gv[bj][n] * acc[ai][bj][m][n]; }
                if (m & 1) asm volatile("" ::: "memory"); }
    }
};
struct EpiSwiGLU {
    static constexpr bool PERM = true, AFTER_DRAIN = false;
    bf16_t* H; int ldh; int ntl;
    __device__ __forceinline__ void operator()(const f32x4 (&acc)[2][2][4][2], const Unit& u, int wr, int wc, int fr, int fq) const {
        const int row0 = u.pm * BM + wr * 64 + fr; const int ct = u.pn % ntl; const int col0 = ct * HALF + wc * 32 + 8 * fq;
#pragma unroll
        for (int ai = 0; ai < 2; ++ai)
#pragma unroll
            for (int m = 0; m < 4; ++m) { bf16_t* rowp = H + (size_t)(row0 + ai * HALF + m * 16) * ldh + col0;
                float hv[8];
#pragma unroll
                for (int n = 0; n < 2; ++n)
#pragma unroll
                    for (int j = 0; j < 4; ++j) { const float a = acc[ai][0][m][n][j], b = acc[ai][1][m][n][j];
                        const float e = __builtin_amdgcn_exp2f(a * -1.4426950408889634f); hv[n * 4 + j] = a * __builtin_amdgcn_rcpf(1.0f + e) * b; }
                u32x4 w; w.x = cvt_pk_bf16(hv[0], hv[1]); w.y = cvt_pk_bf16(hv[2], hv[3]); w.z = cvt_pk_bf16(hv[4], hv[5]); w.w = cvt_pk_bf16(hv[6], hv[7]);
                *(u32x4*)rowp = w; }
    }
};
__device__ __forceinline__ unsigned cvt4_fp8(float a, float b, float c, float d) { unsigned w = 0u; w = (unsigned)__builtin_amdgcn_cvt_pk_fp8_f32(a, b, (int)w, false); w = (unsigned)__builtin_amdgcn_cvt_pk_fp8_f32(c, d, (int)w, true); return w; }
struct EpiSwiGLUF8 {
    static constexpr bool PERM = true, AFTER_DRAIN = false;
    unsigned char* H; int ldh; int ntl; float s;
    __device__ __forceinline__ void operator()(const f32x4 (&acc)[2][2][4][2], const Unit& u, int wr, int wc, int fr, int fq) const {
        const int row0 = u.pm * BM + wr * 64 + fr; const int ct = u.pn % ntl; const int col0 = ct * HALF + wc * 32 + 8 * fq;
#pragma unroll
        for (int ai = 0; ai < 2; ++ai)
#pragma unroll
            for (int m = 0; m < 4; ++m) { unsigned char* rowp = H + (size_t)(row0 + ai * HALF + m * 16) * ldh + col0;
                float hv[8];
#pragma unroll
                for (int n = 0; n < 2; ++n)
#pragma unroll
                    for (int j = 0; j < 4; ++j) { const float a = acc[ai][0][m][n][j] * s, b = acc[ai][1][m][n][j] * s;
                        const float e = __builtin_amdgcn_exp2f(a * -1.4426950408889634f); hv[n * 4 + j] = a * __builtin_amdgcn_rcpf(1.0f + e) * b; }
                u32x2 w; w.x = cvt4_fp8(hv[0], hv[1], hv[2], hv[3]); w.y = cvt4_fp8(hv[4], hv[5], hv[6], hv[7]);
                *(u32x2*)rowp = w; }
    }
};
struct EpiBf16S {
    static constexpr bool PERM = true, AFTER_DRAIN = false;
    bf16_t* O; int ldc; int ntl; float s;
    __device__ __forceinline__ void operator()(const f32x4 (&acc)[2][2][4][2], const Unit& u, int wr, int wc, int fr, int fq) const {
        const int row0 = u.pm * BM + wr * 64 + fr; const int col0 = (u.pn % ntl) * BM + wc * 32 + 8 * fq;
#pragma unroll
        for (int ai = 0; ai < 2; ++ai)
#pragma unroll
            for (int m = 0; m < 4; ++m) { bf16_t* rowp = O + (size_t)(row0 + ai * HALF + m * 16) * ldc + col0;
#pragma unroll
                for (int bj = 0; bj < 2; ++bj) { const f32x4 v0 = acc[ai][bj][m][0] * s, v1 = acc[ai][bj][m][1] * s;
                    u32x4 w; w.x = cvt_pk_bf16(v0[0], v0[1]); w.y = cvt_pk_bf16(v0[2], v0[3]); w.z = cvt_pk_bf16(v1[0], v1[1]); w.w = cvt_pk_bf16(v1[2], v1[3]);
                    *(u32x4*)(rowp + bj * HALF) = w; } }
    }
};
struct MoeOrder {
    int npan, ntl, G, c; const PG8_LAS int* pexp;
    __device__ __forceinline__ bool next(int i, Unit& u) const {
        const long L = (long)i * G + c; if (L >= (long)npan * ntl) return false;
        const int pm = (int)(L / ntl), j = (int)(L % ntl); u.pm = pm; u.pn = __builtin_amdgcn_readfirstlane(pexp[pm]) * ntl + j; return true;
    }
    __device__ __forceinline__ void a_ready(const Unit&) const {}
    __device__ __forceinline__ void done(const Unit&) const {}
};
template <class Epi, class Sched, bool ALIGN_EPI = false, bool SP2 = false, bool FP8 = false>
__device__ __forceinline__ void gemm_phase(PG8_LAS unsigned char* lds, const Gemm g, const Sched& S, const Epi& E) {
    const int tid = threadIdx.x, wid = __builtin_amdgcn_readfirstlane(tid >> 6), lane = tid & 63, wr = wid >> 2, wc = wid & 3, fr = lane & 15, fq = lane >> 4;
    const int K = g.K, nt = K / BK;
    unsigned voffA[2], voffB[2];
#pragma unroll
    for (int i = 0; i < 2; ++i) { int R, C; stage_rc(tid * 16 + i * 8192, R, C); const int Rb = Epi::PERM ? ((R & ~31) + perm32(R & 31)) : R;
        voffA[i] = (unsigned)(R * K + C) * 2u; voffB[i] = (unsigned)(Rb * K + C) * 2u; }
    const size_t kstep = (size_t)(BK * 2);
    const size_t hstep = (size_t)HALF * K * 2;
    const size_t tstep = 2 * hstep;
    const unsigned ldsw = (unsigned)wid * 1024u;
    const int aoff = lds_byte(wr * 64 + fr, fq * 8), boff = lds_byte(wc * 32 + fr, fq * 8);
#define PG8_SA(b, h) (((b) * 2 + (h)) * HTB)
#define PG8_SB(b, h) ((4 + (b) * 2 + (h)) * HTB)
#define PG8_STAGE(bufoff, gbase, voff) do { _Pragma("unroll") for (int _i = 0; _i < 2; ++_i) \
        __builtin_amdgcn_global_load_lds((const unsigned*)((const char*)(gbase) + (voff)[_i]), (PG8_LAS unsigned*)(lds + (bufoff) + ldsw + _i * 8192), 16, 0, 0); } while (0)
#define PG8_CAT(x, y) __builtin_shufflevector(__builtin_bit_cast(i32x4, x), __builtin_bit_cast(i32x4, y), 0, 1, 2, 3, 4, 5, 6, 7)
#define PG8_LDA(dst, b, h) do { if constexpr (FP8) { _Pragma("unroll") for (int m = 0; m < 4; ++m) dst##8[m] = PG8_CAT(*(const PG8_LAS bf16x8*)(lds + PG8_SA(b, h) + aoff + m * 2048), *(const PG8_LAS bf16x8*)(lds + PG8_SA(b, h) + aoff + m * 2048 + 1024)); } else { \
        _Pragma("unroll") for (int m = 0; m < 4; ++m) _Pragma("unroll") for (int k = 0; k < 2; ++k) dst[m][k] = *(const PG8_LAS bf16x8*)(lds + PG8_SA(b, h) + aoff + m * 2048 + k * 1024); } } while (0)
#define PG8_LDB(dst, b, h) do { if constexpr (FP8) { _Pragma("unroll") for (int n = 0; n < 2; ++n) dst##8[n] = PG8_CAT(*(const PG8_LAS bf16x8*)(lds + PG8_SB(b, h) + boff + n * 2048), *(const PG8_LAS bf16x8*)(lds + PG8_SB(b, h) + boff + n * 2048 + 1024)); } else { \
        _Pragma("unroll") for (int n = 0; n < 2; ++n) _Pragma("unroll") for (int k = 0; k < 2; ++k) dst[n][k] = *(const PG8_LAS bf16x8*)(lds + PG8_SB(b, h) + boff + n * 2048 + k * 1024); } } while (0)
#define PG8_MMA(ai, bj, At, Bt) do { __builtin_amdgcn_s_setprio(1); if constexpr (FP8) { _Pragma("unroll") for (int m = 0; m < 4; ++m) _Pragma("unroll") for (int n = 0; n < 2; ++n) \
        asm volatile("v_mfma_f32_16x16x128_f8f6f4 %0, %1, %2, %0" : "+v"(acc[ai][bj][m][n]) : "v"(Bt##8[n]), "v"(At##8[m]));   } else { \
        _Pragma("unroll") for (int m = 0; m < 4; ++m) _Pragma("unroll") for (int n = 0; n < 2; ++n) _Pragma("unroll") for (int k = 0; k < 2; ++k) \
        acc[ai][bj][m][n] = __builtin_amdgcn_mfma_f32_16x16x32_bf16(Bt[n][k], At[m][k], acc[ai][bj][m][n], 0, 0, 0); } __builtin_amdgcn_s_setprio(0); } while (0)
#define PG8_WAIT_V(n) asm volatile("s_waitcnt vmcnt(" #n ")" ::: "memory")
#define PG8_WAIT_L(n) asm volatile("s_waitcnt lgkmcnt(" #n ")" ::: "memory")
#define PG8_BAR __builtin_amdgcn_s_barrier()
#define PG8_SCHED __builtin_amdgcn_sched_barrier(0)
    Unit cur, nxt; int ui = 0;
    if (!S.next(0, cur)) return;
    f32x4 acc[2][2][4][2];
#pragma unroll
    for (int a = 0; a < 2; ++a)
#pragma unroll
        for (int b = 0; b < 2; ++b)
#pragma unroll
            for (int m = 0; m < 4; ++m)
#pragma unroll
                for (int n = 0; n < 2; ++n) acc[a][b][m][n] = (f32x4){0.f, 0.f, 0.f, 0.f};
    bf16x8 At[4][2], B0[2][2], B1[2][2]; i32x8 At8[4], B08[2], B18[2];
    const char* cA = (const char*)g.A + (size_t)cur.pm * tstep; const char* cB = (const char*)g.Bt + (size_t)cur.pn * tstep;
    S.a_ready(cur);
    if constexpr (SP2) {
        PG8_STAGE(PG8_SB(0, 0), cB, voffB); PG8_STAGE(PG8_SB(0, 1), cB + hstep, voffB); PG8_STAGE(PG8_SA(0, 0), cA, voffA); PG8_STAGE(PG8_SA(0, 1), cA + hstep, voffA);
        if (wr == 1) PG8_BAR;
        PG8_WAIT_V(2); PG8_BAR;
        PG8_STAGE(PG8_SB(1, 0), cB + kstep, voffB); PG8_STAGE(PG8_SA(1, 0), cA + kstep, voffA); PG8_STAGE(PG8_SB(1, 1), cB + hstep + kstep, voffB);
        PG8_WAIT_V(6); PG8_BAR;
    } else {
        PG8_STAGE(PG8_SB(0, 0), cB, voffB); PG8_STAGE(PG8_SA(0, 0), cA, voffA); PG8_STAGE(PG8_SB(0, 1), cB + hstep, voffB); PG8_STAGE(PG8_SA(0, 1), cA + hstep, voffA);
        if (wr == 1) PG8_BAR;
        PG8_WAIT_V(4); PG8_BAR;
        PG8_STAGE(PG8_SB(1, 0), cB + kstep, voffB); PG8_STAGE(PG8_SA(1, 0), cA + kstep, voffA); PG8_STAGE(PG8_SB(1, 1), cB + hstep + kstep, voffB);
        PG8_WAIT_V(6); PG8_BAR;
    }
    for (;;) {
        const bool has_next = S.next(ui + 1, nxt);
        const char* nA = has_next ? (const char*)g.A + (size_t)nxt.pm * tstep : cA; const char* nB = has_next ? (const char*)g.Bt + (size_t)nxt.pn * tstep : cB;
#pragma unroll 1
        for (int t = 0; t < nt; t += 2) {
            const bool last = (t == nt - 2);
            const char* a1 = cA + (size_t)(t + 1) * kstep;
            const char* a2 = last ? nA : cA + (size_t)(t + 2) * kstep; const char* b2 = last ? nB : cB + (size_t)(t + 2) * kstep;
            const char* a3 = a2 + kstep; const char* b3 = b2 + kstep;
            if (last && has_next) S.a_ready(nxt);
            if constexpr (SP2) {
            PG8_LDB(B0, 0, 0); PG8_LDB(B1, 0, 1); PG8_SCHED; PG8_LDA(At, 0, 0); PG8_STAGE(PG8_SA(1, 1), a1 + hstep, voffA);
            PG8_WAIT_V(8); PG8_WAIT_L(0); PG8_BAR; PG8_MMA(0, 0, At, B0); PG8_MMA(0, 1, At, B1); PG8_BAR; PG8_SCHED;
            PG8_LDA(At, 0, 1); PG8_STAGE(PG8_SB(0, 0), b2, voffB); PG8_STAGE(PG8_SB(0, 1), b2 + hstep, voffB); PG8_STAGE(PG8_SA(0, 0), a2, voffA);
            PG8_WAIT_V(8); PG8_WAIT_L(0); PG8_BAR; PG8_MMA(1, 0, At, B0); PG8_MMA(1, 1, At, B1); PG8_BAR; PG8_SCHED;
            PG8_LDB(B0, 1, 0); PG8_LDB(B1, 1, 1); PG8_SCHED; PG8_LDA(At, 1, 0); PG8_STAGE(PG8_SA(0, 1), a2 + hstep, voffA);
            PG8_WAIT_V(8); PG8_WAIT_L(0); PG8_BAR; PG8_MMA(0, 0, At, B0); PG8_MMA(0, 1, At, B1); PG8_BAR; PG8_SCHED;
            PG8_LDA(At, 1, 1); PG8_STAGE(PG8_SB(1, 0), b3, voffB); PG8_STAGE(PG8_SB(1, 1), b3 + hstep, voffB); PG8_STAGE(PG8_SA(1, 0), a3, voffA);
            PG8_WAIT_V(8); PG8_WAIT_L(0); PG8_BAR; PG8_MMA(1, 0, At, B0); PG8_MMA(1, 1, At, B1); PG8_BAR; PG8_SCHED;
            } else {
            PG8_LDB(B0, 0, 0); PG8_SCHED; PG8_LDA(At, 0, 0); PG8_STAGE(PG8_SA(1, 1), a1 + hstep, voffA);
            PG8_WAIT_L(8); PG8_BAR; PG8_WAIT_L(0); PG8_MMA(0, 0, At, B0); PG8_BAR; PG8_SCHED;
            PG8_LDB(B1, 0, 1); PG8_STAGE(PG8_SB(0, 0), b2, voffB);
            PG8_BAR; PG8_WAIT_L(0); PG8_MMA(0, 1, At, B1); PG8_BAR;
            PG8_LDA(At, 0, 1); PG8_STAGE(PG8_SA(0, 0), a2, voffA);
            PG8_BAR; PG8_WAIT_L(0); PG8_MMA(1, 0, At, B0); PG8_BAR; PG8_SCHED;
            PG8_STAGE(PG8_SB(0, 1), b2 + hstep, voffB);
            PG8_WAIT_V(6); PG8_BAR; PG8_MMA(1, 1, At, B1); PG8_BAR;
            PG8_LDB(B0, 1, 0); PG8_SCHED; PG8_LDA(At, 1, 0); PG8_STAGE(PG8_SA(0, 1), a2 + hstep, voffA);
            PG8_WAIT_L(8); PG8_BAR; PG8_WAIT_L(0); PG8_MMA(0, 0, At, B0); PG8_BAR; PG8_SCHED;
            PG8_LDB(B1, 1, 1); PG8_STAGE(PG8_SB(1, 0), b3, voffB);
            PG8_BAR; PG8_WAIT_L(0); PG8_MMA(0, 1, At, B1); PG8_BAR;
            PG8_LDA(At, 1, 1); PG8_STAGE(PG8_SA(1, 0), a3, voffA);
            PG8_BAR; PG8_WAIT_L(0); PG8_MMA(1, 0, At, B0); PG8_BAR; PG8_SCHED;
            PG8_STAGE(PG8_SB(1, 1), b3 + hstep, voffB);
            PG8_WAIT_V(6); PG8_BAR; PG8_MMA(1, 1, At, B1); PG8_BAR;
            }
        }
        if constexpr (FP8) asm volatile("s_nop 15\n\ts_nop 15" ::: "memory");
        if constexpr (ALIGN_EPI) { if (wr == 0) PG8_BAR; }
        if constexpr (!Epi::AFTER_DRAIN) { E(acc, cur, wr, wc, fr, fq); S.done(cur); }
        if (!has_next) break;
#pragma unroll
        for (int a = 0; a < 2; ++a)
#pragma unroll
            for (int b = 0; b < 2; ++b)
#pragma unroll
                for (int m = 0; m < 4; ++m)
#pragma unroll
                    for (int n = 0; n < 2; ++n) acc[a][b][m][n] = (f32x4){0.f, 0.f, 0.f, 0.f};
        cur = nxt; cA = nA; cB = nB; ++ui;
        if constexpr (ALIGN_EPI) { if (wr == 1) PG8_BAR; }
    }
    PG8_WAIT_V(0);
    if constexpr (!ALIGN_EPI) { if (wr == 0) PG8_BAR; }
    PG8_BAR;
    if constexpr (Epi::AFTER_DRAIN) { E.fused(acc, cur, wr, wc, fr, fq, lds, wid, lane); S.done(cur); }
#undef PG8_SA
#undef PG8_SB
#undef PG8_STAGE
#undef PG8_LDA
#undef PG8_LDB
#undef PG8_MMA
#undef PG8_CAT
#undef PG8_WAIT_V
#undef PG8_WAIT_L
#undef PG8_BAR
#undef PG8_SCHED
}
}

#ifndef PG8_SP2
#define PG8_SP2 true
#endif
#ifndef PG8_ALIGN
#define PG8_ALIGN true
#endif
#include <hip/hip_bf16.h>
#include <cmath>
namespace attn_body {
using bf16=__hip_bfloat16;
using bf16x8=__attribute__((ext_vector_type(8)))short;
using s16x4=__attribute__((ext_vector_type(4)))short;
using f32x16=__attribute__((ext_vector_type(16)))float;
using u32x4=__attribute__((ext_vector_type(4)))unsigned;
constexpr int D=64;
constexpr int NW=8,QBLK=32,QB=QBLK*NW,KVBLK=64;
constexpr int ATTN_UNIT_ROWS=QB;
__device__ __forceinline__ int crow(int r,int hi){return (r&3)+8*(r>>2)+4*hi;}
#define SBAR() __builtin_amdgcn_sched_barrier(0)
__device__ __forceinline__ void cmask(f32x16&p0,f32x16&p1,int jb,int qrel,int hi){
  const float NEG=-INFINITY; int kb=64*jb+4*hi;
  #pragma unroll
  for(int r=0;r<16;++r){int kv=kb+(r&3)+8*(r>>2); if(kv>qrel)p0[r]=NEG; if(kv+32>qrel)p1[r]=NEG;}
}

constexpr int NSLOT=3, SLOTB=8192;
constexpr int LDS_K=0, LDS_V=NSLOT*SLOTB, LDS_WS=2*NSLOT*SLOTB, LDS_OST=LDS_WS+NW*64*4, LDS_BYTES=LDS_OST+NW*4096;
constexpr float C2=0.125f*1.4426950408889634f;
__device__ __forceinline__ void glds16s(const void*sbase,unsigned voff,unsigned lds_dst){unsigned keep;
  asm volatile("s_mov_b32 %0, m0\n\ts_mov_b32 m0, %3\n\ts_nop 0\n\tglobal_load_lds_dwordx4 %1, %2\n\ts_mov_b32 m0, %0":"=&s"(keep):"v"(voff),"s"(sbase),"s"(lds_dst):"memory");}
__device__ __forceinline__ void glds16(const void*gsrc,unsigned lds_dst){unsigned keep;
  asm volatile("s_mov_b32 %0, m0\n\ts_mov_b32 m0, %2\n\ts_nop 0\n\tglobal_load_lds_dwordx4 %1, off\n\ts_mov_b32 m0, %0":"=&s"(keep):"v"(gsrc),"s"(lds_dst):"memory");}
__device__ __forceinline__ float max3f(float a,float b,float c){float r;asm("v_max3_f32 %0, %1, %2, %3":"=v"(r):"v"(a),"v"(b),"v"(c));return r;}
__device__ __forceinline__ float max2f(float a,float b){float r;asm("v_max_f32_e32 %0, %1, %2":"=v"(r):"v"(a),"v"(b));return r;}
__device__ __forceinline__ float fadd_s(float a,float b){float r;asm("v_add_f32_e32 %0, %1, %2":"=v"(r):"v"(a),"v"(b));return r;}
__device__ __forceinline__ float fsub_s(float a,float b){float r;asm("v_sub_f32_e32 %0, %1, %2":"=v"(r):"v"(a),"v"(b));return r;}
typedef float f32x2_t __attribute__((ext_vector_type(2))); typedef __bf16 bf16x2_t __attribute__((ext_vector_type(2)));
__device__ __forceinline__ unsigned cvtpk_s(float lo,float hi){f32x2_t v={lo,hi};bf16x2_t b=__builtin_convertvector(v,bf16x2_t);return __builtin_bit_cast(unsigned,b);}
#define WAIT_BAR(N) asm volatile("s_waitcnt vmcnt(" #N ") lgkmcnt(0)\n\ts_barrier":::"memory")

__device__ __forceinline__ void qkt(f32x16&p0,f32x16&p1,const char*Kslot,const bf16x8*qr,const f32x16&negm,int r32,int hi){
  const char*kb=Kslot+hi*1024+r32*16;
  #pragma unroll
  for(int d0=0;d0<4;++d0){
    const bf16x8 b0=*reinterpret_cast<const bf16x8*>(kb+d0*2048);
    const bf16x8 b1=*reinterpret_cast<const bf16x8*>(kb+d0*2048+512);
    if(d0==0){p0=__builtin_amdgcn_mfma_f32_32x32x16_bf16(b0,qr[0],negm,0,0,0);p1=__builtin_amdgcn_mfma_f32_32x32x16_bf16(b1,qr[0],negm,0,0,0);}
    else{p0=__builtin_amdgcn_mfma_f32_32x32x16_bf16(b0,qr[d0],p0,0,0,0);p1=__builtin_amdgcn_mfma_f32_32x32x16_bf16(b1,qr[d0],p1,0,0,0);}}
}
typedef __attribute__((address_space(3))) const char* lds_cptr;
typedef short v4i16_t __attribute__((ext_vector_type(4)));
__device__ __forceinline__ void kload8(bf16x8*kf,lds_cptr kp){
  kf[0]=*(const __attribute__((address_space(3))) bf16x8*)(kp);      kf[1]=*(const __attribute__((address_space(3))) bf16x8*)(kp+512);
  kf[2]=*(const __attribute__((address_space(3))) bf16x8*)(kp+2048); kf[3]=*(const __attribute__((address_space(3))) bf16x8*)(kp+2560);
  kf[4]=*(const __attribute__((address_space(3))) bf16x8*)(kp+4096); kf[5]=*(const __attribute__((address_space(3))) bf16x8*)(kp+4608);
  kf[6]=*(const __attribute__((address_space(3))) bf16x8*)(kp+6144); kf[7]=*(const __attribute__((address_space(3))) bf16x8*)(kp+6656);
}
__device__ __forceinline__ void kload2(bf16x8*kf,lds_cptr kp,int j){ kf[2*j]=*(const __attribute__((address_space(3))) bf16x8*)(kp+j*2048); kf[2*j+1]=*(const __attribute__((address_space(3))) bf16x8*)(kp+j*2048+512); }
__device__ __forceinline__ s16x4 vtr(lds_cptr p){ return __builtin_bit_cast(s16x4,__builtin_amdgcn_ds_read_tr16_b64_v4i16((__attribute__((address_space(3))) v4i16_t*)p)); }
__device__ __forceinline__ float rowmax(const f32x16&p0,const f32x16&p1){
  float a=max3f(p0[0],p0[1],p1[0]),b=max3f(p0[2],p0[3],p1[1]);a=max3f(a,p1[2],p1[3]);
  #pragma unroll
  for(int r=4;r<16;r+=4){a=max3f(a,p0[r],p0[r+1]);b=max3f(b,p0[r+2],p0[r+3]);a=max3f(a,p1[r],p1[r+1]);b=max3f(b,p1[r+2],p1[r+3]);}
  const float m=max2f(a,b);
  auto rr=__builtin_amdgcn_permlane32_swap(__float_as_uint(m),__float_as_uint(m),false,false);
  return max2f(__uint_as_float(rr[0]),__uint_as_float(rr[1]));
}
__device__ __forceinline__ void pv(f32x16*o,int vb,bf16x8 pa0,bf16x8 pa1,bf16x8 pa2,bf16x8 pa3){
  #pragma unroll
  for(int d0=0;d0<2;++d0){s16x4 lo[4],hi[4];
    #pragma unroll
    for(int ks=0;ks<4;++ks){
      asm volatile("ds_read_b64_tr_b16 %0,%1 offset:%c2":"=&v"(lo[ks]):"v"(vb),"i"(d0*4096+ks*1024):"memory");
      asm volatile("ds_read_b64_tr_b16 %0,%1 offset:%c2":"=&v"(hi[ks]):"v"(vb),"i"(d0*4096+ks*1024+512):"memory");}
    asm volatile("s_waitcnt lgkmcnt(0)":::"memory");SBAR();
    #define PK(k) (bf16x8){lo[k][0],lo[k][1],lo[k][2],lo[k][3],hi[k][0],hi[k][1],hi[k][2],hi[k][3]}
    o[d0]=__builtin_amdgcn_mfma_f32_32x32x16_bf16(pa0,PK(0),o[d0],0,0,0);
    o[d0]=__builtin_amdgcn_mfma_f32_32x32x16_bf16(pa1,PK(1),o[d0],0,0,0);
    o[d0]=__builtin_amdgcn_mfma_f32_32x32x16_bf16(pa2,PK(2),o[d0],0,0,0);
    o[d0]=__builtin_amdgcn_mfma_f32_32x32x16_bf16(pa3,PK(3),o[d0],0,0,0);
    #undef PK
  }
}

#ifndef ATTN_STORE16
#define ATTN_STORE16(p,v) (*(u32x4*)(p)=(v))
#endif
template<int THRL,bool TILED> __device__ __forceinline__ void attn_unit(const bf16*Qu,int qp,const bf16*__restrict__ Kc,const bf16*__restrict__ Kl,int kp,const bf16*__restrict__ Vc,const bf16*__restrict__ Vl,int vp,bf16*Ou,int op,int NT,int NCT,int rot,char*shm){
  const int tid=threadIdx.x,lane=tid&63,r32=lane&31,hi=lane>>5; const int wid=__builtin_amdgcn_readfirstlane(tid>>6);
  const bf16*Qw=Qu+(long)(wid*QBLK)*qp;
  const unsigned lds0=(unsigned)(uintptr_t)shm;
  float*wsf=(float*)(shm+LDS_WS)+wid*64;
  const long koff=TILED?(long)(wid*512+lane*8):((long)lane*kp+wid*8); const bf16*ksrc_c=Kc+koff; const bf16*ksrc_l=Kl+koff-(long)NCT*KVBLK*kp;
  const long voff=TILED?(long)(wid*512+lane*8):((long)(16*(wid&3)+(lane>>2))*vp+(wid>>2)*32+(lane&3)*8); const bf16*vsrc_c=Vc+voff; const bf16*vsrc_l=Vl+voff-(long)NCT*KVBLK*vp;
  const unsigned kdst=lds0+LDS_K+wid*1024, vdst=lds0+LDS_V+wid*1024;
  #define ROTT(t) (((t)+rot>=NT)?((t)+rot-NT):((t)+rot))
  const unsigned koffb1=(unsigned)(wid*512+lane*8)*2u;
  #define DMA_K(t,slot) do{ if constexpr(TILED) glds16s(Kc+(long)ROTT(t)*4096,koffb1,(unsigned)__builtin_amdgcn_readfirstlane(kdst+(slot))); else glds16((ROTT(t)<NCT?ksrc_c:ksrc_l)+(long)ROTT(t)*KVBLK*kp,(unsigned)__builtin_amdgcn_readfirstlane(kdst+(slot))); }while(0)
  #define DMA_V(t,slot) do{ if constexpr(TILED) glds16s(Vc+(long)ROTT(t)*4096,koffb1,(unsigned)__builtin_amdgcn_readfirstlane(vdst+(slot))); else glds16((ROTT(t)<NCT?vsrc_c:vsrc_l)+(long)ROTT(t)*KVBLK*vp,(unsigned)__builtin_amdgcn_readfirstlane(vdst+(slot))); }while(0)
  const int vb0=(int)(lds0+LDS_V)+((lane>>4)&1)*32+(lane&3)*8+(4*hi+((lane&15)>>2))*64;
  const char*Kbase=shm+LDS_K; bf16x8 kf[8];
  const lds_cptr shm3=(lds_cptr)shm; const lds_cptr kp0=shm3+LDS_K+hi*1024+r32*16; const lds_cptr vp0=shm3+LDS_V+((lane>>4)&1)*32+(lane&3)*8+(4*hi+((lane&15)>>2))*64;
  DMA_K(0,0);DMA_V(0,0);DMA_K(1,SLOTB);
  bf16x8 qr[4];
  #pragma unroll
  for(int d0=0;d0<4;++d0)qr[d0]=*reinterpret_cast<const bf16x8*>(&Qw[(long)r32*qp+d0*16+hi*8]);
  float mhat=0.f,l_reg=0.f;f32x16 o[2];o[0]=f32x16{};o[1]=f32x16{};f32x16 negm=f32x16{};if constexpr(THRL>=0)asm volatile("":"+v"(negm));
  #define CMASK(P0,P1,t) do{}while(0)
  bool resc=false;
  #define START(P0,P1) do{ resc=false; if constexpr(THRL>=0) \
    { const float rm=rowmax(P0,P1); const float dl=rm; mhat=fadd_s(mhat,dl); \
      _Pragma("unroll") for(int r=0;r<16;++r){P0[r]=fsub_s(P0[r],dl);P1[r]=fsub_s(P1[r],dl);} \
      _Pragma("unroll") for(int r=0;r<16;++r)negm[r]=-mhat; asm volatile("":"+v"(negm)); } \
    _Pragma("unroll") for(int r=0;r<16;++r)P0[r]=__builtin_amdgcn_exp2f(P0[r]); }while(0)
  #define RESC() do{ if constexpr(THRL>=0) if(resc){ asm volatile("s_waitcnt lgkmcnt(0)":::"memory"); \
      _Pragma("unroll") for(int d_=0;d_<2;++d_) _Pragma("unroll") for(int r=0;r<16;++r)o[d_][r]*=wsf[crow(r,hi)]; } }while(0)
  f32x16 pA0,pA1,pB0,pB1;
  int sl_prev=0,sl_cur=0,sl_next=SLOTB;
  #define ROT() do{sl_prev=sl_cur;sl_cur=sl_next;sl_next=(sl_next==(NSLOT-1)*SLOTB)?0:sl_next+SLOTB;}while(0)
  DMA_K(2,2*SLOTB);
  WAIT_BAR(3);
  qkt(pA0,pA1,Kbase,qr,negm,r32,hi);asm volatile("s_nop 15\n\ts_nop 7":"+v"(pA0),"+v"(pA1));CMASK(pA0,pA1,0);
  START(pA0,pA1);
  _Pragma("unroll") for(int r=0;r<16;++r)pA1[r]=__builtin_amdgcn_exp2f(pA1[r]);
  WAIT_BAR(0);
  DMA_K(3,0);DMA_V(1,SLOTB);
  ROT();
  kload8(kf,kp0+sl_cur);
  WAIT_BAR(2);
  s16x4 vlo[8],vhi[8]; u32x4 pw0,pw1,pw2,pw3;
  #define PKW(P,B) cvtpk_s(P[B],P[B+1])
  #define PAF(k) __builtin_bit_cast(bf16x8,pw##k)
  #define VFR(i) (bf16x8){vlo[i][0],vlo[i][1],vlo[i][2],vlo[i][3],vhi[i][0],vhi[i][1],vhi[i][2],vhi[i][3]}
  #define PIN(x) asm volatile("":"+v"(x))
  #define MX3(a,b,c) __builtin_fmaxf(__builtin_fmaxf((a),(b)),(c))
  #define GAPA(MF,A0,A1,A2,A3,W0,W1,PW) do{ MF; sacc+=A0; sacc+=A1; sacc+=A2; sacc+=A3; PIN(sacc); W0; W1; PIN(PW); SBAR(); }while(0)
  #define EX(v) __builtin_amdgcn_exp2f(v)
  #define GAPB(MF,X,B) do{ MF; X[B]=EX(X[B]); X[B+1]=EX(X[B+1]); X[B+2]=EX(X[B+2]); X[B+3]=EX(X[B+3]); PIN(X); SBAR(); }while(0)
  #define VRD(i) do{ vlo[i]=vtr(vp_+(((i)>>2)*4096+((i)&3)*1024)); vhi[i]=vtr(vp_+(((i)>>2)*4096+((i)&3)*1024+512)); }while(0)
  #define KRD(G,j) do{ if(G){ kload2(kf,kp0+sl_next,j); SBAR(); } }while(0)
  #define STEP(C0,C1,P0,P1,t,GK,GV,GL) do{ SBAR(); \
    const lds_cptr vp_=vp0+sl_prev; \
    VRD(0); SBAR(); float sacc=(P0[0]+P0[1]); \
    GAPA(C0=__builtin_amdgcn_mfma_f32_32x32x16_bf16(kf[0],qr[0],negm,0,0,0), P0[2],P0[3],P0[4],P0[5],     pw0[0]=PKW(P0,0), pw0[1]=PKW(P0,2), pw0); \
    VRD(4); SBAR(); GAPA(C1=__builtin_amdgcn_mfma_f32_32x32x16_bf16(kf[1],qr[0],negm,0,0,0), P0[6],P0[7],P0[8],P0[9],     pw0[2]=PKW(P0,4), pw0[3]=PKW(P0,6), pw0); \
    VRD(1); SBAR(); GAPA(C0=__builtin_amdgcn_mfma_f32_32x32x16_bf16(kf[2],qr[1],C0,0,0,0),   P0[10],P0[11],P0[12],P0[13], pw1[0]=PKW(P0,8), pw1[1]=PKW(P0,10), pw1); \
    VRD(5); SBAR(); GAPA(C1=__builtin_amdgcn_mfma_f32_32x32x16_bf16(kf[3],qr[1],C1,0,0,0),   P0[14],P0[15],P1[0],P1[1],   pw1[2]=PKW(P0,12),pw1[3]=PKW(P0,14), pw1); \
    VRD(2); SBAR(); GAPA(C0=__builtin_amdgcn_mfma_f32_32x32x16_bf16(kf[4],qr[2],C0,0,0,0),   P1[2],P1[3],P1[4],P1[5],     pw2[0]=PKW(P1,0), pw2[1]=PKW(P1,2), pw2); \
    VRD(6); SBAR(); GAPA(C1=__builtin_amdgcn_mfma_f32_32x32x16_bf16(kf[5],qr[2],C1,0,0,0),   P1[6],P1[7],P1[8],P1[9],     pw2[2]=PKW(P1,4), pw2[3]=PKW(P1,6), pw2); \
    VRD(3); SBAR(); GAPA(C0=__builtin_amdgcn_mfma_f32_32x32x16_bf16(kf[6],qr[3],C0,0,0,0),   P1[10],P1[11],P1[12],P1[13], pw3[0]=PKW(P1,8), pw3[1]=PKW(P1,10), pw3); \
    VRD(7); SBAR(); GAPA(C1=__builtin_amdgcn_mfma_f32_32x32x16_bf16(kf[7],qr[3],C1,0,0,0),   P1[14],P1[15],0.f,0.f,       pw3[2]=PKW(P1,12),pw3[3]=PKW(P1,14), pw3); \
    l_reg+=sacc; \
    if(GK){DMA_K((t)+3,sl_cur);} if(GV){DMA_V((t)+1,sl_next);} \
    CMASK(C0,C1,t); \
    if constexpr(THRL>=0){ float a=MX3(C0[0],C0[1],C1[0]),b=MX3(C0[2],C0[3],C1[1]); a=MX3(a,C1[2],C1[3]); \
      _Pragma("unroll") for(int r=4;r<16;r+=4){a=MX3(a,C0[r],C0[r+1]);b=MX3(b,C0[r+2],C0[r+3]);a=MX3(a,C1[r],C1[r+1]);b=MX3(b,C1[r+2],C1[r+3]);} \
      float rm=__builtin_fmaxf(a,b); { auto rr=__builtin_amdgcn_permlane32_swap(__float_as_uint(rm),__float_as_uint(rm),false,false); rm=__builtin_fmaxf(__uint_as_float(rr[0]),__uint_as_float(rr[1])); } \
      resc=false; \
      if(__builtin_expect(__any(rm>(float)THRL),0)){ const float dl=__builtin_fmaxf(rm,0.f); mhat+=dl; \
        _Pragma("unroll") for(int r=0;r<16;++r){C0[r]-=dl;C1[r]-=dl;} \
        _Pragma("unroll") for(int r=0;r<16;++r)negm[r]=-mhat; asm volatile("":"+v"(negm)); \
        const float f=__builtin_amdgcn_exp2f(-dl); l_reg*=f; if(hi==0)wsf[r32]=f; resc=true; } } \
    SBAR(); \
    GAPB(o[0]=__builtin_amdgcn_mfma_f32_32x32x16_bf16(PAF(0),VFR(0),o[0],0,0,0), C0,0); \
    GAPB(o[1]=__builtin_amdgcn_mfma_f32_32x32x16_bf16(PAF(0),VFR(4),o[1],0,0,0), C0,4); \
    KRD(GL,0); GAPB(o[0]=__builtin_amdgcn_mfma_f32_32x32x16_bf16(PAF(1),VFR(1),o[0],0,0,0), C0,8); \
    KRD(GL,1); GAPB(o[1]=__builtin_amdgcn_mfma_f32_32x32x16_bf16(PAF(1),VFR(5),o[1],0,0,0), C0,12); \
    KRD(GL,2); GAPB(o[0]=__builtin_amdgcn_mfma_f32_32x32x16_bf16(PAF(2),VFR(2),o[0],0,0,0), C1,0); \
    KRD(GL,3); GAPB(o[1]=__builtin_amdgcn_mfma_f32_32x32x16_bf16(PAF(2),VFR(6),o[1],0,0,0), C1,4); \
    GAPB(o[0]=__builtin_amdgcn_mfma_f32_32x32x16_bf16(PAF(3),VFR(3),o[0],0,0,0), C1,8); \
    GAPB(o[1]=__builtin_amdgcn_mfma_f32_32x32x16_bf16(PAF(3),VFR(7),o[1],0,0,0), C1,12); \
    }while(0)
  int t=1;
  #undef CMASK
  #define CMASK(P0,P1,t) do{}while(0)
  for(;t+5<NT;t+=2){
    STEP(pB0,pB1,pA0,pA1,t,true,true,true);     WAIT_BAR(2); RESC(); ROT();
    STEP(pA0,pA1,pB0,pB1,t+1,true,true,true);   WAIT_BAR(2); RESC(); ROT();
  }
  #undef CMASK
  #define CMASK(P0,P1,t) do{}while(0)
  #define ENDW(tt) do{ if((tt)+3<NT){WAIT_BAR(2);} else if((tt)+2<NT){WAIT_BAR(1);} else {WAIT_BAR(0);} }while(0)
  for(;t+1<NT;t+=2){
    STEP(pB0,pB1,pA0,pA1,t,(t+3<NT),(t+1<NT),(t+1<NT));       ENDW(t);   RESC(); ROT();
    STEP(pA0,pA1,pB0,pB1,t+1,(t+4<NT),(t+2<NT),(t+2<NT));     ENDW(t+1); RESC(); ROT();
  }
  STEP(pB0,pB1,pA0,pA1,NT-1,false,false,false); RESC();
  { float sacc=pB0[0]+pB0[1]; _Pragma("unroll") for(int r=2;r<16;++r)sacc+=pB0[r]; _Pragma("unroll") for(int r=0;r<16;++r)sacc+=pB1[r]; l_reg+=sacc;
    pw0=(u32x4){PKW(pB0,0),PKW(pB0,2),PKW(pB0,4),PKW(pB0,6)};pw1=(u32x4){PKW(pB0,8),PKW(pB0,10),PKW(pB0,12),PKW(pB0,14)};pw2=(u32x4){PKW(pB1,0),PKW(pB1,2),PKW(pB1,4),PKW(pB1,6)};pw3=(u32x4){PKW(pB1,8),PKW(pB1,10),PKW(pB1,12),PKW(pB1,14)};
    SBAR(); pv(o,vb0+sl_cur,PAF(0),PAF(1),PAF(2),PAF(3)); }
  #undef PKW
  #undef PAF
  #undef VFR
  #undef PIN
  #undef MX3
  #undef GAPA
  #undef GAPB
  #undef EX
  #undef VRD
  #undef KRD
  #undef STEP
  #undef ENDW
  {auto rr=__builtin_amdgcn_permlane32_swap(__float_as_uint(l_reg),__float_as_uint(l_reg),false,false);l_reg=__uint_as_float(rr[0])+__uint_as_float(rr[1]);}
  if(hi==0)wsf[32+r32]=l_reg;asm volatile("s_waitcnt lgkmcnt(0)":::"memory");
  float rli[16];
  #pragma unroll
  for(int r=0;r<16;++r)rli[r]=__builtin_amdgcn_rcpf(wsf[32+crow(r,hi)]);
  bf16*Ow=Ou+(long)(wid*QBLK)*op;
  { bf16*stg=(bf16*)(shm+LDS_OST)+wid*2048;
    #pragma unroll
    for(int r=0;r<16;++r){const int orow=crow(r,hi);
      #pragma unroll
      for(int d0=0;d0<2;++d0)stg[orow*64+d0*32+r32]=__float2bfloat16(o[d0][r]*rli[r]);}
    asm volatile("s_waitcnt lgkmcnt(0)":::"memory");
    #pragma unroll
    for(int i=0;i<4;++i){const int row=i*8+(lane>>3),ch=lane&7; const u32x4 v=*(const u32x4*)(stg+row*64+ch*8); ATTN_STORE16(Ow+(long)row*op+ch*8,v);} }
  asm volatile("s_waitcnt lgkmcnt(0)\n\ts_barrier":::"memory");
  #undef DMA_K
  #undef ROTT
  #undef DMA_V
  #undef CMASK
  #undef START
  #undef RESC
  #undef ROT
}
constexpr int LDS2_V=NSLOT*SLOTB, LDS2_WS=LDS2_V+NSLOT*2*SLOTB, LDS2_OST=LDS2_WS+NW*64*4, LDS2_BYTES=LDS2_OST+NW*4096;
template<int THRL> __device__ __forceinline__ void attn_unit2(const bf16*Qu,int qp,const bf16*__restrict__ Ks,const bf16*__restrict__ Va,const bf16*__restrict__ Vb,bf16*Ou,int op,int NT,int rot,char*shm,bool FUSE,const bf16*O1,int o1p,float lam,const float*subg,float oscale){
  const int tid=threadIdx.x,lane=tid&63,r32=lane&31,hi=lane>>5; const int wid=__builtin_amdgcn_readfirstlane(tid>>6);
  const bf16*Qw=Qu+(long)(wid*QBLK)*qp;
  const unsigned lds0=(unsigned)(uintptr_t)shm;
  float*wsf=(float*)(shm+LDS2_WS)+wid*64;
  const unsigned koffb=(unsigned)(wid*512+lane*8)*2u;
  const unsigned kdst=lds0+LDS_K+wid*1024, vdst=lds0+LDS2_V+wid*1024;
  #define ROTT(t) (((t)+rot>=NT)?((t)+rot-NT):((t)+rot))
  #define DMA_K(t,slot) glds16s(Ks+(long)ROTT(t)*4096,koffb,(unsigned)__builtin_amdgcn_readfirstlane(kdst+(slot)))
  #define DMA_V(t,slot) do{ glds16s(Va+(long)ROTT(t)*4096,koffb,(unsigned)__builtin_amdgcn_readfirstlane(vdst+2*(slot))); glds16s(Vb+(long)ROTT(t)*4096,koffb,(unsigned)__builtin_amdgcn_readfirstlane(vdst+2*(slot)+8192)); }while(0)
  const int vb0=(int)(lds0+LDS2_V)+((lane>>4)&1)*32+(lane&3)*8+(4*hi+((lane&15)>>2))*64;
  const char*Kbase=shm+LDS_K; bf16x8 kf[8];
  const lds_cptr shm3=(lds_cptr)shm; const lds_cptr kp0=shm3+LDS_K+hi*1024+r32*16; const lds_cptr vp0=shm3+LDS2_V+((lane>>4)&1)*32+(lane&3)*8+(4*hi+((lane&15)>>2))*64;
  DMA_K(0,0);DMA_V(0,0);DMA_K(1,SLOTB);
  bf16x8 qr[4];
  #pragma unroll
  for(int d0=0;d0<4;++d0)qr[d0]=*reinterpret_cast<const bf16x8*>(&Qw[(long)r32*qp+d0*16+hi*8]);
  float mhat=0.f,l_reg=0.f;f32x16 o[4];o[0]=f32x16{};o[1]=f32x16{};o[2]=f32x16{};o[3]=f32x16{};const f32x16 zero16=f32x16{};
  #define CMASK(P0,P1,t) do{}while(0)
  bool resc=false;
  #define SUBM(x) (THRL>=0?(x)-mhat:(x))
  #define START(P0,P1) do{ resc=false; if constexpr(THRL>=0){ mhat=rowmax(P0,P1); } \
    _Pragma("unroll") for(int r=0;r<16;++r)P0[r]=__builtin_amdgcn_exp2f(SUBM(P0[r])); }while(0)
  #define RESC() do{ if constexpr(THRL>=0) if(resc){ asm volatile("s_waitcnt lgkmcnt(0)":::"memory"); \
      _Pragma("unroll") for(int d_=0;d_<4;++d_) _Pragma("unroll") for(int r=0;r<16;++r)o[d_][r]*=wsf[crow(r,hi)]; } }while(0)
  f32x16 pA0,pA1,pB0,pB1;
  int sl_prev=0,sl_cur=0,sl_next=SLOTB;
  #define ROT() do{sl_prev=sl_cur;sl_cur=sl_next;sl_next=(sl_next==(NSLOT-1)*SLOTB)?0:sl_next+SLOTB;}while(0)
  DMA_K(2,2*SLOTB);
  WAIT_BAR(4);
  qkt(pA0,pA1,Kbase,qr,zero16,r32,hi);asm volatile("s_nop 15\n\ts_nop 7":"+v"(pA0),"+v"(pA1));CMASK(pA0,pA1,0);
  START(pA0,pA1);
  _Pragma("unroll") for(int r=0;r<16;++r)pA1[r]=__builtin_amdgcn_exp2f(SUBM(pA1[r]));
  WAIT_BAR(0);
  DMA_K(3,0);DMA_V(1,SLOTB);
  ROT();
  kload8(kf,kp0+sl_cur);
  WAIT_BAR(3);
  s16x4 vlo[8],vhi[8]; u32x4 pw0,pw1,pw2,pw3;
  #define PKW(P,B) cvtpk_s(P[B],P[B+1])
  #define PAF(k) __builtin_bit_cast(bf16x8,pw##k)
  #define VFR(i) (bf16x8){vlo[i][0],vlo[i][1],vlo[i][2],vlo[i][3],vhi[i][0],vhi[i][1],vhi[i][2],vhi[i][3]}
  #define PIN(x) asm volatile("":"+v"(x))
  #define MX3(a,b,c) __builtin_fmaxf(__builtin_fmaxf((a),(b)),(c))
  #define GAPA(MF,A0,A1,A2,A3,W0,W1,PW) do{ MF; sacc+=A0; sacc+=A1; sacc+=A2; sacc+=A3; PIN(sacc); W0; W1; PIN(PW); SBAR(); }while(0)
  #define EX(v) __builtin_amdgcn_exp2f(v)
  #define GAPB(MF,X,B) do{ MF; X[B]=EX(SUBM(X[B])); X[B+1]=EX(SUBM(X[B+1])); PIN(X); SBAR(); }while(0)
  #define VRD(i) do{ vlo[i]=vtr(vp_+(((i)>>2)*4096+((i)&3)*1024)); vhi[i]=vtr(vp_+(((i)>>2)*4096+((i)&3)*1024+512)); }while(0)
  #define VRD2(i) do{ vlo[i]=vtr(vp_+(8192+((i)>>2)*4096+((i)&3)*1024)); vhi[i]=vtr(vp_+(8192+((i)>>2)*4096+((i)&3)*1024+512)); SBAR(); }while(0)
  #define KRD(G,j) do{ if(G){ kload2(kf,kp0+sl_next,j); SBAR(); } }while(0)
  #define STEP(C0,C1,P0,P1,t,GK,GV,GL) do{ SBAR(); \
    const lds_cptr vp_=vp0+2*sl_prev; \
    VRD(0); SBAR(); float sacc=(P0[0]+P0[1]); \
    GAPA(C0=__builtin_amdgcn_mfma_f32_32x32x16_bf16(kf[0],qr[0],zero16,0,0,0), P0[2],P0[3],P0[4],P0[5],     pw0[0]=PKW(P0,0), pw0[1]=PKW(P0,2), pw0); \
    VRD(4); SBAR(); GAPA(C1=__builtin_amdgcn_mfma_f32_32x32x16_bf16(kf[1],qr[0],zero16,0,0,0), P0[6],P0[7],P0[8],P0[9],     pw0[2]=PKW(P0,4), pw0[3]=PKW(P0,6), pw0); \
    VRD(1); SBAR(); GAPA(C0=__builtin_amdgcn_mfma_f32_32x32x16_bf16(kf[2],qr[1],C0,0,0,0),   P0[10],P0[11],P0[12],P0[13], pw1[0]=PKW(P0,8), pw1[1]=PKW(P0,10), pw1); \
    VRD(5); SBAR(); GAPA(C1=__builtin_amdgcn_mfma_f32_32x32x16_bf16(kf[3],qr[1],C1,0,0,0),   P0[14],P0[15],P1[0],P1[1],   pw1[2]=PKW(P0,12),pw1[3]=PKW(P0,14), pw1); \
    VRD(2); SBAR(); GAPA(C0=__builtin_amdgcn_mfma_f32_32x32x16_bf16(kf[4],qr[2],C0,0,0,0),   P1[2],P1[3],P1[4],P1[5],     pw2[0]=PKW(P1,0), pw2[1]=PKW(P1,2), pw2); \
    VRD(6); SBAR(); GAPA(C1=__builtin_amdgcn_mfma_f32_32x32x16_bf16(kf[5],qr[2],C1,0,0,0),   P1[6],P1[7],P1[8],P1[9],     pw2[2]=PKW(P1,4), pw2[3]=PKW(P1,6), pw2); \
    VRD(3); SBAR(); GAPA(C0=__builtin_amdgcn_mfma_f32_32x32x16_bf16(kf[6],qr[3],C0,0,0,0),   P1[10],P1[11],P1[12],P1[13], pw3[0]=PKW(P1,8), pw3[1]=PKW(P1,10), pw3); \
    VRD(7); SBAR(); GAPA(C1=__builtin_amdgcn_mfma_f32_32x32x16_bf16(kf[7],qr[3],C1,0,0,0),   P1[14],P1[15],0.f,0.f,       pw3[2]=PKW(P1,12),pw3[3]=PKW(P1,14), pw3); \
    l_reg+=sacc; \
    if(GK){DMA_K((t)+3,sl_cur);} if(GV){DMA_V((t)+1,sl_next);} \
    CMASK(C0,C1,t); \
    if constexpr(THRL>=0){ float a=MX3(C0[0],C0[1],C1[0]),b=MX3(C0[2],C0[3],C1[1]); a=MX3(a,C1[2],C1[3]); \
      _Pragma("unroll") for(int r=4;r<16;r+=4){a=MX3(a,C0[r],C0[r+1]);b=MX3(b,C0[r+2],C0[r+3]);a=MX3(a,C1[r],C1[r+1]);b=MX3(b,C1[r+2],C1[r+3]);} \
      float rm=__builtin_fmaxf(a,b); { auto rr=__builtin_amdgcn_permlane32_swap(__float_as_uint(rm),__float_as_uint(rm),false,false); rm=__builtin_fmaxf(__uint_as_float(rr[0]),__uint_as_float(rr[1])); } \
      resc=false; \
      rm-=mhat; \
      if(__builtin_expect(__any(rm>(float)THRL),0)){ const float dl=__builtin_fmaxf(rm,0.f); mhat+=dl; \
        const float f=__builtin_amdgcn_exp2f(-dl); l_reg*=f; if(hi==0)wsf[r32]=f; resc=true; } } \
    SBAR(); \
    GAPB(o[0]=__builtin_amdgcn_mfma_f32_32x32x16_bf16(PAF(0),VFR(0),o[0],0,0,0), C0,0); VRD2(0); \
    GAPB(o[1]=__builtin_amdgcn_mfma_f32_32x32x16_bf16(PAF(0),VFR(4),o[1],0,0,0), C0,2); VRD2(4); \
    KRD(GL,0); GAPB(o[0]=__builtin_amdgcn_mfma_f32_32x32x16_bf16(PAF(1),VFR(1),o[0],0,0,0), C0,4); VRD2(1); \
    KRD(GL,1); GAPB(o[1]=__builtin_amdgcn_mfma_f32_32x32x16_bf16(PAF(1),VFR(5),o[1],0,0,0), C0,6); VRD2(5); \
    KRD(GL,2); GAPB(o[0]=__builtin_amdgcn_mfma_f32_32x32x16_bf16(PAF(2),VFR(2),o[0],0,0,0), C0,8); VRD2(2); \
    KRD(GL,3); GAPB(o[1]=__builtin_amdgcn_mfma_f32_32x32x16_bf16(PAF(2),VFR(6),o[1],0,0,0), C0,10); VRD2(6); \
    GAPB(o[0]=__builtin_amdgcn_mfma_f32_32x32x16_bf16(PAF(3),VFR(3),o[0],0,0,0), C0,12); VRD2(3); \
    GAPB(o[1]=__builtin_amdgcn_mfma_f32_32x32x16_bf16(PAF(3),VFR(7),o[1],0,0,0), C0,14); VRD2(7); \
    GAPB(o[2]=__builtin_amdgcn_mfma_f32_32x32x16_bf16(PAF(0),VFR(0),o[2],0,0,0), C1,0); \
    GAPB(o[3]=__builtin_amdgcn_mfma_f32_32x32x16_bf16(PAF(0),VFR(4),o[3],0,0,0), C1,2); \
    GAPB(o[2]=__builtin_amdgcn_mfma_f32_32x32x16_bf16(PAF(1),VFR(1),o[2],0,0,0), C1,4); \
    GAPB(o[3]=__builtin_amdgcn_mfma_f32_32x32x16_bf16(PAF(1),VFR(5),o[3],0,0,0), C1,6); \
    GAPB(o[2]=__builtin_amdgcn_mfma_f32_32x32x16_bf16(PAF(2),VFR(2),o[2],0,0,0), C1,8); \
    GAPB(o[3]=__builtin_amdgcn_mfma_f32_32x32x16_bf16(PAF(2),VFR(6),o[3],0,0,0), C1,10); \
    GAPB(o[2]=__builtin_amdgcn_mfma_f32_32x32x16_bf16(PAF(3),VFR(3),o[2],0,0,0), C1,12); \
    GAPB(o[3]=__builtin_amdgcn_mfma_f32_32x32x16_bf16(PAF(3),VFR(7),o[3],0,0,0), C1,14); \
    }while(0)
  int t=1;
  #undef CMASK
  #define CMASK(P0,P1,t) do{}while(0)
  for(;t+5<NT;t+=2){
    STEP(pB0,pB1,pA0,pA1,t,true,true,true);     WAIT_BAR(3); RESC(); ROT();
    STEP(pA0,pA1,pB0,pB1,t+1,true,true,true);   WAIT_BAR(3); RESC(); ROT();
  }
  #undef CMASK
  #define CMASK(P0,P1,t) do{}while(0)
  #define ENDW(tt) do{ if((tt)+3<NT){WAIT_BAR(3);} else if((tt)+2<NT){WAIT_BAR(2);} else {WAIT_BAR(0);} }while(0)
  for(;t+1<NT;t+=2){
    STEP(pB0,pB1,pA0,pA1,t,(t+3<NT),(t+1<NT),(t+1<NT));       ENDW(t);   RESC(); ROT();
    STEP(pA0,pA1,pB0,pB1,t+1,(t+4<NT),(t+2<NT),(t+2<NT));     ENDW(t+1); RESC(); ROT();
  }
  STEP(pB0,pB1,pA0,pA1,NT-1,false,false,false); RESC();
  { float sacc=pB0[0]+pB0[1]; _Pragma("unroll") for(int r=2;r<16;++r)sacc+=pB0[r]; _Pragma("unroll") for(int r=0;r<16;++r)sacc+=pB1[r]; l_reg+=sacc;
    pw0=(u32x4){PKW(pB0,0),PKW(pB0,2),PKW(pB0,4),PKW(pB0,6)};pw1=(u32x4){PKW(pB0,8),PKW(pB0,10),PKW(pB0,12),PKW(pB0,14)};pw2=(u32x4){PKW(pB1,0),PKW(pB1,2),PKW(pB1,4),PKW(pB1,6)};pw3=(u32x4){PKW(pB1,8),PKW(pB1,10),PKW(pB1,12),PKW(pB1,14)};
    SBAR(); pv(o,vb0+2*sl_cur,PAF(0),PAF(1),PAF(2),PAF(3)); pv(o+2,vb0+2*sl_cur+8192,PAF(0),PAF(1),PAF(2),PAF(3)); }
  #undef PKW
  #undef PAF
  #undef VFR
  #undef PIN
  #undef MX3
  #undef GAPA
  #undef GAPB
  #undef EX
  #undef VRD
  #undef VRD2
  #undef KRD
  #undef STEP
  #undef ENDW
  {auto rr=__builtin_amdgcn_permlane32_swap(__float_as_uint(l_reg),__float_as_uint(l_reg),false,false);l_reg=__uint_as_float(rr[0])+__uint_as_float(rr[1]);}
  if(hi==0)wsf[32+r32]=l_reg;asm volatile("s_waitcnt lgkmcnt(0)":::"memory");
  float rli[16];
  #pragma unroll
  for(int r=0;r<16;++r)rli[r]=__builtin_amdgcn_rcpf(wsf[32+crow(r,hi)]);
  bf16*Ow=Ou+(long)(wid*QBLK)*op;
  { bf16*stg=(bf16*)(shm+LDS2_OST)+wid*2048;
    int lane_e=lane; asm volatile("":"+v"(lane_e));
    if(!FUSE){
    #pragma unroll
    for(int hh=0;hh<2;++hh){
      #pragma unroll
      for(int r=0;r<16;++r){const int orow=crow(r,hi);
        #pragma unroll
        for(int d0=0;d0<2;++d0)stg[orow*64+d0*32+r32]=__float2bfloat16(o[2*hh+d0][r]*rli[r]);}
      asm volatile("s_waitcnt lgkmcnt(0)":::"memory");
      #pragma unroll
      for(int i=0;i<4;++i){const int row=i*8+(lane_e>>3),ch=lane_e&7; const u32x4 v=*(const u32x4*)(stg+row*64+ch*8); ATTN_STORE16(Ow+(long)row*op+hh*64+ch*8,v);}
      asm volatile("s_waitcnt lgkmcnt(0)":::"memory"); }
    } else {
    const bf16*O1w=O1+(long)(wid*QBLK)*o1p; float dd[2][4][8]; float ssq[4]={0.f,0.f,0.f,0.f};
    #pragma unroll
    for(int hh=0;hh<2;++hh){
      #pragma unroll
      for(int r=0;r<16;++r){const int orow=crow(r,hi);
        #pragma unroll
        for(int d0=0;d0<2;++d0)stg[orow*64+d0*32+r32]=__float2bfloat16(o[2*hh+d0][r]*rli[r]);}
      asm volatile("s_waitcnt lgkmcnt(0)":::"memory");
      #pragma unroll
      for(int i=0;i<4;++i){const int row=i*8+(lane_e>>3),ch=lane_e&7; const u32x4 v2=*(const u32x4*)(stg+row*64+ch*8); const u32x4 v1=*(const u32x4*)(O1w+(long)row*o1p+hh*64+ch*8);
        #pragma unroll
        for(int e=0;e<4;++e){ const float a0=__uint_as_float(v1[e]<<16),a1=__uint_as_float(v1[e]&0xffff0000u),b0=__uint_as_float(v2[e]<<16),b1=__uint_as_float(v2[e]&0xffff0000u);
          const float x0=a0-lam*b0,x1=a1-lam*b1; dd[hh][i][2*e]=x0; dd[hh][i][2*e+1]=x1; ssq[i]+=x0*x0+x1*x1; } }
      asm volatile("s_waitcnt lgkmcnt(0)":::"memory"); }
    #pragma unroll
    for(int i=0;i<4;++i){ float t=ssq[i]; t+=__shfl_xor(t,1); t+=__shfl_xor(t,2); t+=__shfl_xor(t,4); const float rs=oscale/sqrtf(t*(1.0f/128.0f)+1e-6f); const int row=i*8+(lane_e>>3),ch=lane_e&7;
      #pragma unroll
      for(int hh=0;hh<2;++hh){ const float*gp=subg+hh*64+ch*8; u32x4 w;
        #pragma unroll
        for(int e=0;e<4;++e)w[e]=cvtpk_s(dd[hh][i][2*e]*rs*gp[2*e],dd[hh][i][2*e+1]*rs*gp[2*e+1]);
        ATTN_STORE16(Ow+(long)row*op+hh*64+ch*8,w);} }
    } }
  asm volatile("s_waitcnt lgkmcnt(0)\n\ts_barrier":::"memory");
  #undef DMA_K
  #undef ROTT
  #undef DMA_V
  #undef CMASK
  #undef START
  #undef RESC
  #undef ROT
}
constexpr int ATTN_LDS_BYTES=LDS_BYTES;
#undef SBAR
#undef WAIT_BAR
}
constexpr int NWAVES = 8;
#ifndef MK_ONE_LAUNCH
#define MK_ONE_LAUNCH 1
#endif
constexpr int NPH = 20;

constexpr int D = 1024, NB = 2, SEQ = 8192, CTXL = 256;
constexpr int ML = NB * SEQ, MC = NB * CTXL, MR = ML + MC;
constexpr int E_IN = 2560, O_IN = 1792, FF = 2816, FF2 = 2 * FF, NEXP = 8;
constexpr int MOE_ROWS = 2 * ML + NEXP * 256, MOE_PAN = MOE_ROWS / 256;
constexpr int NCHUNK = MR / 64;
constexpr float EPS = 1e-6f;
constexpr float MOE_S13 = 32.0f, MOE_S2 = 64.0f;
constexpr float QSCALE = 0.125f * 1.4426950408889634f;

constexpr size_t MiB = 1u << 20, KiB = 1u << 10;
constexpr size_t WS_CTL = 0, CTL_ZERO_BYTES = 1 * MiB;
constexpr size_t WS_MOD = 1 * MiB;
constexpr size_t WS_WG = 1 * MiB + 256 * KiB;
constexpr size_t WS_TOK = 2 * MiB;
constexpr size_t WS_AGG = 4 * MiB;
constexpr size_t WS_WM13 = 8 * MiB, WS_WM2 = 96 * MiB;
constexpr size_t WS_WE = 140 * MiB, WS_WO0 = 145 * MiB, WS_WO1 = 147 * MiB, WS_WF13 = 149 * MiB, WS_WF2 = 160 * MiB, WS_WOI = 166 * MiB;
constexpr size_t WS_XR = 170 * MiB;
constexpr size_t WS_KC0 = 170 * MiB, WS_VC0 = 187 * MiB;
constexpr size_t WS_KC1 = 427 * MiB, WS_VC1 = 432 * MiB;
constexpr int KEYS = CTXL + SEQ;
constexpr size_t WS_XN = 236 * MiB;
constexpr size_t WS_Y = 269 * MiB;
constexpr size_t WS_P0 = 302 * MiB;
constexpr size_t WS_OATT = 385 * MiB;
constexpr size_t WS_H = 302 * MiB;
constexpr size_t WS_P1 = 302 * MiB;
constexpr size_t WS_RI = 360 * MiB;
constexpr size_t WS_XG = 368 * MiB;
constexpr size_t WS_HG = 140 * MiB;
constexpr size_t WS_YG = 368 * MiB;
constexpr size_t WS_END = 436 * MiB;
static_assert(WS_WM13 + (size_t)NEXP * FF2 * D * 2 <= WS_WM2 && WS_WM2 + (size_t)NEXP * D * FF * 2 <= WS_WE && WS_WE + (size_t)E_IN * D * 2 <= WS_WO0 && WS_WF13 + (size_t)FF2 * D * 2 <= WS_WF2 &&
              WS_WF2 + (size_t)D * FF * 2 <= WS_WOI && WS_WOI + (size_t)O_IN * D * 2 <= WS_XR && WS_XR + (size_t)MR * D * 4 <= WS_XN && WS_XN + (size_t)MR * D * 2 <= WS_Y && WS_Y + (size_t)MR * D * 2 <= WS_P0 &&
              WS_P0 + (size_t)MR * E_IN * 2 <= WS_OATT && WS_OATT + (size_t)MR * D * 2 <= WS_END && WS_H + (size_t)MR * FF * 2 <= WS_END && WS_P1 + (size_t)MR * O_IN * 2 <= WS_RI &&
              WS_RI + (size_t)4 * MR * 512 * 2 <= WS_END && WS_XG + (size_t)MOE_ROWS * D * 2 <= WS_END && WS_HG + (size_t)MOE_ROWS * FF * 2 <= WS_XG && WS_AGG + (size_t)2 * NCHUNK * 2 * 512 * 4 <= WS_WM13, "d_ws map");
constexpr int CW_TMO = 0, CW_CODE = 1;
constexpr int CW_BAR = 4096;
constexpr int CW_CNT = 8192;
constexpr int RING_OFF = 0, RING_BYTES = 131072;
constexpr int LDSCTL_OFF = RING_BYTES, MISC_OFF = LDSCTL_OFF + 320;
constexpr int PEXP_OFF = LDSCTL_OFF + 1024;
constexpr int LDS_BYTES = 147456;
#define GAS __attribute__((address_space(1)))
#define LAS __attribute__((address_space(3)))
typedef unsigned short bf16;
typedef unsigned v4u __attribute__((ext_vector_type(4)));
typedef float f32x4 __attribute__((ext_vector_type(4)));
typedef short bf16x8 __attribute__((ext_vector_type(8)));
typedef GAS unsigned gu32;
typedef GAS unsigned long long gu64;
#define RLX_AGENT __ATOMIC_RELAXED, __HIP_MEMORY_SCOPE_AGENT
#define LDS_WAIT() asm volatile("s_waitcnt lgkmcnt(0)" ::: "memory")
#define VM_WAIT() asm volatile("s_waitcnt vmcnt(0)" ::: "memory")
__device__ __forceinline__ unsigned long long rt() { return __builtin_amdgcn_s_memrealtime(); }
__device__ __forceinline__ unsigned f2bf(float f) { unsigned u = __builtin_bit_cast(unsigned, f); return (u + 0x7fffu + ((u >> 16) & 1u)) >> 16; }
__device__ __forceinline__ unsigned pk2(float lo, float hi) { return f2bf(lo) | (f2bf(hi) << 16); }

#define XB_TMO      128
#define XB_XCNT(j)  (256  + 64 * (j))
#define XB_XSUB(j)  (1280 + 64 * (j))
#define XB_XGEN(j)  (2304 + 64 * (j))
#define XB_TOP      3328
#define XB_TOPGEN   3392
#define XCD_BAR_WORDS 3456
#define XB_SPIN_CAP (1u << 18)

__device__ __forceinline__ unsigned xb_ld(unsigned* p)              { return __hip_atomic_load(p, __ATOMIC_RELAXED, __HIP_MEMORY_SCOPE_AGENT); }
__device__ __forceinline__ unsigned xb_add(unsigned* p, unsigned v) { return __hip_atomic_fetch_add(p, v, __ATOMIC_RELAXED, __HIP_MEMORY_SCOPE_AGENT); }
__device__ __forceinline__ unsigned xb_xcc_id() { return (unsigned)__builtin_amdgcn_s_getreg((3 << 11) | 20) & 0xFu; }
#define XB_SPIN(cond, bar) do { unsigned _sp = 0; while (cond) { __builtin_amdgcn_s_sleep(1); \
    if ((++_sp & 255u) == 0u) { if (xb_ld(&(bar)[XB_TMO])) break; if (_sp > XB_SPIN_CAP) { atomicAdd(&(bar)[XB_TMO], 1u); break; } } } } while (0)

struct XcdBarrier {
    unsigned* bar; unsigned x;
    volatile LAS unsigned* st;
};

__device__ __forceinline__ XcdBarrier xcd_barrier_post(unsigned* bar, volatile LAS unsigned* st) {
    XcdBarrier b; b.bar = bar; b.x = xb_xcc_id(); b.st = st;
    if (threadIdx.x == 0) (void)xb_add(&bar[XB_XCNT(b.x)], 1u);
    return b;
}
__device__ __forceinline__ void xcd_barrier_complete(unsigned* bar, unsigned x, unsigned& nloc, unsigned& nx) {
    const unsigned G = gridDim.x * gridDim.y * gridDim.z;
    unsigned sum, cnt, mine, sp = 0u;
    for (;;) {
        sum = 0u; cnt = 0u; mine = 0u;
#pragma unroll
        for (unsigned j = 0; j < 16; ++j) { const unsigned c = xb_ld(&bar[XB_XCNT(j)]); sum += c; cnt += (c > 0u) ? 1u : 0u; mine = (j == x) ? c : mine; }
        if (sum == G) break;
        __builtin_amdgcn_s_sleep(1);
        if ((++sp & 255u) == 0u) { if (xb_ld(&bar[XB_TMO])) break; if (sp > XB_SPIN_CAP) { atomicAdd(&bar[XB_TMO], 1u); break; } }
    }
    nloc = mine > 0u ? mine : 1u; nx = cnt > 0u ? cnt : 1u;
}

__device__ __forceinline__ void xcd_barrier(const XcdBarrier& b) {
    asm volatile("s_waitcnt vmcnt(0)" ::: "memory");
    __syncthreads();
    if (threadIdx.x == 0) {
        unsigned* bar = b.bar;
        __builtin_amdgcn_s_waitcnt(0);
        unsigned nloc = b.st[0], nx = b.st[1];
        if (nloc == 0u) { xcd_barrier_complete(bar, b.x, nloc, nx); b.st[0] = nloc; b.st[1] = nx; }
        const unsigned old = xb_add(&bar[XB_XSUB(b.x)], 1u);
        const unsigned gen = old / nloc;
        if (old + 1u == (gen + 1u) * nloc) {
            __builtin_amdgcn_fence(__ATOMIC_RELEASE, "agent");
            asm volatile("s_waitcnt vmcnt(0)" ::: "memory");
            const unsigned og = xb_add(&bar[XB_TOP], 1u);
            const unsigned tg = og / nx;
            if (og + 1u == (tg + 1u) * nx) xb_add(&bar[XB_TOPGEN], 1u);
            else XB_SPIN(xb_ld(&bar[XB_TOPGEN]) == tg, bar);
            __builtin_amdgcn_fence(__ATOMIC_ACQUIRE, "agent");
            xb_add(&bar[XB_XGEN(b.x)], 1u);
            asm volatile("s_waitcnt vmcnt(0)" ::: "memory");
        } else {
            XB_SPIN(xb_ld(&bar[XB_XGEN(b.x)]) == gen, bar);
            __builtin_amdgcn_fence(__ATOMIC_ACQUIRE, "agent");
            asm volatile("s_waitcnt vmcnt(0)" ::: "memory");
        }
    }
    __syncthreads();
}
typedef _Float16 f16;
typedef unsigned v2u __attribute__((ext_vector_type(2)));
typedef float f32x16 __attribute__((ext_vector_type(16)));
struct InPtrs { __device__ __forceinline__ const float* operator[](int i) const { return ((const float* const __attribute__((address_space(4)))*)__builtin_amdgcn_kernarg_segment_ptr())[i]; } };
struct Frame {
    LAS unsigned char* lds;
    volatile LAS unsigned* MISC;
    gu32* ctl;
    int tid, lane, wave;
    int vcu, G;
    InPtrs in; float* out; unsigned char* ws;
};
enum { I_X = 0, I_C, I_CTX, I_CCTX, I_WMOD, I_BMOD, I_NMIXG, I_NFFNG, I_WOUT, I_EWIN, I_ANORMG, I_AWS, I_ABS, I_BQNG, I_BKNG, I_LQ1, I_LK1, I_LQ2, I_LK2, I_SUBLNG,
       I_FW1, I_FW3, I_FW2, I_OWIN, I_CQNG, I_CKNG, I_CONVW, I_CONVB, I_DWA, I_DBA, I_DWX, I_DBX, I_DLAM, I_RW, I_RB, I_MW1, I_MW3, I_MW2 };

__device__ __forceinline__ float wave_sum(float v) {
#pragma unroll
    for (int o = 1; o < 64; o <<= 1) v += __shfl_xor(v, o);
    return v;
}
__device__ __forceinline__ float bf_lo(unsigned u) { return __uint_as_float(u << 16); }
__device__ __forceinline__ float bf_hi(unsigned u) { return __uint_as_float(u & 0xffff0000u); }
__device__ __forceinline__ float bf2f(bf16 h) { return __uint_as_float((unsigned)h << 16); }
__device__ __forceinline__ unsigned cvtpk(float lo, float hi) { return pg8::cvt_pk_bf16(lo, hi); }
__device__ __forceinline__ bf16 f2bf16(float f) { return (bf16)(cvtpk(f, 0.f) & 0xffffu); }
__device__ __forceinline__ void unpack8(const v4u u, float (&f)[8]) { f[0] = bf_lo(u.x); f[1] = bf_hi(u.x); f[2] = bf_lo(u.y); f[3] = bf_hi(u.y); f[4] = bf_lo(u.z); f[5] = bf_hi(u.z); f[6] = bf_lo(u.w); f[7] = bf_hi(u.w); }
__device__ __forceinline__ v4u pack8(const float (&f)[8]) { v4u o; o.x = cvtpk(f[0], f[1]); o.y = cvtpk(f[2], f[3]); o.z = cvtpk(f[4], f[5]); o.w = cvtpk(f[6], f[7]); return o; }
__device__ __forceinline__ float gelu_tanh(float x) { const float z = 0.7978845608028654f * (x + 0.044715f * x * x * x); return x * __builtin_amdgcn_rcpf(1.0f + __builtin_amdgcn_exp2f(-2.885390081777927f * z)); }
__device__ __forceinline__ float sigmoid_f(float x) { return __builtin_amdgcn_rcpf(1.0f + __builtin_amdgcn_exp2f(-1.4426950408889634f * x)); }
__device__ __forceinline__ int crow16(int r, int hi) { return (r & 3) + 8 * (r >> 2) + 4 * hi; }

__device__ __forceinline__ bool qk_bounded(const float* gq, const float* gk, int lane) {
    float a = fabsf(gq[lane]), b = fabsf(gk[lane]);
#pragma unroll
    for (int o = 1; o < 64; o <<= 1) { a = fmaxf(a, __shfl_xor(a, o)); b = fmaxf(b, __shfl_xor(b, o)); }
    return __builtin_amdgcn_readfirstlane((int)(64.0f * QSCALE * a * b * 1.02f < 64.0f)) != 0;
}
struct TrItem { const float* W; unsigned char* WT; int K, N, ilv, f8, item; float scale; };
__device__ __forceinline__ void tr_load(const TrItem& d, int lane, f32x4 (&v)[8]) {
    const int nblk = d.N / 32, kb = d.item / nblk, nb = d.item % nblk; const float* p = d.W + (size_t)(64 * kb + (lane >> 3)) * d.N + 32 * nb + 4 * (lane & 7);
#pragma unroll
    for (int i = 0; i < 8; ++i) v[i] = *(const GAS f32x4*)(p + (size_t)(8 * i) * d.N);
}
__device__ __forceinline__ void tr_store(const TrItem& d, int lane, const f32x4 (&v)[8], LAS float* scr) {
    const int nblk = d.N / 32, kb = d.item / nblk, nb = d.item % nblk, k0 = 64 * kb, n0 = 32 * nb;
    const int r0 = d.ilv ? ((n0 >> 7) * 256 + (n0 & 127) + (d.ilv == 2 ? 128 : 0)) : n0;
#pragma unroll
    for (int i = 0; i < 8; ++i) { LAS float* q = scr + (8 * i + (lane >> 3)) * 33 + 4 * (lane & 7); q[0] = v[i].x * d.scale; q[1] = v[i].y * d.scale; q[2] = v[i].z * d.scale; q[3] = v[i].w * d.scale; }
    LDS_WAIT(); asm volatile("" ::: "memory");
    if (d.f8) { const int c = lane & 3;
#pragma unroll
        for (int j = 0; j < 2; ++j) { const int n = (lane >> 2) + 16 * j; const LAS float* s = scr + (16 * c) * 33 + n;
            v4u o; o.x = pg8::cvt4_fp8(s[0 * 33], s[1 * 33], s[2 * 33], s[3 * 33]); o.y = pg8::cvt4_fp8(s[4 * 33], s[5 * 33], s[6 * 33], s[7 * 33]);
            o.z = pg8::cvt4_fp8(s[8 * 33], s[9 * 33], s[10 * 33], s[11 * 33]); o.w = pg8::cvt4_fp8(s[12 * 33], s[13 * 33], s[14 * 33], s[15 * 33]);
            *(GAS v4u*)(d.WT + (size_t)(r0 + n) * d.K + k0 + 16 * c) = o; }
    } else { const int c = lane & 7;
#pragma unroll
        for (int j = 0; j < 4; ++j) { const int n = (lane >> 3) + 8 * j; const LAS float* s = scr + (8 * c) * 33 + n;
            v4u o; o.x = cvtpk(s[0 * 33], s[1 * 33]); o.y = cvtpk(s[2 * 33], s[3 * 33]); o.z = cvtpk(s[4 * 33], s[5 * 33]); o.w = cvtpk(s[6 * 33], s[7 * 33]);
            *(GAS v4u*)((bf16*)d.WT + (size_t)(r0 + n) * d.K + k0 + 8 * c) = o; } }
    LDS_WAIT(); asm volatile("" ::: "memory");
}
constexpr int TR_I_E = 16 * 80, TR_I_O = 16 * 32, TR_I_F = 16 * 88, TR_I_OI = 16 * 56, TR_I_EXP = 3 * TR_I_F;
constexpr int TR_NITEMS = TR_I_E + 2 * TR_I_O + 3 * TR_I_F + TR_I_OI + NEXP * TR_I_EXP;
static_assert(TR_I_F == 44 * 32, "item counts of the [1024][2816] and [2816][1024] matrices match");
__device__ __forceinline__ TrItem tr_decode(Frame& F, int it) {
    unsigned char* ws = F.ws; int r = it; TrItem d; d.f8 = 0; d.scale = 1.0f; d.ilv = 0;
    if (r < TR_I_E) { d.W = F.in[I_EWIN]; d.K = D; d.N = E_IN; d.WT = ws + WS_WE; d.item = r; return d; } r -= TR_I_E;
    if (r < TR_I_O) { d.W = F.in[I_WOUT]; d.K = D; d.N = D; d.WT = ws + WS_WO0; d.item = r; return d; } r -= TR_I_O;
    if (r < TR_I_O) { d.W = F.in[I_WOUT] + (size_t)D * D; d.K = D; d.N = D; d.WT = ws + WS_WO1; d.item = r; return d; } r -= TR_I_O;
    if (r < TR_I_F) { d.W = F.in[I_FW1]; d.K = D; d.N = FF; d.WT = ws + WS_WF13; d.ilv = 1; d.f8 = 1; d.scale = MOE_S13; d.item = r; return d; } r -= TR_I_F;
    if (r < TR_I_F) { d.W = F.in[I_FW3]; d.K = D; d.N = FF; d.WT = ws + WS_WF13; d.ilv = 2; d.f8 = 1; d.scale = MOE_S13; d.item = r; return d; } r -= TR_I_F;
    if (r < TR_I_F) { d.W = F.in[I_FW2]; d.K = FF; d.N = D; d.WT = ws + WS_WF2; d.f8 = 1; d.scale = MOE_S2; d.item = r; return d; } r -= TR_I_F;
    if (r < TR_I_OI) { d.W = F.in[I_OWIN]; d.K = D; d.N = O_IN; d.WT = ws + WS_WOI; d.item = r; return d; } r -= TR_I_OI;
    const int e = r / TR_I_EXP, q = r % TR_I_EXP; d.f8 = 1;
    if (q < TR_I_F) { d.W = F.in[I_MW1] + (size_t)e * D * FF; d.K = D; d.N = FF; d.WT = ws + WS_WM13 + (size_t)e * FF2 * D; d.ilv = 1; d.scale = MOE_S13; d.item = q; }
    else if (q < 2 * TR_I_F) { d.W = F.in[I_MW3] + (size_t)e * D * FF; d.K = D; d.N = FF; d.WT = ws + WS_WM13 + (size_t)e * FF2 * D; d.ilv = 2; d.scale = MOE_S13; d.item = q - TR_I_F; }
    else { d.W = F.in[I_MW2] + (size_t)e * FF * D; d.K = FF; d.N = D; d.WT = ws + WS_WM2 + (size_t)e * D * FF; d.scale = MOE_S2; d.item = q - 2 * TR_I_F; }
    return d;
}
constexpr int TR_DENSE = TR_I_E + 2 * TR_I_O + 3 * TR_I_F + TR_I_OI;
__device__ __forceinline__ void tr_range(Frame& F, int lo, int hi) {
    LAS float* scr = (LAS float*)(F.lds + RING_OFF + F.wave * 16384);
    const int gw = F.vcu * NWAVES + F.wave, NGW = F.G * NWAVES, lane = F.lane;
    f32x4 v0[8], v1[8], v2[8], v3[8]; TrItem d0, d1, d2, d3; int it = lo + gw;
#define TR_ISSUE(d, v, idx) do { const int i_ = (idx); d = tr_decode(F, i_ < hi ? i_ : lo); if (i_ < hi) tr_load(d, lane, v); } while (0)
    TR_ISSUE(d0, v0, it); TR_ISSUE(d1, v1, it + NGW); TR_ISSUE(d2, v2, it + 2 * NGW);
    while (it < hi) {
        TR_ISSUE(d3, v3, it + 3 * NGW); tr_store(d0, lane, v0, scr); if (it + NGW >= hi) break;
        TR_ISSUE(d0, v0, it + 4 * NGW); tr_store(d1, lane, v1, scr); if (it + 2 * NGW >= hi) break;
        TR_ISSUE(d1, v1, it + 5 * NGW); tr_store(d2, lane, v2, scr); if (it + 3 * NGW >= hi) break;
        TR_ISSUE(d2, v2, it + 6 * NGW); tr_store(d3, lane, v3, scr);
        it += 4 * NGW; }
#undef TR_ISSUE
}
__device__ __forceinline__ void ph0_prologue(Frame& F) {
    const int lane = F.lane;
    tr_range(F, 0, TR_DENSE);
    { bf16* WG = (bf16*)(F.ws + WS_WG);
      for (int i = (int)blockIdx.x * 512 + F.tid; i < 2 * 2 * 8 * 64 * 64; i += F.G * 512) {
          const int k = i & 63, o = (i >> 6) & 63, n = (i >> 12) & 7, mat = (i >> 15) & 1, d = (i >> 16) & 1;
          const float* W = mat ? F.in[I_DWX] : F.in[I_DWA];
          WG[i] = f2bf16(W[((size_t)(d * 8 + n) * 64 + k) * 64 + o]); } }
    __syncthreads();
    { float* MOD = (float*)(F.ws + WS_MOD); LAS float* red = (LAS float*)(F.lds + RING_OFF);
      for (int cg = (int)blockIdx.x; cg < 2 * 96; cg += F.G) {
          const int layer = cg / 96, n0 = (cg % 96) * 64, kr = lane >> 4, c4 = lane & 15;
          f32x4 acc[3]; acc[0] = acc[1] = acc[2] = (f32x4){0.f, 0.f, 0.f, 0.f};
          const float* Wl = F.in[I_WMOD] + (size_t)layer * D * 6 * D;
#pragma unroll 4
          for (int it = 0; it < 32; ++it) { const int k = F.wave * 128 + 4 * it + kr;
              const f32x4 w = *(const GAS f32x4*)(Wl + (size_t)k * 6 * D + n0 + 4 * c4);
              const float c0 = F.in[I_C][k], c1 = F.in[I_C][D + k], c2 = F.in[I_CCTX][k];
              acc[0] += (c0 * sigmoid_f(c0)) * w; acc[1] += (c1 * sigmoid_f(c1)) * w; acc[2] += (c2 * sigmoid_f(c2)) * w; }
#pragma unroll
          for (int s = 0; s < 3; ++s)
#pragma unroll
              for (int j = 0; j < 4; ++j) { float v = acc[s][j]; v += __shfl_xor(v, 16); v += __shfl_xor(v, 32); acc[s][j] = v; }
          if (lane < 16) {
#pragma unroll
              for (int s = 0; s < 3; ++s)
#pragma unroll
                  for (int j = 0; j < 4; ++j) red[(F.wave * 3 + s) * 64 + 4 * c4 + j] = acc[s][j]; }
          __syncthreads();
          if (F.tid < 192) { const int s = F.tid >> 6, col = F.tid & 63; float v = F.in[I_BMOD][layer * 6 * D + n0 + col];
#pragma unroll
              for (int w = 0; w < 8; ++w) v += red[(w * 3 + s) * 64 + col];
              MOD[(size_t)(layer * 3 + s) * 6 * D + n0 + col] = v; }
          __syncthreads();
      } }
}
template <bool F8 = false> __device__ __forceinline__ void normmod_row(const float* src, const float* g, const float* sc, const float* sh, bf16* dst, int lane, f32x4 (&t)[4]) {
    const GAS f32x4* xr = (const GAS f32x4*)src + lane; float s = 0.f;
#pragma unroll
    for (int j = 0; j < 4; ++j) { t[j] = xr[64 * j]; s += (t[j].x * t[j].x + t[j].y * t[j].y) + (t[j].z * t[j].z + t[j].w * t[j].w); }
    const float rstd = 1.0f / sqrtf(wave_sum(s) * (1.f / D) + EPS);
    GAS v2u* o8 = (GAS v2u*)dst + lane;
#pragma unroll
    for (int j = 0; j < 4; ++j) { const f32x4 gg = ((const GAS f32x4*)g)[lane + 64 * j], cc = ((const GAS f32x4*)sc)[lane + 64 * j], hh = ((const GAS f32x4*)sh)[lane + 64 * j];
        t[j] = t[j] * rstd * gg * (1.0f + cc) + hh;
        if constexpr (F8) ((GAS unsigned*)dst)[lane + 64 * j] = pg8::cvt4_fp8(t[j].x, t[j].y, t[j].z, t[j].w); else { v2u w; w.x = cvtpk(t[j].x, t[j].y); w.y = cvtpk(t[j].z, t[j].w); o8[64 * j] = w; } }
}
template <bool F8 = false> __device__ __forceinline__ void ph_normmod(Frame& F, const float* srcL, const float* srcC, int nrows, const float* g, int layer, int sh_off, int sc_off) {
    const int gw = F.vcu * NWAVES + F.wave, NGW = F.G * NWAVES; const float* MOD = (const float*)(F.ws + WS_MOD) + (size_t)layer * 3 * 6 * D; bf16* XN = (bf16*)(F.ws + WS_XN);
    for (int m = gw; m < nrows; m += NGW) { const int s = m < SEQ ? 0 : (m < ML ? 1 : 2); const float* src = m < ML ? srcL + (size_t)m * D : srcC + (size_t)(m - ML) * D; f32x4 t[4];
        normmod_row<F8>(src, g, MOD + s * 6 * D + sc_off, MOD + s * 6 * D + sh_off, F8 ? (bf16*)((unsigned char*)XN + (size_t)m * D) : XN + (size_t)m * D, F.lane, t); }
}
__device__ __forceinline__ void qknorm_rope(float (&f)[8], const float* g, bool rope, int prow, int pcol, float outscale, int lane) {
    float ss = 0.f;
#pragma unroll
    for (int e = 0; e < 8; ++e) ss += f[e] * f[e];
    ss += __shfl_xor(ss, 1); ss += __shfl_xor(ss, 2); ss += __shfl_xor(ss, 4);
    const float rstd = 1.0f / sqrtf(ss * (1.f / 64.f) + EPS); const int j = lane & 7;
    const f32x4 g0 = *(const GAS f32x4*)(g + 8 * j), g1 = *(const GAS f32x4*)(g + 8 * j + 4);
    const float gg[8] = {g0.x, g0.y, g0.z, g0.w, g1.x, g1.y, g1.z, g1.w};
#pragma unroll
    for (int e = 0; e < 8; ++e) f[e] = f[e] * rstd * gg[e];
    if (rope) {
        const float pos = (float)((j < 4) ? prow : pcol), sgn = (j & 2) ? 1.f : -1.f;
#pragma unroll
        for (int e = 0; e < 8; ++e) { const float p = __shfl_xor(f[e], 2); const int i = (j & 1) * 8 + e;
            const float fr = __builtin_amdgcn_exp2f(-(float)i * (13.287712379549449f / 16.f)); float rev = pos * fr * 0.15915494309189535f; rev = rev - floorf(rev);
            f[e] = f[e] * __builtin_amdgcn_cosf(rev) + sgn * p * __builtin_amdgcn_sinf(rev); }
    }
#pragma unroll
    for (int e = 0; e < 8; ++e) f[e] *= outscale;
}
__device__ __forceinline__ void ph3_post0(Frame& F) {
    const int gw = F.vcu * NWAVES + F.wave, NGW = F.G * NWAVES, lane = F.lane; bf16* P0 = (bf16*)(F.ws + WS_P0); bf16* KC = (bf16*)(F.ws + WS_KC0); bf16* VC = (bf16*)(F.ws + WS_VC0);
    for (int m = gw; m < MR; m += NGW) {
        GAS v4u* rowp = (GAS v4u*)(P0 + (size_t)m * E_IN) + lane;
        const v4u u0 = rowp[0], u1 = rowp[64], u2 = rowp[128], u3 = rowp[192];
        float f[8];
        unpack8(u0, f);
#pragma unroll
        for (int e = 0; e < 8; ++e) f[e] = gelu_tanh(f[e]);
        rowp[0] = pack8(f);
        unpack8(u1, f); float ss = 0.f;
#pragma unroll
        for (int e = 0; e < 8; ++e) { f[e] = gelu_tanh(f[e]); ss += f[e] * f[e]; }
        { const float rstd = 1.0f / sqrtf(wave_sum(ss) * (1.f / 512.f) + EPS); const float* g = F.in[I_ANORMG] + 8 * lane;
          const f32x4 g0 = *(const GAS f32x4*)g, g1 = *(const GAS f32x4*)(g + 4); const float gg[8] = {g0.x, g0.y, g0.z, g0.w, g1.x, g1.y, g1.z, g1.w};
#pragma unroll
          for (int e = 0; e < 8; ++e) f[e] = f[e] * rstd * gg[e]; }
        rowp[64] = pack8(f);
        const bool lat = m < ML; const int t = m & (SEQ - 1), prow = t >> 6, pcol = t & 63;
        unpack8(u2, f); qknorm_rope(f, F.in[I_BQNG], lat, prow, pcol, QSCALE, lane); rowp[128] = pack8(f);
        unpack8(u3, f); qknorm_rope(f, F.in[I_BKNG], lat, prow, pcol, 1.0f, lane);
        { const int b = lat ? (m >> 13) : ((m - ML) >> 8), pos = lat ? CTXL + t : ((m - ML) & (CTXL - 1)); const size_t tb = (size_t)(pos >> 6) * 4096; const int pr = pos & 63;
          *(GAS v4u*)(KC + ((size_t)(b * 8 + (lane >> 3)) * KEYS * 64 + tb + (lane & 7) * 512 + pr * 8)) = pack8(f);
          const v4u u4 = rowp[256];
          *(GAS v4u*)(VC + ((size_t)(b * 8 + (lane >> 3)) * KEYS * 64 + tb + ((((lane & 7) >> 2) * 4 + (pr >> 4)) * 64 + (pr & 15) * 4 + (lane & 3)) * 8)) = u4; }
    }
}
__device__ __forceinline__ void gmlp_unit(Frame& F, int chunk) {
    const int lane = F.lane, r32 = lane & 31, hi = lane >> 5, g = F.wave, r0 = chunk * 128;
    const bf16* P0 = (const bf16*)(F.ws + WS_P0); bf16* Y = (bf16*)(F.ws + WS_Y);
    const float* ws = F.in[I_AWS] + (size_t)g * 128 * 128; const float* bs = F.in[I_ABS] + g * 128;
    bf16x8 afr[2][8];
#pragma unroll
    for (int ct = 0; ct < 2; ++ct)
#pragma unroll
        for (int ks = 0; ks < 8; ++ks)
#pragma unroll
            for (int e = 0; e < 8; ++e) afr[ct][ks][e] = (short)P0[(size_t)(r0 + 16 * ks + 8 * hi + e) * E_IN + 512 + 64 * g + 32 * ct + r32];
#pragma unroll 1
    for (int pt = 0; pt < 4; ++pt) {
        f32x16 acc[2]; acc[0] = f32x16{}; acc[1] = f32x16{};
        const float* wp = ws + (size_t)(32 * pt + r32) * 128 + 8 * hi;
#pragma unroll
        for (int ks = 0; ks < 8; ++ks) { const f32x4 w0 = *(const GAS f32x4*)(wp + 16 * ks), w1 = *(const GAS f32x4*)(wp + 16 * ks + 4);
            v4u pk; pk.x = cvtpk(w0.x, w0.y); pk.y = cvtpk(w0.z, w0.w); pk.z = cvtpk(w1.x, w1.y); pk.w = cvtpk(w1.z, w1.w); const bf16x8 bfr = __builtin_bit_cast(bf16x8, pk);
            acc[0] = __builtin_amdgcn_mfma_f32_32x32x16_bf16(afr[0][ks], bfr, acc[0], 0, 0, 0); acc[1] = __builtin_amdgcn_mfma_f32_32x32x16_bf16(afr[1][ks], bfr, acc[1], 0, 0, 0); }
        const int p = 32 * pt + r32; const float bias = bs[p];
#pragma unroll
        for (int ct = 0; ct < 2; ++ct)
#pragma unroll
            for (int rq = 0; rq < 4; ++rq) { const int c0 = 64 * g + 32 * ct + 8 * rq + 4 * hi;
                const v2u uu = *(const GAS v2u*)(P0 + (size_t)(r0 + p) * E_IN + c0);
                v2u o; o.x = cvtpk(bf_lo(uu.x) * (acc[ct][4 * rq + 0] + bias), bf_hi(uu.x) * (acc[ct][4 * rq + 1] + bias)); o.y = cvtpk(bf_lo(uu.y) * (acc[ct][4 * rq + 2] + bias), bf_hi(uu.y) * (acc[ct][4 * rq + 3] + bias));
                *(GAS v2u*)(Y + (size_t)(r0 + p) * D + c0) = o; }
    }
}
__device__ __forceinline__ void ph5_diffout(Frame& F) {
    const int gw = F.vcu * NWAVES + F.wave, NGW = F.G * NWAVES, lane = F.lane; const bf16* OA = (const bf16*)(F.ws + WS_OATT); bf16* Y = (bf16*)(F.ws + WS_Y);
    const float s1 = wave_sum(F.in[I_LQ1][lane] * F.in[I_LK1][lane]), s2 = wave_sum(F.in[I_LQ2][lane] * F.in[I_LK2][lane]);
    const float lam_init = 0.2f, lam = expf(s1) - expf(s2) + lam_init;
    const int h = lane >> 4, comp = (lane >> 3) & 1, i0 = (lane & 7) * 16;
    float gg[16];
#pragma unroll
    for (int q = 0; q < 4; ++q) { const f32x4 gv = *(const GAS f32x4*)(F.in[I_SUBLNG] + i0 + 4 * q); gg[4 * q] = gv.x; gg[4 * q + 1] = gv.y; gg[4 * q + 2] = gv.z; gg[4 * q + 3] = gv.w; }
    for (int m = gw; m < MR; m += NGW) {
        const GAS v4u* rp = (const GAS v4u*)(OA + (size_t)m * D + 16 * lane);
        const v4u a = rp[0], b = rp[1]; float own[16], d[16];
        { float t8[8]; unpack8(a, t8);
#pragma unroll
          for (int e = 0; e < 8; ++e) own[e] = t8[e];
          unpack8(b, t8);
#pragma unroll
          for (int e = 0; e < 8; ++e) own[8 + e] = t8[e]; }
        float ss = 0.f;
#pragma unroll
        for (int e = 0; e < 16; ++e) { const float oth = __shfl_xor(own[e], 8); const float o1 = comp ? oth : own[e], o2 = comp ? own[e] : oth; d[e] = o1 - lam * o2; ss += d[e] * d[e]; }
        ss += __shfl_xor(ss, 1); ss += __shfl_xor(ss, 2); ss += __shfl_xor(ss, 4);
        const float rstd = (1.0f - lam_init) / sqrtf(ss * (1.f / 128.f) + EPS);
        if (comp == 0) { float o8[8]; GAS v4u* yp = (GAS v4u*)(Y + (size_t)m * D + 512 + 128 * h + i0);
#pragma unroll
            for (int e = 0; e < 8; ++e) o8[e] = d[e] * rstd * gg[e];
            yp[0] = pack8(o8);
#pragma unroll
            for (int e = 0; e < 8; ++e) o8[e] = d[8 + e] * rstd * gg[8 + e];
            yp[1] = pack8(o8); }
    }
}
__device__ __forceinline__ void ph12_post1(Frame& F) {
    const int nskip = (NCHUNK > F.G && NCHUNK - F.G < F.G / 2) ? NCHUNK - F.G : 0;
    if (F.vcu < nskip) return;
    const int gw = (F.vcu - nskip) * NWAVES + F.wave, NGW = (F.G - nskip) * NWAVES, lane = F.lane; bf16* P1 = (bf16*)(F.ws + WS_P1); bf16* KC = (bf16*)(F.ws + WS_KC1); bf16* VC = (bf16*)(F.ws + WS_VC1);
    for (int m = gw; m < MR; m += NGW) {
        GAS v4u* rowp = (GAS v4u*)(P1 + (size_t)m * O_IN) + lane;
        const v4u u0 = rowp[0], u1 = rowp[64];
        const bool lat = m < ML; const int t = m & (SEQ - 1), prow = t >> 6, pcol = t & 63; float f[8];
        unpack8(u0, f); qknorm_rope(f, F.in[I_CQNG], lat, prow, pcol, QSCALE, lane); if (lat) rowp[0] = pack8(f);
        unpack8(u1, f); qknorm_rope(f, F.in[I_CKNG], lat, prow, pcol, 1.0f, lane);
        { const int b = lat ? (m >> 13) : ((m - ML) >> 8), pos = lat ? CTXL + t : ((m - ML) & (CTXL - 1)); const size_t tb = (size_t)(pos >> 6) * 4096; const int pr = pos & 63, l2 = lane & 15;
          if (lane < 16) *(GAS v4u*)(KC + ((size_t)(b * 2 + (l2 >> 3)) * KEYS * 64 + tb + (l2 & 7) * 512 + pr * 8)) = pack8(f);
          else if (lane < 32) *(GAS v4u*)(VC + ((size_t)(b * 2 + (l2 >> 3)) * KEYS * 64 + tb + ((((l2 & 7) >> 2) * 4 + (pr >> 4)) * 64 + (pr & 15) * 4 + (l2 & 3)) * 8)) = u1; }
    }
}
__device__ __forceinline__ bool seq_start(int r) { return r < ML ? (r & (SEQ - 1)) == 0 : ((r - ML) & (CTXL - 1)) == 0; }
constexpr int XDS = 520;
__device__ __forceinline__ void conv_to_lds(Frame& F, int r0, LAS bf16* XD) {
    const int cg = F.lane, w = F.wave; const bf16* P1 = (const bf16*)(F.ws + WS_P1);
    const bool st = seq_start(r0), en = seq_start(r0 + 64) || (r0 + 64 == MR);
    float wj[4][8], cb[8];
#pragma unroll
    for (int j = 0; j < 4; ++j) { const f32x4 a = *(const GAS f32x4*)(F.in[I_CONVW] + j * 512 + 8 * cg), b = *(const GAS f32x4*)(F.in[I_CONVW] + j * 512 + 8 * cg + 4);
        wj[j][0] = a.x; wj[j][1] = a.y; wj[j][2] = a.z; wj[j][3] = a.w; wj[j][4] = b.x; wj[j][5] = b.y; wj[j][6] = b.z; wj[j][7] = b.w; }
    { const f32x4 a = *(const GAS f32x4*)(F.in[I_CONVB] + 8 * cg), b = *(const GAS f32x4*)(F.in[I_CONVB] + 8 * cg + 4); cb[0] = a.x; cb[1] = a.y; cb[2] = a.z; cb[3] = a.w; cb[4] = b.x; cb[5] = b.y; cb[6] = b.z; cb[7] = b.w; }
    v4u xr[11];
#pragma unroll
    for (int i = 0; i < 11; ++i) { const int rl = 8 * w + i - 2; const bool ok = !((st && rl < 0) || (en && rl >= 64));
        xr[i] = ok ? *(const GAS v4u*)(P1 + (size_t)(r0 + rl) * O_IN + 1280 + 8 * cg) : (v4u){0u, 0u, 0u, 0u}; }
    float acc[8][8];
#pragma unroll
    for (int o = 0; o < 8; ++o)
#pragma unroll
        for (int e = 0; e < 8; ++e) acc[o][e] = cb[e];
#pragma unroll
    for (int i = 0; i < 11; ++i) { float f[8]; unpack8(xr[i], f);
#pragma unroll
        for (int j = 0; j < 4; ++j) { const int o = i - j; if (o >= 0 && o < 8) {
#pragma unroll
            for (int e = 0; e < 8; ++e) acc[o][e] += wj[j][e] * f[e]; } } }
#pragma unroll
    for (int o = 0; o < 8; ++o) *(LAS v4u*)(XD + (8 * w + o) * XDS + 8 * cg) = pack8(acc[o]);
}
__device__ __forceinline__ void lru_gates(Frame& F, const LAS bf16* XD, int n, int d, int half, f32x16 (&a)[2], f32x16 (&b)[2]) {
    const int lane = F.lane, r32 = lane & 31, hi = lane >> 5; const bf16* WG = (const bf16*)(F.ws + WS_WG);
    f32x16 ai[2]; a[0] = f32x16{}; a[1] = f32x16{}; ai[0] = f32x16{}; ai[1] = f32x16{};
    const bf16* wpr = WG + ((size_t)(((d * 2 + 0) * 8 + n) * 64 + 32 * half + r32)) * 64 + 8 * hi; const bf16* wpi = WG + ((size_t)(((d * 2 + 1) * 8 + n) * 64 + 32 * half + r32)) * 64 + 8 * hi;
#pragma unroll
    for (int ks = 0; ks < 4; ++ks) { const bf16x8 br = *(const GAS bf16x8*)(wpr + 16 * ks), bi = *(const GAS bf16x8*)(wpi + 16 * ks);
#pragma unroll
        for (int mt = 0; mt < 2; ++mt) { const bf16x8 af = *(const LAS bf16x8*)(XD + (32 * mt + r32) * XDS + 64 * n + 16 * ks + 8 * hi);
            a[mt] = __builtin_amdgcn_mfma_f32_32x32x16_bf16(af, br, a[mt], 0, 0, 0); ai[mt] = __builtin_amdgcn_mfma_f32_32x32x16_bf16(af, bi, ai[mt], 0, 0, 0); } }
    __builtin_amdgcn_sched_barrier(0);
    const int ch = 64 * n + 32 * half + r32; const float ba = F.in[I_DBA][d * 512 + ch], bx = F.in[I_DBX][d * 512 + ch];
    const float sp8 = 8.0f * log1pf(expf(-F.in[I_DLAM][d * 512 + ch]));
#pragma unroll
    for (int mt = 0; mt < 2; ++mt)
#pragma unroll
        for (int r = 0; r < 16; ++r) { const int row = 32 * mt + crow16(r, hi); const float xd = bf2f(XD[row * XDS + ch]);
            const float rr = sigmoid_f(a[mt][r] + ba), ii = sigmoid_f(ai[mt][r] + bx); const float y = rr * sp8, av = __builtin_amdgcn_exp2f(y * -1.4426950408889634f);
            const float y2 = 2.0f * y, om = y2 < 0.03f ? y2 * (1.0f - y2 * (0.5f - y2 * (1.0f / 6.0f))) : fmaf(-av, av, 1.0f);
            a[mt][r] = av; b[mt][r] = sqrtf(om) * (ii * xd); if ((r & 3) == 3) __builtin_amdgcn_sched_barrier(0); }
}
template <bool REV, bool FULL> __device__ __forceinline__ void chunk_scan(f32x16 (&a)[2], f32x16 (&b)[2], int hi, float h0, float& Atot, float& Btot) {
    float GA[8], GB[8], pGA[8], pGB[8], carry[8];
#pragma unroll
    for (int j = 0; j < 8; ++j) { const int mt = j >> 2, q = j & 3;
#pragma unroll
        for (int p = 1; p < 4; ++p) { const int k = REV ? 3 - p : p, kp = REV ? k + 1 : k - 1; const float ak = a[mt][4 * q + k];
            b[mt][4 * q + k] = ak * b[mt][4 * q + kp] + b[mt][4 * q + k]; a[mt][4 * q + k] = ak * a[mt][4 * q + kp]; }
        GA[j] = a[mt][4 * q + (REV ? 0 : 3)]; GB[j] = b[mt][4 * q + (REV ? 0 : 3)]; }
#pragma unroll
    for (int j = 0; j < 8; ++j) { const auto ra = __builtin_amdgcn_permlane32_swap(__float_as_uint(GA[j]), __float_as_uint(GA[j]), false, false); pGA[j] = __uint_as_float(hi ? ra[0] : ra[1]);
        const auto rb = __builtin_amdgcn_permlane32_swap(__float_as_uint(GB[j]), __float_as_uint(GB[j]), false, false); pGB[j] = __uint_as_float(hi ? rb[0] : rb[1]); }
    float c = h0, At = 1.0f; const bool firstMine = REV ? (hi == 1) : (hi == 0);
#pragma unroll
    for (int jj = 0; jj < 8; ++jj) { const int j = REV ? 7 - jj : jj;
        const float A1 = firstMine ? GA[j] : pGA[j], B1 = firstMine ? GB[j] : pGB[j], A2 = firstMine ? pGA[j] : GA[j], B2 = firstMine ? pGB[j] : GB[j];
        const float c1 = A1 * c + B1; carry[j] = firstMine ? c : c1; c = A2 * c1 + B2; At *= GA[j] * pGA[j]; }
    Atot = At; Btot = c;
    if constexpr (FULL) {
#pragma unroll
        for (int j = 0; j < 8; ++j) { const int mt = j >> 2, q = j & 3;
#pragma unroll
            for (int k = 0; k < 4; ++k) b[mt][4 * q + k] = a[mt][4 * q + k] * carry[j] + b[mt][4 * q + k]; }
    }
}
__device__ __forceinline__ void scan_prep_unit(Frame& F, int cid) {
    const int r0 = cid * 64, lane = F.lane, r32 = lane & 31, hi = lane >> 5, n = F.wave; LAS bf16* XD = (LAS bf16*)(F.lds + RING_OFF); float* AGG = (float*)(F.ws + WS_AGG);
    conv_to_lds(F, r0, XD);
    LDS_WAIT(); __syncthreads();
#pragma unroll
    for (int d = 0; d < 2; ++d)
#pragma unroll
        for (int half = 0; half < 2; ++half) { f32x16 a[2], b[2]; lru_gates(F, XD, n, d, half, a, b); float At, Bt;
            if (d == 0) chunk_scan<false, false>(a, b, hi, 0.f, At, Bt); else chunk_scan<true, false>(a, b, hi, 0.f, At, Bt);
            if (hi == 0) { const int ch = 64 * n + 32 * half + r32; AGG[((size_t)(d * NCHUNK + cid) * 2 + 0) * 512 + ch] = At; AGG[((size_t)(d * NCHUNK + cid) * 2 + 1) * 512 + ch] = Bt; } }
    LDS_WAIT(); __syncthreads();
}
__device__ __forceinline__ void scan_fix_unit(Frame& F, int cid) {
    const int b = cid >> 7, j = cid & 127, r0 = cid * 64, lane = F.lane, r32 = lane & 31, hi = lane >> 5, n = F.wave;
    const float* AGG = (const float*)(F.ws + WS_AGG); const bf16* P1 = (const bf16*)(F.ws + WS_P1); bf16* Y = (bf16*)(F.ws + WS_Y);
    LAS bf16* XD = (LAS bf16*)(F.lds + RING_OFF); LAS float* CAR = (LAS float*)(F.lds + RING_OFF + 64 * XDS * 2);
    conv_to_lds(F, r0, XD);
    asm volatile("" ::: "memory"); __builtin_amdgcn_sched_barrier(0);
    { const int ch = F.tid; const float* A0 = AGG + ch; const float* A1 = AGG + (size_t)NCHUNK * 1024 + ch;
      float hf = 0.f, hb = 0.f;
#pragma unroll
      for (int q = 0; q < 4; ++q) { const int c = 256 + 4 * b + q; hf = A0[(size_t)c * 1024] * hf + A0[(size_t)c * 1024 + 512]; }
#pragma unroll 8
      for (int q = 0; q < j; ++q) { const int c = 128 * b + q; hf = A0[(size_t)c * 1024] * hf + A0[(size_t)c * 1024 + 512]; }
#pragma unroll
      for (int q = 3; q >= 0; --q) { const int c = 256 + 4 * b + q; hb = A1[(size_t)c * 1024] * hb + A1[(size_t)c * 1024 + 512]; }
#pragma unroll 8
      for (int q = 127; q > j; --q) { const int c = 128 * b + q; hb = A1[(size_t)c * 1024] * hb + A1[(size_t)c * 1024 + 512]; }
      CAR[ch] = hf; CAR[512 + ch] = hb; }
    LDS_WAIT(); __syncthreads();
#pragma unroll 1
    for (int half = 0; half < 2; ++half) { const int ch = 64 * n + 32 * half + r32; f32x16 a[2], hf[2], hb[2]; float At, Bt;
        lru_gates(F, XD, n, 0, half, a, hf); chunk_scan<false, true>(a, hf, hi, CAR[ch], At, Bt);
        __builtin_amdgcn_sched_barrier(0); lru_gates(F, XD, n, 1, half, a, hb); chunk_scan<true, true>(a, hb, hi, CAR[512 + ch], At, Bt);
        const bf16* gp = P1 + (size_t)r0 * O_IN + 768; bf16* yp = Y + (size_t)r0 * D + 512;
#pragma unroll
        for (int mt = 0; mt < 2; ++mt)
#pragma unroll
            for (int q = 0; q < 4; ++q) {
#pragma unroll
                for (int k = 0; k < 4; ++k) { const unsigned rl = (unsigned)(32 * mt + 8 * q + 4 * hi + k); const float gt = bf2f(gp[rl * (unsigned)O_IN + (unsigned)ch]);
                    yp[rl * (unsigned)D + (unsigned)ch] = f2bf16((hf[mt][4 * q + k] + hb[mt][4 * q + k]) * gelu_tanh(gt)); }
                asm volatile("" ::: "memory"); } }
    LDS_WAIT(); __syncthreads();
}
__device__ __forceinline__ void ph15_router(Frame& F) {
    LAS float* WR = (LAS float*)(F.lds + RING_OFF);
    LAS int* lcnt = (LAS int*)(F.lds + RING_OFF + 32768); LAS int* lbase = lcnt + 8; LAS int* rec = lcnt + 16;
    const int lane = F.lane; const float* MOD = (const float*)(F.ws + WS_MOD) + (size_t)3 * 6 * D; bf16* XN = (bf16*)(F.ws + WS_XN); int* TOK = (int*)(F.ws + WS_TOK);
    for (int i = F.tid; i < 1024 * 8 / 4; i += NWAVES * 64) ((LAS f32x4*)WR)[i] = ((const GAS f32x4*)F.in[I_RW])[i];
    __syncthreads();
    for (int rb = F.vcu; rb < ML / 64; rb += F.G) {
        if (F.tid < 8) lcnt[F.tid] = 0;
        __syncthreads();
#pragma unroll 1
        for (int i = 0; i < 8; ++i) { const int m = rb * 64 + F.wave * 8 + i, s = m >> 13; f32x4 t[4];
            normmod_row(F.out + (size_t)m * D, F.in[I_NFFNG] + D, MOD + s * 6 * D + 4 * D, MOD + s * 6 * D + 3 * D, XN + (size_t)m * D, lane, t);
            float lg[8];
#pragma unroll
            for (int e = 0; e < 8; ++e) lg[e] = 0.f;
#pragma unroll
            for (int j = 0; j < 4; ++j)
#pragma unroll
                for (int k = 0; k < 4; ++k) { const int c = 4 * lane + 256 * j + k; const f32x4 w0 = *(const LAS f32x4*)(WR + c * 8), w1 = *(const LAS f32x4*)(WR + c * 8 + 4); const float tv = t[j][k];
                    lg[0] += tv * w0.x; lg[1] += tv * w0.y; lg[2] += tv * w0.z; lg[3] += tv * w0.w; lg[4] += tv * w1.x; lg[5] += tv * w1.y; lg[6] += tv * w1.z; lg[7] += tv * w1.w; }
#pragma unroll
            for (int e = 0; e < 8; ++e) lg[e] = wave_sum(lg[e]) + F.in[I_RB][e];
            int e1 = 0; float v1 = lg[0];
#pragma unroll
            for (int e = 1; e < 8; ++e) if (lg[e] > v1) { v1 = lg[e]; e1 = e; }
            int e2 = -1; float v2 = -INFINITY;
#pragma unroll
            for (int e = 0; e < 8; ++e) if (e != e1 && lg[e] > v2) { v2 = lg[e]; e2 = e; }
            const float g1 = 1.0f / (1.0f + expf(v2 - v1)), g2 = 1.0f - g1;
            if (lane == 0) { LAS int* rc = rec + (F.wave * 8 + i) * 6; rc[0] = e1; rc[1] = e2; rc[2] = atomicAdd((int*)(lcnt + e1), 1); rc[3] = atomicAdd((int*)(lcnt + e2), 1); rc[4] = __float_as_int(g1); rc[5] = __float_as_int(g2); }
        }
        __syncthreads();
        if (F.tid < 8) lbase[F.tid] = (int)__hip_atomic_fetch_add((unsigned*)(F.ctl + CW_CNT + 64 * F.tid), (unsigned)lcnt[F.tid], __ATOMIC_RELAXED, __HIP_MEMORY_SCOPE_AGENT);
        __syncthreads();
        if (F.tid < 64) { const LAS int* rc = rec + F.tid * 6; int* tk = TOK + (size_t)(rb * 64 + F.tid) * 6;
            tk[0] = rc[0]; tk[1] = rc[1]; tk[2] = lbase[rc[0]] + rc[2]; tk[3] = lbase[rc[1]] + rc[3]; tk[4] = rc[4]; tk[5] = rc[5]; }
        __syncthreads();
    }
}
__device__ __forceinline__ void moe_offsets(Frame& F, int (&off)[9]) {
    int o = 0;
#pragma unroll
    for (int e = 0; e < 8; ++e) { off[e] = o; const int c = (int)__hip_atomic_load((unsigned*)(F.ctl + CW_CNT + 64 * e), __ATOMIC_RELAXED, __HIP_MEMORY_SCOPE_AGENT); o += (c + 255) & ~255; }
    off[8] = o;
}
__device__ __forceinline__ void ph16_gather(Frame& F) {
    int off[9]; moe_offsets(F, off);
    const int gw = F.vcu * NWAVES + F.wave, NGW = F.G * NWAVES, lane = F.lane; const bf16* XN = (const bf16*)(F.ws + WS_XN); unsigned char* XG = F.ws + WS_XG; const int* TOK = (const int*)(F.ws + WS_TOK);
    for (int p = gw; p < 2 * ML; p += NGW) { const int tok = p >> 1, k = p & 1; const int e = TOK[(size_t)tok * 6 + k], pos = TOK[(size_t)tok * 6 + 2 + k];
        int base = 0;
#pragma unroll
        for (int q = 0; q < 8; ++q) base = (e == q) ? off[q] : base;
        const GAS v4u* src = (const GAS v4u*)(XN + (size_t)tok * D + 16 * lane); const v4u a = src[0], b = src[1]; float f[8], g[8]; unpack8(a, f); unpack8(b, g);
        v4u o; o.x = pg8::cvt4_fp8(f[0], f[1], f[2], f[3]); o.y = pg8::cvt4_fp8(f[4], f[5], f[6], f[7]); o.z = pg8::cvt4_fp8(g[0], g[1], g[2], g[3]); o.w = pg8::cvt4_fp8(g[4], g[5], g[6], g[7]);
        *(GAS v4u*)(XG + (size_t)(base + pos) * D + 16 * lane) = o; }
}
__device__ __forceinline__ int moe_tables(Frame& F) {
    int off[9]; moe_offsets(F, off); LAS int* pexp = (LAS int*)(F.lds + PEXP_OFF);
    if (F.tid < MOE_PAN) { const int r = F.tid * 256; int e = 0;
#pragma unroll
        for (int q = 1; q < 8; ++q) e = (r >= off[q]) ? q : e;
        pexp[F.tid] = e; }
    __syncthreads();
    return off[8] / 256;
}
__device__ __forceinline__ void ph19_combine(Frame& F) {
    int off[9]; moe_offsets(F, off);
    const int gw = F.vcu * NWAVES + F.wave, NGW = F.G * NWAVES, lane = F.lane; const bf16* YG = (const bf16*)(F.ws + WS_YG); const int* TOK = (const int*)(F.ws + WS_TOK);
    const float* MOD = (const float*)(F.ws + WS_MOD) + (size_t)3 * 6 * D;
    for (int m = gw; m < ML; m += NGW) { const int* tk = TOK + (size_t)m * 6; const int e1 = tk[0], e2 = tk[1]; int b1 = 0, b2 = 0;
#pragma unroll
        for (int q = 0; q < 8; ++q) { b1 = (e1 == q) ? off[q] : b1; b2 = (e2 == q) ? off[q] : b2; }
        const float g1 = __int_as_float(tk[4]), g2 = __int_as_float(tk[5]); const float* gp = MOD + (m >> 13) * 6 * D + 5 * D;
        const GAS v2u* y1 = (const GAS v2u*)(YG + (size_t)(b1 + tk[2]) * D) + lane; const GAS v2u* y2 = (const GAS v2u*)(YG + (size_t)(b2 + tk[3]) * D) + lane;
        GAS f32x4* o = (GAS f32x4*)(F.out + (size_t)m * D) + lane;
#pragma unroll
        for (int j = 0; j < 4; ++j) { const v2u a = y1[64 * j], b = y2[64 * j]; const f32x4 gv = ((const GAS f32x4*)gp)[lane + 64 * j]; f32x4 x = o[64 * j];
            x.x += gv.x * (g1 * bf_lo(a.x) + g2 * bf_lo(b.x)); x.y += gv.y * (g1 * bf_hi(a.x) + g2 * bf_hi(b.x)); x.z += gv.z * (g1 * bf_lo(a.y) + g2 * bf_lo(b.y)); x.w += gv.w * (g1 * bf_hi(a.y) + g2 * bf_hi(b.y));
            o[64 * j] = x; } }
}
struct Args { const float* in[38]; float* out; unsigned char* ws; int ph_lo, ph_hi; };
__global__ void __launch_bounds__(NWAVES * 64, 2) mk_fwd(Args args) {
    extern __shared__ __attribute__((aligned(16))) unsigned char lds[];
    Frame F;
    F.lds = (LAS unsigned char*)lds;
    F.MISC = (volatile LAS unsigned*)(F.lds + MISC_OFF);
    F.tid = threadIdx.x; F.lane = F.tid & 63; F.wave = __builtin_amdgcn_readfirstlane(F.tid >> 6);
    F.G = gridDim.x; { const int bx = blockIdx.x; F.vcu = (F.G % 8 == 0) ? (bx % 8) * (F.G / 8) + bx / 8 : bx; }
    F.ws = args.ws; F.out = args.out; F.ctl = (gu32*)(args.ws + WS_CTL);
    for (int u = F.tid; u < (LDS_BYTES - LDSCTL_OFF) / 4; u += NWAVES * 64) ((LAS unsigned*)(F.lds + LDSCTL_OFF))[u] = 0u;
    __syncthreads();
    XcdBarrier bar; bar.bar = (unsigned*)(F.ctl + CW_BAR); bar.x = 0; bar.st = nullptr;
    if (MK_ONE_LAUNCH) bar = xcd_barrier_post((unsigned*)(F.ctl + CW_BAR), F.MISC + 8);
#define GRID_BAR() do { if (MK_ONE_LAUNCH) xcd_barrier(bar); } while (0)
    const int lo = args.ph_lo, hi = args.ph_hi;
#define RELANE() do { int t_ = (int)threadIdx.x; asm volatile("" : "+v"(t_)); F.tid = t_; F.lane = t_ & 63; } while (0)
#define IN(k) (lo <= (k) && (k) < hi)
#define BOTH(k) (IN(k) && IN((k) + 1))
#ifndef MK_REP_MASK
#define MK_REP_MASK 0
#endif
#define REP(k) for (int rep_ = 0; rep_ < (((MK_REP_MASK >> (k)) & 1) ? 2 : 1); ++rep_)
    unsigned char* ws = args.ws;
    bf16* XN = (bf16*)(ws + WS_XN); bf16* Y = (bf16*)(ws + WS_Y); bf16* P0 = (bf16*)(ws + WS_P0); bf16* P1 = (bf16*)(ws + WS_P1); bf16* OA = (bf16*)(ws + WS_OATT); bf16* Hb = (bf16*)(ws + WS_H);
    float* XR = (float*)(ws + WS_XR); const float* MOD = (const float*)(ws + WS_MOD);
    using ABF = attn_body::bf16;

    if (IN(0)) { RELANE(); REP(0) { ph0_prologue(F); __syncthreads(); } if (BOTH(0)) GRID_BAR(); }
    if (IN(1)) { RELANE(); REP(1) ph_normmod(F, F.in[I_X], F.in[I_CTX], MR, F.in[I_NMIXG], 0, 0, D); if (BOTH(1)) GRID_BAR(); }
    if (IN(2)) { RELANE();
        pg8::Gemm g{XN, (const bf16*)(ws + WS_WE), MR, E_IN, D}; pg8::StaticOrder S; S.init(MR, E_IN, F.G, (int)blockIdx.x);
        pg8::EpiBf16<0> E{P0, E_IN, nullptr, 0, 0, 1.f};
        REP(2) pg8::gemm_phase<pg8::EpiBf16<0>, pg8::StaticOrder, PG8_ALIGN, PG8_SP2>(F.lds + RING_OFF, g, S, E);
        if (BOTH(2)) GRID_BAR();
    }
    if (IN(3)) { RELANE(); ph3_post0(F); if (BOTH(3)) GRID_BAR(); }
    if (IN(4)) { RELANE();
        const bool nomax0 = qk_bounded(F.in[I_BQNG], F.in[I_BKNG], F.lane);
        const int trslot = F.vcu % 3;
        float lam; { const int ln = F.lane; const float s1 = wave_sum(F.in[I_LQ1][ln] * F.in[I_LK1][ln]), s2 = wave_sum(F.in[I_LQ2][ln] * F.in[I_LK2][ln]); lam = expf(s1) - expf(s2) + 0.2f; }
        REP(4) for (int i = 0;; ++i) { const int L = i * F.G + F.vcu; if (L >= 256 + 8) break;
            const bool lat = L < 256; const int bh4 = lat ? (L >> 5) : (L - 256), qb = lat ? (L & 31) : 0, b = bh4 >> 2, h = bh4 & 3;
            const size_t qrow0 = lat ? (size_t)b * SEQ + (size_t)qb * 256 : (size_t)(ML + b * CTXL); const int NT = lat ? 132 : 4, rot = lat ? (F.vcu & 31) * 4 : 0;
            const ABF* Vs = (const ABF*)(ws + WS_VC0) + (size_t)(b * 8 + 2 * h) * KEYS * 64; ABF* O1 = (ABF*)(OA + qrow0 * D + 256 * h); ABF* Yo = (ABF*)(Y + qrow0 * D + 512 + 128 * h);
#pragma unroll 1
            for (int sc = 0; sc < 3; ++sc) {
                if (lat && sc == trslot && rep_ == 0) { tr_range(F, TR_DENSE, TR_NITEMS); LDS_WAIT(); __syncthreads(); }
                if (sc < 2) { const ABF* Ks = (const ABF*)(ws + WS_KC0) + (size_t)(b * 8 + 2 * h + sc) * KEYS * 64; const ABF* Q = (const ABF*)(P0 + qrow0 * E_IN + 1024 + 128 * h + 64 * sc);
                    if (sc == 1) VM_WAIT();
                    if (nomax0) attn_body::attn_unit2<-1>(Q, E_IN, Ks, Vs, Vs + (size_t)KEYS * 64, sc ? Yo : O1, D, NT, rot, (char*)lds + RING_OFF, sc == 1, O1, D, lam, F.in[I_SUBLNG], 0.8f);
                    else attn_body::attn_unit2<8>(Q, E_IN, Ks, Vs, Vs + (size_t)KEYS * 64, sc ? Yo : O1, D, NT, rot, (char*)lds + RING_OFF, sc == 1, O1, D, lam, F.in[I_SUBLNG], 0.8f); } } }
        RELANE();
        REP(4) for (int c = F.vcu - 32; c >= 0 && c < MR / 128; c += F.G) gmlp_unit(F, c);
        if (BOTH(4)) GRID_BAR();
    }
    if (IN(6)) { RELANE();
        pg8::Gemm g{Y, (const bf16*)(ws + WS_WO0), MR, D, D}; pg8::StaticOrder S; S.init(MR, D, F.G, (int)blockIdx.x);
        pg8::EpiResGate E{F.in[I_X], F.in[I_CTX], XR, MOD + 2 * D, 1.0f};
        REP(6) pg8::gemm_phase<pg8::EpiResGate, pg8::StaticOrder, PG8_ALIGN, PG8_SP2>(F.lds + RING_OFF, g, S, E);
        if (BOTH(6)) GRID_BAR();
    }
    if (IN(7)) { RELANE(); REP(7) ph_normmod<true>(F, XR, XR + (size_t)ML * D, MR, F.in[I_NFFNG], 0, 3 * D, 4 * D); if (BOTH(7)) GRID_BAR(); }
    if (IN(8)) { RELANE();
        pg8::Gemm g{XN, (const bf16*)(ws + WS_WF13), MR, FF2, D / 2}; pg8::StaticOrder S; S.init(MR, FF2, F.G, (int)blockIdx.x);
        pg8::EpiSwiGLUF8 E{(unsigned char*)Hb, FF, FF2 / 256, 1.0f / MOE_S13};
        REP(8) pg8::gemm_phase<pg8::EpiSwiGLUF8, pg8::StaticOrder, PG8_ALIGN, PG8_SP2, true>(F.lds + RING_OFF, g, S, E);
        if (BOTH(8)) GRID_BAR();
    }
    if (IN(9)) { RELANE();
        pg8::Gemm g{Hb, (const bf16*)(ws + WS_WF2), MR, D, FF / 2}; pg8::StaticOrder S; S.init(MR, D, F.G, (int)blockIdx.x);
        pg8::EpiResGate E{XR, XR + (size_t)ML * D, XR, MOD + 5 * D, 1.0f / MOE_S2};
        REP(9) pg8::gemm_phase<pg8::EpiResGate, pg8::StaticOrder, PG8_ALIGN, PG8_SP2, true>(F.lds + RING_OFF, g, S, E);
        if (BOTH(9)) GRID_BAR();
    }
    if (IN(10)) { RELANE(); REP(10) ph_normmod(F, XR, XR + (size_t)ML * D, MR, F.in[I_NMIXG] + D, 1, 0, D); if (BOTH(10)) GRID_BAR(); }
    if (IN(11)) { RELANE();
        pg8::Gemm g{XN, (const bf16*)(ws + WS_WOI), MR, O_IN, D}; pg8::StaticOrder S; S.init(MR, O_IN, F.G, (int)blockIdx.x);
        pg8::EpiBf16<0> E{P1, O_IN, nullptr, 0, 0, 1.f};
        REP(11) pg8::gemm_phase<pg8::EpiBf16<0>, pg8::StaticOrder, PG8_ALIGN, PG8_SP2>(F.lds + RING_OFF, g, S, E);
        if (BOTH(11)) GRID_BAR();
    }
    if (IN(12)) { RELANE();
        ph12_post1(F);
        REP(12) for (int c = F.vcu; c < NCHUNK; c += F.G) scan_prep_unit(F, c);
        if (BOTH(12)) GRID_BAR();
    }
    if (IN(13)) { RELANE();
        REP(13) for (int c = F.vcu; c < ML / 64; c += F.G) scan_fix_unit(F, c);
        const bool nomax1 = qk_bounded(F.in[I_CQNG], F.in[I_CKNG], F.lane);
        REP(13) for (int i = 0;; ++i) { const int L = i * F.G + F.vcu; if (L >= 512) break;
            const int bh = L >> 5, qb = L & 31, b = bh >> 3, hq = bh & 7, kv = hq >> 2;
            const size_t crow0 = (size_t)(ML + b * CTXL), lrow0 = (size_t)b * SEQ, qrow0 = lrow0 + (size_t)qb * 256;
            const ABF* Ks = (const ABF*)(ws + WS_KC1) + (size_t)(b * 2 + kv) * KEYS * 64; const ABF* Vs = (const ABF*)(ws + WS_VC1) + (size_t)(b * 2 + kv) * KEYS * 64;
            if (nomax1) attn_body::attn_unit<-1, true>((const ABF*)(P1 + qrow0 * O_IN + 64 * hq), O_IN, Ks, Ks + 4 * 4096, 64, Vs, Vs + 4 * 4096, 64, (ABF*)(Y + qrow0 * D + 64 * hq), D, 132, 4, (F.vcu & 31) * 4, (char*)lds + RING_OFF);
            else attn_body::attn_unit<8, true>((const ABF*)(P1 + qrow0 * O_IN + 64 * hq), O_IN, Ks, Ks + 4 * 4096, 64, Vs, Vs + 4 * 4096, 64, (ABF*)(Y + qrow0 * D + 64 * hq), D, 132, 4, (F.vcu & 31) * 4, (char*)lds + RING_OFF); }
        if (BOTH(13)) GRID_BAR();
    }
    if (IN(14)) { RELANE();
        pg8::Gemm g{Y, (const bf16*)(ws + WS_WO1), ML, D, D}; pg8::StaticOrder S; S.init(ML, D, F.G, (int)blockIdx.x);
        pg8::EpiResGate E{XR, XR, F.out, MOD + 3 * 6 * D + 2 * D, 1.0f};
        REP(14) pg8::gemm_phase<pg8::EpiResGate, pg8::StaticOrder, PG8_ALIGN, PG8_SP2>(F.lds + RING_OFF, g, S, E);
        if (BOTH(14)) GRID_BAR();
    }
    if (IN(15)) { RELANE(); ph15_router(F); if (BOTH(15)) GRID_BAR(); }
    if (IN(16)) { RELANE(); REP(16) ph16_gather(F); if (BOTH(16)) GRID_BAR(); }
    if (IN(17)) { RELANE();
        const int npan = moe_tables(F);
        pg8::Gemm g{(const bf16*)(ws + WS_XG), (const bf16*)(ws + WS_WM13), MOE_ROWS, NEXP * FF2, D / 2}; pg8::MoeOrder S{npan, FF2 / 256, F.G, F.vcu, (const LAS int*)(F.lds + PEXP_OFF)};
        pg8::EpiSwiGLUF8 E{ws + WS_HG, FF, FF2 / 256, 1.0f / MOE_S13};
        REP(17) pg8::gemm_phase<pg8::EpiSwiGLUF8, pg8::MoeOrder, PG8_ALIGN, PG8_SP2, true>(F.lds + RING_OFF, g, S, E);
        if (BOTH(17)) GRID_BAR();
    }
    if (IN(18)) { RELANE();
        const int npan = moe_tables(F);
        pg8::Gemm g{(const bf16*)(ws + WS_HG), (const bf16*)(ws + WS_WM2), MOE_ROWS, NEXP * D, FF / 2}; pg8::MoeOrder S{npan, D / 256, F.G, F.vcu, (const LAS int*)(F.lds + PEXP_OFF)};
        pg8::EpiBf16S E{(bf16*)(ws + WS_YG), D, D / 256, 1.0f / MOE_S2};
        REP(18) pg8::gemm_phase<pg8::EpiBf16S, pg8::MoeOrder, PG8_ALIGN, PG8_SP2, true>(F.lds + RING_OFF, g, S, E);
        if (BOTH(18)) GRID_BAR();
    }
    if (IN(19)) { RELANE(); ph19_combine(F); }
#undef IN
#undef BOTH
#undef GRID_BAR
}

extern "C" void kernel_launch(void* const* d_in, const int* in_sizes, int n_in, void* d_out, int out_size, void* d_ws, size_t ws_size, hipStream_t stream) {
    static int grid = 0;
    if (grid == 0) {
        if (n_in != 38 || in_sizes[0] != ML * D || out_size != ML * D || ws_size < WS_END) { fprintf(stderr, "kernel_launch: built for 38 inputs, x/out of %d floats, >= %zu bytes of workspace; got n_in %d, in0 %d, out %d, ws %zu; nothing launched\n", ML * D, (size_t)WS_END, n_in, n_in > 0 ? in_sizes[0] : -1, out_size, ws_size); grid = -1; return; }
        int dev = 0, cus = 0, per_cu = 0;
        if (hipGetDevice(&dev) != hipSuccess || hipDeviceGetAttribute(&cus, hipDeviceAttributeMultiprocessorCount, dev) != hipSuccess) { fprintf(stderr, "kernel_launch: device query failed\n"); grid = -1; return; }
        if (hipFuncSetAttribute((const void*)mk_fwd, hipFuncAttributeMaxDynamicSharedMemorySize, LDS_BYTES) != hipSuccess) { fprintf(stderr, "kernel_launch: hipFuncSetAttribute failed\n"); grid = -1; return; }
        if (hipOccupancyMaxActiveBlocksPerMultiprocessor(&per_cu, (const void*)mk_fwd, NWAVES * 64, LDS_BYTES) != hipSuccess || per_cu < 1) fprintf(stderr, "kernel_launch: note: occupancy query reports %d workgroups per CU\n", per_cu);
        (void)hipGetLastError();
        grid = cus;
    }
    if (grid < 0) return;
    if (hipMemsetAsync((char*)d_ws + WS_CTL, 0, CTL_ZERO_BYTES, stream) != hipSuccess) { fprintf(stderr, "kernel_launch: hipMemsetAsync failed\n"); return; }
    Args a{};
    for (int i = 0; i < 38; ++i) a.in[i] = (const float*)d_in[i];
    a.out = (float*)d_out; a.ws = (unsigned char*)d_ws;
#if MK_ONE_LAUNCH
    a.ph_lo = 0; a.ph_hi = NPH;
    hipLaunchKernelGGL(mk_fwd, dim3(grid), dim3(NWAVES * 64), LDS_BYTES, stream, a);
#else
    for (int ph = 0; ph < NPH; ++ph) { a.ph_lo = ph; a.ph_hi = ph + 1; hipLaunchKernelGGL(mk_fwd, dim3(grid), dim3(NWAVES * 64), LDS_BYTES, stream, a); }
#endif
    const hipError_t le = hipPeekAtLastError();
    if (le != hipSuccess) fprintf(stderr, "kernel_launch: launch failed: %s\n", hipGetErrorName(le));
}
```

```cpp
#include <hip/hip_runtime.h>
#include <cstdio>
#include <cstdint>
#include <cmath>
namespace pg8 {
#define PG8_LAS __attribute__((address_space(3)))
typedef unsigned short bf16_t;
typedef short bf16x8 __attribute__((ext_vector_type(8)));
typedef float f32x4 __attribute__((ext_vector_type(4)));
typedef unsigned u32x4 __attribute__((ext_vector_type(4)));
typedef int i32x4 __attribute__((ext_vector_type(4)));
typedef int i32x8 __attribute__((ext_vector_type(8)));
typedef unsigned u32x2 __attribute__((ext_vector_type(2)));
constexpr int BM = 256, BK = 64, HALF = 128, HTB = HALF * BK * 2  , STAGE_BYTES = 8 * HTB, NXCD = 8, WGM = 8;

__host__ __device__ __forceinline__ int lds_byte(int r, int c) { const int st = (r >> 4) * 2 + (c >> 5), rr = r & 15, cc = c & 31, ob = rr * 64 + cc * 2; return st * 1024 + (ob ^ (((ob >> 9) & 1) << 5)); }
__host__ __device__ __forceinline__ void stage_rc(int b, int& R, int& C) { const int st = b / 1024, sb = b % 1024, swz = sb ^ (((sb >> 9) & 1) << 5); R = (st >> 1) * 16 + swz / 64; C = (st & 1) * 32 + (swz % 64) / 2; }
__host__ __device__ __forceinline__ int perm32(int rho) { const int n = rho >> 4, i = rho & 15; return 8 * (i >> 2) + 4 * n + (i & 3); }

struct Unit { int pm, pn, pa; };
struct Gemm { const bf16_t* A; const bf16_t* Bt; int M, N, K; };

struct StaticOrder {
    int nM, nN, nwg, G, c;
    __host__ __device__ void init(int M, int N, int G_, int c_) { nM = M / BM; nN = N / BM; nwg = nM * nN; G = G_; c = c_; }
    __host__ __device__ bool next(int i, Unit& u) const {
        const long L = (long)i * G + c; if (L >= nwg) return false;
        int wgid = (int)L; { const int q = nwg / NXCD, r = nwg % NXCD, xcd = wgid % NXCD, off = wgid / NXCD; wgid = (xcd < r ? xcd * (q + 1) : r * (q + 1) + (xcd - r) * q) + off; }
        const int nig = WGM * nN, gid = wgid / nig, fm = gid * WGM, gsz = (nM - fm) < WGM ? (nM - fm) : WGM;
        u.pm = fm + ((wgid % nig) % gsz); u.pn = (wgid % nig) / gsz; u.pa = u.pm; return true;
    }
    __device__ __forceinline__ void a_ready(const Unit&) const {}
    __device__ __forceinline__ void done(const Unit&) const {}
};

__device__ __forceinline__ unsigned cvt_pk_bf16(float lo, float hi) { unsigned r; asm volatile("v_cvt_pk_bf16_f32 %0, %1, %2" : "=v"(r) : "v"(lo), "v"(hi)); return r; }
typedef float f32x2 __attribute__((ext_vector_type(2)));
__device__ __forceinline__ f32x2 gelu_pk(f32x2 v) {
    const f32x2 av = __builtin_elementwise_abs(v), d = av * 0.2316418882f + 1.0f;
    f32x2 t; t.x = __builtin_amdgcn_rcpf(d.x); t.y = __builtin_amdgcn_rcpf(d.y);
    f32x2 q = t * 0.5307027145f + (-0.7265760135f); q = q * t + 0.7107068705f; q = q * t + (-0.142248368f); q = q * t + 0.127414796f; q = q * t;
    const f32x2 s = (v * v) * (-0.72134752044f);
    f32x2 e; e.x = __builtin_amdgcn_exp2f(s.x); e.y = __builtin_amdgcn_exp2f(s.y);
    const f32x2 m = v * (q * e), r = v - m;
    f32x2 o; o.x = v.x < 0.f ? m.x : r.x; o.y = v.y < 0.f ? m.y : r.y; return o;
}

template <int ACT  > struct EpiBf16 {
    static constexpr bool PERM = true, AFTER_DRAIN = false; static_assert(ACT == 0 || ACT == 1, "EpiBf16: ACT is 0 (none) or 1 (gelu_pk)");
    bf16_t* O; int ldc; const float* bias; int split_cols; size_t split_stride; float scale0;
    __device__ __forceinline__ void operator()(const f32x4 (&acc)[2][2][4][2], const Unit& u, int wr, int wc, int fr, int fq) const {
        const int row0 = u.pm * BM + wr * 64 + fr; int colt = u.pn * BM; bf16_t* base = O;
        float sc = 1.f; if (split_cols) { const int t = colt / split_cols; base += (size_t)t * split_stride; colt -= t * split_cols; if (t == 0) sc = scale0; }
        const int col0 = colt + wc * 32 + 8 * fq, bcol0 = u.pn * BM + wc * 32 + 8 * fq;
        f32x4 bv[2][2];
#pragma unroll
        for (int bj = 0; bj < 2; ++bj)
#pragma unroll
            for (int n = 0; n < 2; ++n) bv[bj][n] = bias ? *(const f32x4*)(bias + bcol0 + bj * HALF + 4 * n) : (f32x4){0.f, 0.f, 0.f, 0.f};
#pragma unroll
        for (int ai = 0; ai < 2; ++ai)
#pragma unroll
            for (int m = 0; m < 4; ++m) { bf16_t* rowp = base + (size_t)(row0 + ai * HALF + m * 16) * ldc + col0;
#pragma unroll
                for (int bj = 0; bj < 2; ++bj) { f32x4 v0 = acc[ai][bj][m][0] + bv[bj][0], v1 = acc[ai][bj][m][1] + bv[bj][1];
                    if (ACT == 1) { f32x2 a = gelu_pk((f32x2){v0[0], v0[1]}), b = gelu_pk((f32x2){v0[2], v0[3]}), c = gelu_pk((f32x2){v1[0], v1[1]}), d = gelu_pk((f32x2){v1[2], v1[3]});
                        v0 = (f32x4){a.x, a.y, b.x, b.y}; v1 = (f32x4){c.x, c.y, d.x, d.y}; }
                    v0 = v0 * sc; v1 = v1 * sc; u32x4 w; w.x = cvt_pk_bf16(v0[0], v0[1]); w.y = cvt_pk_bf16(v0[2], v0[3]); w.z = cvt_pk_bf16(v1[0], v1[1]); w.w = cvt_pk_bf16(v1[2], v1[3]);
                    *(u32x4*)(rowp + bj * HALF) = w; } }
    }
};
struct EpiResGate {
    static constexpr bool PERM = false, AFTER_DRAIN = false;
    const float* baseL; const float* baseC; float* out; const float* gate; float ascale;
    __device__ __forceinline__ void operator()(const f32x4 (&acc)[2][2][4][2], const Unit& u, int wr, int wc, int fr, int fq) const {
        const int s = u.pm < 32 ? 0 : (u.pm < 64 ? 1 : 2);
        const float* gp = gate + s * 6144;
        const float* base = u.pm < 64 ? baseL + (size_t)u.pm * BM * 1024 : baseC + (size_t)(u.pm - 64) * BM * 1024;
        float* o = out + (size_t)u.pm * BM * 1024;
        const int col0 = u.pn * BM + wc * 32 + 4 * fq;
        f32x4 gv[2][2];
#pragma unroll
        for (int bj = 0; bj < 2; ++bj)
#pragma unroll
            for (int n = 0; n < 2; ++n) gv[bj][n] = *(const f32x4*)(gp + col0 + bj * HALF + n * 16) * ascale;
#pragma unroll
        for (int ai = 0; ai < 2; ++ai)
#pragma unroll
            for (int m = 0; m < 4; ++m) { const size_t off = (size_t)(ai * HALF + wr * 64 + m * 16 + fr) * 1024 + col0;
#pragma unroll
                for (int bj = 0; bj < 2; ++bj)
#pragma unroll
                    for (int n = 0; n < 2; ++n) { const f32x4 bs = *(const f32x4*)(base + off + bj * HALF + n * 16); *(f32x4*)(o + off + bj * HALF + n * 16) = bs + gv[bj][n] * acc[ai][bj][m][n]; }
                if (m & 1) asm volatile("" ::: "memory"); }
    }
};
struct EpiSwiGLU {
    static constexpr bool PERM = true, AFTER_DRAIN = false;
    bf16_t* H; int ldh; int ntl;
    __device__ __forceinline__ void operator()(const f32x4 (&acc)[2][2][4][2], const Unit& u, int wr, int wc, int fr, int fq) const {
        const int row0 = u.pm * BM + wr * 64 + fr; const int ct = u.pn % ntl; const int col0 = ct * HALF + wc * 32 + 8 * fq;
#pragma unroll
        for (int ai = 0; ai < 2; ++ai)
#pragma unroll
            for (int m = 0; m < 4; ++m) { bf16_t* rowp = H + (size_t)(row0 + ai * HALF + m * 16) * ldh + col0;
                float hv[8];
#pragma unroll
                for (int n = 0; n < 2; ++n)
#pragma unroll
                    for (int j = 0; j < 4; ++j) { const float a = acc[ai][0][m][n][j], b = acc[ai][1][m][n][j];
                        const float e = __builtin_amdgcn_exp2f(a * -1.4426950408889634f); hv[n * 4 + j] = a * __builtin_amdgcn_rcpf(1.0f + e) * b; }
                u32x4 w; w.x = cvt_pk_bf16(hv[0], hv[1]); w.y = cvt_pk_bf16(hv[2], hv[3]); w.z = cvt_pk_bf16(hv[4], hv[5]); w.w = cvt_pk_bf16(hv[6], hv[7]);
                *(u32x4*)rowp = w; }
    }
};
__device__ __forceinline__ unsigned cvt4_fp8(float a, float b, float c, float d) { unsigned w = 0u; w = (unsigned)__builtin_amdgcn_cvt_pk_fp8_f32(a, b, (int)w, false); w = (unsigned)__builtin_amdgcn_cvt_pk_fp8_f32(c, d, (int)w, true); return w; }
struct EpiSwiGLUF8 {
    static constexpr bool PERM = true, AFTER_DRAIN = false;
    unsigned char* H; int ldh; int ntl; float s;
    __device__ __forceinline__ void operator()(const f32x4 (&acc)[2][2][4][2], const Unit& u, int wr, int wc, int fr, int fq) const {
        const int row0 = u.pm * BM + wr * 64 + fr; const int ct = u.pn % ntl; const int col0 = ct * HALF + wc * 32 + 8 * fq;
#pragma unroll
        for (int ai = 0; ai < 2; ++ai)
#pragma unroll
            for (int m = 0; m < 4; ++m) { unsigned char* rowp = H + (size_t)(row0 + ai * HALF + m * 16) * ldh + col0;
                float hv[8];
#pragma unroll
                for (int n = 0; n < 2; ++n)
#pragma unroll
                    for (int j = 0; j < 4; ++j) { const float a = acc[ai][0][m][n][j], b = acc[ai][1][m][n][j];
                        const float e = __builtin_amdgcn_exp2f(a * (s * -1.4426950408889634f)); hv[n * 4 + j] = (a * b) * (s * s) * __builtin_amdgcn_rcpf(1.0f + e); }
                u32x2 w; w.x = cvt4_fp8(hv[0], hv[1], hv[2], hv[3]); w.y = cvt4_fp8(hv[4], hv[5], hv[6], hv[7]);
                *(u32x2*)rowp = w; }
    }
};
struct EpiBf16S {
    static constexpr bool PERM = true, AFTER_DRAIN = false;
    bf16_t* O; int ldc; int ntl; float s;
    __device__ __forceinline__ void operator()(const f32x4 (&acc)[2][2][4][2], const Unit& u, int wr, int wc, int fr, int fq) const {
        const int row0 = u.pm * BM + wr * 64 + fr; const int col0 = (u.pn % ntl) * BM + wc * 32 + 8 * fq;
#pragma unroll
        for (int ai = 0; ai < 2; ++ai)
#pragma unroll
            for (int m = 0; m < 4; ++m) { bf16_t* rowp = O + (size_t)(row0 + ai * HALF + m * 16) * ldc + col0;
#pragma unroll
                for (int bj = 0; bj < 2; ++bj) { const f32x4 v0 = acc[ai][bj][m][0] * s, v1 = acc[ai][bj][m][1] * s;
                    u32x4 w; w.x = cvt_pk_bf16(v0[0], v0[1]); w.y = cvt_pk_bf16(v0[2], v0[3]); w.z = cvt_pk_bf16(v1[0], v1[1]); w.w = cvt_pk_bf16(v1[2], v1[3]);
                    *(u32x4*)(rowp + bj * HALF) = w; } }
    }
};
struct MoeOrder {
    int npan, ntl, G, c; const PG8_LAS int* pexp; bool capA;
    __device__ __forceinline__ bool next(int i, Unit& u) const {
        const long L = (long)i * G + c; if (L >= (long)npan * ntl) return false;
        const int pm = (int)(L / ntl), j = (int)(L % ntl); const int e = __builtin_amdgcn_readfirstlane(pexp[pm]); u.pm = pm; u.pn = e * ntl + j; u.pa = capA ? 64 * e + pm - __builtin_amdgcn_readfirstlane(pexp[140 + e]) : pm; return true;
    }
    __device__ __forceinline__ void a_ready(const Unit&) const {}
    __device__ __forceinline__ void done(const Unit&) const {}
};
template <class Epi, class Sched, bool ALIGN_EPI = false, bool SP2 = false, bool FP8 = false>
__device__ __forceinline__ void gemm_phase(PG8_LAS unsigned char* lds, const Gemm g, const Sched& S, const Epi& E) {
    const int tid = threadIdx.x, wid = __builtin_amdgcn_readfirstlane(tid >> 6), lane = tid & 63, wr = wid >> 2, wc = wid & 3, fr = lane & 15, fq = lane >> 4;
    const int K = g.K, nt = K / BK;
    unsigned voffA[2], voffB[2];
#pragma unroll
    for (int i = 0; i < 2; ++i) { int R, C; stage_rc(tid * 16 + i * 8192, R, C); const int Rb = Epi::PERM ? ((R & ~31) + perm32(R & 31)) : R;
        voffA[i] = (unsigned)(R * K + C) * 2u; voffB[i] = (unsigned)(Rb * K + C) * 2u; }
    const size_t kstep = (size_t)(BK * 2);
    const size_t hstep = (size_t)HALF * K * 2;
    const size_t tstep = 2 * hstep;
    const unsigned ldsw = (unsigned)wid * 1024u;
    const int aoff = lds_byte(wr * 64 + fr, fq * 8), boff = lds_byte(wc * 32 + fr, fq * 8);
#define PG8_SA(b, h) (((b) * 2 + (h)) * HTB)
#define PG8_SB(b, h) ((4 + (b) * 2 + (h)) * HTB)
#define PG8_STAGE(bufoff, gbase, voff) do { _Pragma("unroll") for (int _i = 0; _i < 2; ++_i) \
        __builtin_amdgcn_global_load_lds((const unsigned*)((const char*)(gbase) + (voff)[_i]), (PG8_LAS unsigned*)(lds + (bufoff) + ldsw + _i * 8192), 16, 0, 0); } while (0)
#define PG8_CAT(x, y) __builtin_shufflevector(__builtin_bit_cast(i32x4, x), __builtin_bit_cast(i32x4, y), 0, 1, 2, 3, 4, 5, 6, 7)
#define PG8_LDA(dst, b, h) do { if constexpr (FP8) { _Pragma("unroll") for (int m = 0; m < 4; ++m) dst##8[m] = PG8_CAT(*(const PG8_LAS bf16x8*)(lds + PG8_SA(b, h) + aoff + m * 2048), *(const PG8_LAS bf16x8*)(lds + PG8_SA(b, h) + aoff + m * 2048 + 1024)); } else { \
        _Pragma("unroll") for (int m = 0; m < 4; ++m) _Pragma("unroll") for (int k = 0; k < 2; ++k) dst[m][k] = *(const PG8_LAS bf16x8*)(lds + PG8_SA(b, h) + aoff + m * 2048 + k * 1024); } } while (0)
#define PG8_LDB(dst, b, h) do { if constexpr (FP8) { _Pragma("unroll") for (int n = 0; n < 2; ++n) dst##8[n] = PG8_CAT(*(const PG8_LAS bf16x8*)(lds + PG8_SB(b, h) + boff + n * 2048), *(const PG8_LAS bf16x8*)(lds + PG8_SB(b, h) + boff + n * 2048 + 1024)); } else { \
        _Pragma("unroll") for (int n = 0; n < 2; ++n) _Pragma("unroll") for (int k = 0; k < 2; ++k) dst[n][k] = *(const PG8_LAS bf16x8*)(lds + PG8_SB(b, h) + boff + n * 2048 + k * 1024); } } while (0)
#define PG8_MMA(ai, bj, At, Bt) do { __builtin_amdgcn_s_setprio(1); if constexpr (FP8) { _Pragma("unroll") for (int m = 0; m < 4; ++m) _Pragma("unroll") for (int n = 0; n < 2; ++n) \
        asm volatile("v_mfma_f32_16x16x128_f8f6f4 %0, %1, %2, %0" : "+v"(acc[ai][bj][m][n]) : "v"(Bt##8[n]), "v"(At##8[m]));   } else { \
        _Pragma("unroll") for (int m = 0; m < 4; ++m) _Pragma("unroll") for (int n = 0; n < 2; ++n) _Pragma("unroll") for (int k = 0; k < 2; ++k) \
        acc[ai][bj][m][n] = __builtin_amdgcn_mfma_f32_16x16x32_bf16(Bt[n][k], At[m][k], acc[ai][bj][m][n], 0, 0, 0); } __builtin_amdgcn_s_setprio(0); } while (0)
#define PG8_WAIT_V(n) asm volatile("s_waitcnt vmcnt(" #n ")" ::: "memory")
#define PG8_WAIT_L(n) asm volatile("s_waitcnt lgkmcnt(" #n ")" ::: "memory")
#define PG8_BAR __builtin_amdgcn_s_barrier()
#define PG8_SCHED __builtin_amdgcn_sched_barrier(0)
    Unit cur, nxt; int ui = 0;
    if (!S.next(0, cur)) return;
    f32x4 acc[2][2][4][2];
#pragma unroll
    for (int a = 0; a < 2; ++a)
#pragma unroll
        for (int b = 0; b < 2; ++b)
#pragma unroll
            for (int m = 0; m < 4; ++m)
#pragma unroll
                for (int n = 0; n < 2; ++n) acc[a][b][m][n] = (f32x4){0.f, 0.f, 0.f, 0.f};
    bf16x8 At[4][2], B0[2][2], B1[2][2]; i32x8 At8[4], B08[2], B18[2];
    const char* cA = (const char*)g.A + (size_t)cur.pa * tstep; const char* cB = (const char*)g.Bt + (size_t)cur.pn * tstep;
    S.a_ready(cur);
    if constexpr (SP2) {
        PG8_STAGE(PG8_SB(0, 0), cB, voffB); PG8_STAGE(PG8_SB(0, 1), cB + hstep, voffB); PG8_STAGE(PG8_SA(0, 0), cA, voffA); PG8_STAGE(PG8_SA(0, 1), cA + hstep, voffA);
        if (wr == 1) PG8_BAR;
        PG8_WAIT_V(2); PG8_BAR;
        PG8_STAGE(PG8_SB(1, 0), cB + kstep, voffB); PG8_STAGE(PG8_SA(1, 0), cA + kstep, voffA); PG8_STAGE(PG8_SB(1, 1), cB + hstep + kstep, voffB);
        PG8_WAIT_V(6); PG8_BAR;
    } else {
        PG8_STAGE(PG8_SB(0, 0), cB, voffB); PG8_STAGE(PG8_SA(0, 0), cA, voffA); PG8_STAGE(PG8_SB(0, 1), cB + hstep, voffB); PG8_STAGE(PG8_SA(0, 1), cA + hstep, voffA);
        if (wr == 1) PG8_BAR;
        PG8_WAIT_V(4); PG8_BAR;
        PG8_STAGE(PG8_SB(1, 0), cB + kstep, voffB); PG8_STAGE(PG8_SA(1, 0), cA + kstep, voffA); PG8_STAGE(PG8_SB(1, 1), cB + hstep + kstep, voffB);
        PG8_WAIT_V(6); PG8_BAR;
    }
    for (;;) {
        const bool has_next = S.next(ui + 1, nxt);
        const char* nA = has_next ? (const char*)g.A + (size_t)nxt.pa * tstep : cA; const char* nB = has_next ? (const char*)g.Bt + (size_t)nxt.pn * tstep : cB;
#pragma unroll 1
        for (int t = 0; t < nt; t += 2) {
            const bool last = (t == nt - 2);
            const char* a1 = cA + (size_t)(t + 1) * kstep;
            const char* a2 = last ? nA : cA + (size_t)(t + 2) * kstep; const char* b2 = last ? nB : cB + (size_t)(t + 2) * kstep;
            const char* a3 = a2 + kstep; const char* b3 = b2 + kstep;
            if (last && has_next) S.a_ready(nxt);
            if constexpr (SP2) {
            PG8_LDB(B0, 0, 0); PG8_LDB(B1, 0, 1); PG8_SCHED; PG8_LDA(At, 0, 0); PG8_STAGE(PG8_SA(1, 1), a1 + hstep, voffA);
            PG8_WAIT_V(8); PG8_WAIT_L(0); PG8_BAR; PG8_MMA(0, 0, At, B0); PG8_MMA(0, 1, At, B1); PG8_BAR; PG8_SCHED;
            PG8_LDA(At, 0, 1); PG8_STAGE(PG8_SB(0, 0), b2, voffB); PG8_STAGE(PG8_SB(0, 1), b2 + hstep, voffB); PG8_STAGE(PG8_SA(0, 0), a2, voffA);
            PG8_WAIT_V(8); PG8_WAIT_L(0); PG8_BAR; PG8_MMA(1, 0, At, B0); PG8_MMA(1, 1, At, B1); PG8_BAR; PG8_SCHED;
            PG8_LDB(B0, 1, 0); PG8_LDB(B1, 1, 1); PG8_SCHED; PG8_LDA(At, 1, 0); PG8_STAGE(PG8_SA(0, 1), a2 + hstep, voffA);
            PG8_WAIT_V(8); PG8_WAIT_L(0); PG8_BAR; PG8_MMA(0, 0, At, B0); PG8_MMA(0, 1, At, B1); PG8_BAR; PG8_SCHED;
            PG8_LDA(At, 1, 1); PG8_STAGE(PG8_SB(1, 0), b3, voffB); PG8_STAGE(PG8_SB(1, 1), b3 + hstep, voffB); PG8_STAGE(PG8_SA(1, 0), a3, voffA);
            PG8_WAIT_V(8); PG8_WAIT_L(0); PG8_BAR; PG8_MMA(1, 0, At, B0); PG8_MMA(1, 1, At, B1); PG8_BAR; PG8_SCHED;
            } else {
            PG8_LDB(B0, 0, 0); PG8_SCHED; PG8_LDA(At, 0, 0); PG8_STAGE(PG8_SA(1, 1), a1 + hstep, voffA);
            PG8_WAIT_L(8); PG8_BAR; PG8_WAIT_L(0); PG8_MMA(0, 0, At, B0); PG8_BAR; PG8_SCHED;
            PG8_LDB(B1, 0, 1); PG8_STAGE(PG8_SB(0, 0), b2, voffB);
            PG8_BAR; PG8_WAIT_L(0); PG8_MMA(0, 1, At, B1); PG8_BAR;
            PG8_LDA(At, 0, 1); PG8_STAGE(PG8_SA(0, 0), a2, voffA);
            PG8_BAR; PG8_WAIT_L(0); PG8_MMA(1, 0, At, B0); PG8_BAR; PG8_SCHED;
            PG8_STAGE(PG8_SB(0, 1), b2 + hstep, voffB);
            PG8_WAIT_V(6); PG8_BAR; PG8_MMA(1, 1, At, B1); PG8_BAR;
            PG8_LDB(B0, 1, 0); PG8_SCHED; PG8_LDA(At, 1, 0); PG8_STAGE(PG8_SA(0, 1), a2 + hstep, voffA);
            PG8_WAIT_L(8); PG8_BAR; PG8_WAIT_L(0); PG8_MMA(0, 0, At, B0); PG8_BAR; PG8_SCHED;
            PG8_LDB(B1, 1, 1); PG8_STAGE(PG8_SB(1, 0), b3, voffB);
            PG8_BAR; PG8_WAIT_L(0); PG8_MMA(0, 1, At, B1); PG8_BAR;
            PG8_LDA(At, 1, 1); PG8_STAGE(PG8_SA(1, 0), a3, voffA);
            PG8_BAR; PG8_WAIT_L(0); PG8_MMA(1, 0, At, B0); PG8_BAR; PG8_SCHED;
            PG8_STAGE(PG8_SB(1, 1), b3 + hstep, voffB);
            PG8_WAIT_V(6); PG8_BAR; PG8_MMA(1, 1, At, B1); PG8_BAR;
            }
        }
        if constexpr (FP8) asm volatile("s_nop 15\n\ts_nop 15" ::: "memory");
        if constexpr (ALIGN_EPI) { if (wr == 0) PG8_BAR; }
        if constexpr (!Epi::AFTER_DRAIN) { E(acc, cur, wr, wc, fr, fq); S.done(cur); }
        if (!has_next) break;
#pragma unroll
        for (int a = 0; a < 2; ++a)
#pragma unroll
            for (int b = 0; b < 2; ++b)
#pragma unroll
                for (int m = 0; m < 4; ++m)
#pragma unroll
                    for (int n = 0; n < 2; ++n) acc[a][b][m][n] = (f32x4){0.f, 0.f, 0.f, 0.f};
        cur = nxt; cA = nA; cB = nB; ++ui;
        if constexpr (ALIGN_EPI) { if (wr == 1) PG8_BAR; }
    }
    PG8_WAIT_V(0);
    if constexpr (!ALIGN_EPI) { if (wr == 0) PG8_BAR; }
    PG8_BAR;
    if constexpr (Epi::AFTER_DRAIN) { E.fused(acc, cur, wr, wc, fr, fq, lds, wid, lane); S.done(cur); }
#undef PG8_SA
#undef PG8_SB
#undef PG8_STAGE
#undef PG8_LDA
#undef PG8_LDB
#undef PG8_MMA
#undef PG8_CAT
#undef PG8_WAIT_V
#undef PG8_WAIT_L
#undef PG8_BAR
#undef PG8_SCHED
}
}

#ifndef PG8_SP2
#define PG8_SP2 true
#endif
#ifndef PG8_ALIGN
#define PG8_ALIGN true
#endif
#include <hip/hip_bf16.h>
#include <cmath>
namespace attn_body {
using bf16=__hip_bfloat16;
using bf16x8=__attribute__((ext_vector_type(8)))short;
using s16x4=__attribute__((ext_vector_type(4)))short;
using f32x16=__attribute__((ext_vector_type(16)))float;
using u32x4=__attribute__((ext_vector_type(4)))unsigned;
constexpr int D=64;
constexpr int NW=8,QBLK=32,QB=QBLK*NW,KVBLK=64;
constexpr int ATTN_UNIT_ROWS=QB;
__device__ __forceinline__ int crow(int r,int hi){return (r&3)+8*(r>>2)+4*hi;}
#define SBAR() __builtin_amdgcn_sched_barrier(0)
__device__ __forceinline__ void cmask(f32x16&p0,f32x16&p1,int jb,int qrel,int hi){
  const float NEG=-INFINITY; int kb=64*jb+4*hi;
  #pragma unroll
  for(int r=0;r<16;++r){int kv=kb+(r&3)+8*(r>>2); if(kv>qrel)p0[r]=NEG; if(kv+32>qrel)p1[r]=NEG;}
}

constexpr int NSLOT=3, SLOTB=8192;
constexpr int LDS_K=0, LDS_V=NSLOT*SLOTB, LDS_WS=2*NSLOT*SLOTB, LDS_OST=LDS_WS+NW*64*4, LDS_BYTES=LDS_OST+NW*4096;
constexpr float C2=0.125f*1.4426950408889634f;
__device__ __forceinline__ void glds16s(const void*sbase,unsigned voff,unsigned lds_dst){
  asm volatile("s_mov_b32 m0, %2\n\ts_nop 0\n\tglobal_load_lds_dwordx4 %0, %1"::"v"(voff),"s"(sbase),"s"(lds_dst):"memory","m0");}
__device__ __forceinline__ void glds16(const void*gsrc,unsigned lds_dst){unsigned keep;
  asm volatile("s_mov_b32 %0, m0\n\ts_mov_b32 m0, %2\n\ts_nop 0\n\tglobal_load_lds_dwordx4 %1, off\n\ts_mov_b32 m0, %0":"=&s"(keep):"v"(gsrc),"s"(lds_dst):"memory");}
__device__ __forceinline__ float max3f(float a,float b,float c){float r;asm("v_max3_f32 %0, %1, %2, %3":"=v"(r):"v"(a),"v"(b),"v"(c));return r;}
__device__ __forceinline__ float max2f(float a,float b){float r;asm("v_max_f32_e32 %0, %1, %2":"=v"(r):"v"(a),"v"(b));return r;}
__device__ __forceinline__ float fadd_s(float a,float b){float r;asm("v_add_f32_e32 %0, %1, %2":"=v"(r):"v"(a),"v"(b));return r;}
__device__ __forceinline__ float fsub_s(float a,float b){float r;asm("v_sub_f32_e32 %0, %1, %2":"=v"(r):"v"(a),"v"(b));return r;}
typedef float f32x2_t __attribute__((ext_vector_type(2))); typedef __bf16 bf16x2_t __attribute__((ext_vector_type(2)));
__device__ __forceinline__ unsigned cvtpk_s(float lo,float hi){f32x2_t v={lo,hi};bf16x2_t b=__builtin_convertvector(v,bf16x2_t);return __builtin_bit_cast(unsigned,b);}
#define WAIT_BAR(N) asm volatile("s_waitcnt vmcnt(" #N ") lgkmcnt(0)\n\ts_barrier":::"memory")

__device__ __forceinline__ void qkt(f32x16&p0,f32x16&p1,const char*Kslot,const bf16x8*qr,const f32x16&negm,int r32,int hi){
  const char*kb=Kslot+hi*1024+r32*16;
  #pragma unroll
  for(int d0=0;d0<4;++d0){
    const bf16x8 b0=*reinterpret_cast<const bf16x8*>(kb+d0*2048);
    const bf16x8 b1=*reinterpret_cast<const bf16x8*>(kb+d0*2048+512);
    if(d0==0){p0=__builtin_amdgcn_mfma_f32_32x32x16_bf16(b0,qr[0],negm,0,0,0);p1=__builtin_amdgcn_mfma_f32_32x32x16_bf16(b1,qr[0],negm,0,0,0);}
    else{p0=__builtin_amdgcn_mfma_f32_32x32x16_bf16(b0,qr[d0],p0,0,0,0);p1=__builtin_amdgcn_mfma_f32_32x32x16_bf16(b1,qr[d0],p1,0,0,0);}}
}
typedef __attribute__((address_space(3))) const char* lds_cptr;
typedef short v4i16_t __attribute__((ext_vector_type(4)));
__device__ __forceinline__ void kload8(bf16x8*kf,lds_cptr kp){
  kf[0]=*(const __attribute__((address_space(3))) bf16x8*)(kp);      kf[1]=*(const __attribute__((address_space(3))) bf16x8*)(kp+512);
  kf[2]=*(const __attribute__((address_space(3))) bf16x8*)(kp+2048); kf[3]=*(const __attribute__((address_space(3))) bf16x8*)(kp+2560);
  kf[4]=*(const __attribute__((address_space(3))) bf16x8*)(kp+4096); kf[5]=*(const __attribute__((address_space(3))) bf16x8*)(kp+4608);
  kf[6]=*(const __attribute__((address_space(3))) bf16x8*)(kp+6144); kf[7]=*(const __attribute__((address_space(3))) bf16x8*)(kp+6656);
}
__device__ __forceinline__ void kload2(bf16x8*kf,lds_cptr kp,int j){ kf[2*j]=*(const __attribute__((address_space(3))) bf16x8*)(kp+j*2048); kf[2*j+1]=*(const __attribute__((address_space(3))) bf16x8*)(kp+j*2048+512); }
__device__ __forceinline__ s16x4 vtr(lds_cptr p){ return __builtin_bit_cast(s16x4,__builtin_amdgcn_ds_read_tr16_b64_v4i16((__attribute__((address_space(3))) v4i16_t*)p)); }
__device__ __forceinline__ float rowmax(const f32x16&p0,const f32x16&p1){
  float a=max3f(p0[0],p0[1],p1[0]),b=max3f(p0[2],p0[3],p1[1]);a=max3f(a,p1[2],p1[3]);
  #pragma unroll
  for(int r=4;r<16;r+=4){a=max3f(a,p0[r],p0[r+1]);b=max3f(b,p0[r+2],p0[r+3]);a=max3f(a,p1[r],p1[r+1]);b=max3f(b,p1[r+2],p1[r+3]);}
  const float m=max2f(a,b);
  auto rr=__builtin_amdgcn_permlane32_swap(__float_as_uint(m),__float_as_uint(m),false,false);
  return max2f(__uint_as_float(rr[0]),__uint_as_float(rr[1]));
}
__device__ __forceinline__ void pv(f32x16*o,int vb,bf16x8 pa0,bf16x8 pa1,bf16x8 pa2,bf16x8 pa3){
  #pragma unroll
  for(int d0=0;d0<2;++d0){s16x4 lo[4],hi[4];
    #pragma unroll
    for(int ks=0;ks<4;++ks){
      asm volatile("ds_read_b64_tr_b16 %0,%1 offset:%c2":"=&v"(lo[ks]):"v"(vb),"i"(d0*4096+ks*1024):"memory");
      asm volatile("ds_read_b64_tr_b16 %0,%1 offset:%c2":"=&v"(hi[ks]):"v"(vb),"i"(d0*4096+ks*1024+512):"memory");}
    asm volatile("s_waitcnt lgkmcnt(0)":::"memory");SBAR();
    #define PK(k) (bf16x8){lo[k][0],lo[k][1],lo[k][2],lo[k][3],hi[k][0],hi[k][1],hi[k][2],hi[k][3]}
    o[d0]=__builtin_amdgcn_mfma_f32_32x32x16_bf16(pa0,PK(0),o[d0],0,0,0);
    o[d0]=__builtin_amdgcn_mfma_f32_32x32x16_bf16(pa1,PK(1),o[d0],0,0,0);
    o[d0]=__builtin_amdgcn_mfma_f32_32x32x16_bf16(pa2,PK(2),o[d0],0,0,0);
    o[d0]=__builtin_amdgcn_mfma_f32_32x32x16_bf16(pa3,PK(3),o[d0],0,0,0);
    #undef PK
  }
}

#ifndef ATTN_STORE16
#define ATTN_STORE16(p,v) (*(u32x4*)(p)=(v))
#endif
template<int THRL,bool TILED> __device__ __forceinline__ void attn_unit(const bf16*Qu,int qp,const bf16*__restrict__ Kc,const bf16*__restrict__ Kl,int kp,const bf16*__restrict__ Vc,const bf16*__restrict__ Vl,int vp,bf16*Ou,int op,int NT,int NCT,int rot,char*shm){
  const int tid=threadIdx.x,lane=tid&63,r32=lane&31,hi=lane>>5; const int wid=__builtin_amdgcn_readfirstlane(tid>>6);
  const bf16*Qw=Qu+(long)(wid*QBLK)*qp;
  const unsigned lds0=(unsigned)(uintptr_t)shm;
  float*wsf=(float*)(shm+LDS_WS)+wid*64;
  const long koff=TILED?(long)(wid*512+lane*8):((long)lane*kp+wid*8); const bf16*ksrc_c=Kc+koff; const bf16*ksrc_l=Kl+koff-(long)NCT*KVBLK*kp;
  const long voff=TILED?(long)(wid*512+lane*8):((long)(16*(wid&3)+(lane>>2))*vp+(wid>>2)*32+(lane&3)*8); const bf16*vsrc_c=Vc+voff; const bf16*vsrc_l=Vl+voff-(long)NCT*KVBLK*vp;
  const unsigned kdst=lds0+LDS_K+wid*1024, vdst=lds0+LDS_V+wid*1024;
  #define ROTT(t) (t)
  const unsigned koffb1=(unsigned)(wid*512+lane*8)*2u;
  #define DMA_K(t,slot) do{ if constexpr(TILED) glds16s(Kc+(long)ROTT(t)*4096,koffb1,(unsigned)__builtin_amdgcn_readfirstlane(kdst+(slot))); else glds16((ROTT(t)<NCT?ksrc_c:ksrc_l)+(long)ROTT(t)*KVBLK*kp,(unsigned)__builtin_amdgcn_readfirstlane(kdst+(slot))); }while(0)
  #define DMA_V(t,slot) do{ if constexpr(TILED) glds16s(Vc+(long)ROTT(t)*4096,koffb1,(unsigned)__builtin_amdgcn_readfirstlane(vdst+(slot))); else glds16((ROTT(t)<NCT?vsrc_c:vsrc_l)+(long)ROTT(t)*KVBLK*vp,(unsigned)__builtin_amdgcn_readfirstlane(vdst+(slot))); }while(0)
  const int vb0=(int)(lds0+LDS_V)+((lane>>4)&1)*32+(lane&3)*8+(4*hi+((lane&15)>>2))*64;
  const char*Kbase=shm+LDS_K; bf16x8 kf[8];
  const lds_cptr shm3=(lds_cptr)shm; const lds_cptr kp0=shm3+LDS_K+hi*1024+r32*16; const lds_cptr vp0=shm3+LDS_V+((lane>>4)&1)*32+(lane&3)*8+(4*hi+((lane&15)>>2))*64;
  DMA_K(0,0);DMA_V(0,0);DMA_K(1,SLOTB);
  bf16x8 qr[4];
  #pragma unroll
  for(int d0=0;d0<4;++d0)qr[d0]=*reinterpret_cast<const bf16x8*>(&Qw[(long)r32*qp+d0*16+hi*8]);
  float mhat=0.f,l_reg=0.f;f32x16 o[2];o[0]=f32x16{};o[1]=f32x16{};f32x16 negm=f32x16{};if constexpr(THRL>=0)asm volatile("":"+v"(negm));
  #define CMASK(P0,P1,t) do{}while(0)
  bool resc=false;
  #define START(P0,P1) do{ resc=false; if constexpr(THRL>=0) \
    { const float rm=rowmax(P0,P1); const float dl=rm; mhat=fadd_s(mhat,dl); \
      _Pragma("unroll") for(int r=0;r<16;++r){P0[r]=fsub_s(P0[r],dl);P1[r]=fsub_s(P1[r],dl);} \
      _Pragma("unroll") for(int r=0;r<16;++r)negm[r]=-mhat; asm volatile("":"+v"(negm)); } \
    _Pragma("unroll") for(int r=0;r<16;++r)P0[r]=__builtin_amdgcn_exp2f(P0[r]); }while(0)
  #define RESC() do{ if constexpr(THRL>=0) if(resc){ asm volatile("s_waitcnt lgkmcnt(0)":::"memory"); \
      _Pragma("unroll") for(int d_=0;d_<2;++d_) _Pragma("unroll") for(int r=0;r<16;++r)o[d_][r]*=wsf[crow(r,hi)]; } }while(0)
  f32x16 pA0,pA1,pB0,pB1;
  int sl_prev=0,sl_cur=0,sl_next=SLOTB;
  #define ROT() do{sl_prev=sl_cur;sl_cur=sl_next;sl_next=(sl_next==(NSLOT-1)*SLOTB)?0:sl_next+SLOTB;}while(0)
  DMA_K(2,2*SLOTB);
  WAIT_BAR(3);
  qkt(pA0,pA1,Kbase,qr,negm,r32,hi);asm volatile("s_nop 15\n\ts_nop 7":"+v"(pA0),"+v"(pA1));CMASK(pA0,pA1,0);
  START(pA0,pA1);
  _Pragma("unroll") for(int r=0;r<16;++r)pA1[r]=__builtin_amdgcn_exp2f(pA1[r]);
  WAIT_BAR(0);
  DMA_K(3,0);DMA_V(1,SLOTB);
  ROT();
  kload8(kf,kp0+sl_cur);
  WAIT_BAR(2);
  s16x4 vlo[8],vhi[8]; u32x4 pw0,pw1,pw2,pw3;
  #define PKW(P,B) cvtpk_s(P[B],P[B+1])
  #define PAF(k) __builtin_bit_cast(bf16x8,pw##k)
  #define VFR(i) (bf16x8){vlo[i][0],vlo[i][1],vlo[i][2],vlo[i][3],vhi[i][0],vhi[i][1],vhi[i][2],vhi[i][3]}
  #define PIN(x) asm volatile("":"+v"(x))
  #define MX3(a,b,c) __builtin_fmaxf(__builtin_fmaxf((a),(b)),(c))
  #define GAPA(MF,A0,A1,A2,A3,W0,W1,PW) do{ MF; sacc+=A0; sacc+=A1; sacc+=A2; sacc+=A3; PIN(sacc); W0; W1; PIN(PW); SBAR(); }while(0)
  #define EX(v) __builtin_amdgcn_exp2f(v)
  #define GAPB(MF,X,B) do{ MF; X[B]=EX(X[B]); X[B+1]=EX(X[B+1]); X[B+2]=EX(X[B+2]); X[B+3]=EX(X[B+3]); PIN(X); SBAR(); }while(0)
  #define VRD(i) do{ vlo[i]=vtr(vp_+(((i)>>2)*4096+((i)&3)*1024)); vhi[i]=vtr(vp_+(((i)>>2)*4096+((i)&3)*1024+512)); }while(0)
  #define KRD(G,j) do{ if(G){ kload2(kf,kp0+sl_next,j); SBAR(); } }while(0)
  #define STEP(C0,C1,P0,P1,t,GK,GV,GL) do{ SBAR(); \
    const lds_cptr vp_=vp0+sl_prev; \
    VRD(0); SBAR(); float sacc=(P0[0]+P0[1]); \
    GAPA(C0=__builtin_amdgcn_mfma_f32_32x32x16_bf16(kf[0],qr[0],negm,0,0,0), P0[2],P0[3],P0[4],P0[5],     pw0[0]=PKW(P0,0), pw0[1]=PKW(P0,2), pw0); \
    VRD(4); SBAR(); GAPA(C1=__builtin_amdgcn_mfma_f32_32x32x16_bf16(kf[1],qr[0],negm,0,0,0), P0[6],P0[7],P0[8],P0[9],     pw0[2]=PKW(P0,4), pw0[3]=PKW(P0,6), pw0); \
    VRD(1); SBAR(); GAPA(C0=__builtin_amdgcn_mfma_f32_32x32x16_bf16(kf[2],qr[1],C0,0,0,0),   P0[10],P0[11],P0[12],P0[13], pw1[0]=PKW(P0,8), pw1[1]=PKW(P0,10), pw1); \
    VRD(5); SBAR(); GAPA(C1=__builtin_amdgcn_mfma_f32_32x32x16_bf16(kf[3],qr[1],C1,0,0,0),   P0[14],P0[15],P1[0],P1[1],   pw1[2]=PKW(P0,12),pw1[3]=PKW(P0,14), pw1); \
    VRD(2); SBAR(); GAPA(C0=__builtin_amdgcn_mfma_f32_32x32x16_bf16(kf[4],qr[2],C0,0,0,0),   P1[2],P1[3],P1[4],P1[5],     pw2[0]=PKW(P1,0), pw2[1]=PKW(P1,2), pw2); \
    VRD(6); SBAR(); GAPA(C1=__builtin_amdgcn_mfma_f32_32x32x16_bf16(kf[5],qr[2],C1,0,0,0),   P1[6],P1[7],P1[8],P1[9],     pw2[2]=PKW(P1,4), pw2[3]=PKW(P1,6), pw2); \
    VRD(3); SBAR(); GAPA(C0=__builtin_amdgcn_mfma_f32_32x32x16_bf16(kf[6],qr[3],C0,0,0,0),   P1[10],P1[11],P1[12],P1[13], pw3[0]=PKW(P1,8), pw3[1]=PKW(P1,10), pw3); \
    VRD(7); SBAR(); GAPA(C1=__builtin_amdgcn_mfma_f32_32x32x16_bf16(kf[7],qr[3],C1,0,0,0),   P1[14],P1[15],0.f,0.f,       pw3[2]=PKW(P1,12),pw3[3]=PKW(P1,14), pw3); \
    l_reg+=sacc; \
    if(GK){DMA_K((t)+3,sl_cur);} if(GV){DMA_V((t)+1,sl_next);} \
    CMASK(C0,C1,t); \
    if constexpr(THRL>=0){ float a=MX3(C0[0],C0[1],C1[0]),b=MX3(C0[2],C0[3],C1[1]); a=MX3(a,C1[2],C1[3]); \
      _Pragma("unroll") for(int r=4;r<16;r+=4){a=MX3(a,C0[r],C0[r+1]);b=MX3(b,C0[r+2],C0[r+3]);a=MX3(a,C1[r],C1[r+1]);b=MX3(b,C1[r+2],C1[r+3]);} \
      float rm=__builtin_fmaxf(a,b); { auto rr=__builtin_amdgcn_permlane32_swap(__float_as_uint(rm),__float_as_uint(rm),false,false); rm=__builtin_fmaxf(__uint_as_float(rr[0]),__uint_as_float(rr[1])); } \
      resc=false; \
      if(__builtin_expect(__any(rm>(float)THRL),0)){ const float dl=__builtin_fmaxf(rm,0.f); mhat+=dl; \
        _Pragma("unroll") for(int r=0;r<16;++r){C0[r]-=dl;C1[r]-=dl;} \
        _Pragma("unroll") for(int r=0;r<16;++r)negm[r]=-mhat; asm volatile("":"+v"(negm)); \
        const float f=__builtin_amdgcn_exp2f(-dl); l_reg*=f; if(hi==0)wsf[r32]=f; resc=true; } } \
    SBAR(); \
    GAPB(o[0]=__builtin_amdgcn_mfma_f32_32x32x16_bf16(PAF(0),VFR(0),o[0],0,0,0), C0,0); \
    GAPB(o[1]=__builtin_amdgcn_mfma_f32_32x32x16_bf16(PAF(0),VFR(4),o[1],0,0,0), C0,4); \
    KRD(GL,0); GAPB(o[0]=__builtin_amdgcn_mfma_f32_32x32x16_bf16(PAF(1),VFR(1),o[0],0,0,0), C0,8); \
    KRD(GL,1); GAPB(o[1]=__builtin_amdgcn_mfma_f32_32x32x16_bf16(PAF(1),VFR(5),o[1],0,0,0), C0,12); \
    KRD(GL,2); GAPB(o[0]=__builtin_amdgcn_mfma_f32_32x32x16_bf16(PAF(2),VFR(2),o[0],0,0,0), C1,0); \
    KRD(GL,3); GAPB(o[1]=__builtin_amdgcn_mfma_f32_32x32x16_bf16(PAF(2),VFR(6),o[1],0,0,0), C1,4); \
    GAPB(o[0]=__builtin_amdgcn_mfma_f32_32x32x16_bf16(PAF(3),VFR(3),o[0],0,0,0), C1,8); \
    GAPB(o[1]=__builtin_amdgcn_mfma_f32_32x32x16_bf16(PAF(3),VFR(7),o[1],0,0,0), C1,12); \
    }while(0)
  int t=1;
  #undef CMASK
  #define CMASK(P0,P1,t) do{}while(0)
  for(;t+5<NT;t+=2){
    STEP(pB0,pB1,pA0,pA1,t,true,true,true);     WAIT_BAR(2); RESC(); ROT();
    STEP(pA0,pA1,pB0,pB1,t+1,true,true,true);   WAIT_BAR(2); RESC(); ROT();
  }
  #undef CMASK
  #define CMASK(P0,P1,t) do{}while(0)
  #define ENDW(tt) do{ if((tt)+3<NT){WAIT_BAR(2);} else if((tt)+2<NT){WAIT_BAR(1);} else {WAIT_BAR(0);} }while(0)
  for(;t+1<NT;t+=2){
    STEP(pB0,pB1,pA0,pA1,t,(t+3<NT),(t+1<NT),(t+1<NT));       ENDW(t);   RESC(); ROT();
    STEP(pA0,pA1,pB0,pB1,t+1,(t+4<NT),(t+2<NT),(t+2<NT));     ENDW(t+1); RESC(); ROT();
  }
  STEP(pB0,pB1,pA0,pA1,NT-1,false,false,false); RESC();
  { float sacc=pB0[0]+pB0[1]; _Pragma("unroll") for(int r=2;r<16;++r)sacc+=pB0[r]; _Pragma("unroll") for(int r=0;r<16;++r)sacc+=pB1[r]; l_reg+=sacc;
    pw0=(u32x4){PKW(pB0,0),PKW(pB0,2),PKW(pB0,4),PKW(pB0,6)};pw1=(u32x4){PKW(pB0,8),PKW(pB0,10),PKW(pB0,12),PKW(pB0,14)};pw2=(u32x4){PKW(pB1,0),PKW(pB1,2),PKW(pB1,4),PKW(pB1,6)};pw3=(u32x4){PKW(pB1,8),PKW(pB1,10),PKW(pB1,12),PKW(pB1,14)};
    SBAR(); pv(o,vb0+sl_cur,PAF(0),PAF(1),PAF(2),PAF(3)); }
  #undef PKW
  #undef PAF
  #undef VFR
  #undef PIN
  #undef MX3
  #undef GAPA
  #undef GAPB
  #undef EX
  #undef VRD
  #undef KRD
  #undef STEP
  #undef ENDW
  {auto rr=__builtin_amdgcn_permlane32_swap(__float_as_uint(l_reg),__float_as_uint(l_reg),false,false);l_reg=__uint_as_float(rr[0])+__uint_as_float(rr[1]);}
  if(hi==0)wsf[32+r32]=l_reg;asm volatile("s_waitcnt lgkmcnt(0)":::"memory");
  float rli[16];
  #pragma unroll
  for(int r=0;r<16;++r)rli[r]=__builtin_amdgcn_rcpf(wsf[32+crow(r,hi)]);
  bf16*Ow=Ou+(long)(wid*QBLK)*op;
  { bf16*stg=(bf16*)(shm+LDS_OST)+wid*2048;
    #pragma unroll
    for(int r=0;r<16;++r){const int orow=crow(r,hi);
      #pragma unroll
      for(int d0=0;d0<2;++d0)stg[orow*64+d0*32+r32]=__float2bfloat16(o[d0][r]*rli[r]);}
    asm volatile("s_waitcnt lgkmcnt(0)":::"memory");
    #pragma unroll
    for(int i=0;i<4;++i){const int row=i*8+(lane>>3),ch=lane&7; const u32x4 v=*(const u32x4*)(stg+row*64+ch*8); ATTN_STORE16(Ow+(long)row*op+ch*8,v);} }
  asm volatile("s_waitcnt lgkmcnt(0)\n\ts_barrier":::"memory");
  #undef DMA_K
  #undef ROTT
  #undef DMA_V
  #undef CMASK
  #undef START
  #undef RESC
  #undef ROT
}
constexpr int LDS2_V=NSLOT*SLOTB, LDS2_WS=LDS2_V+NSLOT*2*SLOTB, LDS2_OST=LDS2_WS+NW*64*4, LDS2_BYTES=LDS2_OST+NW*4096;
template<int THRL> __device__ __forceinline__ void attn_unit2(const bf16*Qu,int qp,const bf16*__restrict__ Ks,const bf16*__restrict__ Va,const bf16*__restrict__ Vb,bf16*Ou,int op,int NT,int rot,char*shm,bool FUSE,const bf16*O1,int o1p,float lam,const float*subg,float oscale){
  const int tid=threadIdx.x,lane=tid&63,r32=lane&31,hi=lane>>5; const int wid=__builtin_amdgcn_readfirstlane(tid>>6);
  const bf16*Qw=Qu+(long)(wid*QBLK)*qp;
  const unsigned lds0=(unsigned)(uintptr_t)shm;
  float*wsf=(float*)(shm+LDS2_WS)+wid*64;
  const unsigned koffb=(unsigned)(wid*512+lane*8)*2u;
  const unsigned kdst=lds0+LDS_K+wid*1024, vdst=lds0+LDS2_V+wid*1024;
  #define ROTT(t) (t)
  #define DMA_K(t,slot) glds16s(Ks+(long)ROTT(t)*4096,koffb,(unsigned)__builtin_amdgcn_readfirstlane(kdst+(slot)))
  #define DMA_V(t,slot) do{ glds16s(Va+(long)ROTT(t)*4096,koffb,(unsigned)__builtin_amdgcn_readfirstlane(vdst+2*(slot))); glds16s(Vb+(long)ROTT(t)*4096,koffb,(unsigned)__builtin_amdgcn_readfirstlane(vdst+2*(slot)+8192)); }while(0)
  const int vb0=(int)(lds0+LDS2_V)+((lane>>4)&1)*32+(lane&3)*8+(4*hi+((lane&15)>>2))*64;
  const char*Kbase=shm+LDS_K; bf16x8 kf[8];
  const lds_cptr shm3=(lds_cptr)shm; const lds_cptr kp0=shm3+LDS_K+hi*1024+r32*16; const lds_cptr vp0=shm3+LDS2_V+((lane>>4)&1)*32+(lane&3)*8+(4*hi+((lane&15)>>2))*64;
  DMA_K(0,0);DMA_V(0,0);DMA_K(1,SLOTB);
  bf16x8 qr[4];
  #pragma unroll
  for(int d0=0;d0<4;++d0)qr[d0]=*reinterpret_cast<const bf16x8*>(&Qw[(long)r32*qp+d0*16+hi*8]);
  float mhat=0.f,l_reg=0.f;f32x16 o[4];o[0]=f32x16{};o[1]=f32x16{};o[2]=f32x16{};o[3]=f32x16{};const f32x16 zero16=f32x16{};
  #define CMASK(P0,P1,t) do{}while(0)
  bool resc=false;
  #define SUBM(x) (THRL>=0?(x)-mhat:(x))
  #define START(P0,P1) do{ resc=false; if constexpr(THRL>=0){ mhat=rowmax(P0,P1); } \
    _Pragma("unroll") for(int r=0;r<16;++r)P0[r]=__builtin_amdgcn_exp2f(SUBM(P0[r])); }while(0)
  #define RESC() do{ if constexpr(THRL>=0) if(resc){ asm volatile("s_waitcnt lgkmcnt(0)":::"memory"); \
      _Pragma("unroll") for(int d_=0;d_<4;++d_) _Pragma("unroll") for(int r=0;r<16;++r)o[d_][r]*=wsf[crow(r,hi)]; } }while(0)
  f32x16 pA0,pA1,pB0,pB1;
  int sl_prev=0,sl_cur=0,sl_next=SLOTB;
  #define ROT() do{sl_prev=sl_cur;sl_cur=sl_next;sl_next=(sl_next==(NSLOT-1)*SLOTB)?0:sl_next+SLOTB;}while(0)
  DMA_K(2,2*SLOTB);
  WAIT_BAR(4);
  qkt(pA0,pA1,Kbase,qr,zero16,r32,hi);asm volatile("s_nop 15\n\ts_nop 7":"+v"(pA0),"+v"(pA1));CMASK(pA0,pA1,0);
  START(pA0,pA1);
  _Pragma("unroll") for(int r=0;r<16;++r)pA1[r]=__builtin_amdgcn_exp2f(SUBM(pA1[r]));
  WAIT_BAR(0);
  DMA_K(3,0);DMA_V(1,SLOTB);
  ROT();
  kload8(kf,kp0+sl_cur);
  WAIT_BAR(3);
  s16x4 vlo[8],vhi[8]; u32x4 pw0,pw1,pw2,pw3;
  #define PKW(P,B) cvtpk_s(P[B],P[B+1])
  #define PAF(k) __builtin_bit_cast(bf16x8,pw##k)
  #define VFR(i) (bf16x8){vlo[i][0],vlo[i][1],vlo[i][2],vlo[i][3],vhi[i][0],vhi[i][1],vhi[i][2],vhi[i][3]}
  #define PIN(x) asm volatile("":"+v"(x))
  #define MX3(a,b,c) __builtin_fmaxf(__builtin_fmaxf((a),(b)),(c))
  #define GAPA(MF,A0,A1,A2,A3,W0,W1,PW) do{ MF; sacc+=A0; sacc+=A1; sacc+=A2; sacc+=A3; PIN(sacc); W0; W1; PIN(PW); SBAR(); }while(0)
  #define EX(v) __builtin_amdgcn_exp2f(v)
  #define GAPB(MF,X,B) do{ MF; X[B]=EX(SUBM(X[B])); X[B+1]=EX(SUBM(X[B+1])); PIN(X); SBAR(); }while(0)
  #define VRD(i) do{ vlo[i]=vtr(vp_+(((i)>>2)*4096+((i)&3)*1024)); vhi[i]=vtr(vp_+(((i)>>2)*4096+((i)&3)*1024+512)); }while(0)
  #define VRD2(i) do{ vlo[i]=vtr(vp_+(8192+((i)>>2)*4096+((i)&3)*1024)); vhi[i]=vtr(vp_+(8192+((i)>>2)*4096+((i)&3)*1024+512)); SBAR(); }while(0)
  #define KRD(G,j) do{ if(G){ kload2(kf,kp0+sl_next,j); SBAR(); } }while(0)
  #define STEP(C0,C1,P0,P1,t,GK,GV,GL) do{ SBAR(); \
    const lds_cptr vp_=vp0+2*sl_prev; \
    VRD(0); SBAR(); float sacc=(P0[0]+P0[1]); \
    GAPA(C0=__builtin_amdgcn_mfma_f32_32x32x16_bf16(kf[0],qr[0],zero16,0,0,0), P0[2],P0[3],P0[4],P0[5],     pw0[0]=PKW(P0,0), pw0[1]=PKW(P0,2), pw0); \
    VRD(4); SBAR(); GAPA(C1=__builtin_amdgcn_mfma_f32_32x32x16_bf16(kf[1],qr[0],zero16,0,0,0), P0[6],P0[7],P0[8],P0[9],     pw0[2]=PKW(P0,4), pw0[3]=PKW(P0,6), pw0); \
    VRD(1); SBAR(); GAPA(C0=__builtin_amdgcn_mfma_f32_32x32x16_bf16(kf[2],qr[1],C0,0,0,0),   P0[10],P0[11],P0[12],P0[13], pw1[0]=PKW(P0,8), pw1[1]=PKW(P0,10), pw1); \
    VRD(5); SBAR(); GAPA(C1=__builtin_amdgcn_mfma_f32_32x32x16_bf16(kf[3],qr[1],C1,0,0,0),   P0[14],P0[15],P1[0],P1[1],   pw1[2]=PKW(P0,12),pw1[3]=PKW(P0,14), pw1); \
    VRD(2); SBAR(); GAPA(C0=__builtin_amdgcn_mfma_f32_32x32x16_bf16(kf[4],qr[2],C0,0,0,0),   P1[2],P1[3],P1[4],P1[5],     pw2[0]=PKW(P1,0), pw2[1]=PKW(P1,2), pw2); \
    VRD(6); SBAR(); GAPA(C1=__builtin_amdgcn_mfma_f32_32x32x16_bf16(kf[5],qr[2],C1,0,0,0),   P1[6],P1[7],P1[8],P1[9],     pw2[2]=PKW(P1,4), pw2[3]=PKW(P1,6), pw2); \
    VRD(3); SBAR(); GAPA(C0=__builtin_amdgcn_mfma_f32_32x32x16_bf16(kf[6],qr[3],C0,0,0,0),   P1[10],P1[11],P1[12],P1[13], pw3[0]=PKW(P1,8), pw3[1]=PKW(P1,10), pw3); \
    VRD(7); SBAR(); GAPA(C1=__builtin_amdgcn_mfma_f32_32x32x16_bf16(kf[7],qr[3],C1,0,0,0),   P1[14],P1[15],0.f,0.f,       pw3[2]=PKW(P1,12),pw3[3]=PKW(P1,14), pw3); \
    l_reg+=sacc; \
    if(GK){DMA_K((t)+3,sl_cur);} if(GV){DMA_V((t)+1,sl_next);} \
    CMASK(C0,C1,t); \
    if constexpr(THRL>=0){ float a=MX3(C0[0],C0[1],C1[0]),b=MX3(C0[2],C0[3],C1[1]); a=MX3(a,C1[2],C1[3]); \
      _Pragma("unroll") for(int r=4;r<16;r+=4){a=MX3(a,C0[r],C0[r+1]);b=MX3(b,C0[r+2],C0[r+3]);a=MX3(a,C1[r],C1[r+1]);b=MX3(b,C1[r+2],C1[r+3]);} \
      float rm=__builtin_fmaxf(a,b); { auto rr=__builtin_amdgcn_permlane32_swap(__float_as_uint(rm),__float_as_uint(rm),false,false); rm=__builtin_fmaxf(__uint_as_float(rr[0]),__uint_as_float(rr[1])); } \
      resc=false; \
      rm-=mhat; \
      if(__builtin_expect(__any(rm>(float)THRL),0)){ const float dl=__builtin_fmaxf(rm,0.f); mhat+=dl; \
        const float f=__builtin_amdgcn_exp2f(-dl); l_reg*=f; if(hi==0)wsf[r32]=f; resc=true; } } \
    SBAR(); \
    GAPB(o[0]=__builtin_amdgcn_mfma_f32_32x32x16_bf16(PAF(0),VFR(0),o[0],0,0,0), C0,0); VRD2(0); \
    GAPB(o[1]=__builtin_amdgcn_mfma_f32_32x32x16_bf16(PAF(0),VFR(4),o[1],0,0,0), C0,2); VRD2(4); \
    KRD(GL,0); GAPB(o[0]=__builtin_amdgcn_mfma_f32_32x32x16_bf16(PAF(1),VFR(1),o[0],0,0,0), C0,4); VRD2(1); \
    KRD(GL,1); GAPB(o[1]=__builtin_amdgcn_mfma_f32_32x32x16_bf16(PAF(1),VFR(5),o[1],0,0,0), C0,6); VRD2(5); \
    KRD(GL,2); GAPB(o[0]=__builtin_amdgcn_mfma_f32_32x32x16_bf16(PAF(2),VFR(2),o[0],0,0,0), C0,8); VRD2(2); \
    KRD(GL,3); GAPB(o[1]=__builtin_amdgcn_mfma_f32_32x32x16_bf16(PAF(2),VFR(6),o[1],0,0,0), C0,10); VRD2(6); \
    GAPB(o[0]=__builtin_amdgcn_mfma_f32_32x32x16_bf16(PAF(3),VFR(3),o[0],0,0,0), C0,12); VRD2(3); \
    GAPB(o[1]=__builtin_amdgcn_mfma_f32_32x32x16_bf16(PAF(3),VFR(7),o[1],0,0,0), C0,14); VRD2(7); \
    GAPB(o[2]=__builtin_amdgcn_mfma_f32_32x32x16_bf16(PAF(0),VFR(0),o[2],0,0,0), C1,0); \
    GAPB(o[3]=__builtin_amdgcn_mfma_f32_32x32x16_bf16(PAF(0),VFR(4),o[3],0,0,0), C1,2); \
    GAPB(o[2]=__builtin_amdgcn_mfma_f32_32x32x16_bf16(PAF(1),VFR(1),o[2],0,0,0), C1,4); \
    GAPB(o[3]=__builtin_amdgcn_mfma_f32_32x32x16_bf16(PAF(1),VFR(5),o[3],0,0,0), C1,6); \
    GAPB(o[2]=__builtin_amdgcn_mfma_f32_32x32x16_bf16(PAF(2),VFR(2),o[2],0,0,0), C1,8); \
    GAPB(o[3]=__builtin_amdgcn_mfma_f32_32x32x16_bf16(PAF(2),VFR(6),o[3],0,0,0), C1,10); \
    GAPB(o[2]=__builtin_amdgcn_mfma_f32_32x32x16_bf16(PAF(3),VFR(3),o[2],0,0,0), C1,12); \
    GAPB(o[3]=__builtin_amdgcn_mfma_f32_32x32x16_bf16(PAF(3),VFR(7),o[3],0,0,0), C1,14); \
    }while(0)
  int t=1;
  #undef CMASK
  #define CMASK(P0,P1,t) do{}while(0)
  for(;t+5<NT;t+=2){
    STEP(pB0,pB1,pA0,pA1,t,true,true,true);     WAIT_BAR(3); RESC(); ROT();
    STEP(pA0,pA1,pB0,pB1,t+1,true,true,true);   WAIT_BAR(3); RESC(); ROT();
  }
  #undef CMASK
  #define CMASK(P0,P1,t) do{}while(0)
  #define ENDW(tt) do{ if((tt)+3<NT){WAIT_BAR(3);} else if((tt)+2<NT){WAIT_BAR(2);} else {WAIT_BAR(0);} }while(0)
  for(;t+1<NT;t+=2){
    STEP(pB0,pB1,pA0,pA1,t,(t+3<NT),(t+1<NT),(t+1<NT));       ENDW(t);   RESC(); ROT();
    STEP(pA0,pA1,pB0,pB1,t+1,(t+4<NT),(t+2<NT),(t+2<NT));     ENDW(t+1); RESC(); ROT();
  }
  STEP(pB0,pB1,pA0,pA1,NT-1,false,false,false); RESC();
  { float sacc=pB0[0]+pB0[1]; _Pragma("unroll") for(int r=2;r<16;++r)sacc+=pB0[r]; _Pragma("unroll") for(int r=0;r<16;++r)sacc+=pB1[r]; l_reg+=sacc;
    pw0=(u32x4){PKW(pB0,0),PKW(pB0,2),PKW(pB0,4),PKW(pB0,6)};pw1=(u32x4){PKW(pB0,8),PKW(pB0,10),PKW(pB0,12),PKW(pB0,14)};pw2=(u32x4){PKW(pB1,0),PKW(pB1,2),PKW(pB1,4),PKW(pB1,6)};pw3=(u32x4){PKW(pB1,8),PKW(pB1,10),PKW(pB1,12),PKW(pB1,14)};
    SBAR(); pv(o,vb0+2*sl_cur,PAF(0),PAF(1),PAF(2),PAF(3)); pv(o+2,vb0+2*sl_cur+8192,PAF(0),PAF(1),PAF(2),PAF(3)); }
  #undef PKW
  #undef PAF
  #undef VFR
  #undef PIN
  #undef MX3
  #undef GAPA
  #undef GAPB
  #undef EX
  #undef VRD
  #undef VRD2
  #undef KRD
  #undef STEP
  #undef ENDW
  {auto rr=__builtin_amdgcn_permlane32_swap(__float_as_uint(l_reg),__float_as_uint(l_reg),false,false);l_reg=__uint_as_float(rr[0])+__uint_as_float(rr[1]);}
  if(hi==0)wsf[32+r32]=l_reg;asm volatile("s_waitcnt lgkmcnt(0)":::"memory");
  float rli[16];
  #pragma unroll
  for(int r=0;r<16;++r)rli[r]=__builtin_amdgcn_rcpf(wsf[32+crow(r,hi)]);
  bf16*Ow=Ou+(long)(wid*QBLK)*op;
  { bf16*stg=(bf16*)(shm+LDS2_OST)+wid*2048;
    int lane_e=lane; asm volatile("":"+v"(lane_e));
    if(!FUSE){
    #pragma unroll
    for(int hh=0;hh<2;++hh){
      #pragma unroll
      for(int r=0;r<16;++r){const int orow=crow(r,hi);
        #pragma unroll
        for(int d0=0;d0<2;++d0)stg[orow*64+d0*32+r32]=__float2bfloat16(o[2*hh+d0][r]*rli[r]);}
      asm volatile("s_waitcnt lgkmcnt(0)":::"memory");
      #pragma unroll
      for(int i=0;i<4;++i){const int row=i*8+(lane_e>>3),ch=lane_e&7; const u32x4 v=*(const u32x4*)(stg+row*64+ch*8); ATTN_STORE16(Ow+(long)row*op+hh*64+ch*8,v);}
      asm volatile("s_waitcnt lgkmcnt(0)":::"memory"); }
    } else {
    const bf16*O1w=O1+(long)(wid*QBLK)*o1p; float dd[2][4][8]; float ssq[4]={0.f,0.f,0.f,0.f};
    #pragma unroll
    for(int hh=0;hh<2;++hh){
      #pragma unroll
      for(int r=0;r<16;++r){const int orow=crow(r,hi);
        #pragma unroll
        for(int d0=0;d0<2;++d0)stg[orow*64+d0*32+r32]=__float2bfloat16(o[2*hh+d0][r]*rli[r]);}
      asm volatile("s_waitcnt lgkmcnt(0)":::"memory");
      #pragma unroll
      for(int i=0;i<4;++i){const int row=i*8+(lane_e>>3),ch=lane_e&7; const u32x4 v2=*(const u32x4*)(stg+row*64+ch*8); const u32x4 v1=*(const u32x4*)(O1w+(long)row*o1p+hh*64+ch*8);
        #pragma unroll
        for(int e=0;e<4;++e){ const float a0=__uint_as_float(v1[e]<<16),a1=__uint_as_float(v1[e]&0xffff0000u),b0=__uint_as_float(v2[e]<<16),b1=__uint_as_float(v2[e]&0xffff0000u);
          const float x0=a0-lam*b0,x1=a1-lam*b1; dd[hh][i][2*e]=x0; dd[hh][i][2*e+1]=x1; ssq[i]+=x0*x0+x1*x1; } }
      asm volatile("s_waitcnt lgkmcnt(0)":::"memory"); }
    #pragma unroll
    for(int i=0;i<4;++i){ float t=ssq[i]; t+=__shfl_xor(t,1); t+=__shfl_xor(t,2); t+=__shfl_xor(t,4); const float rs=oscale/sqrtf(t*(1.0f/128.0f)+1e-6f); const int row=i*8+(lane_e>>3),ch=lane_e&7;
      #pragma unroll
      for(int hh=0;hh<2;++hh){ const float*gp=subg+hh*64+ch*8; u32x4 w;
        #pragma unroll
        for(int e=0;e<4;++e)w[e]=cvtpk_s(dd[hh][i][2*e]*rs*gp[2*e],dd[hh][i][2*e+1]*rs*gp[2*e+1]);
        ATTN_STORE16(Ow+(long)row*op+hh*64+ch*8,w);} }
    } }
  asm volatile("s_waitcnt lgkmcnt(0)\n\ts_barrier":::"memory");
  #undef DMA_K
  #undef ROTT
  #undef DMA_V
  #undef CMASK
  #undef START
  #undef RESC
  #undef ROT
}
constexpr int ATTN_LDS_BYTES=LDS_BYTES;
#undef SBAR
#undef WAIT_BAR
}
constexpr int NWAVES = 8;
#ifndef MK_ONE_LAUNCH
#define MK_ONE_LAUNCH 1
#endif
constexpr int NPH = 20;

constexpr int D = 1024, NB = 2, SEQ = 8192, CTXL = 256;
constexpr int ML = NB * SEQ, MC = NB * CTXL, MR = ML + MC;
constexpr int E_IN = 2560, O_IN = 1792, FF = 2816, FF2 = 2 * FF, NEXP = 8;
constexpr int MOE_ROWS = 2 * ML + NEXP * 256, MOE_PAN = MOE_ROWS / 256;
constexpr int NCHUNK = MR / 64;
constexpr float EPS = 1e-6f;
constexpr float MOE_S13 = 32.0f, MOE_S2 = 64.0f;
constexpr float QSCALE = 0.125f * 1.4426950408889634f;

constexpr size_t MiB = 1u << 20, KiB = 1u << 10;
constexpr size_t WS_CTL = 0, CTL_ZERO_BYTES = 1 * MiB;
constexpr size_t WS_MOD = 1 * MiB;
constexpr size_t WS_WG = 1 * MiB + 256 * KiB;
constexpr size_t WS_TOK = 2 * MiB;
constexpr size_t WS_AGG = 4 * MiB;
constexpr size_t WS_WM13 = 8 * MiB, WS_WM2 = 96 * MiB;
constexpr size_t WS_WE = 140 * MiB, WS_WO0 = 145 * MiB, WS_WO1 = 147 * MiB, WS_WF13 = 149 * MiB, WS_WF2 = 160 * MiB, WS_WOI = 166 * MiB;
constexpr size_t WS_XR = 170 * MiB;
constexpr size_t WS_KC0 = 170 * MiB, WS_VC0 = 187 * MiB;
constexpr size_t WS_KC1 = 427 * MiB, WS_VC1 = 432 * MiB;
constexpr int KEYS = CTXL + SEQ;
constexpr size_t WS_XN = 236 * MiB;
constexpr size_t WS_Y = 269 * MiB;
constexpr size_t WS_P0 = 302 * MiB;
constexpr size_t WS_OATT = 385 * MiB;
constexpr size_t WS_H = 302 * MiB;
constexpr size_t WS_P1 = 302 * MiB;
constexpr size_t WS_RI = 360 * MiB;
constexpr size_t WS_XG = 234 * MiB;
constexpr size_t WS_HG = 140 * MiB;
constexpr size_t WS_YG = 368 * MiB;
constexpr size_t WS_END = 436 * MiB;
static_assert(WS_WM13 + (size_t)NEXP * FF2 * D * 2 <= WS_WM2 && WS_WM2 + (size_t)NEXP * D * FF * 2 <= WS_WE && WS_WE + (size_t)E_IN * D * 2 <= WS_WO0 && WS_WF13 + (size_t)FF2 * D * 2 <= WS_WF2 &&
              WS_WF2 + (size_t)D * FF * 2 <= WS_WOI && WS_WOI + (size_t)O_IN * D * 2 <= WS_XR && WS_XR + (size_t)MR * D * 4 <= WS_XN && WS_XN + (size_t)MR * D * 2 <= WS_Y && WS_Y + (size_t)MR * D * 2 <= WS_P0 &&
              WS_P0 + (size_t)MR * E_IN * 2 <= WS_OATT && WS_OATT + (size_t)MR * D * 2 <= WS_END && WS_H + (size_t)MR * FF * 2 <= WS_END && WS_P1 + (size_t)MR * O_IN * 2 <= WS_RI &&
              WS_RI + (size_t)4 * MR * 512 * 2 <= WS_END && WS_XG + (size_t)NEXP * ML * D <= WS_YG && WS_HG + (size_t)MOE_ROWS * FF <= WS_XG && WS_AGG + (size_t)2 * NCHUNK * 2 * 512 * 4 <= WS_WM13, "d_ws map");
constexpr int CW_TMO = 0, CW_CODE = 1;
constexpr int CW_BAR = 4096;
constexpr int CW_CNT = 8192;
constexpr int RING_OFF = 0, RING_BYTES = 131072;
constexpr int LDSCTL_OFF = RING_BYTES, MISC_OFF = LDSCTL_OFF + 320;
constexpr int PEXP_OFF = LDSCTL_OFF + 1024;
constexpr int LDS_BYTES = 147456;
#define GAS __attribute__((address_space(1)))
#define LAS __attribute__((address_space(3)))
typedef unsigned short bf16;
typedef unsigned v4u __attribute__((ext_vector_type(4)));
typedef float f32x4 __attribute__((ext_vector_type(4)));
typedef short bf16x8 __attribute__((ext_vector_type(8)));
typedef GAS unsigned gu32;
typedef GAS unsigned long long gu64;
#define RLX_AGENT __ATOMIC_RELAXED, __HIP_MEMORY_SCOPE_AGENT
#define LDS_WAIT() asm volatile("s_waitcnt lgkmcnt(0)" ::: "memory")
#define VM_WAIT() asm volatile("s_waitcnt vmcnt(0)" ::: "memory")
__device__ __forceinline__ unsigned long long rt() { return __builtin_amdgcn_s_memrealtime(); }
__device__ __forceinline__ unsigned f2bf(float f) { unsigned u = __builtin_bit_cast(unsigned, f); return (u + 0x7fffu + ((u >> 16) & 1u)) >> 16; }
__device__ __forceinline__ unsigned pk2(float lo, float hi) { return f2bf(lo) | (f2bf(hi) << 16); }

#define XB_TMO      128
#define XB_XCNT(j)  (256  + 64 * (j))
#define XB_XSUB(j)  (1280 + 64 * (j))
#define XB_XGEN(j)  (2304 + 64 * (j))
#define XB_TOP      3328
#define XB_TOPGEN   3392
#define XCD_BAR_WORDS 3456
#define XB_SPIN_CAP (1u << 18)

__device__ __forceinline__ unsigned xb_ld(unsigned* p)              { return __hip_atomic_load(p, __ATOMIC_RELAXED, __HIP_MEMORY_SCOPE_AGENT); }
__device__ __forceinline__ unsigned xb_add(unsigned* p, unsigned v) { return __hip_atomic_fetch_add(p, v, __ATOMIC_RELAXED, __HIP_MEMORY_SCOPE_AGENT); }
__device__ __forceinline__ unsigned xb_xcc_id() { return (unsigned)__builtin_amdgcn_s_getreg((3 << 11) | 20) & 0xFu; }
#define XB_SPIN(cond, bar) do { unsigned _sp = 0; while (cond) { __builtin_amdgcn_s_sleep(1); \
    if ((++_sp & 255u) == 0u) { if (xb_ld(&(bar)[XB_TMO])) break; if (_sp > XB_SPIN_CAP) { atomicAdd(&(bar)[XB_TMO], 1u); break; } } } } while (0)

struct XcdBarrier {
    unsigned* bar; unsigned x;
    volatile LAS unsigned* st;
};

__device__ __forceinline__ XcdBarrier xcd_barrier_post(unsigned* bar, volatile LAS unsigned* st) {
    XcdBarrier b; b.bar = bar; b.x = xb_xcc_id(); b.st = st;
    if (threadIdx.x == 0) (void)xb_add(&bar[XB_XCNT(b.x)], 1u);
    return b;
}
__device__ __forceinline__ void xcd_barrier_complete(unsigned* bar, unsigned x, unsigned& nloc, unsigned& nx) {
    const unsigned G = gridDim.x * gridDim.y * gridDim.z;
    unsigned sum, cnt, mine, sp = 0u;
    for (;;) {
        sum = 0u; cnt = 0u; mine = 0u;
#pragma unroll
        for (unsigned j = 0; j < 16; ++j) { const unsigned c = xb_ld(&bar[XB_XCNT(j)]); sum += c; cnt += (c > 0u) ? 1u : 0u; mine = (j == x) ? c : mine; }
        if (sum == G) break;
        __builtin_amdgcn_s_sleep(1);
        if ((++sp & 255u) == 0u) { if (xb_ld(&bar[XB_TMO])) break; if (sp > XB_SPIN_CAP) { atomicAdd(&bar[XB_TMO], 1u); break; } }
    }
    nloc = mine > 0u ? mine : 1u; nx = cnt > 0u ? cnt : 1u;
}

__device__ __forceinline__ void xcd_barrier(const XcdBarrier& b) {
    asm volatile("s_waitcnt vmcnt(0)" ::: "memory");
    __syncthreads();
    if (threadIdx.x == 0) {
        unsigned* bar = b.bar;
        __builtin_amdgcn_s_waitcnt(0);
        unsigned nloc = b.st[0], nx = b.st[1];
        if (nloc == 0u) { xcd_barrier_complete(bar, b.x, nloc, nx); b.st[0] = nloc; b.st[1] = nx; }
        const unsigned old = xb_add(&bar[XB_XSUB(b.x)], 1u);
        const unsigned gen = old / nloc;
        if (old + 1u == (gen + 1u) * nloc) {
            __builtin_amdgcn_fence(__ATOMIC_RELEASE, "agent");
            asm volatile("s_waitcnt vmcnt(0)" ::: "memory");
            const unsigned og = xb_add(&bar[XB_TOP], 1u);
            const unsigned tg = og / nx;
            if (og + 1u == (tg + 1u) * nx) xb_add(&bar[XB_TOPGEN], 1u);
            else XB_SPIN(xb_ld(&bar[XB_TOPGEN]) == tg, bar);
            __builtin_amdgcn_fence(__ATOMIC_ACQUIRE, "agent");
            xb_add(&bar[XB_XGEN(b.x)], 1u);
            asm volatile("s_waitcnt vmcnt(0)" ::: "memory");
        } else {
            XB_SPIN(xb_ld(&bar[XB_XGEN(b.x)]) == gen, bar);
            __builtin_amdgcn_fence(__ATOMIC_ACQUIRE, "agent");
            asm volatile("s_waitcnt vmcnt(0)" ::: "memory");
        }
    }
    __syncthreads();
}
typedef _Float16 f16;
typedef unsigned v2u __attribute__((ext_vector_type(2)));
typedef float f32x16 __attribute__((ext_vector_type(16)));
struct InPtrs { __device__ __forceinline__ const float* operator[](int i) const { return ((const float* const __attribute__((address_space(4)))*)__builtin_amdgcn_kernarg_segment_ptr())[i]; } };
struct Frame {
    LAS unsigned char* lds;
    volatile LAS unsigned* MISC;
    gu32* ctl;
    int tid, lane, wave;
    int vcu, G;
    InPtrs in; float* out; unsigned char* ws;
};
enum { I_X = 0, I_C, I_CTX, I_CCTX, I_WMOD, I_BMOD, I_NMIXG, I_NFFNG, I_WOUT, I_EWIN, I_ANORMG, I_AWS, I_ABS, I_BQNG, I_BKNG, I_LQ1, I_LK1, I_LQ2, I_LK2, I_SUBLNG,
       I_FW1, I_FW3, I_FW2, I_OWIN, I_CQNG, I_CKNG, I_CONVW, I_CONVB, I_DWA, I_DBA, I_DWX, I_DBX, I_DLAM, I_RW, I_RB, I_MW1, I_MW3, I_MW2 };

__device__ __forceinline__ float wave_sum(float v) {
#pragma unroll
    for (int o = 1; o < 64; o <<= 1) v += __shfl_xor(v, o);
    return v;
}
__device__ __forceinline__ float bf_lo(unsigned u) { return __uint_as_float(u << 16); }
__device__ __forceinline__ float bf_hi(unsigned u) { return __uint_as_float(u & 0xffff0000u); }
__device__ __forceinline__ float bf2f(bf16 h) { return __uint_as_float((unsigned)h << 16); }
__device__ __forceinline__ unsigned cvtpk(float lo, float hi) { return pg8::cvt_pk_bf16(lo, hi); }
__device__ __forceinline__ bf16 f2bf16(float f) { return (bf16)(cvtpk(f, 0.f) & 0xffffu); }
__device__ __forceinline__ void unpack8(const v4u u, float (&f)[8]) { f[0] = bf_lo(u.x); f[1] = bf_hi(u.x); f[2] = bf_lo(u.y); f[3] = bf_hi(u.y); f[4] = bf_lo(u.z); f[5] = bf_hi(u.z); f[6] = bf_lo(u.w); f[7] = bf_hi(u.w); }
__device__ __forceinline__ v4u pack8(const float (&f)[8]) { v4u o; o.x = cvtpk(f[0], f[1]); o.y = cvtpk(f[2], f[3]); o.z = cvtpk(f[4], f[5]); o.w = cvtpk(f[6], f[7]); return o; }
__device__ __forceinline__ float gelu_tanh(float x) { const float z = 0.7978845608028654f * (x + 0.044715f * x * x * x); return x * __builtin_amdgcn_rcpf(1.0f + __builtin_amdgcn_exp2f(-2.885390081777927f * z)); }
__device__ __forceinline__ float sigmoid_f(float x) { return __builtin_amdgcn_rcpf(1.0f + __builtin_amdgcn_exp2f(-1.4426950408889634f * x)); }
__device__ __forceinline__ int crow16(int r, int hi) { return (r & 3) + 8 * (r >> 2) + 4 * hi; }

__device__ __forceinline__ bool qk_bounded(const float* gq, const float* gk, int lane) {
    float a = fabsf(gq[lane]), b = fabsf(gk[lane]);
#pragma unroll
    for (int o = 1; o < 64; o <<= 1) { a = fmaxf(a, __shfl_xor(a, o)); b = fmaxf(b, __shfl_xor(b, o)); }
    return __builtin_amdgcn_readfirstlane((int)(64.0f * QSCALE * a * b * 1.02f < 64.0f)) != 0;
}
struct TrItem { const float* W; unsigned char* WT; int K, N, ilv, f8, item; float scale; };
__device__ __forceinline__ void tr_load(const TrItem& d, int lane, f32x4 (&v)[8]) {
    const int nblk = d.N / 32, kb = d.item / nblk, nb = d.item % nblk; const float* p = d.W + (size_t)(64 * kb + (lane >> 3)) * d.N + 32 * nb + 4 * (lane & 7);
#pragma unroll
    for (int i = 0; i < 8; ++i) v[i] = *(const GAS f32x4*)(p + (size_t)(8 * i) * d.N);
}
__device__ __forceinline__ void tr_store(const TrItem& d, int lane, const f32x4 (&v)[8], LAS float* scr) {
    const int nblk = d.N / 32, kb = d.item / nblk, nb = d.item % nblk, k0 = 64 * kb, n0 = 32 * nb;
    const int r0 = d.ilv ? ((n0 >> 7) * 256 + (n0 & 127) + (d.ilv == 2 ? 128 : 0)) : n0;
#pragma unroll
    for (int i = 0; i < 8; ++i) { LAS float* q = scr + (8 * i + (lane >> 3)) * 33 + 4 * (lane & 7); q[0] = v[i].x * d.scale; q[1] = v[i].y * d.scale; q[2] = v[i].z * d.scale; q[3] = v[i].w * d.scale; }
    LDS_WAIT(); asm volatile("" ::: "memory");
    if (d.f8) { const int c = lane & 3;
#pragma unroll
        for (int j = 0; j < 2; ++j) { const int n = (lane >> 2) + 16 * j; const LAS float* s = scr + (16 * c) * 33 + n;
            v4u o; o.x = pg8::cvt4_fp8(s[0 * 33], s[1 * 33], s[2 * 33], s[3 * 33]); o.y = pg8::cvt4_fp8(s[4 * 33], s[5 * 33], s[6 * 33], s[7 * 33]);
            o.z = pg8::cvt4_fp8(s[8 * 33], s[9 * 33], s[10 * 33], s[11 * 33]); o.w = pg8::cvt4_fp8(s[12 * 33], s[13 * 33], s[14 * 33], s[15 * 33]);
            *(GAS v4u*)(d.WT + (size_t)(r0 + n) * d.K + k0 + 16 * c) = o; }
    } else { const int c = lane & 7;
#pragma unroll
        for (int j = 0; j < 4; ++j) { const int n = (lane >> 3) + 8 * j; const LAS float* s = scr + (8 * c) * 33 + n;
            v4u o; o.x = cvtpk(s[0 * 33], s[1 * 33]); o.y = cvtpk(s[2 * 33], s[3 * 33]); o.z = cvtpk(s[4 * 33], s[5 * 33]); o.w = cvtpk(s[6 * 33], s[7 * 33]);
            *(GAS v4u*)((bf16*)d.WT + (size_t)(r0 + n) * d.K + k0 + 8 * c) = o; } }
    LDS_WAIT(); asm volatile("" ::: "memory");
}
constexpr int TR_I_E = 16 * 80, TR_I_O = 16 * 32, TR_I_F = 16 * 88, TR_I_OI = 16 * 56, TR_I_EXP = 3 * TR_I_F;
constexpr int TR_NITEMS = TR_I_E + 2 * TR_I_O + 3 * TR_I_F + TR_I_OI + NEXP * TR_I_EXP;
static_assert(TR_I_F == 44 * 32, "item counts of the [1024][2816] and [2816][1024] matrices match");
__device__ __forceinline__ TrItem tr_decode(Frame& F, int it) {
    unsigned char* ws = F.ws; int r = it; TrItem d; d.f8 = 0; d.scale = 1.0f; d.ilv = 0;
    if (r < TR_I_E) { d.W = F.in[I_EWIN]; d.K = D; d.N = E_IN; d.WT = ws + WS_WE; d.item = r; return d; } r -= TR_I_E;
    if (r < TR_I_O) { d.W = F.in[I_WOUT]; d.K = D; d.N = D; d.WT = ws + WS_WO0; d.item = r; return d; } r -= TR_I_O;
    if (r < TR_I_O) { d.W = F.in[I_WOUT] + (size_t)D * D; d.K = D; d.N = D; d.WT = ws + WS_WO1; d.item = r; return d; } r -= TR_I_O;
    if (r < TR_I_F) { d.W = F.in[I_FW1]; d.K = D; d.N = FF; d.WT = ws + WS_WF13; d.ilv = 1; d.f8 = 1; d.scale = MOE_S13; d.item = r; return d; } r -= TR_I_F;
    if (r < TR_I_F) { d.W = F.in[I_FW3]; d.K = D; d.N = FF; d.WT = ws + WS_WF13; d.ilv = 2; d.f8 = 1; d.scale = MOE_S13; d.item = r; return d; } r -= TR_I_F;
    if (r < TR_I_F) { d.W = F.in[I_FW2]; d.K = FF; d.N = D; d.WT = ws + WS_WF2; d.f8 = 1; d.scale = MOE_S2; d.item = r; return d; } r -= TR_I_F;
    if (r < TR_I_OI) { d.W = F.in[I_OWIN]; d.K = D; d.N = O_IN; d.WT = ws + WS_WOI; d.item = r; return d; } r -= TR_I_OI;
    const int e = r / TR_I_EXP, q = r % TR_I_EXP; d.f8 = 1;
    if (q < TR_I_F) { d.W = F.in[I_MW1] + (size_t)e * D * FF; d.K = D; d.N = FF; d.WT = ws + WS_WM13 + (size_t)e * FF2 * D; d.ilv = 1; d.scale = MOE_S13; d.item = q; }
    else if (q < 2 * TR_I_F) { d.W = F.in[I_MW3] + (size_t)e * D * FF; d.K = D; d.N = FF; d.WT = ws + WS_WM13 + (size_t)e * FF2 * D; d.ilv = 2; d.scale = MOE_S13; d.item = q - TR_I_F; }
    else { d.W = F.in[I_MW2] + (size_t)e * FF * D; d.K = FF; d.N = D; d.WT = ws + WS_WM2 + (size_t)e * D * FF; d.scale = MOE_S2; d.item = q - 2 * TR_I_F; }
    return d;
}
constexpr int TR_DENSE = TR_I_E + 2 * TR_I_O + 3 * TR_I_F + TR_I_OI;
__device__ __forceinline__ void tr_range(Frame& F, int lo, int hi) {
    LAS float* scr = (LAS float*)(F.lds + RING_OFF + F.wave * 16384);
    const int gw = F.vcu * NWAVES + F.wave, NGW = F.G * NWAVES, lane = F.lane;
    f32x4 v0[8], v1[8], v2[8], v3[8]; TrItem d0, d1, d2, d3; int it = lo + gw;
#define TR_ISSUE(d, v, idx) do { const int i_ = (idx); d = tr_decode(F, i_ < hi ? i_ : lo); if (i_ < hi) tr_load(d, lane, v); } while (0)
    TR_ISSUE(d0, v0, it); TR_ISSUE(d1, v1, it + NGW); TR_ISSUE(d2, v2, it + 2 * NGW);
    while (it < hi) {
        TR_ISSUE(d3, v3, it + 3 * NGW); tr_store(d0, lane, v0, scr); if (it + NGW >= hi) break;
        TR_ISSUE(d0, v0, it + 4 * NGW); tr_store(d1, lane, v1, scr); if (it + 2 * NGW >= hi) break;
        TR_ISSUE(d1, v1, it + 5 * NGW); tr_store(d2, lane, v2, scr); if (it + 3 * NGW >= hi) break;
        TR_ISSUE(d2, v2, it + 6 * NGW); tr_store(d3, lane, v3, scr);
        it += 4 * NGW; }
#undef TR_ISSUE
}
__device__ __forceinline__ void ph0_prologue(Frame& F) {
    const int lane = F.lane;
    tr_range(F, 0, TR_DENSE);
    { bf16* WG = (bf16*)(F.ws + WS_WG);
      for (int i = (int)blockIdx.x * 512 + F.tid; i < 2 * 2 * 8 * 64 * 64; i += F.G * 512) {
          const int k = i & 63, o = (i >> 6) & 63, n = (i >> 12) & 7, mat = (i >> 15) & 1, d = (i >> 16) & 1;
          const float* W = mat ? F.in[I_DWX] : F.in[I_DWA];
          WG[i] = f2bf16(W[((size_t)(d * 8 + n) * 64 + k) * 64 + o]); } }
    __syncthreads();
    { float* MOD = (float*)(F.ws + WS_MOD); LAS float* red = (LAS float*)(F.lds + RING_OFF);
      for (int cg = (int)blockIdx.x; cg < 2 * 96; cg += F.G) {
          const int layer = cg / 96, n0 = (cg % 96) * 64, kr = lane >> 4, c4 = lane & 15;
          f32x4 acc[3]; acc[0] = acc[1] = acc[2] = (f32x4){0.f, 0.f, 0.f, 0.f};
          const float* Wl = F.in[I_WMOD] + (size_t)layer * D * 6 * D;
#pragma unroll 4
          for (int it = 0; it < 32; ++it) { const int k = F.wave * 128 + 4 * it + kr;
              const f32x4 w = *(const GAS f32x4*)(Wl + (size_t)k * 6 * D + n0 + 4 * c4);
              const float c0 = F.in[I_C][k], c1 = F.in[I_C][D + k], c2 = F.in[I_CCTX][k];
              acc[0] += (c0 * sigmoid_f(c0)) * w; acc[1] += (c1 * sigmoid_f(c1)) * w; acc[2] += (c2 * sigmoid_f(c2)) * w; }
#pragma unroll
          for (int s = 0; s < 3; ++s)
#pragma unroll
              for (int j = 0; j < 4; ++j) { float v = acc[s][j]; v += __shfl_xor(v, 16); v += __shfl_xor(v, 32); acc[s][j] = v; }
          if (lane < 16) {
#pragma unroll
              for (int s = 0; s < 3; ++s)
#pragma unroll
                  for (int j = 0; j < 4; ++j) red[(F.wave * 3 + s) * 64 + 4 * c4 + j] = acc[s][j]; }
          __syncthreads();
          if (F.tid < 192) { const int s = F.tid >> 6, col = F.tid & 63; float v = F.in[I_BMOD][layer * 6 * D + n0 + col];
#pragma unroll
              for (int w = 0; w < 8; ++w) v += red[(w * 3 + s) * 64 + col];
              MOD[(size_t)(layer * 3 + s) * 6 * D + n0 + col] = v; }
          __syncthreads();
      } }
}
template <bool F8 = false> __device__ __forceinline__ void normmod_row(const float* src, const float* g, const float* sc, const float* sh, bf16* dst, int lane, f32x4 (&t)[4]) {
    const GAS f32x4* xr = (const GAS f32x4*)src + lane; float s = 0.f;
#pragma unroll
    for (int j = 0; j < 4; ++j) { t[j] = xr[64 * j]; s += (t[j].x * t[j].x + t[j].y * t[j].y) + (t[j].z * t[j].z + t[j].w * t[j].w); }
    const float rstd = 1.0f / sqrtf(wave_sum(s) * (1.f / D) + EPS);
    GAS v2u* o8 = (GAS v2u*)dst + lane;
#pragma unroll
    for (int j = 0; j < 4; ++j) { const f32x4 gg = ((const GAS f32x4*)g)[lane + 64 * j], cc = ((const GAS f32x4*)sc)[lane + 64 * j], hh = ((const GAS f32x4*)sh)[lane + 64 * j];
        t[j] = t[j] * rstd * gg * (1.0f + cc) + hh;
        if constexpr (F8) ((GAS unsigned*)dst)[lane + 64 * j] = pg8::cvt4_fp8(t[j].x, t[j].y, t[j].z, t[j].w); else { v2u w; w.x = cvtpk(t[j].x, t[j].y); w.y = cvtpk(t[j].z, t[j].w); o8[64 * j] = w; } }
}
template <bool F8 = false> __device__ __forceinline__ void ph_normmod(Frame& F, const float* srcL, const float* srcC, int nrows, const float* g, int layer, int sh_off, int sc_off) {
    const int gw = F.vcu * NWAVES + F.wave, NGW = F.G * NWAVES; const float* MOD = (const float*)(F.ws + WS_MOD) + (size_t)layer * 3 * 6 * D; bf16* XN = (bf16*)(F.ws + WS_XN);
    for (int m = gw; m < nrows; m += NGW) { const int s = m < SEQ ? 0 : (m < ML ? 1 : 2); const float* src = m < ML ? srcL + (size_t)m * D : srcC + (size_t)(m - ML) * D; f32x4 t[4];
        normmod_row<F8>(src, g, MOD + s * 6 * D + sc_off, MOD + s * 6 * D + sh_off, F8 ? (bf16*)((unsigned char*)XN + (size_t)m * D) : XN + (size_t)m * D, F.lane, t); }
}
__device__ __forceinline__ void qknorm_rope(float (&f)[8], const float* g, bool rope, int prow, int pcol, float outscale, int lane) {
    float ss = 0.f;
#pragma unroll
    for (int e = 0; e < 8; ++e) ss += f[e] * f[e];
    ss += __shfl_xor(ss, 1); ss += __shfl_xor(ss, 2); ss += __shfl_xor(ss, 4);
    const float rstd = 1.0f / sqrtf(ss * (1.f / 64.f) + EPS); const int j = lane & 7;
    const f32x4 g0 = *(const GAS f32x4*)(g + 8 * j), g1 = *(const GAS f32x4*)(g + 8 * j + 4);
    const float gg[8] = {g0.x, g0.y, g0.z, g0.w, g1.x, g1.y, g1.z, g1.w};
#pragma unroll
    for (int e = 0; e < 8; ++e) f[e] = f[e] * rstd * gg[e];
    if (rope) {
        const float pos = (float)((j < 4) ? prow : pcol), sgn = (j & 2) ? 1.f : -1.f;
#pragma unroll
        for (int e = 0; e < 8; ++e) { const float p = __shfl_xor(f[e], 2); const int i = (j & 1) * 8 + e;
            const float fr = __builtin_amdgcn_exp2f(-(float)i * (13.287712379549449f / 16.f)); float rev = pos * fr * 0.15915494309189535f; rev = rev - floorf(rev);
            f[e] = f[e] * __builtin_amdgcn_cosf(rev) + sgn * p * __builtin_amdgcn_sinf(rev); }
    }
#pragma unroll
    for (int e = 0; e < 8; ++e) f[e] *= outscale;
}
__device__ __forceinline__ void ph3_post0(Frame& F) {
    const int gw = F.vcu * NWAVES + F.wave, NGW = F.G * NWAVES, lane = F.lane; bf16* P0 = (bf16*)(F.ws + WS_P0); bf16* KC = (bf16*)(F.ws + WS_KC0); bf16* VC = (bf16*)(F.ws + WS_VC0);
    for (int m = gw; m < MR; m += NGW) {
        GAS v4u* rowp = (GAS v4u*)(P0 + (size_t)m * E_IN) + lane;
        const v4u u0 = rowp[0], u1 = rowp[64], u2 = rowp[128], u3 = rowp[192];
        float f[8];
        unpack8(u0, f);
#pragma unroll
        for (int e = 0; e < 8; ++e) f[e] = gelu_tanh(f[e]);
        rowp[0] = pack8(f);
        unpack8(u1, f); float ss = 0.f;
#pragma unroll
        for (int e = 0; e < 8; ++e) { f[e] = gelu_tanh(f[e]); ss += f[e] * f[e]; }
        { const float rstd = 1.0f / sqrtf(wave_sum(ss) * (1.f / 512.f) + EPS); const float* g = F.in[I_ANORMG] + 8 * lane;
          const f32x4 g0 = *(const GAS f32x4*)g, g1 = *(const GAS f32x4*)(g + 4); const float gg[8] = {g0.x, g0.y, g0.z, g0.w, g1.x, g1.y, g1.z, g1.w};
#pragma unroll
          for (int e = 0; e < 8; ++e) f[e] = f[e] * rstd * gg[e]; }
        rowp[64] = pack8(f);
        const bool lat = m < ML; const int t = m & (SEQ - 1), prow = t >> 6, pcol = t & 63;
        unpack8(u2, f); qknorm_rope(f, F.in[I_BQNG], lat, prow, pcol, QSCALE, lane); rowp[128] = pack8(f);
        unpack8(u3, f); qknorm_rope(f, F.in[I_BKNG], lat, prow, pcol, 1.0f, lane);
        { const int b = lat ? (m >> 13) : ((m - ML) >> 8), pos = lat ? CTXL + t : ((m - ML) & (CTXL - 1)); const size_t tb = (size_t)(pos >> 6) * 4096; const int pr = pos & 63;
          *(GAS v4u*)(KC + ((size_t)(b * 8 + (lane >> 3)) * KEYS * 64 + tb + (lane & 7) * 512 + pr * 8)) = pack8(f);
          const v4u u4 = rowp[256];
          *(GAS v4u*)(VC + ((size_t)(b * 8 + (lane >> 3)) * KEYS * 64 + tb + ((((lane & 7) >> 2) * 4 + (pr >> 4)) * 64 + (pr & 15) * 4 + (lane & 3)) * 8)) = u4; }
    }
}
__device__ __forceinline__ void gmlp_unit(Frame& F, int chunk) {
    const int lane = F.lane, r32 = lane & 31, hi = lane >> 5, g = F.wave, r0 = chunk * 128;
    const bf16* P0 = (const bf16*)(F.ws + WS_P0); bf16* Y = (bf16*)(F.ws + WS_Y);
    const float* ws = F.in[I_AWS] + (size_t)g * 128 * 128; const float* bs = F.in[I_ABS] + g * 128;
    bf16x8 afr[2][8];
#pragma unroll
    for (int ct = 0; ct < 2; ++ct)
#pragma unroll
        for (int ks = 0; ks < 8; ++ks)
#pragma unroll
            for (int e = 0; e < 8; ++e) afr[ct][ks][e] = (short)P0[(size_t)(r0 + 16 * ks + 8 * hi + e) * E_IN + 512 + 64 * g + 32 * ct + r32];
#pragma unroll 1
    for (int pt = 0; pt < 4; ++pt) {
        f32x16 acc[2]; acc[0] = f32x16{}; acc[1] = f32x16{};
        const float* wp = ws + (size_t)(32 * pt + r32) * 128 + 8 * hi;
#pragma unroll
        for (int ks = 0; ks < 8; ++ks) { const f32x4 w0 = *(const GAS f32x4*)(wp + 16 * ks), w1 = *(const GAS f32x4*)(wp + 16 * ks + 4);
            v4u pk; pk.x = cvtpk(w0.x, w0.y); pk.y = cvtpk(w0.z, w0.w); pk.z = cvtpk(w1.x, w1.y); pk.w = cvtpk(w1.z, w1.w); const bf16x8 bfr = __builtin_bit_cast(bf16x8, pk);
            acc[0] = __builtin_amdgcn_mfma_f32_32x32x16_bf16(afr[0][ks], bfr, acc[0], 0, 0, 0); acc[1] = __builtin_amdgcn_mfma_f32_32x32x16_bf16(afr[1][ks], bfr, acc[1], 0, 0, 0); }
        const int p = 32 * pt + r32; const float bias = bs[p];
#pragma unroll
        for (int ct = 0; ct < 2; ++ct)
#pragma unroll
            for (int rq = 0; rq < 4; ++rq) { const int c0 = 64 * g + 32 * ct + 8 * rq + 4 * hi;
                const v2u uu = *(const GAS v2u*)(P0 + (size_t)(r0 + p) * E_IN + c0);
                v2u o; o.x = cvtpk(bf_lo(uu.x) * (acc[ct][4 * rq + 0] + bias), bf_hi(uu.x) * (acc[ct][4 * rq + 1] + bias)); o.y = cvtpk(bf_lo(uu.y) * (acc[ct][4 * rq + 2] + bias), bf_hi(uu.y) * (acc[ct][4 * rq + 3] + bias));
                *(GAS v2u*)(Y + (size_t)(r0 + p) * D + c0) = o; }
    }
}
__device__ __forceinline__ void ph5_diffout(Frame& F) {
    const int gw = F.vcu * NWAVES + F.wave, NGW = F.G * NWAVES, lane = F.lane; const bf16* OA = (const bf16*)(F.ws + WS_OATT); bf16* Y = (bf16*)(F.ws + WS_Y);
    const float s1 = wave_sum(F.in[I_LQ1][lane] * F.in[I_LK1][lane]), s2 = wave_sum(F.in[I_LQ2][lane] * F.in[I_LK2][lane]);
    const float lam_init = 0.2f, lam = expf(s1) - expf(s2) + lam_init;
    const int h = lane >> 4, comp = (lane >> 3) & 1, i0 = (lane & 7) * 16;
    float gg[16];
#pragma unroll
    for (int q = 0; q < 4; ++q) { const f32x4 gv = *(const GAS f32x4*)(F.in[I_SUBLNG] + i0 + 4 * q); gg[4 * q] = gv.x; gg[4 * q + 1] = gv.y; gg[4 * q + 2] = gv.z; gg[4 * q + 3] = gv.w; }
    for (int m = gw; m < MR; m += NGW) {
        const GAS v4u* rp = (const GAS v4u*)(OA + (size_t)m * D + 16 * lane);
        const v4u a = rp[0], b = rp[1]; float own[16], d[16];
        { float t8[8]; unpack8(a, t8);
#pragma unroll
          for (int e = 0; e < 8; ++e) own[e] = t8[e];
          unpack8(b, t8);
#pragma unroll
          for (int e = 0; e < 8; ++e) own[8 + e] = t8[e]; }
        float ss = 0.f;
#pragma unroll
        for (int e = 0; e < 16; ++e) { const float oth = __shfl_xor(own[e], 8); const float o1 = comp ? oth : own[e], o2 = comp ? own[e] : oth; d[e] = o1 - lam * o2; ss += d[e] * d[e]; }
        ss += __shfl_xor(ss, 1); ss += __shfl_xor(ss, 2); ss += __shfl_xor(ss, 4);
        const float rstd = (1.0f - lam_init) / sqrtf(ss * (1.f / 128.f) + EPS);
        if (comp == 0) { float o8[8]; GAS v4u* yp = (GAS v4u*)(Y + (size_t)m * D + 512 + 128 * h + i0);
#pragma unroll
            for (int e = 0; e < 8; ++e) o8[e] = d[e] * rstd * gg[e];
            yp[0] = pack8(o8);
#pragma unroll
            for (int e = 0; e < 8; ++e) o8[e] = d[8 + e] * rstd * gg[8 + e];
            yp[1] = pack8(o8); }
    }
}
__device__ __forceinline__ void ph12_post1(Frame& F) {
    const int nskip = (NCHUNK > F.G && NCHUNK - F.G < F.G / 2) ? NCHUNK - F.G : 0;
    if (F.vcu < nskip) return;
    const int gw = (F.vcu - nskip) * NWAVES + F.wave, NGW = (F.G - nskip) * NWAVES, lane = F.lane; bf16* P1 = (bf16*)(F.ws + WS_P1); bf16* KC = (bf16*)(F.ws + WS_KC1); bf16* VC = (bf16*)(F.ws + WS_VC1);
    for (int m = gw; m < MR; m += NGW) {
        GAS v4u* rowp = (GAS v4u*)(P1 + (size_t)m * O_IN) + lane;
        const v4u u0 = rowp[0], u1 = rowp[64];
        const bool lat = m < ML; const int t = m & (SEQ - 1), prow = t >> 6, pcol = t & 63; float f[8];
        unpack8(u0, f); qknorm_rope(f, F.in[I_CQNG], lat, prow, pcol, QSCALE, lane); if (lat) rowp[0] = pack8(f);
        unpack8(u1, f); qknorm_rope(f, F.in[I_CKNG], lat, prow, pcol, 1.0f, lane);
        { const int b = lat ? (m >> 13) : ((m - ML) >> 8), pos = lat ? CTXL + t : ((m - ML) & (CTXL - 1)); const size_t tb = (size_t)(pos >> 6) * 4096; const int pr = pos & 63, l2 = lane & 15;
          if (lane < 16) *(GAS v4u*)(KC + ((size_t)(b * 2 + (l2 >> 3)) * KEYS * 64 + tb + (l2 & 7) * 512 + pr * 8)) = pack8(f);
          else if (lane < 32) *(GAS v4u*)(VC + ((size_t)(b * 2 + (l2 >> 3)) * KEYS * 64 + tb + ((((l2 & 7) >> 2) * 4 + (pr >> 4)) * 64 + (pr & 15) * 4 + (l2 & 3)) * 8)) = u1; }
    }
}
__device__ __forceinline__ bool seq_start(int r) { return r < ML ? (r & (SEQ - 1)) == 0 : ((r - ML) & (CTXL - 1)) == 0; }
constexpr int XDS = 520;
__device__ __forceinline__ void conv_to_lds(Frame& F, int r0, LAS bf16* XD) {
    const int cg = F.lane, w = F.wave; const bf16* P1 = (const bf16*)(F.ws + WS_P1);
    const bool st = seq_start(r0), en = seq_start(r0 + 64) || (r0 + 64 == MR);
    float wj[4][8], cb[8];
#pragma unroll
    for (int j = 0; j < 4; ++j) { const f32x4 a = *(const GAS f32x4*)(F.in[I_CONVW] + j * 512 + 8 * cg), b = *(const GAS f32x4*)(F.in[I_CONVW] + j * 512 + 8 * cg + 4);
        wj[j][0] = a.x; wj[j][1] = a.y; wj[j][2] = a.z; wj[j][3] = a.w; wj[j][4] = b.x; wj[j][5] = b.y; wj[j][6] = b.z; wj[j][7] = b.w; }
    { const f32x4 a = *(const GAS f32x4*)(F.in[I_CONVB] + 8 * cg), b = *(const GAS f32x4*)(F.in[I_CONVB] + 8 * cg + 4); cb[0] = a.x; cb[1] = a.y; cb[2] = a.z; cb[3] = a.w; cb[4] = b.x; cb[5] = b.y; cb[6] = b.z; cb[7] = b.w; }
    v4u xr[11];
#pragma unroll
    for (int i = 0; i < 11; ++i) { const int rl = 8 * w + i - 2; const bool ok = !((st && rl < 0) || (en && rl >= 64));
        xr[i] = ok ? *(const GAS v4u*)(P1 + (size_t)(r0 + rl) * O_IN + 1280 + 8 * cg) : (v4u){0u, 0u, 0u, 0u}; }
    float acc[8][8];
#pragma unroll
    for (int o = 0; o < 8; ++o)
#pragma unroll
        for (int e = 0; e < 8; ++e) acc[o][e] = cb[e];
#pragma unroll
    for (int i = 0; i < 11; ++i) { float f[8]; unpack8(xr[i], f);
#pragma unroll
        for (int j = 0; j < 4; ++j) { const int o = i - j; if (o >= 0 && o < 8) {
#pragma unroll
            for (int e = 0; e < 8; ++e) acc[o][e] += wj[j][e] * f[e]; } } }
#pragma unroll
    for (int o = 0; o < 8; ++o) *(LAS v4u*)(XD + (8 * w + o) * XDS + 8 * cg) = pack8(acc[o]);
}
__device__ __forceinline__ void lru_gates(Frame& F, const LAS bf16* XD, int n, int d, int half, f32x16 (&a)[2], f32x16 (&b)[2]) {
    const int lane = F.lane, r32 = lane & 31, hi = lane >> 5; const bf16* WG = (const bf16*)(F.ws + WS_WG);
    f32x16 ai[2]; a[0] = f32x16{}; a[1] = f32x16{}; ai[0] = f32x16{}; ai[1] = f32x16{};
    const bf16* wpr = WG + ((size_t)(((d * 2 + 0) * 8 + n) * 64 + 32 * half + r32)) * 64 + 8 * hi; const bf16* wpi = WG + ((size_t)(((d * 2 + 1) * 8 + n) * 64 + 32 * half + r32)) * 64 + 8 * hi;
#pragma unroll
    for (int ks = 0; ks < 4; ++ks) { const bf16x8 br = *(const GAS bf16x8*)(wpr + 16 * ks), bi = *(const GAS bf16x8*)(wpi + 16 * ks);
#pragma unroll
        for (int mt = 0; mt < 2; ++mt) { const bf16x8 af = *(const LAS bf16x8*)(XD + (32 * mt + r32) * XDS + 64 * n + 16 * ks + 8 * hi);
            a[mt] = __builtin_amdgcn_mfma_f32_32x32x16_bf16(af, br, a[mt], 0, 0, 0); ai[mt] = __builtin_amdgcn_mfma_f32_32x32x16_bf16(af, bi, ai[mt], 0, 0, 0); } }
    __builtin_amdgcn_sched_barrier(0);
    const int ch = 64 * n + 32 * half + r32; const float ba = F.in[I_DBA][d * 512 + ch], bx = F.in[I_DBX][d * 512 + ch];
    const float sp8 = 8.0f * log1pf(expf(-F.in[I_DLAM][d * 512 + ch]));
#pragma unroll
    for (int mt = 0; mt < 2; ++mt)
#pragma unroll
        for (int r = 0; r < 16; ++r) { const int row = 32 * mt + crow16(r, hi); const float xd = bf2f(XD[row * XDS + ch]);
            const float rr = sigmoid_f(a[mt][r] + ba), ii = sigmoid_f(ai[mt][r] + bx); const float y = rr * sp8, av = __builtin_amdgcn_exp2f(y * -1.4426950408889634f);
            const float y2 = 2.0f * y, om = y2 < 0.03f ? y2 * (1.0f - y2 * (0.5f - y2 * (1.0f / 6.0f))) : fmaf(-av, av, 1.0f);
            a[mt][r] = av; b[mt][r] = sqrtf(om) * (ii * xd); if ((r & 3) == 3) __builtin_amdgcn_sched_barrier(0); }
}
template <bool REV, bool FULL> __device__ __forceinline__ void chunk_scan(f32x16 (&a)[2], f32x16 (&b)[2], int hi, float h0, float& Atot, float& Btot) {
    float GA[8], GB[8], pGA[8], pGB[8], carry[8];
#pragma unroll
    for (int j = 0; j < 8; ++j) { const int mt = j >> 2, q = j & 3;
#pragma unroll
        for (int p = 1; p < 4; ++p) { const int k = REV ? 3 - p : p, kp = REV ? k + 1 : k - 1; const float ak = a[mt][4 * q + k];
            b[mt][4 * q + k] = ak * b[mt][4 * q + kp] + b[mt][4 * q + k]; a[mt][4 * q + k] = ak * a[mt][4 * q + kp]; }
        GA[j] = a[mt][4 * q + (REV ? 0 : 3)]; GB[j] = b[mt][4 * q + (REV ? 0 : 3)]; }
#pragma unroll
    for (int j = 0; j < 8; ++j) { const auto ra = __builtin_amdgcn_permlane32_swap(__float_as_uint(GA[j]), __float_as_uint(GA[j]), false, false); pGA[j] = __uint_as_float(hi ? ra[0] : ra[1]);
        const auto rb = __builtin_amdgcn_permlane32_swap(__float_as_uint(GB[j]), __float_as_uint(GB[j]), false, false); pGB[j] = __uint_as_float(hi ? rb[0] : rb[1]); }
    float c = h0, At = 1.0f; const bool firstMine = REV ? (hi == 1) : (hi == 0);
#pragma unroll
    for (int jj = 0; jj < 8; ++jj) { const int j = REV ? 7 - jj : jj;
        const float A1 = firstMine ? GA[j] : pGA[j], B1 = firstMine ? GB[j] : pGB[j], A2 = firstMine ? pGA[j] : GA[j], B2 = firstMine ? pGB[j] : GB[j];
        const float c1 = A1 * c + B1; carry[j] = firstMine ? c : c1; c = A2 * c1 + B2; At *= GA[j] * pGA[j]; }
    Atot = At; Btot = c;
    if constexpr (FULL) {
#pragma unroll
        for (int j = 0; j < 8; ++j) { const int mt = j >> 2, q = j & 3;
#pragma unroll
            for (int k = 0; k < 4; ++k) b[mt][4 * q + k] = a[mt][4 * q + k] * carry[j] + b[mt][4 * q + k]; }
    }
}
__device__ __forceinline__ void scan_prep_unit(Frame& F, int cid) {
    const int r0 = cid * 64, lane = F.lane, r32 = lane & 31, hi = lane >> 5, n = F.wave; LAS bf16* XD = (LAS bf16*)(F.lds + RING_OFF); float* AGG = (float*)(F.ws + WS_AGG);
    conv_to_lds(F, r0, XD);
    LDS_WAIT(); __syncthreads();
#pragma unroll
    for (int d = 0; d < 2; ++d)
#pragma unroll
        for (int half = 0; half < 2; ++half) { f32x16 a[2], b[2]; lru_gates(F, XD, n, d, half, a, b); float At, Bt;
            if (d == 0) chunk_scan<false, false>(a, b, hi, 0.f, At, Bt); else chunk_scan<true, false>(a, b, hi, 0.f, At, Bt);
            if (hi == 0) { const int ch = 64 * n + 32 * half + r32; AGG[((size_t)(d * NCHUNK + cid) * 2 + 0) * 512 + ch] = At; AGG[((size_t)(d * NCHUNK + cid) * 2 + 1) * 512 + ch] = Bt; } }
    LDS_WAIT(); __syncthreads();
}
__device__ __forceinline__ void scan_fix_unit(Frame& F, int cid) {
    const int b = cid >> 7, j = cid & 127, r0 = cid * 64, lane = F.lane, r32 = lane & 31, hi = lane >> 5, n = F.wave;
    const float* AGG = (const float*)(F.ws + WS_AGG); const bf16* P1 = (const bf16*)(F.ws + WS_P1); bf16* Y = (bf16*)(F.ws + WS_Y);
    LAS bf16* XD = (LAS bf16*)(F.lds + RING_OFF); LAS float* CAR = (LAS float*)(F.lds + RING_OFF + 64 * XDS * 2);
    conv_to_lds(F, r0, XD);
    asm volatile("" ::: "memory"); __builtin_amdgcn_sched_barrier(0);
    { const int ch = F.tid; const float* A0 = AGG + ch; const float* A1 = AGG + (size_t)NCHUNK * 1024 + ch;
      float hf = 0.f, hb = 0.f;
#pragma unroll
      for (int q = 0; q < 4; ++q) { const int c = 256 + 4 * b + q; hf = A0[(size_t)c * 1024] * hf + A0[(size_t)c * 1024 + 512]; }
#pragma unroll 8
      for (int q = 0; q < j; ++q) { const int c = 128 * b + q; hf = A0[(size_t)c * 1024] * hf + A0[(size_t)c * 1024 + 512]; }
#pragma unroll
      for (int q = 3; q >= 0; --q) { const int c = 256 + 4 * b + q; hb = A1[(size_t)c * 1024] * hb + A1[(size_t)c * 1024 + 512]; }
#pragma unroll 8
      for (int q = 127; q > j; --q) { const int c = 128 * b + q; hb = A1[(size_t)c * 1024] * hb + A1[(size_t)c * 1024 + 512]; }
      CAR[ch] = hf; CAR[512 + ch] = hb; }
    LDS_WAIT(); __syncthreads();
#pragma unroll 1
    for (int half = 0; half < 2; ++half) { const int ch = 64 * n + 32 * half + r32; f32x16 a[2], hf[2], hb[2]; float At, Bt;
        lru_gates(F, XD, n, 0, half, a, hf); chunk_scan<false, true>(a, hf, hi, CAR[ch], At, Bt);
        __builtin_amdgcn_sched_barrier(0); lru_gates(F, XD, n, 1, half, a, hb); chunk_scan<true, true>(a, hb, hi, CAR[512 + ch], At, Bt);
        const bf16* gp = P1 + (size_t)r0 * O_IN + 768; bf16* yp = Y + (size_t)r0 * D + 512;
#pragma unroll
        for (int mt = 0; mt < 2; ++mt)
#pragma unroll
            for (int q = 0; q < 4; ++q) {
#pragma unroll
                for (int k = 0; k < 4; ++k) { const unsigned rl = (unsigned)(32 * mt + 8 * q + 4 * hi + k); const float gt = bf2f(gp[rl * (unsigned)O_IN + (unsigned)ch]);
                    yp[rl * (unsigned)D + (unsigned)ch] = f2bf16((hf[mt][4 * q + k] + hb[mt][4 * q + k]) * gelu_tanh(gt)); }
                asm volatile("" ::: "memory"); } }
    LDS_WAIT(); __syncthreads();
}
__device__ __forceinline__ void ph15_router(Frame& F) {
    LAS float* WR = (LAS float*)(F.lds + RING_OFF);
    LAS int* lcnt = (LAS int*)(F.lds + RING_OFF + 32768); LAS int* lbase = lcnt + 8; LAS int* rec = lcnt + 16;
    LAS unsigned char* STG = F.lds + RING_OFF + 40960;
    const int lane = F.lane; const float* MOD = (const float*)(F.ws + WS_MOD) + (size_t)3 * 6 * D; unsigned char* XG = F.ws + WS_XG; int* TOK = (int*)(F.ws + WS_TOK);
    for (int i = F.tid; i < 1024 * 8 / 4; i += NWAVES * 64) ((LAS f32x4*)WR)[i] = ((const GAS f32x4*)F.in[I_RW])[i];
    __syncthreads();
    for (int rb = F.vcu; rb < ML / 64; rb += F.G) {
        if (F.tid < 8) lcnt[F.tid] = 0;
        __syncthreads();
#pragma unroll 1
        for (int i = 0; i < 8; ++i) { const int rl = F.wave * 8 + i, m = rb * 64 + rl, s = m >> 13; f32x4 t[4];
            { const GAS f32x4* xr = (const GAS f32x4*)(F.out + (size_t)m * D) + lane; float q = 0.f;
#pragma unroll
              for (int j = 0; j < 4; ++j) { t[j] = xr[64 * j]; q += (t[j].x * t[j].x + t[j].y * t[j].y) + (t[j].z * t[j].z + t[j].w * t[j].w); }
              const float rstd = 1.0f / sqrtf(wave_sum(q) * (1.f / D) + EPS); const float* g = F.in[I_NFFNG] + D; const float* sc = MOD + s * 6 * D + 4 * D; const float* sh = MOD + s * 6 * D + 3 * D;
#pragma unroll
              for (int j = 0; j < 4; ++j) { const f32x4 gg = ((const GAS f32x4*)g)[lane + 64 * j], cc = ((const GAS f32x4*)sc)[lane + 64 * j], hh = ((const GAS f32x4*)sh)[lane + 64 * j];
                  t[j] = t[j] * rstd * gg * (1.0f + cc) + hh; ((LAS unsigned*)(STG + rl * 1024))[lane + 64 * j] = pg8::cvt4_fp8(t[j].x, t[j].y, t[j].z, t[j].w); } }
            float lg[8];
#pragma unroll
            for (int e = 0; e < 8; ++e) lg[e] = 0.f;
#pragma unroll
            for (int j = 0; j < 4; ++j)
#pragma unroll
                for (int k = 0; k < 4; ++k) { const int c = 4 * lane + 256 * j + k; const f32x4 w0 = *(const LAS f32x4*)(WR + c * 8), w1 = *(const LAS f32x4*)(WR + c * 8 + 4); const float tv = t[j][k];
                    lg[0] += tv * w0.x; lg[1] += tv * w0.y; lg[2] += tv * w0.z; lg[3] += tv * w0.w; lg[4] += tv * w1.x; lg[5] += tv * w1.y; lg[6] += tv * w1.z; lg[7] += tv * w1.w; }
#pragma unroll
            for (int e = 0; e < 8; ++e) lg[e] = wave_sum(lg[e]) + F.in[I_RB][e];
            int e1 = 0; float v1 = lg[0];
#pragma unroll
            for (int e = 1; e < 8; ++e) if (lg[e] > v1) { v1 = lg[e]; e1 = e; }
            int e2 = -1; float v2 = -INFINITY;
#pragma unroll
            for (int e = 0; e < 8; ++e) if (e != e1 && lg[e] > v2) { v2 = lg[e]; e2 = e; }
            const float g1 = 1.0f / (1.0f + expf(v2 - v1)), g2 = 1.0f - g1;
            if (lane == 0) { LAS int* rc = rec + rl * 6; rc[0] = e1; rc[1] = e2; rc[2] = (int)__hip_atomic_fetch_add((LAS unsigned*)(lcnt + e1), 1u, __ATOMIC_RELAXED, __HIP_MEMORY_SCOPE_WORKGROUP);
                rc[3] = (int)__hip_atomic_fetch_add((LAS unsigned*)(lcnt + e2), 1u, __ATOMIC_RELAXED, __HIP_MEMORY_SCOPE_WORKGROUP); rc[4] = __float_as_int(g1); rc[5] = __float_as_int(g2); }
        }
        LDS_WAIT(); __syncthreads();
        if (F.tid < 8) lbase[F.tid] = (int)__hip_atomic_fetch_add((unsigned*)(F.ctl + CW_CNT + 64 * F.tid), (unsigned)lcnt[F.tid], __ATOMIC_RELAXED, __HIP_MEMORY_SCOPE_AGENT);
        LDS_WAIT(); __syncthreads();
        if (F.tid < 64) { const LAS int* rc = rec + F.tid * 6; int* tk = TOK + (size_t)(rb * 64 + F.tid) * 6;
            tk[0] = rc[0]; tk[1] = rc[1]; tk[2] = lbase[rc[0]] + rc[2]; tk[3] = lbase[rc[1]] + rc[3]; tk[4] = rc[4]; tk[5] = rc[5]; }
#pragma unroll
        for (int i = 0; i < 8; ++i) { const int rl = F.wave * 8 + i; const LAS int* rc = rec + rl * 6; const v4u row = *(const LAS v4u*)(STG + rl * 1024 + 16 * lane);
            const int e1 = rc[0], e2 = rc[1], p1 = lbase[e1] + rc[2], p2 = lbase[e2] + rc[3];
            *(GAS v4u*)(XG + ((size_t)e1 * ML + p1) * D + 16 * lane) = row; *(GAS v4u*)(XG + ((size_t)e2 * ML + p2) * D + 16 * lane) = row; }
        LDS_WAIT(); __syncthreads();
    }
}
__device__ __forceinline__ void moe_offsets(Frame& F, int (&off)[9]) {
    int o = 0;
#pragma unroll
    for (int e = 0; e < 8; ++e) { off[e] = o; const int c = (int)__hip_atomic_load((unsigned*)(F.ctl + CW_CNT + 64 * e), __ATOMIC_RELAXED, __HIP_MEMORY_SCOPE_AGENT); o += (c + 255) & ~255; }
    off[8] = o;
}
__device__ __forceinline__ int moe_tables(Frame& F) {
    int off[9]; moe_offsets(F, off); LAS int* pexp = (LAS int*)(F.lds + PEXP_OFF);
    if (F.tid < MOE_PAN) { const int r = F.tid * 256; int e = 0;
#pragma unroll
        for (int q = 1; q < 8; ++q) e = (r >= off[q]) ? q : e;
        pexp[F.tid] = e; }
    if (F.tid < 8) pexp[140 + F.tid] = off[F.tid] / 256;
    __syncthreads();
    return off[8] / 256;
}
__device__ __forceinline__ void ph19_combine(Frame& F) {
    int off[9]; moe_offsets(F, off);
    const int gw = F.vcu * NWAVES + F.wave, NGW = F.G * NWAVES, lane = F.lane; const bf16* YG = (const bf16*)(F.ws + WS_YG); const int* TOK = (const int*)(F.ws + WS_TOK);
    const float* MOD = (const float*)(F.ws + WS_MOD) + (size_t)3 * 6 * D;
    for (int m = gw; m < ML; m += NGW) { const int* tk = TOK + (size_t)m * 6; const int e1 = tk[0], e2 = tk[1]; int b1 = 0, b2 = 0;
#pragma unroll
        for (int q = 0; q < 8; ++q) { b1 = (e1 == q) ? off[q] : b1; b2 = (e2 == q) ? off[q] : b2; }
        const float g1 = __int_as_float(tk[4]), g2 = __int_as_float(tk[5]); const float* gp = MOD + (m >> 13) * 6 * D + 5 * D;
        const GAS v2u* y1 = (const GAS v2u*)(YG + (size_t)(b1 + tk[2]) * D) + lane; const GAS v2u* y2 = (const GAS v2u*)(YG + (size_t)(b2 + tk[3]) * D) + lane;
        GAS f32x4* o = (GAS f32x4*)(F.out + (size_t)m * D) + lane;
#pragma unroll
        for (int j = 0; j < 4; ++j) { const v2u a = y1[64 * j], b = y2[64 * j]; const f32x4 gv = ((const GAS f32x4*)gp)[lane + 64 * j]; f32x4 x = o[64 * j];
            x.x += gv.x * (g1 * bf_lo(a.x) + g2 * bf_lo(b.x)); x.y += gv.y * (g1 * bf_hi(a.x) + g2 * bf_hi(b.x)); x.z += gv.z * (g1 * bf_lo(a.y) + g2 * bf_lo(b.y)); x.w += gv.w * (g1 * bf_hi(a.y) + g2 * bf_hi(b.y));
            o[64 * j] = x; } }
}
struct Args { const float* in[38]; float* out; unsigned char* ws; int ph_lo, ph_hi; };
__global__ void __launch_bounds__(NWAVES * 64, 2) mk_fwd(Args args) {
    extern __shared__ __attribute__((aligned(16))) unsigned char lds[];
    Frame F;
    F.lds = (LAS unsigned char*)lds;
    F.MISC = (volatile LAS unsigned*)(F.lds + MISC_OFF);
    F.tid = threadIdx.x; F.lane = F.tid & 63; F.wave = __builtin_amdgcn_readfirstlane(F.tid >> 6);
    F.G = gridDim.x; { const int bx = blockIdx.x; F.vcu = (F.G % 8 == 0) ? (bx % 8) * (F.G / 8) + bx / 8 : bx; }
    F.ws = args.ws; F.out = args.out; F.ctl = (gu32*)(args.ws + WS_CTL);
    for (int u = F.tid; u < (LDS_BYTES - LDSCTL_OFF) / 4; u += NWAVES * 64) ((LAS unsigned*)(F.lds + LDSCTL_OFF))[u] = 0u;
    __syncthreads();
    XcdBarrier bar; bar.bar = (unsigned*)(F.ctl + CW_BAR); bar.x = 0; bar.st = nullptr;
    if (MK_ONE_LAUNCH) bar = xcd_barrier_post((unsigned*)(F.ctl + CW_BAR), F.MISC + 8);
#define GRID_BAR() do { if (MK_ONE_LAUNCH) xcd_barrier(bar); } while (0)
    const int lo = args.ph_lo, hi = args.ph_hi;
#define RELANE() do { int t_ = (int)threadIdx.x; asm volatile("" : "+v"(t_)); F.tid = t_; F.lane = t_ & 63; } while (0)
#define IN(k) (lo <= (k) && (k) < hi)
#define BOTH(k) (IN(k) && IN((k) + 1))
#ifndef MK_REP_MASK
#define MK_REP_MASK 0
#endif
#define REP(k) for (int rep_ = 0; rep_ < (((MK_REP_MASK >> (k)) & 1) ? 2 : 1); ++rep_)
    unsigned char* ws = args.ws;
    bf16* XN = (bf16*)(ws + WS_XN); bf16* Y = (bf16*)(ws + WS_Y); bf16* P0 = (bf16*)(ws + WS_P0); bf16* P1 = (bf16*)(ws + WS_P1); bf16* OA = (bf16*)(ws + WS_OATT); bf16* Hb = (bf16*)(ws + WS_H);
    float* XR = (float*)(ws + WS_XR); const float* MOD = (const float*)(ws + WS_MOD);
    using ABF = attn_body::bf16;

    if (IN(0)) { RELANE(); REP(0) { ph0_prologue(F); __syncthreads(); } if (BOTH(0)) GRID_BAR(); }
    if (IN(1)) { RELANE(); REP(1) ph_normmod(F, F.in[I_X], F.in[I_CTX], MR, F.in[I_NMIXG], 0, 0, D); if (BOTH(1)) GRID_BAR(); }
    if (IN(2)) { RELANE();
        pg8::Gemm g{XN, (const bf16*)(ws + WS_WE), MR, E_IN, D}; pg8::StaticOrder S; S.init(MR, E_IN, F.G, (int)blockIdx.x);
        pg8::EpiBf16<0> E{P0, E_IN, nullptr, 0, 0, 1.f};
        REP(2) pg8::gemm_phase<pg8::EpiBf16<0>, pg8::StaticOrder, PG8_ALIGN, PG8_SP2>(F.lds + RING_OFF, g, S, E);
        if (BOTH(2)) GRID_BAR();
    }
    if (IN(3)) { RELANE(); ph3_post0(F); if (BOTH(3)) GRID_BAR(); }
    if (IN(4)) { RELANE();
        const bool nomax0 = qk_bounded(F.in[I_BQNG], F.in[I_BKNG], F.lane);
        const int trslot = F.vcu % 3;
        float lam; { const int ln = F.lane; const float s1 = wave_sum(F.in[I_LQ1][ln] * F.in[I_LK1][ln]), s2 = wave_sum(F.in[I_LQ2][ln] * F.in[I_LK2][ln]); lam = expf(s1) - expf(s2) + 0.2f; }
        REP(4) for (int i = 0;; ++i) { const int L = i * F.G + F.vcu; if (L >= 256 + 8) break;
            const bool lat = L < 256; const int bh4 = lat ? (L >> 5) : (L - 256), qb = lat ? (L & 31) : 0, b = bh4 >> 2, h = bh4 & 3;
            const size_t qrow0 = lat ? (size_t)b * SEQ + (size_t)qb * 256 : (size_t)(ML + b * CTXL); const int NT = lat ? 132 : 4, rot = lat ? (F.vcu & 31) * 4 : 0;
            const ABF* Vs = (const ABF*)(ws + WS_VC0) + (size_t)(b * 8 + 2 * h) * KEYS * 64; ABF* O1 = (ABF*)(OA + qrow0 * D + 256 * h); ABF* Yo = (ABF*)(Y + qrow0 * D + 512 + 128 * h);
#pragma unroll 1
            for (int sc = 0; sc < 3; ++sc) {
                if (lat && sc == trslot && rep_ == 0) { tr_range(F, TR_DENSE, TR_NITEMS); LDS_WAIT(); __syncthreads(); }
                if (sc < 2) { const ABF* Ks = (const ABF*)(ws + WS_KC0) + (size_t)(b * 8 + 2 * h + sc) * KEYS * 64; const ABF* Q = (const ABF*)(P0 + qrow0 * E_IN + 1024 + 128 * h + 64 * sc);
                    if (sc == 1) VM_WAIT();
                    if (nomax0) attn_body::attn_unit2<-1>(Q, E_IN, Ks, Vs, Vs + (size_t)KEYS * 64, sc ? Yo : O1, D, NT, rot, (char*)lds + RING_OFF, sc == 1, O1, D, lam, F.in[I_SUBLNG], 0.8f);
                    else attn_body::attn_unit2<8>(Q, E_IN, Ks, Vs, Vs + (size_t)KEYS * 64, sc ? Yo : O1, D, NT, rot, (char*)lds + RING_OFF, sc == 1, O1, D, lam, F.in[I_SUBLNG], 0.8f); } } }
        RELANE();
        REP(4) for (int c = F.vcu - 32; c >= 0 && c < MR / 128; c += F.G) gmlp_unit(F, c);
        if (BOTH(4)) GRID_BAR();
    }
    if (IN(6)) { RELANE();
        pg8::Gemm g{Y, (const bf16*)(ws + WS_WO0), MR, D, D}; pg8::StaticOrder S; S.init(MR, D, F.G, (int)blockIdx.x);
        pg8::EpiResGate E{F.in[I_X], F.in[I_CTX], XR, MOD + 2 * D, 1.0f};
        REP(6) pg8::gemm_phase<pg8::EpiResGate, pg8::StaticOrder, PG8_ALIGN, PG8_SP2>(F.lds + RING_OFF, g, S, E);
        if (BOTH(6)) GRID_BAR();
    }
    if (IN(7)) { RELANE(); REP(7) ph_normmod<true>(F, XR, XR + (size_t)ML * D, MR, F.in[I_NFFNG], 0, 3 * D, 4 * D); if (BOTH(7)) GRID_BAR(); }
    if (IN(8)) { RELANE();
        pg8::Gemm g{XN, (const bf16*)(ws + WS_WF13), MR, FF2, D / 2}; pg8::StaticOrder S; S.init(MR, FF2, F.G, (int)blockIdx.x);
        pg8::EpiSwiGLUF8 E{(unsigned char*)Hb, FF, FF2 / 256, 1.0f / MOE_S13};
        REP(8) pg8::gemm_phase<pg8::EpiSwiGLUF8, pg8::StaticOrder, PG8_ALIGN, PG8_SP2, true>(F.lds + RING_OFF, g, S, E);
        if (BOTH(8)) GRID_BAR();
    }
    if (IN(9)) { RELANE();
        pg8::Gemm g{Hb, (const bf16*)(ws + WS_WF2), MR, D, FF / 2}; pg8::StaticOrder S; S.init(MR, D, F.G, (int)blockIdx.x);
        pg8::EpiResGate E{XR, XR + (size_t)ML * D, XR, MOD + 5 * D, 1.0f / MOE_S2};
        REP(9) pg8::gemm_phase<pg8::EpiResGate, pg8::StaticOrder, PG8_ALIGN, PG8_SP2, true>(F.lds + RING_OFF, g, S, E);
        if (BOTH(9)) GRID_BAR();
    }
    if (IN(10)) { RELANE(); REP(10) ph_normmod(F, XR, XR + (size_t)ML * D, MR, F.in[I_NMIXG] + D, 1, 0, D); if (BOTH(10)) GRID_BAR(); }
    if (IN(11)) { RELANE();
        pg8::Gemm g{XN, (const bf16*)(ws + WS_WOI), MR, O_IN, D}; pg8::StaticOrder S; S.init(MR, O_IN, F.G, (int)blockIdx.x);
        pg8::EpiBf16<0> E{P1, O_IN, nullptr, 0, 0, 1.f};
        REP(11) pg8::gemm_phase<pg8::EpiBf16<0>, pg8::StaticOrder, PG8_ALIGN, PG8_SP2>(F.lds + RING_OFF, g, S, E);
        if (BOTH(11)) GRID_BAR();
    }
    if (IN(12)) { RELANE();
        ph12_post1(F);
        REP(12) for (int c = F.vcu; c < NCHUNK; c += F.G) scan_prep_unit(F, c);
        if (BOTH(12)) GRID_BAR();
    }
    if (IN(13)) { RELANE();
        REP(13) for (int c = F.vcu; c < ML / 64; c += F.G) scan_fix_unit(F, c);
        const bool nomax1 = qk_bounded(F.in[I_CQNG], F.in[I_CKNG], F.lane);
        REP(13) for (int i = 0;; ++i) { const int L = i * F.G + F.vcu; if (L >= 512) break;
            const int bh = L >> 5, qb = L & 31, b = bh >> 3, hq = bh & 7, kv = hq >> 2;
            const size_t crow0 = (size_t)(ML + b * CTXL), lrow0 = (size_t)b * SEQ, qrow0 = lrow0 + (size_t)qb * 256;
            const ABF* Ks = (const ABF*)(ws + WS_KC1) + (size_t)(b * 2 + kv) * KEYS * 64; const ABF* Vs = (const ABF*)(ws + WS_VC1) + (size_t)(b * 2 + kv) * KEYS * 64;
            if (nomax1) attn_body::attn_unit<-1, true>((const ABF*)(P1 + qrow0 * O_IN + 64 * hq), O_IN, Ks, Ks + 4 * 4096, 64, Vs, Vs + 4 * 4096, 64, (ABF*)(Y + qrow0 * D + 64 * hq), D, 132, 4, (F.vcu & 31) * 4, (char*)lds + RING_OFF);
            else attn_body::attn_unit<8, true>((const ABF*)(P1 + qrow0 * O_IN + 64 * hq), O_IN, Ks, Ks + 4 * 4096, 64, Vs, Vs + 4 * 4096, 64, (ABF*)(Y + qrow0 * D + 64 * hq), D, 132, 4, (F.vcu & 31) * 4, (char*)lds + RING_OFF); }
        if (BOTH(13)) GRID_BAR();
    }
    if (IN(14)) { RELANE();
        pg8::Gemm g{Y, (const bf16*)(ws + WS_WO1), ML, D, D}; pg8::StaticOrder S; S.init(ML, D, F.G, (int)blockIdx.x);
        pg8::EpiResGate E{XR, XR, F.out, MOD + 3 * 6 * D + 2 * D, 1.0f};
        REP(14) pg8::gemm_phase<pg8::EpiResGate, pg8::StaticOrder, PG8_ALIGN, PG8_SP2>(F.lds + RING_OFF, g, S, E);
        if (BOTH(14)) GRID_BAR();
    }
    if (IN(15)) { RELANE(); ph15_router(F); if (BOTH(15)) GRID_BAR(); }
    if (IN(17)) { RELANE();
        const int npan = moe_tables(F);
        pg8::Gemm g{(const bf16*)(ws + WS_XG), (const bf16*)(ws + WS_WM13), MOE_ROWS, NEXP * FF2, D / 2}; pg8::MoeOrder S{npan, FF2 / 256, F.G, F.vcu, (const LAS int*)(F.lds + PEXP_OFF), true};
        pg8::EpiSwiGLUF8 E{ws + WS_HG, FF, FF2 / 256, 1.0f / MOE_S13};
        REP(17) pg8::gemm_phase<pg8::EpiSwiGLUF8, pg8::MoeOrder, PG8_ALIGN, PG8_SP2, true>(F.lds + RING_OFF, g, S, E);
        if (BOTH(17)) GRID_BAR();
    }
    if (IN(18)) { RELANE();
        const int npan = moe_tables(F);
        pg8::Gemm g{(const bf16*)(ws + WS_HG), (const bf16*)(ws + WS_WM2), MOE_ROWS, NEXP * D, FF / 2}; pg8::MoeOrder S{npan, D / 256, F.G, F.vcu, (const LAS int*)(F.lds + PEXP_OFF), false};
        pg8::EpiBf16S E{(bf16*)(ws + WS_YG), D, D / 256, 1.0f / MOE_S2};
        REP(18) pg8::gemm_phase<pg8::EpiBf16S, pg8::MoeOrder, PG8_ALIGN, PG8_SP2, true>(F.lds + RING_OFF, g, S, E);
        if (BOTH(18)) GRID_BAR();
    }
    if (IN(19)) { RELANE(); ph19_combine(F); }
#undef IN
#undef BOTH
#undef GRID_BAR
}

extern "C" void kernel_launch(void* const* d_in, const int* in_sizes, int n_in, void* d_out, int out_size, void* d_ws, size_t ws_size, hipStream_t stream) {
    static int grid = 0;
    if (grid == 0) {
        if (n_in != 38 || in_sizes[0] != ML * D || out_size != ML * D || ws_size < WS_END) { fprintf(stderr, "kernel_launch: built for 38 inputs, x/out of %d floats, >= %zu bytes of workspace; got n_in %d, in0 %d, out %d, ws %zu; nothing launched\n", ML * D, (size_t)WS_END, n_in, n_in > 0 ? in_sizes[0] : -1, out_size, ws_size); grid = -1; return; }
        int dev = 0, cus = 0, per_cu = 0;
        if (hipGetDevice(&dev) != hipSuccess || hipDeviceGetAttribute(&cus, hipDeviceAttributeMultiprocessorCount, dev) != hipSuccess) { fprintf(stderr, "kernel_launch: device query failed\n"); grid = -1; return; }
        if (hipFuncSetAttribute((const void*)mk_fwd, hipFuncAttributeMaxDynamicSharedMemorySize, LDS_BYTES) != hipSuccess) { fprintf(stderr, "kernel_launch: hipFuncSetAttribute failed\n"); grid = -1; return; }
        if (hipOccupancyMaxActiveBlocksPerMultiprocessor(&per_cu, (const void*)mk_fwd, NWAVES * 64, LDS_BYTES) != hipSuccess || per_cu < 1) fprintf(stderr, "kernel_launch: note: occupancy query reports %d workgroups per CU\n", per_cu);
        (void)hipGetLastError();
        grid = cus;
    }
    if (grid < 0) return;
    if (hipMemsetAsync((char*)d_ws + WS_CTL, 0, CTL_ZERO_BYTES, stream) != hipSuccess) { fprintf(stderr, "kernel_launch: hipMemsetAsync failed\n"); return; }
    Args a{};
    for (int i = 0; i < 38; ++i) a.in[i] = (const float*)d_in[i];
    a.out = (float*)d_out; a.ws = (unsigned char*)d_ws;
#if MK_ONE_LAUNCH
    a.ph_lo = 0; a.ph_hi = NPH;
    hipLaunchKernelGGL(mk_fwd, dim3(grid), dim3(NWAVES * 64), LDS_BYTES, stream, a);
#else
    for (int ph = 0; ph < NPH; ++ph) { a.ph_lo = ph; a.ph_hi = ph + 1; hipLaunchKernelGGL(mk_fwd, dim3(grid), dim3(NWAVES * 64), LDS_BYTES, stream, a); }
#endif
    const hipError_t le = hipPeekAtLastError();
    if (le != hipSuccess) fprintf(stderr, "kernel_launch: launch failed: %s\n", hipGetErrorName(le));
}
```

```cpp
#include <hip/hip_runtime.h>
#include <cstdio>
#include <cstdint>
#include <cmath>
namespace pg8 {
#define PG8_LAS __attribute__((address_space(3)))
typedef unsigned short bf16_t;
typedef short bf16x8 __attribute__((ext_vector_type(8)));
typedef float f32x4 __attribute__((ext_vector_type(4)));
typedef unsigned u32x4 __attribute__((ext_vector_type(4)));
typedef int i32x4 __attribute__((ext_vector_type(4)));
typedef int i32x8 __attribute__((ext_vector_type(8)));
typedef unsigned u32x2 __attribute__((ext_vector_type(2)));
constexpr int BM = 256, BK = 64, HALF = 128, HTB = HALF * BK * 2  , STAGE_BYTES = 8 * HTB, NXCD = 8, WGM = 8;

__host__ __device__ __forceinline__ int lds_byte(int r, int c) { const int st = (r >> 4) * 2 + (c >> 5), rr = r & 15, cc = c & 31, ob = rr * 64 + cc * 2; return st * 1024 + (ob ^ (((ob >> 9) & 1) << 5)); }
__host__ __device__ __forceinline__ void stage_rc(int b, int& R, int& C) { const int st = b / 1024, sb = b % 1024, swz = sb ^ (((sb >> 9) & 1) << 5); R = (st >> 1) * 16 + swz / 64; C = (st & 1) * 32 + (swz % 64) / 2; }
__host__ __device__ __forceinline__ int perm32(int rho) { const int n = rho >> 4, i = rho & 15; return 8 * (i >> 2) + 4 * n + (i & 3); }

struct Unit { int pm, pn, pa; };
struct Gemm { const bf16_t* A; const bf16_t* Bt; int M, N, K; };

struct StaticOrder {
    int nM, nN, nwg, G, c;
    __host__ __device__ void init(int M, int N, int G_, int c_) { nM = M / BM; nN = N / BM; nwg = nM * nN; G = G_; c = c_; }
    __host__ __device__ bool next(int i, Unit& u) const {
        const long L = (long)i * G + c; if (L >= nwg) return false;
        int wgid = (int)L; { const int q = nwg / NXCD, r = nwg % NXCD, xcd = wgid % NXCD, off = wgid / NXCD; wgid = (xcd < r ? xcd * (q + 1) : r * (q + 1) + (xcd - r) * q) + off; }
        const int nig = WGM * nN, gid = wgid / nig, fm = gid * WGM, gsz = (nM - fm) < WGM ? (nM - fm) : WGM;
        u.pm = fm + ((wgid % nig) % gsz); u.pn = (wgid % nig) / gsz; u.pa = u.pm; return true;
    }
    __device__ __forceinline__ void a_ready(const Unit&) const {}
    __device__ __forceinline__ void done(const Unit&) const {}
};

__device__ __forceinline__ unsigned cvt_pk_bf16(float lo, float hi) { unsigned r; asm volatile("v_cvt_pk_bf16_f32 %0, %1, %2" : "=v"(r) : "v"(lo), "v"(hi)); return r; }
typedef float f32x2 __attribute__((ext_vector_type(2)));
__device__ __forceinline__ f32x2 gelu_pk(f32x2 v) {
    const f32x2 av = __builtin_elementwise_abs(v), d = av * 0.2316418882f + 1.0f;
    f32x2 t; t.x = __builtin_amdgcn_rcpf(d.x); t.y = __builtin_amdgcn_rcpf(d.y);
    f32x2 q = t * 0.5307027145f + (-0.7265760135f); q = q * t + 0.7107068705f; q = q * t + (-0.142248368f); q = q * t + 0.127414796f; q = q * t;
    const f32x2 s = (v * v) * (-0.72134752044f);
    f32x2 e; e.x = __builtin_amdgcn_exp2f(s.x); e.y = __builtin_amdgcn_exp2f(s.y);
    const f32x2 m = v * (q * e), r = v - m;
    f32x2 o; o.x = v.x < 0.f ? m.x : r.x; o.y = v.y < 0.f ? m.y : r.y; return o;
}

template <int ACT  > struct EpiBf16 {
    static constexpr bool PERM = true, AFTER_DRAIN = false; static_assert(ACT == 0 || ACT == 1, "EpiBf16: ACT is 0 (none) or 1 (gelu_pk)");
    bf16_t* O; int ldc; const float* bias; int split_cols; size_t split_stride; float scale0;
    __device__ __forceinline__ void operator()(const f32x4 (&acc)[2][2][4][2], const Unit& u, int wr, int wc, int fr, int fq) const {
        const int row0 = u.pm * BM + wr * 64 + fr; int colt = u.pn * BM; bf16_t* base = O;
        float sc = 1.f; if (split_cols) { const int t = colt / split_cols; base += (size_t)t * split_stride; colt -= t * split_cols; if (t == 0) sc = scale0; }
        const int col0 = colt + wc * 32 + 8 * fq, bcol0 = u.pn * BM + wc * 32 + 8 * fq;
        f32x4 bv[2][2];
#pragma unroll
        for (int bj = 0; bj < 2; ++bj)
#pragma unroll
            for (int n = 0; n < 2; ++n) bv[bj][n] = bias ? *(const f32x4*)(bias + bcol0 + bj * HALF + 4 * n) : (f32x4){0.f, 0.f, 0.f, 0.f};
#pragma unroll
        for (int ai = 0; ai < 2; ++ai)
#pragma unroll
            for (int m = 0; m < 4; ++m) { bf16_t* rowp = base + (size_t)(row0 + ai * HALF + m * 16) * ldc + col0;
#pragma unroll
                for (int bj = 0; bj < 2; ++bj) { f32x4 v0 = acc[ai][bj][m][0] + bv[bj][0], v1 = acc[ai][bj][m][1] + bv[bj][1];
                    if (ACT == 1) { f32x2 a = gelu_pk((f32x2){v0[0], v0[1]}), b = gelu_pk((f32x2){v0[2], v0[3]}), c = gelu_pk((f32x2){v1[0], v1[1]}), d = gelu_pk((f32x2){v1[2], v1[3]});
                        v0 = (f32x4){a.x, a.y, b.x, b.y}; v1 = (f32x4){c.x, c.y, d.x, d.y}; }
                    v0 = v0 * sc; v1 = v1 * sc; u32x4 w; w.x = cvt_pk_bf16(v0[0], v0[1]); w.y = cvt_pk_bf16(v0[2], v0[3]); w.z = cvt_pk_bf16(v1[0], v1[1]); w.w = cvt_pk_bf16(v1[2], v1[3]);
                    *(u32x4*)(rowp + bj * HALF) = w; } }
    }
};
struct EpiResGate {
    static constexpr bool PERM = false, AFTER_DRAIN = false;
    const float* baseL; const float* baseC; float* out; const float* gate; float ascale;
    __device__ __forceinline__ void operator()(const f32x4 (&acc)[2][2][4][2], const Unit& u, int wr, int wc, int fr, int fq) const {
        const int s = u.pm < 32 ? 0 : (u.pm < 64 ? 1 : 2);
        const float* gp = gate + s * 6144;
        const float* base = u.pm < 64 ? baseL + (size_t)u.pm * BM * 1024 : baseC + (size_t)(u.pm - 64) * BM * 1024;
        float* o = out + (size_t)u.pm * BM * 1024;
        const int col0 = u.pn * BM + wc * 32 + 4 * fq;
        f32x4 gv[2][2];
#pragma unroll
        for (int bj = 0; bj < 2; ++bj)
#pragma unroll
            for (int n = 0; n < 2; ++n) gv[bj][n] = *(const f32x4*)(gp + col0 + bj * HALF + n * 16) * ascale;
#pragma unroll
        for (int ai = 0; ai < 2; ++ai)
#pragma unroll
            for (int m = 0; m < 4; ++m) { const size_t off = (size_t)(ai * HALF + wr * 64 + m * 16 + fr) * 1024 + col0;
#pragma unroll
                for (int bj = 0; bj < 2; ++bj)
#pragma unroll
                    for (int n = 0; n < 2; ++n) { const f32x4 bs = *(const f32x4*)(base + off + bj * HALF + n * 16); *(f32x4*)(o + off + bj * HALF + n * 16) = bs + gv[bj][n] * acc[ai][bj][m][n]; }
                if (m & 1) asm volatile("" ::: "memory"); }
    }
};
struct EpiSwiGLU {
    static constexpr bool PERM = true, AFTER_DRAIN = false;
    bf16_t* H; int ldh; int ntl;
    __device__ __forceinline__ void operator()(const f32x4 (&acc)[2][2][4][2], const Unit& u, int wr, int wc, int fr, int fq) const {
        const int row0 = u.pm * BM + wr * 64 + fr; const int ct = u.pn % ntl; const int col0 = ct * HALF + wc * 32 + 8 * fq;
#pragma unroll
        for (int ai = 0; ai < 2; ++ai)
#pragma unroll
            for (int m = 0; m < 4; ++m) { bf16_t* rowp = H + (size_t)(row0 + ai * HALF + m * 16) * ldh + col0;
                float hv[8];
#pragma unroll
                for (int n = 0; n < 2; ++n)
#pragma unroll
                    for (int j = 0; j < 4; ++j) { const float a = acc[ai][0][m][n][j], b = acc[ai][1][m][n][j];
                        const float e = __builtin_amdgcn_exp2f(a * -1.4426950408889634f); hv[n * 4 + j] = a * __builtin_amdgcn_rcpf(1.0f + e) * b; }
                u32x4 w; w.x = cvt_pk_bf16(hv[0], hv[1]); w.y = cvt_pk_bf16(hv[2], hv[3]); w.z = cvt_pk_bf16(hv[4], hv[5]); w.w = cvt_pk_bf16(hv[6], hv[7]);
                *(u32x4*)rowp = w; }
    }
};
__device__ __forceinline__ unsigned cvt4_fp8(float a, float b, float c, float d) { unsigned w = 0u; w = (unsigned)__builtin_amdgcn_cvt_pk_fp8_f32(a, b, (int)w, false); w = (unsigned)__builtin_amdgcn_cvt_pk_fp8_f32(c, d, (int)w, true); return w; }
struct EpiSwiGLUF8 {
    static constexpr bool PERM = true, AFTER_DRAIN = false;
    unsigned char* H; int ldh; int ntl; float s;
    __device__ __forceinline__ void operator()(const f32x4 (&acc)[2][2][4][2], const Unit& u, int wr, int wc, int fr, int fq) const {
        const int row0 = u.pm * BM + wr * 64 + fr; const int ct = u.pn % ntl; const int col0 = ct * HALF + wc * 32 + 8 * fq;
#pragma unroll
        for (int ai = 0; ai < 2; ++ai)
#pragma unroll
            for (int m = 0; m < 4; ++m) { unsigned char* rowp = H + (size_t)(row0 + ai * HALF + m * 16) * ldh + col0;
                float hv[8];
#pragma unroll
                for (int n = 0; n < 2; ++n)
#pragma unroll
                    for (int j = 0; j < 4; ++j) { const float a = acc[ai][0][m][n][j], b = acc[ai][1][m][n][j];
                        const float e = __builtin_amdgcn_exp2f(a * (s * -1.4426950408889634f)); hv[n * 4 + j] = (a * b) * (s * s) * __builtin_amdgcn_rcpf(1.0f + e); }
                u32x2 w; w.x = cvt4_fp8(hv[0], hv[1], hv[2], hv[3]); w.y = cvt4_fp8(hv[4], hv[5], hv[6], hv[7]);
                *(u32x2*)rowp = w; }
    }
};
struct EpiBf16S {
    static constexpr bool PERM = true, AFTER_DRAIN = false;
    bf16_t* O; int ldc; int ntl; float s;
    __device__ __forceinline__ void operator()(const f32x4 (&acc)[2][2][4][2], const Unit& u, int wr, int wc, int fr, int fq) const {
        const int row0 = u.pm * BM + wr * 64 + fr; const int col0 = (u.pn % ntl) * BM + wc * 32 + 8 * fq;
#pragma unroll
        for (int ai = 0; ai < 2; ++ai)
#pragma unroll
            for (int m = 0; m < 4; ++m) { bf16_t* rowp = O + (size_t)(row0 + ai * HALF + m * 16) * ldc + col0;
#pragma unroll
                for (int bj = 0; bj < 2; ++bj) { const f32x4 v0 = acc[ai][bj][m][0] * s, v1 = acc[ai][bj][m][1] * s;
                    u32x4 w; w.x = cvt_pk_bf16(v0[0], v0[1]); w.y = cvt_pk_bf16(v0[2], v0[3]); w.z = cvt_pk_bf16(v1[0], v1[1]); w.w = cvt_pk_bf16(v1[2], v1[3]);
                    *(u32x4*)(rowp + bj * HALF) = w; } }
    }
};
struct MoeOrder {
    int npan, ntl, G, c; const PG8_LAS int* pexp; bool capA;
    __device__ __forceinline__ bool next(int i, Unit& u) const {
        const long L = (long)i * G + c; if (L >= (long)npan * ntl) return false;
        const int pm = (int)(L / ntl), j = (int)(L % ntl); const int e = __builtin_amdgcn_readfirstlane(pexp[pm]); u.pm = pm; u.pn = e * ntl + j; u.pa = capA ? 64 * e + pm - __builtin_amdgcn_readfirstlane(pexp[140 + e]) : pm; return true;
    }
    __device__ __forceinline__ void a_ready(const Unit&) const {}
    __device__ __forceinline__ void done(const Unit&) const {}
};
template <class Epi, class Sched, bool ALIGN_EPI = false, bool SP2 = false, bool FP8 = false>
__device__ __forceinline__ void gemm_phase(PG8_LAS unsigned char* lds, const Gemm g, const Sched& S, const Epi& E) {
    const int tid = threadIdx.x, wid = __builtin_amdgcn_readfirstlane(tid >> 6), lane = tid & 63, wr = wid >> 2, wc = wid & 3, fr = lane & 15, fq = lane >> 4;
    const int K = g.K, nt = K / BK;
    unsigned voffA[2], voffB[2];
#pragma unroll
    for (int i = 0; i < 2; ++i) { int R, C; stage_rc(tid * 16 + i * 8192, R, C); const int Rb = Epi::PERM ? ((R & ~31) + perm32(R & 31)) : R;
        voffA[i] = (unsigned)(R * K + C) * 2u; voffB[i] = (unsigned)(Rb * K + C) * 2u; }
    const size_t kstep = (size_t)(BK * 2);
    const size_t hstep = (size_t)HALF * K * 2;
    const size_t tstep = 2 * hstep;
    const unsigned ldsw = (unsigned)wid * 1024u;
    const int aoff = lds_byte(wr * 64 + fr, fq * 8), boff = lds_byte(wc * 32 + fr, fq * 8);
#define PG8_SA(b, h) (((b) * 2 + (h)) * HTB)
#define PG8_SB(b, h) ((4 + (b) * 2 + (h)) * HTB)
#define PG8_STAGE(bufoff, gbase, voff) do { _Pragma("unroll") for (int _i = 0; _i < 2; ++_i) \
        __builtin_amdgcn_global_load_lds((const unsigned*)((const char*)(gbase) + (voff)[_i]), (PG8_LAS unsigned*)(lds + (bufoff) + ldsw + _i * 8192), 16, 0, 0); } while (0)
#define PG8_CAT(x, y) __builtin_shufflevector(__builtin_bit_cast(i32x4, x), __builtin_bit_cast(i32x4, y), 0, 1, 2, 3, 4, 5, 6, 7)
#define PG8_LDA(dst, b, h) do { if constexpr (FP8) { _Pragma("unroll") for (int m = 0; m < 4; ++m) dst##8[m] = PG8_CAT(*(const PG8_LAS bf16x8*)(lds + PG8_SA(b, h) + aoff + m * 2048), *(const PG8_LAS bf16x8*)(lds + PG8_SA(b, h) + aoff + m * 2048 + 1024)); } else { \
        _Pragma("unroll") for (int m = 0; m < 4; ++m) _Pragma("unroll") for (int k = 0; k < 2; ++k) dst[m][k] = *(const PG8_LAS bf16x8*)(lds + PG8_SA(b, h) + aoff + m * 2048 + k * 1024); } } while (0)
#define PG8_LDB(dst, b, h) do { if constexpr (FP8) { _Pragma("unroll") for (int n = 0; n < 2; ++n) dst##8[n] = PG8_CAT(*(const PG8_LAS bf16x8*)(lds + PG8_SB(b, h) + boff + n * 2048), *(const PG8_LAS bf16x8*)(lds + PG8_SB(b, h) + boff + n * 2048 + 1024)); } else { \
        _Pragma("unroll") for (int n = 0; n < 2; ++n) _Pragma("unroll") for (int k = 0; k < 2; ++k) dst[n][k] = *(const PG8_LAS bf16x8*)(lds + PG8_SB(b, h) + boff + n * 2048 + k * 1024); } } while (0)
#define PG8_MMA(ai, bj, At, Bt) do { __builtin_amdgcn_s_setprio(1); if constexpr (FP8) { _Pragma("unroll") for (int m = 0; m < 4; ++m) _Pragma("unroll") for (int n = 0; n < 2; ++n) \
        asm volatile("v_mfma_f32_16x16x128_f8f6f4 %0, %1, %2, %0" : "+v"(acc[ai][bj][m][n]) : "v"(Bt##8[n]), "v"(At##8[m]));   } else { \
        _Pragma("unroll") for (int m = 0; m < 4; ++m) _Pragma("unroll") for (int n = 0; n < 2; ++n) _Pragma("unroll") for (int k = 0; k < 2; ++k) \
        acc[ai][bj][m][n] = __builtin_amdgcn_mfma_f32_16x16x32_bf16(Bt[n][k], At[m][k], acc[ai][bj][m][n], 0, 0, 0); } __builtin_amdgcn_s_setprio(0); } while (0)
#define PG8_WAIT_V(n) asm volatile("s_waitcnt vmcnt(" #n ")" ::: "memory")
#define PG8_WAIT_L(n) asm volatile("s_waitcnt lgkmcnt(" #n ")" ::: "memory")
#define PG8_BAR __builtin_amdgcn_s_barrier()
#define PG8_SCHED __builtin_amdgcn_sched_barrier(0)
    Unit cur, nxt; int ui = 0;
    if (!S.next(0, cur)) return;
    f32x4 acc[2][2][4][2];
#pragma unroll
    for (int a = 0; a < 2; ++a)
#pragma unroll
        for (int b = 0; b < 2; ++b)
#pragma unroll
            for (int m = 0; m < 4; ++m)
#pragma unroll
                for (int n = 0; n < 2; ++n) acc[a][b][m][n] = (f32x4){0.f, 0.f, 0.f, 0.f};
    bf16x8 At[4][2], B0[2][2], B1[2][2]; i32x8 At8[4], B08[2], B18[2];
    const char* cA = (const char*)g.A + (size_t)cur.pa * tstep; const char* cB = (const char*)g.Bt + (size_t)cur.pn * tstep;
    S.a_ready(cur);
    if constexpr (SP2) {
        PG8_STAGE(PG8_SB(0, 0), cB, voffB); PG8_STAGE(PG8_SB(0, 1), cB + hstep, voffB); PG8_STAGE(PG8_SA(0, 0), cA, voffA); PG8_STAGE(PG8_SA(0, 1), cA + hstep, voffA);
        if (wr == 1) PG8_BAR;
        PG8_WAIT_V(2); PG8_BAR;
        PG8_STAGE(PG8_SB(1, 0), cB + kstep, voffB); PG8_STAGE(PG8_SA(1, 0), cA + kstep, voffA); PG8_STAGE(PG8_SB(1, 1), cB + hstep + kstep, voffB);
        PG8_WAIT_V(6); PG8_BAR;
    } else {
        PG8_STAGE(PG8_SB(0, 0), cB, voffB); PG8_STAGE(PG8_SA(0, 0), cA, voffA); PG8_STAGE(PG8_SB(0, 1), cB + hstep, voffB); PG8_STAGE(PG8_SA(0, 1), cA + hstep, voffA);
        if (wr == 1) PG8_BAR;
        PG8_WAIT_V(4); PG8_BAR;
        PG8_STAGE(PG8_SB(1, 0), cB + kstep, voffB); PG8_STAGE(PG8_SA(1, 0), cA + kstep, voffA); PG8_STAGE(PG8_SB(1, 1), cB + hstep + kstep, voffB);
        PG8_WAIT_V(6); PG8_BAR;
    }
    for (;;) {
        const bool has_next = S.next(ui + 1, nxt);
        const char* nA = has_next ? (const char*)g.A + (size_t)nxt.pa * tstep : cA; const char* nB = has_next ? (const char*)g.Bt + (size_t)nxt.pn * tstep : cB;
#pragma unroll 1
        for (int t = 0; t < nt; t += 2) {
            const bool last = (t == nt - 2);
            const char* a1 = cA + (size_t)(t + 1) * kstep;
            const char* a2 = last ? nA : cA + (size_t)(t + 2) * kstep; const char* b2 = last ? nB : cB + (size_t)(t + 2) * kstep;
            const char* a3 = a2 + kstep; const char* b3 = b2 + kstep;
            if (last && has_next) S.a_ready(nxt);
            if constexpr (SP2) {
            PG8_LDB(B0, 0, 0); PG8_LDB(B1, 0, 1); PG8_SCHED; PG8_LDA(At, 0, 0); PG8_STAGE(PG8_SA(1, 1), a1 + hstep, voffA);
            PG8_WAIT_V(8); PG8_WAIT_L(0); PG8_BAR; PG8_MMA(0, 0, At, B0); PG8_MMA(0, 1, At, B1); PG8_BAR; PG8_SCHED;
            PG8_LDA(At, 0, 1); PG8_STAGE(PG8_SB(0, 0), b2, voffB); PG8_STAGE(PG8_SB(0, 1), b2 + hstep, voffB); PG8_STAGE(PG8_SA(0, 0), a2, voffA);
            PG8_WAIT_V(8); PG8_WAIT_L(0); PG8_BAR; PG8_MMA(1, 0, At, B0); PG8_MMA(1, 1, At, B1); PG8_BAR; PG8_SCHED;
            PG8_LDB(B0, 1, 0); PG8_LDB(B1, 1, 1); PG8_SCHED; PG8_LDA(At, 1, 0); PG8_STAGE(PG8_SA(0, 1), a2 + hstep, voffA);
            PG8_WAIT_V(8); PG8_WAIT_L(0); PG8_BAR; PG8_MMA(0, 0, At, B0); PG8_MMA(0, 1, At, B1); PG8_BAR; PG8_SCHED;
            PG8_LDA(At, 1, 1); PG8_STAGE(PG8_SB(1, 0), b3, voffB); PG8_STAGE(PG8_SB(1, 1), b3 + hstep, voffB); PG8_STAGE(PG8_SA(1, 0), a3, voffA);
            PG8_WAIT_V(8); PG8_WAIT_L(0); PG8_BAR; PG8_MMA(1, 0, At, B0); PG8_MMA(1, 1, At, B1); PG8_BAR; PG8_SCHED;
            } else {
            PG8_LDB(B0, 0, 0); PG8_SCHED; PG8_LDA(At, 0, 0); PG8_STAGE(PG8_SA(1, 1), a1 + hstep, voffA);
            PG8_WAIT_L(8); PG8_BAR; PG8_WAIT_L(0); PG8_MMA(0, 0, At, B0); PG8_BAR; PG8_SCHED;
            PG8_LDB(B1, 0, 1); PG8_STAGE(PG8_SB(0, 0), b2, voffB);
            PG8_BAR; PG8_WAIT_L(0); PG8_MMA(0, 1, At, B1); PG8_BAR;
            PG8_LDA(At, 0, 1); PG8_STAGE(PG8_SA(0, 0), a2, voffA);
            PG8_BAR; PG8_WAIT_L(0); PG8_MMA(1, 0, At, B0); PG8_BAR; PG8_SCHED;
            PG8_STAGE(PG8_SB(0, 1), b2 + hstep, voffB);
            PG8_WAIT_V(6); PG8_BAR; PG8_MMA(1, 1, At, B1); PG8_BAR;
            PG8_LDB(B0, 1, 0); PG8_SCHED; PG8_LDA(At, 1, 0); PG8_STAGE(PG8_SA(0, 1), a2 + hstep, voffA);
            PG8_WAIT_L(8); PG8_BAR; PG8_WAIT_L(0); PG8_MMA(0, 0, At, B0); PG8_BAR; PG8_SCHED;
            PG8_LDB(B1, 1, 1); PG8_STAGE(PG8_SB(1, 0), b3, voffB);
            PG8_BAR; PG8_WAIT_L(0); PG8_MMA(0, 1, At, B1); PG8_BAR;
            PG8_LDA(At, 1, 1); PG8_STAGE(PG8_SA(1, 0), a3, voffA);
            PG8_BAR; PG8_WAIT_L(0); PG8_MMA(1, 0, At, B0); PG8_BAR; PG8_SCHED;
            PG8_STAGE(PG8_SB(1, 1), b3 + hstep, voffB);
            PG8_WAIT_V(6); PG8_BAR; PG8_MMA(1, 1, At, B1); PG8_BAR;
            }
        }
        if constexpr (FP8) asm volatile("s_nop 15\n\ts_nop 15" ::: "memory");
        if constexpr (ALIGN_EPI) { if (wr == 0) PG8_BAR; }
        if constexpr (!Epi::AFTER_DRAIN) { E(acc, cur, wr, wc, fr, fq); S.done(cur); }
        if (!has_next) break;
#pragma unroll
        for (int a = 0; a < 2; ++a)
#pragma unroll
            for (int b = 0; b < 2; ++b)
#pragma unroll
                for (int m = 0; m < 4; ++m)
#pragma unroll
                    for (int n = 0; n < 2; ++n) acc[a][b][m][n] = (f32x4){0.f, 0.f, 0.f, 0.f};
        cur = nxt; cA = nA; cB = nB; ++ui;
        if constexpr (ALIGN_EPI) { if (wr == 1) PG8_BAR; }
    }
    PG8_WAIT_V(0);
    if constexpr (!ALIGN_EPI) { if (wr == 0) PG8_BAR; }
    PG8_BAR;
    if constexpr (Epi::AFTER_DRAIN) { E.fused(acc, cur, wr, wc, fr, fq, lds, wid, lane); S.done(cur); }
#undef PG8_SA
#undef PG8_SB
#undef PG8_STAGE
#undef PG8_LDA
#undef PG8_LDB
#undef PG8_MMA
#undef PG8_CAT
#undef PG8_WAIT_V
#undef PG8_WAIT_L
#undef PG8_BAR
#undef PG8_SCHED
}
}

#ifndef PG8_SP2
#define PG8_SP2 true
#endif
#ifndef PG8_ALIGN
#define PG8_ALIGN true
#endif
#include <hip/hip_bf16.h>
#include <cmath>
namespace attn_body {
using bf16=__hip_bfloat16;
using bf16x8=__attribute__((ext_vector_type(8)))short;
using s16x4=__attribute__((ext_vector_type(4)))short;
using f32x16=__attribute__((ext_vector_type(16)))float;
using u32x4=__attribute__((ext_vector_type(4)))unsigned;
constexpr int D=64;
constexpr int NW=8,QBLK=32,QB=QBLK*NW,KVBLK=64;
constexpr int ATTN_UNIT_ROWS=QB;
__device__ __forceinline__ int crow(int r,int hi){return (r&3)+8*(r>>2)+4*hi;}
#define SBAR() __builtin_amdgcn_sched_barrier(0)
__device__ __forceinline__ void cmask(f32x16&p0,f32x16&p1,int jb,int qrel,int hi){
  const float NEG=-INFINITY; int kb=64*jb+4*hi;
  #pragma unroll
  for(int r=0;r<16;++r){int kv=kb+(r&3)+8*(r>>2); if(kv>qrel)p0[r]=NEG; if(kv+32>qrel)p1[r]=NEG;}
}

constexpr int NSLOT=3, SLOTB=8192;
constexpr int LDS_K=0, LDS_V=NSLOT*SLOTB, LDS_WS=2*NSLOT*SLOTB, LDS_OST=LDS_WS+NW*64*4, LDS_BYTES=LDS_OST+NW*4096;
constexpr float C2=0.125f*1.4426950408889634f;
__device__ __forceinline__ void glds16s(const void*sbase,unsigned voff,unsigned lds_dst){
  asm volatile("s_mov_b32 m0, %2\n\ts_nop 0\n\tglobal_load_lds_dwordx4 %0, %1"::"v"(voff),"s"(sbase),"s"(lds_dst):"memory","m0");}
__device__ __forceinline__ void glds16(const void*gsrc,unsigned lds_dst){unsigned keep;
  asm volatile("s_mov_b32 %0, m0\n\ts_mov_b32 m0, %2\n\ts_nop 0\n\tglobal_load_lds_dwordx4 %1, off\n\ts_mov_b32 m0, %0":"=&s"(keep):"v"(gsrc),"s"(lds_dst):"memory");}
__device__ __forceinline__ float max3f(float a,float b,float c){float r;asm("v_max3_f32 %0, %1, %2, %3":"=v"(r):"v"(a),"v"(b),"v"(c));return r;}
__device__ __forceinline__ float max2f(float a,float b){float r;asm("v_max_f32_e32 %0, %1, %2":"=v"(r):"v"(a),"v"(b));return r;}
__device__ __forceinline__ float fadd_s(float a,float b){float r;asm("v_add_f32_e32 %0, %1, %2":"=v"(r):"v"(a),"v"(b));return r;}
__device__ __forceinline__ float fsub_s(float a,float b){float r;asm("v_sub_f32_e32 %0, %1, %2":"=v"(r):"v"(a),"v"(b));return r;}
typedef float f32x2_t __attribute__((ext_vector_type(2))); typedef __bf16 bf16x2_t __attribute__((ext_vector_type(2)));
__device__ __forceinline__ unsigned cvtpk_s(float lo,float hi){f32x2_t v={lo,hi};bf16x2_t b=__builtin_convertvector(v,bf16x2_t);return __builtin_bit_cast(unsigned,b);}
#define WAIT_BAR(N) asm volatile("s_waitcnt vmcnt(" #N ") lgkmcnt(0)\n\ts_barrier":::"memory")

__device__ __forceinline__ void qkt(f32x16&p0,f32x16&p1,const char*Kslot,const bf16x8*qr,const f32x16&negm,int r32,int hi){
  const char*kb=Kslot+hi*1024+r32*16;
  #pragma unroll
  for(int d0=0;d0<4;++d0){
    const bf16x8 b0=*reinterpret_cast<const bf16x8*>(kb+d0*2048);
    const bf16x8 b1=*reinterpret_cast<const bf16x8*>(kb+d0*2048+512);
    if(d0==0){p0=__builtin_amdgcn_mfma_f32_32x32x16_bf16(b0,qr[0],negm,0,0,0);p1=__builtin_amdgcn_mfma_f32_32x32x16_bf16(b1,qr[0],negm,0,0,0);}
    else{p0=__builtin_amdgcn_mfma_f32_32x32x16_bf16(b0,qr[d0],p0,0,0,0);p1=__builtin_amdgcn_mfma_f32_32x32x16_bf16(b1,qr[d0],p1,0,0,0);}}
}
typedef __attribute__((address_space(3))) const char* lds_cptr;
typedef short v4i16_t __attribute__((ext_vector_type(4)));
__device__ __forceinline__ void kload8(bf16x8*kf,lds_cptr kp){
  kf[0]=*(const __attribute__((address_space(3))) bf16x8*)(kp);      kf[1]=*(const __attribute__((address_space(3))) bf16x8*)(kp+512);
  kf[2]=*(const __attribute__((address_space(3))) bf16x8*)(kp+2048); kf[3]=*(const __attribute__((address_space(3))) bf16x8*)(kp+2560);
  kf[4]=*(const __attribute__((address_space(3))) bf16x8*)(kp+4096); kf[5]=*(const __attribute__((address_space(3))) bf16x8*)(kp+4608);
  kf[6]=*(const __attribute__((address_space(3))) bf16x8*)(kp+6144); kf[7]=*(const __attribute__((address_space(3))) bf16x8*)(kp+6656);
}
__device__ __forceinline__ void kload2(bf16x8*kf,lds_cptr kp,int j){ kf[2*j]=*(const __attribute__((address_space(3))) bf16x8*)(kp+j*2048); kf[2*j+1]=*(const __attribute__((address_space(3))) bf16x8*)(kp+j*2048+512); }
__device__ __forceinline__ s16x4 vtr(lds_cptr p){ return __builtin_bit_cast(s16x4,__builtin_amdgcn_ds_read_tr16_b64_v4i16((__attribute__((address_space(3))) v4i16_t*)p)); }
__device__ __forceinline__ float rowmax(const f32x16&p0,const f32x16&p1){
  float a=max3f(p0[0],p0[1],p1[0]),b=max3f(p0[2],p0[3],p1[1]);a=max3f(a,p1[2],p1[3]);
  #pragma unroll
  for(int r=4;r<16;r+=4){a=max3f(a,p0[r],p0[r+1]);b=max3f(b,p0[r+2],p0[r+3]);a=max3f(a,p1[r],p1[r+1]);b=max3f(b,p1[r+2],p1[r+3]);}
  const float m=max2f(a,b);
  auto rr=__builtin_amdgcn_permlane32_swap(__float_as_uint(m),__float_as_uint(m),false,false);
  return max2f(__uint_as_float(rr[0]),__uint_as_float(rr[1]));
}
__device__ __forceinline__ void pv(f32x16*o,int vb,bf16x8 pa0,bf16x8 pa1,bf16x8 pa2,bf16x8 pa3){
  #pragma unroll
  for(int d0=0;d0<2;++d0){s16x4 lo[4],hi[4];
    #pragma unroll
    for(int ks=0;ks<4;++ks){
      asm volatile("ds_read_b64_tr_b16 %0,%1 offset:%c2":"=&v"(lo[ks]):"v"(vb),"i"(d0*4096+ks*1024):"memory");
      asm volatile("ds_read_b64_tr_b16 %0,%1 offset:%c2":"=&v"(hi[ks]):"v"(vb),"i"(d0*4096+ks*1024+512):"memory");}
    asm volatile("s_waitcnt lgkmcnt(0)":::"memory");SBAR();
    #define PK(k) (bf16x8){lo[k][0],lo[k][1],lo[k][2],lo[k][3],hi[k][0],hi[k][1],hi[k][2],hi[k][3]}
    o[d0]=__builtin_amdgcn_mfma_f32_32x32x16_bf16(pa0,PK(0),o[d0],0,0,0);
    o[d0]=__builtin_amdgcn_mfma_f32_32x32x16_bf16(pa1,PK(1),o[d0],0,0,0);
    o[d0]=__builtin_amdgcn_mfma_f32_32x32x16_bf16(pa2,PK(2),o[d0],0,0,0);
    o[d0]=__builtin_amdgcn_mfma_f32_32x32x16_bf16(pa3,PK(3),o[d0],0,0,0);
    #undef PK
  }
}

#ifndef ATTN_STORE16
#define ATTN_STORE16(p,v) (*(u32x4*)(p)=(v))
#endif
template<int THRL,bool TILED> __device__ __forceinline__ void attn_unit(const bf16*Qu,int qp,const bf16*__restrict__ Kc,const bf16*__restrict__ Kl,int kp,const bf16*__restrict__ Vc,const bf16*__restrict__ Vl,int vp,bf16*Ou,int op,int NT,int NCT,int rot,char*shm){
  const int tid=threadIdx.x,lane=tid&63,r32=lane&31,hi=lane>>5; const int wid=__builtin_amdgcn_readfirstlane(tid>>6);
  const bf16*Qw=Qu+(long)(wid*QBLK)*qp;
  const unsigned lds0=(unsigned)(uintptr_t)shm;
  float*wsf=(float*)(shm+LDS_WS)+wid*64;
  const long koff=TILED?(long)(wid*512+lane*8):((long)lane*kp+wid*8); const bf16*ksrc_c=Kc+koff; const bf16*ksrc_l=Kl+koff-(long)NCT*KVBLK*kp;
  const long voff=TILED?(long)(wid*512+lane*8):((long)(16*(wid&3)+(lane>>2))*vp+(wid>>2)*32+(lane&3)*8); const bf16*vsrc_c=Vc+voff; const bf16*vsrc_l=Vl+voff-(long)NCT*KVBLK*vp;
  const unsigned kdst=lds0+LDS_K+wid*1024, vdst=lds0+LDS_V+wid*1024;
  #define ROTT(t) (t)
  const unsigned koffb1=(unsigned)(wid*512+lane*8)*2u;
  #define DMA_K(t,slot) do{ if constexpr(TILED) glds16s(Kc+(long)ROTT(t)*4096,koffb1,(unsigned)__builtin_amdgcn_readfirstlane(kdst+(slot))); else glds16((ROTT(t)<NCT?ksrc_c:ksrc_l)+(long)ROTT(t)*KVBLK*kp,(unsigned)__builtin_amdgcn_readfirstlane(kdst+(slot))); }while(0)
  #define DMA_V(t,slot) do{ if constexpr(TILED) glds16s(Vc+(long)ROTT(t)*4096,koffb1,(unsigned)__builtin_amdgcn_readfirstlane(vdst+(slot))); else glds16((ROTT(t)<NCT?vsrc_c:vsrc_l)+(long)ROTT(t)*KVBLK*vp,(unsigned)__builtin_amdgcn_readfirstlane(vdst+(slot))); }while(0)
  const int vb0=(int)(lds0+LDS_V)+((lane>>4)&1)*32+(lane&3)*8+(4*hi+((lane&15)>>2))*64;
  const char*Kbase=shm+LDS_K; bf16x8 kf[8];
  const lds_cptr shm3=(lds_cptr)shm; const lds_cptr kp0=shm3+LDS_K+hi*1024+r32*16; const lds_cptr vp0=shm3+LDS_V+((lane>>4)&1)*32+(lane&3)*8+(4*hi+((lane&15)>>2))*64;
  DMA_K(0,0);DMA_V(0,0);DMA_K(1,SLOTB);
  bf16x8 qr[4];
  #pragma unroll
  for(int d0=0;d0<4;++d0)qr[d0]=*reinterpret_cast<const bf16x8*>(&Qw[(long)r32*qp+d0*16+hi*8]);
  float mhat=0.f,l_reg=0.f;f32x16 o[2];o[0]=f32x16{};o[1]=f32x16{};f32x16 negm=f32x16{};if constexpr(THRL>=0)asm volatile("":"+v"(negm));
  #define CMASK(P0,P1,t) do{}while(0)
  bool resc=false;
  #define START(P0,P1) do{ resc=false; if constexpr(THRL>=0) \
    { const float rm=rowmax(P0,P1); const float dl=rm; mhat=fadd_s(mhat,dl); \
      _Pragma("unroll") for(int r=0;r<16;++r){P0[r]=fsub_s(P0[r],dl);P1[r]=fsub_s(P1[r],dl);} \
      _Pragma("unroll") for(int r=0;r<16;++r)negm[r]=-mhat; asm volatile("":"+v"(negm)); } \
    _Pragma("unroll") for(int r=0;r<16;++r)P0[r]=__builtin_amdgcn_exp2f(P0[r]); }while(0)
  #define RESC() do{ if constexpr(THRL>=0) if(resc){ asm volatile("s_waitcnt lgkmcnt(0)":::"memory"); \
      _Pragma("unroll") for(int d_=0;d_<2;++d_) _Pragma("unroll") for(int r=0;r<16;++r)o[d_][r]*=wsf[crow(r,hi)]; } }while(0)
  f32x16 pA0,pA1,pB0,pB1;
  int sl_prev=0,sl_cur=0,sl_next=SLOTB;
  #define ROT() do{sl_prev=sl_cur;sl_cur=sl_next;sl_next=(sl_next==(NSLOT-1)*SLOTB)?0:sl_next+SLOTB;}while(0)
  DMA_K(2,2*SLOTB);
  WAIT_BAR(3);
  qkt(pA0,pA1,Kbase,qr,negm,r32,hi);asm volatile("s_nop 15\n\ts_nop 7":"+v"(pA0),"+v"(pA1));CMASK(pA0,pA1,0);
  START(pA0,pA1);
  _Pragma("unroll") for(int r=0;r<16;++r)pA1[r]=__builtin_amdgcn_exp2f(pA1[r]);
  WAIT_BAR(0);
  DMA_K(3,0);DMA_V(1,SLOTB);
  ROT();
  kload8(kf,kp0+sl_cur);
  WAIT_BAR(2);
  s16x4 vlo[8],vhi[8]; u32x4 pw0,pw1,pw2,pw3;
  #define PKW(P,B) cvtpk_s(P[B],P[B+1])
  #define PAF(k) __builtin_bit_cast(bf16x8,pw##k)
  #define VFR(i) (bf16x8){vlo[i][0],vlo[i][1],vlo[i][2],vlo[i][3],vhi[i][0],vhi[i][1],vhi[i][2],vhi[i][3]}
  #define PIN(x) asm volatile("":"+v"(x))
  #define MX3(a,b,c) __builtin_fmaxf(__builtin_fmaxf((a),(b)),(c))
  #define GAPA(MF,A0,A1,A2,A3,W0,W1,PW) do{ MF; sacc+=A0; sacc+=A1; sacc+=A2; sacc+=A3; PIN(sacc); W0; W1; PIN(PW); SBAR(); }while(0)
  #define EX(v) __builtin_amdgcn_exp2f(v)
  #define GAPB(MF,X,B) do{ MF; X[B]=EX(X[B]); X[B+1]=EX(X[B+1]); X[B+2]=EX(X[B+2]); X[B+3]=EX(X[B+3]); PIN(X); SBAR(); }while(0)
  #define VRD(i) do{ vlo[i]=vtr(vp_+(((i)>>2)*4096+((i)&3)*1024)); vhi[i]=vtr(vp_+(((i)>>2)*4096+((i)&3)*1024+512)); }while(0)
  #define KRD(G,j) do{ if(G){ kload2(kf,kp0+sl_next,j); SBAR(); } }while(0)
  #define STEP(C0,C1,P0,P1,t,GK,GV,GL) do{ SBAR(); \
    const lds_cptr vp_=vp0+sl_prev; \
    VRD(0); SBAR(); float sacc=(P0[0]+P0[1]); \
    GAPA(C0=__builtin_amdgcn_mfma_f32_32x32x16_bf16(kf[0],qr[0],negm,0,0,0), P0[2],P0[3],P0[4],P0[5],     pw0[0]=PKW(P0,0), pw0[1]=PKW(P0,2), pw0); \
    VRD(4); SBAR(); GAPA(C1=__builtin_amdgcn_mfma_f32_32x32x16_bf16(kf[1],qr[0],negm,0,0,0), P0[6],P0[7],P0[8],P0[9],     pw0[2]=PKW(P0,4), pw0[3]=PKW(P0,6), pw0); \
    VRD(1); SBAR(); GAPA(C0=__builtin_amdgcn_mfma_f32_32x32x16_bf16(kf[2],qr[1],C0,0,0,0),   P0[10],P0[11],P0[12],P0[13], pw1[0]=PKW(P0,8), pw1[1]=PKW(P0,10), pw1); \
    VRD(5); SBAR(); GAPA(C1=__builtin_amdgcn_mfma_f32_32x32x16_bf16(kf[3],qr[1],C1,0,0,0),   P0[14],P0[15],P1[0],P1[1],   pw1[2]=PKW(P0,12),pw1[3]=PKW(P0,14), pw1); \
    VRD(2); SBAR(); GAPA(C0=__builtin_amdgcn_mfma_f32_32x32x16_bf16(kf[4],qr[2],C0,0,0,0),   P1[2],P1[3],P1[4],P1[5],     pw2[0]=PKW(P1,0), pw2[1]=PKW(P1,2), pw2); \
    VRD(6); SBAR(); GAPA(C1=__builtin_amdgcn_mfma_f32_32x32x16_bf16(kf[5],qr[2],C1,0,0,0),   P1[6],P1[7],P1[8],P1[9],     pw2[2]=PKW(P1,4), pw2[3]=PKW(P1,6), pw2); \
    VRD(3); SBAR(); GAPA(C0=__builtin_amdgcn_mfma_f32_32x32x16_bf16(kf[6],qr[3],C0,0,0,0),   P1[10],P1[11],P1[12],P1[13], pw3[0]=PKW(P1,8), pw3[1]=PKW(P1,10), pw3); \
    VRD(7); SBAR(); GAPA(C1=__builtin_amdgcn_mfma_f32_32x32x16_bf16(kf[7],qr[3],C1,0,0,0),   P1[14],P1[15],0.f,0.f,       pw3[2]=PKW(P1,12),pw3[3]=PKW(P1,14), pw3); \
    l_reg+=sacc; \
    if(GK){DMA_K((t)+3,sl_cur);} if(GV){DMA_V((t)+1,sl_next);} \
    CMASK(C0,C1,t); \
    if constexpr(THRL>=0){ float a=MX3(C0[0],C0[1],C1[0]),b=MX3(C0[2],C0[3],C1[1]); a=MX3(a,C1[2],C1[3]); \
      _Pragma("unroll") for(int r=4;r<16;r+=4){a=MX3(a,C0[r],C0[r+1]);b=MX3(b,C0[r+2],C0[r+3]);a=MX3(a,C1[r],C1[r+1]);b=MX3(b,C1[r+2],C1[r+3]);} \
      float rm=__builtin_fmaxf(a,b); { auto rr=__builtin_amdgcn_permlane32_swap(__float_as_uint(rm),__float_as_uint(rm),false,false); rm=__builtin_fmaxf(__uint_as_float(rr[0]),__uint_as_float(rr[1])); } \
      resc=false; \
      if(__builtin_expect(__any(rm>(float)THRL),0)){ const float dl=__builtin_fmaxf(rm,0.f); mhat+=dl; \
        _Pragma("unroll") for(int r=0;r<16;++r){C0[r]-=dl;C1[r]-=dl;} \
        _Pragma("unroll") for(int r=0;r<16;++r)negm[r]=-mhat; asm volatile("":"+v"(negm)); \
        const float f=__builtin_amdgcn_exp2f(-dl); l_reg*=f; if(hi==0)wsf[r32]=f; resc=true; } } \
    SBAR(); \
    GAPB(o[0]=__builtin_amdgcn_mfma_f32_32x32x16_bf16(PAF(0),VFR(0),o[0],0,0,0), C0,0); \
    GAPB(o[1]=__builtin_amdgcn_mfma_f32_32x32x16_bf16(PAF(0),VFR(4),o[1],0,0,0), C0,4); \
    KRD(GL,0); GAPB(o[0]=__builtin_amdgcn_mfma_f32_32x32x16_bf16(PAF(1),VFR(1),o[0],0,0,0), C0,8); \
    KRD(GL,1); GAPB(o[1]=__builtin_amdgcn_mfma_f32_32x32x16_bf16(PAF(1),VFR(5),o[1],0,0,0), C0,12); \
    KRD(GL,2); GAPB(o[0]=__builtin_amdgcn_mfma_f32_32x32x16_bf16(PAF(2),VFR(2),o[0],0,0,0), C1,0); \
    KRD(GL,3); GAPB(o[1]=__builtin_amdgcn_mfma_f32_32x32x16_bf16(PAF(2),VFR(6),o[1],0,0,0), C1,4); \
    GAPB(o[0]=__builtin_amdgcn_mfma_f32_32x32x16_bf16(PAF(3),VFR(3),o[0],0,0,0), C1,8); \
    GAPB(o[1]=__builtin_amdgcn_mfma_f32_32x32x16_bf16(PAF(3),VFR(7),o[1],0,0,0), C1,12); \
    }while(0)
  int t=1;
  #undef CMASK
  #define CMASK(P0,P1,t) do{}while(0)
  for(;t+5<NT;t+=2){
    STEP(pB0,pB1,pA0,pA1,t,true,true,true);     WAIT_BAR(2); RESC(); ROT();
    STEP(pA0,pA1,pB0,pB1,t+1,true,true,true);   WAIT_BAR(2); RESC(); ROT();
  }
  #undef CMASK
  #define CMASK(P0,P1,t) do{}while(0)
  #define ENDW(tt) do{ if((tt)+3<NT){WAIT_BAR(2);} else if((tt)+2<NT){WAIT_BAR(1);} else {WAIT_BAR(0);} }while(0)
  for(;t+1<NT;t+=2){
    STEP(pB0,pB1,pA0,pA1,t,(t+3<NT),(t+1<NT),(t+1<NT));       ENDW(t);   RESC(); ROT();
    STEP(pA0,pA1,pB0,pB1,t+1,(t+4<NT),(t+2<NT),(t+2<NT));     ENDW(t+1); RESC(); ROT();
  }
  STEP(pB0,pB1,pA0,pA1,NT-1,false,false,false); RESC();
  { float sacc=pB0[0]+pB0[1]; _Pragma("unroll") for(int r=2;r<16;++r)sacc+=pB0[r]; _Pragma("unroll") for(int r=0;r<16;++r)sacc+=pB1[r]; l_reg+=sacc;
    pw0=(u32x4){PKW(pB0,0),PKW(pB0,2),PKW(pB0,4),PKW(pB0,6)};pw1=(u32x4){PKW(pB0,8),PKW(pB0,10),PKW(pB0,12),PKW(pB0,14)};pw2=(u32x4){PKW(pB1,0),PKW(pB1,2),PKW(pB1,4),PKW(pB1,6)};pw3=(u32x4){PKW(pB1,8),PKW(pB1,10),PKW(pB1,12),PKW(pB1,14)};
    SBAR(); pv(o,vb0+sl_cur,PAF(0),PAF(1),PAF(2),PAF(3)); }
  #undef PKW
  #undef PAF
  #undef VFR
  #undef PIN
  #undef MX3
  #undef GAPA
  #undef GAPB
  #undef EX
  #undef VRD
  #undef KRD
  #undef STEP
  #undef ENDW
  {auto rr=__builtin_amdgcn_permlane32_swap(__float_as_uint(l_reg),__float_as_uint(l_reg),false,false);l_reg=__uint_as_float(rr[0])+__uint_as_float(rr[1]);}
  if(hi==0)wsf[32+r32]=l_reg;asm volatile("s_waitcnt lgkmcnt(0)":::"memory");
  float rli[16];
  #pragma unroll
  for(int r=0;r<16;++r)rli[r]=__builtin_amdgcn_rcpf(wsf[32+crow(r,hi)]);
  bf16*Ow=Ou+(long)(wid*QBLK)*op;
  { bf16*stg=(bf16*)(shm+LDS_OST)+wid*2048;
    #pragma unroll
    for(int r=0;r<16;++r){const int orow=crow(r,hi);
      #pragma unroll
      for(int d0=0;d0<2;++d0)stg[orow*64+d0*32+r32]=__float2bfloat16(o[d0][r]*rli[r]);}
    asm volatile("s_waitcnt lgkmcnt(0)":::"memory");
    #pragma unroll
    for(int i=0;i<4;++i){const int row=i*8+(lane>>3),ch=lane&7; const u32x4 v=*(const u32x4*)(stg+row*64+ch*8); ATTN_STORE16(Ow+(long)row*op+ch*8,v);} }
  asm volatile("s_waitcnt lgkmcnt(0)\n\ts_barrier":::"memory");
  #undef DMA_K
  #undef ROTT
  #undef DMA_V
  #undef CMASK
  #undef START
  #undef RESC
  #undef ROT
}
constexpr int LDS2_V=NSLOT*SLOTB, LDS2_WS=LDS2_V+NSLOT*2*SLOTB, LDS2_OST=LDS2_WS+NW*64*4, LDS2_BYTES=LDS2_OST+NW*4096;
template<int THRL> __device__ __forceinline__ void attn_unit2(const bf16*Qu,int qp,const bf16*__restrict__ Ks,const bf16*__restrict__ Va,const bf16*__restrict__ Vb,bf16*Ou,int op,int NT,int rot,char*shm,bool FUSE,const bf16*O1,int o1p,float lam,const float*subg,float oscale){
  const int tid=threadIdx.x,lane=tid&63,r32=lane&31,hi=lane>>5; const int wid=__builtin_amdgcn_readfirstlane(tid>>6);
  const bf16*Qw=Qu+(long)(wid*QBLK)*qp;
  const unsigned lds0=(unsigned)(uintptr_t)shm;
  float*wsf=(float*)(shm+LDS2_WS)+wid*64;
  const unsigned koffb=(unsigned)(wid*512+lane*8)*2u;
  const unsigned kdst=lds0+LDS_K+wid*1024, vdst=lds0+LDS2_V+wid*1024;
  #define ROTT(t) (t)
  #define DMA_K(t,slot) glds16s(Ks+(long)ROTT(t)*4096,koffb,(unsigned)__builtin_amdgcn_readfirstlane(kdst+(slot)))
  #define DMA_V(t,slot) do{ glds16s(Va+(long)ROTT(t)*4096,koffb,(unsigned)__builtin_amdgcn_readfirstlane(vdst+2*(slot))); glds16s(Vb+(long)ROTT(t)*4096,koffb,(unsigned)__builtin_amdgcn_readfirstlane(vdst+2*(slot)+8192)); }while(0)
  const int vb0=(int)(lds0+LDS2_V)+((lane>>4)&1)*32+(lane&3)*8+(4*hi+((lane&15)>>2))*64;
  const char*Kbase=shm+LDS_K; bf16x8 kf[8];
  const lds_cptr shm3=(lds_cptr)shm; const lds_cptr kp0=shm3+LDS_K+hi*1024+r32*16; const lds_cptr vp0=shm3+LDS2_V+((lane>>4)&1)*32+(lane&3)*8+(4*hi+((lane&15)>>2))*64;
  DMA_K(0,0);DMA_V(0,0);DMA_K(1,SLOTB);
  bf16x8 qr[4];
  #pragma unroll
  for(int d0=0;d0<4;++d0)qr[d0]=*reinterpret_cast<const bf16x8*>(&Qw[(long)r32*qp+d0*16+hi*8]);
  float mhat=0.f,l_reg=0.f;f32x16 o[4];o[0]=f32x16{};o[1]=f32x16{};o[2]=f32x16{};o[3]=f32x16{};const f32x16 zero16=f32x16{};
  #define CMASK(P0,P1,t) do{}while(0)
  bool resc=false;
  #define SUBM(x) (THRL>=0?(x)-mhat:(x))
  #define START(P0,P1) do{ resc=false; if constexpr(THRL>=0){ mhat=rowmax(P0,P1); } \
    _Pragma("unroll") for(int r=0;r<16;++r)P0[r]=__builtin_amdgcn_exp2f(SUBM(P0[r])); }while(0)
  #define RESC() do{ if constexpr(THRL>=0) if(resc){ asm volatile("s_waitcnt lgkmcnt(0)":::"memory"); \
      _Pragma("unroll") for(int d_=0;d_<4;++d_) _Pragma("unroll") for(int r=0;r<16;++r)o[d_][r]*=wsf[crow(r,hi)]; } }while(0)
  f32x16 pA0,pA1,pB0,pB1;
  int sl_prev=0,sl_cur=0,sl_next=SLOTB;
  #define ROT() do{sl_prev=sl_cur;sl_cur=sl_next;sl_next=(sl_next==(NSLOT-1)*SLOTB)?0:sl_next+SLOTB;}while(0)
  DMA_K(2,2*SLOTB);
  WAIT_BAR(4);
  qkt(pA0,pA1,Kbase,qr,zero16,r32,hi);asm volatile("s_nop 15\n\ts_nop 7":"+v"(pA0),"+v"(pA1));CMASK(pA0,pA1,0);
  START(pA0,pA1);
  _Pragma("unroll") for(int r=0;r<16;++r)pA1[r]=__builtin_amdgcn_exp2f(SUBM(pA1[r]));
  WAIT_BAR(0);
  DMA_K(3,0);DMA_V(1,SLOTB);
  ROT();
  kload8(kf,kp0+sl_cur);
  WAIT_BAR(3);
  s16x4 vlo[8],vhi[8]; u32x4 pw0,pw1,pw2,pw3;
  #define PKW(P,B) cvtpk_s(P[B],P[B+1])
  #define PAF(k) __builtin_bit_cast(bf16x8,pw##k)
  #define VFR(i) (bf16x8){vlo[i][0],vlo[i][1],vlo[i][2],vlo[i][3],vhi[i][0],vhi[i][1],vhi[i][2],vhi[i][3]}
  #define PIN(x) asm volatile("":"+v"(x))
  #define MX3(a,b,c) __builtin_fmaxf(__builtin_fmaxf((a),(b)),(c))
  #define GAPA(MF,A0,A1,A2,A3,W0,W1,PW) do{ MF; sacc+=A0; sacc+=A1; sacc+=A2; sacc+=A3; PIN(sacc); W0; W1; PIN(PW); SBAR(); }while(0)
  #define EX(v) __builtin_amdgcn_exp2f(v)
  #define GAPB(MF,X,B) do{ MF; X[B]=EX(SUBM(X[B])); X[B+1]=EX(SUBM(X[B+1])); PIN(X); SBAR(); }while(0)
  #define VRD(i) do{ vlo[i]=vtr(vp_+(((i)>>2)*4096+((i)&3)*1024)); vhi[i]=vtr(vp_+(((i)>>2)*4096+((i)&3)*1024+512)); }while(0)
  #define VRD2(i) do{ vlo[i]=vtr(vp_+(8192+((i)>>2)*4096+((i)&3)*1024)); vhi[i]=vtr(vp_+(8192+((i)>>2)*4096+((i)&3)*1024+512)); SBAR(); }while(0)
  #define KRD(G,j) do{ if(G){ kload2(kf,kp0+sl_next,j); SBAR(); } }while(0)
  #define STEP(C0,C1,P0,P1,t,GK,GV,GL) do{ SBAR(); \
    const lds_cptr vp_=vp0+2*sl_prev; \
    VRD(0); SBAR(); float sacc=(P0[0]+P0[1]); \
    GAPA(C0=__builtin_amdgcn_mfma_f32_32x32x16_bf16(kf[0],qr[0],zero16,0,0,0), P0[2],P0[3],P0[4],P0[5],     pw0[0]=PKW(P0,0), pw0[1]=PKW(P0,2), pw0); \
    VRD(4); SBAR(); GAPA(C1=__builtin_amdgcn_mfma_f32_32x32x16_bf16(kf[1],qr[0],zero16,0,0,0), P0[6],P0[7],P0[8],P0[9],     pw0[2]=PKW(P0,4), pw0[3]=PKW(P0,6), pw0); \
    VRD(1); SBAR(); GAPA(C0=__builtin_amdgcn_mfma_f32_32x32x16_bf16(kf[2],qr[1],C0,0,0,0),   P0[10],P0[11],P0[12],P0[13], pw1[0]=PKW(P0,8), pw1[1]=PKW(P0,10), pw1); \
    VRD(5); SBAR(); GAPA(C1=__builtin_amdgcn_mfma_f32_32x32x16_bf16(kf[3],qr[1],C1,0,0,0),   P0[14],P0[15],P1[0],P1[1],   pw1[2]=PKW(P0,12),pw1[3]=PKW(P0,14), pw1); \
    VRD(2); SBAR(); GAPA(C0=__builtin_amdgcn_mfma_f32_32x32x16_bf16(kf[4],qr[2],C0,0,0,0),   P1[2],P1[3],P1[4],P1[5],     pw2[0]=PKW(P1,0), pw2[1]=PKW(P1,2), pw2); \
    VRD(6); SBAR(); GAPA(C1=__builtin_amdgcn_mfma_f32_32x32x16_bf16(kf[5],qr[2],C1,0,0,0),   P1[6],P1[7],P1[8],P1[9],     pw2[2]=PKW(P1,4), pw2[3]=PKW(P1,6), pw2); \
    VRD(3); SBAR(); GAPA(C0=__builtin_amdgcn_mfma_f32_32x32x16_bf16(kf[6],qr[3],C0,0,0,0),   P1[10],P1[11],P1[12],P1[13], pw3[0]=PKW(P1,8), pw3[1]=PKW(P1,10), pw3); \
    VRD(7); SBAR(); GAPA(C1=__builtin_amdgcn_mfma_f32_32x32x16_bf16(kf[7],qr[3],C1,0,0,0),   P1[14],P1[15],0.f,0.f,       pw3[2]=PKW(P1,12),pw3[3]=PKW(P1,14), pw3); \
    l_reg+=sacc; \
    if(GK){DMA_K((t)+3,sl_cur);} if(GV){DMA_V((t)+1,sl_next);} \
    CMASK(C0,C1,t); \
    if constexpr(THRL>=0){ float a=MX3(C0[0],C0[1],C1[0]),b=MX3(C0[2],C0[3],C1[1]); a=MX3(a,C1[2],C1[3]); \
      _Pragma("unroll") for(int r=4;r<16;r+=4){a=MX3(a,C0[r],C0[r+1]);b=MX3(b,C0[r+2],C0[r+3]);a=MX3(a,C1[r],C1[r+1]);b=MX3(b,C1[r+2],C1[r+3]);} \
      float rm=__builtin_fmaxf(a,b); { auto rr=__builtin_amdgcn_permlane32_swap(__float_as_uint(rm),__float_as_uint(rm),false,false); rm=__builtin_fmaxf(__uint_as_float(rr[0]),__uint_as_float(rr[1])); } \
      resc=false; \
      rm-=mhat; \
      if(__builtin_expect(__any(rm>(float)THRL),0)){ const float dl=__builtin_fmaxf(rm,0.f); mhat+=dl; \
        const float f=__builtin_amdgcn_exp2f(-dl); l_reg*=f; if(hi==0)wsf[r32]=f; resc=true; } } \
    SBAR(); \
    GAPB(o[0]=__builtin_amdgcn_mfma_f32_32x32x16_bf16(PAF(0),VFR(0),o[0],0,0,0), C0,0); VRD2(0); \
    GAPB(o[1]=__builtin_amdgcn_mfma_f32_32x32x16_bf16(PAF(0),VFR(4),o[1],0,0,0), C0,2); VRD2(4); \
    KRD(GL,0); GAPB(o[0]=__builtin_amdgcn_mfma_f32_32x32x16_bf16(PAF(1),VFR(1),o[0],0,0,0), C0,4); VRD2(1); \
    KRD(GL,1); GAPB(o[1]=__builtin_amdgcn_mfma_f32_32x32x16_bf16(PAF(1),VFR(5),o[1],0,0,0), C0,6); VRD2(5); \
    KRD(GL,2); GAPB(o[0]=__builtin_amdgcn_mfma_f32_32x32x16_bf16(PAF(2),VFR(2),o[0],0,0,0), C0,8); VRD2(2); \
    KRD(GL,3); GAPB(o[1]=__builtin_amdgcn_mfma_f32_32x32x16_bf16(PAF(2),VFR(6),o[1],0,0,0), C0,10); VRD2(6); \
    GAPB(o[0]=__builtin_amdgcn_mfma_f32_32x32x16_bf16(PAF(3),VFR(3),o[0],0,0,0), C0,12); VRD2(3); \
    GAPB(o[1]=__builtin_amdgcn_mfma_f32_32x32x16_bf16(PAF(3),VFR(7),o[1],0,0,0), C0,14); VRD2(7); \
    GAPB(o[2]=__builtin_amdgcn_mfma_f32_32x32x16_bf16(PAF(0),VFR(0),o[2],0,0,0), C1,0); \
    GAPB(o[3]=__builtin_amdgcn_mfma_f32_32x32x16_bf16(PAF(0),VFR(4),o[3],0,0,0), C1,2); \
    GAPB(o[2]=__builtin_amdgcn_mfma_f32_32x32x16_bf16(PAF(1),VFR(1),o[2],0,0,0), C1,4); \
    GAPB(o[3]=__builtin_amdgcn_mfma_f32_32x32x16_bf16(PAF(1),VFR(5),o[3],0,0,0), C1,6); \
    GAPB(o[2]=__builtin_amdgcn_mfma_f32_32x32x16_bf16(PAF(2),VFR(2),o[2],0,0,0), C1,8); \
    GAPB(o[3]=__builtin_amdgcn_mfma_f32_32x32x16_bf16(PAF(2),VFR(6),o[3],0,0,0), C1,10); \
    GAPB(o[2]=__builtin_amdgcn_mfma_f32_32x32x16_bf16(PAF(3),VFR(3),o[2],0,0,0), C1,12); \
    GAPB(o[3]=__builtin_amdgcn_mfma_f32_32x32x16_bf16(PAF(3),VFR(7),o[3],0,0,0), C1,14); \
    }while(0)
  int t=1;
  #undef CMASK
  #define CMASK(P0,P1,t) do{}while(0)
  for(;t+5<NT;t+=2){
    STEP(pB0,pB1,pA0,pA1,t,true,true,true);     WAIT_BAR(3); RESC(); ROT();
    STEP(pA0,pA1,pB0,pB1,t+1,true,true,true);   WAIT_BAR(3); RESC(); ROT();
  }
  #undef CMASK
  #define CMASK(P0,P1,t) do{}while(0)
  #define ENDW(tt) do{ if((tt)+3<NT){WAIT_BAR(3);} else if((tt)+2<NT){WAIT_BAR(2);} else {WAIT_BAR(0);} }while(0)
  for(;t+1<NT;t+=2){
    STEP(pB0,pB1,pA0,pA1,t,(t+3<NT),(t+1<NT),(t+1<NT));       ENDW(t);   RESC(); ROT();
    STEP(pA0,pA1,pB0,pB1,t+1,(t+4<NT),(t+2<NT),(t+2<NT));     ENDW(t+1); RESC(); ROT();
  }
  STEP(pB0,pB1,pA0,pA1,NT-1,false,false,false); RESC();
  { float sacc=pB0[0]+pB0[1]; _Pragma("unroll") for(int r=2;r<16;++r)sacc+=pB0[r]; _Pragma("unroll") for(int r=0;r<16;++r)sacc+=pB1[r]; l_reg+=sacc;
    pw0=(u32x4){PKW(pB0,0),PKW(pB0,2),PKW(pB0,4),PKW(pB0,6)};pw1=(u32x4){PKW(pB0,8),PKW(pB0,10),PKW(pB0,12),PKW(pB0,14)};pw2=(u32x4){PKW(pB1,0),PKW(pB1,2),PKW(pB1,4),PKW(pB1,6)};pw3=(u32x4){PKW(pB1,8),PKW(pB1,10),PKW(pB1,12),PKW(pB1,14)};
    SBAR(); pv(o,vb0+2*sl_cur,PAF(0),PAF(1),PAF(2),PAF(3)); pv(o+2,vb0+2*sl_cur+8192,PAF(0),PAF(1),PAF(2),PAF(3)); }
  #undef PKW
  #undef PAF
  #undef VFR
  #undef PIN
  #undef MX3
  #undef GAPA
  #undef GAPB
  #undef EX
  #undef VRD
  #undef VRD2
  #undef KRD
  #undef STEP
  #undef ENDW
  {auto rr=__builtin_amdgcn_permlane32_swap(__float_as_uint(l_reg),__float_as_uint(l_reg),false,false);l_reg=__uint_as_float(rr[0])+__uint_as_float(rr[1]);}
  if(hi==0)wsf[32+r32]=l_reg;asm volatile("s_waitcnt lgkmcnt(0)":::"memory");
  float rli[16];
  #pragma unroll
  for(int r=0;r<16;++r)rli[r]=__builtin_amdgcn_rcpf(wsf[32+crow(r,hi)]);
  bf16*Ow=Ou+(long)(wid*QBLK)*op;
  { bf16*stg=(bf16*)(shm+LDS2_OST)+wid*2048;
    int lane_e=lane; asm volatile("":"+v"(lane_e));
    if(!FUSE){
    #pragma unroll
    for(int hh=0;hh<2;++hh){
      #pragma unroll
      for(int r=0;r<16;++r){const int orow=crow(r,hi);
        #pragma unroll
        for(int d0=0;d0<2;++d0)stg[orow*64+d0*32+r32]=__float2bfloat16(o[2*hh+d0][r]*rli[r]);}
      asm volatile("s_waitcnt lgkmcnt(0)":::"memory");
      #pragma unroll
      for(int i=0;i<4;++i){const int row=i*8+(lane_e>>3),ch=lane_e&7; const u32x4 v=*(const u32x4*)(stg+row*64+ch*8); ATTN_STORE16(Ow+(long)row*op+hh*64+ch*8,v);}
      asm volatile("s_waitcnt lgkmcnt(0)":::"memory"); }
    } else {
    const bf16*O1w=O1+(long)(wid*QBLK)*o1p; float dd[2][4][8]; float ssq[4]={0.f,0.f,0.f,0.f};
    #pragma unroll
    for(int hh=0;hh<2;++hh){
      #pragma unroll
      for(int r=0;r<16;++r){const int orow=crow(r,hi);
        #pragma unroll
        for(int d0=0;d0<2;++d0)stg[orow*64+d0*32+r32]=__float2bfloat16(o[2*hh+d0][r]*rli[r]);}
      asm volatile("s_waitcnt lgkmcnt(0)":::"memory");
      #pragma unroll
      for(int i=0;i<4;++i){const int row=i*8+(lane_e>>3),ch=lane_e&7; const u32x4 v2=*(const u32x4*)(stg+row*64+ch*8); const u32x4 v1=*(const u32x4*)(O1w+(long)row*o1p+hh*64+ch*8);
        #pragma unroll
        for(int e=0;e<4;++e){ const float a0=__uint_as_float(v1[e]<<16),a1=__uint_as_float(v1[e]&0xffff0000u),b0=__uint_as_float(v2[e]<<16),b1=__uint_as_float(v2[e]&0xffff0000u);
          const float x0=a0-lam*b0,x1=a1-lam*b1; dd[hh][i][2*e]=x0; dd[hh][i][2*e+1]=x1; ssq[i]+=x0*x0+x1*x1; } }
      asm volatile("s_waitcnt lgkmcnt(0)":::"memory"); }
    #pragma unroll
    for(int i=0;i<4;++i){ float t=ssq[i]; t+=__shfl_xor(t,1); t+=__shfl_xor(t,2); t+=__shfl_xor(t,4); const float rs=oscale/sqrtf(t*(1.0f/128.0f)+1e-6f); const int row=i*8+(lane_e>>3),ch=lane_e&7;
      #pragma unroll
      for(int hh=0;hh<2;++hh){ const float*gp=subg+hh*64+ch*8; u32x4 w;
        #pragma unroll
        for(int e=0;e<4;++e)w[e]=cvtpk_s(dd[hh][i][2*e]*rs*gp[2*e],dd[hh][i][2*e+1]*rs*gp[2*e+1]);
        ATTN_STORE16(Ow+(long)row*op+hh*64+ch*8,w);} }
    } }
  asm volatile("s_waitcnt lgkmcnt(0)\n\ts_barrier":::"memory");
  #undef DMA_K
  #undef ROTT
  #undef DMA_V
  #undef CMASK
  #undef START
  #undef RESC
  #undef ROT
}
constexpr int ATTN_LDS_BYTES=LDS_BYTES;
#undef SBAR
#undef WAIT_BAR
}
constexpr int NWAVES = 8;
#ifndef MK_ONE_LAUNCH
#define MK_ONE_LAUNCH 1
#endif
constexpr int NPH = 20;

constexpr int D = 1024, NB = 2, SEQ = 8192, CTXL = 256;
constexpr int ML = NB * SEQ, MC = NB * CTXL, MR = ML + MC;
constexpr int E_IN = 2560, O_IN = 1792, FF = 2816, FF2 = 2 * FF, NEXP = 8;
constexpr int MOE_ROWS = 2 * ML + NEXP * 256, MOE_PAN = MOE_ROWS / 256;
constexpr int NCHUNK = MR / 64;
constexpr float EPS = 1e-6f;
constexpr float MOE_S13 = 32.0f, MOE_S2 = 64.0f;
constexpr float QSCALE = 0.125f * 1.4426950408889634f;

constexpr size_t MiB = 1u << 20, KiB = 1u << 10;
constexpr size_t WS_CTL = 0, CTL_ZERO_BYTES = 1 * MiB;
constexpr size_t WS_MOD = 1 * MiB;
constexpr size_t WS_WG = 1 * MiB + 256 * KiB;
constexpr size_t WS_TOK = 2 * MiB;
constexpr size_t WS_AGG = 4 * MiB;
constexpr size_t WS_WM13 = 8 * MiB, WS_WM2 = 96 * MiB;
constexpr size_t WS_WE = 140 * MiB, WS_WO0 = 145 * MiB, WS_WO1 = 147 * MiB, WS_WF13 = 149 * MiB, WS_WF2 = 160 * MiB, WS_WOI = 166 * MiB;
constexpr size_t WS_XR = 170 * MiB;
constexpr size_t WS_KC0 = 170 * MiB, WS_VC0 = 187 * MiB;
constexpr size_t WS_KC1 = 427 * MiB, WS_VC1 = 432 * MiB;
constexpr int KEYS = CTXL + SEQ;
constexpr size_t WS_XN = 236 * MiB;
constexpr size_t WS_Y = 269 * MiB;
constexpr size_t WS_P0 = 302 * MiB;
constexpr size_t WS_OATT = 385 * MiB;
constexpr size_t WS_H = 302 * MiB;
constexpr size_t WS_P1 = 302 * MiB;
constexpr size_t WS_RI = 360 * MiB;
constexpr size_t WS_XG = 234 * MiB;
constexpr size_t WS_HG = 140 * MiB;
constexpr size_t WS_YG = 368 * MiB;
constexpr size_t WS_END = 436 * MiB;
static_assert(WS_WM13 + (size_t)NEXP * FF2 * D * 2 <= WS_WM2 && WS_WM2 + (size_t)NEXP * D * FF * 2 <= WS_WE && WS_WE + (size_t)E_IN * D * 2 <= WS_WO0 && WS_WF13 + (size_t)FF2 * D * 2 <= WS_WF2 &&
              WS_WF2 + (size_t)D * FF * 2 <= WS_WOI && WS_WOI + (size_t)O_IN * D * 2 <= WS_XR && WS_XR + (size_t)MR * D * 4 <= WS_XN && WS_XN + (size_t)MR * D * 2 <= WS_Y && WS_Y + (size_t)MR * D * 2 <= WS_P0 &&
              WS_P0 + (size_t)MR * E_IN * 2 <= WS_OATT && WS_OATT + (size_t)MR * D * 2 <= WS_END && WS_H + (size_t)MR * FF * 2 <= WS_END && WS_P1 + (size_t)MR * O_IN * 2 <= WS_RI &&
              WS_RI + (size_t)4 * MR * 512 * 2 <= WS_END && WS_XG + (size_t)NEXP * ML * D <= WS_YG && WS_HG + (size_t)MOE_ROWS * FF <= WS_XG && WS_AGG + (size_t)2 * NCHUNK * 2 * 512 * 4 <= WS_WM13, "d_ws map");
constexpr int CW_TMO = 0, CW_CODE = 1;
constexpr int CW_BAR = 4096;
constexpr int CW_CNT = 8192;
constexpr int RING_OFF = 0, RING_BYTES = 131072;
constexpr int LDSCTL_OFF = RING_BYTES, MISC_OFF = LDSCTL_OFF + 320;
constexpr int PEXP_OFF = LDSCTL_OFF + 1024;
constexpr int LDS_BYTES = 147456;
#define GAS __attribute__((address_space(1)))
#define LAS __attribute__((address_space(3)))
typedef unsigned short bf16;
typedef unsigned v4u __attribute__((ext_vector_type(4)));
typedef float f32x4 __attribute__((ext_vector_type(4)));
typedef short bf16x8 __attribute__((ext_vector_type(8)));
typedef GAS unsigned gu32;
typedef GAS unsigned long long gu64;
#define RLX_AGENT __ATOMIC_RELAXED, __HIP_MEMORY_SCOPE_AGENT
#define LDS_WAIT() asm volatile("s_waitcnt lgkmcnt(0)" ::: "memory")
#define VM_WAIT() asm volatile("s_waitcnt vmcnt(0)" ::: "memory")
__device__ __forceinline__ unsigned long long rt() { return __builtin_amdgcn_s_memrealtime(); }
__device__ __forceinline__ unsigned f2bf(float f) { unsigned u = __builtin_bit_cast(unsigned, f); return (u + 0x7fffu + ((u >> 16) & 1u)) >> 16; }
__device__ __forceinline__ unsigned pk2(float lo, float hi) { return f2bf(lo) | (f2bf(hi) << 16); }

#define XB_TMO      128
#define XB_XCNT(j)  (256  + 64 * (j))
#define XB_XSUB(j)  (1280 + 64 * (j))
#define XB_XGEN(j)  (2304 + 64 * (j))
#define XB_TOP      3328
#define XB_TOPGEN   3392
#define XCD_BAR_WORDS 3456
#define XB_SPIN_CAP (1u << 18)

__device__ __forceinline__ unsigned xb_ld(unsigned* p)              { return __hip_atomic_load(p, __ATOMIC_RELAXED, __HIP_MEMORY_SCOPE_AGENT); }
__device__ __forceinline__ unsigned xb_add(unsigned* p, unsigned v) { return __hip_atomic_fetch_add(p, v, __ATOMIC_RELAXED, __HIP_MEMORY_SCOPE_AGENT); }
__device__ __forceinline__ unsigned xb_xcc_id() { return (unsigned)__builtin_amdgcn_s_getreg((3 << 11) | 20) & 0xFu; }
#define XB_SPIN(cond, bar) do { unsigned _sp = 0; while (cond) { __builtin_amdgcn_s_sleep(1); \
    if ((++_sp & 255u) == 0u) { if (xb_ld(&(bar)[XB_TMO])) break; if (_sp > XB_SPIN_CAP) { atomicAdd(&(bar)[XB_TMO], 1u); break; } } } } while (0)

struct XcdBarrier {
    unsigned* bar; unsigned x;
    volatile LAS unsigned* st;
};

__device__ __forceinline__ XcdBarrier xcd_barrier_post(unsigned* bar, volatile LAS unsigned* st) {
    XcdBarrier b; b.bar = bar; b.x = xb_xcc_id(); b.st = st;
    if (threadIdx.x == 0) (void)xb_add(&bar[XB_XCNT(b.x)], 1u);
    return b;
}
__device__ __forceinline__ void xcd_barrier_complete(unsigned* bar, unsigned x, unsigned& nloc, unsigned& nx) {
    const unsigned G = gridDim.x * gridDim.y * gridDim.z;
    unsigned sum, cnt, mine, sp = 0u;
    for (;;) {
        sum = 0u; cnt = 0u; mine = 0u;
#pragma unroll
        for (unsigned j = 0; j < 16; ++j) { const unsigned c = xb_ld(&bar[XB_XCNT(j)]); sum += c; cnt += (c > 0u) ? 1u : 0u; mine = (j == x) ? c : mine; }
        if (sum == G) break;
        __builtin_amdgcn_s_sleep(1);
        if ((++sp & 255u) == 0u) { if (xb_ld(&bar[XB_TMO])) break; if (sp > XB_SPIN_CAP) { atomicAdd(&bar[XB_TMO], 1u); break; } }
    }
    nloc = mine > 0u ? mine : 1u; nx = cnt > 0u ? cnt : 1u;
}

__device__ __forceinline__ void xcd_barrier(const XcdBarrier& b) {
    asm volatile("s_waitcnt vmcnt(0)" ::: "memory");
    __syncthreads();
    if (threadIdx.x == 0) {
        unsigned* bar = b.bar;
        __builtin_amdgcn_s_waitcnt(0);
        unsigned nloc = b.st[0], nx = b.st[1];
        if (nloc == 0u) { xcd_barrier_complete(bar, b.x, nloc, nx); b.st[0] = nloc; b.st[1] = nx; }
        const unsigned old = xb_add(&bar[XB_XSUB(b.x)], 1u);
        const unsigned gen = old / nloc;
        if (old + 1u == (gen + 1u) * nloc) {
            __builtin_amdgcn_fence(__ATOMIC_RELEASE, "agent");
            asm volatile("s_waitcnt vmcnt(0)" ::: "memory");
            const unsigned og = xb_add(&bar[XB_TOP], 1u);
            const unsigned tg = og / nx;
            if (og + 1u == (tg + 1u) * nx) xb_add(&bar[XB_TOPGEN], 1u);
            else XB_SPIN(xb_ld(&bar[XB_TOPGEN]) == tg, bar);
            __builtin_amdgcn_fence(__ATOMIC_ACQUIRE, "agent");
            xb_add(&bar[XB_XGEN(b.x)], 1u);
            asm volatile("s_waitcnt vmcnt(0)" ::: "memory");
        } else {
            XB_SPIN(xb_ld(&bar[XB_XGEN(b.x)]) == gen, bar);
            __builtin_amdgcn_fence(__ATOMIC_ACQUIRE, "agent");
            asm volatile("s_waitcnt vmcnt(0)" ::: "memory");
        }
    }
    __syncthreads();
}
typedef _Float16 f16;
typedef unsigned v2u __attribute__((ext_vector_type(2)));
typedef float f32x16 __attribute__((ext_vector_type(16)));
struct InPtrs { __device__ __forceinline__ const float* operator[](int i) const { return ((const float* const __attribute__((address_space(4)))*)__builtin_amdgcn_kernarg_segment_ptr())[i]; } };
struct Frame {
    LAS unsigned char* lds;
    volatile LAS unsigned* MISC;
    gu32* ctl;
    int tid, lane, wave;
    int vcu, G;
    InPtrs in; float* out; unsigned char* ws;
};
enum { I_X = 0, I_C, I_CTX, I_CCTX, I_WMOD, I_BMOD, I_NMIXG, I_NFFNG, I_WOUT, I_EWIN, I_ANORMG, I_AWS, I_ABS, I_BQNG, I_BKNG, I_LQ1, I_LK1, I_LQ2, I_LK2, I_SUBLNG,
       I_FW1, I_FW3, I_FW2, I_OWIN, I_CQNG, I_CKNG, I_CONVW, I_CONVB, I_DWA, I_DBA, I_DWX, I_DBX, I_DLAM, I_RW, I_RB, I_MW1, I_MW3, I_MW2 };

__device__ __forceinline__ float wave_sum(float v) {
#pragma unroll
    for (int o = 1; o < 64; o <<= 1) v += __shfl_xor(v, o);
    return v;
}
__device__ __forceinline__ float bf_lo(unsigned u) { return __uint_as_float(u << 16); }
__device__ __forceinline__ float bf_hi(unsigned u) { return __uint_as_float(u & 0xffff0000u); }
__device__ __forceinline__ float bf2f(bf16 h) { return __uint_as_float((unsigned)h << 16); }
__device__ __forceinline__ unsigned cvtpk(float lo, float hi) { return pg8::cvt_pk_bf16(lo, hi); }
__device__ __forceinline__ bf16 f2bf16(float f) { return (bf16)(cvtpk(f, 0.f) & 0xffffu); }
__device__ __forceinline__ void unpack8(const v4u u, float (&f)[8]) { f[0] = bf_lo(u.x); f[1] = bf_hi(u.x); f[2] = bf_lo(u.y); f[3] = bf_hi(u.y); f[4] = bf_lo(u.z); f[5] = bf_hi(u.z); f[6] = bf_lo(u.w); f[7] = bf_hi(u.w); }
__device__ __forceinline__ v4u pack8(const float (&f)[8]) { v4u o; o.x = cvtpk(f[0], f[1]); o.y = cvtpk(f[2], f[3]); o.z = cvtpk(f[4], f[5]); o.w = cvtpk(f[6], f[7]); return o; }
__device__ __forceinline__ float gelu_tanh(float x) { const float p = fmaf(x * x, -0.10294324f, -2.3022082f); return x * __builtin_amdgcn_rcpf(1.0f + __builtin_amdgcn_exp2f(x * p)); }
__device__ __forceinline__ float sigmoid_f(float x) { return __builtin_amdgcn_rcpf(1.0f + __builtin_amdgcn_exp2f(-1.4426950408889634f * x)); }
__device__ __forceinline__ int crow16(int r, int hi) { return (r & 3) + 8 * (r >> 2) + 4 * hi; }

__device__ __forceinline__ bool qk_bounded(const float* gq, const float* gk, int lane) {
    float a = fabsf(gq[lane]), b = fabsf(gk[lane]);
#pragma unroll
    for (int o = 1; o < 64; o <<= 1) { a = fmaxf(a, __shfl_xor(a, o)); b = fmaxf(b, __shfl_xor(b, o)); }
    return __builtin_amdgcn_readfirstlane((int)(64.0f * QSCALE * a * b * 1.02f < 64.0f)) != 0;
}
struct TrItem { const float* W; unsigned char* WT; int K, N, ilv, f8, item; float scale; };
__device__ __forceinline__ void tr_load(const TrItem& d, int lane, f32x4 (&v)[8]) {
    const int nblk = d.N / 32, kb = d.item / nblk, nb = d.item % nblk; const float* p = d.W + (size_t)(64 * kb + (lane >> 3)) * d.N + 32 * nb + 4 * (lane & 7);
#pragma unroll
    for (int i = 0; i < 8; ++i) v[i] = *(const GAS f32x4*)(p + (size_t)(8 * i) * d.N);
}
__device__ __forceinline__ void tr_store(const TrItem& d, int lane, const f32x4 (&v)[8], LAS float* scr) {
    const int nblk = d.N / 32, kb = d.item / nblk, nb = d.item % nblk, k0 = 64 * kb, n0 = 32 * nb;
    const int r0 = d.ilv ? ((n0 >> 7) * 256 + (n0 & 127) + (d.ilv == 2 ? 128 : 0)) : n0;
#pragma unroll
    for (int i = 0; i < 8; ++i) { LAS float* q = scr + (8 * i + (lane >> 3)) * 33 + 4 * (lane & 7); q[0] = v[i].x * d.scale; q[1] = v[i].y * d.scale; q[2] = v[i].z * d.scale; q[3] = v[i].w * d.scale; }
    LDS_WAIT(); asm volatile("" ::: "memory");
    if (d.f8) { const int c = lane & 3;
#pragma unroll
        for (int j = 0; j < 2; ++j) { const int n = (lane >> 2) + 16 * j; const LAS float* s = scr + (16 * c) * 33 + n;
            v4u o; o.x = pg8::cvt4_fp8(s[0 * 33], s[1 * 33], s[2 * 33], s[3 * 33]); o.y = pg8::cvt4_fp8(s[4 * 33], s[5 * 33], s[6 * 33], s[7 * 33]);
            o.z = pg8::cvt4_fp8(s[8 * 33], s[9 * 33], s[10 * 33], s[11 * 33]); o.w = pg8::cvt4_fp8(s[12 * 33], s[13 * 33], s[14 * 33], s[15 * 33]);
            *(GAS v4u*)(d.WT + (size_t)(r0 + n) * d.K + k0 + 16 * c) = o; }
    } else { const int c = lane & 7;
#pragma unroll
        for (int j = 0; j < 4; ++j) { const int n = (lane >> 3) + 8 * j; const LAS float* s = scr + (8 * c) * 33 + n;
            v4u o; o.x = cvtpk(s[0 * 33], s[1 * 33]); o.y = cvtpk(s[2 * 33], s[3 * 33]); o.z = cvtpk(s[4 * 33], s[5 * 33]); o.w = cvtpk(s[6 * 33], s[7 * 33]);
            *(GAS v4u*)((bf16*)d.WT + (size_t)(r0 + n) * d.K + k0 + 8 * c) = o; } }
    LDS_WAIT(); asm volatile("" ::: "memory");
}
constexpr int TR_I_E = 16 * 80, TR_I_O = 16 * 32, TR_I_F = 16 * 88, TR_I_OI = 16 * 56, TR_I_EXP = 3 * TR_I_F;
constexpr int TR_NITEMS = TR_I_E + 2 * TR_I_O + 3 * TR_I_F + TR_I_OI + NEXP * TR_I_EXP;
static_assert(TR_I_F == 44 * 32, "item counts of the [1024][2816] and [2816][1024] matrices match");
__device__ __forceinline__ TrItem tr_decode(Frame& F, int it) {
    unsigned char* ws = F.ws; int r = it; TrItem d; d.f8 = 0; d.scale = 1.0f; d.ilv = 0;
    if (r < TR_I_E) { d.W = F.in[I_EWIN]; d.K = D; d.N = E_IN; d.WT = ws + WS_WE; d.item = r; return d; } r -= TR_I_E;
    if (r < TR_I_O) { d.W = F.in[I_WOUT]; d.K = D; d.N = D; d.WT = ws + WS_WO0; d.item = r; return d; } r -= TR_I_O;
    if (r < TR_I_O) { d.W = F.in[I_WOUT] + (size_t)D * D; d.K = D; d.N = D; d.WT = ws + WS_WO1; d.item = r; return d; } r -= TR_I_O;
    if (r < TR_I_F) { d.W = F.in[I_FW1]; d.K = D; d.N = FF; d.WT = ws + WS_WF13; d.ilv = 1; d.f8 = 1; d.scale = MOE_S13; d.item = r; return d; } r -= TR_I_F;
    if (r < TR_I_F) { d.W = F.in[I_FW3]; d.K = D; d.N = FF; d.WT = ws + WS_WF13; d.ilv = 2; d.f8 = 1; d.scale = MOE_S13; d.item = r; return d; } r -= TR_I_F;
    if (r < TR_I_F) { d.W = F.in[I_FW2]; d.K = FF; d.N = D; d.WT = ws + WS_WF2; d.f8 = 1; d.scale = MOE_S2; d.item = r; return d; } r -= TR_I_F;
    if (r < TR_I_OI) { d.W = F.in[I_OWIN]; d.K = D; d.N = O_IN; d.WT = ws + WS_WOI; d.item = r; return d; } r -= TR_I_OI;
    const int e = r / TR_I_EXP, q = r % TR_I_EXP; d.f8 = 1;
    if (q < TR_I_F) { d.W = F.in[I_MW1] + (size_t)e * D * FF; d.K = D; d.N = FF; d.WT = ws + WS_WM13 + (size_t)e * FF2 * D; d.ilv = 1; d.scale = MOE_S13; d.item = q; }
    else if (q < 2 * TR_I_F) { d.W = F.in[I_MW3] + (size_t)e * D * FF; d.K = D; d.N = FF; d.WT = ws + WS_WM13 + (size_t)e * FF2 * D; d.ilv = 2; d.scale = MOE_S13; d.item = q - TR_I_F; }
    else { d.W = F.in[I_MW2] + (size_t)e * FF * D; d.K = FF; d.N = D; d.WT = ws + WS_WM2 + (size_t)e * D * FF; d.scale = MOE_S2; d.item = q - 2 * TR_I_F; }
    return d;
}
constexpr int TR_DENSE = TR_I_E + 2 * TR_I_O + 3 * TR_I_F + TR_I_OI;
__device__ __forceinline__ void tr_range(Frame& F, int lo, int hi) {
    LAS float* scr = (LAS float*)(F.lds + RING_OFF + F.wave * 16384);
    const int gw = F.vcu * NWAVES + F.wave, NGW = F.G * NWAVES, lane = F.lane;
    f32x4 v0[8], v1[8], v2[8], v3[8]; TrItem d0, d1, d2, d3; int it = lo + gw;
#define TR_ISSUE(d, v, idx) do { const int i_ = (idx); d = tr_decode(F, i_ < hi ? i_ : lo); if (i_ < hi) tr_load(d, lane, v); } while (0)
    TR_ISSUE(d0, v0, it); TR_ISSUE(d1, v1, it + NGW); TR_ISSUE(d2, v2, it + 2 * NGW);
    while (it < hi) {
        TR_ISSUE(d3, v3, it + 3 * NGW); tr_store(d0, lane, v0, scr); if (it + NGW >= hi) break;
        TR_ISSUE(d0, v0, it + 4 * NGW); tr_store(d1, lane, v1, scr); if (it + 2 * NGW >= hi) break;
        TR_ISSUE(d1, v1, it + 5 * NGW); tr_store(d2, lane, v2, scr); if (it + 3 * NGW >= hi) break;
        TR_ISSUE(d2, v2, it + 6 * NGW); tr_store(d3, lane, v3, scr);
        it += 4 * NGW; }
#undef TR_ISSUE
}
__device__ __forceinline__ void ph0_prologue(Frame& F) {
    const int lane = F.lane;
    tr_range(F, 0, TR_DENSE);
    { bf16* WG = (bf16*)(F.ws + WS_WG);
      for (int i = (int)blockIdx.x * 512 + F.tid; i < 2 * 2 * 8 * 64 * 64; i += F.G * 512) {
          const int k = i & 63, o = (i >> 6) & 63, n = (i >> 12) & 7, mat = (i >> 15) & 1, d = (i >> 16) & 1;
          const float* W = mat ? F.in[I_DWX] : F.in[I_DWA];
          WG[i] = f2bf16(W[((size_t)(d * 8 + n) * 64 + k) * 64 + o]); } }
    __syncthreads();
    { float* MOD = (float*)(F.ws + WS_MOD); LAS float* red = (LAS float*)(F.lds + RING_OFF);
      for (int cg = (int)blockIdx.x; cg < 2 * 96; cg += F.G) {
          const int layer = cg / 96, n0 = (cg % 96) * 64, kr = lane >> 4, c4 = lane & 15;
          f32x4 acc[3]; acc[0] = acc[1] = acc[2] = (f32x4){0.f, 0.f, 0.f, 0.f};
          const float* Wl = F.in[I_WMOD] + (size_t)layer * D * 6 * D;
#pragma unroll 4
          for (int it = 0; it < 32; ++it) { const int k = F.wave * 128 + 4 * it + kr;
              const f32x4 w = *(const GAS f32x4*)(Wl + (size_t)k * 6 * D + n0 + 4 * c4);
              const float c0 = F.in[I_C][k], c1 = F.in[I_C][D + k], c2 = F.in[I_CCTX][k];
              acc[0] += (c0 * sigmoid_f(c0)) * w; acc[1] += (c1 * sigmoid_f(c1)) * w; acc[2] += (c2 * sigmoid_f(c2)) * w; }
#pragma unroll
          for (int s = 0; s < 3; ++s)
#pragma unroll
              for (int j = 0; j < 4; ++j) { float v = acc[s][j]; v += __shfl_xor(v, 16); v += __shfl_xor(v, 32); acc[s][j] = v; }
          if (lane < 16) {
#pragma unroll
              for (int s = 0; s < 3; ++s)
#pragma unroll
                  for (int j = 0; j < 4; ++j) red[(F.wave * 3 + s) * 64 + 4 * c4 + j] = acc[s][j]; }
          __syncthreads();
          if (F.tid < 192) { const int s = F.tid >> 6, col = F.tid & 63; float v = F.in[I_BMOD][layer * 6 * D + n0 + col];
#pragma unroll
              for (int w = 0; w < 8; ++w) v += red[(w * 3 + s) * 64 + col];
              MOD[(size_t)(layer * 3 + s) * 6 * D + n0 + col] = v; }
          __syncthreads();
      } }
}
template <bool F8 = false> __device__ __forceinline__ void normmod_row(const float* src, const float* g, const float* sc, const float* sh, bf16* dst, int lane, f32x4 (&t)[4]) {
    const GAS f32x4* xr = (const GAS f32x4*)src + lane; float s = 0.f;
#pragma unroll
    for (int j = 0; j < 4; ++j) { t[j] = xr[64 * j]; s += (t[j].x * t[j].x + t[j].y * t[j].y) + (t[j].z * t[j].z + t[j].w * t[j].w); }
    const float rstd = 1.0f / sqrtf(wave_sum(s) * (1.f / D) + EPS);
    GAS v2u* o8 = (GAS v2u*)dst + lane;
#pragma unroll
    for (int j = 0; j < 4; ++j) { const f32x4 gg = ((const GAS f32x4*)g)[lane + 64 * j], cc = ((const GAS f32x4*)sc)[lane + 64 * j], hh = ((const GAS f32x4*)sh)[lane + 64 * j];
        t[j] = t[j] * rstd * gg * (1.0f + cc) + hh;
        if constexpr (F8) ((GAS unsigned*)dst)[lane + 64 * j] = pg8::cvt4_fp8(t[j].x, t[j].y, t[j].z, t[j].w); else { v2u w; w.x = cvtpk(t[j].x, t[j].y); w.y = cvtpk(t[j].z, t[j].w); o8[64 * j] = w; } }
}
template <bool F8 = false> __device__ __forceinline__ void ph_normmod(Frame& F, const float* srcL, const float* srcC, int nrows, const float* g, int layer, int sh_off, int sc_off) {
    const int gw = F.vcu * NWAVES + F.wave, NGW = F.G * NWAVES; const float* MOD = (const float*)(F.ws + WS_MOD) + (size_t)layer * 3 * 6 * D; bf16* XN = (bf16*)(F.ws + WS_XN);
    for (int m = gw; m < nrows; m += NGW) { const int s = m < SEQ ? 0 : (m < ML ? 1 : 2); const float* src = m < ML ? srcL + (size_t)m * D : srcC + (size_t)(m - ML) * D; f32x4 t[4];
        normmod_row<F8>(src, g, MOD + s * 6 * D + sc_off, MOD + s * 6 * D + sh_off, F8 ? (bf16*)((unsigned char*)XN + (size_t)m * D) : XN + (size_t)m * D, F.lane, t); }
}
struct RopeLane { float fr[8]; float sgn; int useRow; };
__device__ __forceinline__ RopeLane rope_lane(int lane) { RopeLane R; const int j = lane & 7; R.sgn = (j & 2) ? 1.f : -1.f; R.useRow = (j < 4);
#pragma unroll
    for (int e = 0; e < 8; ++e) R.fr[e] = __builtin_amdgcn_exp2f(-(float)((j & 1) * 8 + e) * (13.287712379549449f / 16.f)) * 0.15915494309189535f;
    return R; }
__device__ __forceinline__ void rope_cs(const RopeLane& R, int prow, int pcol, float (&cs)[8], float (&sn)[8]) {
    const float pos = (float)(R.useRow ? prow : pcol);
#pragma unroll
    for (int e = 0; e < 8; ++e) { float rev = pos * R.fr[e]; rev = rev - floorf(rev); cs[e] = __builtin_amdgcn_cosf(rev); sn[e] = R.sgn * __builtin_amdgcn_sinf(rev); }
}
__device__ __forceinline__ void qknorm_rope(float (&f)[8], const float* g, bool rope, const float (&cs)[8], const float (&sn)[8], float outscale, int lane) {
    float ss = 0.f;
#pragma unroll
    for (int e = 0; e < 8; ++e) ss += f[e] * f[e];
    ss += __shfl_xor(ss, 1); ss += __shfl_xor(ss, 2); ss += __shfl_xor(ss, 4);
    const float rstd = outscale * __builtin_amdgcn_rsqf(ss * (1.f / 64.f) + EPS); const int j = lane & 7;
    const f32x4 g0 = *(const GAS f32x4*)(g + 8 * j), g1 = *(const GAS f32x4*)(g + 8 * j + 4);
    const float gg[8] = {g0.x, g0.y, g0.z, g0.w, g1.x, g1.y, g1.z, g1.w};
#pragma unroll
    for (int e = 0; e < 8; ++e) f[e] = f[e] * (rstd * gg[e]);
    if (rope) {
#pragma unroll
        for (int e = 0; e < 8; ++e) { const float p = __shfl_xor(f[e], 2); f[e] = f[e] * cs[e] + p * sn[e]; }
    }
}
__device__ __forceinline__ void ph3_post0(Frame& F) {
    const int gw = F.vcu * NWAVES + F.wave, NGW = F.G * NWAVES, lane = F.lane; bf16* P0 = (bf16*)(F.ws + WS_P0); bf16* KC = (bf16*)(F.ws + WS_KC0); bf16* VC = (bf16*)(F.ws + WS_VC0); const RopeLane RL = rope_lane(lane);
    for (int m = gw; m < MR; m += NGW) {
        GAS v4u* rowp = (GAS v4u*)(P0 + (size_t)m * E_IN) + lane;
        const v4u u0 = rowp[0], u1 = rowp[64], u2 = rowp[128], u3 = rowp[192];
        float f[8];
        unpack8(u0, f);
#pragma unroll
        for (int e = 0; e < 8; ++e) f[e] = gelu_tanh(f[e]);
        rowp[0] = pack8(f);
        unpack8(u1, f); float ss = 0.f;
#pragma unroll
        for (int e = 0; e < 8; ++e) { f[e] = gelu_tanh(f[e]); ss += f[e] * f[e]; }
        { const float rstd = 1.0f / sqrtf(wave_sum(ss) * (1.f / 512.f) + EPS); const float* g = F.in[I_ANORMG] + 8 * lane;
          const f32x4 g0 = *(const GAS f32x4*)g, g1 = *(const GAS f32x4*)(g + 4); const float gg[8] = {g0.x, g0.y, g0.z, g0.w, g1.x, g1.y, g1.z, g1.w};
#pragma unroll
          for (int e = 0; e < 8; ++e) f[e] = f[e] * rstd * gg[e]; }
        rowp[64] = pack8(f);
        const bool lat = m < ML; const int t = m & (SEQ - 1), prow = t >> 6, pcol = t & 63; float cs[8], sn[8]; if (lat) rope_cs(RL, prow, pcol, cs, sn);
        unpack8(u2, f); qknorm_rope(f, F.in[I_BQNG], lat, cs, sn, QSCALE, lane); rowp[128] = pack8(f);
        unpack8(u3, f); qknorm_rope(f, F.in[I_BKNG], lat, cs, sn, 1.0f, lane);
        { const int b = lat ? (m >> 13) : ((m - ML) >> 8), pos = lat ? CTXL + t : ((m - ML) & (CTXL - 1)); const size_t tb = (size_t)(pos >> 6) * 4096; const int pr = pos & 63;
          *(GAS v4u*)(KC + ((size_t)(b * 8 + (lane >> 3)) * KEYS * 64 + tb + (lane & 7) * 512 + pr * 8)) = pack8(f);
          const v4u u4 = rowp[256];
          *(GAS v4u*)(VC + ((size_t)(b * 8 + (lane >> 3)) * KEYS * 64 + tb + ((((lane & 7) >> 2) * 4 + (pr >> 4)) * 64 + (pr & 15) * 4 + (lane & 3)) * 8)) = u4; }
    }
}
__device__ __forceinline__ void gmlp_unit(Frame& F, int chunk) {
    const int lane = F.lane, r32 = lane & 31, hi = lane >> 5, g = F.wave, r0 = chunk * 128;
    const bf16* P0 = (const bf16*)(F.ws + WS_P0); bf16* Y = (bf16*)(F.ws + WS_Y);
    const float* ws = F.in[I_AWS] + (size_t)g * 128 * 128; const float* bs = F.in[I_ABS] + g * 128;
    bf16x8 afr[2][8];
#pragma unroll
    for (int ct = 0; ct < 2; ++ct)
#pragma unroll
        for (int ks = 0; ks < 8; ++ks)
#pragma unroll
            for (int e = 0; e < 8; ++e) afr[ct][ks][e] = (short)P0[(size_t)(r0 + 16 * ks + 8 * hi + e) * E_IN + 512 + 64 * g + 32 * ct + r32];
#pragma unroll 1
    for (int pt = 0; pt < 4; ++pt) {
        f32x16 acc[2]; acc[0] = f32x16{}; acc[1] = f32x16{};
        const float* wp = ws + (size_t)(32 * pt + r32) * 128 + 8 * hi;
#pragma unroll
        for (int ks = 0; ks < 8; ++ks) { const f32x4 w0 = *(const GAS f32x4*)(wp + 16 * ks), w1 = *(const GAS f32x4*)(wp + 16 * ks + 4);
            v4u pk; pk.x = cvtpk(w0.x, w0.y); pk.y = cvtpk(w0.z, w0.w); pk.z = cvtpk(w1.x, w1.y); pk.w = cvtpk(w1.z, w1.w); const bf16x8 bfr = __builtin_bit_cast(bf16x8, pk);
            acc[0] = __builtin_amdgcn_mfma_f32_32x32x16_bf16(afr[0][ks], bfr, acc[0], 0, 0, 0); acc[1] = __builtin_amdgcn_mfma_f32_32x32x16_bf16(afr[1][ks], bfr, acc[1], 0, 0, 0); }
        const int p = 32 * pt + r32; const float bias = bs[p];
#pragma unroll
        for (int ct = 0; ct < 2; ++ct)
#pragma unroll
            for (int rq = 0; rq < 4; ++rq) { const int c0 = 64 * g + 32 * ct + 8 * rq + 4 * hi;
                const v2u uu = *(const GAS v2u*)(P0 + (size_t)(r0 + p) * E_IN + c0);
                v2u o; o.x = cvtpk(bf_lo(uu.x) * (acc[ct][4 * rq + 0] + bias), bf_hi(uu.x) * (acc[ct][4 * rq + 1] + bias)); o.y = cvtpk(bf_lo(uu.y) * (acc[ct][4 * rq + 2] + bias), bf_hi(uu.y) * (acc[ct][4 * rq + 3] + bias));
                *(GAS v2u*)(Y + (size_t)(r0 + p) * D + c0) = o; }
    }
}
__device__ __forceinline__ void ph5_diffout(Frame& F) {
    const int gw = F.vcu * NWAVES + F.wave, NGW = F.G * NWAVES, lane = F.lane; const bf16* OA = (const bf16*)(F.ws + WS_OATT); bf16* Y = (bf16*)(F.ws + WS_Y);
    const float s1 = wave_sum(F.in[I_LQ1][lane] * F.in[I_LK1][lane]), s2 = wave_sum(F.in[I_LQ2][lane] * F.in[I_LK2][lane]);
    const float lam_init = 0.2f, lam = expf(s1) - expf(s2) + lam_init;
    const int h = lane >> 4, comp = (lane >> 3) & 1, i0 = (lane & 7) * 16;
    float gg[16];
#pragma unroll
    for (int q = 0; q < 4; ++q) { const f32x4 gv = *(const GAS f32x4*)(F.in[I_SUBLNG] + i0 + 4 * q); gg[4 * q] = gv.x; gg[4 * q + 1] = gv.y; gg[4 * q + 2] = gv.z; gg[4 * q + 3] = gv.w; }
    for (int m = gw; m < MR; m += NGW) {
        const GAS v4u* rp = (const GAS v4u*)(OA + (size_t)m * D + 16 * lane);
        const v4u a = rp[0], b = rp[1]; float own[16], d[16];
        { float t8[8]; unpack8(a, t8);
#pragma unroll
          for (int e = 0; e < 8; ++e) own[e] = t8[e];
          unpack8(b, t8);
#pragma unroll
          for (int e = 0; e < 8; ++e) own[8 + e] = t8[e]; }
        float ss = 0.f;
#pragma unroll
        for (int e = 0; e < 16; ++e) { const float oth = __shfl_xor(own[e], 8); const float o1 = comp ? oth : own[e], o2 = comp ? own[e] : oth; d[e] = o1 - lam * o2; ss += d[e] * d[e]; }
        ss += __shfl_xor(ss, 1); ss += __shfl_xor(ss, 2); ss += __shfl_xor(ss, 4);
        const float rstd = (1.0f - lam_init) / sqrtf(ss * (1.f / 128.f) + EPS);
        if (comp == 0) { float o8[8]; GAS v4u* yp = (GAS v4u*)(Y + (size_t)m * D + 512 + 128 * h + i0);
#pragma unroll
            for (int e = 0; e < 8; ++e) o8[e] = d[e] * rstd * gg[e];
            yp[0] = pack8(o8);
#pragma unroll
            for (int e = 0; e < 8; ++e) o8[e] = d[8 + e] * rstd * gg[8 + e];
            yp[1] = pack8(o8); }
    }
}
__device__ __forceinline__ void ph12_post1(Frame& F) {
    const int nskip = (NCHUNK > F.G && NCHUNK - F.G < F.G / 2) ? NCHUNK - F.G : 0;
    if (F.vcu < nskip) return;
    const int gw = (F.vcu - nskip) * NWAVES + F.wave, NGW = (F.G - nskip) * NWAVES, lane = F.lane; bf16* P1 = (bf16*)(F.ws + WS_P1); bf16* KC = (bf16*)(F.ws + WS_KC1); bf16* VC = (bf16*)(F.ws + WS_VC1); const RopeLane RL = rope_lane(lane);
    for (int m = gw; m < MR; m += NGW) {
        GAS v4u* rowp = (GAS v4u*)(P1 + (size_t)m * O_IN) + lane;
        const v4u u0 = rowp[0], u1 = rowp[64];
        const bool lat = m < ML; const int t = m & (SEQ - 1), prow = t >> 6, pcol = t & 63; float f[8]; float cs[8], sn[8]; if (lat) rope_cs(RL, prow, pcol, cs, sn);
        unpack8(u0, f); qknorm_rope(f, F.in[I_CQNG], lat, cs, sn, QSCALE, lane); if (lat) rowp[0] = pack8(f);
        unpack8(u1, f); qknorm_rope(f, F.in[I_CKNG], lat, cs, sn, 1.0f, lane);
        { const int b = lat ? (m >> 13) : ((m - ML) >> 8), pos = lat ? CTXL + t : ((m - ML) & (CTXL - 1)); const size_t tb = (size_t)(pos >> 6) * 4096; const int pr = pos & 63, l2 = lane & 15;
          if (lane < 16) *(GAS v4u*)(KC + ((size_t)(b * 2 + (l2 >> 3)) * KEYS * 64 + tb + (l2 & 7) * 512 + pr * 8)) = pack8(f);
          else if (lane < 32) *(GAS v4u*)(VC + ((size_t)(b * 2 + (l2 >> 3)) * KEYS * 64 + tb + ((((l2 & 7) >> 2) * 4 + (pr >> 4)) * 64 + (pr & 15) * 4 + (l2 & 3)) * 8)) = u1; }
    }
}
__device__ __forceinline__ bool seq_start(int r) { return r < ML ? (r & (SEQ - 1)) == 0 : ((r - ML) & (CTXL - 1)) == 0; }
constexpr int XDS = 520;
__device__ __forceinline__ void conv_to_lds(Frame& F, int r0, LAS bf16* XD) {
    const int cg = F.lane, w = F.wave; const bf16* P1 = (const bf16*)(F.ws + WS_P1);
    const bool st = seq_start(r0), en = seq_start(r0 + 64) || (r0 + 64 == MR);
    float wj[4][8], cb[8];
#pragma unroll
    for (int j = 0; j < 4; ++j) { const f32x4 a = *(const GAS f32x4*)(F.in[I_CONVW] + j * 512 + 8 * cg), b = *(const GAS f32x4*)(F.in[I_CONVW] + j * 512 + 8 * cg + 4);
        wj[j][0] = a.x; wj[j][1] = a.y; wj[j][2] = a.z; wj[j][3] = a.w; wj[j][4] = b.x; wj[j][5] = b.y; wj[j][6] = b.z; wj[j][7] = b.w; }
    { const f32x4 a = *(const GAS f32x4*)(F.in[I_CONVB] + 8 * cg), b = *(const GAS f32x4*)(F.in[I_CONVB] + 8 * cg + 4); cb[0] = a.x; cb[1] = a.y; cb[2] = a.z; cb[3] = a.w; cb[4] = b.x; cb[5] = b.y; cb[6] = b.z; cb[7] = b.w; }
    v4u xr[11];
#pragma unroll
    for (int i = 0; i < 11; ++i) { const int rl = 8 * w + i - 2; const bool ok = !((st && rl < 0) || (en && rl >= 64));
        xr[i] = ok ? *(const GAS v4u*)(P1 + (size_t)(r0 + rl) * O_IN + 1280 + 8 * cg) : (v4u){0u, 0u, 0u, 0u}; }
    float acc[8][8];
#pragma unroll
    for (int o = 0; o < 8; ++o)
#pragma unroll
        for (int e = 0; e < 8; ++e) acc[o][e] = cb[e];
#pragma unroll
    for (int i = 0; i < 11; ++i) { float f[8]; unpack8(xr[i], f);
#pragma unroll
        for (int j = 0; j < 4; ++j) { const int o = i - j; if (o >= 0 && o < 8) {
#pragma unroll
            for (int e = 0; e < 8; ++e) acc[o][e] += wj[j][e] * f[e]; } } }
#pragma unroll
    for (int o = 0; o < 8; ++o) *(LAS v4u*)(XD + (8 * w + o) * XDS + 8 * cg) = pack8(acc[o]);
}
__device__ __forceinline__ void lru_gates(Frame& F, const LAS bf16* XD, int n, int d, int half, f32x16 (&a)[2], f32x16 (&b)[2]) {
    const int lane = F.lane, r32 = lane & 31, hi = lane >> 5; const bf16* WG = (const bf16*)(F.ws + WS_WG);
    f32x16 ai[2]; a[0] = f32x16{}; a[1] = f32x16{}; ai[0] = f32x16{}; ai[1] = f32x16{};
    const bf16* wpr = WG + ((size_t)(((d * 2 + 0) * 8 + n) * 64 + 32 * half + r32)) * 64 + 8 * hi; const bf16* wpi = WG + ((size_t)(((d * 2 + 1) * 8 + n) * 64 + 32 * half + r32)) * 64 + 8 * hi;
#pragma unroll
    for (int ks = 0; ks < 4; ++ks) { const bf16x8 br = *(const GAS bf16x8*)(wpr + 16 * ks), bi = *(const GAS bf16x8*)(wpi + 16 * ks);
#pragma unroll
        for (int mt = 0; mt < 2; ++mt) { const bf16x8 af = *(const LAS bf16x8*)(XD + (32 * mt + r32) * XDS + 64 * n + 16 * ks + 8 * hi);
            a[mt] = __builtin_amdgcn_mfma_f32_32x32x16_bf16(af, br, a[mt], 0, 0, 0); ai[mt] = __builtin_amdgcn_mfma_f32_32x32x16_bf16(af, bi, ai[mt], 0, 0, 0); } }
    __builtin_amdgcn_sched_barrier(0);
    const int ch = 64 * n + 32 * half + r32; const float ba = F.in[I_DBA][d * 512 + ch], bx = F.in[I_DBX][d * 512 + ch];
    const float spl = -8.0f * 1.4426950408889634f * log1pf(expf(-F.in[I_DLAM][d * 512 + ch]));
    const float nba = -1.4426950408889634f * ba, nbx = -1.4426950408889634f * bx;
#pragma unroll
    for (int mt = 0; mt < 2; ++mt)
#pragma unroll
        for (int r = 0; r < 16; ++r) { const int row = 32 * mt + crow16(r, hi); const float xd = bf2f(XD[row * XDS + ch]);
            const float rr = __builtin_amdgcn_rcpf(1.0f + __builtin_amdgcn_exp2f(fmaf(a[mt][r], -1.4426950408889634f, nba))), ii = __builtin_amdgcn_rcpf(1.0f + __builtin_amdgcn_exp2f(fmaf(ai[mt][r], -1.4426950408889634f, nbx)));
            const float av = __builtin_amdgcn_exp2f(rr * spl), om = fmaxf(fmaf(-av, av, 1.0f), 0.0f);
            a[mt][r] = av; b[mt][r] = __builtin_amdgcn_sqrtf(om) * (ii * xd);     if ((r & 3) == 3) __builtin_amdgcn_sched_barrier(0); }
}
template <bool REV, bool FULL> __device__ __forceinline__ void chunk_scan(f32x16 (&a)[2], f32x16 (&b)[2], int hi, float h0, float& Atot, float& Btot) {
    float GA[8], GB[8], pGA[8], pGB[8], carry[8];
#pragma unroll
    for (int j = 0; j < 8; ++j) { const int mt = j >> 2, q = j & 3;
#pragma unroll
        for (int p = 1; p < 4; ++p) { const int k = REV ? 3 - p : p, kp = REV ? k + 1 : k - 1; const float ak = a[mt][4 * q + k];
            b[mt][4 * q + k] = ak * b[mt][4 * q + kp] + b[mt][4 * q + k]; a[mt][4 * q + k] = ak * a[mt][4 * q + kp]; }
        GA[j] = a[mt][4 * q + (REV ? 0 : 3)]; GB[j] = b[mt][4 * q + (REV ? 0 : 3)]; }
#pragma unroll
    for (int j = 0; j < 8; ++j) { const auto ra = __builtin_amdgcn_permlane32_swap(__float_as_uint(GA[j]), __float_as_uint(GA[j]), false, false); pGA[j] = __uint_as_float(hi ? ra[0] : ra[1]);
        const auto rb = __builtin_amdgcn_permlane32_swap(__float_as_uint(GB[j]), __float_as_uint(GB[j]), false, false); pGB[j] = __uint_as_float(hi ? rb[0] : rb[1]); }
    float c = h0, At = 1.0f; const bool firstMine = REV ? (hi == 1) : (hi == 0);
#pragma unroll
    for (int jj = 0; jj < 8; ++jj) { const int j = REV ? 7 - jj : jj;
        const float A1 = firstMine ? GA[j] : pGA[j], B1 = firstMine ? GB[j] : pGB[j], A2 = firstMine ? pGA[j] : GA[j], B2 = firstMine ? pGB[j] : GB[j];
        const float c1 = A1 * c + B1; carry[j] = firstMine ? c : c1; c = A2 * c1 + B2; At *= GA[j] * pGA[j]; }
    Atot = At; Btot = c;
    if constexpr (FULL) {
#pragma unroll
        for (int j = 0; j < 8; ++j) { const int mt = j >> 2, q = j & 3;
#pragma unroll
            for (int k = 0; k < 4; ++k) b[mt][4 * q + k] = a[mt][4 * q + k] * carry[j] + b[mt][4 * q + k]; }
    }
}
__device__ __forceinline__ void scan_prep_unit(Frame& F, int cid) {
    const int r0 = cid * 64, lane = F.lane, r32 = lane & 31, hi = lane >> 5, n = F.wave; LAS bf16* XD = (LAS bf16*)(F.lds + RING_OFF); float* AGG = (float*)(F.ws + WS_AGG);
    conv_to_lds(F, r0, XD);
    LDS_WAIT(); __syncthreads();
#pragma unroll
    for (int d = 0; d < 2; ++d)
#pragma unroll
        for (int half = 0; half < 2; ++half) { f32x16 a[2], b[2]; lru_gates(F, XD, n, d, half, a, b); float At, Bt;
            if (d == 0) chunk_scan<false, false>(a, b, hi, 0.f, At, Bt); else chunk_scan<true, false>(a, b, hi, 0.f, At, Bt);
            if (hi == 0) { const int ch = 64 * n + 32 * half + r32; AGG[((size_t)(d * NCHUNK + cid) * 2 + 0) * 512 + ch] = At; AGG[((size_t)(d * NCHUNK + cid) * 2 + 1) * 512 + ch] = Bt; } }
    LDS_WAIT(); __syncthreads();
}
__device__ __forceinline__ void scan_fix_unit(Frame& F, int cid) {
    const int b = cid >> 7, j = cid & 127, r0 = cid * 64, lane = F.lane, r32 = lane & 31, hi = lane >> 5, n = F.wave;
    const float* AGG = (const float*)(F.ws + WS_AGG); const bf16* P1 = (const bf16*)(F.ws + WS_P1); bf16* Y = (bf16*)(F.ws + WS_Y);
    LAS bf16* XD = (LAS bf16*)(F.lds + RING_OFF); LAS float* CAR = (LAS float*)(F.lds + RING_OFF + 64 * XDS * 2);
    conv_to_lds(F, r0, XD);
    asm volatile("" ::: "memory"); __builtin_amdgcn_sched_barrier(0);
    { const int ch = F.tid; const float* A0 = AGG + ch; const float* A1 = AGG + (size_t)NCHUNK * 1024 + ch;
      float hf = 0.f, hb = 0.f;
#pragma unroll
      for (int q = 0; q < 4; ++q) { const int c = 256 + 4 * b + q; hf = A0[(size_t)c * 1024] * hf + A0[(size_t)c * 1024 + 512]; }
#pragma unroll 8
      for (int q = 0; q < j; ++q) { const int c = 128 * b + q; hf = A0[(size_t)c * 1024] * hf + A0[(size_t)c * 1024 + 512]; }
#pragma unroll
      for (int q = 3; q >= 0; --q) { const int c = 256 + 4 * b + q; hb = A1[(size_t)c * 1024] * hb + A1[(size_t)c * 1024 + 512]; }
#pragma unroll 8
      for (int q = 127; q > j; --q) { const int c = 128 * b + q; hb = A1[(size_t)c * 1024] * hb + A1[(size_t)c * 1024 + 512]; }
      CAR[ch] = hf; CAR[512 + ch] = hb; }
    LDS_WAIT(); __syncthreads();
#pragma unroll 1
    for (int half = 0; half < 2; ++half) { const int ch = 64 * n + 32 * half + r32; f32x16 a[2], hf[2], hb[2]; float At, Bt;
        lru_gates(F, XD, n, 0, half, a, hf); chunk_scan<false, true>(a, hf, hi, CAR[ch], At, Bt);
        __builtin_amdgcn_sched_barrier(0); lru_gates(F, XD, n, 1, half, a, hb); chunk_scan<true, true>(a, hb, hi, CAR[512 + ch], At, Bt);
        const bf16* gp = P1 + (size_t)r0 * O_IN + 768; bf16* yp = Y + (size_t)r0 * D + 512;
#pragma unroll
        for (int mt = 0; mt < 2; ++mt)
#pragma unroll
            for (int q = 0; q < 4; ++q) {
#pragma unroll
                for (int k = 0; k < 4; ++k) { const unsigned rl = (unsigned)(32 * mt + 8 * q + 4 * hi + k); const float gt = bf2f(gp[rl * (unsigned)O_IN + (unsigned)ch]);
                    yp[rl * (unsigned)D + (unsigned)ch] = f2bf16((hf[mt][4 * q + k] + hb[mt][4 * q + k]) * gelu_tanh(gt)); }
                asm volatile("" ::: "memory"); } }
    LDS_WAIT(); __syncthreads();
}
__device__ __forceinline__ void ph15_router(Frame& F) {
    LAS float* WR = (LAS float*)(F.lds + RING_OFF);
    LAS int* lcnt = (LAS int*)(F.lds + RING_OFF + 32768); LAS int* lbase = lcnt + 8; LAS int* rec = lcnt + 16;
    LAS unsigned char* STG = F.lds + RING_OFF + 40960;
    const int lane = F.lane; const float* MOD = (const float*)(F.ws + WS_MOD) + (size_t)3 * 6 * D; unsigned char* XG = F.ws + WS_XG; int* TOK = (int*)(F.ws + WS_TOK);
    for (int i = F.tid; i < 1024 * 8 / 4; i += NWAVES * 64) ((LAS f32x4*)WR)[i] = ((const GAS f32x4*)F.in[I_RW])[i];
    __syncthreads();
    for (int rb = F.vcu; rb < ML / 64; rb += F.G) {
        if (F.tid < 8) lcnt[F.tid] = 0;
        __syncthreads();
#pragma unroll 1
        for (int i = 0; i < 8; ++i) { const int rl = F.wave * 8 + i, m = rb * 64 + rl, s = m >> 13; f32x4 t[4];
            { const GAS f32x4* xr = (const GAS f32x4*)(F.out + (size_t)m * D) + lane; float q = 0.f;
#pragma unroll
              for (int j = 0; j < 4; ++j) { t[j] = xr[64 * j]; q += (t[j].x * t[j].x + t[j].y * t[j].y) + (t[j].z * t[j].z + t[j].w * t[j].w); }
              const float rstd = 1.0f / sqrtf(wave_sum(q) * (1.f / D) + EPS); const float* g = F.in[I_NFFNG] + D; const float* sc = MOD + s * 6 * D + 4 * D; const float* sh = MOD + s * 6 * D + 3 * D;
#pragma unroll
              for (int j = 0; j < 4; ++j) { const f32x4 gg = ((const GAS f32x4*)g)[lane + 64 * j], cc = ((const GAS f32x4*)sc)[lane + 64 * j], hh = ((const GAS f32x4*)sh)[lane + 64 * j];
                  t[j] = t[j] * rstd * gg * (1.0f + cc) + hh; ((LAS unsigned*)(STG + rl * 1024))[lane + 64 * j] = pg8::cvt4_fp8(t[j].x, t[j].y, t[j].z, t[j].w); } }
            float lg[8];
#pragma unroll
            for (int e = 0; e < 8; ++e) lg[e] = 0.f;
#pragma unroll
            for (int j = 0; j < 4; ++j)
#pragma unroll
                for (int k = 0; k < 4; ++k) { const int c = 4 * lane + 256 * j + k; const f32x4 w0 = *(const LAS f32x4*)(WR + c * 8), w1 = *(const LAS f32x4*)(WR + c * 8 + 4); const float tv = t[j][k];
                    lg[0] += tv * w0.x; lg[1] += tv * w0.y; lg[2] += tv * w0.z; lg[3] += tv * w0.w; lg[4] += tv * w1.x; lg[5] += tv * w1.y; lg[6] += tv * w1.z; lg[7] += tv * w1.w; }
#pragma unroll
            for (int e = 0; e < 8; ++e) lg[e] = wave_sum(lg[e]) + F.in[I_RB][e];
            int e1 = 0; float v1 = lg[0];
#pragma unroll
            for (int e = 1; e < 8; ++e) if (lg[e] > v1) { v1 = lg[e]; e1 = e; }
            int e2 = -1; float v2 = -INFINITY;
#pragma unroll
            for (int e = 0; e < 8; ++e) if (e != e1 && lg[e] > v2) { v2 = lg[e]; e2 = e; }
            const float g1 = 1.0f / (1.0f + expf(v2 - v1)), g2 = 1.0f - g1;
            if (lane == 0) { LAS int* rc = rec + rl * 6; rc[0] = e1; rc[1] = e2; rc[2] = (int)__hip_atomic_fetch_add((LAS unsigned*)(lcnt + e1), 1u, __ATOMIC_RELAXED, __HIP_MEMORY_SCOPE_WORKGROUP);
                rc[3] = (int)__hip_atomic_fetch_add((LAS unsigned*)(lcnt + e2), 1u, __ATOMIC_RELAXED, __HIP_MEMORY_SCOPE_WORKGROUP); rc[4] = __float_as_int(g1); rc[5] = __float_as_int(g2); }
        }
        LDS_WAIT(); __syncthreads();
        if (F.tid < 8) lbase[F.tid] = (int)__hip_atomic_fetch_add((unsigned*)(F.ctl + CW_CNT + 64 * F.tid), (unsigned)lcnt[F.tid], __ATOMIC_RELAXED, __HIP_MEMORY_SCOPE_AGENT);
        LDS_WAIT(); __syncthreads();
        if (F.tid < 64) { const LAS int* rc = rec + F.tid * 6; int* tk = TOK + (size_t)(rb * 64 + F.tid) * 6;
            tk[0] = rc[0]; tk[1] = rc[1]; tk[2] = lbase[rc[0]] + rc[2]; tk[3] = lbase[rc[1]] + rc[3]; tk[4] = rc[4]; tk[5] = rc[5]; }
#pragma unroll
        for (int i = 0; i < 8; ++i) { const int rl = F.wave * 8 + i; const LAS int* rc = rec + rl * 6; const v4u row = *(const LAS v4u*)(STG + rl * 1024 + 16 * lane);
            const int e1 = rc[0], e2 = rc[1], p1 = lbase[e1] + rc[2], p2 = lbase[e2] + rc[3];
            *(GAS v4u*)(XG + ((size_t)e1 * ML + p1) * D + 16 * lane) = row; *(GAS v4u*)(XG + ((size_t)e2 * ML + p2) * D + 16 * lane) = row; }
        LDS_WAIT(); __syncthreads();
    }
}
__device__ __forceinline__ void moe_offsets(Frame& F, int (&off)[9]) {
    int o = 0;
#pragma unroll
    for (int e = 0; e < 8; ++e) { off[e] = o; const int c = (int)__hip_atomic_load((unsigned*)(F.ctl + CW_CNT + 64 * e), __ATOMIC_RELAXED, __HIP_MEMORY_SCOPE_AGENT); o += (c + 255) & ~255; }
    off[8] = o;
}
__device__ __forceinline__ int moe_tables(Frame& F) {
    int off[9]; moe_offsets(F, off); LAS int* pexp = (LAS int*)(F.lds + PEXP_OFF);
    if (F.tid < MOE_PAN) { const int r = F.tid * 256; int e = 0;
#pragma unroll
        for (int q = 1; q < 8; ++q) e = (r >= off[q]) ? q : e;
        pexp[F.tid] = e; }
    if (F.tid < 8) pexp[140 + F.tid] = off[F.tid] / 256;
    __syncthreads();
    return off[8] / 256;
}
__device__ __forceinline__ void ph19_combine(Frame& F) {
    int off[9]; moe_offsets(F, off);
    const int gw = F.vcu * NWAVES + F.wave, NGW = F.G * NWAVES, lane = F.lane; const bf16* YG = (const bf16*)(F.ws + WS_YG); const int* TOK = (const int*)(F.ws + WS_TOK);
    const float* MOD = (const float*)(F.ws + WS_MOD) + (size_t)3 * 6 * D;
    for (int m = gw; m < ML; m += NGW) { const int* tk = TOK + (size_t)m * 6; const int e1 = tk[0], e2 = tk[1]; int b1 = 0, b2 = 0;
#pragma unroll
        for (int q = 0; q < 8; ++q) { b1 = (e1 == q) ? off[q] : b1; b2 = (e2 == q) ? off[q] : b2; }
        const float g1 = __int_as_float(tk[4]), g2 = __int_as_float(tk[5]); const float* gp = MOD + (m >> 13) * 6 * D + 5 * D;
        const GAS v2u* y1 = (const GAS v2u*)(YG + (size_t)(b1 + tk[2]) * D) + lane; const GAS v2u* y2 = (const GAS v2u*)(YG + (size_t)(b2 + tk[3]) * D) + lane;
        GAS f32x4* o = (GAS f32x4*)(F.out + (size_t)m * D) + lane;
#pragma unroll
        for (int j = 0; j < 4; ++j) { const v2u a = y1[64 * j], b = y2[64 * j]; const f32x4 gv = ((const GAS f32x4*)gp)[lane + 64 * j]; f32x4 x = o[64 * j];
            x.x += gv.x * (g1 * bf_lo(a.x) + g2 * bf_lo(b.x)); x.y += gv.y * (g1 * bf_hi(a.x) + g2 * bf_hi(b.x)); x.z += gv.z * (g1 * bf_lo(a.y) + g2 * bf_lo(b.y)); x.w += gv.w * (g1 * bf_hi(a.y) + g2 * bf_hi(b.y));
            o[64 * j] = x; } }
}
struct Args { const float* in[38]; float* out; unsigned char* ws; int ph_lo, ph_hi; };
__global__ void __launch_bounds__(NWAVES * 64, 2) mk_fwd(Args args) {
    extern __shared__ __attribute__((aligned(16))) unsigned char lds[];
    Frame F;
    F.lds = (LAS unsigned char*)lds;
    F.MISC = (volatile LAS unsigned*)(F.lds + MISC_OFF);
    F.tid = threadIdx.x; F.lane = F.tid & 63; F.wave = __builtin_amdgcn_readfirstlane(F.tid >> 6);
    F.G = gridDim.x; { const int bx = blockIdx.x; F.vcu = (F.G % 8 == 0) ? (bx % 8) * (F.G / 8) + bx / 8 : bx; }
    F.ws = args.ws; F.out = args.out; F.ctl = (gu32*)(args.ws + WS_CTL);
    for (int u = F.tid; u < (LDS_BYTES - LDSCTL_OFF) / 4; u += NWAVES * 64) ((LAS unsigned*)(F.lds + LDSCTL_OFF))[u] = 0u;
    __syncthreads();
    XcdBarrier bar; bar.bar = (unsigned*)(F.ctl + CW_BAR); bar.x = 0; bar.st = nullptr;
    if (MK_ONE_LAUNCH) bar = xcd_barrier_post((unsigned*)(F.ctl + CW_BAR), F.MISC + 8);
#define GRID_BAR() do { if (MK_ONE_LAUNCH) xcd_barrier(bar); } while (0)
    const int lo = args.ph_lo, hi = args.ph_hi;
#define RELANE() do { int t_ = (int)threadIdx.x; asm volatile("" : "+v"(t_)); F.tid = t_; F.lane = t_ & 63; } while (0)
#define IN(k) (lo <= (k) && (k) < hi)
#define BOTH(k) (IN(k) && IN((k) + 1))
#ifndef MK_REP_MASK
#define MK_REP_MASK 0
#endif
#define REP(k) for (int rep_ = 0; rep_ < (((MK_REP_MASK >> (k)) & 1) ? 2 : 1); ++rep_)
    unsigned char* ws = args.ws;
    bf16* XN = (bf16*)(ws + WS_XN); bf16* Y = (bf16*)(ws + WS_Y); bf16* P0 = (bf16*)(ws + WS_P0); bf16* P1 = (bf16*)(ws + WS_P1); bf16* OA = (bf16*)(ws + WS_OATT); bf16* Hb = (bf16*)(ws + WS_H);
    float* XR = (float*)(ws + WS_XR); const float* MOD = (const float*)(ws + WS_MOD);
    using ABF = attn_body::bf16;

    if (IN(0)) { RELANE(); REP(0) { ph0_prologue(F); __syncthreads(); } if (BOTH(0)) GRID_BAR(); }
    if (IN(1)) { RELANE(); REP(1) ph_normmod(F, F.in[I_X], F.in[I_CTX], MR, F.in[I_NMIXG], 0, 0, D); if (BOTH(1)) GRID_BAR(); }
    if (IN(2)) { RELANE();
        pg8::Gemm g{XN, (const bf16*)(ws + WS_WE), MR, E_IN, D}; pg8::StaticOrder S; S.init(MR, E_IN, F.G, (int)blockIdx.x);
        pg8::EpiBf16<0> E{P0, E_IN, nullptr, 0, 0, 1.f};
        REP(2) pg8::gemm_phase<pg8::EpiBf16<0>, pg8::StaticOrder, PG8_ALIGN, PG8_SP2>(F.lds + RING_OFF, g, S, E);
        if (BOTH(2)) GRID_BAR();
    }
    if (IN(3)) { RELANE(); ph3_post0(F); if (BOTH(3)) GRID_BAR(); }
    if (IN(4)) { RELANE();
        const bool nomax0 = qk_bounded(F.in[I_BQNG], F.in[I_BKNG], F.lane);
        const int trslot = F.vcu % 3;
        float lam; { const int ln = F.lane; const float s1 = wave_sum(F.in[I_LQ1][ln] * F.in[I_LK1][ln]), s2 = wave_sum(F.in[I_LQ2][ln] * F.in[I_LK2][ln]); lam = expf(s1) - expf(s2) + 0.2f; }
        REP(4) for (int i = 0;; ++i) { const int L = i * F.G + F.vcu; if (L >= 256 + 8) break;
            const bool lat = L < 256; const int bh4 = lat ? (L >> 5) : (L - 256), qb = lat ? (L & 31) : 0, b = bh4 >> 2, h = bh4 & 3;
            const size_t qrow0 = lat ? (size_t)b * SEQ + (size_t)qb * 256 : (size_t)(ML + b * CTXL); const int NT = lat ? 132 : 4, rot = lat ? (F.vcu & 31) * 4 : 0;
            const ABF* Vs = (const ABF*)(ws + WS_VC0) + (size_t)(b * 8 + 2 * h) * KEYS * 64; ABF* O1 = (ABF*)(OA + qrow0 * D + 256 * h); ABF* Yo = (ABF*)(Y + qrow0 * D + 512 + 128 * h);
#pragma unroll 1
            for (int sc = 0; sc < 3; ++sc) {
                if (lat && sc == trslot && rep_ == 0) { tr_range(F, TR_DENSE, TR_NITEMS); LDS_WAIT(); __syncthreads(); }
                if (sc < 2) { const ABF* Ks = (const ABF*)(ws + WS_KC0) + (size_t)(b * 8 + 2 * h + sc) * KEYS * 64; const ABF* Q = (const ABF*)(P0 + qrow0 * E_IN + 1024 + 128 * h + 64 * sc);
                    if (sc == 1) VM_WAIT();
                    if (nomax0) attn_body::attn_unit2<-1>(Q, E_IN, Ks, Vs, Vs + (size_t)KEYS * 64, sc ? Yo : O1, D, NT, rot, (char*)lds + RING_OFF, sc == 1, O1, D, lam, F.in[I_SUBLNG], 0.8f);
                    else attn_body::attn_unit2<8>(Q, E_IN, Ks, Vs, Vs + (size_t)KEYS * 64, sc ? Yo : O1, D, NT, rot, (char*)lds + RING_OFF, sc == 1, O1, D, lam, F.in[I_SUBLNG], 0.8f); } } }
        RELANE();
        REP(4) for (int c = F.vcu - 32; c >= 0 && c < MR / 128; c += F.G) gmlp_unit(F, c);
        if (BOTH(4)) GRID_BAR();
    }
    if (IN(6)) { RELANE();
        pg8::Gemm g{Y, (const bf16*)(ws + WS_WO0), MR, D, D}; pg8::StaticOrder S; S.init(MR, D, F.G, (int)blockIdx.x);
        pg8::EpiResGate E{F.in[I_X], F.in[I_CTX], XR, MOD + 2 * D, 1.0f};
        REP(6) pg8::gemm_phase<pg8::EpiResGate, pg8::StaticOrder, PG8_ALIGN, PG8_SP2>(F.lds + RING_OFF, g, S, E);
        if (BOTH(6)) GRID_BAR();
    }
    if (IN(7)) { RELANE(); REP(7) ph_normmod<true>(F, XR, XR + (size_t)ML * D, MR, F.in[I_NFFNG], 0, 3 * D, 4 * D); if (BOTH(7)) GRID_BAR(); }
    if (IN(8)) { RELANE();
        pg8::Gemm g{XN, (const bf16*)(ws + WS_WF13), MR, FF2, D / 2}; pg8::StaticOrder S; S.init(MR, FF2, F.G, (int)blockIdx.x);
        pg8::EpiSwiGLUF8 E{(unsigned char*)Hb, FF, FF2 / 256, 1.0f / MOE_S13};
        REP(8) pg8::gemm_phase<pg8::EpiSwiGLUF8, pg8::StaticOrder, PG8_ALIGN, PG8_SP2, true>(F.lds + RING_OFF, g, S, E);
        if (BOTH(8)) GRID_BAR();
    }
    if (IN(9)) { RELANE();
        pg8::Gemm g{Hb, (const bf16*)(ws + WS_WF2), MR, D, FF / 2}; pg8::StaticOrder S; S.init(MR, D, F.G, (int)blockIdx.x);
        pg8::EpiResGate E{XR, XR + (size_t)ML * D, XR, MOD + 5 * D, 1.0f / MOE_S2};
        REP(9) pg8::gemm_phase<pg8::EpiResGate, pg8::StaticOrder, PG8_ALIGN, PG8_SP2, true>(F.lds + RING_OFF, g, S, E);
        if (BOTH(9)) GRID_BAR();
    }
    if (IN(10)) { RELANE(); REP(10) ph_normmod(F, XR, XR + (size_t)ML * D, MR, F.in[I_NMIXG] + D, 1, 0, D); if (BOTH(10)) GRID_BAR(); }
    if (IN(11)) { RELANE();
        pg8::Gemm g{XN, (const bf16*)(ws + WS_WOI), MR, O_IN, D}; pg8::StaticOrder S; S.init(MR, O_IN, F.G, (int)blockIdx.x);
        pg8::EpiBf16<0> E{P1, O_IN, nullptr, 0, 0, 1.f};
        REP(11) pg8::gemm_phase<pg8::EpiBf16<0>, pg8::StaticOrder, PG8_ALIGN, PG8_SP2>(F.lds + RING_OFF, g, S, E);
        if (BOTH(11)) GRID_BAR();
    }
    if (IN(12)) { RELANE();
        ph12_post1(F);
        REP(12) for (int c = F.vcu; c < NCHUNK; c += F.G) scan_prep_unit(F, c);
        if (BOTH(12)) GRID_BAR();
    }
    if (IN(13)) { RELANE();
        REP(13) for (int c = F.vcu; c < ML / 64; c += F.G) scan_fix_unit(F, c);
        const bool nomax1 = qk_bounded(F.in[I_CQNG], F.in[I_CKNG], F.lane);
        REP(13) for (int i = 0;; ++i) { const int L = i * F.G + F.vcu; if (L >= 512) break;
            const int bh = L >> 5, qb = L & 31, b = bh >> 3, hq = bh & 7, kv = hq >> 2;
            const size_t crow0 = (size_t)(ML + b * CTXL), lrow0 = (size_t)b * SEQ, qrow0 = lrow0 + (size_t)qb * 256;
            const ABF* Ks = (const ABF*)(ws + WS_KC1) + (size_t)(b * 2 + kv) * KEYS * 64; const ABF* Vs = (const ABF*)(ws + WS_VC1) + (size_t)(b * 2 + kv) * KEYS * 64;
            if (nomax1) attn_body::attn_unit<-1, true>((const ABF*)(P1 + qrow0 * O_IN + 64 * hq), O_IN, Ks, Ks + 4 * 4096, 64, Vs, Vs + 4 * 4096, 64, (ABF*)(Y + qrow0 * D + 64 * hq), D, 132, 4, (F.vcu & 31) * 4, (char*)lds + RING_OFF);
            else attn_body::attn_unit<8, true>((const ABF*)(P1 + qrow0 * O_IN + 64 * hq), O_IN, Ks, Ks + 4 * 4096, 64, Vs, Vs + 4 * 4096, 64, (ABF*)(Y + qrow0 * D + 64 * hq), D, 132, 4, (F.vcu & 31) * 4, (char*)lds + RING_OFF); }
        if (BOTH(13)) GRID_BAR();
    }
    if (IN(14)) { RELANE();
        pg8::Gemm g{Y, (const bf16*)(ws + WS_WO1), ML, D, D}; pg8::StaticOrder S; S.init(ML, D, F.G, (int)blockIdx.x);
        pg8::EpiResGate E{XR, XR, F.out, MOD + 3 * 6 * D + 2 * D, 1.0f};
        REP(14) pg8::gemm_phase<pg8::EpiResGate, pg8::StaticOrder, PG8_ALIGN, PG8_SP2>(F.lds + RING_OFF, g, S, E);
        if (BOTH(14)) GRID_BAR();
    }
    if (IN(15)) { RELANE(); ph15_router(F); if (BOTH(15)) GRID_BAR(); }
    if (IN(17)) { RELANE();
        const int npan = moe_tables(F);
        pg8::Gemm g{(const bf16*)(ws + WS_XG), (const bf16*)(ws + WS_WM13), MOE_ROWS, NEXP * FF2, D / 2}; pg8::MoeOrder S{npan, FF2 / 256, F.G, F.vcu, (const LAS int*)(F.lds + PEXP_OFF), true};
        pg8::EpiSwiGLUF8 E{ws + WS_HG, FF, FF2 / 256, 1.0f / MOE_S13};
        REP(17) pg8::gemm_phase<pg8::EpiSwiGLUF8, pg8::MoeOrder, PG8_ALIGN, PG8_SP2, true>(F.lds + RING_OFF, g, S, E);
        if (BOTH(17)) GRID_BAR();
    }
    if (IN(18)) { RELANE();
        const int npan = moe_tables(F);
        pg8::Gemm g{(const bf16*)(ws + WS_HG), (const bf16*)(ws + WS_WM2), MOE_ROWS, NEXP * D, FF / 2}; pg8::MoeOrder S{npan, D / 256, F.G, F.vcu, (const LAS int*)(F.lds + PEXP_OFF), false};
        pg8::EpiBf16S E{(bf16*)(ws + WS_YG), D, D / 256, 1.0f / MOE_S2};
        REP(18) pg8::gemm_phase<pg8::EpiBf16S, pg8::MoeOrder, PG8_ALIGN, PG8_SP2, true>(F.lds + RING_OFF, g, S, E);
        if (BOTH(18)) GRID_BAR();
    }
    if (IN(19)) { RELANE(); ph19_combine(F); }
#undef IN
#undef BOTH
#undef GRID_BAR
}

extern "C" void kernel_launch(void* const* d_in, const int* in_sizes, int n_in, void* d_out, int out_size, void* d_ws, size_t ws_size, hipStream_t stream) {
    static int grid = 0;
    if (grid == 0) {
        if (n_in != 38 || in_sizes[0] != ML * D || out_size != ML * D || ws_size < WS_END) { fprintf(stderr, "kernel_launch: built for 38 inputs, x/out of %d floats, >= %zu bytes of workspace; got n_in %d, in0 %d, out %d, ws %zu; nothing launched\n", ML * D, (size_t)WS_END, n_in, n_in > 0 ? in_sizes[0] : -1, out_size, ws_size); grid = -1; return; }
        int dev = 0, cus = 0, per_cu = 0;
        if (hipGetDevice(&dev) != hipSuccess || hipDeviceGetAttribute(&cus, hipDeviceAttributeMultiprocessorCount, dev) != hipSuccess) { fprintf(stderr, "kernel_launch: device query failed\n"); grid = -1; return; }
        if (hipFuncSetAttribute((const void*)mk_fwd, hipFuncAttributeMaxDynamicSharedMemorySize, LDS_BYTES) != hipSuccess) { fprintf(stderr, "kernel_launch: hipFuncSetAttribute failed\n"); grid = -1; return; }
        if (hipOccupancyMaxActiveBlocksPerMultiprocessor(&per_cu, (const void*)mk_fwd, NWAVES * 64, LDS_BYTES) != hipSuccess || per_cu < 1) fprintf(stderr, "kernel_launch: note: occupancy query reports %d workgroups per CU\n", per_cu);
        (void)hipGetLastError();
        grid = cus;
    }
    if (grid < 0) return;
    if (hipMemsetAsync((char*)d_ws + WS_CTL, 0, CTL_ZERO_BYTES, stream) != hipSuccess) { fprintf(stderr, "kernel_launch: hipMemsetAsync failed\n"); return; }
    Args a{};
    for (int i = 0; i < 38; ++i) a.in[i] = (const float*)d_in[i];
    a.out = (float*)d_out; a.ws = (unsigned char*)d_ws;
#if MK_ONE_LAUNCH
    a.ph_lo = 0; a.ph_hi = NPH;
    hipLaunchKernelGGL(mk_fwd, dim3(grid), dim3(NWAVES * 64), LDS_BYTES, stream, a);
#else
    for (int ph = 0; ph < NPH; ++ph) { a.ph_lo = ph; a.ph_hi = ph + 1; hipLaunchKernelGGL(mk_fwd, dim3(grid), dim3(NWAVES * 64), LDS_BYTES, stream, a); }
#endif
    const hipError_t le = hipPeekAtLastError();
    if (le != hipSuccess) fprintf(stderr, "kernel_launch: launch failed: %s\n", hipGetErrorName(le));
}
```

```cpp
#include <hip/hip_runtime.h>
#include <cstdio>
#include <cstdint>
#include <cmath>
namespace pg8 {
#define PG8_LAS __attribute__((address_space(3)))
typedef unsigned short bf16_t;
typedef short bf16x8 __attribute__((ext_vector_type(8)));
typedef float f32x4 __attribute__((ext_vector_type(4)));
typedef unsigned u32x4 __attribute__((ext_vector_type(4)));
typedef int i32x4 __attribute__((ext_vector_type(4)));
typedef int i32x8 __attribute__((ext_vector_type(8)));
typedef unsigned u32x2 __attribute__((ext_vector_type(2)));
constexpr int BM = 256, BK = 64, HALF = 128, HTB = HALF * BK * 2  , STAGE_BYTES = 8 * HTB, NXCD = 8, WGM = 8;

__host__ __device__ __forceinline__ int lds_byte(int r, int c) { const int st = (r >> 4) * 2 + (c >> 5), rr = r & 15, cc = c & 31, ob = rr * 64 + cc * 2; return st * 1024 + (ob ^ (((ob >> 9) & 1) << 5)); }
__host__ __device__ __forceinline__ void stage_rc(int b, int& R, int& C) { const int st = b / 1024, sb = b % 1024, swz = sb ^ (((sb >> 9) & 1) << 5); R = (st >> 1) * 16 + swz / 64; C = (st & 1) * 32 + (swz % 64) / 2; }
__host__ __device__ __forceinline__ int perm32(int rho) { const int n = rho >> 4, i = rho & 15; return 8 * (i >> 2) + 4 * n + (i & 3); }

struct Unit { int pm, pn, pa; };
struct Gemm { const bf16_t* A; const bf16_t* Bt; int M, N, K; };

struct StaticOrder {
    int nM, nN, nwg, G, c;
    __host__ __device__ void init(int M, int N, int G_, int c_) { nM = M / BM; nN = N / BM; nwg = nM * nN; G = G_; c = c_; }
    __host__ __device__ bool next(int i, Unit& u) const {
        const long L = (long)i * G + c; if (L >= nwg) return false;
        int wgid = (int)L; { const int q = nwg / NXCD, r = nwg % NXCD, xcd = wgid % NXCD, off = wgid / NXCD; wgid = (xcd < r ? xcd * (q + 1) : r * (q + 1) + (xcd - r) * q) + off; }
        const int nig = WGM * nN, gid = wgid / nig, fm = gid * WGM, gsz = (nM - fm) < WGM ? (nM - fm) : WGM;
        u.pm = fm + ((wgid % nig) % gsz); u.pn = (wgid % nig) / gsz; u.pa = u.pm; return true;
    }
    __device__ __forceinline__ void a_ready(const Unit&) const {}
    __device__ __forceinline__ void done(const Unit&) const {}
};

__device__ __forceinline__ unsigned cvt_pk_bf16(float lo, float hi) { unsigned r; asm volatile("v_cvt_pk_bf16_f32 %0, %1, %2" : "=v"(r) : "v"(lo), "v"(hi)); return r; }
typedef float f32x2 __attribute__((ext_vector_type(2)));
__device__ __forceinline__ f32x2 gelu_pk(f32x2 v) {
    const f32x2 av = __builtin_elementwise_abs(v), d = av * 0.2316418882f + 1.0f;
    f32x2 t; t.x = __builtin_amdgcn_rcpf(d.x); t.y = __builtin_amdgcn_rcpf(d.y);
    f32x2 q = t * 0.5307027145f + (-0.7265760135f); q = q * t + 0.7107068705f; q = q * t + (-0.142248368f); q = q * t + 0.127414796f; q = q * t;
    const f32x2 s = (v * v) * (-0.72134752044f);
    f32x2 e; e.x = __builtin_amdgcn_exp2f(s.x); e.y = __builtin_amdgcn_exp2f(s.y);
    const f32x2 m = v * (q * e), r = v - m;
    f32x2 o; o.x = v.x < 0.f ? m.x : r.x; o.y = v.y < 0.f ? m.y : r.y; return o;
}

template <int ACT  > struct EpiBf16 {
    static constexpr bool PERM = true, AFTER_DRAIN = false; static_assert(ACT == 0 || ACT == 1, "EpiBf16: ACT is 0 (none) or 1 (gelu_pk)");
    bf16_t* O; int ldc; const float* bias; int split_cols; size_t split_stride; float scale0;
    __device__ __forceinline__ void operator()(const f32x4 (&acc)[2][2][4][2], const Unit& u, int wr, int wc, int fr, int fq) const {
        const int row0 = u.pm * BM + wr * 64 + fr; int colt = u.pn * BM; bf16_t* base = O;
        float sc = 1.f; if (split_cols) { const int t = colt / split_cols; base += (size_t)t * split_stride; colt -= t * split_cols; if (t == 0) sc = scale0; }
        const int col0 = colt + wc * 32 + 8 * fq, bcol0 = u.pn * BM + wc * 32 + 8 * fq;
        f32x4 bv[2][2];
#pragma unroll
        for (int bj = 0; bj < 2; ++bj)
#pragma unroll
            for (int n = 0; n < 2; ++n) bv[bj][n] = bias ? *(const f32x4*)(bias + bcol0 + bj * HALF + 4 * n) : (f32x4){0.f, 0.f, 0.f, 0.f};
#pragma unroll
        for (int ai = 0; ai < 2; ++ai)
#pragma unroll
            for (int m = 0; m < 4; ++m) { bf16_t* rowp = base + (size_t)(row0 + ai * HALF + m * 16) * ldc + col0;
#pragma unroll
                for (int bj = 0; bj < 2; ++bj) { f32x4 v0 = acc[ai][bj][m][0] + bv[bj][0], v1 = acc[ai][bj][m][1] + bv[bj][1];
                    if (ACT == 1) { f32x2 a = gelu_pk((f32x2){v0[0], v0[1]}), b = gelu_pk((f32x2){v0[2], v0[3]}), c = gelu_pk((f32x2){v1[0], v1[1]}), d = gelu_pk((f32x2){v1[2], v1[3]});
                        v0 = (f32x4){a.x, a.y, b.x, b.y}; v1 = (f32x4){c.x, c.y, d.x, d.y}; }
                    v0 = v0 * sc; v1 = v1 * sc; u32x4 w; w.x = cvt_pk_bf16(v0[0], v0[1]); w.y = cvt_pk_bf16(v0[2], v0[3]); w.z = cvt_pk_bf16(v1[0], v1[1]); w.w = cvt_pk_bf16(v1[2], v1[3]);
                    *(u32x4*)(rowp + bj * HALF) = w; } }
    }
};
struct EpiResGate {
    static constexpr bool PERM = false, AFTER_DRAIN = false;
    const float* baseL; const float* baseC; float* out; const float* gate; float ascale;
    __device__ __forceinline__ void operator()(const f32x4 (&acc)[2][2][4][2], const Unit& u, int wr, int wc, int fr, int fq) const {
        const int s = u.pm < 32 ? 0 : (u.pm < 64 ? 1 : 2);
        const float* gp = gate + s * 6144;
        const float* base = u.pm < 64 ? baseL + (size_t)u.pm * BM * 1024 : baseC + (size_t)(u.pm - 64) * BM * 1024;
        float* o = out + (size_t)u.pm * BM * 1024;
        const int col0 = u.pn * BM + wc * 32 + 4 * fq;
        f32x4 gv[2][2];
#pragma unroll
        for (int bj = 0; bj < 2; ++bj)
#pragma unroll
            for (int n = 0; n < 2; ++n) gv[bj][n] = *(const f32x4*)(gp + col0 + bj * HALF + n * 16) * ascale;
#pragma unroll
        for (int ai = 0; ai < 2; ++ai)
#pragma unroll
            for (int m = 0; m < 4; ++m) { const size_t off = (size_t)(ai * HALF + wr * 64 + m * 16 + fr) * 1024 + col0;
#pragma unroll
                for (int bj = 0; bj < 2; ++bj)
#pragma unroll
                    for (int n = 0; n < 2; ++n) { const f32x4 bs = *(const f32x4*)(base + off + bj * HALF + n * 16); *(f32x4*)(o + off + bj * HALF + n * 16) = bs + gv[bj][n] * acc[ai][bj][m][n]; }
                if (m & 1) asm volatile("" ::: "memory"); }
    }
};
struct EpiSwiGLU {
    static constexpr bool PERM = true, AFTER_DRAIN = false;
    bf16_t* H; int ldh; int ntl;
    __device__ __forceinline__ void operator()(const f32x4 (&acc)[2][2][4][2], const Unit& u, int wr, int wc, int fr, int fq) const {
        const int row0 = u.pm * BM + wr * 64 + fr; const int ct = u.pn % ntl; const int col0 = ct * HALF + wc * 32 + 8 * fq;
#pragma unroll
        for (int ai = 0; ai < 2; ++ai)
#pragma unroll
            for (int m = 0; m < 4; ++m) { bf16_t* rowp = H + (size_t)(row0 + ai * HALF + m * 16) * ldh + col0;
                float hv[8];
#pragma unroll
                for (int n = 0; n < 2; ++n)
#pragma unroll
                    for (int j = 0; j < 4; ++j) { const float a = acc[ai][0][m][n][j], b = acc[ai][1][m][n][j];
                        const float e = __builtin_amdgcn_exp2f(a * -1.4426950408889634f); hv[n * 4 + j] = a * __builtin_amdgcn_rcpf(1.0f + e) * b; }
                u32x4 w; w.x = cvt_pk_bf16(hv[0], hv[1]); w.y = cvt_pk_bf16(hv[2], hv[3]); w.z = cvt_pk_bf16(hv[4], hv[5]); w.w = cvt_pk_bf16(hv[6], hv[7]);
                *(u32x4*)rowp = w; }
    }
};
__device__ __forceinline__ unsigned cvt4_fp8(float a, float b, float c, float d) { unsigned w = 0u; w = (unsigned)__builtin_amdgcn_cvt_pk_fp8_f32(a, b, (int)w, false); w = (unsigned)__builtin_amdgcn_cvt_pk_fp8_f32(c, d, (int)w, true); return w; }
struct EpiSwiGLUF8 {
    static constexpr bool PERM = true, AFTER_DRAIN = false;
    unsigned char* H; int ldh; int ntl; float s;
    __device__ __forceinline__ void operator()(const f32x4 (&acc)[2][2][4][2], const Unit& u, int wr, int wc, int fr, int fq) const {
        const int row0 = u.pm * BM + wr * 64 + fr; const int ct = u.pn % ntl; const int col0 = ct * HALF + wc * 32 + 8 * fq;
#pragma unroll
        for (int ai = 0; ai < 2; ++ai)
#pragma unroll
            for (int m = 0; m < 4; ++m) { unsigned char* rowp = H + (size_t)(row0 + ai * HALF + m * 16) * ldh + col0;
                float hv[8];
#pragma unroll
                for (int n = 0; n < 2; ++n)
#pragma unroll
                    for (int j = 0; j < 4; ++j) { const float a = acc[ai][0][m][n][j], b = acc[ai][1][m][n][j];
                        const float e = __builtin_amdgcn_exp2f(a * (s * -1.4426950408889634f)); hv[n * 4 + j] = (a * b) * (s * s) * __builtin_amdgcn_rcpf(1.0f + e); }
                u32x2 w; w.x = cvt4_fp8(hv[0], hv[1], hv[2], hv[3]); w.y = cvt4_fp8(hv[4], hv[5], hv[6], hv[7]);
                *(u32x2*)rowp = w; }
    }
};
struct EpiBf16S {
    static constexpr bool PERM = true, AFTER_DRAIN = false;
    bf16_t* O; int ldc; int ntl; float s;
    __device__ __forceinline__ void operator()(const f32x4 (&acc)[2][2][4][2], const Unit& u, int wr, int wc, int fr, int fq) const {
        const int row0 = u.pm * BM + wr * 64 + fr; const int col0 = (u.pn % ntl) * BM + wc * 32 + 8 * fq;
#pragma unroll
        for (int ai = 0; ai < 2; ++ai)
#pragma unroll
            for (int m = 0; m < 4; ++m) { bf16_t* rowp = O + (size_t)(row0 + ai * HALF + m * 16) * ldc + col0;
#pragma unroll
                for (int bj = 0; bj < 2; ++bj) { const f32x4 v0 = acc[ai][bj][m][0] * s, v1 = acc[ai][bj][m][1] * s;
                    u32x4 w; w.x = cvt_pk_bf16(v0[0], v0[1]); w.y = cvt_pk_bf16(v0[2], v0[3]); w.z = cvt_pk_bf16(v1[0], v1[1]); w.w = cvt_pk_bf16(v1[2], v1[3]);
                    *(u32x4*)(rowp + bj * HALF) = w; } }
    }
};
struct MoeOrder {
    int npan, ntl, G, c; const PG8_LAS int* pexp; bool capA;
    __device__ __forceinline__ bool next(int i, Unit& u) const {
        const long L = (long)i * G + c; if (L >= (long)npan * ntl) return false;
        const int pm = (int)(L / ntl), j = (int)(L % ntl); const int e = __builtin_amdgcn_readfirstlane(pexp[pm]); u.pm = pm; u.pn = e * ntl + j; u.pa = capA ? 64 * e + pm - __builtin_amdgcn_readfirstlane(pexp[140 + e]) : pm; return true;
    }
    __device__ __forceinline__ void a_ready(const Unit&) const {}
    __device__ __forceinline__ void done(const Unit&) const {}
};
template <class Epi, class Sched, bool ALIGN_EPI = false, bool SP2 = false, bool FP8 = false>
__device__ __forceinline__ void gemm_phase(PG8_LAS unsigned char* lds, const Gemm g, const Sched& S, const Epi& E) {
    const int tid = threadIdx.x, wid = __builtin_amdgcn_readfirstlane(tid >> 6), lane = tid & 63, wr = wid >> 2, wc = wid & 3, fr = lane & 15, fq = lane >> 4;
    const int K = g.K, nt = K / BK;
    unsigned voffA[2], voffB[2];
#pragma unroll
    for (int i = 0; i < 2; ++i) { int R, C; stage_rc(tid * 16 + i * 8192, R, C); const int Rb = Epi::PERM ? ((R & ~31) + perm32(R & 31)) : R;
        voffA[i] = (unsigned)(R * K + C) * 2u; voffB[i] = (unsigned)(Rb * K + C) * 2u; }
    const size_t kstep = (size_t)(BK * 2);
    const size_t hstep = (size_t)HALF * K * 2;
    const size_t tstep = 2 * hstep;
    const unsigned ldsw = (unsigned)wid * 1024u;
    const int aoff = lds_byte(wr * 64 + fr, fq * 8), boff = lds_byte(wc * 32 + fr, fq * 8);
#define PG8_SA(b, h) (((b) * 2 + (h)) * HTB)
#define PG8_SB(b, h) ((4 + (b) * 2 + (h)) * HTB)
#define PG8_STAGE(bufoff, gbase, voff) do { _Pragma("unroll") for (int _i = 0; _i < 2; ++_i) \
        __builtin_amdgcn_global_load_lds((const unsigned*)((const char*)(gbase) + (voff)[_i]), (PG8_LAS unsigned*)(lds + (bufoff) + ldsw + _i * 8192), 16, 0, 0); } while (0)
#define PG8_CAT(x, y) __builtin_shufflevector(__builtin_bit_cast(i32x4, x), __builtin_bit_cast(i32x4, y), 0, 1, 2, 3, 4, 5, 6, 7)
#define PG8_LDA(dst, b, h) do { if constexpr (FP8) { _Pragma("unroll") for (int m = 0; m < 4; ++m) dst##8[m] = PG8_CAT(*(const PG8_LAS bf16x8*)(lds + PG8_SA(b, h) + aoff + m * 2048), *(const PG8_LAS bf16x8*)(lds + PG8_SA(b, h) + aoff + m * 2048 + 1024)); } else { \
        _Pragma("unroll") for (int m = 0; m < 4; ++m) _Pragma("unroll") for (int k = 0; k < 2; ++k) dst[m][k] = *(const PG8_LAS bf16x8*)(lds + PG8_SA(b, h) + aoff + m * 2048 + k * 1024); } } while (0)
#define PG8_LDB(dst, b, h) do { if constexpr (FP8) { _Pragma("unroll") for (int n = 0; n < 2; ++n) dst##8[n] = PG8_CAT(*(const PG8_LAS bf16x8*)(lds + PG8_SB(b, h) + boff + n * 2048), *(const PG8_LAS bf16x8*)(lds + PG8_SB(b, h) + boff + n * 2048 + 1024)); } else { \
        _Pragma("unroll") for (int n = 0; n < 2; ++n) _Pragma("unroll") for (int k = 0; k < 2; ++k) dst[n][k] = *(const PG8_LAS bf16x8*)(lds + PG8_SB(b, h) + boff + n * 2048 + k * 1024); } } while (0)
#define PG8_MMA(ai, bj, At, Bt) do { __builtin_amdgcn_s_setprio(1); if constexpr (FP8) { _Pragma("unroll") for (int m = 0; m < 4; ++m) _Pragma("unroll") for (int n = 0; n < 2; ++n) \
        asm volatile("v_mfma_f32_16x16x128_f8f6f4 %0, %1, %2, %0" : "+v"(acc[ai][bj][m][n]) : "v"(Bt##8[n]), "v"(At##8[m]));   } else { \
        _Pragma("unroll") for (int m = 0; m < 4; ++m) _Pragma("unroll") for (int n = 0; n < 2; ++n) _Pragma("unroll") for (int k = 0; k < 2; ++k) \
        acc[ai][bj][m][n] = __builtin_amdgcn_mfma_f32_16x16x32_bf16(Bt[n][k], At[m][k], acc[ai][bj][m][n], 0, 0, 0); } __builtin_amdgcn_s_setprio(0); } while (0)
#define PG8_WAIT_V(n) asm volatile("s_waitcnt vmcnt(" #n ")" ::: "memory")
#define PG8_WAIT_L(n) asm volatile("s_waitcnt lgkmcnt(" #n ")" ::: "memory")
#define PG8_BAR __builtin_amdgcn_s_barrier()
#define PG8_SCHED __builtin_amdgcn_sched_barrier(0)
    Unit cur, nxt; int ui = 0;
    if (!S.next(0, cur)) return;
    f32x4 acc[2][2][4][2];
#pragma unroll
    for (int a = 0; a < 2; ++a)
#pragma unroll
        for (int b = 0; b < 2; ++b)
#pragma unroll
            for (int m = 0; m < 4; ++m)
#pragma unroll
                for (int n = 0; n < 2; ++n) acc[a][b][m][n] = (f32x4){0.f, 0.f, 0.f, 0.f};
    bf16x8 At[4][2], B0[2][2], B1[2][2]; i32x8 At8[4], B08[2], B18[2];
    const char* cA = (const char*)g.A + (size_t)cur.pa * tstep; const char* cB = (const char*)g.Bt + (size_t)cur.pn * tstep;
    S.a_ready(cur);
    if constexpr (SP2) {
        PG8_STAGE(PG8_SB(0, 0), cB, voffB); PG8_STAGE(PG8_SB(0, 1), cB + hstep, voffB); PG8_STAGE(PG8_SA(0, 0), cA, voffA); PG8_STAGE(PG8_SA(0, 1), cA + hstep, voffA);
        if (wr == 1) PG8_BAR;
        PG8_WAIT_V(2); PG8_BAR;
        PG8_STAGE(PG8_SB(1, 0), cB + kstep, voffB); PG8_STAGE(PG8_SA(1, 0), cA + kstep, voffA); PG8_STAGE(PG8_SB(1, 1), cB + hstep + kstep, voffB);
        PG8_WAIT_V(6); PG8_BAR;
    } else {
        PG8_STAGE(PG8_SB(0, 0), cB, voffB); PG8_STAGE(PG8_SA(0, 0), cA, voffA); PG8_STAGE(PG8_SB(0, 1), cB + hstep, voffB); PG8_STAGE(PG8_SA(0, 1), cA + hstep, voffA);
        if (wr == 1) PG8_BAR;
        PG8_WAIT_V(4); PG8_BAR;
        PG8_STAGE(PG8_SB(1, 0), cB + kstep, voffB); PG8_STAGE(PG8_SA(1, 0), cA + kstep, voffA); PG8_STAGE(PG8_SB(1, 1), cB + hstep + kstep, voffB);
        PG8_WAIT_V(6); PG8_BAR;
    }
    for (;;) {
        const bool has_next = S.next(ui + 1, nxt);
        const char* nA = has_next ? (const char*)g.A + (size_t)nxt.pa * tstep : cA; const char* nB = has_next ? (const char*)g.Bt + (size_t)nxt.pn * tstep : cB;
#pragma unroll 1
        for (int t = 0; t < nt; t += 2) {
            const bool last = (t == nt - 2);
            const char* a1 = cA + (size_t)(t + 1) * kstep;
            const char* a2 = last ? nA : cA + (size_t)(t + 2) * kstep; const char* b2 = last ? nB : cB + (size_t)(t + 2) * kstep;
            const char* a3 = a2 + kstep; const char* b3 = b2 + kstep;
            if (last && has_next) S.a_ready(nxt);
            if constexpr (SP2) {
            PG8_LDB(B0, 0, 0); PG8_LDB(B1, 0, 1); PG8_SCHED; PG8_LDA(At, 0, 0); PG8_STAGE(PG8_SA(1, 1), a1 + hstep, voffA);
            PG8_WAIT_V(8); PG8_WAIT_L(0); PG8_BAR; PG8_MMA(0, 0, At, B0); PG8_MMA(0, 1, At, B1); PG8_BAR; PG8_SCHED;
            PG8_LDA(At, 0, 1); PG8_STAGE(PG8_SB(0, 0), b2, voffB); PG8_STAGE(PG8_SB(0, 1), b2 + hstep, voffB); PG8_STAGE(PG8_SA(0, 0), a2, voffA);
            PG8_WAIT_V(8); PG8_WAIT_L(0); PG8_BAR; PG8_MMA(1, 0, At, B0); PG8_MMA(1, 1, At, B1); PG8_BAR; PG8_SCHED;
            PG8_LDB(B0, 1, 0); PG8_LDB(B1, 1, 1); PG8_SCHED; PG8_LDA(At, 1, 0); PG8_STAGE(PG8_SA(0, 1), a2 + hstep, voffA);
            PG8_WAIT_V(8); PG8_WAIT_L(0); PG8_BAR; PG8_MMA(0, 0, At, B0); PG8_MMA(0, 1, At, B1); PG8_BAR; PG8_SCHED;
            PG8_LDA(At, 1, 1); PG8_STAGE(PG8_SB(1, 0), b3, voffB); PG8_STAGE(PG8_SB(1, 1), b3 + hstep, voffB); PG8_STAGE(PG8_SA(1, 0), a3, voffA);
            PG8_WAIT_V(8); PG8_WAIT_L(0); PG8_BAR; PG8_MMA(1, 0, At, B0); PG8_MMA(1, 1, At, B1); PG8_BAR; PG8_SCHED;
            } else {
            PG8_LDB(B0, 0, 0); PG8_SCHED; PG8_LDA(At, 0, 0); PG8_STAGE(PG8_SA(1, 1), a1 + hstep, voffA);
            PG8_WAIT_L(8); PG8_BAR; PG8_WAIT_L(0); PG8_MMA(0, 0, At, B0); PG8_BAR; PG8_SCHED;
            PG8_LDB(B1, 0, 1); PG8_STAGE(PG8_SB(0, 0), b2, voffB);
            PG8_BAR; PG8_WAIT_L(0); PG8_MMA(0, 1, At, B1); PG8_BAR;
            PG8_LDA(At, 0, 1); PG8_STAGE(PG8_SA(0, 0), a2, voffA);
            PG8_BAR; PG8_WAIT_L(0); PG8_MMA(1, 0, At, B0); PG8_BAR; PG8_SCHED;
            PG8_STAGE(PG8_SB(0, 1), b2 + hstep, voffB);
            PG8_WAIT_V(6); PG8_BAR; PG8_MMA(1, 1, At, B1); PG8_BAR;
            PG8_LDB(B0, 1, 0); PG8_SCHED; PG8_LDA(At, 1, 0); PG8_STAGE(PG8_SA(0, 1), a2 + hstep, voffA);
            PG8_WAIT_L(8); PG8_BAR; PG8_WAIT_L(0); PG8_MMA(0, 0, At, B0); PG8_BAR; PG8_SCHED;
            PG8_LDB(B1, 1, 1); PG8_STAGE(PG8_SB(1, 0), b3, voffB);
            PG8_BAR; PG8_WAIT_L(0); PG8_MMA(0, 1, At, B1); PG8_BAR;
            PG8_LDA(At, 1, 1); PG8_STAGE(PG8_SA(1, 0), a3, voffA);
            PG8_BAR; PG8_WAIT_L(0); PG8_MMA(1, 0, At, B0); PG8_BAR; PG8_SCHED;
            PG8_STAGE(PG8_SB(1, 1), b3 + hstep, voffB);
            PG8_WAIT_V(6); PG8_BAR; PG8_MMA(1, 1, At, B1); PG8_BAR;
            }
        }
        if constexpr (FP8) asm volatile("s_nop 15\n\ts_nop 15" ::: "memory");
        if constexpr (ALIGN_EPI) { if (wr == 0) PG8_BAR; }
        if constexpr (!Epi::AFTER_DRAIN) { E(acc, cur, wr, wc, fr, fq); S.done(cur); }
        if (!has_next) break;
#pragma unroll
        for (int a = 0; a < 2; ++a)
#pragma unroll
            for (int b = 0; b < 2; ++b)
#pragma unroll
                for (int m = 0; m < 4; ++m)
#pragma unroll
                    for (int n = 0; n < 2; ++n) acc[a][b][m][n] = (f32x4){0.f, 0.f, 0.f, 0.f};
        cur = nxt; cA = nA; cB = nB; ++ui;
        if constexpr (ALIGN_EPI) { if (wr == 1) PG8_BAR; }
    }
    PG8_WAIT_V(0);
    if constexpr (!ALIGN_EPI) { if (wr == 0) PG8_BAR; }
    PG8_BAR;
    if constexpr (Epi::AFTER_DRAIN) { E.fused(acc, cur, wr, wc, fr, fq, lds, wid, lane); S.done(cur); }
#undef PG8_SA
#undef PG8_SB
#undef PG8_STAGE
#undef PG8_LDA
#undef PG8_LDB
#undef PG8_MMA
#undef PG8_CAT
#undef PG8_WAIT_V
#undef PG8_WAIT_L
#undef PG8_BAR
#undef PG8_SCHED
}
}

#ifndef PG8_SP2
#define PG8_SP2 true
#endif
#ifndef PG8_ALIGN
#define PG8_ALIGN true
#endif
#include <hip/hip_bf16.h>
#include <cmath>
namespace attn_body {
using bf16=__hip_bfloat16;
using bf16x8=__attribute__((ext_vector_type(8)))short;
using s16x4=__attribute__((ext_vector_type(4)))short;
using f32x16=__attribute__((ext_vector_type(16)))float;
using u32x4=__attribute__((ext_vector_type(4)))unsigned;
constexpr int D=64;
constexpr int NW=8,QBLK=32,QB=QBLK*NW,KVBLK=64;
constexpr int ATTN_UNIT_ROWS=QB;
__device__ __forceinline__ int crow(int r,int hi){return (r&3)+8*(r>>2)+4*hi;}
#define SBAR() __builtin_amdgcn_sched_barrier(0)
__device__ __forceinline__ void cmask(f32x16&p0,f32x16&p1,int jb,int qrel,int hi){
  const float NEG=-INFINITY; int kb=64*jb+4*hi;
  #pragma unroll
  for(int r=0;r<16;++r){int kv=kb+(r&3)+8*(r>>2); if(kv>qrel)p0[r]=NEG; if(kv+32>qrel)p1[r]=NEG;}
}

constexpr int NSLOT=3, SLOTB=8192;
constexpr int LDS_K=0, LDS_V=NSLOT*SLOTB, LDS_WS=2*NSLOT*SLOTB, LDS_OST=LDS_WS+NW*64*4, LDS_BYTES=LDS_OST+NW*4096;
constexpr float C2=0.125f*1.4426950408889634f;
__device__ __forceinline__ void glds16s(const void*sbase,unsigned voff,unsigned lds_dst){
  asm volatile("s_mov_b32 m0, %2\n\ts_nop 0\n\tglobal_load_lds_dwordx4 %0, %1"::"v"(voff),"s"(sbase),"s"(lds_dst):"memory","m0");}
__device__ __forceinline__ void glds16(const void*gsrc,unsigned lds_dst){unsigned keep;
  asm volatile("s_mov_b32 %0, m0\n\ts_mov_b32 m0, %2\n\ts_nop 0\n\tglobal_load_lds_dwordx4 %1, off\n\ts_mov_b32 m0, %0":"=&s"(keep):"v"(gsrc),"s"(lds_dst):"memory");}
__device__ __forceinline__ float max3f(float a,float b,float c){float r;asm("v_max3_f32 %0, %1, %2, %3":"=v"(r):"v"(a),"v"(b),"v"(c));return r;}
__device__ __forceinline__ float max2f(float a,float b){float r;asm("v_max_f32_e32 %0, %1, %2":"=v"(r):"v"(a),"v"(b));return r;}
__device__ __forceinline__ float fadd_s(float a,float b){float r;asm("v_add_f32_e32 %0, %1, %2":"=v"(r):"v"(a),"v"(b));return r;}
__device__ __forceinline__ float fsub_s(float a,float b){float r;asm("v_sub_f32_e32 %0, %1, %2":"=v"(r):"v"(a),"v"(b));return r;}
typedef float f32x2_t __attribute__((ext_vector_type(2))); typedef __bf16 bf16x2_t __attribute__((ext_vector_type(2)));
__device__ __forceinline__ unsigned cvtpk_s(float lo,float hi){f32x2_t v={lo,hi};bf16x2_t b=__builtin_convertvector(v,bf16x2_t);return __builtin_bit_cast(unsigned,b);}
#define WAIT_BAR(N) asm volatile("s_waitcnt vmcnt(" #N ") lgkmcnt(0)\n\ts_barrier":::"memory")

__device__ __forceinline__ void qkt(f32x16&p0,f32x16&p1,const char*Kslot,const bf16x8*qr,const f32x16&negm,int r32,int hi){
  const char*kb=Kslot+hi*1024+r32*16;
  #pragma unroll
  for(int d0=0;d0<4;++d0){
    const bf16x8 b0=*reinterpret_cast<const bf16x8*>(kb+d0*2048);
    const bf16x8 b1=*reinterpret_cast<const bf16x8*>(kb+d0*2048+512);
    if(d0==0){p0=__builtin_amdgcn_mfma_f32_32x32x16_bf16(b0,qr[0],negm,0,0,0);p1=__builtin_amdgcn_mfma_f32_32x32x16_bf16(b1,qr[0],negm,0,0,0);}
    else{p0=__builtin_amdgcn_mfma_f32_32x32x16_bf16(b0,qr[d0],p0,0,0,0);p1=__builtin_amdgcn_mfma_f32_32x32x16_bf16(b1,qr[d0],p1,0,0,0);}}
}
typedef __attribute__((address_space(3))) const char* lds_cptr;
typedef short v4i16_t __attribute__((ext_vector_type(4)));
__device__ __forceinline__ void kload8(bf16x8*kf,lds_cptr kp){
  kf[0]=*(const __attribute__((address_space(3))) bf16x8*)(kp);      kf[1]=*(const __attribute__((address_space(3))) bf16x8*)(kp+512);
  kf[2]=*(const __attribute__((address_space(3))) bf16x8*)(kp+2048); kf[3]=*(const __attribute__((address_space(3))) bf16x8*)(kp+2560);
  kf[4]=*(const __attribute__((address_space(3))) bf16x8*)(kp+4096); kf[5]=*(const __attribute__((address_space(3))) bf16x8*)(kp+4608);
  kf[6]=*(const __attribute__((address_space(3))) bf16x8*)(kp+6144); kf[7]=*(const __attribute__((address_space(3))) bf16x8*)(kp+6656);
}
__device__ __forceinline__ void kload2(bf16x8*kf,lds_cptr kp,int j){ kf[2*j]=*(const __attribute__((address_space(3))) bf16x8*)(kp+j*2048); kf[2*j+1]=*(const __attribute__((address_space(3))) bf16x8*)(kp+j*2048+512); }
__device__ __forceinline__ s16x4 vtr(lds_cptr p){ return __builtin_bit_cast(s16x4,__builtin_amdgcn_ds_read_tr16_b64_v4i16((__attribute__((address_space(3))) v4i16_t*)p)); }
__device__ __forceinline__ float rowmax(const f32x16&p0,const f32x16&p1){
  float a=max3f(p0[0],p0[1],p1[0]),b=max3f(p0[2],p0[3],p1[1]);a=max3f(a,p1[2],p1[3]);
  #pragma unroll
  for(int r=4;r<16;r+=4){a=max3f(a,p0[r],p0[r+1]);b=max3f(b,p0[r+2],p0[r+3]);a=max3f(a,p1[r],p1[r+1]);b=max3f(b,p1[r+2],p1[r+3]);}
  const float m=max2f(a,b);
  auto rr=__builtin_amdgcn_permlane32_swap(__float_as_uint(m),__float_as_uint(m),false,false);
  return max2f(__uint_as_float(rr[0]),__uint_as_float(rr[1]));
}
__device__ __forceinline__ void pv(f32x16*o,int vb,bf16x8 pa0,bf16x8 pa1,bf16x8 pa2,bf16x8 pa3){
  #pragma unroll
  for(int d0=0;d0<2;++d0){s16x4 lo[4],hi[4];
    #pragma unroll
    for(int ks=0;ks<4;++ks){
      asm volatile("ds_read_b64_tr_b16 %0,%1 offset:%c2":"=&v"(lo[ks]):"v"(vb),"i"(d0*4096+ks*1024):"memory");
      asm volatile("ds_read_b64_tr_b16 %0,%1 offset:%c2":"=&v"(hi[ks]):"v"(vb),"i"(d0*4096+ks*1024+512):"memory");}
    asm volatile("s_waitcnt lgkmcnt(0)":::"memory");SBAR();
    #define PK(k) (bf16x8){lo[k][0],lo[k][1],lo[k][2],lo[k][3],hi[k][0],hi[k][1],hi[k][2],hi[k][3]}
    o[d0]=__builtin_amdgcn_mfma_f32_32x32x16_bf16(pa0,PK(0),o[d0],0,0,0);
    o[d0]=__builtin_amdgcn_mfma_f32_32x32x16_bf16(pa1,PK(1),o[d0],0,0,0);
    o[d0]=__builtin_amdgcn_mfma_f32_32x32x16_bf16(pa2,PK(2),o[d0],0,0,0);
    o[d0]=__builtin_amdgcn_mfma_f32_32x32x16_bf16(pa3,PK(3),o[d0],0,0,0);
    #undef PK
  }
}

#ifndef ATTN_STORE16
#define ATTN_STORE16(p,v) (*(u32x4*)(p)=(v))
#endif
template<int THRL,bool TILED> __device__ __forceinline__ void attn_unit(const bf16*Qu,int qp,const bf16*__restrict__ Kc,const bf16*__restrict__ Kl,int kp,const bf16*__restrict__ Vc,const bf16*__restrict__ Vl,int vp,bf16*Ou,int op,int NT,int NCT,int rot,char*shm){
  const int tid=threadIdx.x,lane=tid&63,r32=lane&31,hi=lane>>5; const int wid=__builtin_amdgcn_readfirstlane(tid>>6);
  const bf16*Qw=Qu+(long)(wid*QBLK)*qp;
  const unsigned lds0=(unsigned)(uintptr_t)shm;
  float*wsf=(float*)(shm+LDS_WS)+wid*64;
  const long koff=TILED?(long)(wid*512+lane*8):((long)lane*kp+wid*8); const bf16*ksrc_c=Kc+koff; const bf16*ksrc_l=Kl+koff-(long)NCT*KVBLK*kp;
  const long voff=TILED?(long)(wid*512+lane*8):((long)(16*(wid&3)+(lane>>2))*vp+(wid>>2)*32+(lane&3)*8); const bf16*vsrc_c=Vc+voff; const bf16*vsrc_l=Vl+voff-(long)NCT*KVBLK*vp;
  const unsigned kdst=lds0+LDS_K+wid*1024, vdst=lds0+LDS_V+wid*1024;
  #define ROTT(t) (t)
  const unsigned koffb1=(unsigned)(wid*512+lane*8)*2u;
  #define DMA_K(t,slot) do{ if constexpr(TILED) glds16s(Kc+(long)ROTT(t)*4096,koffb1,(unsigned)__builtin_amdgcn_readfirstlane(kdst+(slot))); else glds16((ROTT(t)<NCT?ksrc_c:ksrc_l)+(long)ROTT(t)*KVBLK*kp,(unsigned)__builtin_amdgcn_readfirstlane(kdst+(slot))); }while(0)
  #define DMA_V(t,slot) do{ if constexpr(TILED) glds16s(Vc+(long)ROTT(t)*4096,koffb1,(unsigned)__builtin_amdgcn_readfirstlane(vdst+(slot))); else glds16((ROTT(t)<NCT?vsrc_c:vsrc_l)+(long)ROTT(t)*KVBLK*vp,(unsigned)__builtin_amdgcn_readfirstlane(vdst+(slot))); }while(0)
  const int vb0=(int)(lds0+LDS_V)+((lane>>4)&1)*32+(lane&3)*8+(4*hi+((lane&15)>>2))*64;
  const char*Kbase=shm+LDS_K; bf16x8 kf[8];
  const lds_cptr shm3=(lds_cptr)shm; const lds_cptr kp0=shm3+LDS_K+hi*1024+r32*16; const lds_cptr vp0=shm3+LDS_V+((lane>>4)&1)*32+(lane&3)*8+(4*hi+((lane&15)>>2))*64;
  DMA_K(0,0);DMA_V(0,0);DMA_K(1,SLOTB);
  bf16x8 qr[4];
  #pragma unroll
  for(int d0=0;d0<4;++d0)qr[d0]=*reinterpret_cast<const bf16x8*>(&Qw[(long)r32*qp+d0*16+hi*8]);
  float mhat=0.f,l_reg=0.f;f32x16 o[2];o[0]=f32x16{};o[1]=f32x16{};f32x16 negm=f32x16{};if constexpr(THRL>=0)asm volatile("":"+v"(negm));
  #define CMASK(P0,P1,t) do{}while(0)
  bool resc=false;
  #define START(P0,P1) do{ resc=false; if constexpr(THRL>=0) \
    { const float rm=rowmax(P0,P1); const float dl=rm; mhat=fadd_s(mhat,dl); \
      _Pragma("unroll") for(int r=0;r<16;++r){P0[r]=fsub_s(P0[r],dl);P1[r]=fsub_s(P1[r],dl);} \
      _Pragma("unroll") for(int r=0;r<16;++r)negm[r]=-mhat; asm volatile("":"+v"(negm)); } \
    _Pragma("unroll") for(int r=0;r<16;++r)P0[r]=__builtin_amdgcn_exp2f(P0[r]); }while(0)
  #define RESC() do{ if constexpr(THRL>=0) if(resc){ asm volatile("s_waitcnt lgkmcnt(0)":::"memory"); \
      _Pragma("unroll") for(int d_=0;d_<2;++d_) _Pragma("unroll") for(int r=0;r<16;++r)o[d_][r]*=wsf[crow(r,hi)]; } }while(0)
  f32x16 pA0,pA1,pB0,pB1;
  int sl_prev=0,sl_cur=0,sl_next=SLOTB;
  #define ROT() do{sl_prev=sl_cur;sl_cur=sl_next;sl_next=(sl_next==(NSLOT-1)*SLOTB)?0:sl_next+SLOTB;}while(0)
  DMA_K(2,2*SLOTB);
  WAIT_BAR(3);
  qkt(pA0,pA1,Kbase,qr,negm,r32,hi);asm volatile("s_nop 15\n\ts_nop 7":"+v"(pA0),"+v"(pA1));CMASK(pA0,pA1,0);
  START(pA0,pA1);
  _Pragma("unroll") for(int r=0;r<16;++r)pA1[r]=__builtin_amdgcn_exp2f(pA1[r]);
  WAIT_BAR(0);
  DMA_K(3,0);DMA_V(1,SLOTB);
  ROT();
  kload8(kf,kp0+sl_cur);
  WAIT_BAR(2);
  s16x4 vlo[8],vhi[8]; u32x4 pw0,pw1,pw2,pw3;
  #define PKW(P,B) cvtpk_s(P[B],P[B+1])
  #define PAF(k) __builtin_bit_cast(bf16x8,pw##k)
  #define VFR(i) (bf16x8){vlo[i][0],vlo[i][1],vlo[i][2],vlo[i][3],vhi[i][0],vhi[i][1],vhi[i][2],vhi[i][3]}
  #define PIN(x) asm volatile("":"+v"(x))
  #define MX3(a,b,c) __builtin_fmaxf(__builtin_fmaxf((a),(b)),(c))
  #define GAPA(MF,A0,A1,A2,A3,W0,W1,PW) do{ MF; sacc+=A0; sacc+=A1; sacc+=A2; sacc+=A3; PIN(sacc); W0; W1; PIN(PW); SBAR(); }while(0)
  #define EX(v) __builtin_amdgcn_exp2f(v)
  #define GAPB(MF,X,B) do{ MF; X[B]=EX(X[B]); X[B+1]=EX(X[B+1]); X[B+2]=EX(X[B+2]); X[B+3]=EX(X[B+3]); PIN(X); SBAR(); }while(0)
  #define VRD(i) do{ vlo[i]=vtr(vp_+(((i)>>2)*4096+((i)&3)*1024)); vhi[i]=vtr(vp_+(((i)>>2)*4096+((i)&3)*1024+512)); }while(0)
  #define KRD(G,j) do{ if(G){ kload2(kf,kp0+sl_next,j); SBAR(); } }while(0)
  #define STEP(C0,C1,P0,P1,t,GK,GV,GL) do{ SBAR(); \
    const lds_cptr vp_=vp0+sl_prev; \
    VRD(0); SBAR(); float sacc=(P0[0]+P0[1]); \
    GAPA(C0=__builtin_amdgcn_mfma_f32_32x32x16_bf16(kf[0],qr[0],negm,0,0,0), P0[2],P0[3],P0[4],P0[5],     pw0[0]=PKW(P0,0), pw0[1]=PKW(P0,2), pw0); \
    VRD(4); SBAR(); GAPA(C1=__builtin_amdgcn_mfma_f32_32x32x16_bf16(kf[1],qr[0],negm,0,0,0), P0[6],P0[7],P0[8],P0[9],     pw0[2]=PKW(P0,4), pw0[3]=PKW(P0,6), pw0); \
    VRD(1); SBAR(); GAPA(C0=__builtin_amdgcn_mfma_f32_32x32x16_bf16(kf[2],qr[1],C0,0,0,0),   P0[10],P0[11],P0[12],P0[13], pw1[0]=PKW(P0,8), pw1[1]=PKW(P0,10), pw1); \
    VRD(5); SBAR(); GAPA(C1=__builtin_amdgcn_mfma_f32_32x32x16_bf16(kf[3],qr[1],C1,0,0,0),   P0[14],P0[15],P1[0],P1[1],   pw1[2]=PKW(P0,12),pw1[3]=PKW(P0,14), pw1); \
    VRD(2); SBAR(); GAPA(C0=__builtin_amdgcn_mfma_f32_32x32x16_bf16(kf[4],qr[2],C0,0,0,0),   P1[2],P1[3],P1[4],P1[5],     pw2[0]=PKW(P1,0), pw2[1]=PKW(P1,2), pw2); \
    VRD(6); SBAR(); GAPA(C1=__builtin_amdgcn_mfma_f32_32x32x16_bf16(kf[5],qr[2],C1,0,0,0),   P1[6],P1[7],P1[8],P1[9],     pw2[2]=PKW(P1,4), pw2[3]=PKW(P1,6), pw2); \
    VRD(3); SBAR(); GAPA(C0=__builtin_amdgcn_mfma_f32_32x32x16_bf16(kf[6],qr[3],C0,0,0,0),   P1[10],P1[11],P1[12],P1[13], pw3[0]=PKW(P1,8), pw3[1]=PKW(P1,10), pw3); \
    VRD(7); SBAR(); GAPA(C1=__builtin_amdgcn_mfma_f32_32x32x16_bf16(kf[7],qr[3],C1,0,0,0),   P1[14],P1[15],0.f,0.f,       pw3[2]=PKW(P1,12),pw3[3]=PKW(P1,14), pw3); \
    l_reg+=sacc; \
    if(GK){DMA_K((t)+3,sl_cur);} if(GV){DMA_V((t)+1,sl_next);} \
    CMASK(C0,C1,t); \
    if constexpr(THRL>=0){ float a=MX3(C0[0],C0[1],C1[0]),b=MX3(C0[2],C0[3],C1[1]); a=MX3(a,C1[2],C1[3]); \
      _Pragma("unroll") for(int r=4;r<16;r+=4){a=MX3(a,C0[r],C0[r+1]);b=MX3(b,C0[r+2],C0[r+3]);a=MX3(a,C1[r],C1[r+1]);b=MX3(b,C1[r+2],C1[r+3]);} \
      float rm=__builtin_fmaxf(a,b); { auto rr=__builtin_amdgcn_permlane32_swap(__float_as_uint(rm),__float_as_uint(rm),false,false); rm=__builtin_fmaxf(__uint_as_float(rr[0]),__uint_as_float(rr[1])); } \
      resc=false; \
      if(__builtin_expect(__any(rm>(float)THRL),0)){ const float dl=__builtin_fmaxf(rm,0.f); mhat+=dl; \
        _Pragma("unroll") for(int r=0;r<16;++r){C0[r]-=dl;C1[r]-=dl;} \
        _Pragma("unroll") for(int r=0;r<16;++r)negm[r]=-mhat; asm volatile("":"+v"(negm)); \
        const float f=__builtin_amdgcn_exp2f(-dl); l_reg*=f; if(hi==0)wsf[r32]=f; resc=true; } } \
    SBAR(); \
    GAPB(o[0]=__builtin_amdgcn_mfma_f32_32x32x16_bf16(PAF(0),VFR(0),o[0],0,0,0), C0,0); \
    GAPB(o[1]=__builtin_amdgcn_mfma_f32_32x32x16_bf16(PAF(0),VFR(4),o[1],0,0,0), C0,4); \
    KRD(GL,0); GAPB(o[0]=__builtin_amdgcn_mfma_f32_32x32x16_bf16(PAF(1),VFR(1),o[0],0,0,0), C0,8); \
    KRD(GL,1); GAPB(o[1]=__builtin_amdgcn_mfma_f32_32x32x16_bf16(PAF(1),VFR(5),o[1],0,0,0), C0,12); \
    KRD(GL,2); GAPB(o[0]=__builtin_amdgcn_mfma_f32_32x32x16_bf16(PAF(2),VFR(2),o[0],0,0,0), C1,0); \
    KRD(GL,3); GAPB(o[1]=__builtin_amdgcn_mfma_f32_32x32x16_bf16(PAF(2),VFR(6),o[1],0,0,0), C1,4); \
    GAPB(o[0]=__builtin_amdgcn_mfma_f32_32x32x16_bf16(PAF(3),VFR(3),o[0],0,0,0), C1,8); \
    GAPB(o[1]=__builtin_amdgcn_mfma_f32_32x32x16_bf16(PAF(3),VFR(7),o[1],0,0,0), C1,12); \
    }while(0)
  int t=1;
  #undef CMASK
  #define CMASK(P0,P1,t) do{}while(0)
  for(;t+5<NT;t+=2){
    STEP(pB0,pB1,pA0,pA1,t,true,true,true);     WAIT_BAR(2); RESC(); ROT();
    STEP(pA0,pA1,pB0,pB1,t+1,true,true,true);   WAIT_BAR(2); RESC(); ROT();
  }
  #undef CMASK
  #define CMASK(P0,P1,t) do{}while(0)
  #define ENDW(tt) do{ if((tt)+3<NT){WAIT_BAR(2);} else if((tt)+2<NT){WAIT_BAR(1);} else {WAIT_BAR(0);} }while(0)
  for(;t+1<NT;t+=2){
    STEP(pB0,pB1,pA0,pA1,t,(t+3<NT),(t+1<NT),(t+1<NT));       ENDW(t);   RESC(); ROT();
    STEP(pA0,pA1,pB0,pB1,t+1,(t+4<NT),(t+2<NT),(t+2<NT));     ENDW(t+1); RESC(); ROT();
  }
  STEP(pB0,pB1,pA0,pA1,NT-1,false,false,false); RESC();
  { float sacc=pB0[0]+pB0[1]; _Pragma("unroll") for(int r=2;r<16;++r)sacc+=pB0[r]; _Pragma("unroll") for(int r=0;r<16;++r)sacc+=pB1[r]; l_reg+=sacc;
    pw0=(u32x4){PKW(pB0,0),PKW(pB0,2),PKW(pB0,4),PKW(pB0,6)};pw1=(u32x4){PKW(pB0,8),PKW(pB0,10),PKW(pB0,12),PKW(pB0,14)};pw2=(u32x4){PKW(pB1,0),PKW(pB1,2),PKW(pB1,4),PKW(pB1,6)};pw3=(u32x4){PKW(pB1,8),PKW(pB1,10),PKW(pB1,12),PKW(pB1,14)};
    SBAR(); pv(o,vb0+sl_cur,PAF(0),PAF(1),PAF(2),PAF(3)); }
  #undef PKW
  #undef PAF
  #undef VFR
  #undef PIN
  #undef MX3
  #undef GAPA
  #undef GAPB
  #undef EX
  #undef VRD
  #undef KRD
  #undef STEP
  #undef ENDW
  {auto rr=__builtin_amdgcn_permlane32_swap(__float_as_uint(l_reg),__float_as_uint(l_reg),false,false);l_reg=__uint_as_float(rr[0])+__uint_as_float(rr[1]);}
  if(hi==0)wsf[32+r32]=l_reg;asm volatile("s_waitcnt lgkmcnt(0)":::"memory");
  float rli[16];
  #pragma unroll
  for(int r=0;r<16;++r)rli[r]=__builtin_amdgcn_rcpf(wsf[32+crow(r,hi)]);
  bf16*Ow=Ou+(long)(wid*QBLK)*op;
  { bf16*stg=(bf16*)(shm+LDS_OST)+wid*2048;
    #pragma unroll
    for(int r=0;r<16;++r){const int orow=crow(r,hi);
      #pragma unroll
      for(int d0=0;d0<2;++d0)stg[orow*64+d0*32+r32]=__float2bfloat16(o[d0][r]*rli[r]);}
    asm volatile("s_waitcnt lgkmcnt(0)":::"memory");
    #pragma unroll
    for(int i=0;i<4;++i){const int row=i*8+(lane>>3),ch=lane&7; const u32x4 v=*(const u32x4*)(stg+row*64+ch*8); ATTN_STORE16(Ow+(long)row*op+ch*8,v);} }
  asm volatile("s_waitcnt lgkmcnt(0)\n\ts_barrier":::"memory");
  #undef DMA_K
  #undef ROTT
  #undef DMA_V
  #undef CMASK
  #undef START
  #undef RESC
  #undef ROT
}
constexpr int LDS2_V=NSLOT*SLOTB, LDS2_WS=LDS2_V+NSLOT*2*SLOTB, LDS2_OST=LDS2_WS+NW*64*4, LDS2_BYTES=LDS2_OST+NW*4096;
template<int THRL> __device__ __forceinline__ void attn_unit2(const bf16*Qu,int qp,const bf16*__restrict__ Ks,const bf16*__restrict__ Va,const bf16*__restrict__ Vb,bf16*Ou,int op,int NT,int rot,char*shm,bool FUSE,const bf16*O1,int o1p,float lam,const float*subg,float oscale){
  const int tid=threadIdx.x,lane=tid&63,r32=lane&31,hi=lane>>5; const int wid=__builtin_amdgcn_readfirstlane(tid>>6);
  const bf16*Qw=Qu+(long)(wid*QBLK)*qp;
  const unsigned lds0=(unsigned)(uintptr_t)shm;
  float*wsf=(float*)(shm+LDS2_WS)+wid*64;
  const unsigned koffb=(unsigned)(wid*512+lane*8)*2u;
  const unsigned kdst=lds0+LDS_K+wid*1024, vdst=lds0+LDS2_V+wid*1024;
  #define ROTT(t) (t)
  #define DMA_K(t,slot) glds16s(Ks+(long)ROTT(t)*4096,koffb,(unsigned)__builtin_amdgcn_readfirstlane(kdst+(slot)))
  #define DMA_V(t,slot) do{ glds16s(Va+(long)ROTT(t)*4096,koffb,(unsigned)__builtin_amdgcn_readfirstlane(vdst+2*(slot))); glds16s(Vb+(long)ROTT(t)*4096,koffb,(unsigned)__builtin_amdgcn_readfirstlane(vdst+2*(slot)+8192)); }while(0)
  const int vb0=(int)(lds0+LDS2_V)+((lane>>4)&1)*32+(lane&3)*8+(4*hi+((lane&15)>>2))*64;
  const char*Kbase=shm+LDS_K; bf16x8 kf[8];
  const lds_cptr shm3=(lds_cptr)shm; const lds_cptr kp0=shm3+LDS_K+hi*1024+r32*16; const lds_cptr vp0=shm3+LDS2_V+((lane>>4)&1)*32+(lane&3)*8+(4*hi+((lane&15)>>2))*64;
  DMA_K(0,0);DMA_V(0,0);DMA_K(1,SLOTB);
  bf16x8 qr[4];
  #pragma unroll
  for(int d0=0;d0<4;++d0)qr[d0]=*reinterpret_cast<const bf16x8*>(&Qw[(long)r32*qp+d0*16+hi*8]);
  float mhat=0.f,l_reg=0.f;f32x16 o[4];o[0]=f32x16{};o[1]=f32x16{};o[2]=f32x16{};o[3]=f32x16{};const f32x16 zero16=f32x16{};
  #define CMASK(P0,P1,t) do{}while(0)
  bool resc=false;
  #define SUBM(x) (THRL>=0?(x)-mhat:(x))
  #define START(P0,P1) do{ resc=false; if constexpr(THRL>=0){ mhat=rowmax(P0,P1); } \
    _Pragma("unroll") for(int r=0;r<16;++r)P0[r]=__builtin_amdgcn_exp2f(SUBM(P0[r])); }while(0)
  #define RESC() do{ if constexpr(THRL>=0) if(resc){ asm volatile("s_waitcnt lgkmcnt(0)":::"memory"); \
      _Pragma("unroll") for(int d_=0;d_<4;++d_) _Pragma("unroll") for(int r=0;r<16;++r)o[d_][r]*=wsf[crow(r,hi)]; } }while(0)
  f32x16 pA0,pA1,pB0,pB1;
  int sl_prev=0,sl_cur=0,sl_next=SLOTB;
  #define ROT() do{sl_prev=sl_cur;sl_cur=sl_next;sl_next=(sl_next==(NSLOT-1)*SLOTB)?0:sl_next+SLOTB;}while(0)
  DMA_K(2,2*SLOTB);
  WAIT_BAR(4);
  qkt(pA0,pA1,Kbase,qr,zero16,r32,hi);asm volatile("s_nop 15\n\ts_nop 7":"+v"(pA0),"+v"(pA1));CMASK(pA0,pA1,0);
  START(pA0,pA1);
  _Pragma("unroll") for(int r=0;r<16;++r)pA1[r]=__builtin_amdgcn_exp2f(SUBM(pA1[r]));
  WAIT_BAR(0);
  DMA_K(3,0);DMA_V(1,SLOTB);
  ROT();
  kload8(kf,kp0+sl_cur);
  WAIT_BAR(3);
  s16x4 vlo[8],vhi[8]; u32x4 pw0,pw1,pw2,pw3;
  #define PKW(P,B) cvtpk_s(P[B],P[B+1])
  #define PAF(k) __builtin_bit_cast(bf16x8,pw##k)
  #define VFR(i) (bf16x8){vlo[i][0],vlo[i][1],vlo[i][2],vlo[i][3],vhi[i][0],vhi[i][1],vhi[i][2],vhi[i][3]}
  #define PIN(x) asm volatile("":"+v"(x))
  #define MX3(a,b,c) __builtin_fmaxf(__builtin_fmaxf((a),(b)),(c))
  #define GAPA(MF,A0,A1,A2,A3,W0,W1,PW) do{ MF; sacc+=A0; sacc+=A1; sacc+=A2; sacc+=A3; PIN(sacc); W0; W1; PIN(PW); SBAR(); }while(0)
  #define EX(v) __builtin_amdgcn_exp2f(v)
  #define GAPB(MF,X,B) do{ MF; X[B]=EX(SUBM(X[B])); X[B+1]=EX(SUBM(X[B+1])); PIN(X); SBAR(); }while(0)
  #define VRD(i) do{ vlo[i]=vtr(vp_+(((i)>>2)*4096+((i)&3)*1024)); vhi[i]=vtr(vp_+(((i)>>2)*4096+((i)&3)*1024+512)); }while(0)
  #define VRD2(i) do{ vlo[i]=vtr(vp_+(8192+((i)>>2)*4096+((i)&3)*1024)); vhi[i]=vtr(vp_+(8192+((i)>>2)*4096+((i)&3)*1024+512)); SBAR(); }while(0)
  #define KRD(G,j) do{ if(G){ kload2(kf,kp0+sl_next,j); SBAR(); } }while(0)
  #define STEP(C0,C1,P0,P1,t,GK,GV,GL) do{ SBAR(); \
    const lds_cptr vp_=vp0+2*sl_prev; \
    VRD(0); SBAR(); float sacc=(P0[0]+P0[1]); \
    GAPA(C0=__builtin_amdgcn_mfma_f32_32x32x16_bf16(kf[0],qr[0],zero16,0,0,0), P0[2],P0[3],P0[4],P0[5],     pw0[0]=PKW(P0,0), pw0[1]=PKW(P0,2), pw0); \
    VRD(4); SBAR(); GAPA(C1=__builtin_amdgcn_mfma_f32_32x32x16_bf16(kf[1],qr[0],zero16,0,0,0), P0[6],P0[7],P0[8],P0[9],     pw0[2]=PKW(P0,4), pw0[3]=PKW(P0,6), pw0); \
    VRD(1); SBAR(); GAPA(C0=__builtin_amdgcn_mfma_f32_32x32x16_bf16(kf[2],qr[1],C0,0,0,0),   P0[10],P0[11],P0[12],P0[13], pw1[0]=PKW(P0,8), pw1[1]=PKW(P0,10), pw1); \
    VRD(5); SBAR(); GAPA(C1=__builtin_amdgcn_mfma_f32_32x32x16_bf16(kf[3],qr[1],C1,0,0,0),   P0[14],P0[15],P1[0],P1[1],   pw1[2]=PKW(P0,12),pw1[3]=PKW(P0,14), pw1); \
    VRD(2); SBAR(); GAPA(C0=__builtin_amdgcn_mfma_f32_32x32x16_bf16(kf[4],qr[2],C0,0,0,0),   P1[2],P1[3],P1[4],P1[5],     pw2[0]=PKW(P1,0), pw2[1]=PKW(P1,2), pw2); \
    VRD(6); SBAR(); GAPA(C1=__builtin_amdgcn_mfma_f32_32x32x16_bf16(kf[5],qr[2],C1,0,0,0),   P1[6],P1[7],P1[8],P1[9],     pw2[2]=PKW(P1,4), pw2[3]=PKW(P1,6), pw2); \
    VRD(3); SBAR(); GAPA(C0=__builtin_amdgcn_mfma_f32_32x32x16_bf16(kf[6],qr[3],C0,0,0,0),   P1[10],P1[11],P1[12],P1[13], pw3[0]=PKW(P1,8), pw3[1]=PKW(P1,10), pw3); \
    VRD(7); SBAR(); GAPA(C1=__builtin_amdgcn_mfma_f32_32x32x16_bf16(kf[7],qr[3],C1,0,0,0),   P1[14],P1[15],0.f,0.f,       pw3[2]=PKW(P1,12),pw3[3]=PKW(P1,14), pw3); \
    l_reg+=sacc; \
    if(GK){DMA_K((t)+3,sl_cur);} if(GV){DMA_V((t)+1,sl_next);} \
    CMASK(C0,C1,t); \
    if constexpr(THRL>=0){ float a=MX3(C0[0],C0[1],C1[0]),b=MX3(C0[2],C0[3],C1[1]); a=MX3(a,C1[2],C1[3]); \
      _Pragma("unroll") for(int r=4;r<16;r+=4){a=MX3(a,C0[r],C0[r+1]);b=MX3(b,C0[r+2],C0[r+3]);a=MX3(a,C1[r],C1[r+1]);b=MX3(b,C1[r+2],C1[r+3]);} \
      float rm=__builtin_fmaxf(a,b); { auto rr=__builtin_amdgcn_permlane32_swap(__float_as_uint(rm),__float_as_uint(rm),false,false); rm=__builtin_fmaxf(__uint_as_float(rr[0]),__uint_as_float(rr[1])); } \
      resc=false; \
      rm-=mhat; \
      if(__builtin_expect(__any(rm>(float)THRL),0)){ const float dl=__builtin_fmaxf(rm,0.f); mhat+=dl; \
        const float f=__builtin_amdgcn_exp2f(-dl); l_reg*=f; if(hi==0)wsf[r32]=f; resc=true; } } \
    SBAR(); \
    GAPB(o[0]=__builtin_amdgcn_mfma_f32_32x32x16_bf16(PAF(0),VFR(0),o[0],0,0,0), C0,0); VRD2(0); \
    GAPB(o[1]=__builtin_amdgcn_mfma_f32_32x32x16_bf16(PAF(0),VFR(4),o[1],0,0,0), C0,2); VRD2(4); \
    KRD(GL,0); GAPB(o[0]=__builtin_amdgcn_mfma_f32_32x32x16_bf16(PAF(1),VFR(1),o[0],0,0,0), C0,4); VRD2(1); \
    KRD(GL,1); GAPB(o[1]=__builtin_amdgcn_mfma_f32_32x32x16_bf16(PAF(1),VFR(5),o[1],0,0,0), C0,6); VRD2(5); \
    KRD(GL,2); GAPB(o[0]=__builtin_amdgcn_mfma_f32_32x32x16_bf16(PAF(2),VFR(2),o[0],0,0,0), C0,8); VRD2(2); \
    KRD(GL,3); GAPB(o[1]=__builtin_amdgcn_mfma_f32_32x32x16_bf16(PAF(2),VFR(6),o[1],0,0,0), C0,10); VRD2(6); \
    GAPB(o[0]=__builtin_amdgcn_mfma_f32_32x32x16_bf16(PAF(3),VFR(3),o[0],0,0,0), C0,12); VRD2(3); \
    GAPB(o[1]=__builtin_amdgcn_mfma_f32_32x32x16_bf16(PAF(3),VFR(7),o[1],0,0,0), C0,14); VRD2(7); \
    GAPB(o[2]=__builtin_amdgcn_mfma_f32_32x32x16_bf16(PAF(0),VFR(0),o[2],0,0,0), C1,0); \
    GAPB(o[3]=__builtin_amdgcn_mfma_f32_32x32x16_bf16(PAF(0),VFR(4),o[3],0,0,0), C1,2); \
    GAPB(o[2]=__builtin_amdgcn_mfma_f32_32x32x16_bf16(PAF(1),VFR(1),o[2],0,0,0), C1,4); \
    GAPB(o[3]=__builtin_amdgcn_mfma_f32_32x32x16_bf16(PAF(1),VFR(5),o[3],0,0,0), C1,6); \
    GAPB(o[2]=__builtin_amdgcn_mfma_f32_32x32x16_bf16(PAF(2),VFR(2),o[2],0,0,0), C1,8); \
    GAPB(o[3]=__builtin_amdgcn_mfma_f32_32x32x16_bf16(PAF(2),VFR(6),o[3],0,0,0), C1,10); \
    GAPB(o[2]=__builtin_amdgcn_mfma_f32_32x32x16_bf16(PAF(3),VFR(3),o[2],0,0,0), C1,12); \
    GAPB(o[3]=__builtin_amdgcn_mfma_f32_32x32x16_bf16(PAF(3),VFR(7),o[3],0,0,0), C1,14); \
    }while(0)
  int t=1;
  #undef CMASK
  #define CMASK(P0,P1,t) do{}while(0)
  for(;t+5<NT;t+=2){
    STEP(pB0,pB1,pA0,pA1,t,true,true,true);     WAIT_BAR(3); RESC(); ROT();
    STEP(pA0,pA1,pB0,pB1,t+1,true,true,true);   WAIT_BAR(3); RESC(); ROT();
  }
  #undef CMASK
  #define CMASK(P0,P1,t) do{}while(0)
  #define ENDW(tt) do{ if((tt)+3<NT){WAIT_BAR(3);} else if((tt)+2<NT){WAIT_BAR(2);} else {WAIT_BAR(0);} }while(0)
  for(;t+1<NT;t+=2){
    STEP(pB0,pB1,pA0,pA1,t,(t+3<NT),(t+1<NT),(t+1<NT));       ENDW(t);   RESC(); ROT();
    STEP(pA0,pA1,pB0,pB1,t+1,(t+4<NT),(t+2<NT),(t+2<NT));     ENDW(t+1); RESC(); ROT();
  }
  STEP(pB0,pB1,pA0,pA1,NT-1,false,false,false); RESC();
  { float sacc=pB0[0]+pB0[1]; _Pragma("unroll") for(int r=2;r<16;++r)sacc+=pB0[r]; _Pragma("unroll") for(int r=0;r<16;++r)sacc+=pB1[r]; l_reg+=sacc;
    pw0=(u32x4){PKW(pB0,0),PKW(pB0,2),PKW(pB0,4),PKW(pB0,6)};pw1=(u32x4){PKW(pB0,8),PKW(pB0,10),PKW(pB0,12),PKW(pB0,14)};pw2=(u32x4){PKW(pB1,0),PKW(pB1,2),PKW(pB1,4),PKW(pB1,6)};pw3=(u32x4){PKW(pB1,8),PKW(pB1,10),PKW(pB1,12),PKW(pB1,14)};
    SBAR(); pv(o,vb0+2*sl_cur,PAF(0),PAF(1),PAF(2),PAF(3)); pv(o+2,vb0+2*sl_cur+8192,PAF(0),PAF(1),PAF(2),PAF(3)); }
  #undef PKW
  #undef PAF
  #undef VFR
  #undef PIN
  #undef MX3
  #undef GAPA
  #undef GAPB
  #undef EX
  #undef VRD
  #undef VRD2
  #undef KRD
  #undef STEP
  #undef ENDW
  {auto rr=__builtin_amdgcn_permlane32_swap(__float_as_uint(l_reg),__float_as_uint(l_reg),false,false);l_reg=__uint_as_float(rr[0])+__uint_as_float(rr[1]);}
  if(hi==0)wsf[32+r32]=l_reg;asm volatile("s_waitcnt lgkmcnt(0)":::"memory");
  float rli[16];
  #pragma unroll
  for(int r=0;r<16;++r)rli[r]=__builtin_amdgcn_rcpf(wsf[32+crow(r,hi)]);
  bf16*Ow=Ou+(long)(wid*QBLK)*op;
  { bf16*stg=(bf16*)(shm+LDS2_OST)+wid*2048;
    int lane_e=lane; asm volatile("":"+v"(lane_e));
    if(!FUSE){
    #pragma unroll
    for(int hh=0;hh<2;++hh){
      #pragma unroll
      for(int r=0;r<16;++r){const int orow=crow(r,hi);
        #pragma unroll
        for(int d0=0;d0<2;++d0)stg[orow*64+d0*32+r32]=__float2bfloat16(o[2*hh+d0][r]*rli[r]);}
      asm volatile("s_waitcnt lgkmcnt(0)":::"memory");
      #pragma unroll
      for(int i=0;i<4;++i){const int row=i*8+(lane_e>>3),ch=lane_e&7; const u32x4 v=*(const u32x4*)(stg+row*64+ch*8); ATTN_STORE16(Ow+(long)row*op+hh*64+ch*8,v);}
      asm volatile("s_waitcnt lgkmcnt(0)":::"memory"); }
    } else {
    const bf16*O1w=O1+(long)(wid*QBLK)*o1p; float dd[2][4][8]; float ssq[4]={0.f,0.f,0.f,0.f};
    #pragma unroll
    for(int hh=0;hh<2;++hh){
      #pragma unroll
      for(int r=0;r<16;++r){const int orow=crow(r,hi);
        #pragma unroll
        for(int d0=0;d0<2;++d0)stg[orow*64+d0*32+r32]=__float2bfloat16(o[2*hh+d0][r]*rli[r]);}
      asm volatile("s_waitcnt lgkmcnt(0)":::"memory");
      #pragma unroll
      for(int i=0;i<4;++i){const int row=i*8+(lane_e>>3),ch=lane_e&7; const u32x4 v2=*(const u32x4*)(stg+row*64+ch*8); const u32x4 v1=*(const u32x4*)(O1w+(long)row*o1p+hh*64+ch*8);
        #pragma unroll
        for(int e=0;e<4;++e){ const float a0=__uint_as_float(v1[e]<<16),a1=__uint_as_float(v1[e]&0xffff0000u),b0=__uint_as_float(v2[e]<<16),b1=__uint_as_float(v2[e]&0xffff0000u);
          const float x0=a0-lam*b0,x1=a1-lam*b1; dd[hh][i][2*e]=x0; dd[hh][i][2*e+1]=x1; ssq[i]+=x0*x0+x1*x1; } }
      asm volatile("s_waitcnt lgkmcnt(0)":::"memory"); }
    #pragma unroll
    for(int i=0;i<4;++i){ float t=ssq[i]; t+=__shfl_xor(t,1); t+=__shfl_xor(t,2); t+=__shfl_xor(t,4); const float rs=oscale/sqrtf(t*(1.0f/128.0f)+1e-6f); const int row=i*8+(lane_e>>3),ch=lane_e&7;
      #pragma unroll
      for(int hh=0;hh<2;++hh){ const float*gp=subg+hh*64+ch*8; u32x4 w;
        #pragma unroll
        for(int e=0;e<4;++e)w[e]=cvtpk_s(dd[hh][i][2*e]*rs*gp[2*e],dd[hh][i][2*e+1]*rs*gp[2*e+1]);
        ATTN_STORE16(Ow+(long)row*op+hh*64+ch*8,w);} }
    } }
  asm volatile("s_waitcnt lgkmcnt(0)\n\ts_barrier":::"memory");
  #undef DMA_K
  #undef ROTT
  #undef DMA_V
  #undef CMASK
  #undef START
  #undef RESC
  #undef ROT
}
constexpr int ATTN_LDS_BYTES=LDS_BYTES;
#undef SBAR
#undef WAIT_BAR
}
constexpr int NWAVES = 8;
#ifndef MK_ONE_LAUNCH
#define MK_ONE_LAUNCH 1
#endif
constexpr int NPH = 20;

constexpr int D = 1024, NB = 2, SEQ = 8192, CTXL = 256;
constexpr int ML = NB * SEQ, MC = NB * CTXL, MR = ML + MC;
constexpr int E_IN = 2560, O_IN = 1792, FF = 2816, FF2 = 2 * FF, NEXP = 8;
constexpr int MOE_ROWS = 2 * ML + NEXP * 256, MOE_PAN = MOE_ROWS / 256;
constexpr int NCHUNK = MR / 64;
constexpr float EPS = 1e-6f;
constexpr float MOE_S13 = 32.0f, MOE_S2 = 64.0f;
constexpr float QSCALE = 0.125f * 1.4426950408889634f;

constexpr size_t MiB = 1u << 20, KiB = 1u << 10;
constexpr size_t WS_CTL = 0, CTL_ZERO_BYTES = 1 * MiB;
constexpr size_t WS_MOD = 1 * MiB;
constexpr size_t WS_WG = 1 * MiB + 256 * KiB;
constexpr size_t WS_TOK = 2 * MiB;
constexpr size_t WS_AGG = 4 * MiB;
constexpr size_t WS_WM13 = 8 * MiB, WS_WM2 = 96 * MiB;
constexpr size_t WS_WE = 140 * MiB, WS_WO0 = 145 * MiB, WS_WO1 = 147 * MiB, WS_WF13 = 149 * MiB, WS_WF2 = 160 * MiB, WS_WOI = 166 * MiB;
constexpr size_t WS_XR = 170 * MiB;
constexpr size_t WS_KC0 = 170 * MiB, WS_VC0 = 187 * MiB;
constexpr size_t WS_KC1 = 427 * MiB, WS_VC1 = 432 * MiB;
constexpr int KEYS = CTXL + SEQ;
constexpr size_t WS_XN = 236 * MiB;
constexpr size_t WS_Y = 269 * MiB;
constexpr size_t WS_P0 = 302 * MiB;
constexpr size_t WS_OATT = 385 * MiB;
constexpr size_t WS_H = 302 * MiB;
constexpr size_t WS_P1 = 302 * MiB;
constexpr size_t WS_RI = 360 * MiB;
constexpr size_t WS_XG = 234 * MiB;
constexpr size_t WS_HG = 140 * MiB;
constexpr size_t WS_YG = 368 * MiB;
constexpr size_t WS_END = 436 * MiB;
static_assert(WS_WM13 + (size_t)NEXP * FF2 * D * 2 <= WS_WM2 && WS_WM2 + (size_t)NEXP * D * FF * 2 <= WS_WE && WS_WE + (size_t)E_IN * D * 2 <= WS_WO0 && WS_WF13 + (size_t)FF2 * D * 2 <= WS_WF2 &&
              WS_WF2 + (size_t)D * FF * 2 <= WS_WOI && WS_WOI + (size_t)O_IN * D * 2 <= WS_XR && WS_XR + (size_t)MR * D * 4 <= WS_XN && WS_XN + (size_t)MR * D * 2 <= WS_Y && WS_Y + (size_t)MR * D * 2 <= WS_P0 &&
              WS_P0 + (size_t)MR * E_IN * 2 <= WS_OATT && WS_OATT + (size_t)MR * D * 2 <= WS_END && WS_H + (size_t)MR * FF * 2 <= WS_END && WS_P1 + (size_t)MR * O_IN * 2 <= WS_RI &&
              WS_RI + (size_t)4 * MR * 512 * 2 <= WS_END && WS_XG + (size_t)NEXP * ML * D <= WS_YG && WS_HG + (size_t)MOE_ROWS * FF <= WS_XG && WS_AGG + (size_t)2 * NCHUNK * 2 * 512 * 4 <= WS_WM13, "d_ws map");
constexpr int CW_TMO = 0, CW_CODE = 1;
constexpr int CW_BAR = 4096;
constexpr int CW_CNT = 8192;
constexpr int RING_OFF = 0, RING_BYTES = 131072;
constexpr int LDSCTL_OFF = RING_BYTES, MISC_OFF = LDSCTL_OFF + 320;
constexpr int PEXP_OFF = LDSCTL_OFF + 1024;
constexpr int LDS_BYTES = 147456;
#define GAS __attribute__((address_space(1)))
#define LAS __attribute__((address_space(3)))
typedef unsigned short bf16;
typedef unsigned v4u __attribute__((ext_vector_type(4)));
typedef float f32x4 __attribute__((ext_vector_type(4)));
typedef short bf16x8 __attribute__((ext_vector_type(8)));
typedef GAS unsigned gu32;
typedef GAS unsigned long long gu64;
#define RLX_AGENT __ATOMIC_RELAXED, __HIP_MEMORY_SCOPE_AGENT
#define LDS_WAIT() asm volatile("s_waitcnt lgkmcnt(0)" ::: "memory")
#define VM_WAIT() asm volatile("s_waitcnt vmcnt(0)" ::: "memory")
__device__ __forceinline__ unsigned long long rt() { return __builtin_amdgcn_s_memrealtime(); }
__device__ __forceinline__ unsigned f2bf(float f) { unsigned u = __builtin_bit_cast(unsigned, f); return (u + 0x7fffu + ((u >> 16) & 1u)) >> 16; }
__device__ __forceinline__ unsigned pk2(float lo, float hi) { return f2bf(lo) | (f2bf(hi) << 16); }

#define XB_TMO      128
#define XB_XCNT(j)  (256  + 64 * (j))
#define XB_XSUB(j)  (1280 + 64 * (j))
#define XB_XGEN(j)  (2304 + 64 * (j))
#define XB_TOP      3328
#define XB_TOPGEN   3392
#define XCD_BAR_WORDS 3456
#define XB_SPIN_CAP (1u << 18)

__device__ __forceinline__ unsigned xb_ld(unsigned* p)              { return __hip_atomic_load(p, __ATOMIC_RELAXED, __HIP_MEMORY_SCOPE_AGENT); }
__device__ __forceinline__ unsigned xb_add(unsigned* p, unsigned v) { return __hip_atomic_fetch_add(p, v, __ATOMIC_RELAXED, __HIP_MEMORY_SCOPE_AGENT); }
__device__ __forceinline__ unsigned xb_xcc_id() { return (unsigned)__builtin_amdgcn_s_getreg((3 << 11) | 20) & 0xFu; }
#define XB_SPIN(cond, bar) do { unsigned _sp = 0; while (cond) { __builtin_amdgcn_s_sleep(1); \
    if ((++_sp & 255u) == 0u) { if (xb_ld(&(bar)[XB_TMO])) break; if (_sp > XB_SPIN_CAP) { atomicAdd(&(bar)[XB_TMO], 1u); break; } } } } while (0)

struct XcdBarrier {
    unsigned* bar; unsigned x;
    volatile LAS unsigned* st;
};

__device__ __forceinline__ XcdBarrier xcd_barrier_post(unsigned* bar, volatile LAS unsigned* st) {
    XcdBarrier b; b.bar = bar; b.x = xb_xcc_id(); b.st = st;
    if (threadIdx.x == 0) (void)xb_add(&bar[XB_XCNT(b.x)], 1u);
    return b;
}
__device__ __forceinline__ void xcd_barrier_complete(unsigned* bar, unsigned x, unsigned& nloc, unsigned& nx) {
    const unsigned G = gridDim.x * gridDim.y * gridDim.z;
    unsigned sum, cnt, mine, sp = 0u;
    for (;;) {
        sum = 0u; cnt = 0u; mine = 0u;
#pragma unroll
        for (unsigned j = 0; j < 16; ++j) { const unsigned c = xb_ld(&bar[XB_XCNT(j)]); sum += c; cnt += (c > 0u) ? 1u : 0u; mine = (j == x) ? c : mine; }
        if (sum == G) break;
        __builtin_amdgcn_s_sleep(1);
        if ((++sp & 255u) == 0u) { if (xb_ld(&bar[XB_TMO])) break; if (sp > XB_SPIN_CAP) { atomicAdd(&bar[XB_TMO], 1u); break; } }
    }
    nloc = mine > 0u ? mine : 1u; nx = cnt > 0u ? cnt : 1u;
}

__device__ __forceinline__ void xcd_barrier(const XcdBarrier& b) {
    asm volatile("s_waitcnt vmcnt(0)" ::: "memory");
    __syncthreads();
    if (threadIdx.x == 0) {
        unsigned* bar = b.bar;
        __builtin_amdgcn_s_waitcnt(0);
        unsigned nloc = b.st[0], nx = b.st[1];
        if (nloc == 0u) { xcd_barrier_complete(bar, b.x, nloc, nx); b.st[0] = nloc; b.st[1] = nx; }
        const unsigned old = xb_add(&bar[XB_XSUB(b.x)], 1u);
        const unsigned gen = old / nloc;
        if (old + 1u == (gen + 1u) * nloc) {
            __builtin_amdgcn_fence(__ATOMIC_RELEASE, "agent");
            asm volatile("s_waitcnt vmcnt(0)" ::: "memory");
            const unsigned og = xb_add(&bar[XB_TOP], 1u);
            const unsigned tg = og / nx;
            if (og + 1u == (tg + 1u) * nx) xb_add(&bar[XB_TOPGEN], 1u);
            else XB_SPIN(xb_ld(&bar[XB_TOPGEN]) == tg, bar);
            __builtin_amdgcn_fence(__ATOMIC_ACQUIRE, "agent");
            xb_add(&bar[XB_XGEN(b.x)], 1u);
            asm volatile("s_waitcnt vmcnt(0)" ::: "memory");
        } else {
            XB_SPIN(xb_ld(&bar[XB_XGEN(b.x)]) == gen, bar);
            __builtin_amdgcn_fence(__ATOMIC_ACQUIRE, "agent");
            asm volatile("s_waitcnt vmcnt(0)" ::: "memory");
        }
    }
    __syncthreads();
}
typedef _Float16 f16;
typedef unsigned v2u __attribute__((ext_vector_type(2)));
typedef float f32x16 __attribute__((ext_vector_type(16)));
struct InPtrs { __device__ __forceinline__ const float* operator[](int i) const { return ((const float* const __attribute__((address_space(4)))*)__builtin_amdgcn_kernarg_segment_ptr())[i]; } };
struct Frame {
    LAS unsigned char* lds;
    volatile LAS unsigned* MISC;
    gu32* ctl;
    int tid, lane, wave;
    int vcu, G;
    InPtrs in; float* out; unsigned char* ws;
};
enum { I_X = 0, I_C, I_CTX, I_CCTX, I_WMOD, I_BMOD, I_NMIXG, I_NFFNG, I_WOUT, I_EWIN, I_ANORMG, I_AWS, I_ABS, I_BQNG, I_BKNG, I_LQ1, I_LK1, I_LQ2, I_LK2, I_SUBLNG,
       I_FW1, I_FW3, I_FW2, I_OWIN, I_CQNG, I_CKNG, I_CONVW, I_CONVB, I_DWA, I_DBA, I_DWX, I_DBX, I_DLAM, I_RW, I_RB, I_MW1, I_MW3, I_MW2 };

__device__ __forceinline__ float wave_sum(float v) {
#pragma unroll
    for (int o = 1; o < 64; o <<= 1) v += __shfl_xor(v, o);
    return v;
}
__device__ __forceinline__ float bf_lo(unsigned u) { return __uint_as_float(u << 16); }
__device__ __forceinline__ float bf_hi(unsigned u) { return __uint_as_float(u & 0xffff0000u); }
__device__ __forceinline__ float bf2f(bf16 h) { return __uint_as_float((unsigned)h << 16); }
__device__ __forceinline__ unsigned cvtpk(float lo, float hi) { return pg8::cvt_pk_bf16(lo, hi); }
__device__ __forceinline__ bf16 f2bf16(float f) { return (bf16)(cvtpk(f, 0.f) & 0xffffu); }
__device__ __forceinline__ void unpack8(const v4u u, float (&f)[8]) { f[0] = bf_lo(u.x); f[1] = bf_hi(u.x); f[2] = bf_lo(u.y); f[3] = bf_hi(u.y); f[4] = bf_lo(u.z); f[5] = bf_hi(u.z); f[6] = bf_lo(u.w); f[7] = bf_hi(u.w); }
__device__ __forceinline__ v4u pack8(const float (&f)[8]) { v4u o; o.x = cvtpk(f[0], f[1]); o.y = cvtpk(f[2], f[3]); o.z = cvtpk(f[4], f[5]); o.w = cvtpk(f[6], f[7]); return o; }
__device__ __forceinline__ float gelu_tanh(float x) { const float p = fmaf(x * x, -0.10294324f, -2.3022082f); return x * __builtin_amdgcn_rcpf(1.0f + __builtin_amdgcn_exp2f(x * p)); }
__device__ __forceinline__ float sigmoid_f(float x) { return __builtin_amdgcn_rcpf(1.0f + __builtin_amdgcn_exp2f(-1.4426950408889634f * x)); }
__device__ __forceinline__ int crow16(int r, int hi) { return (r & 3) + 8 * (r >> 2) + 4 * hi; }

__device__ __forceinline__ bool qk_bounded(const float* gq, const float* gk, int lane) {
    float a = fabsf(gq[lane]), b = fabsf(gk[lane]);
#pragma unroll
    for (int o = 1; o < 64; o <<= 1) { a = fmaxf(a, __shfl_xor(a, o)); b = fmaxf(b, __shfl_xor(b, o)); }
    return __builtin_amdgcn_readfirstlane((int)(64.0f * QSCALE * a * b * 1.02f < 64.0f)) != 0;
}
struct TrItem { const float* W; unsigned char* WT; int K, N, ilv, f8, item; float scale; };
__device__ __forceinline__ void tr_load(const TrItem& d, int lane, f32x4 (&v)[8]) {
    const int nblk = d.N / 32, kb = d.item / nblk, nb = d.item % nblk; const float* p = d.W + (size_t)(64 * kb + (lane >> 3)) * d.N + 32 * nb + 4 * (lane & 7);
#pragma unroll
    for (int i = 0; i < 8; ++i) v[i] = *(const GAS f32x4*)(p + (size_t)(8 * i) * d.N);
}
__device__ __forceinline__ void tr_store(const TrItem& d, int lane, const f32x4 (&v)[8], LAS float* scr) {
    const int nblk = d.N / 32, kb = d.item / nblk, nb = d.item % nblk, k0 = 64 * kb, n0 = 32 * nb;
    const int r0 = d.ilv ? ((n0 >> 7) * 256 + (n0 & 127) + (d.ilv == 2 ? 128 : 0)) : n0;
#pragma unroll
    for (int i = 0; i < 8; ++i) { LAS float* q = scr + (8 * i + (lane >> 3)) * 33 + 4 * (lane & 7); q[0] = v[i].x * d.scale; q[1] = v[i].y * d.scale; q[2] = v[i].z * d.scale; q[3] = v[i].w * d.scale; }
    LDS_WAIT(); asm volatile("" ::: "memory");
    if (d.f8) { const int c = lane & 3;
#pragma unroll
        for (int j = 0; j < 2; ++j) { const int n = (lane >> 2) + 16 * j; const LAS float* s = scr + (16 * c) * 33 + n;
            v4u o; o.x = pg8::cvt4_fp8(s[0 * 33], s[1 * 33], s[2 * 33], s[3 * 33]); o.y = pg8::cvt4_fp8(s[4 * 33], s[5 * 33], s[6 * 33], s[7 * 33]);
            o.z = pg8::cvt4_fp8(s[8 * 33], s[9 * 33], s[10 * 33], s[11 * 33]); o.w = pg8::cvt4_fp8(s[12 * 33], s[13 * 33], s[14 * 33], s[15 * 33]);
            *(GAS v4u*)(d.WT + (size_t)(r0 + n) * d.K + k0 + 16 * c) = o; }
    } else { const int c = lane & 7;
#pragma unroll
        for (int j = 0; j < 4; ++j) { const int n = (lane >> 3) + 8 * j; const LAS float* s = scr + (8 * c) * 33 + n;
            v4u o; o.x = cvtpk(s[0 * 33], s[1 * 33]); o.y = cvtpk(s[2 * 33], s[3 * 33]); o.z = cvtpk(s[4 * 33], s[5 * 33]); o.w = cvtpk(s[6 * 33], s[7 * 33]);
            *(GAS v4u*)((bf16*)d.WT + (size_t)(r0 + n) * d.K + k0 + 8 * c) = o; } }
    LDS_WAIT(); asm volatile("" ::: "memory");
}
constexpr int TR_I_E = 16 * 80, TR_I_O = 16 * 32, TR_I_F = 16 * 88, TR_I_OI = 16 * 56, TR_I_EXP = 3 * TR_I_F;
constexpr int TR_NITEMS = TR_I_E + 2 * TR_I_O + 3 * TR_I_F + TR_I_OI + NEXP * TR_I_EXP;
static_assert(TR_I_F == 44 * 32, "item counts of the [1024][2816] and [2816][1024] matrices match");
__device__ __forceinline__ TrItem tr_decode(Frame& F, int it) {
    unsigned char* ws = F.ws; int r = it; TrItem d; d.f8 = 0; d.scale = 1.0f; d.ilv = 0;
    if (r < TR_I_E) { d.W = F.in[I_EWIN]; d.K = D; d.N = E_IN; d.WT = ws + WS_WE; d.item = r; return d; } r -= TR_I_E;
    if (r < TR_I_O) { d.W = F.in[I_WOUT]; d.K = D; d.N = D; d.WT = ws + WS_WO0; d.item = r; return d; } r -= TR_I_O;
    if (r < TR_I_O) { d.W = F.in[I_WOUT] + (size_t)D * D; d.K = D; d.N = D; d.WT = ws + WS_WO1; d.item = r; return d; } r -= TR_I_O;
    if (r < TR_I_F) { d.W = F.in[I_FW1]; d.K = D; d.N = FF; d.WT = ws + WS_WF13; d.ilv = 1; d.f8 = 1; d.scale = MOE_S13; d.item = r; return d; } r -= TR_I_F;
    if (r < TR_I_F) { d.W = F.in[I_FW3]; d.K = D; d.N = FF; d.WT = ws + WS_WF13; d.ilv = 2; d.f8 = 1; d.scale = MOE_S13; d.item = r; return d; } r -= TR_I_F;
    if (r < TR_I_F) { d.W = F.in[I_FW2]; d.K = FF; d.N = D; d.WT = ws + WS_WF2; d.f8 = 1; d.scale = MOE_S2; d.item = r; return d; } r -= TR_I_F;
    if (r < TR_I_OI) { d.W = F.in[I_OWIN]; d.K = D; d.N = O_IN; d.WT = ws + WS_WOI; d.item = r; return d; } r -= TR_I_OI;
    const int e = r / TR_I_EXP, q = r % TR_I_EXP; d.f8 = 1;
    if (q < TR_I_F) { d.W = F.in[I_MW1] + (size_t)e * D * FF; d.K = D; d.N = FF; d.WT = ws + WS_WM13 + (size_t)e * FF2 * D; d.ilv = 1; d.scale = MOE_S13; d.item = q; }
    else if (q < 2 * TR_I_F) { d.W = F.in[I_MW3] + (size_t)e * D * FF; d.K = D; d.N = FF; d.WT = ws + WS_WM13 + (size_t)e * FF2 * D; d.ilv = 2; d.scale = MOE_S13; d.item = q - TR_I_F; }
    else { d.W = F.in[I_MW2] + (size_t)e * FF * D; d.K = FF; d.N = D; d.WT = ws + WS_WM2 + (size_t)e * D * FF; d.scale = MOE_S2; d.item = q - 2 * TR_I_F; }
    return d;
}
constexpr int TR_DENSE = TR_I_E + TR_I_O;
__device__ __forceinline__ void tr_range(Frame& F, int lo, int hi) {
    LAS float* scr = (LAS float*)(F.lds + RING_OFF + F.wave * 16384);
    const int gw = F.vcu * NWAVES + F.wave, NGW = F.G * NWAVES, lane = F.lane;
    f32x4 v0[8], v1[8], v2[8], v3[8]; TrItem d0, d1, d2, d3; int it = lo + gw;
#define TR_ISSUE(d, v, idx) do { const int i_ = (idx); d = tr_decode(F, i_ < hi ? i_ : lo); if (i_ < hi) tr_load(d, lane, v); } while (0)
    TR_ISSUE(d0, v0, it); TR_ISSUE(d1, v1, it + NGW); TR_ISSUE(d2, v2, it + 2 * NGW);
    while (it < hi) {
        TR_ISSUE(d3, v3, it + 3 * NGW); tr_store(d0, lane, v0, scr); if (it + NGW >= hi) break;
        TR_ISSUE(d0, v0, it + 4 * NGW); tr_store(d1, lane, v1, scr); if (it + 2 * NGW >= hi) break;
        TR_ISSUE(d1, v1, it + 5 * NGW); tr_store(d2, lane, v2, scr); if (it + 3 * NGW >= hi) break;
        TR_ISSUE(d2, v2, it + 6 * NGW); tr_store(d3, lane, v3, scr);
        it += 4 * NGW; }
#undef TR_ISSUE
}
__device__ __forceinline__ void ph0_prologue(Frame& F) {
    const int lane = F.lane;
    tr_range(F, 0, TR_DENSE);
    { bf16* WG = (bf16*)(F.ws + WS_WG);
      for (int i = (int)blockIdx.x * 512 + F.tid; i < 2 * 2 * 8 * 64 * 64; i += F.G * 512) {
          const int k = i & 63, o = (i >> 6) & 63, n = (i >> 12) & 7, mat = (i >> 15) & 1, d = (i >> 16) & 1;
          const float* W = mat ? F.in[I_DWX] : F.in[I_DWA];
          WG[i] = f2bf16(W[((size_t)(d * 8 + n) * 64 + k) * 64 + o]); } }
    __syncthreads();
    { float* MOD = (float*)(F.ws + WS_MOD); LAS float* red = (LAS float*)(F.lds + RING_OFF);
      for (int cg = (int)blockIdx.x; cg < 2 * 96; cg += F.G) {
          const int layer = cg / 96, n0 = (cg % 96) * 64, kr = lane >> 4, c4 = lane & 15;
          f32x4 acc[3]; acc[0] = acc[1] = acc[2] = (f32x4){0.f, 0.f, 0.f, 0.f};
          const float* Wl = F.in[I_WMOD] + (size_t)layer * D * 6 * D;
#pragma unroll 4
          for (int it = 0; it < 32; ++it) { const int k = F.wave * 128 + 4 * it + kr;
              const f32x4 w = *(const GAS f32x4*)(Wl + (size_t)k * 6 * D + n0 + 4 * c4);
              const float c0 = F.in[I_C][k], c1 = F.in[I_C][D + k], c2 = F.in[I_CCTX][k];
              acc[0] += (c0 * sigmoid_f(c0)) * w; acc[1] += (c1 * sigmoid_f(c1)) * w; acc[2] += (c2 * sigmoid_f(c2)) * w; }
#pragma unroll
          for (int s = 0; s < 3; ++s)
#pragma unroll
              for (int j = 0; j < 4; ++j) { float v = acc[s][j]; v += __shfl_xor(v, 16); v += __shfl_xor(v, 32); acc[s][j] = v; }
          if (lane < 16) {
#pragma unroll
              for (int s = 0; s < 3; ++s)
#pragma unroll
                  for (int j = 0; j < 4; ++j) red[(F.wave * 3 + s) * 64 + 4 * c4 + j] = acc[s][j]; }
          __syncthreads();
          if (F.tid < 192) { const int s = F.tid >> 6, col = F.tid & 63; float v = F.in[I_BMOD][layer * 6 * D + n0 + col];
#pragma unroll
              for (int w = 0; w < 8; ++w) v += red[(w * 3 + s) * 64 + col];
              MOD[(size_t)(layer * 3 + s) * 6 * D + n0 + col] = v; }
          __syncthreads();
      } }
}
template <bool F8 = false> __device__ __forceinline__ void normmod_row(const float* src, const float* g, const float* sc, const float* sh, bf16* dst, int lane, f32x4 (&t)[4]) {
    const GAS f32x4* xr = (const GAS f32x4*)src + lane; float s = 0.f;
#pragma unroll
    for (int j = 0; j < 4; ++j) { t[j] = xr[64 * j]; s += (t[j].x * t[j].x + t[j].y * t[j].y) + (t[j].z * t[j].z + t[j].w * t[j].w); }
    const float rstd = 1.0f / sqrtf(wave_sum(s) * (1.f / D) + EPS);
    GAS v2u* o8 = (GAS v2u*)dst + lane;
#pragma unroll
    for (int j = 0; j < 4; ++j) { const f32x4 gg = ((const GAS f32x4*)g)[lane + 64 * j], cc = ((const GAS f32x4*)sc)[lane + 64 * j], hh = ((const GAS f32x4*)sh)[lane + 64 * j];
        t[j] = t[j] * rstd * gg * (1.0f + cc) + hh;
        if constexpr (F8) ((GAS unsigned*)dst)[lane + 64 * j] = pg8::cvt4_fp8(t[j].x, t[j].y, t[j].z, t[j].w); else { v2u w; w.x = cvtpk(t[j].x, t[j].y); w.y = cvtpk(t[j].z, t[j].w); o8[64 * j] = w; } }
}
template <bool F8 = false> __device__ __forceinline__ void ph_normmod(Frame& F, const float* srcL, const float* srcC, int nrows, const float* g, int layer, int sh_off, int sc_off) {
    const int gw = F.vcu * NWAVES + F.wave, NGW = F.G * NWAVES; const float* MOD = (const float*)(F.ws + WS_MOD) + (size_t)layer * 3 * 6 * D; bf16* XN = (bf16*)(F.ws + WS_XN);
    for (int m = gw; m < nrows; m += NGW) { const int s = m < SEQ ? 0 : (m < ML ? 1 : 2); const float* src = m < ML ? srcL + (size_t)m * D : srcC + (size_t)(m - ML) * D; f32x4 t[4];
        normmod_row<F8>(src, g, MOD + s * 6 * D + sc_off, MOD + s * 6 * D + sh_off, F8 ? (bf16*)((unsigned char*)XN + (size_t)m * D) : XN + (size_t)m * D, F.lane, t); }
}
struct RopeLane { float fr[8]; float sgn; int useRow; };
__device__ __forceinline__ RopeLane rope_lane(int lane) { RopeLane R; const int j = lane & 7; R.sgn = (j & 2) ? 1.f : -1.f; R.useRow = (j < 4);
#pragma unroll
    for (int e = 0; e < 8; ++e) R.fr[e] = __builtin_amdgcn_exp2f(-(float)((j & 1) * 8 + e) * (13.287712379549449f / 16.f)) * 0.15915494309189535f;
    return R; }
__device__ __forceinline__ void rope_cs(const RopeLane& R, int prow, int pcol, float (&cs)[8], float (&sn)[8]) {
    const float pos = (float)(R.useRow ? prow : pcol);
#pragma unroll
    for (int e = 0; e < 8; ++e) { float rev = pos * R.fr[e]; rev = rev - floorf(rev); cs[e] = __builtin_amdgcn_cosf(rev); sn[e] = R.sgn * __builtin_amdgcn_sinf(rev); }
}
__device__ __forceinline__ void qknorm_rope(float (&f)[8], const float* g, bool rope, const float (&cs)[8], const float (&sn)[8], float outscale, int lane) {
    float ss = 0.f;
#pragma unroll
    for (int e = 0; e < 8; ++e) ss += f[e] * f[e];
    ss += __shfl_xor(ss, 1); ss += __shfl_xor(ss, 2); ss += __shfl_xor(ss, 4);
    const float rstd = outscale * __builtin_amdgcn_rsqf(ss * (1.f / 64.f) + EPS); const int j = lane & 7;
    const f32x4 g0 = *(const GAS f32x4*)(g + 8 * j), g1 = *(const GAS f32x4*)(g + 8 * j + 4);
    const float gg[8] = {g0.x, g0.y, g0.z, g0.w, g1.x, g1.y, g1.z, g1.w};
#pragma unroll
    for (int e = 0; e < 8; ++e) f[e] = f[e] * (rstd * gg[e]);
    if (rope) {
#pragma unroll
        for (int e = 0; e < 8; ++e) { const float p = __shfl_xor(f[e], 2); f[e] = f[e] * cs[e] + p * sn[e]; }
    }
}
__device__ __forceinline__ void ph3_post0(Frame& F) {
    const int gw = F.vcu * NWAVES + F.wave, NGW = F.G * NWAVES, lane = F.lane; bf16* P0 = (bf16*)(F.ws + WS_P0); bf16* KC = (bf16*)(F.ws + WS_KC0); bf16* VC = (bf16*)(F.ws + WS_VC0); const RopeLane RL = rope_lane(lane);
    for (int m = gw; m < MR; m += NGW) {
        GAS v4u* rowp = (GAS v4u*)(P0 + (size_t)m * E_IN) + lane;
        const v4u u0 = rowp[0], u1 = rowp[64], u2 = rowp[128], u3 = rowp[192];
        float f[8];
        unpack8(u0, f);
#pragma unroll
        for (int e = 0; e < 8; ++e) f[e] = gelu_tanh(f[e]);
        rowp[0] = pack8(f);
        unpack8(u1, f); float ss = 0.f;
#pragma unroll
        for (int e = 0; e < 8; ++e) { f[e] = gelu_tanh(f[e]); ss += f[e] * f[e]; }
        { const float rstd = 1.0f / sqrtf(wave_sum(ss) * (1.f / 512.f) + EPS); const float* g = F.in[I_ANORMG] + 8 * lane;
          const f32x4 g0 = *(const GAS f32x4*)g, g1 = *(const GAS f32x4*)(g + 4); const float gg[8] = {g0.x, g0.y, g0.z, g0.w, g1.x, g1.y, g1.z, g1.w};
#pragma unroll
          for (int e = 0; e < 8; ++e) f[e] = f[e] * rstd * gg[e]; }
        rowp[64] = pack8(f);
        const bool lat = m < ML; const int t = m & (SEQ - 1), prow = t >> 6, pcol = t & 63; float cs[8], sn[8]; if (lat) rope_cs(RL, prow, pcol, cs, sn);
        unpack8(u2, f); qknorm_rope(f, F.in[I_BQNG], lat, cs, sn, QSCALE, lane); rowp[128] = pack8(f);
        unpack8(u3, f); qknorm_rope(f, F.in[I_BKNG], lat, cs, sn, 1.0f, lane);
        { const int b = lat ? (m >> 13) : ((m - ML) >> 8), pos = lat ? CTXL + t : ((m - ML) & (CTXL - 1)); const size_t tb = (size_t)(pos >> 6) * 4096; const int pr = pos & 63;
          *(GAS v4u*)(KC + ((size_t)(b * 8 + (lane >> 3)) * KEYS * 64 + tb + (lane & 7) * 512 + pr * 8)) = pack8(f);
          const v4u u4 = rowp[256];
          *(GAS v4u*)(VC + ((size_t)(b * 8 + (lane >> 3)) * KEYS * 64 + tb + ((((lane & 7) >> 2) * 4 + (pr >> 4)) * 64 + (pr & 15) * 4 + (lane & 3)) * 8)) = u4; }
    }
}
__device__ __forceinline__ void gmlp_unit(Frame& F, int chunk) {
    const int lane = F.lane, r32 = lane & 31, hi = lane >> 5, g = F.wave, r0 = chunk * 128;
    const bf16* P0 = (const bf16*)(F.ws + WS_P0); bf16* Y = (bf16*)(F.ws + WS_Y);
    const float* ws = F.in[I_AWS] + (size_t)g * 128 * 128; const float* bs = F.in[I_ABS] + g * 128;
    bf16x8 afr[2][8];
#pragma unroll
    for (int ct = 0; ct < 2; ++ct)
#pragma unroll
        for (int ks = 0; ks < 8; ++ks)
#pragma unroll
            for (int e = 0; e < 8; ++e) afr[ct][ks][e] = (short)P0[(size_t)(r0 + 16 * ks + 8 * hi + e) * E_IN + 512 + 64 * g + 32 * ct + r32];
#pragma unroll 1
    for (int pt = 0; pt < 4; ++pt) {
        f32x16 acc[2]; acc[0] = f32x16{}; acc[1] = f32x16{};
        const float* wp = ws + (size_t)(32 * pt + r32) * 128 + 8 * hi;
#pragma unroll
        for (int ks = 0; ks < 8; ++ks) { const f32x4 w0 = *(const GAS f32x4*)(wp + 16 * ks), w1 = *(const GAS f32x4*)(wp + 16 * ks + 4);
            v4u pk; pk.x = cvtpk(w0.x, w0.y); pk.y = cvtpk(w0.z, w0.w); pk.z = cvtpk(w1.x, w1.y); pk.w = cvtpk(w1.z, w1.w); const bf16x8 bfr = __builtin_bit_cast(bf16x8, pk);
            acc[0] = __builtin_amdgcn_mfma_f32_32x32x16_bf16(afr[0][ks], bfr, acc[0], 0, 0, 0); acc[1] = __builtin_amdgcn_mfma_f32_32x32x16_bf16(afr[1][ks], bfr, acc[1], 0, 0, 0); }
        const int p = 32 * pt + r32; const float bias = bs[p];
#pragma unroll
        for (int ct = 0; ct < 2; ++ct)
#pragma unroll
            for (int rq = 0; rq < 4; ++rq) { const int c0 = 64 * g + 32 * ct + 8 * rq + 4 * hi;
                const v2u uu = *(const GAS v2u*)(P0 + (size_t)(r0 + p) * E_IN + c0);
                v2u o; o.x = cvtpk(bf_lo(uu.x) * (acc[ct][4 * rq + 0] + bias), bf_hi(uu.x) * (acc[ct][4 * rq + 1] + bias)); o.y = cvtpk(bf_lo(uu.y) * (acc[ct][4 * rq + 2] + bias), bf_hi(uu.y) * (acc[ct][4 * rq + 3] + bias));
                *(GAS v2u*)(Y + (size_t)(r0 + p) * D + c0) = o; }
    }
}
__device__ __forceinline__ void ph5_diffout(Frame& F) {
    const int gw = F.vcu * NWAVES + F.wave, NGW = F.G * NWAVES, lane = F.lane; const bf16* OA = (const bf16*)(F.ws + WS_OATT); bf16* Y = (bf16*)(F.ws + WS_Y);
    const float s1 = wave_sum(F.in[I_LQ1][lane] * F.in[I_LK1][lane]), s2 = wave_sum(F.in[I_LQ2][lane] * F.in[I_LK2][lane]);
    const float lam_init = 0.2f, lam = expf(s1) - expf(s2) + lam_init;
    const int h = lane >> 4, comp = (lane >> 3) & 1, i0 = (lane & 7) * 16;
    float gg[16];
#pragma unroll
    for (int q = 0; q < 4; ++q) { const f32x4 gv = *(const GAS f32x4*)(F.in[I_SUBLNG] + i0 + 4 * q); gg[4 * q] = gv.x; gg[4 * q + 1] = gv.y; gg[4 * q + 2] = gv.z; gg[4 * q + 3] = gv.w; }
    for (int m = gw; m < MR; m += NGW) {
        const GAS v4u* rp = (const GAS v4u*)(OA + (size_t)m * D + 16 * lane);
        const v4u a = rp[0], b = rp[1]; float own[16], d[16];
        { float t8[8]; unpack8(a, t8);
#pragma unroll
          for (int e = 0; e < 8; ++e) own[e] = t8[e];
          unpack8(b, t8);
#pragma unroll
          for (int e = 0; e < 8; ++e) own[8 + e] = t8[e]; }
        float ss = 0.f;
#pragma unroll
        for (int e = 0; e < 16; ++e) { const float oth = __shfl_xor(own[e], 8); const float o1 = comp ? oth : own[e], o2 = comp ? own[e] : oth; d[e] = o1 - lam * o2; ss += d[e] * d[e]; }
        ss += __shfl_xor(ss, 1); ss += __shfl_xor(ss, 2); ss += __shfl_xor(ss, 4);
        const float rstd = (1.0f - lam_init) / sqrtf(ss * (1.f / 128.f) + EPS);
        if (comp == 0) { float o8[8]; GAS v4u* yp = (GAS v4u*)(Y + (size_t)m * D + 512 + 128 * h + i0);
#pragma unroll
            for (int e = 0; e < 8; ++e) o8[e] = d[e] * rstd * gg[e];
            yp[0] = pack8(o8);
#pragma unroll
            for (int e = 0; e < 8; ++e) o8[e] = d[8 + e] * rstd * gg[8 + e];
            yp[1] = pack8(o8); }
    }
}
__device__ __forceinline__ void ph12_post1(Frame& F) {
    const int nskip = (NCHUNK > F.G && NCHUNK - F.G < F.G / 2) ? NCHUNK - F.G : 0;
    if (F.vcu < nskip) return;
    const int gw = (F.vcu - nskip) * NWAVES + F.wave, NGW = (F.G - nskip) * NWAVES, lane = F.lane; bf16* P1 = (bf16*)(F.ws + WS_P1); bf16* KC = (bf16*)(F.ws + WS_KC1); bf16* VC = (bf16*)(F.ws + WS_VC1); const RopeLane RL = rope_lane(lane);
    for (int m = gw; m < MR; m += NGW) {
        GAS v4u* rowp = (GAS v4u*)(P1 + (size_t)m * O_IN) + lane;
        const v4u u0 = rowp[0], u1 = rowp[64];
        const bool lat = m < ML; const int t = m & (SEQ - 1), prow = t >> 6, pcol = t & 63; float f[8]; float cs[8], sn[8]; if (lat) rope_cs(RL, prow, pcol, cs, sn);
        unpack8(u0, f); qknorm_rope(f, F.in[I_CQNG], lat, cs, sn, QSCALE, lane); if (lat) rowp[0] = pack8(f);
        unpack8(u1, f); qknorm_rope(f, F.in[I_CKNG], lat, cs, sn, 1.0f, lane);
        { const int b = lat ? (m >> 13) : ((m - ML) >> 8), pos = lat ? CTXL + t : ((m - ML) & (CTXL - 1)); const size_t tb = (size_t)(pos >> 6) * 4096; const int pr = pos & 63, l2 = lane & 15;
          if (lane < 16) *(GAS v4u*)(KC + ((size_t)(b * 2 + (l2 >> 3)) * KEYS * 64 + tb + (l2 & 7) * 512 + pr * 8)) = pack8(f);
          else if (lane < 32) *(GAS v4u*)(VC + ((size_t)(b * 2 + (l2 >> 3)) * KEYS * 64 + tb + ((((l2 & 7) >> 2) * 4 + (pr >> 4)) * 64 + (pr & 15) * 4 + (l2 & 3)) * 8)) = u1; }
    }
}
__device__ __forceinline__ bool seq_start(int r) { return r < ML ? (r & (SEQ - 1)) == 0 : ((r - ML) & (CTXL - 1)) == 0; }
constexpr int XDS = 520;
__device__ __forceinline__ void conv_to_lds(Frame& F, int r0, LAS bf16* XD) {
    const int cg = F.lane, w = F.wave; const bf16* P1 = (const bf16*)(F.ws + WS_P1);
    const bool st = seq_start(r0), en = seq_start(r0 + 64) || (r0 + 64 == MR);
    float wj[4][8], cb[8];
#pragma unroll
    for (int j = 0; j < 4; ++j) { const f32x4 a = *(const GAS f32x4*)(F.in[I_CONVW] + j * 512 + 8 * cg), b = *(const GAS f32x4*)(F.in[I_CONVW] + j * 512 + 8 * cg + 4);
        wj[j][0] = a.x; wj[j][1] = a.y; wj[j][2] = a.z; wj[j][3] = a.w; wj[j][4] = b.x; wj[j][5] = b.y; wj[j][6] = b.z; wj[j][7] = b.w; }
    { const f32x4 a = *(const GAS f32x4*)(F.in[I_CONVB] + 8 * cg), b = *(const GAS f32x4*)(F.in[I_CONVB] + 8 * cg + 4); cb[0] = a.x; cb[1] = a.y; cb[2] = a.z; cb[3] = a.w; cb[4] = b.x; cb[5] = b.y; cb[6] = b.z; cb[7] = b.w; }
    v4u xr[11];
#pragma unroll
    for (int i = 0; i < 11; ++i) { const int rl = 8 * w + i - 2; const bool ok = !((st && rl < 0) || (en && rl >= 64));
        xr[i] = ok ? *(const GAS v4u*)(P1 + (size_t)(r0 + rl) * O_IN + 1280 + 8 * cg) : (v4u){0u, 0u, 0u, 0u}; }
    float acc[8][8];
#pragma unroll
    for (int o = 0; o < 8; ++o)
#pragma unroll
        for (int e = 0; e < 8; ++e) acc[o][e] = cb[e];
#pragma unroll
    for (int i = 0; i < 11; ++i) { float f[8]; unpack8(xr[i], f);
#pragma unroll
        for (int j = 0; j < 4; ++j) { const int o = i - j; if (o >= 0 && o < 8) {
#pragma unroll
            for (int e = 0; e < 8; ++e) acc[o][e] += wj[j][e] * f[e]; } } }
#pragma unroll
    for (int o = 0; o < 8; ++o) *(LAS v4u*)(XD + (8 * w + o) * XDS + 8 * cg) = pack8(acc[o]);
}
__device__ __forceinline__ void lru_gates(Frame& F, const LAS bf16* XD, int n, int d, int half, f32x16 (&a)[2], f32x16 (&b)[2]) {
    const int lane = F.lane, r32 = lane & 31, hi = lane >> 5; const bf16* WG = (const bf16*)(F.ws + WS_WG);
    f32x16 ai[2]; a[0] = f32x16{}; a[1] = f32x16{}; ai[0] = f32x16{}; ai[1] = f32x16{};
    const bf16* wpr = WG + ((size_t)(((d * 2 + 0) * 8 + n) * 64 + 32 * half + r32)) * 64 + 8 * hi; const bf16* wpi = WG + ((size_t)(((d * 2 + 1) * 8 + n) * 64 + 32 * half + r32)) * 64 + 8 * hi;
#pragma unroll
    for (int ks = 0; ks < 4; ++ks) { const bf16x8 br = *(const GAS bf16x8*)(wpr + 16 * ks), bi = *(const GAS bf16x8*)(wpi + 16 * ks);
#pragma unroll
        for (int mt = 0; mt < 2; ++mt) { const bf16x8 af = *(const LAS bf16x8*)(XD + (32 * mt + r32) * XDS + 64 * n + 16 * ks + 8 * hi);
            a[mt] = __builtin_amdgcn_mfma_f32_32x32x16_bf16(af, br, a[mt], 0, 0, 0); ai[mt] = __builtin_amdgcn_mfma_f32_32x32x16_bf16(af, bi, ai[mt], 0, 0, 0); } }
    __builtin_amdgcn_sched_barrier(0);
    const int ch = 64 * n + 32 * half + r32; const float ba = F.in[I_DBA][d * 512 + ch], bx = F.in[I_DBX][d * 512 + ch];
    const float spl = -8.0f * 1.4426950408889634f * log1pf(expf(-F.in[I_DLAM][d * 512 + ch]));
    const float nba = -1.4426950408889634f * ba, nbx = -1.4426950408889634f * bx;
#pragma unroll
    for (int mt = 0; mt < 2; ++mt)
#pragma unroll
        for (int r = 0; r < 16; ++r) { const int row = 32 * mt + crow16(r, hi); const float xd = bf2f(XD[row * XDS + ch]);
            const float rr = __builtin_amdgcn_rcpf(1.0f + __builtin_amdgcn_exp2f(fmaf(a[mt][r], -1.4426950408889634f, nba))), ii = __builtin_amdgcn_rcpf(1.0f + __builtin_amdgcn_exp2f(fmaf(ai[mt][r], -1.4426950408889634f, nbx)));
            const float av = __builtin_amdgcn_exp2f(rr * spl), om = fmaxf(fmaf(-av, av, 1.0f), 0.0f);
            a[mt][r] = av; b[mt][r] = __builtin_amdgcn_sqrtf(om) * (ii * xd);     if ((r & 3) == 3) __builtin_amdgcn_sched_barrier(0); }
}
template <bool REV, bool FULL> __device__ __forceinline__ void chunk_scan(f32x16 (&a)[2], f32x16 (&b)[2], int hi, float h0, float& Atot, float& Btot) {
    float GA[8], GB[8], pGA[8], pGB[8], carry[8];
#pragma unroll
    for (int j = 0; j < 8; ++j) { const int mt = j >> 2, q = j & 3;
#pragma unroll
        for (int p = 1; p < 4; ++p) { const int k = REV ? 3 - p : p, kp = REV ? k + 1 : k - 1; const float ak = a[mt][4 * q + k];
            b[mt][4 * q + k] = ak * b[mt][4 * q + kp] + b[mt][4 * q + k]; a[mt][4 * q + k] = ak * a[mt][4 * q + kp]; }
        GA[j] = a[mt][4 * q + (REV ? 0 : 3)]; GB[j] = b[mt][4 * q + (REV ? 0 : 3)]; }
#pragma unroll
    for (int j = 0; j < 8; ++j) { const auto ra = __builtin_amdgcn_permlane32_swap(__float_as_uint(GA[j]), __float_as_uint(GA[j]), false, false); pGA[j] = __uint_as_float(hi ? ra[0] : ra[1]);
        const auto rb = __builtin_amdgcn_permlane32_swap(__float_as_uint(GB[j]), __float_as_uint(GB[j]), false, false); pGB[j] = __uint_as_float(hi ? rb[0] : rb[1]); }
    float c = h0, At = 1.0f; const bool firstMine = REV ? (hi == 1) : (hi == 0);
#pragma unroll
    for (int jj = 0; jj < 8; ++jj) { const int j = REV ? 7 - jj : jj;
        const float A1 = firstMine ? GA[j] : pGA[j], B1 = firstMine ? GB[j] : pGB[j], A2 = firstMine ? pGA[j] : GA[j], B2 = firstMine ? pGB[j] : GB[j];
        const float c1 = A1 * c + B1; carry[j] = firstMine ? c : c1; c = A2 * c1 + B2; At *= GA[j] * pGA[j]; }
    Atot = At; Btot = c;
    if constexpr (FULL) {
#pragma unroll
        for (int j = 0; j < 8; ++j) { const int mt = j >> 2, q = j & 3;
#pragma unroll
            for (int k = 0; k < 4; ++k) b[mt][4 * q + k] = a[mt][4 * q + k] * carry[j] + b[mt][4 * q + k]; }
    }
}
__device__ __forceinline__ void scan_prep_unit(Frame& F, int cid) {
    const int r0 = cid * 64, lane = F.lane, r32 = lane & 31, hi = lane >> 5, n = F.wave; LAS bf16* XD = (LAS bf16*)(F.lds + RING_OFF); float* AGG = (float*)(F.ws + WS_AGG);
    conv_to_lds(F, r0, XD);
    LDS_WAIT(); __syncthreads();
#pragma unroll
    for (int d = 0; d < 2; ++d)
#pragma unroll
        for (int half = 0; half < 2; ++half) { f32x16 a[2], b[2]; lru_gates(F, XD, n, d, half, a, b); float At, Bt;
            if (d == 0) chunk_scan<false, false>(a, b, hi, 0.f, At, Bt); else chunk_scan<true, false>(a, b, hi, 0.f, At, Bt);
            if (hi == 0) { const int ch = 64 * n + 32 * half + r32; AGG[((size_t)(d * NCHUNK + cid) * 2 + 0) * 512 + ch] = At; AGG[((size_t)(d * NCHUNK + cid) * 2 + 1) * 512 + ch] = Bt; } }
    LDS_WAIT(); __syncthreads();
}
__device__ __forceinline__ void scan_fix_unit(Frame& F, int cid) {
    const int b = cid >> 7, j = cid & 127, r0 = cid * 64, lane = F.lane, r32 = lane & 31, hi = lane >> 5, n = F.wave;
    const float* AGG = (const float*)(F.ws + WS_AGG); const bf16* P1 = (const bf16*)(F.ws + WS_P1); bf16* Y = (bf16*)(F.ws + WS_Y);
    LAS bf16* XD = (LAS bf16*)(F.lds + RING_OFF); LAS float* CAR = (LAS float*)(F.lds + RING_OFF + 64 * XDS * 2);
    conv_to_lds(F, r0, XD);
    asm volatile("" ::: "memory"); __builtin_amdgcn_sched_barrier(0);
    { const int ch = F.tid; const float* A0 = AGG + ch; const float* A1 = AGG + (size_t)NCHUNK * 1024 + ch;
      float hf = 0.f, hb = 0.f;
#pragma unroll
      for (int q = 0; q < 4; ++q) { const int c = 256 + 4 * b + q; hf = A0[(size_t)c * 1024] * hf + A0[(size_t)c * 1024 + 512]; }
#pragma unroll 8
      for (int q = 0; q < j; ++q) { const int c = 128 * b + q; hf = A0[(size_t)c * 1024] * hf + A0[(size_t)c * 1024 + 512]; }
#pragma unroll
      for (int q = 3; q >= 0; --q) { const int c = 256 + 4 * b + q; hb = A1[(size_t)c * 1024] * hb + A1[(size_t)c * 1024 + 512]; }
#pragma unroll 8
      for (int q = 127; q > j; --q) { const int c = 128 * b + q; hb = A1[(size_t)c * 1024] * hb + A1[(size_t)c * 1024 + 512]; }
      CAR[ch] = hf; CAR[512 + ch] = hb; }
    LDS_WAIT(); __syncthreads();
#pragma unroll 1
    for (int half = 0; half < 2; ++half) { const int ch = 64 * n + 32 * half + r32; f32x16 a[2], hf[2], hb[2]; float At, Bt;
        lru_gates(F, XD, n, 0, half, a, hf); chunk_scan<false, true>(a, hf, hi, CAR[ch], At, Bt);
        __builtin_amdgcn_sched_barrier(0); lru_gates(F, XD, n, 1, half, a, hb); chunk_scan<true, true>(a, hb, hi, CAR[512 + ch], At, Bt);
        const bf16* gp = P1 + (size_t)r0 * O_IN + 768; bf16* yp = Y + (size_t)r0 * D + 512;
#pragma unroll
        for (int mt = 0; mt < 2; ++mt)
#pragma unroll
            for (int q = 0; q < 4; ++q) {
#pragma unroll
                for (int k = 0; k < 4; ++k) { const unsigned rl = (unsigned)(32 * mt + 8 * q + 4 * hi + k); const float gt = bf2f(gp[rl * (unsigned)O_IN + (unsigned)ch]);
                    yp[rl * (unsigned)D + (unsigned)ch] = f2bf16((hf[mt][4 * q + k] + hb[mt][4 * q + k]) * gelu_tanh(gt)); }
                asm volatile("" ::: "memory"); } }
    LDS_WAIT(); __syncthreads();
}
__device__ __forceinline__ void ph15_router(Frame& F) {
    LAS float* WR = (LAS float*)(F.lds + RING_OFF);
    LAS int* lcnt = (LAS int*)(F.lds + RING_OFF + 32768); LAS int* lbase = lcnt + 8; LAS int* rec = lcnt + 16;
    LAS unsigned char* STG = F.lds + RING_OFF + 40960;
    const int lane = F.lane; const float* MOD = (const float*)(F.ws + WS_MOD) + (size_t)3 * 6 * D; unsigned char* XG = F.ws + WS_XG; int* TOK = (int*)(F.ws + WS_TOK);
    for (int i = F.tid; i < 1024 * 8 / 4; i += NWAVES * 64) ((LAS f32x4*)WR)[i] = ((const GAS f32x4*)F.in[I_RW])[i];
    __syncthreads();
    for (int rb = F.vcu; rb < ML / 64; rb += F.G) {
        if (F.tid < 8) lcnt[F.tid] = 0;
        __syncthreads();
#pragma unroll 1
        for (int i = 0; i < 8; ++i) { const int rl = F.wave * 8 + i, m = rb * 64 + rl, s = m >> 13; f32x4 t[4];
            { const GAS f32x4* xr = (const GAS f32x4*)(F.out + (size_t)m * D) + lane; float q = 0.f;
#pragma unroll
              for (int j = 0; j < 4; ++j) { t[j] = xr[64 * j]; q += (t[j].x * t[j].x + t[j].y * t[j].y) + (t[j].z * t[j].z + t[j].w * t[j].w); }
              const float rstd = 1.0f / sqrtf(wave_sum(q) * (1.f / D) + EPS); const float* g = F.in[I_NFFNG] + D; const float* sc = MOD + s * 6 * D + 4 * D; const float* sh = MOD + s * 6 * D + 3 * D;
#pragma unroll
              for (int j = 0; j < 4; ++j) { const f32x4 gg = ((const GAS f32x4*)g)[lane + 64 * j], cc = ((const GAS f32x4*)sc)[lane + 64 * j], hh = ((const GAS f32x4*)sh)[lane + 64 * j];
                  t[j] = t[j] * rstd * gg * (1.0f + cc) + hh; ((LAS unsigned*)(STG + rl * 1024))[lane + 64 * j] = pg8::cvt4_fp8(t[j].x, t[j].y, t[j].z, t[j].w); } }
            float lg[8];
#pragma unroll
            for (int e = 0; e < 8; ++e) lg[e] = 0.f;
#pragma unroll
            for (int j = 0; j < 4; ++j)
#pragma unroll
                for (int k = 0; k < 4; ++k) { const int c = 4 * lane + 256 * j + k; const f32x4 w0 = *(const LAS f32x4*)(WR + c * 8), w1 = *(const LAS f32x4*)(WR + c * 8 + 4); const float tv = t[j][k];
                    lg[0] += tv * w0.x; lg[1] += tv * w0.y; lg[2] += tv * w0.z; lg[3] += tv * w0.w; lg[4] += tv * w1.x; lg[5] += tv * w1.y; lg[6] += tv * w1.z; lg[7] += tv * w1.w; }
#pragma unroll
            for (int e = 0; e < 8; ++e) lg[e] = wave_sum(lg[e]) + F.in[I_RB][e];
            int e1 = 0; float v1 = lg[0];
#pragma unroll
            for (int e = 1; e < 8; ++e) if (lg[e] > v1) { v1 = lg[e]; e1 = e; }
            int e2 = -1; float v2 = -INFINITY;
#pragma unroll
            for (int e = 0; e < 8; ++e) if (e != e1 && lg[e] > v2) { v2 = lg[e]; e2 = e; }
            const float g1 = 1.0f / (1.0f + expf(v2 - v1)), g2 = 1.0f - g1;
            if (lane == 0) { LAS int* rc = rec + rl * 6; rc[0] = e1; rc[1] = e2; rc[2] = (int)__hip_atomic_fetch_add((LAS unsigned*)(lcnt + e1), 1u, __ATOMIC_RELAXED, __HIP_MEMORY_SCOPE_WORKGROUP);
                rc[3] = (int)__hip_atomic_fetch_add((LAS unsigned*)(lcnt + e2), 1u, __ATOMIC_RELAXED, __HIP_MEMORY_SCOPE_WORKGROUP); rc[4] = __float_as_int(g1); rc[5] = __float_as_int(g2); }
        }
        LDS_WAIT(); __syncthreads();
        if (F.tid < 8) lbase[F.tid] = (int)__hip_atomic_fetch_add((unsigned*)(F.ctl + CW_CNT + 64 * F.tid), (unsigned)lcnt[F.tid], __ATOMIC_RELAXED, __HIP_MEMORY_SCOPE_AGENT);
        LDS_WAIT(); __syncthreads();
        if (F.tid < 64) { const LAS int* rc = rec + F.tid * 6; int* tk = TOK + (size_t)(rb * 64 + F.tid) * 6;
            tk[0] = rc[0]; tk[1] = rc[1]; tk[2] = lbase[rc[0]] + rc[2]; tk[3] = lbase[rc[1]] + rc[3]; tk[4] = rc[4]; tk[5] = rc[5]; }
#pragma unroll
        for (int i = 0; i < 8; ++i) { const int rl = F.wave * 8 + i; const LAS int* rc = rec + rl * 6; const v4u row = *(const LAS v4u*)(STG + rl * 1024 + 16 * lane);
            const int e1 = rc[0], e2 = rc[1], p1 = lbase[e1] + rc[2], p2 = lbase[e2] + rc[3];
            *(GAS v4u*)(XG + ((size_t)e1 * ML + p1) * D + 16 * lane) = row; *(GAS v4u*)(XG + ((size_t)e2 * ML + p2) * D + 16 * lane) = row; }
        LDS_WAIT(); __syncthreads();
    }
}
__device__ __forceinline__ void moe_offsets(Frame& F, int (&off)[9]) {
    int o = 0;
#pragma unroll
    for (int e = 0; e < 8; ++e) { off[e] = o; const int c = (int)__hip_atomic_load((unsigned*)(F.ctl + CW_CNT + 64 * e), __ATOMIC_RELAXED, __HIP_MEMORY_SCOPE_AGENT); o += (c + 255) & ~255; }
    off[8] = o;
}
__device__ __forceinline__ int moe_tables(Frame& F) {
    int off[9]; moe_offsets(F, off); LAS int* pexp = (LAS int*)(F.lds + PEXP_OFF);
    if (F.tid < MOE_PAN) { const int r = F.tid * 256; int e = 0;
#pragma unroll
        for (int q = 1; q < 8; ++q) e = (r >= off[q]) ? q : e;
        pexp[F.tid] = e; }
    if (F.tid < 8) pexp[140 + F.tid] = off[F.tid] / 256;
    __syncthreads();
    return off[8] / 256;
}
__device__ __forceinline__ void ph19_combine(Frame& F) {
    int off[9]; moe_offsets(F, off);
    const int gw = F.vcu * NWAVES + F.wave, NGW = F.G * NWAVES, lane = F.lane; const bf16* YG = (const bf16*)(F.ws + WS_YG); const int* TOK = (const int*)(F.ws + WS_TOK);
    const float* MOD = (const float*)(F.ws + WS_MOD) + (size_t)3 * 6 * D;
    for (int m = gw; m < ML; m += NGW) { const int* tk = TOK + (size_t)m * 6; const int e1 = tk[0], e2 = tk[1]; int b1 = 0, b2 = 0;
#pragma unroll
        for (int q = 0; q < 8; ++q) { b1 = (e1 == q) ? off[q] : b1; b2 = (e2 == q) ? off[q] : b2; }
        const float g1 = __int_as_float(tk[4]), g2 = __int_as_float(tk[5]); const float* gp = MOD + (m >> 13) * 6 * D + 5 * D;
        const GAS v2u* y1 = (const GAS v2u*)(YG + (size_t)(b1 + tk[2]) * D) + lane; const GAS v2u* y2 = (const GAS v2u*)(YG + (size_t)(b2 + tk[3]) * D) + lane;
        GAS f32x4* o = (GAS f32x4*)(F.out + (size_t)m * D) + lane;
#pragma unroll
        for (int j = 0; j < 4; ++j) { const v2u a = y1[64 * j], b = y2[64 * j]; const f32x4 gv = ((const GAS f32x4*)gp)[lane + 64 * j]; f32x4 x = o[64 * j];
            x.x += gv.x * (g1 * bf_lo(a.x) + g2 * bf_lo(b.x)); x.y += gv.y * (g1 * bf_hi(a.x) + g2 * bf_hi(b.x)); x.z += gv.z * (g1 * bf_lo(a.y) + g2 * bf_lo(b.y)); x.w += gv.w * (g1 * bf_hi(a.y) + g2 * bf_hi(b.y));
            o[64 * j] = x; } }
}
struct Args { const float* in[38]; float* out; unsigned char* ws; int ph_lo, ph_hi; };
__global__ void __launch_bounds__(NWAVES * 64, 2) mk_fwd(Args args) {
    extern __shared__ __attribute__((aligned(16))) unsigned char lds[];
    Frame F;
    F.lds = (LAS unsigned char*)lds;
    F.MISC = (volatile LAS unsigned*)(F.lds + MISC_OFF);
    F.tid = threadIdx.x; F.lane = F.tid & 63; F.wave = __builtin_amdgcn_readfirstlane(F.tid >> 6);
    F.G = gridDim.x; { const int bx = blockIdx.x; F.vcu = (F.G % 8 == 0) ? (bx % 8) * (F.G / 8) + bx / 8 : bx; }
    F.ws = args.ws; F.out = args.out; F.ctl = (gu32*)(args.ws + WS_CTL);
    for (int u = F.tid; u < (LDS_BYTES - LDSCTL_OFF) / 4; u += NWAVES * 64) ((LAS unsigned*)(F.lds + LDSCTL_OFF))[u] = 0u;
    __syncthreads();
    XcdBarrier bar; bar.bar = (unsigned*)(F.ctl + CW_BAR); bar.x = 0; bar.st = nullptr;
    if (MK_ONE_LAUNCH) bar = xcd_barrier_post((unsigned*)(F.ctl + CW_BAR), F.MISC + 8);
#define GRID_BAR() do { if (MK_ONE_LAUNCH) xcd_barrier(bar); } while (0)
    const int lo = args.ph_lo, hi = args.ph_hi;
#define RELANE() do { int t_ = (int)threadIdx.x; asm volatile("" : "+v"(t_)); F.tid = t_; F.lane = t_ & 63; } while (0)
#define IN(k) (lo <= (k) && (k) < hi)
#define BOTH(k) (IN(k) && IN((k) + 1))
#ifndef MK_REP_MASK
#define MK_REP_MASK 0
#endif
#define REP(k) for (int rep_ = 0; rep_ < (((MK_REP_MASK >> (k)) & 1) ? 2 : 1); ++rep_)
    unsigned char* ws = args.ws;
    bf16* XN = (bf16*)(ws + WS_XN); bf16* Y = (bf16*)(ws + WS_Y); bf16* P0 = (bf16*)(ws + WS_P0); bf16* P1 = (bf16*)(ws + WS_P1); bf16* OA = (bf16*)(ws + WS_OATT); bf16* Hb = (bf16*)(ws + WS_H);
    float* XR = (float*)(ws + WS_XR); const float* MOD = (const float*)(ws + WS_MOD);
    using ABF = attn_body::bf16;

    if (IN(0)) { RELANE(); REP(0) { ph0_prologue(F); __syncthreads(); } if (BOTH(0)) GRID_BAR(); }
    if (IN(1)) { RELANE(); REP(1) ph_normmod(F, F.in[I_X], F.in[I_CTX], MR, F.in[I_NMIXG], 0, 0, D); if (BOTH(1)) GRID_BAR(); }
    if (IN(2)) { RELANE();
        pg8::Gemm g{XN, (const bf16*)(ws + WS_WE), MR, E_IN, D}; pg8::StaticOrder S; S.init(MR, E_IN, F.G, (int)blockIdx.x);
        pg8::EpiBf16<0> E{P0, E_IN, nullptr, 0, 0, 1.f};
        REP(2) pg8::gemm_phase<pg8::EpiBf16<0>, pg8::StaticOrder, PG8_ALIGN, PG8_SP2>(F.lds + RING_OFF, g, S, E);
        if (BOTH(2)) GRID_BAR();
    }
    if (IN(3)) { RELANE(); ph3_post0(F); if (BOTH(3)) GRID_BAR(); }
    if (IN(4)) { RELANE();
        const bool nomax0 = qk_bounded(F.in[I_BQNG], F.in[I_BKNG], F.lane);
        const int trslot = F.vcu % 3;
        float lam; { const int ln = F.lane; const float s1 = wave_sum(F.in[I_LQ1][ln] * F.in[I_LK1][ln]), s2 = wave_sum(F.in[I_LQ2][ln] * F.in[I_LK2][ln]); lam = expf(s1) - expf(s2) + 0.2f; }
        REP(4) for (int i = 0;; ++i) { const int L = i * F.G + F.vcu; if (L >= 256 + 8) break;
            const bool lat = L < 256; const int bh4 = lat ? (L >> 5) : (L - 256), qb = lat ? (L & 31) : 0, b = bh4 >> 2, h = bh4 & 3;
            const size_t qrow0 = lat ? (size_t)b * SEQ + (size_t)qb * 256 : (size_t)(ML + b * CTXL); const int NT = lat ? 132 : 4, rot = lat ? (F.vcu & 31) * 4 : 0;
            const ABF* Vs = (const ABF*)(ws + WS_VC0) + (size_t)(b * 8 + 2 * h) * KEYS * 64; ABF* O1 = (ABF*)(OA + qrow0 * D + 256 * h); ABF* Yo = (ABF*)(Y + qrow0 * D + 512 + 128 * h);
#pragma unroll 1
            for (int sc = 0; sc < 3; ++sc) {
                if (lat && sc == trslot && rep_ == 0) { tr_range(F, TR_DENSE, TR_NITEMS); LDS_WAIT(); __syncthreads(); }
                if (sc < 2) { const ABF* Ks = (const ABF*)(ws + WS_KC0) + (size_t)(b * 8 + 2 * h + sc) * KEYS * 64; const ABF* Q = (const ABF*)(P0 + qrow0 * E_IN + 1024 + 128 * h + 64 * sc);
                    if (sc == 1) VM_WAIT();
                    if (nomax0) attn_body::attn_unit2<-1>(Q, E_IN, Ks, Vs, Vs + (size_t)KEYS * 64, sc ? Yo : O1, D, NT, rot, (char*)lds + RING_OFF, sc == 1, O1, D, lam, F.in[I_SUBLNG], 0.8f);
                    else attn_body::attn_unit2<8>(Q, E_IN, Ks, Vs, Vs + (size_t)KEYS * 64, sc ? Yo : O1, D, NT, rot, (char*)lds + RING_OFF, sc == 1, O1, D, lam, F.in[I_SUBLNG], 0.8f); } } }
        RELANE();
        REP(4) for (int c = F.vcu - 32; c >= 0 && c < MR / 128; c += F.G) gmlp_unit(F, c);
        if (BOTH(4)) GRID_BAR();
    }
    if (IN(6)) { RELANE();
        pg8::Gemm g{Y, (const bf16*)(ws + WS_WO0), MR, D, D}; pg8::StaticOrder S; S.init(MR, D, F.G, (int)blockIdx.x);
        pg8::EpiResGate E{F.in[I_X], F.in[I_CTX], XR, MOD + 2 * D, 1.0f};
        REP(6) pg8::gemm_phase<pg8::EpiResGate, pg8::StaticOrder, PG8_ALIGN, PG8_SP2>(F.lds + RING_OFF, g, S, E);
        if (BOTH(6)) GRID_BAR();
    }
    if (IN(7)) { RELANE(); REP(7) ph_normmod<true>(F, XR, XR + (size_t)ML * D, MR, F.in[I_NFFNG], 0, 3 * D, 4 * D); if (BOTH(7)) GRID_BAR(); }
    if (IN(8)) { RELANE();
        pg8::Gemm g{XN, (const bf16*)(ws + WS_WF13), MR, FF2, D / 2}; pg8::StaticOrder S; S.init(MR, FF2, F.G, (int)blockIdx.x);
        pg8::EpiSwiGLUF8 E{(unsigned char*)Hb, FF, FF2 / 256, 1.0f / MOE_S13};
        REP(8) pg8::gemm_phase<pg8::EpiSwiGLUF8, pg8::StaticOrder, PG8_ALIGN, PG8_SP2, true>(F.lds + RING_OFF, g, S, E);
        if (BOTH(8)) GRID_BAR();
    }
    if (IN(9)) { RELANE();
        pg8::Gemm g{Hb, (const bf16*)(ws + WS_WF2), MR, D, FF / 2}; pg8::StaticOrder S; S.init(MR, D, F.G, (int)blockIdx.x);
        pg8::EpiResGate E{XR, XR + (size_t)ML * D, XR, MOD + 5 * D, 1.0f / MOE_S2};
        REP(9) pg8::gemm_phase<pg8::EpiResGate, pg8::StaticOrder, PG8_ALIGN, PG8_SP2, true>(F.lds + RING_OFF, g, S, E);
        if (BOTH(9)) GRID_BAR();
    }
    if (IN(10)) { RELANE(); REP(10) ph_normmod(F, XR, XR + (size_t)ML * D, MR, F.in[I_NMIXG] + D, 1, 0, D); if (BOTH(10)) GRID_BAR(); }
    if (IN(11)) { RELANE();
        pg8::Gemm g{XN, (const bf16*)(ws + WS_WOI), MR, O_IN, D}; pg8::StaticOrder S; S.init(MR, O_IN, F.G, (int)blockIdx.x);
        pg8::EpiBf16<0> E{P1, O_IN, nullptr, 0, 0, 1.f};
        REP(11) pg8::gemm_phase<pg8::EpiBf16<0>, pg8::StaticOrder, PG8_ALIGN, PG8_SP2>(F.lds + RING_OFF, g, S, E);
        if (BOTH(11)) GRID_BAR();
    }
    if (IN(12)) { RELANE();
        ph12_post1(F);
        REP(12) for (int c = F.vcu; c < NCHUNK; c += F.G) scan_prep_unit(F, c);
        if (BOTH(12)) GRID_BAR();
    }
    if (IN(13)) { RELANE();
        REP(13) for (int c = F.vcu; c < ML / 64; c += F.G) scan_fix_unit(F, c);
        const bool nomax1 = qk_bounded(F.in[I_CQNG], F.in[I_CKNG], F.lane);
        REP(13) for (int i = 0;; ++i) { const int L = i * F.G + F.vcu; if (L >= 512) break;
            const int bh = L >> 5, qb = L & 31, b = bh >> 3, hq = bh & 7, kv = hq >> 2;
            const size_t crow0 = (size_t)(ML + b * CTXL), lrow0 = (size_t)b * SEQ, qrow0 = lrow0 + (size_t)qb * 256;
            const ABF* Ks = (const ABF*)(ws + WS_KC1) + (size_t)(b * 2 + kv) * KEYS * 64; const ABF* Vs = (const ABF*)(ws + WS_VC1) + (size_t)(b * 2 + kv) * KEYS * 64;
            if (nomax1) attn_body::attn_unit<-1, true>((const ABF*)(P1 + qrow0 * O_IN + 64 * hq), O_IN, Ks, Ks + 4 * 4096, 64, Vs, Vs + 4 * 4096, 64, (ABF*)(Y + qrow0 * D + 64 * hq), D, 132, 4, (F.vcu & 31) * 4, (char*)lds + RING_OFF);
            else attn_body::attn_unit<8, true>((const ABF*)(P1 + qrow0 * O_IN + 64 * hq), O_IN, Ks, Ks + 4 * 4096, 64, Vs, Vs + 4 * 4096, 64, (ABF*)(Y + qrow0 * D + 64 * hq), D, 132, 4, (F.vcu & 31) * 4, (char*)lds + RING_OFF); }
        if (BOTH(13)) GRID_BAR();
    }
    if (IN(14)) { RELANE();
        pg8::Gemm g{Y, (const bf16*)(ws + WS_WO1), ML, D, D}; pg8::StaticOrder S; S.init(ML, D, F.G, (int)blockIdx.x);
        pg8::EpiResGate E{XR, XR, F.out, MOD + 3 * 6 * D + 2 * D, 1.0f};
        REP(14) pg8::gemm_phase<pg8::EpiResGate, pg8::StaticOrder, PG8_ALIGN, PG8_SP2>(F.lds + RING_OFF, g, S, E);
        if (BOTH(14)) GRID_BAR();
    }
    if (IN(15)) { RELANE(); ph15_router(F); if (BOTH(15)) GRID_BAR(); }
    if (IN(17)) { RELANE();
        const int npan = moe_tables(F);
        pg8::Gemm g{(const bf16*)(ws + WS_XG), (const bf16*)(ws + WS_WM13), MOE_ROWS, NEXP * FF2, D / 2}; pg8::MoeOrder S{npan, FF2 / 256, F.G, F.vcu, (const LAS int*)(F.lds + PEXP_OFF), true};
        pg8::EpiSwiGLUF8 E{ws + WS_HG, FF, FF2 / 256, 1.0f / MOE_S13};
        REP(17) pg8::gemm_phase<pg8::EpiSwiGLUF8, pg8::MoeOrder, PG8_ALIGN, PG8_SP2, true>(F.lds + RING_OFF, g, S, E);
        if (BOTH(17)) GRID_BAR();
    }
    if (IN(18)) { RELANE();
        const int npan = moe_tables(F);
        pg8::Gemm g{(const bf16*)(ws + WS_HG), (const bf16*)(ws + WS_WM2), MOE_ROWS, NEXP * D, FF / 2}; pg8::MoeOrder S{npan, D / 256, F.G, F.vcu, (const LAS int*)(F.lds + PEXP_OFF), false};
        pg8::EpiBf16S E{(bf16*)(ws + WS_YG), D, D / 256, 1.0f / MOE_S2};
        REP(18) pg8::gemm_phase<pg8::EpiBf16S, pg8::MoeOrder, PG8_ALIGN, PG8_SP2, true>(F.lds + RING_OFF, g, S, E);
        if (BOTH(18)) GRID_BAR();
    }
    if (IN(19)) { RELANE(); ph19_combine(F); }
#undef IN
#undef BOTH
#undef GRID_BAR
}

extern "C" void kernel_launch(void* const* d_in, const int* in_sizes, int n_in, void* d_out, int out_size, void* d_ws, size_t ws_size, hipStream_t stream) {
    static int grid = 0;
    if (grid == 0) {
        if (n_in != 38 || in_sizes[0] != ML * D || out_size != ML * D || ws_size < WS_END) { fprintf(stderr, "kernel_launch: built for 38 inputs, x/out of %d floats, >= %zu bytes of workspace; got n_in %d, in0 %d, out %d, ws %zu; nothing launched\n", ML * D, (size_t)WS_END, n_in, n_in > 0 ? in_sizes[0] : -1, out_size, ws_size); grid = -1; return; }
        int dev = 0, cus = 0, per_cu = 0;
        if (hipGetDevice(&dev) != hipSuccess || hipDeviceGetAttribute(&cus, hipDeviceAttributeMultiprocessorCount, dev) != hipSuccess) { fprintf(stderr, "kernel_launch: device query failed\n"); grid = -1; return; }
        if (hipFuncSetAttribute((const void*)mk_fwd, hipFuncAttributeMaxDynamicSharedMemorySize, LDS_BYTES) != hipSuccess) { fprintf(stderr, "kernel_launch: hipFuncSetAttribute failed\n"); grid = -1; return; }
        if (hipOccupancyMaxActiveBlocksPerMultiprocessor(&per_cu, (const void*)mk_fwd, NWAVES * 64, LDS_BYTES) != hipSuccess || per_cu < 1) fprintf(stderr, "kernel_launch: note: occupancy query reports %d workgroups per CU\n", per_cu);
        (void)hipGetLastError();
        grid = cus;
    }
    if (grid < 0) return;
    if (hipMemsetAsync((char*)d_ws + WS_CTL, 0, CTL_ZERO_BYTES, stream) != hipSuccess) { fprintf(stderr, "kernel_launch: hipMemsetAsync failed\n"); return; }
    Args a{};
    for (int i = 0; i < 38; ++i) a.in[i] = (const float*)d_in[i];
    a.out = (float*)d_out; a.ws = (unsigned char*)d_ws;
#if MK_ONE_LAUNCH
    a.ph_lo = 0; a.ph_hi = NPH;
    hipLaunchKernelGGL(mk_fwd, dim3(grid), dim3(NWAVES * 64), LDS_BYTES, stream, a);
#else
    for (int ph = 0; ph < NPH; ++ph) { a.ph_lo = ph; a.ph_hi = ph + 1; hipLaunchKernelGGL(mk_fwd, dim3(grid), dim3(NWAVES * 64), LDS_BYTES, stream, a); }
#endif
    const hipError_t le = hipPeekAtLastError();
    if (le != hipSuccess) fprintf(stderr, "kernel_launch: launch failed: %s\n", hipGetErrorName(le));
}
```

```cpp
#include <hip/hip_runtime.h>
#include <cstdio>
#include <cstdint>
#include <cmath>
namespace pg8 {
#define PG8_LAS __attribute__((address_space(3)))
typedef unsigned short bf16_t;
typedef short bf16x8 __attribute__((ext_vector_type(8)));
typedef float f32x4 __attribute__((ext_vector_type(4)));
typedef unsigned u32x4 __attribute__((ext_vector_type(4)));
typedef int i32x4 __attribute__((ext_vector_type(4)));
typedef int i32x8 __attribute__((ext_vector_type(8)));
typedef unsigned u32x2 __attribute__((ext_vector_type(2)));
constexpr int BM = 256, BK = 64, HALF = 128, HTB = HALF * BK * 2  , STAGE_BYTES = 8 * HTB, NXCD = 8, WGM = 8;

__host__ __device__ __forceinline__ int lds_byte(int r, int c) { const int st = (r >> 4) * 2 + (c >> 5), rr = r & 15, cc = c & 31, ob = rr * 64 + cc * 2; return st * 1024 + (ob ^ (((ob >> 9) & 1) << 5)); }
__host__ __device__ __forceinline__ void stage_rc(int b, int& R, int& C) { const int st = b / 1024, sb = b % 1024, swz = sb ^ (((sb >> 9) & 1) << 5); R = (st >> 1) * 16 + swz / 64; C = (st & 1) * 32 + (swz % 64) / 2; }
__host__ __device__ __forceinline__ int perm32(int rho) { const int n = rho >> 4, i = rho & 15; return 8 * (i >> 2) + 4 * n + (i & 3); }

struct Unit { int pm, pn, pa; };
struct Gemm { const bf16_t* A; const bf16_t* Bt; int M, N, K; };

struct StaticOrder {
    int nM, nN, nwg, G, c;
    __host__ __device__ void init(int M, int N, int G_, int c_) { nM = M / BM; nN = N / BM; nwg = nM * nN; G = G_; c = c_; }
    __host__ __device__ bool next(int i, Unit& u) const {
        const long L = (long)i * G + c; if (L >= nwg) return false;
        int wgid = (int)L; { const int q = nwg / NXCD, r = nwg % NXCD, xcd = wgid % NXCD, off = wgid / NXCD; wgid = (xcd < r ? xcd * (q + 1) : r * (q + 1) + (xcd - r) * q) + off; }
        const int nig = WGM * nN, gid = wgid / nig, fm = gid * WGM, gsz = (nM - fm) < WGM ? (nM - fm) : WGM;
        u.pm = fm + ((wgid % nig) % gsz); u.pn = (wgid % nig) / gsz; u.pa = u.pm; return true;
    }
    __device__ __forceinline__ void a_ready(const Unit&) const {}
    __device__ __forceinline__ void done(const Unit&) const {}
};

__device__ __forceinline__ unsigned cvt_pk_bf16(float lo, float hi) { unsigned r; asm volatile("v_cvt_pk_bf16_f32 %0, %1, %2" : "=v"(r) : "v"(lo), "v"(hi)); return r; }
typedef float f32x2 __attribute__((ext_vector_type(2)));
__device__ __forceinline__ f32x2 gelu_pk(f32x2 v) {
    const f32x2 av = __builtin_elementwise_abs(v), d = av * 0.2316418882f + 1.0f;
    f32x2 t; t.x = __builtin_amdgcn_rcpf(d.x); t.y = __builtin_amdgcn_rcpf(d.y);
    f32x2 q = t * 0.5307027145f + (-0.7265760135f); q = q * t + 0.7107068705f; q = q * t + (-0.142248368f); q = q * t + 0.127414796f; q = q * t;
    const f32x2 s = (v * v) * (-0.72134752044f);
    f32x2 e; e.x = __builtin_amdgcn_exp2f(s.x); e.y = __builtin_amdgcn_exp2f(s.y);
    const f32x2 m = v * (q * e), r = v - m;
    f32x2 o; o.x = v.x < 0.f ? m.x : r.x; o.y = v.y < 0.f ? m.y : r.y; return o;
}

template <int ACT  > struct EpiBf16 {
    static constexpr bool PERM = true, AFTER_DRAIN = false; static_assert(ACT == 0 || ACT == 1, "EpiBf16: ACT is 0 (none) or 1 (gelu_pk)");
    bf16_t* O; int ldc; const float* bias; int split_cols; size_t split_stride; float scale0;
    __device__ __forceinline__ void operator()(const f32x4 (&acc)[2][2][4][2], const Unit& u, int wr, int wc, int fr, int fq) const {
        const int row0 = u.pm * BM + wr * 64 + fr; int colt = u.pn * BM; bf16_t* base = O;
        float sc = 1.f; if (split_cols) { const int t = colt / split_cols; base += (size_t)t * split_stride; colt -= t * split_cols; if (t == 0) sc = scale0; }
        const int col0 = colt + wc * 32 + 8 * fq, bcol0 = u.pn * BM + wc * 32 + 8 * fq;
        f32x4 bv[2][2];
#pragma unroll
        for (int bj = 0; bj < 2; ++bj)
#pragma unroll
            for (int n = 0; n < 2; ++n) bv[bj][n] = bias ? *(const f32x4*)(bias + bcol0 + bj * HALF + 4 * n) : (f32x4){0.f, 0.f, 0.f, 0.f};
#pragma unroll
        for (int ai = 0; ai < 2; ++ai)
#pragma unroll
            for (int m = 0; m < 4; ++m) { bf16_t* rowp = base + (size_t)(row0 + ai * HALF + m * 16) * ldc + col0;
#pragma unroll
                for (int bj = 0; bj < 2; ++bj) { f32x4 v0 = acc[ai][bj][m][0] + bv[bj][0], v1 = acc[ai][bj][m][1] + bv[bj][1];
                    if (ACT == 1) { f32x2 a = gelu_pk((f32x2){v0[0], v0[1]}), b = gelu_pk((f32x2){v0[2], v0[3]}), c = gelu_pk((f32x2){v1[0], v1[1]}), d = gelu_pk((f32x2){v1[2], v1[3]});
                        v0 = (f32x4){a.x, a.y, b.x, b.y}; v1 = (f32x4){c.x, c.y, d.x, d.y}; }
                    v0 = v0 * sc; v1 = v1 * sc; u32x4 w; w.x = cvt_pk_bf16(v0[0], v0[1]); w.y = cvt_pk_bf16(v0[2], v0[3]); w.z = cvt_pk_bf16(v1[0], v1[1]); w.w = cvt_pk_bf16(v1[2], v1[3]);
                    *(u32x4*)(rowp + bj * HALF) = w; } }
    }
};
template <bool B16, bool O16> struct EpiResGate {
    static constexpr bool PERM = true, AFTER_DRAIN = false;
    const void* baseL; const void* baseC; void* out; const float* gate; float ascale;
    __device__ __forceinline__ void operator()(const f32x4 (&acc)[2][2][4][2], const Unit& u, int wr, int wc, int fr, int fq) const {
        const int st = u.pm < 32 ? 0 : (u.pm < 64 ? 1 : 2);
        const float* gp = gate + st * 6144;
        const size_t prow = u.pm < 64 ? (size_t)u.pm * BM : (size_t)(u.pm - 64) * BM; const void* base = u.pm < 64 ? baseL : baseC;
        const int col0 = u.pn * BM + wc * 32 + 8 * fq;
        f32x4 gv[2][2];
#pragma unroll
        for (int bj = 0; bj < 2; ++bj)
#pragma unroll
            for (int n = 0; n < 2; ++n) gv[bj][n] = *(const f32x4*)(gp + col0 + bj * HALF + 4 * n) * ascale;
#pragma unroll
        for (int ai = 0; ai < 2; ++ai)
#pragma unroll
            for (int m = 0; m < 4; ++m) { const int rl = ai * HALF + wr * 64 + m * 16 + fr; const size_t boff = (prow + rl) * 1024 + col0, ooff = ((size_t)u.pm * BM + rl) * 1024 + col0;
#pragma unroll
                for (int bj = 0; bj < 2; ++bj) { f32x4 b0, b1;
                    if constexpr (B16) { const u32x4 w = *(const u32x4*)((const bf16_t*)base + boff + bj * HALF);
                        b0 = (f32x4){__builtin_bit_cast(float, w.x << 16), __builtin_bit_cast(float, w.x & 0xffff0000u), __builtin_bit_cast(float, w.y << 16), __builtin_bit_cast(float, w.y & 0xffff0000u)};
                        b1 = (f32x4){__builtin_bit_cast(float, w.z << 16), __builtin_bit_cast(float, w.z & 0xffff0000u), __builtin_bit_cast(float, w.w << 16), __builtin_bit_cast(float, w.w & 0xffff0000u)}; }
                    else { b0 = *(const f32x4*)((const float*)base + boff + bj * HALF); b1 = *(const f32x4*)((const float*)base + boff + bj * HALF + 4); }
                    const f32x4 v0 = b0 + gv[bj][0] * acc[ai][bj][m][0], v1 = b1 + gv[bj][1] * acc[ai][bj][m][1];
                    if constexpr (O16) { u32x4 w; w.x = cvt_pk_bf16(v0[0], v0[1]); w.y = cvt_pk_bf16(v0[2], v0[3]); w.z = cvt_pk_bf16(v1[0], v1[1]); w.w = cvt_pk_bf16(v1[2], v1[3]); *(u32x4*)((bf16_t*)out + ooff + bj * HALF) = w; }
                    else { *(f32x4*)((float*)out + ooff + bj * HALF) = v0; *(f32x4*)((float*)out + ooff + bj * HALF + 4) = v1; } }
                if (m & 1) asm volatile("" ::: "memory"); }
    }
};
struct EpiSwiGLU {
    static constexpr bool PERM = true, AFTER_DRAIN = false;
    bf16_t* H; int ldh; int ntl;
    __device__ __forceinline__ void operator()(const f32x4 (&acc)[2][2][4][2], const Unit& u, int wr, int wc, int fr, int fq) const {
        const int row0 = u.pm * BM + wr * 64 + fr; const int ct = u.pn % ntl; const int col0 = ct * HALF + wc * 32 + 8 * fq;
#pragma unroll
        for (int ai = 0; ai < 2; ++ai)
#pragma unroll
            for (int m = 0; m < 4; ++m) { bf16_t* rowp = H + (size_t)(row0 + ai * HALF + m * 16) * ldh + col0;
                float hv[8];
#pragma unroll
                for (int n = 0; n < 2; ++n)
#pragma unroll
                    for (int j = 0; j < 4; ++j) { const float a = acc[ai][0][m][n][j], b = acc[ai][1][m][n][j];
                        const float e = __builtin_amdgcn_exp2f(a * -1.4426950408889634f); hv[n * 4 + j] = a * __builtin_amdgcn_rcpf(1.0f + e) * b; }
                u32x4 w; w.x = cvt_pk_bf16(hv[0], hv[1]); w.y = cvt_pk_bf16(hv[2], hv[3]); w.z = cvt_pk_bf16(hv[4], hv[5]); w.w = cvt_pk_bf16(hv[6], hv[7]);
                *(u32x4*)rowp = w; }
    }
};
__device__ __forceinline__ unsigned cvt4_fp8(float a, float b, float c, float d) { unsigned w = 0u; w = (unsigned)__builtin_amdgcn_cvt_pk_fp8_f32(a, b, (int)w, false); w = (unsigned)__builtin_amdgcn_cvt_pk_fp8_f32(c, d, (int)w, true); return w; }
struct EpiSwiGLUF8 {
    static constexpr bool PERM = true, AFTER_DRAIN = false;
    unsigned char* H; int ldh; int ntl; float s;
    __device__ __forceinline__ void operator()(const f32x4 (&acc)[2][2][4][2], const Unit& u, int wr, int wc, int fr, int fq) const {
        const int row0 = u.pm * BM + wr * 64 + fr; const int ct = u.pn % ntl; const int col0 = ct * HALF + wc * 32 + 8 * fq;
#pragma unroll
        for (int ai = 0; ai < 2; ++ai)
#pragma unroll
            for (int m = 0; m < 4; ++m) { unsigned char* rowp = H + (size_t)(row0 + ai * HALF + m * 16) * ldh + col0;
                float hv[8];
#pragma unroll
                for (int n = 0; n < 2; ++n)
#pragma unroll
                    for (int j = 0; j < 4; ++j) { const float a = acc[ai][0][m][n][j], b = acc[ai][1][m][n][j];
                        const float e = __builtin_amdgcn_exp2f(a * (s * -1.4426950408889634f)); hv[n * 4 + j] = (a * b) * (s * s) * __builtin_amdgcn_rcpf(1.0f + e); }
                u32x2 w; w.x = cvt4_fp8(hv[0], hv[1], hv[2], hv[3]); w.y = cvt4_fp8(hv[4], hv[5], hv[6], hv[7]);
                *(u32x2*)rowp = w; }
    }
};
struct EpiBf16S {
    static constexpr bool PERM = true, AFTER_DRAIN = false;
    bf16_t* O; int ldc; int ntl; float s;
    __device__ __forceinline__ void operator()(const f32x4 (&acc)[2][2][4][2], const Unit& u, int wr, int wc, int fr, int fq) const {
        const int row0 = u.pm * BM + wr * 64 + fr; const int col0 = (u.pn % ntl) * BM + wc * 32 + 8 * fq;
#pragma unroll
        for (int ai = 0; ai < 2; ++ai)
#pragma unroll
            for (int m = 0; m < 4; ++m) { bf16_t* rowp = O + (size_t)(row0 + ai * HALF + m * 16) * ldc + col0;
#pragma unroll
                for (int bj = 0; bj < 2; ++bj) { const f32x4 v0 = acc[ai][bj][m][0] * s, v1 = acc[ai][bj][m][1] * s;
                    u32x4 w; w.x = cvt_pk_bf16(v0[0], v0[1]); w.y = cvt_pk_bf16(v0[2], v0[3]); w.z = cvt_pk_bf16(v1[0], v1[1]); w.w = cvt_pk_bf16(v1[2], v1[3]);
                    *(u32x4*)(rowp + bj * HALF) = w; } }
    }
};
struct MoeOrder {
    int npan, ntl, G, c; const PG8_LAS int* pexp; bool capA;
    __device__ __forceinline__ bool next(int i, Unit& u) const {
        const long L = (long)i * G + c; if (L >= (long)npan * ntl) return false;
        const int pm = (int)(L / ntl), j = (int)(L % ntl); const int e = __builtin_amdgcn_readfirstlane(pexp[pm]); u.pm = pm; u.pn = e * ntl + j; u.pa = capA ? 64 * e + pm - __builtin_amdgcn_readfirstlane(pexp[140 + e]) : pm; return true;
    }
    __device__ __forceinline__ void a_ready(const Unit&) const {}
    __device__ __forceinline__ void done(const Unit&) const {}
};
template <class Epi, class Sched, bool ALIGN_EPI = false, bool SP2 = false, bool FP8 = false>
__device__ __forceinline__ void gemm_phase(PG8_LAS unsigned char* lds, const Gemm g, const Sched& S, const Epi& E) {
    const int tid = threadIdx.x, wid = __builtin_amdgcn_readfirstlane(tid >> 6), lane = tid & 63, wr = wid >> 2, wc = wid & 3, fr = lane & 15, fq = lane >> 4;
    const int K = g.K, nt = K / BK;
    unsigned voffA[2], voffB[2];
#pragma unroll
    for (int i = 0; i < 2; ++i) { int R, C; stage_rc(tid * 16 + i * 8192, R, C); const int Rb = Epi::PERM ? ((R & ~31) + perm32(R & 31)) : R;
        voffA[i] = (unsigned)(R * K + C) * 2u; voffB[i] = (unsigned)(Rb * K + C) * 2u; }
    const size_t kstep = (size_t)(BK * 2);
    const size_t hstep = (size_t)HALF * K * 2;
    const size_t tstep = 2 * hstep;
    const unsigned ldsw = (unsigned)wid * 1024u;
    const int aoff = lds_byte(wr * 64 + fr, fq * 8), boff = lds_byte(wc * 32 + fr, fq * 8);
#define PG8_SA(b, h) (((b) * 2 + (h)) * HTB)
#define PG8_SB(b, h) ((4 + (b) * 2 + (h)) * HTB)
#define PG8_STAGE(bufoff, gbase, voff) do { _Pragma("unroll") for (int _i = 0; _i < 2; ++_i) \
        __builtin_amdgcn_global_load_lds((const unsigned*)((const char*)(gbase) + (voff)[_i]), (PG8_LAS unsigned*)(lds + (bufoff) + ldsw + _i * 8192), 16, 0, 0); } while (0)
#define PG8_CAT(x, y) __builtin_shufflevector(__builtin_bit_cast(i32x4, x), __builtin_bit_cast(i32x4, y), 0, 1, 2, 3, 4, 5, 6, 7)
#define PG8_LDA(dst, b, h) do { if constexpr (FP8) { _Pragma("unroll") for (int m = 0; m < 4; ++m) dst##8[m] = PG8_CAT(*(const PG8_LAS bf16x8*)(lds + PG8_SA(b, h) + aoff + m * 2048), *(const PG8_LAS bf16x8*)(lds + PG8_SA(b, h) + aoff + m * 2048 + 1024)); } else { \
        _Pragma("unroll") for (int m = 0; m < 4; ++m) _Pragma("unroll") for (int k = 0; k < 2; ++k) dst[m][k] = *(const PG8_LAS bf16x8*)(lds + PG8_SA(b, h) + aoff + m * 2048 + k * 1024); } } while (0)
#define PG8_LDB(dst, b, h) do { if constexpr (FP8) { _Pragma("unroll") for (int n = 0; n < 2; ++n) dst##8[n] = PG8_CAT(*(const PG8_LAS bf16x8*)(lds + PG8_SB(b, h) + boff + n * 2048), *(const PG8_LAS bf16x8*)(lds + PG8_SB(b, h) + boff + n * 2048 + 1024)); } else { \
        _Pragma("unroll") for (int n = 0; n < 2; ++n) _Pragma("unroll") for (int k = 0; k < 2; ++k) dst[n][k] = *(const PG8_LAS bf16x8*)(lds + PG8_SB(b, h) + boff + n * 2048 + k * 1024); } } while (0)
#define PG8_MMA(ai, bj, At, Bt) do { __builtin_amdgcn_s_setprio(1); if constexpr (FP8) { _Pragma("unroll") for (int m = 0; m < 4; ++m) _Pragma("unroll") for (int n = 0; n < 2; ++n) \
        asm volatile("v_mfma_f32_16x16x128_f8f6f4 %0, %1, %2, %0" : "+v"(acc[ai][bj][m][n]) : "v"(Bt##8[n]), "v"(At##8[m]));   } else { \
        _Pragma("unroll") for (int m = 0; m < 4; ++m) _Pragma("unroll") for (int n = 0; n < 2; ++n) _Pragma("unroll") for (int k = 0; k < 2; ++k) \
        acc[ai][bj][m][n] = __builtin_amdgcn_mfma_f32_16x16x32_bf16(Bt[n][k], At[m][k], acc[ai][bj][m][n], 0, 0, 0); } __builtin_amdgcn_s_setprio(0); } while (0)
#define PG8_WAIT_V(n) asm volatile("s_waitcnt vmcnt(" #n ")" ::: "memory")
#define PG8_WAIT_L(n) asm volatile("s_waitcnt lgkmcnt(" #n ")" ::: "memory")
#define PG8_BAR __builtin_amdgcn_s_barrier()
#define PG8_SCHED __builtin_amdgcn_sched_barrier(0)
    Unit cur, nxt; int ui = 0;
    if (!S.next(0, cur)) return;
    f32x4 acc[2][2][4][2];
#pragma unroll
    for (int a = 0; a < 2; ++a)
#pragma unroll
        for (int b = 0; b < 2; ++b)
#pragma unroll
            for (int m = 0; m < 4; ++m)
#pragma unroll
                for (int n = 0; n < 2; ++n) acc[a][b][m][n] = (f32x4){0.f, 0.f, 0.f, 0.f};
    bf16x8 At[4][2], B0[2][2], B1[2][2]; i32x8 At8[4], B08[2], B18[2];
    const char* cA = (const char*)g.A + (size_t)cur.pa * tstep; const char* cB = (const char*)g.Bt + (size_t)cur.pn * tstep;
    S.a_ready(cur);
    if constexpr (SP2) {
        PG8_STAGE(PG8_SB(0, 0), cB, voffB); PG8_STAGE(PG8_SB(0, 1), cB + hstep, voffB); PG8_STAGE(PG8_SA(0, 0), cA, voffA); PG8_STAGE(PG8_SA(0, 1), cA + hstep, voffA);
        if (wr == 1) PG8_BAR;
        PG8_WAIT_V(2); PG8_BAR;
        PG8_STAGE(PG8_SB(1, 0), cB + kstep, voffB); PG8_STAGE(PG8_SA(1, 0), cA + kstep, voffA); PG8_STAGE(PG8_SB(1, 1), cB + hstep + kstep, voffB);
        PG8_WAIT_V(6); PG8_BAR;
    } else {
        PG8_STAGE(PG8_SB(0, 0), cB, voffB); PG8_STAGE(PG8_SA(0, 0), cA, voffA); PG8_STAGE(PG8_SB(0, 1), cB + hstep, voffB); PG8_STAGE(PG8_SA(0, 1), cA + hstep, voffA);
        if (wr == 1) PG8_BAR;
        PG8_WAIT_V(4); PG8_BAR;
        PG8_STAGE(PG8_SB(1, 0), cB + kstep, voffB); PG8_STAGE(PG8_SA(1, 0), cA + kstep, voffA); PG8_STAGE(PG8_SB(1, 1), cB + hstep + kstep, voffB);
        PG8_WAIT_V(6); PG8_BAR;
    }
    for (;;) {
        const bool has_next = S.next(ui + 1, nxt);
        const char* nA = has_next ? (const char*)g.A + (size_t)nxt.pa * tstep : cA; const char* nB = has_next ? (const char*)g.Bt + (size_t)nxt.pn * tstep : cB;
#pragma unroll 1
        for (int t = 0; t < nt; t += 2) {
            const bool last = (t == nt - 2);
            const char* a1 = cA + (size_t)(t + 1) * kstep;
            const char* a2 = last ? nA : cA + (size_t)(t + 2) * kstep; const char* b2 = last ? nB : cB + (size_t)(t + 2) * kstep;
            const char* a3 = a2 + kstep; const char* b3 = b2 + kstep;
            if (last && has_next) S.a_ready(nxt);
            if constexpr (SP2) {
            PG8_LDB(B0, 0, 0); PG8_LDB(B1, 0, 1); PG8_SCHED; PG8_LDA(At, 0, 0); PG8_STAGE(PG8_SA(1, 1), a1 + hstep, voffA);
            PG8_WAIT_V(8); PG8_WAIT_L(0); PG8_BAR; PG8_MMA(0, 0, At, B0); PG8_MMA(0, 1, At, B1); PG8_BAR; PG8_SCHED;
            PG8_LDA(At, 0, 1); PG8_STAGE(PG8_SB(0, 0), b2, voffB); PG8_STAGE(PG8_SB(0, 1), b2 + hstep, voffB); PG8_STAGE(PG8_SA(0, 0), a2, voffA);
            PG8_WAIT_V(8); PG8_WAIT_L(0); PG8_BAR; PG8_MMA(1, 0, At, B0); PG8_MMA(1, 1, At, B1); PG8_BAR; PG8_SCHED;
            PG8_LDB(B0, 1, 0); PG8_LDB(B1, 1, 1); PG8_SCHED; PG8_LDA(At, 1, 0); PG8_STAGE(PG8_SA(0, 1), a2 + hstep, voffA);
            PG8_WAIT_V(8); PG8_WAIT_L(0); PG8_BAR; PG8_MMA(0, 0, At, B0); PG8_MMA(0, 1, At, B1); PG8_BAR; PG8_SCHED;
            PG8_LDA(At, 1, 1); PG8_STAGE(PG8_SB(1, 0), b3, voffB); PG8_STAGE(PG8_SB(1, 1), b3 + hstep, voffB); PG8_STAGE(PG8_SA(1, 0), a3, voffA);
            PG8_WAIT_V(8); PG8_WAIT_L(0); PG8_BAR; PG8_MMA(1, 0, At, B0); PG8_MMA(1, 1, At, B1); PG8_BAR; PG8_SCHED;
            } else {
            PG8_LDB(B0, 0, 0); PG8_SCHED; PG8_LDA(At, 0, 0); PG8_STAGE(PG8_SA(1, 1), a1 + hstep, voffA);
            PG8_WAIT_L(8); PG8_BAR; PG8_WAIT_L(0); PG8_MMA(0, 0, At, B0); PG8_BAR; PG8_SCHED;
            PG8_LDB(B1, 0, 1); PG8_STAGE(PG8_SB(0, 0), b2, voffB);
            PG8_BAR; PG8_WAIT_L(0); PG8_MMA(0, 1, At, B1); PG8_BAR;
            PG8_LDA(At, 0, 1); PG8_STAGE(PG8_SA(0, 0), a2, voffA);
            PG8_BAR; PG8_WAIT_L(0); PG8_MMA(1, 0, At, B0); PG8_BAR; PG8_SCHED;
            PG8_STAGE(PG8_SB(0, 1), b2 + hstep, voffB);
            PG8_WAIT_V(6); PG8_BAR; PG8_MMA(1, 1, At, B1); PG8_BAR;
            PG8_LDB(B0, 1, 0); PG8_SCHED; PG8_LDA(At, 1, 0); PG8_STAGE(PG8_SA(0, 1), a2 + hstep, voffA);
            PG8_WAIT_L(8); PG8_BAR; PG8_WAIT_L(0); PG8_MMA(0, 0, At, B0); PG8_BAR; PG8_SCHED;
            PG8_LDB(B1, 1, 1); PG8_STAGE(PG8_SB(1, 0), b3, voffB);
            PG8_BAR; PG8_WAIT_L(0); PG8_MMA(0, 1, At, B1); PG8_BAR;
            PG8_LDA(At, 1, 1); PG8_STAGE(PG8_SA(1, 0), a3, voffA);
            PG8_BAR; PG8_WAIT_L(0); PG8_MMA(1, 0, At, B0); PG8_BAR; PG8_SCHED;
            PG8_STAGE(PG8_SB(1, 1), b3 + hstep, voffB);
            PG8_WAIT_V(6); PG8_BAR; PG8_MMA(1, 1, At, B1); PG8_BAR;
            }
        }
        if constexpr (FP8) asm volatile("s_nop 15\n\ts_nop 15" ::: "memory");
        if constexpr (ALIGN_EPI) { if (wr == 0) PG8_BAR; }
        if constexpr (!Epi::AFTER_DRAIN) { E(acc, cur, wr, wc, fr, fq); S.done(cur); }
        if (!has_next) break;
#pragma unroll
        for (int a = 0; a < 2; ++a)
#pragma unroll
            for (int b = 0; b < 2; ++b)
#pragma unroll
                for (int m = 0; m < 4; ++m)
#pragma unroll
                    for (int n = 0; n < 2; ++n) acc[a][b][m][n] = (f32x4){0.f, 0.f, 0.f, 0.f};
        cur = nxt; cA = nA; cB = nB; ++ui;
        if constexpr (ALIGN_EPI) { if (wr == 1) PG8_BAR; }
    }
    PG8_WAIT_V(0);
    if constexpr (!ALIGN_EPI) { if (wr == 0) PG8_BAR; }
    PG8_BAR;
    if constexpr (Epi::AFTER_DRAIN) { E.fused(acc, cur, wr, wc, fr, fq, lds, wid, lane); S.done(cur); }
#undef PG8_SA
#undef PG8_SB
#undef PG8_STAGE
#undef PG8_LDA
#undef PG8_LDB
#undef PG8_MMA
#undef PG8_CAT
#undef PG8_WAIT_V
#undef PG8_WAIT_L
#undef PG8_BAR
#undef PG8_SCHED
}
}

#ifndef PG8_SP2
#define PG8_SP2 true
#endif
#ifndef PG8_ALIGN
#define PG8_ALIGN true
#endif
#include <hip/hip_bf16.h>
#include <cmath>
namespace attn_body {
using bf16=__hip_bfloat16;
using bf16x8=__attribute__((ext_vector_type(8)))short;
using s16x4=__attribute__((ext_vector_type(4)))short;
using f32x16=__attribute__((ext_vector_type(16)))float;
using u32x4=__attribute__((ext_vector_type(4)))unsigned;
constexpr int D=64;
constexpr int NW=8,QBLK=32,QB=QBLK*NW,KVBLK=64;
constexpr int ATTN_UNIT_ROWS=QB;
__device__ __forceinline__ int crow(int r,int hi){return (r&3)+8*(r>>2)+4*hi;}
#define SBAR() __builtin_amdgcn_sched_barrier(0)
__device__ __forceinline__ void cmask(f32x16&p0,f32x16&p1,int jb,int qrel,int hi){
  const float NEG=-INFINITY; int kb=64*jb+4*hi;
  #pragma unroll
  for(int r=0;r<16;++r){int kv=kb+(r&3)+8*(r>>2); if(kv>qrel)p0[r]=NEG; if(kv+32>qrel)p1[r]=NEG;}
}

constexpr int NSLOT=3, SLOTB=8192;
constexpr int LDS_K=0, LDS_V=NSLOT*SLOTB, LDS_WS=2*NSLOT*SLOTB, LDS_OST=LDS_WS+NW*64*4, LDS_BYTES=LDS_OST+NW*4096;
constexpr float C2=0.125f*1.4426950408889634f;
__device__ __forceinline__ void glds16s(const void*sbase,unsigned voff,unsigned lds_dst){
  asm volatile("s_mov_b32 m0, %2\n\ts_nop 0\n\tglobal_load_lds_dwordx4 %0, %1"::"v"(voff),"s"(sbase),"s"(lds_dst):"memory","m0");}
__device__ __forceinline__ void glds16(const void*gsrc,unsigned lds_dst){unsigned keep;
  asm volatile("s_mov_b32 %0, m0\n\ts_mov_b32 m0, %2\n\ts_nop 0\n\tglobal_load_lds_dwordx4 %1, off\n\ts_mov_b32 m0, %0":"=&s"(keep):"v"(gsrc),"s"(lds_dst):"memory");}
__device__ __forceinline__ float max3f(float a,float b,float c){float r;asm("v_max3_f32 %0, %1, %2, %3":"=v"(r):"v"(a),"v"(b),"v"(c));return r;}
__device__ __forceinline__ float max2f(float a,float b){float r;asm("v_max_f32_e32 %0, %1, %2":"=v"(r):"v"(a),"v"(b));return r;}
__device__ __forceinline__ float fadd_s(float a,float b){float r;asm("v_add_f32_e32 %0, %1, %2":"=v"(r):"v"(a),"v"(b));return r;}
__device__ __forceinline__ float fsub_s(float a,float b){float r;asm("v_sub_f32_e32 %0, %1, %2":"=v"(r):"v"(a),"v"(b));return r;}
typedef float f32x2_t __attribute__((ext_vector_type(2))); typedef __bf16 bf16x2_t __attribute__((ext_vector_type(2)));
__device__ __forceinline__ unsigned cvtpk_s(float lo,float hi){f32x2_t v={lo,hi};bf16x2_t b=__builtin_convertvector(v,bf16x2_t);return __builtin_bit_cast(unsigned,b);}
#define WAIT_BAR(N) asm volatile("s_waitcnt vmcnt(" #N ") lgkmcnt(0)\n\ts_barrier":::"memory")

__device__ __forceinline__ void qkt(f32x16&p0,f32x16&p1,const char*Kslot,const bf16x8*qr,const f32x16&negm,int r32,int hi){
  const char*kb=Kslot+hi*1024+r32*16;
  #pragma unroll
  for(int d0=0;d0<4;++d0){
    const bf16x8 b0=*reinterpret_cast<const bf16x8*>(kb+d0*2048);
    const bf16x8 b1=*reinterpret_cast<const bf16x8*>(kb+d0*2048+512);
    if(d0==0){p0=__builtin_amdgcn_mfma_f32_32x32x16_bf16(b0,qr[0],negm,0,0,0);p1=__builtin_amdgcn_mfma_f32_32x32x16_bf16(b1,qr[0],negm,0,0,0);}
    else{p0=__builtin_amdgcn_mfma_f32_32x32x16_bf16(b0,qr[d0],p0,0,0,0);p1=__builtin_amdgcn_mfma_f32_32x32x16_bf16(b1,qr[d0],p1,0,0,0);}}
}
typedef __attribute__((address_space(3))) const char* lds_cptr;
typedef short v4i16_t __attribute__((ext_vector_type(4)));
__device__ __forceinline__ void kload8(bf16x8*kf,lds_cptr kp){
  kf[0]=*(const __attribute__((address_space(3))) bf16x8*)(kp);      kf[1]=*(const __attribute__((address_space(3))) bf16x8*)(kp+512);
  kf[2]=*(const __attribute__((address_space(3))) bf16x8*)(kp+2048); kf[3]=*(const __attribute__((address_space(3))) bf16x8*)(kp+2560);
  kf[4]=*(const __attribute__((address_space(3))) bf16x8*)(kp+4096); kf[5]=*(const __attribute__((address_space(3))) bf16x8*)(kp+4608);
  kf[6]=*(const __attribute__((address_space(3))) bf16x8*)(kp+6144); kf[7]=*(const __attribute__((address_space(3))) bf16x8*)(kp+6656);
}
__device__ __forceinline__ void kload2(bf16x8*kf,lds_cptr kp,int j){ kf[2*j]=*(const __attribute__((address_space(3))) bf16x8*)(kp+j*2048); kf[2*j+1]=*(const __attribute__((address_space(3))) bf16x8*)(kp+j*2048+512); }
__device__ __forceinline__ s16x4 vtr(lds_cptr p){ return __builtin_bit_cast(s16x4,__builtin_amdgcn_ds_read_tr16_b64_v4i16((__attribute__((address_space(3))) v4i16_t*)p)); }
__device__ __forceinline__ float rowmax(const f32x16&p0,const f32x16&p1){
  float a=max3f(p0[0],p0[1],p1[0]),b=max3f(p0[2],p0[3],p1[1]);a=max3f(a,p1[2],p1[3]);
  #pragma unroll
  for(int r=4;r<16;r+=4){a=max3f(a,p0[r],p0[r+1]);b=max3f(b,p0[r+2],p0[r+3]);a=max3f(a,p1[r],p1[r+1]);b=max3f(b,p1[r+2],p1[r+3]);}
  const float m=max2f(a,b);
  auto rr=__builtin_amdgcn_permlane32_swap(__float_as_uint(m),__float_as_uint(m),false,false);
  return max2f(__uint_as_float(rr[0]),__uint_as_float(rr[1]));
}
__device__ __forceinline__ void pv(f32x16*o,int vb,bf16x8 pa0,bf16x8 pa1,bf16x8 pa2,bf16x8 pa3){
  #pragma unroll
  for(int d0=0;d0<2;++d0){s16x4 lo[4],hi[4];
    #pragma unroll
    for(int ks=0;ks<4;++ks){
      asm volatile("ds_read_b64_tr_b16 %0,%1 offset:%c2":"=&v"(lo[ks]):"v"(vb),"i"(d0*4096+ks*1024):"memory");
      asm volatile("ds_read_b64_tr_b16 %0,%1 offset:%c2":"=&v"(hi[ks]):"v"(vb),"i"(d0*4096+ks*1024+512):"memory");}
    asm volatile("s_waitcnt lgkmcnt(0)":::"memory");SBAR();
    #define PK(k) (bf16x8){lo[k][0],lo[k][1],lo[k][2],lo[k][3],hi[k][0],hi[k][1],hi[k][2],hi[k][3]}
    o[d0]=__builtin_amdgcn_mfma_f32_32x32x16_bf16(pa0,PK(0),o[d0],0,0,0);
    o[d0]=__builtin_amdgcn_mfma_f32_32x32x16_bf16(pa1,PK(1),o[d0],0,0,0);
    o[d0]=__builtin_amdgcn_mfma_f32_32x32x16_bf16(pa2,PK(2),o[d0],0,0,0);
    o[d0]=__builtin_amdgcn_mfma_f32_32x32x16_bf16(pa3,PK(3),o[d0],0,0,0);
    #undef PK
  }
}

#ifndef ATTN_STORE16
#define ATTN_STORE16(p,v) (*(u32x4*)(p)=(v))
#endif
template<int THRL,bool TILED> __device__ __forceinline__ void attn_unit(const bf16*Qu,int qp,const bf16*__restrict__ Kc,const bf16*__restrict__ Kl,int kp,const bf16*__restrict__ Vc,const bf16*__restrict__ Vl,int vp,bf16*Ou,int op,int NT,int NCT,int rot,char*shm){
  const int tid=threadIdx.x,lane=tid&63,r32=lane&31,hi=lane>>5; const int wid=__builtin_amdgcn_readfirstlane(tid>>6);
  const bf16*Qw=Qu+(long)(wid*QBLK)*qp;
  const unsigned lds0=(unsigned)(uintptr_t)shm;
  float*wsf=(float*)(shm+LDS_WS)+wid*64;
  const long koff=TILED?(long)(wid*512+lane*8):((long)lane*kp+wid*8); const bf16*ksrc_c=Kc+koff; const bf16*ksrc_l=Kl+koff-(long)NCT*KVBLK*kp;
  const long voff=TILED?(long)(wid*512+lane*8):((long)(16*(wid&3)+(lane>>2))*vp+(wid>>2)*32+(lane&3)*8); const bf16*vsrc_c=Vc+voff; const bf16*vsrc_l=Vl+voff-(long)NCT*KVBLK*vp;
  const unsigned kdst=lds0+LDS_K+wid*1024, vdst=lds0+LDS_V+wid*1024;
  #define ROTT(t) (t)
  const unsigned koffb1=(unsigned)(wid*512+lane*8)*2u;
  #define DMA_K(t,slot) do{ if constexpr(TILED) glds16s(Kc+(long)ROTT(t)*4096,koffb1,(unsigned)__builtin_amdgcn_readfirstlane(kdst+(slot))); else glds16((ROTT(t)<NCT?ksrc_c:ksrc_l)+(long)ROTT(t)*KVBLK*kp,(unsigned)__builtin_amdgcn_readfirstlane(kdst+(slot))); }while(0)
  #define DMA_V(t,slot) do{ if constexpr(TILED) glds16s(Vc+(long)ROTT(t)*4096,koffb1,(unsigned)__builtin_amdgcn_readfirstlane(vdst+(slot))); else glds16((ROTT(t)<NCT?vsrc_c:vsrc_l)+(long)ROTT(t)*KVBLK*vp,(unsigned)__builtin_amdgcn_readfirstlane(vdst+(slot))); }while(0)
  const int vb0=(int)(lds0+LDS_V)+((lane>>4)&1)*32+(lane&3)*8+(4*hi+((lane&15)>>2))*64;
  const char*Kbase=shm+LDS_K; bf16x8 kf[8];
  const lds_cptr shm3=(lds_cptr)shm; const lds_cptr kp0=shm3+LDS_K+hi*1024+r32*16; const lds_cptr vp0=shm3+LDS_V+((lane>>4)&1)*32+(lane&3)*8+(4*hi+((lane&15)>>2))*64;
  DMA_K(0,0);DMA_V(0,0);DMA_K(1,SLOTB);
  bf16x8 qr[4];
  #pragma unroll
  for(int d0=0;d0<4;++d0)qr[d0]=*reinterpret_cast<const bf16x8*>(&Qw[(long)r32*qp+d0*16+hi*8]);
  float mhat=0.f,l_reg=0.f;f32x16 o[2];o[0]=f32x16{};o[1]=f32x16{};f32x16 negm=f32x16{};if constexpr(THRL>=0)asm volatile("":"+v"(negm));
  #define CMASK(P0,P1,t) do{}while(0)
  bool resc=false;
  #define START(P0,P1) do{ resc=false; if constexpr(THRL>=0) \
    { const float rm=rowmax(P0,P1); const float dl=rm; mhat=fadd_s(mhat,dl); \
      _Pragma("unroll") for(int r=0;r<16;++r){P0[r]=fsub_s(P0[r],dl);P1[r]=fsub_s(P1[r],dl);} \
      _Pragma("unroll") for(int r=0;r<16;++r)negm[r]=-mhat; asm volatile("":"+v"(negm)); } \
    _Pragma("unroll") for(int r=0;r<16;++r)P0[r]=__builtin_amdgcn_exp2f(P0[r]); }while(0)
  #define RESC() do{ if constexpr(THRL>=0) if(resc){ asm volatile("s_waitcnt lgkmcnt(0)":::"memory"); \
      _Pragma("unroll") for(int d_=0;d_<2;++d_) _Pragma("unroll") for(int r=0;r<16;++r)o[d_][r]*=wsf[crow(r,hi)]; } }while(0)
  f32x16 pA0,pA1,pB0,pB1;
  int sl_prev=0,sl_cur=0,sl_next=SLOTB;
  #define ROT() do{sl_prev=sl_cur;sl_cur=sl_next;sl_next=(sl_next==(NSLOT-1)*SLOTB)?0:sl_next+SLOTB;}while(0)
  DMA_K(2,2*SLOTB);
  WAIT_BAR(3);
  qkt(pA0,pA1,Kbase,qr,negm,r32,hi);asm volatile("s_nop 15\n\ts_nop 7":"+v"(pA0),"+v"(pA1));CMASK(pA0,pA1,0);
  START(pA0,pA1);
  _Pragma("unroll") for(int r=0;r<16;++r)pA1[r]=__builtin_amdgcn_exp2f(pA1[r]);
  WAIT_BAR(0);
  DMA_K(3,0);DMA_V(1,SLOTB);
  ROT();
  kload8(kf,kp0+sl_cur);
  WAIT_BAR(2);
  s16x4 vlo[8],vhi[8]; u32x4 pw0,pw1,pw2,pw3;
  #define PKW(P,B) cvtpk_s(P[B],P[B+1])
  #define PAF(k) __builtin_bit_cast(bf16x8,pw##k)
  #define VFR(i) (bf16x8){vlo[i][0],vlo[i][1],vlo[i][2],vlo[i][3],vhi[i][0],vhi[i][1],vhi[i][2],vhi[i][3]}
  #define PIN(x) asm volatile("":"+v"(x))
  #define MX3(a,b,c) __builtin_fmaxf(__builtin_fmaxf((a),(b)),(c))
  #define GAPA(MF,A0,A1,A2,A3,W0,W1,PW) do{ MF; sacc+=A0; sacc+=A1; sacc+=A2; sacc+=A3; PIN(sacc); W0; W1; PIN(PW); SBAR(); }while(0)
  #define EX(v) __builtin_amdgcn_exp2f(v)
  #define GAPB(MF,X,B) do{ MF; X[B]=EX(X[B]); X[B+1]=EX(X[B+1]); X[B+2]=EX(X[B+2]); X[B+3]=EX(X[B+3]); PIN(X); SBAR(); }while(0)
  #define VRD(i) do{ vlo[i]=vtr(vp_+(((i)>>2)*4096+((i)&3)*1024)); vhi[i]=vtr(vp_+(((i)>>2)*4096+((i)&3)*1024+512)); }while(0)
  #define KRD(G,j) do{ if(G){ kload2(kf,kp0+sl_next,j); SBAR(); } }while(0)
  #define STEP(C0,C1,P0,P1,t,GK,GV,GL) do{ SBAR(); \
    const lds_cptr vp_=vp0+sl_prev; \
    VRD(0); SBAR(); float sacc=(P0[0]+P0[1]); \
    GAPA(C0=__builtin_amdgcn_mfma_f32_32x32x16_bf16(kf[0],qr[0],negm,0,0,0), P0[2],P0[3],P0[4],P0[5],     pw0[0]=PKW(P0,0), pw0[1]=PKW(P0,2), pw0); \
    VRD(4); SBAR(); GAPA(C1=__builtin_amdgcn_mfma_f32_32x32x16_bf16(kf[1],qr[0],negm,0,0,0), P0[6],P0[7],P0[8],P0[9],     pw0[2]=PKW(P0,4), pw0[3]=PKW(P0,6), pw0); \
    VRD(1); SBAR(); GAPA(C0=__builtin_amdgcn_mfma_f32_32x32x16_bf16(kf[2],qr[1],C0,0,0,0),   P0[10],P0[11],P0[12],P0[13], pw1[0]=PKW(P0,8), pw1[1]=PKW(P0,10), pw1); \
    VRD(5); SBAR(); GAPA(C1=__builtin_amdgcn_mfma_f32_32x32x16_bf16(kf[3],qr[1],C1,0,0,0),   P0[14],P0[15],P1[0],P1[1],   pw1[2]=PKW(P0,12),pw1[3]=PKW(P0,14), pw1); \
    VRD(2); SBAR(); GAPA(C0=__builtin_amdgcn_mfma_f32_32x32x16_bf16(kf[4],qr[2],C0,0,0,0),   P1[2],P1[3],P1[4],P1[5],     pw2[0]=PKW(P1,0), pw2[1]=PKW(P1,2), pw2); \
    VRD(6); SBAR(); GAPA(C1=__builtin_amdgcn_mfma_f32_32x32x16_bf16(kf[5],qr[2],C1,0,0,0),   P1[6],P1[7],P1[8],P1[9],     pw2[2]=PKW(P1,4), pw2[3]=PKW(P1,6), pw2); \
    VRD(3); SBAR(); GAPA(C0=__builtin_amdgcn_mfma_f32_32x32x16_bf16(kf[6],qr[3],C0,0,0,0),   P1[10],P1[11],P1[12],P1[13], pw3[0]=PKW(P1,8), pw3[1]=PKW(P1,10), pw3); \
    VRD(7); SBAR(); GAPA(C1=__builtin_amdgcn_mfma_f32_32x32x16_bf16(kf[7],qr[3],C1,0,0,0),   P1[14],P1[15],0.f,0.f,       pw3[2]=PKW(P1,12),pw3[3]=PKW(P1,14), pw3); \
    l_reg+=sacc; \
    if(GK){DMA_K((t)+3,sl_cur);} if(GV){DMA_V((t)+1,sl_next);} \
    CMASK(C0,C1,t); \
    if constexpr(THRL>=0){ float a=MX3(C0[0],C0[1],C1[0]),b=MX3(C0[2],C0[3],C1[1]); a=MX3(a,C1[2],C1[3]); \
      _Pragma("unroll") for(int r=4;r<16;r+=4){a=MX3(a,C0[r],C0[r+1]);b=MX3(b,C0[r+2],C0[r+3]);a=MX3(a,C1[r],C1[r+1]);b=MX3(b,C1[r+2],C1[r+3]);} \
      float rm=__builtin_fmaxf(a,b); { auto rr=__builtin_amdgcn_permlane32_swap(__float_as_uint(rm),__float_as_uint(rm),false,false); rm=__builtin_fmaxf(__uint_as_float(rr[0]),__uint_as_float(rr[1])); } \
      resc=false; \
      if(__builtin_expect(__any(rm>(float)THRL),0)){ const float dl=__builtin_fmaxf(rm,0.f); mhat+=dl; \
        _Pragma("unroll") for(int r=0;r<16;++r){C0[r]-=dl;C1[r]-=dl;} \
        _Pragma("unroll") for(int r=0;r<16;++r)negm[r]=-mhat; asm volatile("":"+v"(negm)); \
        const float f=__builtin_amdgcn_exp2f(-dl); l_reg*=f; if(hi==0)wsf[r32]=f; resc=true; } } \
    SBAR(); \
    GAPB(o[0]=__builtin_amdgcn_mfma_f32_32x32x16_bf16(PAF(0),VFR(0),o[0],0,0,0), C0,0); \
    GAPB(o[1]=__builtin_amdgcn_mfma_f32_32x32x16_bf16(PAF(0),VFR(4),o[1],0,0,0), C0,4); \
    KRD(GL,0); GAPB(o[0]=__builtin_amdgcn_mfma_f32_32x32x16_bf16(PAF(1),VFR(1),o[0],0,0,0), C0,8); \
    KRD(GL,1); GAPB(o[1]=__builtin_amdgcn_mfma_f32_32x32x16_bf16(PAF(1),VFR(5),o[1],0,0,0), C0,12); \
    KRD(GL,2); GAPB(o[0]=__builtin_amdgcn_mfma_f32_32x32x16_bf16(PAF(2),VFR(2),o[0],0,0,0), C1,0); \
    KRD(GL,3); GAPB(o[1]=__builtin_amdgcn_mfma_f32_32x32x16_bf16(PAF(2),VFR(6),o[1],0,0,0), C1,4); \
    GAPB(o[0]=__builtin_amdgcn_mfma_f32_32x32x16_bf16(PAF(3),VFR(3),o[0],0,0,0), C1,8); \
    GAPB(o[1]=__builtin_amdgcn_mfma_f32_32x32x16_bf16(PAF(3),VFR(7),o[1],0,0,0), C1,12); \
    }while(0)
  int t=1;
  #undef CMASK
  #define CMASK(P0,P1,t) do{}while(0)
  for(;t+5<NT;t+=2){
    STEP(pB0,pB1,pA0,pA1,t,true,true,true);     WAIT_BAR(2); RESC(); ROT();
    STEP(pA0,pA1,pB0,pB1,t+1,true,true,true);   WAIT_BAR(2); RESC(); ROT();
  }
  #undef CMASK
  #define CMASK(P0,P1,t) do{}while(0)
  #define ENDW(tt) do{ if((tt)+3<NT){WAIT_BAR(2);} else if((tt)+2<NT){WAIT_BAR(1);} else {WAIT_BAR(0);} }while(0)
  for(;t+1<NT;t+=2){
    STEP(pB0,pB1,pA0,pA1,t,(t+3<NT),(t+1<NT),(t+1<NT));       ENDW(t);   RESC(); ROT();
    STEP(pA0,pA1,pB0,pB1,t+1,(t+4<NT),(t+2<NT),(t+2<NT));     ENDW(t+1); RESC(); ROT();
  }
  STEP(pB0,pB1,pA0,pA1,NT-1,false,false,false); RESC();
  { float sacc=pB0[0]+pB0[1]; _Pragma("unroll") for(int r=2;r<16;++r)sacc+=pB0[r]; _Pragma("unroll") for(int r=0;r<16;++r)sacc+=pB1[r]; l_reg+=sacc;
    pw0=(u32x4){PKW(pB0,0),PKW(pB0,2),PKW(pB0,4),PKW(pB0,6)};pw1=(u32x4){PKW(pB0,8),PKW(pB0,10),PKW(pB0,12),PKW(pB0,14)};pw2=(u32x4){PKW(pB1,0),PKW(pB1,2),PKW(pB1,4),PKW(pB1,6)};pw3=(u32x4){PKW(pB1,8),PKW(pB1,10),PKW(pB1,12),PKW(pB1,14)};
    SBAR(); pv(o,vb0+sl_cur,PAF(0),PAF(1),PAF(2),PAF(3)); }
  #undef PKW
  #undef PAF
  #undef VFR
  #undef PIN
  #undef MX3
  #undef GAPA
  #undef GAPB
  #undef EX
  #undef VRD
  #undef KRD
  #undef STEP
  #undef ENDW
  {auto rr=__builtin_amdgcn_permlane32_swap(__float_as_uint(l_reg),__float_as_uint(l_reg),false,false);l_reg=__uint_as_float(rr[0])+__uint_as_float(rr[1]);}
  if(hi==0)wsf[32+r32]=l_reg;asm volatile("s_waitcnt lgkmcnt(0)":::"memory");
  float rli[16];
  #pragma unroll
  for(int r=0;r<16;++r)rli[r]=__builtin_amdgcn_rcpf(wsf[32+crow(r,hi)]);
  bf16*Ow=Ou+(long)(wid*QBLK)*op;
  { bf16*stg=(bf16*)(shm+LDS_OST)+wid*2048;
    #pragma unroll
    for(int r=0;r<16;++r){const int orow=crow(r,hi);
      #pragma unroll
      for(int d0=0;d0<2;++d0)stg[orow*64+d0*32+r32]=__float2bfloat16(o[d0][r]*rli[r]);}
    asm volatile("s_waitcnt lgkmcnt(0)":::"memory");
    #pragma unroll
    for(int i=0;i<4;++i){const int row=i*8+(lane>>3),ch=lane&7; const u32x4 v=*(const u32x4*)(stg+row*64+ch*8); ATTN_STORE16(Ow+(long)row*op+ch*8,v);} }
  asm volatile("s_waitcnt lgkmcnt(0)\n\ts_barrier":::"memory");
  #undef DMA_K
  #undef ROTT
  #undef DMA_V
  #undef CMASK
  #undef START
  #undef RESC
  #undef ROT
}
constexpr int LDS2_V=NSLOT*SLOTB, LDS2_WS=LDS2_V+NSLOT*2*SLOTB, LDS2_OST=LDS2_WS+NW*64*4, LDS2_BYTES=LDS2_OST+NW*4096;
template<int THRL> __device__ __forceinline__ void attn_unit2(const bf16*Qu,int qp,const bf16*__restrict__ Ks,const bf16*__restrict__ Va,const bf16*__restrict__ Vb,bf16*Ou,int op,int NT,int rot,char*shm,bool FUSE,const bf16*O1,int o1p,float lam,const float*subg,float oscale){
  const int tid=threadIdx.x,lane=tid&63,r32=lane&31,hi=lane>>5; const int wid=__builtin_amdgcn_readfirstlane(tid>>6);
  const bf16*Qw=Qu+(long)(wid*QBLK)*qp;
  const unsigned lds0=(unsigned)(uintptr_t)shm;
  float*wsf=(float*)(shm+LDS2_WS)+wid*64;
  const unsigned koffb=(unsigned)(wid*512+lane*8)*2u;
  const unsigned kdst=lds0+LDS_K+wid*1024, vdst=lds0+LDS2_V+wid*1024;
  #define ROTT(t) (t)
  #define DMA_K(t,slot) glds16s(Ks+(long)ROTT(t)*4096,koffb,(unsigned)__builtin_amdgcn_readfirstlane(kdst+(slot)))
  #define DMA_V(t,slot) do{ glds16s(Va+(long)ROTT(t)*4096,koffb,(unsigned)__builtin_amdgcn_readfirstlane(vdst+2*(slot))); glds16s(Vb+(long)ROTT(t)*4096,koffb,(unsigned)__builtin_amdgcn_readfirstlane(vdst+2*(slot)+8192)); }while(0)
  const int vb0=(int)(lds0+LDS2_V)+((lane>>4)&1)*32+(lane&3)*8+(4*hi+((lane&15)>>2))*64;
  const char*Kbase=shm+LDS_K; bf16x8 kf[8];
  const lds_cptr shm3=(lds_cptr)shm; const lds_cptr kp0=shm3+LDS_K+hi*1024+r32*16; const lds_cptr vp0=shm3+LDS2_V+((lane>>4)&1)*32+(lane&3)*8+(4*hi+((lane&15)>>2))*64;
  DMA_K(0,0);DMA_V(0,0);DMA_K(1,SLOTB);
  bf16x8 qr[4];
  #pragma unroll
  for(int d0=0;d0<4;++d0)qr[d0]=*reinterpret_cast<const bf16x8*>(&Qw[(long)r32*qp+d0*16+hi*8]);
  float mhat=0.f,l_reg=0.f;f32x16 o[4];o[0]=f32x16{};o[1]=f32x16{};o[2]=f32x16{};o[3]=f32x16{};const f32x16 zero16=f32x16{};
  #define CMASK(P0,P1,t) do{}while(0)
  bool resc=false;
  #define SUBM(x) (THRL>=0?(x)-mhat:(x))
  #define START(P0,P1) do{ resc=false; if constexpr(THRL>=0){ mhat=rowmax(P0,P1); } \
    _Pragma("unroll") for(int r=0;r<16;++r)P0[r]=__builtin_amdgcn_exp2f(SUBM(P0[r])); }while(0)
  #define RESC() do{ if constexpr(THRL>=0) if(resc){ asm volatile("s_waitcnt lgkmcnt(0)":::"memory"); \
      _Pragma("unroll") for(int d_=0;d_<4;++d_) _Pragma("unroll") for(int r=0;r<16;++r)o[d_][r]*=wsf[crow(r,hi)]; } }while(0)
  f32x16 pA0,pA1,pB0,pB1;
  int sl_prev=0,sl_cur=0,sl_next=SLOTB;
  #define ROT() do{sl_prev=sl_cur;sl_cur=sl_next;sl_next=(sl_next==(NSLOT-1)*SLOTB)?0:sl_next+SLOTB;}while(0)
  DMA_K(2,2*SLOTB);
  WAIT_BAR(4);
  qkt(pA0,pA1,Kbase,qr,zero16,r32,hi);asm volatile("s_nop 15\n\ts_nop 7":"+v"(pA0),"+v"(pA1));CMASK(pA0,pA1,0);
  START(pA0,pA1);
  _Pragma("unroll") for(int r=0;r<16;++r)pA1[r]=__builtin_amdgcn_exp2f(SUBM(pA1[r]));
  WAIT_BAR(0);
  DMA_K(3,0);DMA_V(1,SLOTB);
  ROT();
  kload8(kf,kp0+sl_cur);
  WAIT_BAR(3);
  s16x4 vlo[8],vhi[8]; u32x4 pw0,pw1,pw2,pw3;
  #define PKW(P,B) cvtpk_s(P[B],P[B+1])
  #define PAF(k) __builtin_bit_cast(bf16x8,pw##k)
  #define VFR(i) (bf16x8){vlo[i][0],vlo[i][1],vlo[i][2],vlo[i][3],vhi[i][0],vhi[i][1],vhi[i][2],vhi[i][3]}
  #define PIN(x) asm volatile("":"+v"(x))
  #define MX3(a,b,c) __builtin_fmaxf(__builtin_fmaxf((a),(b)),(c))
  #define GAPA(MF,A0,A1,A2,A3,W0,W1,PW) do{ MF; sacc+=A0; sacc+=A1; sacc+=A2; sacc+=A3; PIN(sacc); W0; W1; PIN(PW); SBAR(); }while(0)
  #define EX(v) __builtin_amdgcn_exp2f(v)
  #define GAPB(MF,X,B) do{ MF; X[B]=EX(SUBM(X[B])); X[B+1]=EX(SUBM(X[B+1])); PIN(X); SBAR(); }while(0)
  #define VRD(i) do{ vlo[i]=vtr(vp_+(((i)>>2)*4096+((i)&3)*1024)); vhi[i]=vtr(vp_+(((i)>>2)*4096+((i)&3)*1024+512)); }while(0)
  #define VRD2(i) do{ vlo[i]=vtr(vp_+(8192+((i)>>2)*4096+((i)&3)*1024)); vhi[i]=vtr(vp_+(8192+((i)>>2)*4096+((i)&3)*1024+512)); SBAR(); }while(0)
  #define KRD(G,j) do{ if(G){ kload2(kf,kp0+sl_next,j); SBAR(); } }while(0)
  #define STEP(C0,C1,P0,P1,t,GK,GV,GL) do{ SBAR(); \
    const lds_cptr vp_=vp0+2*sl_prev; \
    VRD(0); SBAR(); float sacc=(P0[0]+P0[1]); \
    GAPA(C0=__builtin_amdgcn_mfma_f32_32x32x16_bf16(kf[0],qr[0],zero16,0,0,0), P0[2],P0[3],P0[4],P0[5],     pw0[0]=PKW(P0,0), pw0[1]=PKW(P0,2), pw0); \
    VRD(4); SBAR(); GAPA(C1=__builtin_amdgcn_mfma_f32_32x32x16_bf16(kf[1],qr[0],zero16,0,0,0), P0[6],P0[7],P0[8],P0[9],     pw0[2]=PKW(P0,4), pw0[3]=PKW(P0,6), pw0); \
    VRD(1); SBAR(); GAPA(C0=__builtin_amdgcn_mfma_f32_32x32x16_bf16(kf[2],qr[1],C0,0,0,0),   P0[10],P0[11],P0[12],P0[13], pw1[0]=PKW(P0,8), pw1[1]=PKW(P0,10), pw1); \
    VRD(5); SBAR(); GAPA(C1=__builtin_amdgcn_mfma_f32_32x32x16_bf16(kf[3],qr[1],C1,0,0,0),   P0[14],P0[15],P1[0],P1[1],   pw1[2]=PKW(P0,12),pw1[3]=PKW(P0,14), pw1); \
    VRD(2); SBAR(); GAPA(C0=__builtin_amdgcn_mfma_f32_32x32x16_bf16(kf[4],qr[2],C0,0,0,0),   P1[2],P1[3],P1[4],P1[5],     pw2[0]=PKW(P1,0), pw2[1]=PKW(P1,2), pw2); \
    VRD(6); SBAR(); GAPA(C1=__builtin_amdgcn_mfma_f32_32x32x16_bf16(kf[5],qr[2],C1,0,0,0),   P1[6],P1[7],P1[8],P1[9],     pw2[2]=PKW(P1,4), pw2[3]=PKW(P1,6), pw2); \
    VRD(3); SBAR(); GAPA(C0=__builtin_amdgcn_mfma_f32_32x32x16_bf16(kf[6],qr[3],C0,0,0,0),   P1[10],P1[11],P1[12],P1[13], pw3[0]=PKW(P1,8), pw3[1]=PKW(P1,10), pw3); \
    VRD(7); SBAR(); GAPA(C1=__builtin_amdgcn_mfma_f32_32x32x16_bf16(kf[7],qr[3],C1,0,0,0),   P1[14],P1[15],0.f,0.f,       pw3[2]=PKW(P1,12),pw3[3]=PKW(P1,14), pw3); \
    l_reg+=sacc; \
    if(GK){DMA_K((t)+3,sl_cur);} if(GV){DMA_V((t)+1,sl_next);} \
    CMASK(C0,C1,t); \
    if constexpr(THRL>=0){ float a=MX3(C0[0],C0[1],C1[0]),b=MX3(C0[2],C0[3],C1[1]); a=MX3(a,C1[2],C1[3]); \
      _Pragma("unroll") for(int r=4;r<16;r+=4){a=MX3(a,C0[r],C0[r+1]);b=MX3(b,C0[r+2],C0[r+3]);a=MX3(a,C1[r],C1[r+1]);b=MX3(b,C1[r+2],C1[r+3]);} \
      float rm=__builtin_fmaxf(a,b); { auto rr=__builtin_amdgcn_permlane32_swap(__float_as_uint(rm),__float_as_uint(rm),false,false); rm=__builtin_fmaxf(__uint_as_float(rr[0]),__uint_as_float(rr[1])); } \
      resc=false; \
      rm-=mhat; \
      if(__builtin_expect(__any(rm>(float)THRL),0)){ const float dl=__builtin_fmaxf(rm,0.f); mhat+=dl; \
        const float f=__builtin_amdgcn_exp2f(-dl); l_reg*=f; if(hi==0)wsf[r32]=f; resc=true; } } \
    SBAR(); \
    GAPB(o[0]=__builtin_amdgcn_mfma_f32_32x32x16_bf16(PAF(0),VFR(0),o[0],0,0,0), C0,0); VRD2(0); \
    GAPB(o[1]=__builtin_amdgcn_mfma_f32_32x32x16_bf16(PAF(0),VFR(4),o[1],0,0,0), C0,2); VRD2(4); \
    KRD(GL,0); GAPB(o[0]=__builtin_amdgcn_mfma_f32_32x32x16_bf16(PAF(1),VFR(1),o[0],0,0,0), C0,4); VRD2(1); \
    KRD(GL,1); GAPB(o[1]=__builtin_amdgcn_mfma_f32_32x32x16_bf16(PAF(1),VFR(5),o[1],0,0,0), C0,6); VRD2(5); \
    KRD(GL,2); GAPB(o[0]=__builtin_amdgcn_mfma_f32_32x32x16_bf16(PAF(2),VFR(2),o[0],0,0,0), C0,8); VRD2(2); \
    KRD(GL,3); GAPB(o[1]=__builtin_amdgcn_mfma_f32_32x32x16_bf16(PAF(2),VFR(6),o[1],0,0,0), C0,10); VRD2(6); \
    GAPB(o[0]=__builtin_amdgcn_mfma_f32_32x32x16_bf16(PAF(3),VFR(3),o[0],0,0,0), C0,12); VRD2(3); \
    GAPB(o[1]=__builtin_amdgcn_mfma_f32_32x32x16_bf16(PAF(3),VFR(7),o[1],0,0,0), C0,14); VRD2(7); \
    GAPB(o[2]=__builtin_amdgcn_mfma_f32_32x32x16_bf16(PAF(0),VFR(0),o[2],0,0,0), C1,0); \
    GAPB(o[3]=__builtin_amdgcn_mfma_f32_32x32x16_bf16(PAF(0),VFR(4),o[3],0,0,0), C1,2); \
    GAPB(o[2]=__builtin_amdgcn_mfma_f32_32x32x16_bf16(PAF(1),VFR(1),o[2],0,0,0), C1,4); \
    GAPB(o[3]=__builtin_amdgcn_mfma_f32_32x32x16_bf16(PAF(1),VFR(5),o[3],0,0,0), C1,6); \
    GAPB(o[2]=__builtin_amdgcn_mfma_f32_32x32x16_bf16(PAF(2),VFR(2),o[2],0,0,0), C1,8); \
    GAPB(o[3]=__builtin_amdgcn_mfma_f32_32x32x16_bf16(PAF(2),VFR(6),o[3],0,0,0), C1,10); \
    GAPB(o[2]=__builtin_amdgcn_mfma_f32_32x32x16_bf16(PAF(3),VFR(3),o[2],0,0,0), C1,12); \
    GAPB(o[3]=__builtin_amdgcn_mfma_f32_32x32x16_bf16(PAF(3),VFR(7),o[3],0,0,0), C1,14); \
    }while(0)
  int t=1;
  #undef CMASK
  #define CMASK(P0,P1,t) do{}while(0)
  for(;t+5<NT;t+=2){
    STEP(pB0,pB1,pA0,pA1,t,true,true,true);     WAIT_BAR(3); RESC(); ROT();
    STEP(pA0,pA1,pB0,pB1,t+1,true,true,true);   WAIT_BAR(3); RESC(); ROT();
  }
  #undef CMASK
  #define CMASK(P0,P1,t) do{}while(0)
  #define ENDW(tt) do{ if((tt)+3<NT){WAIT_BAR(3);} else if((tt)+2<NT){WAIT_BAR(2);} else {WAIT_BAR(0);} }while(0)
  for(;t+1<NT;t+=2){
    STEP(pB0,pB1,pA0,pA1,t,(t+3<NT),(t+1<NT),(t+1<NT));       ENDW(t);   RESC(); ROT();
    STEP(pA0,pA1,pB0,pB1,t+1,(t+4<NT),(t+2<NT),(t+2<NT));     ENDW(t+1); RESC(); ROT();
  }
  STEP(pB0,pB1,pA0,pA1,NT-1,false,false,false); RESC();
  { float sacc=pB0[0]+pB0[1]; _Pragma("unroll") for(int r=2;r<16;++r)sacc+=pB0[r]; _Pragma("unroll") for(int r=0;r<16;++r)sacc+=pB1[r]; l_reg+=sacc;
    pw0=(u32x4){PKW(pB0,0),PKW(pB0,2),PKW(pB0,4),PKW(pB0,6)};pw1=(u32x4){PKW(pB0,8),PKW(pB0,10),PKW(pB0,12),PKW(pB0,14)};pw2=(u32x4){PKW(pB1,0),PKW(pB1,2),PKW(pB1,4),PKW(pB1,6)};pw3=(u32x4){PKW(pB1,8),PKW(pB1,10),PKW(pB1,12),PKW(pB1,14)};
    SBAR(); pv(o,vb0+2*sl_cur,PAF(0),PAF(1),PAF(2),PAF(3)); pv(o+2,vb0+2*sl_cur+8192,PAF(0),PAF(1),PAF(2),PAF(3)); }
  #undef PKW
  #undef PAF
  #undef VFR
  #undef PIN
  #undef MX3
  #undef GAPA
  #undef GAPB
  #undef EX
  #undef VRD
  #undef VRD2
  #undef KRD
  #undef STEP
  #undef ENDW
  {auto rr=__builtin_amdgcn_permlane32_swap(__float_as_uint(l_reg),__float_as_uint(l_reg),false,false);l_reg=__uint_as_float(rr[0])+__uint_as_float(rr[1]);}
  if(hi==0)wsf[32+r32]=l_reg;asm volatile("s_waitcnt lgkmcnt(0)":::"memory");
  float rli[16];
  #pragma unroll
  for(int r=0;r<16;++r)rli[r]=__builtin_amdgcn_rcpf(wsf[32+crow(r,hi)]);
  bf16*Ow=Ou+(long)(wid*QBLK)*op;
  { bf16*stg=(bf16*)(shm+LDS2_OST)+wid*2048;
    int lane_e=lane; asm volatile("":"+v"(lane_e));
    if(!FUSE){
    #pragma unroll
    for(int hh=0;hh<2;++hh){
      #pragma unroll
      for(int r=0;r<16;++r){const int orow=crow(r,hi);
        #pragma unroll
        for(int d0=0;d0<2;++d0)stg[orow*64+d0*32+r32]=__float2bfloat16(o[2*hh+d0][r]*rli[r]);}
      asm volatile("s_waitcnt lgkmcnt(0)":::"memory");
      #pragma unroll
      for(int i=0;i<4;++i){const int row=i*8+(lane_e>>3),ch=lane_e&7; const u32x4 v=*(const u32x4*)(stg+row*64+ch*8); ATTN_STORE16(Ow+(long)row*op+hh*64+ch*8,v);}
      asm volatile("s_waitcnt lgkmcnt(0)":::"memory"); }
    } else {
    const bf16*O1w=O1+(long)(wid*QBLK)*o1p; float dd[2][4][8]; float ssq[4]={0.f,0.f,0.f,0.f};
    #pragma unroll
    for(int hh=0;hh<2;++hh){
      #pragma unroll
      for(int r=0;r<16;++r){const int orow=crow(r,hi);
        #pragma unroll
        for(int d0=0;d0<2;++d0)stg[orow*64+d0*32+r32]=__float2bfloat16(o[2*hh+d0][r]*rli[r]);}
      asm volatile("s_waitcnt lgkmcnt(0)":::"memory");
      #pragma unroll
      for(int i=0;i<4;++i){const int row=i*8+(lane_e>>3),ch=lane_e&7; const u32x4 v2=*(const u32x4*)(stg+row*64+ch*8); const u32x4 v1=*(const u32x4*)(O1w+(long)row*o1p+hh*64+ch*8);
        #pragma unroll
        for(int e=0;e<4;++e){ const float a0=__uint_as_float(v1[e]<<16),a1=__uint_as_float(v1[e]&0xffff0000u),b0=__uint_as_float(v2[e]<<16),b1=__uint_as_float(v2[e]&0xffff0000u);
          const float x0=a0-lam*b0,x1=a1-lam*b1; dd[hh][i][2*e]=x0; dd[hh][i][2*e+1]=x1; ssq[i]+=x0*x0+x1*x1; } }
      asm volatile("s_waitcnt lgkmcnt(0)":::"memory"); }
    #pragma unroll
    for(int i=0;i<4;++i){ float t=ssq[i]; t+=__shfl_xor(t,1); t+=__shfl_xor(t,2); t+=__shfl_xor(t,4); const float rs=oscale/sqrtf(t*(1.0f/128.0f)+1e-6f); const int row=i*8+(lane_e>>3),ch=lane_e&7;
      #pragma unroll
      for(int hh=0;hh<2;++hh){ const float*gp=subg+hh*64+ch*8; u32x4 w;
        #pragma unroll
        for(int e=0;e<4;++e)w[e]=cvtpk_s(dd[hh][i][2*e]*rs*gp[2*e],dd[hh][i][2*e+1]*rs*gp[2*e+1]);
        ATTN_STORE16(Ow+(long)row*op+hh*64+ch*8,w);} }
    } }
  asm volatile("s_waitcnt lgkmcnt(0)\n\ts_barrier":::"memory");
  #undef DMA_K
  #undef ROTT
  #undef DMA_V
  #undef CMASK
  #undef START
  #undef RESC
  #undef ROT
}
constexpr int ATTN_LDS_BYTES=LDS_BYTES;
#undef SBAR
#undef WAIT_BAR
}
constexpr int NWAVES = 8;
#ifndef MK_ONE_LAUNCH
#define MK_ONE_LAUNCH 1
#endif
constexpr int NPH = 20;

constexpr int D = 1024, NB = 2, SEQ = 8192, CTXL = 256;
constexpr int ML = NB * SEQ, MC = NB * CTXL, MR = ML + MC;
constexpr int E_IN = 2560, O_IN = 1792, FF = 2816, FF2 = 2 * FF, NEXP = 8;
constexpr int MOE_ROWS = 2 * ML + NEXP * 256, MOE_PAN = MOE_ROWS / 256;
constexpr int NCHUNK = MR / 64;
constexpr float EPS = 1e-6f;
constexpr float MOE_S13 = 32.0f, MOE_S2 = 64.0f;
constexpr float QSCALE = 0.125f * 1.4426950408889634f;

constexpr size_t MiB = 1u << 20, KiB = 1u << 10;
constexpr size_t WS_CTL = 0, CTL_ZERO_BYTES = 1 * MiB;
constexpr size_t WS_MOD = 1 * MiB;
constexpr size_t WS_WG = 1 * MiB + 256 * KiB;
constexpr size_t WS_TOK = 2 * MiB;
constexpr size_t WS_AGG = 4 * MiB;
constexpr size_t WS_WM13 = 8 * MiB, WS_WM2 = 96 * MiB;
constexpr size_t WS_WE = 140 * MiB, WS_WO0 = 145 * MiB, WS_WO1 = 147 * MiB, WS_WF13 = 149 * MiB, WS_WF2 = 160 * MiB, WS_WOI = 166 * MiB;
constexpr size_t WS_XR = 170 * MiB;
constexpr size_t WS_KC0 = 170 * MiB, WS_VC0 = 187 * MiB;
constexpr size_t WS_KC1 = 427 * MiB, WS_VC1 = 432 * MiB;
constexpr int KEYS = CTXL + SEQ;
constexpr size_t WS_X3 = 56 * MiB;
constexpr size_t WS_XN = 236 * MiB;
constexpr size_t WS_Y = 269 * MiB;
constexpr size_t WS_P0 = 302 * MiB;
constexpr size_t WS_OATT = 385 * MiB;
constexpr size_t WS_H = 302 * MiB;
constexpr size_t WS_P1 = 302 * MiB;
constexpr size_t WS_RI = 360 * MiB;
constexpr size_t WS_XG = 234 * MiB;
constexpr size_t WS_HG = 140 * MiB;
constexpr size_t WS_YG = 368 * MiB;
constexpr size_t WS_END = 436 * MiB;
static_assert(WS_WM13 + (size_t)NEXP * FF2 * D <= WS_X3 && WS_X3 + (size_t)ML * D * 2 <= WS_WM2 && WS_WM13 + (size_t)NEXP * FF2 * D * 2 <= WS_WM2 && WS_WM2 + (size_t)NEXP * D * FF * 2 <= WS_WE && WS_WE + (size_t)E_IN * D * 2 <= WS_WO0 && WS_WF13 + (size_t)FF2 * D * 2 <= WS_WF2 &&
              WS_WF2 + (size_t)D * FF * 2 <= WS_WOI && WS_WOI + (size_t)O_IN * D * 2 <= WS_XR && WS_XR + (size_t)MR * D * 2 <= WS_XN && WS_XN + (size_t)MR * D * 2 <= WS_Y && WS_Y + (size_t)MR * D * 2 <= WS_P0 &&
              WS_P0 + (size_t)MR * E_IN * 2 <= WS_OATT && WS_OATT + (size_t)MR * D * 2 <= WS_END && WS_H + (size_t)MR * FF * 2 <= WS_END && WS_P1 + (size_t)MR * O_IN * 2 <= WS_RI &&
              WS_RI + (size_t)4 * MR * 512 * 2 <= WS_END && WS_XG + (size_t)NEXP * ML * D <= WS_YG && WS_HG + (size_t)MOE_ROWS * FF <= WS_XG && WS_AGG + (size_t)2 * NCHUNK * 2 * 512 * 4 <= WS_WM13, "d_ws map");
constexpr int CW_TMO = 0, CW_CODE = 1;
constexpr int CW_BAR = 4096;
constexpr int CW_CNT = 8192;
constexpr int RING_OFF = 0, RING_BYTES = 131072;
constexpr int LDSCTL_OFF = RING_BYTES, MISC_OFF = LDSCTL_OFF + 320;
constexpr int PEXP_OFF = LDSCTL_OFF + 1024;
constexpr int LDS_BYTES = 147456;
#define GAS __attribute__((address_space(1)))
#define LAS __attribute__((address_space(3)))
typedef unsigned short bf16;
typedef unsigned v4u __attribute__((ext_vector_type(4)));
typedef float f32x4 __attribute__((ext_vector_type(4)));
typedef short bf16x8 __attribute__((ext_vector_type(8)));
typedef GAS unsigned gu32;
typedef GAS unsigned long long gu64;
#define RLX_AGENT __ATOMIC_RELAXED, __HIP_MEMORY_SCOPE_AGENT
#define LDS_WAIT() asm volatile("s_waitcnt lgkmcnt(0)" ::: "memory")
#define VM_WAIT() asm volatile("s_waitcnt vmcnt(0)" ::: "memory")
__device__ __forceinline__ unsigned long long rt() { return __builtin_amdgcn_s_memrealtime(); }
__device__ __forceinline__ unsigned f2bf(float f) { unsigned u = __builtin_bit_cast(unsigned, f); return (u + 0x7fffu + ((u >> 16) & 1u)) >> 16; }
__device__ __forceinline__ unsigned pk2(float lo, float hi) { return f2bf(lo) | (f2bf(hi) << 16); }

#define XB_TMO      128
#define XB_XCNT(j)  (256  + 64 * (j))
#define XB_XSUB(j)  (1280 + 64 * (j))
#define XB_XGEN(j)  (2304 + 64 * (j))
#define XB_TOP      3328
#define XB_TOPGEN   3392
#define XCD_BAR_WORDS 3456
#define XB_SPIN_CAP (1u << 18)

__device__ __forceinline__ unsigned xb_ld(unsigned* p)              { return __hip_atomic_load(p, __ATOMIC_RELAXED, __HIP_MEMORY_SCOPE_AGENT); }
__device__ __forceinline__ unsigned xb_add(unsigned* p, unsigned v) { return __hip_atomic_fetch_add(p, v, __ATOMIC_RELAXED, __HIP_MEMORY_SCOPE_AGENT); }
__device__ __forceinline__ unsigned xb_xcc_id() { return (unsigned)__builtin_amdgcn_s_getreg((3 << 11) | 20) & 0xFu; }
#define XB_SPIN(cond, bar) do { unsigned _sp = 0; while (cond) { __builtin_amdgcn_s_sleep(1); \
    if ((++_sp & 255u) == 0u) { if (xb_ld(&(bar)[XB_TMO])) break; if (_sp > XB_SPIN_CAP) { atomicAdd(&(bar)[XB_TMO], 1u); break; } } } } while (0)

struct XcdBarrier {
    unsigned* bar; unsigned x;
    volatile LAS unsigned* st;
};

__device__ __forceinline__ XcdBarrier xcd_barrier_post(unsigned* bar, volatile LAS unsigned* st) {
    XcdBarrier b; b.bar = bar; b.x = xb_xcc_id(); b.st = st;
    if (threadIdx.x == 0) (void)xb_add(&bar[XB_XCNT(b.x)], 1u);
    return b;
}
__device__ __forceinline__ void xcd_barrier_complete(unsigned* bar, unsigned x, unsigned& nloc, unsigned& nx) {
    const unsigned G = gridDim.x * gridDim.y * gridDim.z;
    unsigned sum, cnt, mine, sp = 0u;
    for (;;) {
        sum = 0u; cnt = 0u; mine = 0u;
#pragma unroll
        for (unsigned j = 0; j < 16; ++j) { const unsigned c = xb_ld(&bar[XB_XCNT(j)]); sum += c; cnt += (c > 0u) ? 1u : 0u; mine = (j == x) ? c : mine; }
        if (sum == G) break;
        __builtin_amdgcn_s_sleep(1);
        if ((++sp & 255u) == 0u) { if (xb_ld(&bar[XB_TMO])) break; if (sp > XB_SPIN_CAP) { atomicAdd(&bar[XB_TMO], 1u); break; } }
    }
    nloc = mine > 0u ? mine : 1u; nx = cnt > 0u ? cnt : 1u;
}

__device__ __forceinline__ void xcd_barrier(const XcdBarrier& b) {
    asm volatile("s_waitcnt vmcnt(0)" ::: "memory");
    __syncthreads();
    if (threadIdx.x == 0) {
        unsigned* bar = b.bar;
        __builtin_amdgcn_s_waitcnt(0);
        unsigned nloc = b.st[0], nx = b.st[1];
        if (nloc == 0u) { xcd_barrier_complete(bar, b.x, nloc, nx); b.st[0] = nloc; b.st[1] = nx; }
        const unsigned old = xb_add(&bar[XB_XSUB(b.x)], 1u);
        const unsigned gen = old / nloc;
        if (old + 1u == (gen + 1u) * nloc) {
            __builtin_amdgcn_fence(__ATOMIC_RELEASE, "agent");
            asm volatile("s_waitcnt vmcnt(0)" ::: "memory");
            const unsigned og = xb_add(&bar[XB_TOP], 1u);
            const unsigned tg = og / nx;
            if (og + 1u == (tg + 1u) * nx) xb_add(&bar[XB_TOPGEN], 1u);
            else XB_SPIN(xb_ld(&bar[XB_TOPGEN]) == tg, bar);
            __builtin_amdgcn_fence(__ATOMIC_ACQUIRE, "agent");
            xb_add(&bar[XB_XGEN(b.x)], 1u);
            asm volatile("s_waitcnt vmcnt(0)" ::: "memory");
        } else {
            XB_SPIN(xb_ld(&bar[XB_XGEN(b.x)]) == gen, bar);
            __builtin_amdgcn_fence(__ATOMIC_ACQUIRE, "agent");
            asm volatile("s_waitcnt vmcnt(0)" ::: "memory");
        }
    }
    __syncthreads();
}
typedef _Float16 f16;
typedef unsigned v2u __attribute__((ext_vector_type(2)));
typedef float f32x16 __attribute__((ext_vector_type(16)));
struct InPtrs { __device__ __forceinline__ const float* operator[](int i) const { return ((const float* const __attribute__((address_space(4)))*)__builtin_amdgcn_kernarg_segment_ptr())[i]; } };
struct Frame {
    LAS unsigned char* lds;
    volatile LAS unsigned* MISC;
    gu32* ctl;
    int tid, lane, wave;
    int vcu, G;
    InPtrs in; float* out; unsigned char* ws;
};
enum { I_X = 0, I_C, I_CTX, I_CCTX, I_WMOD, I_BMOD, I_NMIXG, I_NFFNG, I_WOUT, I_EWIN, I_ANORMG, I_AWS, I_ABS, I_BQNG, I_BKNG, I_LQ1, I_LK1, I_LQ2, I_LK2, I_SUBLNG,
       I_FW1, I_FW3, I_FW2, I_OWIN, I_CQNG, I_CKNG, I_CONVW, I_CONVB, I_DWA, I_DBA, I_DWX, I_DBX, I_DLAM, I_RW, I_RB, I_MW1, I_MW3, I_MW2 };

__device__ __forceinline__ float wave_sum(float v) {
#pragma unroll
    for (int o = 1; o < 64; o <<= 1) v += __shfl_xor(v, o);
    return v;
}
__device__ __forceinline__ float bf_lo(unsigned u) { return __uint_as_float(u << 16); }
__device__ __forceinline__ float bf_hi(unsigned u) { return __uint_as_float(u & 0xffff0000u); }
__device__ __forceinline__ float bf2f(bf16 h) { return __uint_as_float((unsigned)h << 16); }
__device__ __forceinline__ unsigned cvtpk(float lo, float hi) { return pg8::cvt_pk_bf16(lo, hi); }
__device__ __forceinline__ bf16 f2bf16(float f) { return (bf16)(cvtpk(f, 0.f) & 0xffffu); }
__device__ __forceinline__ void unpack8(const v4u u, float (&f)[8]) { f[0] = bf_lo(u.x); f[1] = bf_hi(u.x); f[2] = bf_lo(u.y); f[3] = bf_hi(u.y); f[4] = bf_lo(u.z); f[5] = bf_hi(u.z); f[6] = bf_lo(u.w); f[7] = bf_hi(u.w); }
__device__ __forceinline__ v4u pack8(const float (&f)[8]) { v4u o; o.x = cvtpk(f[0], f[1]); o.y = cvtpk(f[2], f[3]); o.z = cvtpk(f[4], f[5]); o.w = cvtpk(f[6], f[7]); return o; }
__device__ __forceinline__ float gelu_tanh(float x) { const float p = fmaf(x * x, -0.10294324f, -2.3022082f); return x * __builtin_amdgcn_rcpf(1.0f + __builtin_amdgcn_exp2f(x * p)); }
__device__ __forceinline__ float sigmoid_f(float x) { return __builtin_amdgcn_rcpf(1.0f + __builtin_amdgcn_exp2f(-1.4426950408889634f * x)); }
__device__ __forceinline__ int crow16(int r, int hi) { return (r & 3) + 8 * (r >> 2) + 4 * hi; }

__device__ __forceinline__ bool qk_bounded(const float* gq, const float* gk, int lane) {
    float a = fabsf(gq[lane]), b = fabsf(gk[lane]);
#pragma unroll
    for (int o = 1; o < 64; o <<= 1) { a = fmaxf(a, __shfl_xor(a, o)); b = fmaxf(b, __shfl_xor(b, o)); }
    return __builtin_amdgcn_readfirstlane((int)(64.0f * QSCALE * a * b * 1.02f < 64.0f)) != 0;
}
struct TrItem { const float* W; unsigned char* WT; int K, N, ilv, f8, item; float scale; };
__device__ __forceinline__ void tr_load(const TrItem& d, int lane, f32x4 (&v)[8]) {
    const int nblk = d.N / 32, kb = d.item / nblk, nb = d.item % nblk; const float* p = d.W + (size_t)(64 * kb + (lane >> 3)) * d.N + 32 * nb + 4 * (lane & 7);
#pragma unroll
    for (int i = 0; i < 8; ++i) v[i] = *(const GAS f32x4*)(p + (size_t)(8 * i) * d.N);
}
__device__ __forceinline__ void tr_store(const TrItem& d, int lane, const f32x4 (&v)[8], LAS float* scr) {
    const int nblk = d.N / 32, kb = d.item / nblk, nb = d.item % nblk, k0 = 64 * kb, n0 = 32 * nb;
    const int r0 = d.ilv ? ((n0 >> 7) * 256 + (n0 & 127) + (d.ilv == 2 ? 128 : 0)) : n0;
#pragma unroll
    for (int i = 0; i < 8; ++i) { LAS float* q = scr + (8 * i + (lane >> 3)) * 33 + 4 * (lane & 7); q[0] = v[i].x * d.scale; q[1] = v[i].y * d.scale; q[2] = v[i].z * d.scale; q[3] = v[i].w * d.scale; }
    LDS_WAIT(); asm volatile("" ::: "memory");
    if (d.f8) { const int c = lane & 3;
#pragma unroll
        for (int j = 0; j < 2; ++j) { const int n = (lane >> 2) + 16 * j; const LAS float* s = scr + (16 * c) * 33 + n;
            v4u o; o.x = pg8::cvt4_fp8(s[0 * 33], s[1 * 33], s[2 * 33], s[3 * 33]); o.y = pg8::cvt4_fp8(s[4 * 33], s[5 * 33], s[6 * 33], s[7 * 33]);
            o.z = pg8::cvt4_fp8(s[8 * 33], s[9 * 33], s[10 * 33], s[11 * 33]); o.w = pg8::cvt4_fp8(s[12 * 33], s[13 * 33], s[14 * 33], s[15 * 33]);
            *(GAS v4u*)(d.WT + (size_t)(r0 + n) * d.K + k0 + 16 * c) = o; }
    } else { const int c = lane & 7;
#pragma unroll
        for (int j = 0; j < 4; ++j) { const int n = (lane >> 3) + 8 * j; const LAS float* s = scr + (8 * c) * 33 + n;
            v4u o; o.x = cvtpk(s[0 * 33], s[1 * 33]); o.y = cvtpk(s[2 * 33], s[3 * 33]); o.z = cvtpk(s[4 * 33], s[5 * 33]); o.w = cvtpk(s[6 * 33], s[7 * 33]);
            *(GAS v4u*)((bf16*)d.WT + (size_t)(r0 + n) * d.K + k0 + 8 * c) = o; } }
    LDS_WAIT(); asm volatile("" ::: "memory");
}
constexpr int TR_I_E = 16 * 80, TR_I_O = 16 * 32, TR_I_F = 16 * 88, TR_I_OI = 16 * 56, TR_I_EXP = 3 * TR_I_F;
constexpr int TR_NITEMS = TR_I_E + 2 * TR_I_O + 3 * TR_I_F + TR_I_OI + NEXP * TR_I_EXP;
static_assert(TR_I_F == 44 * 32, "item counts of the [1024][2816] and [2816][1024] matrices match");
__device__ __forceinline__ TrItem tr_decode(Frame& F, int it) {
    unsigned char* ws = F.ws; int r = it; TrItem d; d.f8 = 0; d.scale = 1.0f; d.ilv = 0;
    if (r < TR_I_E) { d.W = F.in[I_EWIN]; d.K = D; d.N = E_IN; d.WT = ws + WS_WE; d.item = r; return d; } r -= TR_I_E;
    if (r < TR_I_O) { d.W = F.in[I_WOUT]; d.K = D; d.N = D; d.WT = ws + WS_WO0; d.item = r; return d; } r -= TR_I_O;
    if (r < TR_I_O) { d.W = F.in[I_WOUT] + (size_t)D * D; d.K = D; d.N = D; d.WT = ws + WS_WO1; d.item = r; return d; } r -= TR_I_O;
    if (r < TR_I_F) { d.W = F.in[I_FW1]; d.K = D; d.N = FF; d.WT = ws + WS_WF13; d.ilv = 1; d.f8 = 1; d.scale = MOE_S13; d.item = r; return d; } r -= TR_I_F;
    if (r < TR_I_F) { d.W = F.in[I_FW3]; d.K = D; d.N = FF; d.WT = ws + WS_WF13; d.ilv = 2; d.f8 = 1; d.scale = MOE_S13; d.item = r; return d; } r -= TR_I_F;
    if (r < TR_I_F) { d.W = F.in[I_FW2]; d.K = FF; d.N = D; d.WT = ws + WS_WF2; d.f8 = 1; d.scale = MOE_S2; d.item = r; return d; } r -= TR_I_F;
    if (r < TR_I_OI) { d.W = F.in[I_OWIN]; d.K = D; d.N = O_IN; d.WT = ws + WS_WOI; d.item = r; return d; } r -= TR_I_OI;
    const int e = r / TR_I_EXP, q = r % TR_I_EXP; d.f8 = 1;
    if (q < TR_I_F) { d.W = F.in[I_MW1] + (size_t)e * D * FF; d.K = D; d.N = FF; d.WT = ws + WS_WM13 + (size_t)e * FF2 * D; d.ilv = 1; d.scale = MOE_S13; d.item = q; }
    else if (q < 2 * TR_I_F) { d.W = F.in[I_MW3] + (size_t)e * D * FF; d.K = D; d.N = FF; d.WT = ws + WS_WM13 + (size_t)e * FF2 * D; d.ilv = 2; d.scale = MOE_S13; d.item = q - TR_I_F; }
    else { d.W = F.in[I_MW2] + (size_t)e * FF * D; d.K = FF; d.N = D; d.WT = ws + WS_WM2 + (size_t)e * D * FF; d.scale = MOE_S2; d.item = q - 2 * TR_I_F; }
    return d;
}
constexpr int TR_DENSE = TR_I_E + TR_I_O;
__device__ __forceinline__ void tr_range(Frame& F, int lo, int hi) {
    LAS float* scr = (LAS float*)(F.lds + RING_OFF + F.wave * 16384);
    const int gw = F.vcu * NWAVES + F.wave, NGW = F.G * NWAVES, lane = F.lane;
    f32x4 v0[8], v1[8], v2[8], v3[8]; TrItem d0, d1, d2, d3; int it = lo + gw;
#define TR_ISSUE(d, v, idx) do { const int i_ = (idx); d = tr_decode(F, i_ < hi ? i_ : lo); if (i_ < hi) tr_load(d, lane, v); } while (0)
    TR_ISSUE(d0, v0, it); TR_ISSUE(d1, v1, it + NGW); TR_ISSUE(d2, v2, it + 2 * NGW);
    while (it < hi) {
        TR_ISSUE(d3, v3, it + 3 * NGW); tr_store(d0, lane, v0, scr); if (it + NGW >= hi) break;
        TR_ISSUE(d0, v0, it + 4 * NGW); tr_store(d1, lane, v1, scr); if (it + 2 * NGW >= hi) break;
        TR_ISSUE(d1, v1, it + 5 * NGW); tr_store(d2, lane, v2, scr); if (it + 3 * NGW >= hi) break;
        TR_ISSUE(d2, v2, it + 6 * NGW); tr_store(d3, lane, v3, scr);
        it += 4 * NGW; }
#undef TR_ISSUE
}
__device__ __forceinline__ void ph0_prologue(Frame& F) {
    const int lane = F.lane;
    tr_range(F, 0, TR_DENSE);
    { bf16* WG = (bf16*)(F.ws + WS_WG);
      for (int i = (int)blockIdx.x * 512 + F.tid; i < 2 * 2 * 8 * 64 * 64; i += F.G * 512) {
          const int k = i & 63, o = (i >> 6) & 63, n = (i >> 12) & 7, mat = (i >> 15) & 1, d = (i >> 16) & 1;
          const float* W = mat ? F.in[I_DWX] : F.in[I_DWA];
          WG[i] = f2bf16(W[((size_t)(d * 8 + n) * 64 + k) * 64 + o]); } }
    __syncthreads();
    { float* MOD = (float*)(F.ws + WS_MOD); LAS float* red = (LAS float*)(F.lds + RING_OFF);
      for (int cg = (int)blockIdx.x; cg < 2 * 96; cg += F.G) {
          const int layer = cg / 96, n0 = (cg % 96) * 64, kr = lane >> 4, c4 = lane & 15;
          f32x4 acc[3]; acc[0] = acc[1] = acc[2] = (f32x4){0.f, 0.f, 0.f, 0.f};
          const float* Wl = F.in[I_WMOD] + (size_t)layer * D * 6 * D;
#pragma unroll 4
          for (int it = 0; it < 32; ++it) { const int k = F.wave * 128 + 4 * it + kr;
              const f32x4 w = *(const GAS f32x4*)(Wl + (size_t)k * 6 * D + n0 + 4 * c4);
              const float c0 = F.in[I_C][k], c1 = F.in[I_C][D + k], c2 = F.in[I_CCTX][k];
              acc[0] += (c0 * sigmoid_f(c0)) * w; acc[1] += (c1 * sigmoid_f(c1)) * w; acc[2] += (c2 * sigmoid_f(c2)) * w; }
#pragma unroll
          for (int s = 0; s < 3; ++s)
#pragma unroll
              for (int j = 0; j < 4; ++j) { float v = acc[s][j]; v += __shfl_xor(v, 16); v += __shfl_xor(v, 32); acc[s][j] = v; }
          if (lane < 16) {
#pragma unroll
              for (int s = 0; s < 3; ++s)
#pragma unroll
                  for (int j = 0; j < 4; ++j) red[(F.wave * 3 + s) * 64 + 4 * c4 + j] = acc[s][j]; }
          __syncthreads();
          if (F.tid < 192) { const int s = F.tid >> 6, col = F.tid & 63; float v = F.in[I_BMOD][layer * 6 * D + n0 + col];
#pragma unroll
              for (int w = 0; w < 8; ++w) v += red[(w * 3 + s) * 64 + col];
              MOD[(size_t)(layer * 3 + s) * 6 * D + n0 + col] = v; }
          __syncthreads();
      } }
}
template <bool F8 = false, bool S16 = false> __device__ __forceinline__ void normmod_row(const float* src, const float* g, const float* sc, const float* sh, bf16* dst, int lane, f32x4 (&t)[4]) {
    const GAS f32x4* xr = (const GAS f32x4*)src + lane; float s = 0.f;
#pragma unroll
    for (int j = 0; j < 4; ++j) { if constexpr (S16) { const v2u w = ((const GAS v2u*)src)[lane + 64 * j]; t[j] = (f32x4){bf_lo(w.x), bf_hi(w.x), bf_lo(w.y), bf_hi(w.y)}; } else t[j] = xr[64 * j];
        s += (t[j].x * t[j].x + t[j].y * t[j].y) + (t[j].z * t[j].z + t[j].w * t[j].w); }
    const float rstd = 1.0f / sqrtf(wave_sum(s) * (1.f / D) + EPS);
    GAS v2u* o8 = (GAS v2u*)dst + lane;
#pragma unroll
    for (int j = 0; j < 4; ++j) { const f32x4 gg = ((const GAS f32x4*)g)[lane + 64 * j], cc = ((const GAS f32x4*)sc)[lane + 64 * j], hh = ((const GAS f32x4*)sh)[lane + 64 * j];
        t[j] = t[j] * rstd * gg * (1.0f + cc) + hh;
        if constexpr (F8) ((GAS unsigned*)dst)[lane + 64 * j] = pg8::cvt4_fp8(t[j].x, t[j].y, t[j].z, t[j].w); else { v2u w; w.x = cvtpk(t[j].x, t[j].y); w.y = cvtpk(t[j].z, t[j].w); o8[64 * j] = w; } }
}
template <bool S16> __device__ __forceinline__ void nm_load_row(const float* srcL, const float* srcC, int m, int lane, f32x4 (&t)[4]) {
    if constexpr (S16) { const GAS v2u* p = (const GAS v2u*)((const bf16*)(m < ML ? srcL : srcC) + (size_t)(m < ML ? m : m - ML) * D) + lane;
#pragma unroll
        for (int j = 0; j < 4; ++j) { const v2u w = p[64 * j]; t[j] = (f32x4){bf_lo(w.x), bf_hi(w.x), bf_lo(w.y), bf_hi(w.y)}; } }
    else { const GAS f32x4* p = (const GAS f32x4*)(m < ML ? srcL + (size_t)m * D : srcC + (size_t)(m - ML) * D) + lane;
#pragma unroll
        for (int j = 0; j < 4; ++j) t[j] = p[64 * j]; }
}
template <bool F8 = false, bool S16 = false> __device__ __forceinline__ void ph_normmod(Frame& F, const float* srcL, const float* srcC, int nrows, const float* g, int layer, int sh_off, int sc_off) {
    const int gw = F.vcu * NWAVES + F.wave, NGW = F.G * NWAVES, lane = F.lane; const float* MOD = (const float*)(F.ws + WS_MOD) + (size_t)layer * 3 * 6 * D; bf16* XN = (bf16*)(F.ws + WS_XN);
    int m = gw; if (m >= nrows) return;
    f32x4 tn[4], gm[4], hh[4]; int cur_s = -1; nm_load_row<S16>(srcL, srcC, m, lane, tn);
    for (; m < nrows; m += NGW) { f32x4 t[4]; float q = 0.f;
#pragma unroll
        for (int j = 0; j < 4; ++j) { t[j] = tn[j]; q += (t[j].x * t[j].x + t[j].y * t[j].y) + (t[j].z * t[j].z + t[j].w * t[j].w); }
        if (m + NGW < nrows) nm_load_row<S16>(srcL, srcC, m + NGW, lane, tn);
        const int s = m < SEQ ? 0 : (m < ML ? 1 : 2);
        if (s != cur_s) { cur_s = s; const float* sc = MOD + s * 6 * D + sc_off; const float* sh = MOD + s * 6 * D + sh_off;
#pragma unroll
            for (int j = 0; j < 4; ++j) { gm[j] = ((const GAS f32x4*)g)[lane + 64 * j] * (((const GAS f32x4*)sc)[lane + 64 * j] + 1.0f); hh[j] = ((const GAS f32x4*)sh)[lane + 64 * j]; } }
        const float rstd = __builtin_amdgcn_rsqf(wave_sum(q) * (1.f / D) + EPS);
        bf16* dst = F8 ? (bf16*)((unsigned char*)XN + (size_t)m * D) : XN + (size_t)m * D;
#pragma unroll
        for (int j = 0; j < 4; ++j) { const f32x4 o = t[j] * rstd * gm[j] + hh[j];
            if constexpr (F8) ((GAS unsigned*)dst)[lane + 64 * j] = pg8::cvt4_fp8(o.x, o.y, o.z, o.w); else { v2u w; w.x = cvtpk(o.x, o.y); w.y = cvtpk(o.z, o.w); ((GAS v2u*)dst)[lane + 64 * j] = w; } }
    }
}
struct RopeLane { float fr[8]; float sgn; int useRow; };
__device__ __forceinline__ RopeLane rope_lane(int lane) { RopeLane R; const int j = lane & 7; R.sgn = (j & 2) ? 1.f : -1.f; R.useRow = (j < 4);
#pragma unroll
    for (int e = 0; e < 8; ++e) R.fr[e] = __builtin_amdgcn_exp2f(-(float)((j & 1) * 8 + e) * (13.287712379549449f / 16.f)) * 0.15915494309189535f;
    return R; }
__device__ __forceinline__ void rope_cs(const RopeLane& R, int prow, int pcol, float (&cs)[8], float (&sn)[8]) {
    const float pos = (float)(R.useRow ? prow : pcol);
#pragma unroll
    for (int e = 0; e < 8; ++e) { float rev = pos * R.fr[e]; rev = rev - floorf(rev); cs[e] = __builtin_amdgcn_cosf(rev); sn[e] = R.sgn * __builtin_amdgcn_sinf(rev); }
}
__device__ __forceinline__ void qknorm_rope(float (&f)[8], const float* g, bool rope, const float (&cs)[8], const float (&sn)[8], float outscale, int lane) {
    float ss = 0.f;
#pragma unroll
    for (int e = 0; e < 8; ++e) ss += f[e] * f[e];
    ss += __shfl_xor(ss, 1); ss += __shfl_xor(ss, 2); ss += __shfl_xor(ss, 4);
    const float rstd = outscale * __builtin_amdgcn_rsqf(ss * (1.f / 64.f) + EPS); const int j = lane & 7;
    const f32x4 g0 = *(const GAS f32x4*)(g + 8 * j), g1 = *(const GAS f32x4*)(g + 8 * j + 4);
    const float gg[8] = {g0.x, g0.y, g0.z, g0.w, g1.x, g1.y, g1.z, g1.w};
#pragma unroll
    for (int e = 0; e < 8; ++e) f[e] = f[e] * (rstd * gg[e]);
    if (rope) {
#pragma unroll
        for (int e = 0; e < 8; ++e) { const float p = __shfl_xor(f[e], 2); f[e] = f[e] * cs[e] + p * sn[e]; }
    }
}
__device__ __forceinline__ void ph3_post0(Frame& F) {
    const int gw = F.vcu * NWAVES + F.wave, NGW = F.G * NWAVES, lane = F.lane; bf16* P0 = (bf16*)(F.ws + WS_P0); bf16* KC = (bf16*)(F.ws + WS_KC0); bf16* VC = (bf16*)(F.ws + WS_VC0); const RopeLane RL = rope_lane(lane);
    for (int m = gw; m < MR; m += NGW) {
        GAS v4u* rowp = (GAS v4u*)(P0 + (size_t)m * E_IN) + lane;
        const v4u u0 = rowp[0], u1 = rowp[64], u2 = rowp[128], u3 = rowp[192];
        float f[8];
        unpack8(u0, f);
#pragma unroll
        for (int e = 0; e < 8; ++e) f[e] = gelu_tanh(f[e]);
        rowp[0] = pack8(f);
        unpack8(u1, f); float ss = 0.f;
#pragma unroll
        for (int e = 0; e < 8; ++e) { f[e] = gelu_tanh(f[e]); ss += f[e] * f[e]; }
        { const float rstd = 1.0f / sqrtf(wave_sum(ss) * (1.f / 512.f) + EPS); const float* g = F.in[I_ANORMG] + 8 * lane;
          const f32x4 g0 = *(const GAS f32x4*)g, g1 = *(const GAS f32x4*)(g + 4); const float gg[8] = {g0.x, g0.y, g0.z, g0.w, g1.x, g1.y, g1.z, g1.w};
#pragma unroll
          for (int e = 0; e < 8; ++e) f[e] = f[e] * rstd * gg[e]; }
        rowp[64] = pack8(f);
        const bool lat = m < ML; const int t = m & (SEQ - 1), prow = t >> 6, pcol = t & 63; float cs[8], sn[8]; if (lat) rope_cs(RL, prow, pcol, cs, sn);
        unpack8(u2, f); qknorm_rope(f, F.in[I_BQNG], lat, cs, sn, QSCALE, lane); rowp[128] = pack8(f);
        unpack8(u3, f); qknorm_rope(f, F.in[I_BKNG], lat, cs, sn, 1.0f, lane);
        { const int b = lat ? (m >> 13) : ((m - ML) >> 8), pos = lat ? CTXL + t : ((m - ML) & (CTXL - 1)); const size_t tb = (size_t)(pos >> 6) * 4096; const int pr = pos & 63;
          *(GAS v4u*)(KC + ((size_t)(b * 8 + (lane >> 3)) * KEYS * 64 + tb + (lane & 7) * 512 + pr * 8)) = pack8(f);
          const v4u u4 = rowp[256];
          *(GAS v4u*)(VC + ((size_t)(b * 8 + (lane >> 3)) * KEYS * 64 + tb + ((((lane & 7) >> 2) * 4 + (pr >> 4)) * 64 + (pr & 15) * 4 + (lane & 3)) * 8)) = u4; }
    }
}
__device__ __forceinline__ void gmlp_unit(Frame& F, int chunk) {
    const int lane = F.lane, r32 = lane & 31, hi = lane >> 5, g = F.wave, r0 = chunk * 128;
    const bf16* P0 = (const bf16*)(F.ws + WS_P0); bf16* Y = (bf16*)(F.ws + WS_Y);
    const float* ws = F.in[I_AWS] + (size_t)g * 128 * 128; const float* bs = F.in[I_ABS] + g * 128;
    bf16x8 afr[2][8];
#pragma unroll
    for (int ct = 0; ct < 2; ++ct)
#pragma unroll
        for (int ks = 0; ks < 8; ++ks)
#pragma unroll
            for (int e = 0; e < 8; ++e) afr[ct][ks][e] = (short)P0[(size_t)(r0 + 16 * ks + 8 * hi + e) * E_IN + 512 + 64 * g + 32 * ct + r32];
#pragma unroll 1
    for (int pt = 0; pt < 4; ++pt) {
        f32x16 acc[2]; acc[0] = f32x16{}; acc[1] = f32x16{};
        const float* wp = ws + (size_t)(32 * pt + r32) * 128 + 8 * hi;
#pragma unroll
        for (int ks = 0; ks < 8; ++ks) { const f32x4 w0 = *(const GAS f32x4*)(wp + 16 * ks), w1 = *(const GAS f32x4*)(wp + 16 * ks + 4);
            v4u pk; pk.x = cvtpk(w0.x, w0.y); pk.y = cvtpk(w0.z, w0.w); pk.z = cvtpk(w1.x, w1.y); pk.w = cvtpk(w1.z, w1.w); const bf16x8 bfr = __builtin_bit_cast(bf16x8, pk);
            acc[0] = __builtin_amdgcn_mfma_f32_32x32x16_bf16(afr[0][ks], bfr, acc[0], 0, 0, 0); acc[1] = __builtin_amdgcn_mfma_f32_32x32x16_bf16(afr[1][ks], bfr, acc[1], 0, 0, 0); }
        const int p = 32 * pt + r32; const float bias = bs[p];
#pragma unroll
        for (int ct = 0; ct < 2; ++ct)
#pragma unroll
            for (int rq = 0; rq < 4; ++rq) { const int c0 = 64 * g + 32 * ct + 8 * rq + 4 * hi;
                const v2u uu = *(const GAS v2u*)(P0 + (size_t)(r0 + p) * E_IN + c0);
                v2u o; o.x = cvtpk(bf_lo(uu.x) * (acc[ct][4 * rq + 0] + bias), bf_hi(uu.x) * (acc[ct][4 * rq + 1] + bias)); o.y = cvtpk(bf_lo(uu.y) * (acc[ct][4 * rq + 2] + bias), bf_hi(uu.y) * (acc[ct][4 * rq + 3] + bias));
                *(GAS v2u*)(Y + (size_t)(r0 + p) * D + c0) = o; }
    }
}
__device__ __forceinline__ void ph5_diffout(Frame& F) {
    const int gw = F.vcu * NWAVES + F.wave, NGW = F.G * NWAVES, lane = F.lane; const bf16* OA = (const bf16*)(F.ws + WS_OATT); bf16* Y = (bf16*)(F.ws + WS_Y);
    const float s1 = wave_sum(F.in[I_LQ1][lane] * F.in[I_LK1][lane]), s2 = wave_sum(F.in[I_LQ2][lane] * F.in[I_LK2][lane]);
    const float lam_init = 0.2f, lam = expf(s1) - expf(s2) + lam_init;
    const int h = lane >> 4, comp = (lane >> 3) & 1, i0 = (lane & 7) * 16;
    float gg[16];
#pragma unroll
    for (int q = 0; q < 4; ++q) { const f32x4 gv = *(const GAS f32x4*)(F.in[I_SUBLNG] + i0 + 4 * q); gg[4 * q] = gv.x; gg[4 * q + 1] = gv.y; gg[4 * q + 2] = gv.z; gg[4 * q + 3] = gv.w; }
    for (int m = gw; m < MR; m += NGW) {
        const GAS v4u* rp = (const GAS v4u*)(OA + (size_t)m * D + 16 * lane);
        const v4u a = rp[0], b = rp[1]; float own[16], d[16];
        { float t8[8]; unpack8(a, t8);
#pragma unroll
          for (int e = 0; e < 8; ++e) own[e] = t8[e];
          unpack8(b, t8);
#pragma unroll
          for (int e = 0; e < 8; ++e) own[8 + e] = t8[e]; }
        float ss = 0.f;
#pragma unroll
        for (int e = 0; e < 16; ++e) { const float oth = __shfl_xor(own[e], 8); const float o1 = comp ? oth : own[e], o2 = comp ? own[e] : oth; d[e] = o1 - lam * o2; ss += d[e] * d[e]; }
        ss += __shfl_xor(ss, 1); ss += __shfl_xor(ss, 2); ss += __shfl_xor(ss, 4);
        const float rstd = (1.0f - lam_init) / sqrtf(ss * (1.f / 128.f) + EPS);
        if (comp == 0) { float o8[8]; GAS v4u* yp = (GAS v4u*)(Y + (size_t)m * D + 512 + 128 * h + i0);
#pragma unroll
            for (int e = 0; e < 8; ++e) o8[e] = d[e] * rstd * gg[e];
            yp[0] = pack8(o8);
#pragma unroll
            for (int e = 0; e < 8; ++e) o8[e] = d[8 + e] * rstd * gg[8 + e];
            yp[1] = pack8(o8); }
    }
}
__device__ __forceinline__ void ph12_post1(Frame& F) {
    const int nskip = (NCHUNK > F.G && NCHUNK - F.G < F.G / 2) ? NCHUNK - F.G : 0;
    if (F.vcu < nskip) return;
    const int gw = (F.vcu - nskip) * NWAVES + F.wave, NGW = (F.G - nskip) * NWAVES, lane = F.lane; bf16* P1 = (bf16*)(F.ws + WS_P1); bf16* KC = (bf16*)(F.ws + WS_KC1); bf16* VC = (bf16*)(F.ws + WS_VC1); const RopeLane RL = rope_lane(lane);
    for (int m = gw; m < MR; m += NGW) {
        GAS v4u* rowp = (GAS v4u*)(P1 + (size_t)m * O_IN) + lane;
        const v4u u0 = rowp[0], u1 = rowp[64];
        const bool lat = m < ML; const int t = m & (SEQ - 1), prow = t >> 6, pcol = t & 63; float f[8]; float cs[8], sn[8]; if (lat) rope_cs(RL, prow, pcol, cs, sn);
        unpack8(u0, f); qknorm_rope(f, F.in[I_CQNG], lat, cs, sn, QSCALE, lane); if (lat) rowp[0] = pack8(f);
        unpack8(u1, f); qknorm_rope(f, F.in[I_CKNG], lat, cs, sn, 1.0f, lane);
        { const int b = lat ? (m >> 13) : ((m - ML) >> 8), pos = lat ? CTXL + t : ((m - ML) & (CTXL - 1)); const size_t tb = (size_t)(pos >> 6) * 4096; const int pr = pos & 63, l2 = lane & 15;
          if (lane < 16) *(GAS v4u*)(KC + ((size_t)(b * 2 + (l2 >> 3)) * KEYS * 64 + tb + (l2 & 7) * 512 + pr * 8)) = pack8(f);
          else if (lane < 32) *(GAS v4u*)(VC + ((size_t)(b * 2 + (l2 >> 3)) * KEYS * 64 + tb + ((((l2 & 7) >> 2) * 4 + (pr >> 4)) * 64 + (pr & 15) * 4 + (l2 & 3)) * 8)) = u1; }
    }
}
__device__ __forceinline__ bool seq_start(int r) { return r < ML ? (r & (SEQ - 1)) == 0 : ((r - ML) & (CTXL - 1)) == 0; }
constexpr int XDS = 520;
__device__ __forceinline__ void conv_to_lds(Frame& F, int r0, LAS bf16* XD) {
    const int cg = F.lane, w = F.wave; const bf16* P1 = (const bf16*)(F.ws + WS_P1);
    const bool st = seq_start(r0), en = seq_start(r0 + 64) || (r0 + 64 == MR);
    float wj[4][8], cb[8];
#pragma unroll
    for (int j = 0; j < 4; ++j) { const f32x4 a = *(const GAS f32x4*)(F.in[I_CONVW] + j * 512 + 8 * cg), b = *(const GAS f32x4*)(F.in[I_CONVW] + j * 512 + 8 * cg + 4);
        wj[j][0] = a.x; wj[j][1] = a.y; wj[j][2] = a.z; wj[j][3] = a.w; wj[j][4] = b.x; wj[j][5] = b.y; wj[j][6] = b.z; wj[j][7] = b.w; }
    { const f32x4 a = *(const GAS f32x4*)(F.in[I_CONVB] + 8 * cg), b = *(const GAS f32x4*)(F.in[I_CONVB] + 8 * cg + 4); cb[0] = a.x; cb[1] = a.y; cb[2] = a.z; cb[3] = a.w; cb[4] = b.x; cb[5] = b.y; cb[6] = b.z; cb[7] = b.w; }
    v4u xr[11];
#pragma unroll
    for (int i = 0; i < 11; ++i) { const int rl = 8 * w + i - 2; const bool ok = !((st && rl < 0) || (en && rl >= 64));
        xr[i] = ok ? *(const GAS v4u*)(P1 + (size_t)(r0 + rl) * O_IN + 1280 + 8 * cg) : (v4u){0u, 0u, 0u, 0u}; }
    float acc[8][8];
#pragma unroll
    for (int o = 0; o < 8; ++o)
#pragma unroll
        for (int e = 0; e < 8; ++e) acc[o][e] = cb[e];
#pragma unroll
    for (int i = 0; i < 11; ++i) { float f[8]; unpack8(xr[i], f);
#pragma unroll
        for (int j = 0; j < 4; ++j) { const int o = i - j; if (o >= 0 && o < 8) {
#pragma unroll
            for (int e = 0; e < 8; ++e) acc[o][e] += wj[j][e] * f[e]; } } }
#pragma unroll
    for (int o = 0; o < 8; ++o) *(LAS v4u*)(XD + (8 * w + o) * XDS + 8 * cg) = pack8(acc[o]);
}
__device__ __forceinline__ void lru_gates(Frame& F, const LAS bf16* XD, int n, int d, int half, f32x16 (&a)[2], f32x16 (&b)[2]) {
    const int lane = F.lane, r32 = lane & 31, hi = lane >> 5; const bf16* WG = (const bf16*)(F.ws + WS_WG);
    f32x16 ai[2]; a[0] = f32x16{}; a[1] = f32x16{}; ai[0] = f32x16{}; ai[1] = f32x16{};
    const bf16* wpr = WG + ((size_t)(((d * 2 + 0) * 8 + n) * 64 + 32 * half + r32)) * 64 + 8 * hi; const bf16* wpi = WG + ((size_t)(((d * 2 + 1) * 8 + n) * 64 + 32 * half + r32)) * 64 + 8 * hi;
#pragma unroll
    for (int ks = 0; ks < 4; ++ks) { const bf16x8 br = *(const GAS bf16x8*)(wpr + 16 * ks), bi = *(const GAS bf16x8*)(wpi + 16 * ks);
#pragma unroll
        for (int mt = 0; mt < 2; ++mt) { const bf16x8 af = *(const LAS bf16x8*)(XD + (32 * mt + r32) * XDS + 64 * n + 16 * ks + 8 * hi);
            a[mt] = __builtin_amdgcn_mfma_f32_32x32x16_bf16(af, br, a[mt], 0, 0, 0); ai[mt] = __builtin_amdgcn_mfma_f32_32x32x16_bf16(af, bi, ai[mt], 0, 0, 0); } }
    __builtin_amdgcn_sched_barrier(0);
    const int ch = 64 * n + 32 * half + r32; const float ba = F.in[I_DBA][d * 512 + ch], bx = F.in[I_DBX][d * 512 + ch];
    const float spl = -8.0f * 1.4426950408889634f * log1pf(expf(-F.in[I_DLAM][d * 512 + ch]));
    const float nba = -1.4426950408889634f * ba, nbx = -1.4426950408889634f * bx;
#pragma unroll
    for (int mt = 0; mt < 2; ++mt)
#pragma unroll
        for (int r = 0; r < 16; ++r) { const int row = 32 * mt + crow16(r, hi); const float xd = bf2f(XD[row * XDS + ch]);
            const float rr = __builtin_amdgcn_rcpf(1.0f + __builtin_amdgcn_exp2f(fmaf(a[mt][r], -1.4426950408889634f, nba))), ii = __builtin_amdgcn_rcpf(1.0f + __builtin_amdgcn_exp2f(fmaf(ai[mt][r], -1.4426950408889634f, nbx)));
            const float av = __builtin_amdgcn_exp2f(rr * spl), om = fmaxf(fmaf(-av, av, 1.0f), 0.0f);
            a[mt][r] = av; b[mt][r] = __builtin_amdgcn_sqrtf(om) * (ii * xd);     if ((r & 3) == 3) __builtin_amdgcn_sched_barrier(0); }
}
template <bool REV, bool FULL> __device__ __forceinline__ void chunk_scan(f32x16 (&a)[2], f32x16 (&b)[2], int hi, float h0, float& Atot, float& Btot) {
    float GA[8], GB[8], pGA[8], pGB[8], carry[8];
#pragma unroll
    for (int j = 0; j < 8; ++j) { const int mt = j >> 2, q = j & 3;
#pragma unroll
        for (int p = 1; p < 4; ++p) { const int k = REV ? 3 - p : p, kp = REV ? k + 1 : k - 1; const float ak = a[mt][4 * q + k];
            b[mt][4 * q + k] = ak * b[mt][4 * q + kp] + b[mt][4 * q + k]; a[mt][4 * q + k] = ak * a[mt][4 * q + kp]; }
        GA[j] = a[mt][4 * q + (REV ? 0 : 3)]; GB[j] = b[mt][4 * q + (REV ? 0 : 3)]; }
#pragma unroll
    for (int j = 0; j < 8; ++j) { const auto ra = __builtin_amdgcn_permlane32_swap(__float_as_uint(GA[j]), __float_as_uint(GA[j]), false, false); pGA[j] = __uint_as_float(hi ? ra[0] : ra[1]);
        const auto rb = __builtin_amdgcn_permlane32_swap(__float_as_uint(GB[j]), __float_as_uint(GB[j]), false, false); pGB[j] = __uint_as_float(hi ? rb[0] : rb[1]); }
    float c = h0, At = 1.0f; const bool firstMine = REV ? (hi == 1) : (hi == 0);
#pragma unroll
    for (int jj = 0; jj < 8; ++jj) { const int j = REV ? 7 - jj : jj;
        const float A1 = firstMine ? GA[j] : pGA[j], B1 = firstMine ? GB[j] : pGB[j], A2 = firstMine ? pGA[j] : GA[j], B2 = firstMine ? pGB[j] : GB[j];
        const float c1 = A1 * c + B1; carry[j] = firstMine ? c : c1; c = A2 * c1 + B2; At *= GA[j] * pGA[j]; }
    Atot = At; Btot = c;
    if constexpr (FULL) {
#pragma unroll
        for (int j = 0; j < 8; ++j) { const int mt = j >> 2, q = j & 3;
#pragma unroll
            for (int k = 0; k < 4; ++k) b[mt][4 * q + k] = a[mt][4 * q + k] * carry[j] + b[mt][4 * q + k]; }
    }
}
__device__ __forceinline__ void scan_prep_unit(Frame& F, int cid) {
    const int r0 = cid * 64, lane = F.lane, r32 = lane & 31, hi = lane >> 5, n = F.wave; LAS bf16* XD = (LAS bf16*)(F.lds + RING_OFF); float* AGG = (float*)(F.ws + WS_AGG);
    conv_to_lds(F, r0, XD);
    LDS_WAIT(); __syncthreads();
#pragma unroll
    for (int d = 0; d < 2; ++d)
#pragma unroll
        for (int half = 0; half < 2; ++half) { f32x16 a[2], b[2]; lru_gates(F, XD, n, d, half, a, b); float At, Bt;
            if (d == 0) chunk_scan<false, false>(a, b, hi, 0.f, At, Bt); else chunk_scan<true, false>(a, b, hi, 0.f, At, Bt);
            if (hi == 0) { const int ch = 64 * n + 32 * half + r32; AGG[((size_t)(d * NCHUNK + cid) * 2 + 0) * 512 + ch] = At; AGG[((size_t)(d * NCHUNK + cid) * 2 + 1) * 512 + ch] = Bt; } }
    LDS_WAIT(); __syncthreads();
}
__device__ __forceinline__ void scan_fix_unit(Frame& F, int cid) {
    const int b = cid >> 7, j = cid & 127, r0 = cid * 64, lane = F.lane, r32 = lane & 31, hi = lane >> 5, n = F.wave;
    const float* AGG = (const float*)(F.ws + WS_AGG); const bf16* P1 = (const bf16*)(F.ws + WS_P1); bf16* Y = (bf16*)(F.ws + WS_Y);
    LAS bf16* XD = (LAS bf16*)(F.lds + RING_OFF); LAS float* CAR = (LAS float*)(F.lds + RING_OFF + 64 * XDS * 2);
    conv_to_lds(F, r0, XD);
    asm volatile("" ::: "memory"); __builtin_amdgcn_sched_barrier(0);
    { const int ch = F.tid; const float* A0 = AGG + ch; const float* A1 = AGG + (size_t)NCHUNK * 1024 + ch;
      float hf = 0.f, hb = 0.f;
#pragma unroll
      for (int q = 0; q < 4; ++q) { const int c = 256 + 4 * b + q; hf = A0[(size_t)c * 1024] * hf + A0[(size_t)c * 1024 + 512]; }
#pragma unroll 8
      for (int q = 0; q < j; ++q) { const int c = 128 * b + q; hf = A0[(size_t)c * 1024] * hf + A0[(size_t)c * 1024 + 512]; }
#pragma unroll
      for (int q = 3; q >= 0; --q) { const int c = 256 + 4 * b + q; hb = A1[(size_t)c * 1024] * hb + A1[(size_t)c * 1024 + 512]; }
#pragma unroll 8
      for (int q = 127; q > j; --q) { const int c = 128 * b + q; hb = A1[(size_t)c * 1024] * hb + A1[(size_t)c * 1024 + 512]; }
      CAR[ch] = hf; CAR[512 + ch] = hb; }
    LDS_WAIT(); __syncthreads();
#pragma unroll 1
    for (int half = 0; half < 2; ++half) { const int ch = 64 * n + 32 * half + r32; f32x16 a[2], hf[2], hb[2]; float At, Bt;
        lru_gates(F, XD, n, 0, half, a, hf); chunk_scan<false, true>(a, hf, hi, CAR[ch], At, Bt);
        __builtin_amdgcn_sched_barrier(0); lru_gates(F, XD, n, 1, half, a, hb); chunk_scan<true, true>(a, hb, hi, CAR[512 + ch], At, Bt);
        const bf16* gp = P1 + (size_t)r0 * O_IN + 768; bf16* yp = Y + (size_t)r0 * D + 512;
#pragma unroll
        for (int mt = 0; mt < 2; ++mt)
#pragma unroll
            for (int q = 0; q < 4; ++q) {
#pragma unroll
                for (int k = 0; k < 4; ++k) { const unsigned rl = (unsigned)(32 * mt + 8 * q + 4 * hi + k); const float gt = bf2f(gp[rl * (unsigned)O_IN + (unsigned)ch]);
                    yp[rl * (unsigned)D + (unsigned)ch] = f2bf16((hf[mt][4 * q + k] + hb[mt][4 * q + k]) * gelu_tanh(gt)); }
                asm volatile("" ::: "memory"); } }
    LDS_WAIT(); __syncthreads();
}
__device__ __forceinline__ void ph15_router(Frame& F) {
    LAS float* WR = (LAS float*)(F.lds + RING_OFF);
    LAS int* lcnt = (LAS int*)(F.lds + RING_OFF + 32768); LAS int* lbase = lcnt + 8; LAS int* rec = lcnt + 16;
    LAS unsigned char* STG = F.lds + RING_OFF + 40960;
    const int lane = F.lane; const float* MOD = (const float*)(F.ws + WS_MOD) + (size_t)3 * 6 * D; unsigned char* XG = F.ws + WS_XG; int* TOK = (int*)(F.ws + WS_TOK);
    for (int i = F.tid; i < 1024 * 8 / 4; i += NWAVES * 64) { const int c = i >> 1, hf = i & 1; ((LAS f32x4*)WR)[hf * 1024 + ((c >> 8) * 4 + (c & 3)) * 64 + ((c & 255) >> 2)] = ((const GAS f32x4*)F.in[I_RW])[i]; }
    __syncthreads();
    for (int rb = F.vcu; rb < ML / 64; rb += F.G) {
        if (F.tid < 8) lcnt[F.tid] = 0;
        __syncthreads();
        f32x4 tn[4];
        const bf16* X3 = (const bf16*)(F.ws + WS_X3);
        { const GAS v2u* xr0 = (const GAS v2u*)(X3 + (size_t)(rb * 64 + F.wave * 8) * D) + lane;
#pragma unroll
          for (int j = 0; j < 4; ++j) { const v2u w = xr0[64 * j]; tn[j] = (f32x4){bf_lo(w.x), bf_hi(w.x), bf_lo(w.y), bf_hi(w.y)}; } }
#pragma unroll 4
        for (int i = 0; i < 8; ++i) { const int rl = F.wave * 8 + i, m = rb * 64 + rl, s = m >> 13; f32x4 t[4];
            { float q = 0.f;
#pragma unroll
              for (int j = 0; j < 4; ++j) { t[j] = tn[j]; q += (t[j].x * t[j].x + t[j].y * t[j].y) + (t[j].z * t[j].z + t[j].w * t[j].w); }
              if (i < 7) { const GAS v2u* xr = (const GAS v2u*)(X3 + (size_t)(m + 1) * D) + lane;
#pragma unroll
                  for (int j = 0; j < 4; ++j) { const v2u w = xr[64 * j]; tn[j] = (f32x4){bf_lo(w.x), bf_hi(w.x), bf_lo(w.y), bf_hi(w.y)}; } }
              const float rstd = 1.0f / sqrtf(wave_sum(q) * (1.f / D) + EPS); const float* g = F.in[I_NFFNG] + D; const float* sc = MOD + s * 6 * D + 4 * D; const float* sh = MOD + s * 6 * D + 3 * D;
#pragma unroll
              for (int j = 0; j < 4; ++j) { const f32x4 gg = ((const GAS f32x4*)g)[lane + 64 * j], cc = ((const GAS f32x4*)sc)[lane + 64 * j], hh = ((const GAS f32x4*)sh)[lane + 64 * j];
                  t[j] = t[j] * rstd * gg * (1.0f + cc) + hh; ((LAS unsigned*)(STG + rl * 1024))[lane + 64 * j] = pg8::cvt4_fp8(t[j].x, t[j].y, t[j].z, t[j].w); } }
            float lg[8];
#pragma unroll
            for (int e = 0; e < 8; ++e) lg[e] = 0.f;
#pragma unroll
            for (int j = 0; j < 4; ++j)
#pragma unroll
                for (int k = 0; k < 4; ++k) { const f32x4 w0 = ((const LAS f32x4*)WR)[(j * 4 + k) * 64 + lane], w1 = ((const LAS f32x4*)WR)[1024 + (j * 4 + k) * 64 + lane]; const float tv = t[j][k];
                    lg[0] += tv * w0.x; lg[1] += tv * w0.y; lg[2] += tv * w0.z; lg[3] += tv * w0.w; lg[4] += tv * w1.x; lg[5] += tv * w1.y; lg[6] += tv * w1.z; lg[7] += tv * w1.w; }
#pragma unroll
            for (int e = 0; e < 8; ++e) lg[e] = wave_sum(lg[e]) + F.in[I_RB][e];
            int e1 = 0; float v1 = lg[0];
#pragma unroll
            for (int e = 1; e < 8; ++e) if (lg[e] > v1) { v1 = lg[e]; e1 = e; }
            int e2 = -1; float v2 = -INFINITY;
#pragma unroll
            for (int e = 0; e < 8; ++e) if (e != e1 && lg[e] > v2) { v2 = lg[e]; e2 = e; }
            const float g1 = 1.0f / (1.0f + expf(v2 - v1)), g2 = 1.0f - g1;
            if (lane == 0) { LAS int* rc = rec + rl * 6; rc[0] = e1; rc[1] = e2; rc[2] = (int)__hip_atomic_fetch_add((LAS unsigned*)(lcnt + e1), 1u, __ATOMIC_RELAXED, __HIP_MEMORY_SCOPE_WORKGROUP);
                rc[3] = (int)__hip_atomic_fetch_add((LAS unsigned*)(lcnt + e2), 1u, __ATOMIC_RELAXED, __HIP_MEMORY_SCOPE_WORKGROUP); rc[4] = __float_as_int(g1); rc[5] = __float_as_int(g2); }
        }
        LDS_WAIT(); __syncthreads();
        if (F.tid < 8) lbase[F.tid] = (int)__hip_atomic_fetch_add((unsigned*)(F.ctl + CW_CNT + 64 * F.tid), (unsigned)lcnt[F.tid], __ATOMIC_RELAXED, __HIP_MEMORY_SCOPE_AGENT);
        LDS_WAIT(); __syncthreads();
        if (F.tid < 64) { const LAS int* rc = rec + F.tid * 6; int* tk = TOK + (size_t)(rb * 64 + F.tid) * 6;
            tk[0] = rc[0]; tk[1] = rc[1]; tk[2] = lbase[rc[0]] + rc[2]; tk[3] = lbase[rc[1]] + rc[3]; tk[4] = rc[4]; tk[5] = rc[5]; }
#pragma unroll
        for (int i = 0; i < 8; ++i) { const int rl = F.wave * 8 + i; const LAS int* rc = rec + rl * 6; const v4u row = *(const LAS v4u*)(STG + rl * 1024 + 16 * lane);
            const int e1 = rc[0], e2 = rc[1], p1 = lbase[e1] + rc[2], p2 = lbase[e2] + rc[3];
            *(GAS v4u*)(XG + ((size_t)e1 * ML + p1) * D + 16 * lane) = row; *(GAS v4u*)(XG + ((size_t)e2 * ML + p2) * D + 16 * lane) = row; }
        LDS_WAIT(); __syncthreads();
    }
}
__device__ __forceinline__ void moe_offsets(Frame& F, int (&off)[9]) {
    int o = 0;
#pragma unroll
    for (int e = 0; e < 8; ++e) { off[e] = o; const int c = (int)__hip_atomic_load((unsigned*)(F.ctl + CW_CNT + 64 * e), __ATOMIC_RELAXED, __HIP_MEMORY_SCOPE_AGENT); o += (c + 255) & ~255; }
    off[8] = o;
}
__device__ __forceinline__ int moe_tables(Frame& F) {
    int off[9]; moe_offsets(F, off); LAS int* pexp = (LAS int*)(F.lds + PEXP_OFF);
    if (F.tid < MOE_PAN) { const int r = F.tid * 256; int e = 0;
#pragma unroll
        for (int q = 1; q < 8; ++q) e = (r >= off[q]) ? q : e;
        pexp[F.tid] = e; }
    if (F.tid < 8) pexp[140 + F.tid] = off[F.tid] / 256;
    __syncthreads();
    return off[8] / 256;
}
__device__ __forceinline__ void ph19_combine(Frame& F) {
    int off[9]; moe_offsets(F, off);
    const int gw = F.vcu * NWAVES + F.wave, NGW = F.G * NWAVES, lane = F.lane; const bf16* YG = (const bf16*)(F.ws + WS_YG); const int* TOK = (const int*)(F.ws + WS_TOK);
    const float* MOD = (const float*)(F.ws + WS_MOD) + (size_t)3 * 6 * D;
    for (int m = gw; m < ML; m += NGW) { const int* tk = TOK + (size_t)m * 6; const int e1 = tk[0], e2 = tk[1]; int b1 = 0, b2 = 0;
#pragma unroll
        for (int q = 0; q < 8; ++q) { b1 = (e1 == q) ? off[q] : b1; b2 = (e2 == q) ? off[q] : b2; }
        const float g1 = __int_as_float(tk[4]), g2 = __int_as_float(tk[5]); const float* gp = MOD + (m >> 13) * 6 * D + 5 * D;
        const GAS v2u* y1 = (const GAS v2u*)(YG + (size_t)(b1 + tk[2]) * D) + lane; const GAS v2u* y2 = (const GAS v2u*)(YG + (size_t)(b2 + tk[3]) * D) + lane;
        GAS f32x4* o = (GAS f32x4*)(F.out + (size_t)m * D) + lane; const GAS v2u* x3 = (const GAS v2u*)((const bf16*)(F.ws + WS_X3) + (size_t)m * D) + lane;
#pragma unroll
        for (int j = 0; j < 4; ++j) { const v2u a = y1[64 * j], b = y2[64 * j]; const f32x4 gv = ((const GAS f32x4*)gp)[lane + 64 * j]; const v2u xw = x3[64 * j]; f32x4 x = (f32x4){bf_lo(xw.x), bf_hi(xw.x), bf_lo(xw.y), bf_hi(xw.y)};
            x.x += gv.x * (g1 * bf_lo(a.x) + g2 * bf_lo(b.x)); x.y += gv.y * (g1 * bf_hi(a.x) + g2 * bf_hi(b.x)); x.z += gv.z * (g1 * bf_lo(a.y) + g2 * bf_lo(b.y)); x.w += gv.w * (g1 * bf_hi(a.y) + g2 * bf_hi(b.y));
            o[64 * j] = x; } }
}
struct Args { const float* in[38]; float* out; unsigned char* ws; int ph_lo, ph_hi; };
__global__ void __launch_bounds__(NWAVES * 64, 2) mk_fwd(Args args) {
    extern __shared__ __attribute__((aligned(16))) unsigned char lds[];
    Frame F;
    F.lds = (LAS unsigned char*)lds;
    F.MISC = (volatile LAS unsigned*)(F.lds + MISC_OFF);
    F.tid = threadIdx.x; F.lane = F.tid & 63; F.wave = __builtin_amdgcn_readfirstlane(F.tid >> 6);
    F.G = gridDim.x; { const int bx = blockIdx.x; F.vcu = (F.G % 8 == 0) ? (bx % 8) * (F.G / 8) + bx / 8 : bx; }
    F.ws = args.ws; F.out = args.out; F.ctl = (gu32*)(args.ws + WS_CTL);
    for (int u = F.tid; u < (LDS_BYTES - LDSCTL_OFF) / 4; u += NWAVES * 64) ((LAS unsigned*)(F.lds + LDSCTL_OFF))[u] = 0u;
    __syncthreads();
    XcdBarrier bar; bar.bar = (unsigned*)(F.ctl + CW_BAR); bar.x = 0; bar.st = nullptr;
    if (MK_ONE_LAUNCH) bar = xcd_barrier_post((unsigned*)(F.ctl + CW_BAR), F.MISC + 8);
#define GRID_BAR() do { if (MK_ONE_LAUNCH) xcd_barrier(bar); } while (0)
    const int lo = args.ph_lo, hi = args.ph_hi;
#define RELANE() do { int t_ = (int)threadIdx.x; asm volatile("" : "+v"(t_)); F.tid = t_; F.lane = t_ & 63; } while (0)
#ifndef MK_TPROBE
#define MK_TPROBE -1
#endif
#ifndef MK_TPK
#define MK_TPK 4
#endif
    unsigned long long tp0 = 0ull, tp1 = 0ull;
#define TP_BEGIN(k) do { if (MK_TPROBE == (k)) tp0 = __builtin_amdgcn_s_memrealtime(); } while (0)
#define TP_END(k) do { if (MK_TPROBE == (k)) tp1 = __builtin_amdgcn_s_memrealtime(); } while (0)
#define IN(k) (lo <= (k) && (k) < hi)
#define BOTH(k) (IN(k) && IN((k) + 1))
#ifndef MK_REP_MASK
#define MK_REP_MASK 0
#endif
#define REP(k) for (int rep_ = 0; rep_ < (((MK_REP_MASK >> (k)) & 1) ? 2 : 1); ++rep_)
    unsigned char* ws = args.ws;
    bf16* XN = (bf16*)(ws + WS_XN); bf16* Y = (bf16*)(ws + WS_Y); bf16* P0 = (bf16*)(ws + WS_P0); bf16* P1 = (bf16*)(ws + WS_P1); bf16* OA = (bf16*)(ws + WS_OATT); bf16* Hb = (bf16*)(ws + WS_H);
    bf16* XR = (bf16*)(ws + WS_XR); const float* MOD = (const float*)(ws + WS_MOD);
    using ABF = attn_body::bf16;

    if (IN(0)) { RELANE(); TP_BEGIN(0); REP(0) { ph0_prologue(F); __syncthreads(); } if (BOTH(0)) GRID_BAR();  TP_END(0); }
    if (IN(1)) { RELANE(); TP_BEGIN(1); REP(1) ph_normmod(F, F.in[I_X], F.in[I_CTX], MR, F.in[I_NMIXG], 0, 0, D); if (BOTH(1)) GRID_BAR();  TP_END(1); }
    if (IN(2)) { RELANE(); TP_BEGIN(2);
        pg8::Gemm g{XN, (const bf16*)(ws + WS_WE), MR, E_IN, D}; pg8::StaticOrder S; S.init(MR, E_IN, F.G, (int)blockIdx.x);
        pg8::EpiBf16<0> E{P0, E_IN, nullptr, 0, 0, 1.f};
        REP(2) pg8::gemm_phase<pg8::EpiBf16<0>, pg8::StaticOrder, PG8_ALIGN, PG8_SP2>(F.lds + RING_OFF, g, S, E);
        if (BOTH(2)) GRID_BAR();
        TP_END(2);
    }
    if (IN(3)) { RELANE(); TP_BEGIN(3); ph3_post0(F); if (BOTH(3)) GRID_BAR();  TP_END(3); }
    if (IN(4)) { RELANE(); TP_BEGIN(4);
        const bool nomax0 = qk_bounded(F.in[I_BQNG], F.in[I_BKNG], F.lane);
        const int trslot = F.vcu % 3;
        float lam; { const int ln = F.lane; const float s1 = wave_sum(F.in[I_LQ1][ln] * F.in[I_LK1][ln]), s2 = wave_sum(F.in[I_LQ2][ln] * F.in[I_LK2][ln]); lam = expf(s1) - expf(s2) + 0.2f; }
        REP(4) for (int i = 0;; ++i) { const int L = i * F.G + F.vcu; if (L >= 256 + 8) break;
            const bool lat = L < 256; const int bh4 = lat ? (L >> 5) : (L - 256), qb = lat ? (L & 31) : 0, b = bh4 >> 2, h = bh4 & 3;
            const size_t qrow0 = lat ? (size_t)b * SEQ + (size_t)qb * 256 : (size_t)(ML + b * CTXL); const int NT = lat ? 132 : 4, rot = lat ? (F.vcu & 31) * 4 : 0;
            const ABF* Vs = (const ABF*)(ws + WS_VC0) + (size_t)(b * 8 + 2 * h) * KEYS * 64; ABF* O1 = (ABF*)(OA + qrow0 * D + 256 * h); ABF* Yo = (ABF*)(Y + qrow0 * D + 512 + 128 * h);
#pragma unroll 1
            for (int sc = 0; sc < 3; ++sc) {
                if (lat && sc == trslot && rep_ == 0) { tr_range(F, TR_DENSE, TR_NITEMS); LDS_WAIT(); __syncthreads(); }
                if (sc < 2) { const ABF* Ks = (const ABF*)(ws + WS_KC0) + (size_t)(b * 8 + 2 * h + sc) * KEYS * 64; const ABF* Q = (const ABF*)(P0 + qrow0 * E_IN + 1024 + 128 * h + 64 * sc);
                    if (sc == 1) VM_WAIT();
                    if (nomax0) attn_body::attn_unit2<-1>(Q, E_IN, Ks, Vs, Vs + (size_t)KEYS * 64, sc ? Yo : O1, D, NT, rot, (char*)lds + RING_OFF, sc == 1, O1, D, lam, F.in[I_SUBLNG], 0.8f);
                    else attn_body::attn_unit2<8>(Q, E_IN, Ks, Vs, Vs + (size_t)KEYS * 64, sc ? Yo : O1, D, NT, rot, (char*)lds + RING_OFF, sc == 1, O1, D, lam, F.in[I_SUBLNG], 0.8f); } } }
        RELANE();
        REP(4) for (int c = F.vcu - 32; c >= 0 && c < MR / 128; c += F.G) gmlp_unit(F, c);
        if (BOTH(4)) GRID_BAR();
        TP_END(4);
    }
    if (IN(6)) { RELANE(); TP_BEGIN(6);
        pg8::Gemm g{Y, (const bf16*)(ws + WS_WO0), MR, D, D}; pg8::StaticOrder S; S.init(MR, D, F.G, (int)blockIdx.x);
        pg8::EpiResGate<false, true> E{F.in[I_X], F.in[I_CTX], XR, MOD + 2 * D, 1.0f};
        REP(6) pg8::gemm_phase<pg8::EpiResGate<false, true>, pg8::StaticOrder, PG8_ALIGN, PG8_SP2>(F.lds + RING_OFF, g, S, E);
        if (BOTH(6)) GRID_BAR();
        TP_END(6);
    }
    if (IN(7)) { RELANE(); TP_BEGIN(7); REP(7) ph_normmod<true, true>(F, (const float*)XR, (const float*)(XR + (size_t)ML * D), MR, F.in[I_NFFNG], 0, 3 * D, 4 * D); if (BOTH(7)) GRID_BAR();  TP_END(7); }
    if (IN(8)) { RELANE(); TP_BEGIN(8);
        pg8::Gemm g{XN, (const bf16*)(ws + WS_WF13), MR, FF2, D / 2}; pg8::StaticOrder S; S.init(MR, FF2, F.G, (int)blockIdx.x);
        pg8::EpiSwiGLUF8 E{(unsigned char*)Hb, FF, FF2 / 256, 1.0f / MOE_S13};
        REP(8) pg8::gemm_phase<pg8::EpiSwiGLUF8, pg8::StaticOrder, PG8_ALIGN, PG8_SP2, true>(F.lds + RING_OFF, g, S, E);
        if (BOTH(8)) GRID_BAR();
        TP_END(8);
    }
    if (IN(9)) { RELANE(); TP_BEGIN(9);
        pg8::Gemm g{Hb, (const bf16*)(ws + WS_WF2), MR, D, FF / 2}; pg8::StaticOrder S; S.init(MR, D, F.G, (int)blockIdx.x);
        pg8::EpiResGate<true, true> E{XR, XR + (size_t)ML * D, XR, MOD + 5 * D, 1.0f / MOE_S2};
        REP(9) pg8::gemm_phase<pg8::EpiResGate<true, true>, pg8::StaticOrder, PG8_ALIGN, PG8_SP2, true>(F.lds + RING_OFF, g, S, E);
        if (BOTH(9)) GRID_BAR();
        TP_END(9);
    }
    if (IN(10)) { RELANE(); TP_BEGIN(10); REP(10) ph_normmod<false, true>(F, (const float*)XR, (const float*)(XR + (size_t)ML * D), MR, F.in[I_NMIXG] + D, 1, 0, D); if (BOTH(10)) GRID_BAR();  TP_END(10); }
    if (IN(11)) { RELANE(); TP_BEGIN(11);
        pg8::Gemm g{XN, (const bf16*)(ws + WS_WOI), MR, O_IN, D}; pg8::StaticOrder S; S.init(MR, O_IN, F.G, (int)blockIdx.x);
        pg8::EpiBf16<0> E{P1, O_IN, nullptr, 0, 0, 1.f};
        REP(11) pg8::gemm_phase<pg8::EpiBf16<0>, pg8::StaticOrder, PG8_ALIGN, PG8_SP2>(F.lds + RING_OFF, g, S, E);
        if (BOTH(11)) GRID_BAR();
        TP_END(11);
    }
    if (IN(12)) { RELANE(); TP_BEGIN(12);
        ph12_post1(F);
        REP(12) for (int c = F.vcu; c < NCHUNK; c += F.G) scan_prep_unit(F, c);
        if (BOTH(12)) GRID_BAR();
        TP_END(12);
    }
    if (IN(13)) { RELANE(); TP_BEGIN(13);
        REP(13) for (int c = F.vcu; c < ML / 64; c += F.G) scan_fix_unit(F, c);
        const bool nomax1 = qk_bounded(F.in[I_CQNG], F.in[I_CKNG], F.lane);
        REP(13) for (int i = 0;; ++i) { const int L = i * F.G + F.vcu; if (L >= 512) break;
            const int bh = L >> 5, qb = L & 31, b = bh >> 3, hq = bh & 7, kv = hq >> 2;
            const size_t crow0 = (size_t)(ML + b * CTXL), lrow0 = (size_t)b * SEQ, qrow0 = lrow0 + (size_t)qb * 256;
            const ABF* Ks = (const ABF*)(ws + WS_KC1) + (size_t)(b * 2 + kv) * KEYS * 64; const ABF* Vs = (const ABF*)(ws + WS_VC1) + (size_t)(b * 2 + kv) * KEYS * 64;
            if (nomax1) attn_body::attn_unit<-1, true>((const ABF*)(P1 + qrow0 * O_IN + 64 * hq), O_IN, Ks, Ks + 4 * 4096, 64, Vs, Vs + 4 * 4096, 64, (ABF*)(Y + qrow0 * D + 64 * hq), D, 132, 4, (F.vcu & 31) * 4, (char*)lds + RING_OFF);
            else attn_body::attn_unit<8, true>((const ABF*)(P1 + qrow0 * O_IN + 64 * hq), O_IN, Ks, Ks + 4 * 4096, 64, Vs, Vs + 4 * 4096, 64, (ABF*)(Y + qrow0 * D + 64 * hq), D, 132, 4, (F.vcu & 31) * 4, (char*)lds + RING_OFF); }
        if (BOTH(13)) GRID_BAR();
        TP_END(13);
    }
    if (IN(14)) { RELANE(); TP_BEGIN(14);
        pg8::Gemm g{Y, (const bf16*)(ws + WS_WO1), ML, D, D}; pg8::StaticOrder S; S.init(ML, D, F.G, (int)blockIdx.x);
        pg8::EpiResGate<true, true> E{XR, XR, (bf16*)(ws + WS_X3), MOD + 3 * 6 * D + 2 * D, 1.0f};
        REP(14) pg8::gemm_phase<pg8::EpiResGate<true, true>, pg8::StaticOrder, PG8_ALIGN, PG8_SP2>(F.lds + RING_OFF, g, S, E);
        if (BOTH(14)) GRID_BAR();
        TP_END(14);
    }
    if (IN(15)) { RELANE(); TP_BEGIN(15); ph15_router(F); if (BOTH(15)) GRID_BAR();  TP_END(15); }
    if (IN(17)) { RELANE(); TP_BEGIN(17);
        const int npan = moe_tables(F);
        pg8::Gemm g{(const bf16*)(ws + WS_XG), (const bf16*)(ws + WS_WM13), MOE_ROWS, NEXP * FF2, D / 2}; pg8::MoeOrder S{npan, FF2 / 256, F.G, F.vcu, (const LAS int*)(F.lds + PEXP_OFF), true};
        pg8::EpiSwiGLUF8 E{ws + WS_HG, FF, FF2 / 256, 1.0f / MOE_S13};
        REP(17) pg8::gemm_phase<pg8::EpiSwiGLUF8, pg8::MoeOrder, PG8_ALIGN, PG8_SP2, true>(F.lds + RING_OFF, g, S, E);
        if (BOTH(17)) GRID_BAR();
        TP_END(17);
    }
    if (IN(18)) { RELANE(); TP_BEGIN(18);
        const int npan = moe_tables(F);
        pg8::Gemm g{(const bf16*)(ws + WS_HG), (const bf16*)(ws + WS_WM2), MOE_ROWS, NEXP * D, FF / 2}; pg8::MoeOrder S{npan, D / 256, F.G, F.vcu, (const LAS int*)(F.lds + PEXP_OFF), false};
        pg8::EpiBf16S E{(bf16*)(ws + WS_YG), D, D / 256, 1.0f / MOE_S2};
        REP(18) pg8::gemm_phase<pg8::EpiBf16S, pg8::MoeOrder, PG8_ALIGN, PG8_SP2, true>(F.lds + RING_OFF, g, S, E);
        if (BOTH(18)) GRID_BAR();
        TP_END(18);
    }
    if (IN(19)) { RELANE(); TP_BEGIN(19); ph19_combine(F);  TP_END(19); }
    if (MK_TPROBE >= 0 && blockIdx.x == 0 && threadIdx.x == 0) { const unsigned long long tgt = __builtin_amdgcn_s_memrealtime() + (unsigned long long)MK_TPK * (tp1 - tp0); while (__builtin_amdgcn_s_memrealtime() < tgt) __builtin_amdgcn_s_sleep(20); }
#undef IN
#undef BOTH
#undef GRID_BAR
}

extern "C" void kernel_launch(void* const* d_in, const int* in_sizes, int n_in, void* d_out, int out_size, void* d_ws, size_t ws_size, hipStream_t stream) {
    static int grid = 0;
    if (grid == 0) {
        if (n_in != 38 || in_sizes[0] != ML * D || out_size != ML * D || ws_size < WS_END) { fprintf(stderr, "kernel_launch: built for 38 inputs, x/out of %d floats, >= %zu bytes of workspace; got n_in %d, in0 %d, out %d, ws %zu; nothing launched\n", ML * D, (size_t)WS_END, n_in, n_in > 0 ? in_sizes[0] : -1, out_size, ws_size); grid = -1; return; }
        int dev = 0, cus = 0, per_cu = 0;
        if (hipGetDevice(&dev) != hipSuccess || hipDeviceGetAttribute(&cus, hipDeviceAttributeMultiprocessorCount, dev) != hipSuccess) { fprintf(stderr, "kernel_launch: device query failed\n"); grid = -1; return; }
        if (hipFuncSetAttribute((const void*)mk_fwd, hipFuncAttributeMaxDynamicSharedMemorySize, LDS_BYTES) != hipSuccess) { fprintf(stderr, "kernel_launch: hipFuncSetAttribute failed\n"); grid = -1; return; }
        if (hipOccupancyMaxActiveBlocksPerMultiprocessor(&per_cu, (const void*)mk_fwd, NWAVES * 64, LDS_BYTES) != hipSuccess || per_cu < 1) fprintf(stderr, "kernel_launch: note: occupancy query reports %d workgroups per CU\n", per_cu);
        (void)hipGetLastError();
        grid = cus;
    }
    if (grid < 0) return;
    if (hipMemsetAsync((char*)d_ws + WS_CTL, 0, CTL_ZERO_BYTES, stream) != hipSuccess) { fprintf(stderr, "kernel_launch: hipMemsetAsync failed\n"); return; }
    Args a{};
    for (int i = 0; i < 38; ++i) a.in[i] = (const float*)d_in[i];
    a.out = (float*)d_out; a.ws = (unsigned char*)d_ws;
#if MK_ONE_LAUNCH
    a.ph_lo = 0; a.ph_hi = NPH;
    hipLaunchKernelGGL(mk_fwd, dim3(grid), dim3(NWAVES * 64), LDS_BYTES, stream, a);
#else
    for (int ph = 0; ph < NPH; ++ph) { a.ph_lo = ph; a.ph_hi = ph + 1; hipLaunchKernelGGL(mk_fwd, dim3(grid), dim3(NWAVES * 64), LDS_BYTES, stream, a); }
#endif
    const hipError_t le = hipPeekAtLastError();
    if (le != hipSuccess) fprintf(stderr, "kernel_launch: launch failed: %s\n", hipGetErrorName(le));
}
```

```cpp
#include <hip/hip_runtime.h>
#include <cstdio>
#include <cstdint>
#include <cmath>
namespace pg8 {
#define PG8_LAS __attribute__((address_space(3)))
typedef unsigned short bf16_t;
typedef short bf16x8 __attribute__((ext_vector_type(8)));
typedef float f32x4 __attribute__((ext_vector_type(4)));
typedef unsigned u32x4 __attribute__((ext_vector_type(4)));
typedef int i32x4 __attribute__((ext_vector_type(4)));
typedef int i32x8 __attribute__((ext_vector_type(8)));
typedef unsigned u32x2 __attribute__((ext_vector_type(2)));
constexpr int BM = 256, BK = 64, HALF = 128, HTB = HALF * BK * 2  , STAGE_BYTES = 8 * HTB, NXCD = 8, WGM = 8;

__host__ __device__ __forceinline__ int lds_byte(int r, int c) { const int st = (r >> 4) * 2 + (c >> 5), rr = r & 15, cc = c & 31, ob = rr * 64 + cc * 2; return st * 1024 + (ob ^ (((ob >> 9) & 1) << 5)); }
__host__ __device__ __forceinline__ void stage_rc(int b, int& R, int& C) { const int st = b / 1024, sb = b % 1024, swz = sb ^ (((sb >> 9) & 1) << 5); R = (st >> 1) * 16 + swz / 64; C = (st & 1) * 32 + (swz % 64) / 2; }
__host__ __device__ __forceinline__ int perm32(int rho) { const int n = rho >> 4, i = rho & 15; return 8 * (i >> 2) + 4 * n + (i & 3); }

struct Unit { int pm, pn, pa; };
struct Gemm { const bf16_t* A; const bf16_t* Bt; int M, N, K; };

struct StaticOrder {
    int nM, nN, nwg, G, c;
    __host__ __device__ void init(int M, int N, int G_, int c_) { nM = M / BM; nN = N / BM; nwg = nM * nN; G = G_; c = c_; }
    __host__ __device__ bool next(int i, Unit& u) const {
        const long L = (long)i * G + c; if (L >= nwg) return false;
        int wgid = (int)L; { const int q = nwg / NXCD, r = nwg % NXCD, xcd = wgid % NXCD, off = wgid / NXCD; wgid = (xcd < r ? xcd * (q + 1) : r * (q + 1) + (xcd - r) * q) + off; }
        const int nig = WGM * nN, gid = wgid / nig, fm = gid * WGM, gsz = (nM - fm) < WGM ? (nM - fm) : WGM;
        u.pm = fm + ((wgid % nig) % gsz); u.pn = (wgid % nig) / gsz; u.pa = u.pm; return true;
    }
    __device__ __forceinline__ void a_ready(const Unit&) const {}
    __device__ __forceinline__ void done(const Unit&) const {}
};

__device__ __forceinline__ unsigned cvt_pk_bf16(float lo, float hi) { unsigned r; asm volatile("v_cvt_pk_bf16_f32 %0, %1, %2" : "=v"(r) : "v"(lo), "v"(hi)); return r; }
typedef float f32x2 __attribute__((ext_vector_type(2)));
__device__ __forceinline__ f32x2 gelu_pk(f32x2 v) {
    const f32x2 av = __builtin_elementwise_abs(v), d = av * 0.2316418882f + 1.0f;
    f32x2 t; t.x = __builtin_amdgcn_rcpf(d.x); t.y = __builtin_amdgcn_rcpf(d.y);
    f32x2 q = t * 0.5307027145f + (-0.7265760135f); q = q * t + 0.7107068705f; q = q * t + (-0.142248368f); q = q * t + 0.127414796f; q = q * t;
    const f32x2 s = (v * v) * (-0.72134752044f);
    f32x2 e; e.x = __builtin_amdgcn_exp2f(s.x); e.y = __builtin_amdgcn_exp2f(s.y);
    const f32x2 m = v * (q * e), r = v - m;
    f32x2 o; o.x = v.x < 0.f ? m.x : r.x; o.y = v.y < 0.f ? m.y : r.y; return o;
}

template <int ACT  > struct EpiBf16 {
    static constexpr bool PERM = true, AFTER_DRAIN = false; static_assert(ACT == 0 || ACT == 1, "EpiBf16: ACT is 0 (none) or 1 (gelu_pk)");
    bf16_t* O; int ldc; const float* bias; int split_cols; size_t split_stride; float scale0;
    __device__ __forceinline__ void operator()(const f32x4 (&acc)[2][2][4][2], const Unit& u, int wr, int wc, int fr, int fq) const {
        const int row0 = u.pm * BM + wr * 64 + fr; int colt = u.pn * BM; bf16_t* base = O;
        float sc = 1.f; if (split_cols) { const int t = colt / split_cols; base += (size_t)t * split_stride; colt -= t * split_cols; if (t == 0) sc = scale0; }
        const int col0 = colt + wc * 32 + 8 * fq, bcol0 = u.pn * BM + wc * 32 + 8 * fq;
        f32x4 bv[2][2];
#pragma unroll
        for (int bj = 0; bj < 2; ++bj)
#pragma unroll
            for (int n = 0; n < 2; ++n) bv[bj][n] = bias ? *(const f32x4*)(bias + bcol0 + bj * HALF + 4 * n) : (f32x4){0.f, 0.f, 0.f, 0.f};
#pragma unroll
        for (int ai = 0; ai < 2; ++ai)
#pragma unroll
            for (int m = 0; m < 4; ++m) { bf16_t* rowp = base + (size_t)(row0 + ai * HALF + m * 16) * ldc + col0;
#pragma unroll
                for (int bj = 0; bj < 2; ++bj) { f32x4 v0 = acc[ai][bj][m][0] + bv[bj][0], v1 = acc[ai][bj][m][1] + bv[bj][1];
                    if (ACT == 1) { f32x2 a = gelu_pk((f32x2){v0[0], v0[1]}), b = gelu_pk((f32x2){v0[2], v0[3]}), c = gelu_pk((f32x2){v1[0], v1[1]}), d = gelu_pk((f32x2){v1[2], v1[3]});
                        v0 = (f32x4){a.x, a.y, b.x, b.y}; v1 = (f32x4){c.x, c.y, d.x, d.y}; }
                    v0 = v0 * sc; v1 = v1 * sc; u32x4 w; w.x = cvt_pk_bf16(v0[0], v0[1]); w.y = cvt_pk_bf16(v0[2], v0[3]); w.z = cvt_pk_bf16(v1[0], v1[1]); w.w = cvt_pk_bf16(v1[2], v1[3]);
                    *(u32x4*)(rowp + bj * HALF) = w; } }
    }
};
template <bool B16, bool O16> struct EpiResGate {
    static constexpr bool PERM = true, AFTER_DRAIN = false;
    const void* baseL; const void* baseC; void* out; const float* gate; float ascale;
    __device__ __forceinline__ void operator()(const f32x4 (&acc)[2][2][4][2], const Unit& u, int wr, int wc, int fr, int fq) const {
        const int st = u.pm < 32 ? 0 : (u.pm < 64 ? 1 : 2);
        const float* gp = gate + st * 6144;
        const size_t prow = u.pm < 64 ? (size_t)u.pm * BM : (size_t)(u.pm - 64) * BM; const void* base = u.pm < 64 ? baseL : baseC;
        const int col0 = u.pn * BM + wc * 32 + 8 * fq;
        f32x4 gv[2][2];
#pragma unroll
        for (int bj = 0; bj < 2; ++bj)
#pragma unroll
            for (int n = 0; n < 2; ++n) gv[bj][n] = *(const f32x4*)(gp + col0 + bj * HALF + 4 * n) * ascale;
#pragma unroll
        for (int ai = 0; ai < 2; ++ai)
#pragma unroll
            for (int m = 0; m < 4; ++m) { const int rl = ai * HALF + wr * 64 + m * 16 + fr; const size_t boff = (prow + rl) * 1024 + col0, ooff = ((size_t)u.pm * BM + rl) * 1024 + col0;
#pragma unroll
                for (int bj = 0; bj < 2; ++bj) { f32x4 b0, b1;
                    if constexpr (B16) { const u32x4 w = *(const u32x4*)((const bf16_t*)base + boff + bj * HALF);
                        b0 = (f32x4){__builtin_bit_cast(float, w.x << 16), __builtin_bit_cast(float, w.x & 0xffff0000u), __builtin_bit_cast(float, w.y << 16), __builtin_bit_cast(float, w.y & 0xffff0000u)};
                        b1 = (f32x4){__builtin_bit_cast(float, w.z << 16), __builtin_bit_cast(float, w.z & 0xffff0000u), __builtin_bit_cast(float, w.w << 16), __builtin_bit_cast(float, w.w & 0xffff0000u)}; }
                    else { b0 = *(const f32x4*)((const float*)base + boff + bj * HALF); b1 = *(const f32x4*)((const float*)base + boff + bj * HALF + 4); }
                    const f32x4 v0 = b0 + gv[bj][0] * acc[ai][bj][m][0], v1 = b1 + gv[bj][1] * acc[ai][bj][m][1];
                    if constexpr (O16) { u32x4 w; w.x = cvt_pk_bf16(v0[0], v0[1]); w.y = cvt_pk_bf16(v0[2], v0[3]); w.z = cvt_pk_bf16(v1[0], v1[1]); w.w = cvt_pk_bf16(v1[2], v1[3]); *(u32x4*)((bf16_t*)out + ooff + bj * HALF) = w; }
                    else { *(f32x4*)((float*)out + ooff + bj * HALF) = v0; *(f32x4*)((float*)out + ooff + bj * HALF + 4) = v1; } }
                if (m & 1) asm volatile("" ::: "memory"); }
    }
};
struct EpiSwiGLU {
    static constexpr bool PERM = true, AFTER_DRAIN = false;
    bf16_t* H; int ldh; int ntl;
    __device__ __forceinline__ void operator()(const f32x4 (&acc)[2][2][4][2], const Unit& u, int wr, int wc, int fr, int fq) const {
        const int row0 = u.pm * BM + wr * 64 + fr; const int ct = u.pn % ntl; const int col0 = ct * HALF + wc * 32 + 8 * fq;
#pragma unroll
        for (int ai = 0; ai < 2; ++ai)
#pragma unroll
            for (int m = 0; m < 4; ++m) { bf16_t* rowp = H + (size_t)(row0 + ai * HALF + m * 16) * ldh + col0;
                float hv[8];
#pragma unroll
                for (int n = 0; n < 2; ++n)
#pragma unroll
                    for (int j = 0; j < 4; ++j) { const float a = acc[ai][0][m][n][j], b = acc[ai][1][m][n][j];
                        const float e = __builtin_amdgcn_exp2f(a * -1.4426950408889634f); hv[n * 4 + j] = a * __builtin_amdgcn_rcpf(1.0f + e) * b; }
                u32x4 w; w.x = cvt_pk_bf16(hv[0], hv[1]); w.y = cvt_pk_bf16(hv[2], hv[3]); w.z = cvt_pk_bf16(hv[4], hv[5]); w.w = cvt_pk_bf16(hv[6], hv[7]);
                *(u32x4*)rowp = w; }
    }
};
__device__ __forceinline__ unsigned cvt4_fp8(float a, float b, float c, float d) { unsigned w = 0u; w = (unsigned)__builtin_amdgcn_cvt_pk_fp8_f32(a, b, (int)w, false); w = (unsigned)__builtin_amdgcn_cvt_pk_fp8_f32(c, d, (int)w, true); return w; }
struct EpiSwiGLUF8 {
    static constexpr bool PERM = true, AFTER_DRAIN = false;
    unsigned char* H; int ldh; int ntl; float s;
    __device__ __forceinline__ void operator()(const f32x4 (&acc)[2][2][4][2], const Unit& u, int wr, int wc, int fr, int fq) const {
        const int row0 = u.pm * BM + wr * 64 + fr; const int ct = u.pn % ntl; const int col0 = ct * HALF + wc * 32 + 8 * fq;
#pragma unroll
        for (int ai = 0; ai < 2; ++ai)
#pragma unroll
            for (int m = 0; m < 4; ++m) { unsigned char* rowp = H + (size_t)(row0 + ai * HALF + m * 16) * ldh + col0;
                float hv[8];
#pragma unroll
                for (int n = 0; n < 2; ++n)
#pragma unroll
                    for (int j = 0; j < 4; ++j) { const float a = acc[ai][0][m][n][j], b = acc[ai][1][m][n][j];
                        const float e = __builtin_amdgcn_exp2f(a * (s * -1.4426950408889634f)); hv[n * 4 + j] = (a * b) * (s * s) * __builtin_amdgcn_rcpf(1.0f + e); }
                u32x2 w; w.x = cvt4_fp8(hv[0], hv[1], hv[2], hv[3]); w.y = cvt4_fp8(hv[4], hv[5], hv[6], hv[7]);
                *(u32x2*)rowp = w; }
    }
};
struct EpiBf16S {
    static constexpr bool PERM = true, AFTER_DRAIN = false;
    bf16_t* O; int ldc; int ntl; float s;
    __device__ __forceinline__ void operator()(const f32x4 (&acc)[2][2][4][2], const Unit& u, int wr, int wc, int fr, int fq) const {
        const int row0 = u.pm * BM + wr * 64 + fr; const int col0 = (u.pn % ntl) * BM + wc * 32 + 8 * fq;
#pragma unroll
        for (int ai = 0; ai < 2; ++ai)
#pragma unroll
            for (int m = 0; m < 4; ++m) { bf16_t* rowp = O + (size_t)(row0 + ai * HALF + m * 16) * ldc + col0;
#pragma unroll
                for (int bj = 0; bj < 2; ++bj) { const f32x4 v0 = acc[ai][bj][m][0] * s, v1 = acc[ai][bj][m][1] * s;
                    u32x4 w; w.x = cvt_pk_bf16(v0[0], v0[1]); w.y = cvt_pk_bf16(v0[2], v0[3]); w.z = cvt_pk_bf16(v1[0], v1[1]); w.w = cvt_pk_bf16(v1[2], v1[3]);
                    *(u32x4*)(rowp + bj * HALF) = w; } }
    }
};
struct MoeOrder {
    int npan, ntl, G, c; const PG8_LAS int* pexp; bool capA;
    __device__ __forceinline__ bool next(int i, Unit& u) const {
        const long L = (long)i * G + c; if (L >= (long)npan * ntl) return false;
        const int pm = (int)(L / ntl), j = (int)(L % ntl); const int e = __builtin_amdgcn_readfirstlane(pexp[pm]); u.pm = pm; u.pn = e * ntl + j; u.pa = capA ? 64 * e + pm - __builtin_amdgcn_readfirstlane(pexp[140 + e]) : pm; return true;
    }
    __device__ __forceinline__ void a_ready(const Unit&) const {}
    __device__ __forceinline__ void done(const Unit&) const {}
};
template <class Epi, class Sched, bool ALIGN_EPI = false, bool SP2 = false, bool FP8 = false>
__device__ __forceinline__ void gemm_phase(PG8_LAS unsigned char* lds, const Gemm g, const Sched& S, const Epi& E) {
    const int tid = threadIdx.x, wid = __builtin_amdgcn_readfirstlane(tid >> 6), lane = tid & 63, wr = wid >> 2, wc = wid & 3, fr = lane & 15, fq = lane >> 4;
    const int K = g.K, nt = K / BK;
    unsigned voffA[2], voffB[2];
#pragma unroll
    for (int i = 0; i < 2; ++i) { int R, C; stage_rc(tid * 16 + i * 8192, R, C); const int Rb = Epi::PERM ? ((R & ~31) + perm32(R & 31)) : R;
        voffA[i] = (unsigned)(R * K + C) * 2u; voffB[i] = (unsigned)(Rb * K + C) * 2u; }
    const size_t kstep = (size_t)(BK * 2);
    const size_t hstep = (size_t)HALF * K * 2;
    const size_t tstep = 2 * hstep;
    const unsigned ldsw = (unsigned)wid * 1024u;
    const int aoff = lds_byte(wr * 64 + fr, fq * 8), boff = lds_byte(wc * 32 + fr, fq * 8);
#define PG8_SA(b, h) (((b) * 2 + (h)) * HTB)
#define PG8_SB(b, h) ((4 + (b) * 2 + (h)) * HTB)
#define PG8_STAGE(bufoff, gbase, voff) do { _Pragma("unroll") for (int _i = 0; _i < 2; ++_i) \
        __builtin_amdgcn_global_load_lds((const unsigned*)((const char*)(gbase) + (voff)[_i]), (PG8_LAS unsigned*)(lds + (bufoff) + ldsw + _i * 8192), 16, 0, 0); } while (0)
#define PG8_CAT(x, y) __builtin_shufflevector(__builtin_bit_cast(i32x4, x), __builtin_bit_cast(i32x4, y), 0, 1, 2, 3, 4, 5, 6, 7)
#define PG8_LDA(dst, b, h) do { if constexpr (FP8) { _Pragma("unroll") for (int m = 0; m < 4; ++m) dst##8[m] = PG8_CAT(*(const PG8_LAS bf16x8*)(lds + PG8_SA(b, h) + aoff + m * 2048), *(const PG8_LAS bf16x8*)(lds + PG8_SA(b, h) + aoff + m * 2048 + 1024)); } else { \
        _Pragma("unroll") for (int m = 0; m < 4; ++m) _Pragma("unroll") for (int k = 0; k < 2; ++k) dst[m][k] = *(const PG8_LAS bf16x8*)(lds + PG8_SA(b, h) + aoff + m * 2048 + k * 1024); } } while (0)
#define PG8_LDB(dst, b, h) do { if constexpr (FP8) { _Pragma("unroll") for (int n = 0; n < 2; ++n) dst##8[n] = PG8_CAT(*(const PG8_LAS bf16x8*)(lds + PG8_SB(b, h) + boff + n * 2048), *(const PG8_LAS bf16x8*)(lds + PG8_SB(b, h) + boff + n * 2048 + 1024)); } else { \
        _Pragma("unroll") for (int n = 0; n < 2; ++n) _Pragma("unroll") for (int k = 0; k < 2; ++k) dst[n][k] = *(const PG8_LAS bf16x8*)(lds + PG8_SB(b, h) + boff + n * 2048 + k * 1024); } } while (0)
#define PG8_MMA(ai, bj, At, Bt) do { __builtin_amdgcn_s_setprio(1); if constexpr (FP8) { _Pragma("unroll") for (int m = 0; m < 4; ++m) _Pragma("unroll") for (int n = 0; n < 2; ++n) \
        asm volatile("v_mfma_f32_16x16x128_f8f6f4 %0, %1, %2, %0" : "+v"(acc[ai][bj][m][n]) : "v"(Bt##8[n]), "v"(At##8[m]));   } else { \
        _Pragma("unroll") for (int m = 0; m < 4; ++m) _Pragma("unroll") for (int n = 0; n < 2; ++n) _Pragma("unroll") for (int k = 0; k < 2; ++k) \
        acc[ai][bj][m][n] = __builtin_amdgcn_mfma_f32_16x16x32_bf16(Bt[n][k], At[m][k], acc[ai][bj][m][n], 0, 0, 0); } __builtin_amdgcn_s_setprio(0); } while (0)
#define PG8_WAIT_V(n) asm volatile("s_waitcnt vmcnt(" #n ")" ::: "memory")
#define PG8_WAIT_L(n) asm volatile("s_waitcnt lgkmcnt(" #n ")" ::: "memory")
#define PG8_BAR __builtin_amdgcn_s_barrier()
#define PG8_SCHED __builtin_amdgcn_sched_barrier(0)
    Unit cur, nxt; int ui = 0;
    if (!S.next(0, cur)) return;
    f32x4 acc[2][2][4][2];
#pragma unroll
    for (int a = 0; a < 2; ++a)
#pragma unroll
        for (int b = 0; b < 2; ++b)
#pragma unroll
            for (int m = 0; m < 4; ++m)
#pragma unroll
                for (int n = 0; n < 2; ++n) acc[a][b][m][n] = (f32x4){0.f, 0.f, 0.f, 0.f};
    bf16x8 At[4][2], B0[2][2], B1[2][2]; i32x8 At8[4], B08[2], B18[2];
    const char* cA = (const char*)g.A + (size_t)cur.pa * tstep; const char* cB = (const char*)g.Bt + (size_t)cur.pn * tstep;
    S.a_ready(cur);
    if constexpr (SP2) {
        PG8_STAGE(PG8_SB(0, 0), cB, voffB); PG8_STAGE(PG8_SB(0, 1), cB + hstep, voffB); PG8_STAGE(PG8_SA(0, 0), cA, voffA); PG8_STAGE(PG8_SA(0, 1), cA + hstep, voffA);
        if (wr == 1) PG8_BAR;
        PG8_WAIT_V(2); PG8_BAR;
        PG8_STAGE(PG8_SB(1, 0), cB + kstep, voffB); PG8_STAGE(PG8_SA(1, 0), cA + kstep, voffA); PG8_STAGE(PG8_SB(1, 1), cB + hstep + kstep, voffB);
        PG8_WAIT_V(6); PG8_BAR;
    } else {
        PG8_STAGE(PG8_SB(0, 0), cB, voffB); PG8_STAGE(PG8_SA(0, 0), cA, voffA); PG8_STAGE(PG8_SB(0, 1), cB + hstep, voffB); PG8_STAGE(PG8_SA(0, 1), cA + hstep, voffA);
        if (wr == 1) PG8_BAR;
        PG8_WAIT_V(4); PG8_BAR;
        PG8_STAGE(PG8_SB(1, 0), cB + kstep, voffB); PG8_STAGE(PG8_SA(1, 0), cA + kstep, voffA); PG8_STAGE(PG8_SB(1, 1), cB + hstep + kstep, voffB);
        PG8_WAIT_V(6); PG8_BAR;
    }
    for (;;) {
        const bool has_next = S.next(ui + 1, nxt);
        const char* nA = has_next ? (const char*)g.A + (size_t)nxt.pa * tstep : cA; const char* nB = has_next ? (const char*)g.Bt + (size_t)nxt.pn * tstep : cB;
#pragma unroll 1
        for (int t = 0; t < nt; t += 2) {
            const bool last = (t == nt - 2);
            const char* a1 = cA + (size_t)(t + 1) * kstep;
            const char* a2 = last ? nA : cA + (size_t)(t + 2) * kstep; const char* b2 = last ? nB : cB + (size_t)(t + 2) * kstep;
            const char* a3 = a2 + kstep; const char* b3 = b2 + kstep;
            if (last && has_next) S.a_ready(nxt);
            if constexpr (SP2) {
            PG8_LDB(B0, 0, 0); PG8_LDB(B1, 0, 1); PG8_SCHED; PG8_LDA(At, 0, 0); PG8_STAGE(PG8_SA(1, 1), a1 + hstep, voffA);
            PG8_WAIT_V(8); PG8_WAIT_L(0); PG8_BAR; PG8_MMA(0, 0, At, B0); PG8_MMA(0, 1, At, B1); PG8_BAR; PG8_SCHED;
            PG8_LDA(At, 0, 1); PG8_STAGE(PG8_SB(0, 0), b2, voffB); PG8_STAGE(PG8_SB(0, 1), b2 + hstep, voffB); PG8_STAGE(PG8_SA(0, 0), a2, voffA);
            PG8_WAIT_V(8); PG8_WAIT_L(0); PG8_BAR; PG8_MMA(1, 0, At, B0); PG8_MMA(1, 1, At, B1); PG8_BAR; PG8_SCHED;
            PG8_LDB(B0, 1, 0); PG8_LDB(B1, 1, 1); PG8_SCHED; PG8_LDA(At, 1, 0); PG8_STAGE(PG8_SA(0, 1), a2 + hstep, voffA);
            PG8_WAIT_V(8); PG8_WAIT_L(0); PG8_BAR; PG8_MMA(0, 0, At, B0); PG8_MMA(0, 1, At, B1); PG8_BAR; PG8_SCHED;
            PG8_LDA(At, 1, 1); PG8_STAGE(PG8_SB(1, 0), b3, voffB); PG8_STAGE(PG8_SB(1, 1), b3 + hstep, voffB); PG8_STAGE(PG8_SA(1, 0), a3, voffA);
            PG8_WAIT_V(8); PG8_WAIT_L(0); PG8_BAR; PG8_MMA(1, 0, At, B0); PG8_MMA(1, 1, At, B1); PG8_BAR; PG8_SCHED;
            } else {
            PG8_LDB(B0, 0, 0); PG8_SCHED; PG8_LDA(At, 0, 0); PG8_STAGE(PG8_SA(1, 1), a1 + hstep, voffA);
            PG8_WAIT_L(8); PG8_BAR; PG8_WAIT_L(0); PG8_MMA(0, 0, At, B0); PG8_BAR; PG8_SCHED;
            PG8_LDB(B1, 0, 1); PG8_STAGE(PG8_SB(0, 0), b2, voffB);
            PG8_BAR; PG8_WAIT_L(0); PG8_MMA(0, 1, At, B1); PG8_BAR;
            PG8_LDA(At, 0, 1); PG8_STAGE(PG8_SA(0, 0), a2, voffA);
            PG8_BAR; PG8_WAIT_L(0); PG8_MMA(1, 0, At, B0); PG8_BAR; PG8_SCHED;
            PG8_STAGE(PG8_SB(0, 1), b2 + hstep, voffB);
            PG8_WAIT_V(6); PG8_BAR; PG8_MMA(1, 1, At, B1); PG8_BAR;
            PG8_LDB(B0, 1, 0); PG8_SCHED; PG8_LDA(At, 1, 0); PG8_STAGE(PG8_SA(0, 1), a2 + hstep, voffA);
            PG8_WAIT_L(8); PG8_BAR; PG8_WAIT_L(0); PG8_MMA(0, 0, At, B0); PG8_BAR; PG8_SCHED;
            PG8_LDB(B1, 1, 1); PG8_STAGE(PG8_SB(1, 0), b3, voffB);
            PG8_BAR; PG8_WAIT_L(0); PG8_MMA(0, 1, At, B1); PG8_BAR;
            PG8_LDA(At, 1, 1); PG8_STAGE(PG8_SA(1, 0), a3, voffA);
            PG8_BAR; PG8_WAIT_L(0); PG8_MMA(1, 0, At, B0); PG8_BAR; PG8_SCHED;
            PG8_STAGE(PG8_SB(1, 1), b3 + hstep, voffB);
            PG8_WAIT_V(6); PG8_BAR; PG8_MMA(1, 1, At, B1); PG8_BAR;
            }
        }
        if constexpr (FP8) asm volatile("s_nop 15\n\ts_nop 15" ::: "memory");
        if constexpr (ALIGN_EPI) { if (wr == 0) PG8_BAR; }
        if constexpr (!Epi::AFTER_DRAIN) { E(acc, cur, wr, wc, fr, fq); S.done(cur); }
        if (!has_next) break;
#pragma unroll
        for (int a = 0; a < 2; ++a)
#pragma unroll
            for (int b = 0; b < 2; ++b)
#pragma unroll
                for (int m = 0; m < 4; ++m)
#pragma unroll
                    for (int n = 0; n < 2; ++n) acc[a][b][m][n] = (f32x4){0.f, 0.f, 0.f, 0.f};
        cur = nxt; cA = nA; cB = nB; ++ui;
        if constexpr (ALIGN_EPI) { if (wr == 1) PG8_BAR; }
    }
    PG8_WAIT_V(0);
    if constexpr (!ALIGN_EPI) { if (wr == 0) PG8_BAR; }
    PG8_BAR;
    if constexpr (Epi::AFTER_DRAIN) { E.fused(acc, cur, wr, wc, fr, fq, lds, wid, lane); S.done(cur); }
#undef PG8_SA
#undef PG8_SB
#undef PG8_STAGE
#undef PG8_LDA
#undef PG8_LDB
#undef PG8_MMA
#undef PG8_CAT
#undef PG8_WAIT_V
#undef PG8_WAIT_L
#undef PG8_BAR
#undef PG8_SCHED
}
}

#ifndef PG8_SP2
#define PG8_SP2 true
#endif
#ifndef PG8_ALIGN
#define PG8_ALIGN true
#endif
#include <hip/hip_bf16.h>
#include <cmath>
namespace attn_body {
using bf16=__hip_bfloat16;
using bf16x8=__attribute__((ext_vector_type(8)))short;
using s16x4=__attribute__((ext_vector_type(4)))short;
using f32x16=__attribute__((ext_vector_type(16)))float;
using u32x4=__attribute__((ext_vector_type(4)))unsigned;
constexpr int D=64;
constexpr int NW=8,QBLK=32,QB=QBLK*NW,KVBLK=64;
constexpr int ATTN_UNIT_ROWS=QB;
__device__ __forceinline__ int crow(int r,int hi){return (r&3)+8*(r>>2)+4*hi;}
#define SBAR() __builtin_amdgcn_sched_barrier(0)
__device__ __forceinline__ void cmask(f32x16&p0,f32x16&p1,int jb,int qrel,int hi){
  const float NEG=-INFINITY; int kb=64*jb+4*hi;
  #pragma unroll
  for(int r=0;r<16;++r){int kv=kb+(r&3)+8*(r>>2); if(kv>qrel)p0[r]=NEG; if(kv+32>qrel)p1[r]=NEG;}
}

constexpr int NSLOT=3, SLOTB=8192;
constexpr int LDS_K=0, LDS_V=NSLOT*SLOTB, LDS_WS=2*NSLOT*SLOTB, LDS_OST=LDS_WS+NW*64*4, LDS_BYTES=LDS_OST+NW*4096;
constexpr float C2=0.125f*1.4426950408889634f;
__device__ __forceinline__ void glds16s(const void*sbase,unsigned voff,unsigned lds_dst){
  asm volatile("s_mov_b32 m0, %2\n\ts_nop 0\n\tglobal_load_lds_dwordx4 %0, %1"::"v"(voff),"s"(sbase),"s"(lds_dst):"memory","m0");}
__device__ __forceinline__ void glds16(const void*gsrc,unsigned lds_dst){unsigned keep;
  asm volatile("s_mov_b32 %0, m0\n\ts_mov_b32 m0, %2\n\ts_nop 0\n\tglobal_load_lds_dwordx4 %1, off\n\ts_mov_b32 m0, %0":"=&s"(keep):"v"(gsrc),"s"(lds_dst):"memory");}
__device__ __forceinline__ float max3f(float a,float b,float c){float r;asm("v_max3_f32 %0, %1, %2, %3":"=v"(r):"v"(a),"v"(b),"v"(c));return r;}
__device__ __forceinline__ float max2f(float a,float b){float r;asm("v_max_f32_e32 %0, %1, %2":"=v"(r):"v"(a),"v"(b));return r;}
__device__ __forceinline__ float fadd_s(float a,float b){float r;asm("v_add_f32_e32 %0, %1, %2":"=v"(r):"v"(a),"v"(b));return r;}
__device__ __forceinline__ float fsub_s(float a,float b){float r;asm("v_sub_f32_e32 %0, %1, %2":"=v"(r):"v"(a),"v"(b));return r;}
typedef float f32x2_t __attribute__((ext_vector_type(2))); typedef __bf16 bf16x2_t __attribute__((ext_vector_type(2)));
__device__ __forceinline__ unsigned cvtpk_s(float lo,float hi){f32x2_t v={lo,hi};bf16x2_t b=__builtin_convertvector(v,bf16x2_t);return __builtin_bit_cast(unsigned,b);}
#define WAIT_BAR(N) asm volatile("s_waitcnt vmcnt(" #N ") lgkmcnt(0)\n\ts_barrier":::"memory")

__device__ __forceinline__ void qkt(f32x16&p0,f32x16&p1,const char*Kslot,const bf16x8*qr,const f32x16&negm,int r32,int hi){
  const char*kb=Kslot+hi*1024+r32*16;
  #pragma unroll
  for(int d0=0;d0<4;++d0){
    const bf16x8 b0=*reinterpret_cast<const bf16x8*>(kb+d0*2048);
    const bf16x8 b1=*reinterpret_cast<const bf16x8*>(kb+d0*2048+512);
    if(d0==0){p0=__builtin_amdgcn_mfma_f32_32x32x16_bf16(b0,qr[0],negm,0,0,0);p1=__builtin_amdgcn_mfma_f32_32x32x16_bf16(b1,qr[0],negm,0,0,0);}
    else{p0=__builtin_amdgcn_mfma_f32_32x32x16_bf16(b0,qr[d0],p0,0,0,0);p1=__builtin_amdgcn_mfma_f32_32x32x16_bf16(b1,qr[d0],p1,0,0,0);}}
}
typedef __attribute__((address_space(3))) const char* lds_cptr;
typedef short v4i16_t __attribute__((ext_vector_type(4)));
__device__ __forceinline__ void kload8(bf16x8*kf,lds_cptr kp){
  kf[0]=*(const __attribute__((address_space(3))) bf16x8*)(kp);      kf[1]=*(const __attribute__((address_space(3))) bf16x8*)(kp+512);
  kf[2]=*(const __attribute__((address_space(3))) bf16x8*)(kp+2048); kf[3]=*(const __attribute__((address_space(3))) bf16x8*)(kp+2560);
  kf[4]=*(const __attribute__((address_space(3))) bf16x8*)(kp+4096); kf[5]=*(const __attribute__((address_space(3))) bf16x8*)(kp+4608);
  kf[6]=*(const __attribute__((address_space(3))) bf16x8*)(kp+6144); kf[7]=*(const __attribute__((address_space(3))) bf16x8*)(kp+6656);
}
__device__ __forceinline__ void kload2(bf16x8*kf,lds_cptr kp,int j){ kf[2*j]=*(const __attribute__((address_space(3))) bf16x8*)(kp+j*2048); kf[2*j+1]=*(const __attribute__((address_space(3))) bf16x8*)(kp+j*2048+512); }
__device__ __forceinline__ s16x4 vtr(lds_cptr p){ return __builtin_bit_cast(s16x4,__builtin_amdgcn_ds_read_tr16_b64_v4i16((__attribute__((address_space(3))) v4i16_t*)p)); }
__device__ __forceinline__ float rowmax(const f32x16&p0,const f32x16&p1){
  float a=max3f(p0[0],p0[1],p1[0]),b=max3f(p0[2],p0[3],p1[1]);a=max3f(a,p1[2],p1[3]);
  #pragma unroll
  for(int r=4;r<16;r+=4){a=max3f(a,p0[r],p0[r+1]);b=max3f(b,p0[r+2],p0[r+3]);a=max3f(a,p1[r],p1[r+1]);b=max3f(b,p1[r+2],p1[r+3]);}
  const float m=max2f(a,b);
  auto rr=__builtin_amdgcn_permlane32_swap(__float_as_uint(m),__float_as_uint(m),false,false);
  return max2f(__uint_as_float(rr[0]),__uint_as_float(rr[1]));
}
__device__ __forceinline__ void pv(f32x16*o,int vb,bf16x8 pa0,bf16x8 pa1,bf16x8 pa2,bf16x8 pa3){
  #pragma unroll
  for(int d0=0;d0<2;++d0){s16x4 lo[4],hi[4];
    #pragma unroll
    for(int ks=0;ks<4;++ks){
      asm volatile("ds_read_b64_tr_b16 %0,%1 offset:%c2":"=&v"(lo[ks]):"v"(vb),"i"(d0*4096+ks*1024):"memory");
      asm volatile("ds_read_b64_tr_b16 %0,%1 offset:%c2":"=&v"(hi[ks]):"v"(vb),"i"(d0*4096+ks*1024+512):"memory");}
    asm volatile("s_waitcnt lgkmcnt(0)":::"memory");SBAR();
    #define PK(k) (bf16x8){lo[k][0],lo[k][1],lo[k][2],lo[k][3],hi[k][0],hi[k][1],hi[k][2],hi[k][3]}
    o[d0]=__builtin_amdgcn_mfma_f32_32x32x16_bf16(pa0,PK(0),o[d0],0,0,0);
    o[d0]=__builtin_amdgcn_mfma_f32_32x32x16_bf16(pa1,PK(1),o[d0],0,0,0);
    o[d0]=__builtin_amdgcn_mfma_f32_32x32x16_bf16(pa2,PK(2),o[d0],0,0,0);
    o[d0]=__builtin_amdgcn_mfma_f32_32x32x16_bf16(pa3,PK(3),o[d0],0,0,0);
    #undef PK
  }
}

#ifndef ATTN_STORE16
#define ATTN_STORE16(p,v) (*(u32x4*)(p)=(v))
#endif
template<int THRL,bool TILED> __device__ __forceinline__ void attn_unit(const bf16*Qu,int qp,const bf16*__restrict__ Kc,const bf16*__restrict__ Kl,int kp,const bf16*__restrict__ Vc,const bf16*__restrict__ Vl,int vp,bf16*Ou,int op,int NT,int NCT,int rot,char*shm){
  const int tid=threadIdx.x,lane=tid&63,r32=lane&31,hi=lane>>5; const int wid=__builtin_amdgcn_readfirstlane(tid>>6);
  const bf16*Qw=Qu+(long)(wid*QBLK)*qp;
  const unsigned lds0=(unsigned)(uintptr_t)shm;
  float*wsf=(float*)(shm+LDS_WS)+wid*64;
  const long koff=TILED?(long)(wid*512+lane*8):((long)lane*kp+wid*8); const bf16*ksrc_c=Kc+koff; const bf16*ksrc_l=Kl+koff-(long)NCT*KVBLK*kp;
  const long voff=TILED?(long)(wid*512+lane*8):((long)(16*(wid&3)+(lane>>2))*vp+(wid>>2)*32+(lane&3)*8); const bf16*vsrc_c=Vc+voff; const bf16*vsrc_l=Vl+voff-(long)NCT*KVBLK*vp;
  const unsigned kdst=lds0+LDS_K+wid*1024, vdst=lds0+LDS_V+wid*1024;
  #define ROTT(t) (t)
  const unsigned koffb1=(unsigned)(wid*512+lane*8)*2u;
  #define DMA_K(t,slot) do{ if constexpr(TILED) glds16s(Kc+(long)ROTT(t)*4096,koffb1,(unsigned)__builtin_amdgcn_readfirstlane(kdst+(slot))); else glds16((ROTT(t)<NCT?ksrc_c:ksrc_l)+(long)ROTT(t)*KVBLK*kp,(unsigned)__builtin_amdgcn_readfirstlane(kdst+(slot))); }while(0)
  #define DMA_V(t,slot) do{ if constexpr(TILED) glds16s(Vc+(long)ROTT(t)*4096,koffb1,(unsigned)__builtin_amdgcn_readfirstlane(vdst+(slot))); else glds16((ROTT(t)<NCT?vsrc_c:vsrc_l)+(long)ROTT(t)*KVBLK*vp,(unsigned)__builtin_amdgcn_readfirstlane(vdst+(slot))); }while(0)
  const int vb0=(int)(lds0+LDS_V)+((lane>>4)&1)*32+(lane&3)*8+(4*hi+((lane&15)>>2))*64;
  const char*Kbase=shm+LDS_K; bf16x8 kf[8];
  const lds_cptr shm3=(lds_cptr)shm; const lds_cptr kp0=shm3+LDS_K+hi*1024+r32*16; const lds_cptr vp0=shm3+LDS_V+((lane>>4)&1)*32+(lane&3)*8+(4*hi+((lane&15)>>2))*64;
  DMA_K(0,0);DMA_V(0,0);DMA_K(1,SLOTB);
  bf16x8 qr[4];
  #pragma unroll
  for(int d0=0;d0<4;++d0)qr[d0]=*reinterpret_cast<const bf16x8*>(&Qw[(long)r32*qp+d0*16+hi*8]);
  float mhat=0.f,l_reg=0.f;f32x16 o[2];o[0]=f32x16{};o[1]=f32x16{};f32x16 negm=f32x16{};if constexpr(THRL>=0)asm volatile("":"+v"(negm));
  #define CMASK(P0,P1,t) do{}while(0)
  bool resc=false;
  #define START(P0,P1) do{ resc=false; if constexpr(THRL>=0) \
    { const float rm=rowmax(P0,P1); const float dl=rm; mhat=fadd_s(mhat,dl); \
      _Pragma("unroll") for(int r=0;r<16;++r){P0[r]=fsub_s(P0[r],dl);P1[r]=fsub_s(P1[r],dl);} \
      _Pragma("unroll") for(int r=0;r<16;++r)negm[r]=-mhat; asm volatile("":"+v"(negm)); } \
    _Pragma("unroll") for(int r=0;r<16;++r)P0[r]=__builtin_amdgcn_exp2f(P0[r]); }while(0)
  #define RESC() do{ if constexpr(THRL>=0) if(resc){ asm volatile("s_waitcnt lgkmcnt(0)":::"memory"); \
      _Pragma("unroll") for(int d_=0;d_<2;++d_) _Pragma("unroll") for(int r=0;r<16;++r)o[d_][r]*=wsf[crow(r,hi)]; } }while(0)
  f32x16 pA0,pA1,pB0,pB1;
  int sl_prev=0,sl_cur=0,sl_next=SLOTB;
  #define ROT() do{sl_prev=sl_cur;sl_cur=sl_next;sl_next=(sl_next==(NSLOT-1)*SLOTB)?0:sl_next+SLOTB;}while(0)
  DMA_K(2,2*SLOTB);
  WAIT_BAR(3);
  qkt(pA0,pA1,Kbase,qr,negm,r32,hi);asm volatile("s_nop 15\n\ts_nop 7":"+v"(pA0),"+v"(pA1));CMASK(pA0,pA1,0);
  START(pA0,pA1);
  _Pragma("unroll") for(int r=0;r<16;++r)pA1[r]=__builtin_amdgcn_exp2f(pA1[r]);
  WAIT_BAR(0);
  DMA_K(3,0);DMA_V(1,SLOTB);
  ROT();
  kload8(kf,kp0+sl_cur);
  WAIT_BAR(2);
  s16x4 vlo[8],vhi[8]; u32x4 pw0,pw1,pw2,pw3;
  #define PKW(P,B) cvtpk_s(P[B],P[B+1])
  #define PAF(k) __builtin_bit_cast(bf16x8,pw##k)
  #define VFR(i) (bf16x8){vlo[i][0],vlo[i][1],vlo[i][2],vlo[i][3],vhi[i][0],vhi[i][1],vhi[i][2],vhi[i][3]}
  #define PIN(x) asm volatile("":"+v"(x))
  #define MX3(a,b,c) __builtin_fmaxf(__builtin_fmaxf((a),(b)),(c))
  #define GAPA(MF,A0,A1,A2,A3,W0,W1,PW) do{ MF; sacc+=A0; sacc+=A1; sacc+=A2; sacc+=A3; PIN(sacc); W0; W1; PIN(PW); SBAR(); }while(0)
  #define EX(v) __builtin_amdgcn_exp2f(v)
  #define GAPB(MF,X,B) do{ MF; X[B]=EX(X[B]); X[B+1]=EX(X[B+1]); X[B+2]=EX(X[B+2]); X[B+3]=EX(X[B+3]); PIN(X); SBAR(); }while(0)
  #define VRD(i) do{ vlo[i]=vtr(vp_+(((i)>>2)*4096+((i)&3)*1024)); vhi[i]=vtr(vp_+(((i)>>2)*4096+((i)&3)*1024+512)); }while(0)
  #define KRD(G,j) do{ if(G){ kload2(kf,kp0+sl_next,j); SBAR(); } }while(0)
  #define STEP(C0,C1,P0,P1,t,GK,GV,GL) do{ SBAR(); \
    const lds_cptr vp_=vp0+sl_prev; \
    VRD(0); SBAR(); float sacc=(P0[0]+P0[1]); \
    GAPA(C0=__builtin_amdgcn_mfma_f32_32x32x16_bf16(kf[0],qr[0],negm,0,0,0), P0[2],P0[3],P0[4],P0[5],     pw0[0]=PKW(P0,0), pw0[1]=PKW(P0,2), pw0); \
    VRD(4); SBAR(); GAPA(C1=__builtin_amdgcn_mfma_f32_32x32x16_bf16(kf[1],qr[0],negm,0,0,0), P0[6],P0[7],P0[8],P0[9],     pw0[2]=PKW(P0,4), pw0[3]=PKW(P0,6), pw0); \
    VRD(1); SBAR(); GAPA(C0=__builtin_amdgcn_mfma_f32_32x32x16_bf16(kf[2],qr[1],C0,0,0,0),   P0[10],P0[11],P0[12],P0[13], pw1[0]=PKW(P0,8), pw1[1]=PKW(P0,10), pw1); \
    VRD(5); SBAR(); GAPA(C1=__builtin_amdgcn_mfma_f32_32x32x16_bf16(kf[3],qr[1],C1,0,0,0),   P0[14],P0[15],P1[0],P1[1],   pw1[2]=PKW(P0,12),pw1[3]=PKW(P0,14), pw1); \
    VRD(2); SBAR(); GAPA(C0=__builtin_amdgcn_mfma_f32_32x32x16_bf16(kf[4],qr[2],C0,0,0,0),   P1[2],P1[3],P1[4],P1[5],     pw2[0]=PKW(P1,0), pw2[1]=PKW(P1,2), pw2); \
    VRD(6); SBAR(); GAPA(C1=__builtin_amdgcn_mfma_f32_32x32x16_bf16(kf[5],qr[2],C1,0,0,0),   P1[6],P1[7],P1[8],P1[9],     pw2[2]=PKW(P1,4), pw2[3]=PKW(P1,6), pw2); \
    VRD(3); SBAR(); GAPA(C0=__builtin_amdgcn_mfma_f32_32x32x16_bf16(kf[6],qr[3],C0,0,0,0),   P1[10],P1[11],P1[12],P1[13], pw3[0]=PKW(P1,8), pw3[1]=PKW(P1,10), pw3); \
    VRD(7); SBAR(); GAPA(C1=__builtin_amdgcn_mfma_f32_32x32x16_bf16(kf[7],qr[3],C1,0,0,0),   P1[14],P1[15],0.f,0.f,       pw3[2]=PKW(P1,12),pw3[3]=PKW(P1,14), pw3); \
    l_reg+=sacc; \
    if(GK){DMA_K((t)+3,sl_cur);} if(GV){DMA_V((t)+1,sl_next);} \
    CMASK(C0,C1,t); \
    if constexpr(THRL>=0){ float a=MX3(C0[0],C0[1],C1[0]),b=MX3(C0[2],C0[3],C1[1]); a=MX3(a,C1[2],C1[3]); \
      _Pragma("unroll") for(int r=4;r<16;r+=4){a=MX3(a,C0[r],C0[r+1]);b=MX3(b,C0[r+2],C0[r+3]);a=MX3(a,C1[r],C1[r+1]);b=MX3(b,C1[r+2],C1[r+3]);} \
      float rm=__builtin_fmaxf(a,b); { auto rr=__builtin_amdgcn_permlane32_swap(__float_as_uint(rm),__float_as_uint(rm),false,false); rm=__builtin_fmaxf(__uint_as_float(rr[0]),__uint_as_float(rr[1])); } \
      resc=false; \
      if(__builtin_expect(__any(rm>(float)THRL),0)){ const float dl=__builtin_fmaxf(rm,0.f); mhat+=dl; \
        _Pragma("unroll") for(int r=0;r<16;++r){C0[r]-=dl;C1[r]-=dl;} \
        _Pragma("unroll") for(int r=0;r<16;++r)negm[r]=-mhat; asm volatile("":"+v"(negm)); \
        const float f=__builtin_amdgcn_exp2f(-dl); l_reg*=f; if(hi==0)wsf[r32]=f; resc=true; } } \
    SBAR(); \
    GAPB(o[0]=__builtin_amdgcn_mfma_f32_32x32x16_bf16(PAF(0),VFR(0),o[0],0,0,0), C0,0); \
    GAPB(o[1]=__builtin_amdgcn_mfma_f32_32x32x16_bf16(PAF(0),VFR(4),o[1],0,0,0), C0,4); \
    KRD(GL,0); GAPB(o[0]=__builtin_amdgcn_mfma_f32_32x32x16_bf16(PAF(1),VFR(1),o[0],0,0,0), C0,8); \
    KRD(GL,1); GAPB(o[1]=__builtin_amdgcn_mfma_f32_32x32x16_bf16(PAF(1),VFR(5),o[1],0,0,0), C0,12); \
    KRD(GL,2); GAPB(o[0]=__builtin_amdgcn_mfma_f32_32x32x16_bf16(PAF(2),VFR(2),o[0],0,0,0), C1,0); \
    KRD(GL,3); GAPB(o[1]=__builtin_amdgcn_mfma_f32_32x32x16_bf16(PAF(2),VFR(6),o[1],0,0,0), C1,4); \
    GAPB(o[0]=__builtin_amdgcn_mfma_f32_32x32x16_bf16(PAF(3),VFR(3),o[0],0,0,0), C1,8); \
    GAPB(o[1]=__builtin_amdgcn_mfma_f32_32x32x16_bf16(PAF(3),VFR(7),o[1],0,0,0), C1,12); \
    }while(0)
  int t=1;
  #undef CMASK
  #define CMASK(P0,P1,t) do{}while(0)
  for(;t+5<NT;t+=2){
    STEP(pB0,pB1,pA0,pA1,t,true,true,true);     WAIT_BAR(2); RESC(); ROT();
    STEP(pA0,pA1,pB0,pB1,t+1,true,true,true);   WAIT_BAR(2); RESC(); ROT();
  }
  #undef CMASK
  #define CMASK(P0,P1,t) do{}while(0)
  #define ENDW(tt) do{ if((tt)+3<NT){WAIT_BAR(2);} else if((tt)+2<NT){WAIT_BAR(1);} else {WAIT_BAR(0);} }while(0)
  for(;t+1<NT;t+=2){
    STEP(pB0,pB1,pA0,pA1,t,(t+3<NT),(t+1<NT),(t+1<NT));       ENDW(t);   RESC(); ROT();
    STEP(pA0,pA1,pB0,pB1,t+1,(t+4<NT),(t+2<NT),(t+2<NT));     ENDW(t+1); RESC(); ROT();
  }
  STEP(pB0,pB1,pA0,pA1,NT-1,false,false,false); RESC();
  { float sacc=pB0[0]+pB0[1]; _Pragma("unroll") for(int r=2;r<16;++r)sacc+=pB0[r]; _Pragma("unroll") for(int r=0;r<16;++r)sacc+=pB1[r]; l_reg+=sacc;
    pw0=(u32x4){PKW(pB0,0),PKW(pB0,2),PKW(pB0,4),PKW(pB0,6)};pw1=(u32x4){PKW(pB0,8),PKW(pB0,10),PKW(pB0,12),PKW(pB0,14)};pw2=(u32x4){PKW(pB1,0),PKW(pB1,2),PKW(pB1,4),PKW(pB1,6)};pw3=(u32x4){PKW(pB1,8),PKW(pB1,10),PKW(pB1,12),PKW(pB1,14)};
    SBAR(); pv(o,vb0+sl_cur,PAF(0),PAF(1),PAF(2),PAF(3)); }
  #undef PKW
  #undef PAF
  #undef VFR
  #undef PIN
  #undef MX3
  #undef GAPA
  #undef GAPB
  #undef EX
  #undef VRD
  #undef KRD
  #undef STEP
  #undef ENDW
  {auto rr=__builtin_amdgcn_permlane32_swap(__float_as_uint(l_reg),__float_as_uint(l_reg),false,false);l_reg=__uint_as_float(rr[0])+__uint_as_float(rr[1]);}
  if(hi==0)wsf[32+r32]=l_reg;asm volatile("s_waitcnt lgkmcnt(0)":::"memory");
  float rli[16];
  #pragma unroll
  for(int r=0;r<16;++r)rli[r]=__builtin_amdgcn_rcpf(wsf[32+crow(r,hi)]);
  bf16*Ow=Ou+(long)(wid*QBLK)*op;
  { bf16*stg=(bf16*)(shm+LDS_OST)+wid*2048;
    #pragma unroll
    for(int r=0;r<16;++r){const int orow=crow(r,hi);
      #pragma unroll
      for(int d0=0;d0<2;++d0)stg[orow*64+d0*32+r32]=__float2bfloat16(o[d0][r]*rli[r]);}
    asm volatile("s_waitcnt lgkmcnt(0)":::"memory");
    #pragma unroll
    for(int i=0;i<4;++i){const int row=i*8+(lane>>3),ch=lane&7; const u32x4 v=*(const u32x4*)(stg+row*64+ch*8); ATTN_STORE16(Ow+(long)row*op+ch*8,v);} }
  asm volatile("s_waitcnt lgkmcnt(0)\n\ts_barrier":::"memory");
  #undef DMA_K
  #undef ROTT
  #undef DMA_V
  #undef CMASK
  #undef START
  #undef RESC
  #undef ROT
}
constexpr int LDS2_V=NSLOT*SLOTB, LDS2_WS=LDS2_V+NSLOT*2*SLOTB, LDS2_OST=LDS2_WS+NW*64*4, LDS2_BYTES=LDS2_OST+NW*4096;
template<int THRL> __device__ __forceinline__ void attn_unit2(const bf16*Qu,int qp,const bf16*__restrict__ Ks,const bf16*__restrict__ Va,const bf16*__restrict__ Vb,bf16*Ou,int op,int NT,int rot,char*shm,bool FUSE,const bf16*O1,int o1p,float lam,const float*subg,float oscale){
  const int tid=threadIdx.x,lane=tid&63,r32=lane&31,hi=lane>>5; const int wid=__builtin_amdgcn_readfirstlane(tid>>6);
  const bf16*Qw=Qu+(long)(wid*QBLK)*qp;
  const unsigned lds0=(unsigned)(uintptr_t)shm;
  float*wsf=(float*)(shm+LDS2_WS)+wid*64;
  const unsigned koffb=(unsigned)(wid*512+lane*8)*2u;
  const unsigned kdst=lds0+LDS_K+wid*1024, vdst=lds0+LDS2_V+wid*1024;
  #define ROTT(t) (t)
  #define DMA_K(t,slot) glds16s(Ks+(long)ROTT(t)*4096,koffb,(unsigned)__builtin_amdgcn_readfirstlane(kdst+(slot)))
  #define DMA_V(t,slot) do{ glds16s(Va+(long)ROTT(t)*4096,koffb,(unsigned)__builtin_amdgcn_readfirstlane(vdst+2*(slot))); glds16s(Vb+(long)ROTT(t)*4096,koffb,(unsigned)__builtin_amdgcn_readfirstlane(vdst+2*(slot)+8192)); }while(0)
  const int vb0=(int)(lds0+LDS2_V)+((lane>>4)&1)*32+(lane&3)*8+(4*hi+((lane&15)>>2))*64;
  const char*Kbase=shm+LDS_K; bf16x8 kf[8];
  const lds_cptr shm3=(lds_cptr)shm; const lds_cptr kp0=shm3+LDS_K+hi*1024+r32*16; const lds_cptr vp0=shm3+LDS2_V+((lane>>4)&1)*32+(lane&3)*8+(4*hi+((lane&15)>>2))*64;
  DMA_K(0,0);DMA_V(0,0);DMA_K(1,SLOTB);
  bf16x8 qr[4];
  #pragma unroll
  for(int d0=0;d0<4;++d0)qr[d0]=*reinterpret_cast<const bf16x8*>(&Qw[(long)r32*qp+d0*16+hi*8]);
  float mhat=0.f,l_reg=0.f;f32x16 o[4];o[0]=f32x16{};o[1]=f32x16{};o[2]=f32x16{};o[3]=f32x16{};const f32x16 zero16=f32x16{};
  #define CMASK(P0,P1,t) do{}while(0)
  bool resc=false;
  #define SUBM(x) (THRL>=0?(x)-mhat:(x))
  #define START(P0,P1) do{ resc=false; if constexpr(THRL>=0){ mhat=rowmax(P0,P1); } \
    _Pragma("unroll") for(int r=0;r<16;++r)P0[r]=__builtin_amdgcn_exp2f(SUBM(P0[r])); }while(0)
  #define RESC() do{ if constexpr(THRL>=0) if(resc){ asm volatile("s_waitcnt lgkmcnt(0)":::"memory"); \
      _Pragma("unroll") for(int d_=0;d_<4;++d_) _Pragma("unroll") for(int r=0;r<16;++r)o[d_][r]*=wsf[crow(r,hi)]; } }while(0)
  f32x16 pA0,pA1,pB0,pB1;
  int sl_prev=0,sl_cur=0,sl_next=SLOTB;
  #define ROT() do{sl_prev=sl_cur;sl_cur=sl_next;sl_next=(sl_next==(NSLOT-1)*SLOTB)?0:sl_next+SLOTB;}while(0)
  DMA_K(2,2*SLOTB);
  WAIT_BAR(4);
  qkt(pA0,pA1,Kbase,qr,zero16,r32,hi);asm volatile("s_nop 15\n\ts_nop 7":"+v"(pA0),"+v"(pA1));CMASK(pA0,pA1,0);
  START(pA0,pA1);
  _Pragma("unroll") for(int r=0;r<16;++r)pA1[r]=__builtin_amdgcn_exp2f(SUBM(pA1[r]));
  WAIT_BAR(0);
  DMA_K(3,0);DMA_V(1,SLOTB);
  ROT();
  kload8(kf,kp0+sl_cur);
  WAIT_BAR(3);
  s16x4 vlo[8],vhi[8]; u32x4 pw0,pw1,pw2,pw3;
  #define PKW(P,B) cvtpk_s(P[B],P[B+1])
  #define PAF(k) __builtin_bit_cast(bf16x8,pw##k)
  #define VFR(i) (bf16x8){vlo[i][0],vlo[i][1],vlo[i][2],vlo[i][3],vhi[i][0],vhi[i][1],vhi[i][2],vhi[i][3]}
  #define PIN(x) asm volatile("":"+v"(x))
  #define MX3(a,b,c) __builtin_fmaxf(__builtin_fmaxf((a),(b)),(c))
  #define GAPA(MF,A0,A1,A2,A3,W0,W1,PW) do{ MF; sacc+=A0; sacc+=A1; sacc+=A2; sacc+=A3; PIN(sacc); W0; W1; PIN(PW); SBAR(); }while(0)
  #define EX(v) __builtin_amdgcn_exp2f(v)
  #define GAPB(MF,X,B) do{ MF; X[B]=EX(SUBM(X[B])); X[B+1]=EX(SUBM(X[B+1])); PIN(X); SBAR(); }while(0)
  #define VRD(i) do{ vlo[i]=vtr(vp_+(((i)>>2)*4096+((i)&3)*1024)); vhi[i]=vtr(vp_+(((i)>>2)*4096+((i)&3)*1024+512)); }while(0)
  #define VRD2(i) do{ vlo[i]=vtr(vp_+(8192+((i)>>2)*4096+((i)&3)*1024)); vhi[i]=vtr(vp_+(8192+((i)>>2)*4096+((i)&3)*1024+512)); SBAR(); }while(0)
  #define KRD(G,j) do{ if(G){ kload2(kf,kp0+sl_next,j); SBAR(); } }while(0)
  #define STEP(C0,C1,P0,P1,t,GK,GV,GL) do{ SBAR(); \
    const lds_cptr vp_=vp0+2*sl_prev; \
    VRD(0); SBAR(); float sacc=(P0[0]+P0[1]); \
    GAPA(C0=__builtin_amdgcn_mfma_f32_32x32x16_bf16(kf[0],qr[0],zero16,0,0,0), P0[2],P0[3],P0[4],P0[5],     pw0[0]=PKW(P0,0), pw0[1]=PKW(P0,2), pw0); \
    VRD(4); SBAR(); GAPA(C1=__builtin_amdgcn_mfma_f32_32x32x16_bf16(kf[1],qr[0],zero16,0,0,0), P0[6],P0[7],P0[8],P0[9],     pw0[2]=PKW(P0,4), pw0[3]=PKW(P0,6), pw0); \
    VRD(1); SBAR(); GAPA(C0=__builtin_amdgcn_mfma_f32_32x32x16_bf16(kf[2],qr[1],C0,0,0,0),   P0[10],P0[11],P0[12],P0[13], pw1[0]=PKW(P0,8), pw1[1]=PKW(P0,10), pw1); \
    VRD(5); SBAR(); GAPA(C1=__builtin_amdgcn_mfma_f32_32x32x16_bf16(kf[3],qr[1],C1,0,0,0),   P0[14],P0[15],P1[0],P1[1],   pw1[2]=PKW(P0,12),pw1[3]=PKW(P0,14), pw1); \
    VRD(2); SBAR(); GAPA(C0=__builtin_amdgcn_mfma_f32_32x32x16_bf16(kf[4],qr[2],C0,0,0,0),   P1[2],P1[3],P1[4],P1[5],     pw2[0]=PKW(P1,0), pw2[1]=PKW(P1,2), pw2); \
    VRD(6); SBAR(); GAPA(C1=__builtin_amdgcn_mfma_f32_32x32x16_bf16(kf[5],qr[2],C1,0,0,0),   P1[6],P1[7],P1[8],P1[9],     pw2[2]=PKW(P1,4), pw2[3]=PKW(P1,6), pw2); \
    VRD(3); SBAR(); GAPA(C0=__builtin_amdgcn_mfma_f32_32x32x16_bf16(kf[6],qr[3],C0,0,0,0),   P1[10],P1[11],P1[12],P1[13], pw3[0]=PKW(P1,8), pw3[1]=PKW(P1,10), pw3); \
    VRD(7); SBAR(); GAPA(C1=__builtin_amdgcn_mfma_f32_32x32x16_bf16(kf[7],qr[3],C1,0,0,0),   P1[14],P1[15],0.f,0.f,       pw3[2]=PKW(P1,12),pw3[3]=PKW(P1,14), pw3); \
    l_reg+=sacc; \
    if(GK){DMA_K((t)+3,sl_cur);} if(GV){DMA_V((t)+1,sl_next);} \
    CMASK(C0,C1,t); \
    if constexpr(THRL>=0){ float a=MX3(C0[0],C0[1],C1[0]),b=MX3(C0[2],C0[3],C1[1]); a=MX3(a,C1[2],C1[3]); \
      _Pragma("unroll") for(int r=4;r<16;r+=4){a=MX3(a,C0[r],C0[r+1]);b=MX3(b,C0[r+2],C0[r+3]);a=MX3(a,C1[r],C1[r+1]);b=MX3(b,C1[r+2],C1[r+3]);} \
      float rm=__builtin_fmaxf(a,b); { auto rr=__builtin_amdgcn_permlane32_swap(__float_as_uint(rm),__float_as_uint(rm),false,false); rm=__builtin_fmaxf(__uint_as_float(rr[0]),__uint_as_float(rr[1])); } \
      resc=false; \
      rm-=mhat; \
      if(__builtin_expect(__any(rm>(float)THRL),0)){ const float dl=__builtin_fmaxf(rm,0.f); mhat+=dl; \
        const float f=__builtin_amdgcn_exp2f(-dl); l_reg*=f; if(hi==0)wsf[r32]=f; resc=true; } } \
    SBAR(); \
    GAPB(o[0]=__builtin_amdgcn_mfma_f32_32x32x16_bf16(PAF(0),VFR(0),o[0],0,0,0), C0,0); VRD2(0); \
    GAPB(o[1]=__builtin_amdgcn_mfma_f32_32x32x16_bf16(PAF(0),VFR(4),o[1],0,0,0), C0,2); VRD2(4); \
    KRD(GL,0); GAPB(o[0]=__builtin_amdgcn_mfma_f32_32x32x16_bf16(PAF(1),VFR(1),o[0],0,0,0), C0,4); VRD2(1); \
    KRD(GL,1); GAPB(o[1]=__builtin_amdgcn_mfma_f32_32x32x16_bf16(PAF(1),VFR(5),o[1],0,0,0), C0,6); VRD2(5); \
    KRD(GL,2); GAPB(o[0]=__builtin_amdgcn_mfma_f32_32x32x16_bf16(PAF(2),VFR(2),o[0],0,0,0), C0,8); VRD2(2); \
    KRD(GL,3); GAPB(o[1]=__builtin_amdgcn_mfma_f32_32x32x16_bf16(PAF(2),VFR(6),o[1],0,0,0), C0,10); VRD2(6); \
    GAPB(o[0]=__builtin_amdgcn_mfma_f32_32x32x16_bf16(PAF(3),VFR(3),o[0],0,0,0), C0,12); VRD2(3); \
    GAPB(o[1]=__builtin_amdgcn_mfma_f32_32x32x16_bf16(PAF(3),VFR(7),o[1],0,0,0), C0,14); VRD2(7); \
    GAPB(o[2]=__builtin_amdgcn_mfma_f32_32x32x16_bf16(PAF(0),VFR(0),o[2],0,0,0), C1,0); \
    GAPB(o[3]=__builtin_amdgcn_mfma_f32_32x32x16_bf16(PAF(0),VFR(4),o[3],0,0,0), C1,2); \
    GAPB(o[2]=__builtin_amdgcn_mfma_f32_32x32x16_bf16(PAF(1),VFR(1),o[2],0,0,0), C1,4); \
    GAPB(o[3]=__builtin_amdgcn_mfma_f32_32x32x16_bf16(PAF(1),VFR(5),o[3],0,0,0), C1,6); \
    GAPB(o[2]=__builtin_amdgcn_mfma_f32_32x32x16_bf16(PAF(2),VFR(2),o[2],0,0,0), C1,8); \
    GAPB(o[3]=__builtin_amdgcn_mfma_f32_32x32x16_bf16(PAF(2),VFR(6),o[3],0,0,0), C1,10); \
    GAPB(o[2]=__builtin_amdgcn_mfma_f32_32x32x16_bf16(PAF(3),VFR(3),o[2],0,0,0), C1,12); \
    GAPB(o[3]=__builtin_amdgcn_mfma_f32_32x32x16_bf16(PAF(3),VFR(7),o[3],0,0,0), C1,14); \
    }while(0)
  int t=1;
  #undef CMASK
  #define CMASK(P0,P1,t) do{}while(0)
  for(;t+5<NT;t+=2){
    STEP(pB0,pB1,pA0,pA1,t,true,true,true);     WAIT_BAR(3); RESC(); ROT();
    STEP(pA0,pA1,pB0,pB1,t+1,true,true,true);   WAIT_BAR(3); RESC(); ROT();
  }
  #undef CMASK
  #define CMASK(P0,P1,t) do{}while(0)
  #define ENDW(tt) do{ if((tt)+3<NT){WAIT_BAR(3);} else if((tt)+2<NT){WAIT_BAR(2);} else {WAIT_BAR(0);} }while(0)
  for(;t+1<NT;t+=2){
    STEP(pB0,pB1,pA0,pA1,t,(t+3<NT),(t+1<NT),(t+1<NT));       ENDW(t);   RESC(); ROT();
    STEP(pA0,pA1,pB0,pB1,t+1,(t+4<NT),(t+2<NT),(t+2<NT));     ENDW(t+1); RESC(); ROT();
  }
  STEP(pB0,pB1,pA0,pA1,NT-1,false,false,false); RESC();
  { float sacc=pB0[0]+pB0[1]; _Pragma("unroll") for(int r=2;r<16;++r)sacc+=pB0[r]; _Pragma("unroll") for(int r=0;r<16;++r)sacc+=pB1[r]; l_reg+=sacc;
    pw0=(u32x4){PKW(pB0,0),PKW(pB0,2),PKW(pB0,4),PKW(pB0,6)};pw1=(u32x4){PKW(pB0,8),PKW(pB0,10),PKW(pB0,12),PKW(pB0,14)};pw2=(u32x4){PKW(pB1,0),PKW(pB1,2),PKW(pB1,4),PKW(pB1,6)};pw3=(u32x4){PKW(pB1,8),PKW(pB1,10),PKW(pB1,12),PKW(pB1,14)};
    SBAR(); pv(o,vb0+2*sl_cur,PAF(0),PAF(1),PAF(2),PAF(3)); pv(o+2,vb0+2*sl_cur+8192,PAF(0),PAF(1),PAF(2),PAF(3)); }
  #undef PKW
  #undef PAF
  #undef VFR
  #undef PIN
  #undef MX3
  #undef GAPA
  #undef GAPB
  #undef EX
  #undef VRD
  #undef VRD2
  #undef KRD
  #undef STEP
  #undef ENDW
  {auto rr=__builtin_amdgcn_permlane32_swap(__float_as_uint(l_reg),__float_as_uint(l_reg),false,false);l_reg=__uint_as_float(rr[0])+__uint_as_float(rr[1]);}
  if(hi==0)wsf[32+r32]=l_reg;asm volatile("s_waitcnt lgkmcnt(0)":::"memory");
  float rli[16];
  #pragma unroll
  for(int r=0;r<16;++r)rli[r]=__builtin_amdgcn_rcpf(wsf[32+crow(r,hi)]);
  bf16*Ow=Ou+(long)(wid*QBLK)*op;
  { bf16*stg=(bf16*)(shm+LDS2_OST)+wid*2048;
    int lane_e=lane; asm volatile("":"+v"(lane_e));
    if(!FUSE){
    #pragma unroll
    for(int hh=0;hh<2;++hh){
      #pragma unroll
      for(int r=0;r<16;++r){const int orow=crow(r,hi);
        #pragma unroll
        for(int d0=0;d0<2;++d0)stg[orow*64+d0*32+r32]=__float2bfloat16(o[2*hh+d0][r]*rli[r]);}
      asm volatile("s_waitcnt lgkmcnt(0)":::"memory");
      #pragma unroll
      for(int i=0;i<4;++i){const int row=i*8+(lane_e>>3),ch=lane_e&7; const u32x4 v=*(const u32x4*)(stg+row*64+ch*8); ATTN_STORE16(Ow+(long)row*op+hh*64+ch*8,v);}
      asm volatile("s_waitcnt lgkmcnt(0)":::"memory"); }
    } else {
    const bf16*O1w=O1+(long)(wid*QBLK)*o1p; float dd[2][4][8]; float ssq[4]={0.f,0.f,0.f,0.f};
    #pragma unroll
    for(int hh=0;hh<2;++hh){
      #pragma unroll
      for(int r=0;r<16;++r){const int orow=crow(r,hi);
        #pragma unroll
        for(int d0=0;d0<2;++d0)stg[orow*64+d0*32+r32]=__float2bfloat16(o[2*hh+d0][r]*rli[r]);}
      asm volatile("s_waitcnt lgkmcnt(0)":::"memory");
      #pragma unroll
      for(int i=0;i<4;++i){const int row=i*8+(lane_e>>3),ch=lane_e&7; const u32x4 v2=*(const u32x4*)(stg+row*64+ch*8); const u32x4 v1=*(const u32x4*)(O1w+(long)row*o1p+hh*64+ch*8);
        #pragma unroll
        for(int e=0;e<4;++e){ const float a0=__uint_as_float(v1[e]<<16),a1=__uint_as_float(v1[e]&0xffff0000u),b0=__uint_as_float(v2[e]<<16),b1=__uint_as_float(v2[e]&0xffff0000u);
          const float x0=a0-lam*b0,x1=a1-lam*b1; dd[hh][i][2*e]=x0; dd[hh][i][2*e+1]=x1; ssq[i]+=x0*x0+x1*x1; } }
      asm volatile("s_waitcnt lgkmcnt(0)":::"memory"); }
    #pragma unroll
    for(int i=0;i<4;++i){ float t=ssq[i]; t+=__shfl_xor(t,1); t+=__shfl_xor(t,2); t+=__shfl_xor(t,4); const float rs=oscale/sqrtf(t*(1.0f/128.0f)+1e-6f); const int row=i*8+(lane_e>>3),ch=lane_e&7;
      #pragma unroll
      for(int hh=0;hh<2;++hh){ const float*gp=subg+hh*64+ch*8; u32x4 w;
        #pragma unroll
        for(int e=0;e<4;++e)w[e]=cvtpk_s(dd[hh][i][2*e]*rs*gp[2*e],dd[hh][i][2*e+1]*rs*gp[2*e+1]);
        ATTN_STORE16(Ow+(long)row*op+hh*64+ch*8,w);} }
    } }
  asm volatile("s_waitcnt lgkmcnt(0)\n\ts_barrier":::"memory");
  #undef DMA_K
  #undef ROTT
  #undef DMA_V
  #undef CMASK
  #undef START
  #undef RESC
  #undef ROT
}
constexpr int ATTN_LDS_BYTES=LDS_BYTES;
#undef SBAR
#undef WAIT_BAR
}
constexpr int NWAVES = 8;
#ifndef MK_ONE_LAUNCH
#define MK_ONE_LAUNCH 1
#endif
constexpr int NPH = 20;

constexpr int D = 1024, NB = 2, SEQ = 8192, CTXL = 256;
constexpr int ML = NB * SEQ, MC = NB * CTXL, MR = ML + MC;
constexpr int E_IN = 2560, O_IN = 1792, FF = 2816, FF2 = 2 * FF, NEXP = 8;
constexpr int MOE_ROWS = 2 * ML + NEXP * 256, MOE_PAN = MOE_ROWS / 256;
constexpr int NCHUNK = MR / 64;
constexpr float EPS = 1e-6f;
constexpr float MOE_S13 = 32.0f, MOE_S2 = 64.0f;
constexpr float QSCALE = 0.125f * 1.4426950408889634f;

constexpr size_t MiB = 1u << 20, KiB = 1u << 10;
constexpr size_t WS_CTL = 0, CTL_ZERO_BYTES = 1 * MiB;
constexpr size_t WS_MOD = 1 * MiB;
constexpr size_t WS_WG = 1 * MiB + 256 * KiB;
constexpr size_t WS_TOK = 2 * MiB;
constexpr size_t WS_AGG = 4 * MiB;
constexpr size_t WS_WM13 = 8 * MiB, WS_WM2 = 96 * MiB;
constexpr size_t WS_WE = 140 * MiB, WS_WO0 = 145 * MiB, WS_WO1 = 147 * MiB, WS_WF13 = 149 * MiB, WS_WF2 = 160 * MiB, WS_WOI = 166 * MiB;
constexpr size_t WS_XR = 170 * MiB;
constexpr size_t WS_KC0 = 170 * MiB, WS_VC0 = 187 * MiB;
constexpr size_t WS_KC1 = 427 * MiB, WS_VC1 = 432 * MiB;
constexpr int KEYS = CTXL + SEQ;
constexpr size_t WS_X3 = 56 * MiB;
constexpr size_t WS_XN = 236 * MiB;
constexpr size_t WS_Y = 269 * MiB;
constexpr size_t WS_P0 = 302 * MiB;
constexpr size_t WS_OATT = 385 * MiB;
constexpr size_t WS_H = 302 * MiB;
constexpr size_t WS_P1 = 302 * MiB;
constexpr size_t WS_RI = 360 * MiB;
constexpr size_t WS_XG = 234 * MiB;
constexpr size_t WS_HG = 140 * MiB;
constexpr size_t WS_YG = 368 * MiB;
constexpr size_t WS_END = 436 * MiB;
static_assert(WS_WM13 + (size_t)NEXP * FF2 * D <= WS_X3 && WS_X3 + (size_t)ML * D * 2 <= WS_WM2 && WS_WM13 + (size_t)NEXP * FF2 * D * 2 <= WS_WM2 && WS_WM2 + (size_t)NEXP * D * FF * 2 <= WS_WE && WS_WE + (size_t)E_IN * D * 2 <= WS_WO0 && WS_WF13 + (size_t)FF2 * D * 2 <= WS_WF2 &&
              WS_WF2 + (size_t)D * FF * 2 <= WS_WOI && WS_WOI + (size_t)O_IN * D * 2 <= WS_XR && WS_XR + (size_t)MR * D * 2 <= WS_XN && WS_XN + (size_t)MR * D * 2 <= WS_Y && WS_Y + (size_t)MR * D * 2 <= WS_P0 &&
              WS_P0 + (size_t)MR * E_IN * 2 <= WS_OATT && WS_OATT + (size_t)MR * D * 2 <= WS_END && WS_H + (size_t)MR * FF * 2 <= WS_END && WS_P1 + (size_t)MR * O_IN * 2 <= WS_RI &&
              WS_RI + (size_t)4 * MR * 512 * 2 <= WS_END && WS_XG + (size_t)NEXP * ML * D <= WS_YG && WS_HG + (size_t)MOE_ROWS * FF <= WS_XG && WS_AGG + (size_t)2 * NCHUNK * 2 * 512 * 4 <= WS_WM13, "d_ws map");
constexpr int CW_TMO = 0, CW_CODE = 1;
constexpr int CW_BAR = 4096;
constexpr int CW_CNT = 8192;
constexpr int RING_OFF = 0, RING_BYTES = 131072;
constexpr int LDSCTL_OFF = RING_BYTES, MISC_OFF = LDSCTL_OFF + 320;
constexpr int PEXP_OFF = LDSCTL_OFF + 1024;
constexpr int LDS_BYTES = 147456;
#define GAS __attribute__((address_space(1)))
#define LAS __attribute__((address_space(3)))
typedef unsigned short bf16;
typedef unsigned v4u __attribute__((ext_vector_type(4)));
typedef float f32x4 __attribute__((ext_vector_type(4)));
typedef short bf16x8 __attribute__((ext_vector_type(8)));
typedef GAS unsigned gu32;
typedef GAS unsigned long long gu64;
#define RLX_AGENT __ATOMIC_RELAXED, __HIP_MEMORY_SCOPE_AGENT
#define LDS_WAIT() asm volatile("s_waitcnt lgkmcnt(0)" ::: "memory")
#define VM_WAIT() asm volatile("s_waitcnt vmcnt(0)" ::: "memory")
__device__ __forceinline__ unsigned long long rt() { return __builtin_amdgcn_s_memrealtime(); }
__device__ __forceinline__ unsigned f2bf(float f) { unsigned u = __builtin_bit_cast(unsigned, f); return (u + 0x7fffu + ((u >> 16) & 1u)) >> 16; }
__device__ __forceinline__ unsigned pk2(float lo, float hi) { return f2bf(lo) | (f2bf(hi) << 16); }

#define XB_TMO      128
#define XB_XCNT(j)  (256  + 64 * (j))
#define XB_XSUB(j)  (1280 + 64 * (j))
#define XB_XGEN(j)  (2304 + 64 * (j))
#define XB_TOP      3328
#define XB_TOPGEN   3392
#define XCD_BAR_WORDS 3456
#define XB_SPIN_CAP (1u << 18)

__device__ __forceinline__ unsigned xb_ld(unsigned* p)              { return __hip_atomic_load(p, __ATOMIC_RELAXED, __HIP_MEMORY_SCOPE_AGENT); }
__device__ __forceinline__ unsigned xb_add(unsigned* p, unsigned v) { return __hip_atomic_fetch_add(p, v, __ATOMIC_RELAXED, __HIP_MEMORY_SCOPE_AGENT); }
__device__ __forceinline__ unsigned xb_xcc_id() { return (unsigned)__builtin_amdgcn_s_getreg((3 << 11) | 20) & 0xFu; }
#define XB_SPIN(cond, bar) do { unsigned _sp = 0; while (cond) { __builtin_amdgcn_s_sleep(1); \
    if ((++_sp & 255u) == 0u) { if (xb_ld(&(bar)[XB_TMO])) break; if (_sp > XB_SPIN_CAP) { atomicAdd(&(bar)[XB_TMO], 1u); break; } } } } while (0)

struct XcdBarrier {
    unsigned* bar; unsigned x;
    volatile LAS unsigned* st;
};

__device__ __forceinline__ XcdBarrier xcd_barrier_post(unsigned* bar, volatile LAS unsigned* st) {
    XcdBarrier b; b.bar = bar; b.x = xb_xcc_id(); b.st = st;
    if (threadIdx.x == 0) (void)xb_add(&bar[XB_XCNT(b.x)], 1u);
    return b;
}
__device__ __forceinline__ void xcd_barrier_complete(unsigned* bar, unsigned x, unsigned& nloc, unsigned& nx) {
    const unsigned G = gridDim.x * gridDim.y * gridDim.z;
    unsigned sum, cnt, mine, sp = 0u;
    for (;;) {
        sum = 0u; cnt = 0u; mine = 0u;
#pragma unroll
        for (unsigned j = 0; j < 16; ++j) { const unsigned c = xb_ld(&bar[XB_XCNT(j)]); sum += c; cnt += (c > 0u) ? 1u : 0u; mine = (j == x) ? c : mine; }
        if (sum == G) break;
        __builtin_amdgcn_s_sleep(1);
        if ((++sp & 255u) == 0u) { if (xb_ld(&bar[XB_TMO])) break; if (sp > XB_SPIN_CAP) { atomicAdd(&bar[XB_TMO], 1u); break; } }
    }
    nloc = mine > 0u ? mine : 1u; nx = cnt > 0u ? cnt : 1u;
}

__device__ __forceinline__ void xcd_barrier(const XcdBarrier& b) {
    asm volatile("s_waitcnt vmcnt(0)" ::: "memory");
    __syncthreads();
    if (threadIdx.x == 0) {
        unsigned* bar = b.bar;
        __builtin_amdgcn_s_waitcnt(0);
        unsigned nloc = b.st[0], nx = b.st[1];
        if (nloc == 0u) { xcd_barrier_complete(bar, b.x, nloc, nx); b.st[0] = nloc; b.st[1] = nx; }
        const unsigned old = xb_add(&bar[XB_XSUB(b.x)], 1u);
        const unsigned gen = old / nloc;
        if (old + 1u == (gen + 1u) * nloc) {
            __builtin_amdgcn_fence(__ATOMIC_RELEASE, "agent");
            asm volatile("s_waitcnt vmcnt(0)" ::: "memory");
            const unsigned og = xb_add(&bar[XB_TOP], 1u);
            const unsigned tg = og / nx;
            if (og + 1u == (tg + 1u) * nx) xb_add(&bar[XB_TOPGEN], 1u);
            else XB_SPIN(xb_ld(&bar[XB_TOPGEN]) == tg, bar);
            __builtin_amdgcn_fence(__ATOMIC_ACQUIRE, "agent");
            xb_add(&bar[XB_XGEN(b.x)], 1u);
            asm volatile("s_waitcnt vmcnt(0)" ::: "memory");
        } else {
            XB_SPIN(xb_ld(&bar[XB_XGEN(b.x)]) == gen, bar);
            __builtin_amdgcn_fence(__ATOMIC_ACQUIRE, "agent");
            asm volatile("s_waitcnt vmcnt(0)" ::: "memory");
        }
    }
    __syncthreads();
}
typedef _Float16 f16;
typedef unsigned v2u __attribute__((ext_vector_type(2)));
typedef float f32x16 __attribute__((ext_vector_type(16)));
struct InPtrs { __device__ __forceinline__ const float* operator[](int i) const { return ((const float* const __attribute__((address_space(4)))*)__builtin_amdgcn_kernarg_segment_ptr())[i]; } };
struct Frame {
    LAS unsigned char* lds;
    volatile LAS unsigned* MISC;
    gu32* ctl;
    int tid, lane, wave;
    int vcu, G;
    InPtrs in; float* out; unsigned char* ws;
};
enum { I_X = 0, I_C, I_CTX, I_CCTX, I_WMOD, I_BMOD, I_NMIXG, I_NFFNG, I_WOUT, I_EWIN, I_ANORMG, I_AWS, I_ABS, I_BQNG, I_BKNG, I_LQ1, I_LK1, I_LQ2, I_LK2, I_SUBLNG,
       I_FW1, I_FW3, I_FW2, I_OWIN, I_CQNG, I_CKNG, I_CONVW, I_CONVB, I_DWA, I_DBA, I_DWX, I_DBX, I_DLAM, I_RW, I_RB, I_MW1, I_MW3, I_MW2 };

template <int CTRL> __device__ __forceinline__ float dpp_mov(float v) { return __builtin_bit_cast(float, __builtin_amdgcn_mov_dpp(__builtin_bit_cast(int, v), CTRL, 0xF, 0xF, true)); }
__device__ __forceinline__ float sum8(float v) { v += dpp_mov<0xB1>(v); v += dpp_mov<0x4E>(v); v += dpp_mov<0x141>(v); return v; }
__device__ __forceinline__ float wave_sum(float v) {
    v = sum8(v); v += dpp_mov<0x140>(v);
    v += __builtin_bit_cast(float, __builtin_amdgcn_update_dpp(0, __builtin_bit_cast(int, v), 0x142, 0xA, 0xF, false));
    v += __builtin_bit_cast(float, __builtin_amdgcn_update_dpp(0, __builtin_bit_cast(int, v), 0x143, 0xC, 0xF, false));
    return __builtin_bit_cast(float, __builtin_amdgcn_readlane(__builtin_bit_cast(int, v), 63));
}
__device__ __forceinline__ float bf_lo(unsigned u) { return __uint_as_float(u << 16); }
__device__ __forceinline__ float bf_hi(unsigned u) { return __uint_as_float(u & 0xffff0000u); }
__device__ __forceinline__ float bf2f(bf16 h) { return __uint_as_float((unsigned)h << 16); }
__device__ __forceinline__ unsigned cvtpk(float lo, float hi) { return pg8::cvt_pk_bf16(lo, hi); }
__device__ __forceinline__ bf16 f2bf16(float f) { return (bf16)(cvtpk(f, 0.f) & 0xffffu); }
__device__ __forceinline__ void unpack8(const v4u u, float (&f)[8]) { f[0] = bf_lo(u.x); f[1] = bf_hi(u.x); f[2] = bf_lo(u.y); f[3] = bf_hi(u.y); f[4] = bf_lo(u.z); f[5] = bf_hi(u.z); f[6] = bf_lo(u.w); f[7] = bf_hi(u.w); }
__device__ __forceinline__ v4u pack8(const float (&f)[8]) { v4u o; o.x = cvtpk(f[0], f[1]); o.y = cvtpk(f[2], f[3]); o.z = cvtpk(f[4], f[5]); o.w = cvtpk(f[6], f[7]); return o; }
__device__ __forceinline__ float gelu_tanh(float x) { const float p = fmaf(x * x, -0.10294324f, -2.3022082f); return x * __builtin_amdgcn_rcpf(1.0f + __builtin_amdgcn_exp2f(x * p)); }
__device__ __forceinline__ float sigmoid_f(float x) { return __builtin_amdgcn_rcpf(1.0f + __builtin_amdgcn_exp2f(-1.4426950408889634f * x)); }
__device__ __forceinline__ int crow16(int r, int hi) { return (r & 3) + 8 * (r >> 2) + 4 * hi; }

__device__ __forceinline__ bool qk_bounded(const float* gq, const float* gk, int lane) {
    float a = fabsf(gq[lane]), b = fabsf(gk[lane]);
#pragma unroll
    for (int o = 1; o < 64; o <<= 1) { a = fmaxf(a, __shfl_xor(a, o)); b = fmaxf(b, __shfl_xor(b, o)); }
    return __builtin_amdgcn_readfirstlane((int)(64.0f * QSCALE * a * b * 1.02f < 64.0f)) != 0;
}
struct TrItem { const float* W; unsigned char* WT; int K, N, ilv, f8, item; float scale; };
__device__ __forceinline__ void tr_load(const TrItem& d, int lane, f32x4 (&v)[8]) {
    const int nblk = d.N / 32, kb = d.item / nblk, nb = d.item % nblk; const float* p = d.W + (size_t)(64 * kb + (lane >> 3)) * d.N + 32 * nb + 4 * (lane & 7);
#pragma unroll
    for (int i = 0; i < 8; ++i) v[i] = *(const GAS f32x4*)(p + (size_t)(8 * i) * d.N);
}
__device__ __forceinline__ void tr_store(const TrItem& d, int lane, const f32x4 (&v)[8], LAS float* scr) {
    const int nblk = d.N / 32, kb = d.item / nblk, nb = d.item % nblk, k0 = 64 * kb, n0 = 32 * nb;
    const int r0 = d.ilv ? ((n0 >> 7) * 256 + (n0 & 127) + (d.ilv == 2 ? 128 : 0)) : n0;
#pragma unroll
    for (int i = 0; i < 8; ++i) { LAS float* q = scr + (8 * i + (lane >> 3)) * 33 + 4 * (lane & 7); q[0] = v[i].x * d.scale; q[1] = v[i].y * d.scale; q[2] = v[i].z * d.scale; q[3] = v[i].w * d.scale; }
    LDS_WAIT(); asm volatile("" ::: "memory");
    if (d.f8) { const int c = lane & 3;
#pragma unroll
        for (int j = 0; j < 2; ++j) { const int n = (lane >> 2) + 16 * j; const LAS float* s = scr + (16 * c) * 33 + n;
            v4u o; o.x = pg8::cvt4_fp8(s[0 * 33], s[1 * 33], s[2 * 33], s[3 * 33]); o.y = pg8::cvt4_fp8(s[4 * 33], s[5 * 33], s[6 * 33], s[7 * 33]);
            o.z = pg8::cvt4_fp8(s[8 * 33], s[9 * 33], s[10 * 33], s[11 * 33]); o.w = pg8::cvt4_fp8(s[12 * 33], s[13 * 33], s[14 * 33], s[15 * 33]);
            *(GAS v4u*)(d.WT + (size_t)(r0 + n) * d.K + k0 + 16 * c) = o; }
    } else { const int c = lane & 7;
#pragma unroll
        for (int j = 0; j < 4; ++j) { const int n = (lane >> 3) + 8 * j; const LAS float* s = scr + (8 * c) * 33 + n;
            v4u o; o.x = cvtpk(s[0 * 33], s[1 * 33]); o.y = cvtpk(s[2 * 33], s[3 * 33]); o.z = cvtpk(s[4 * 33], s[5 * 33]); o.w = cvtpk(s[6 * 33], s[7 * 33]);
            *(GAS v4u*)((bf16*)d.WT + (size_t)(r0 + n) * d.K + k0 + 8 * c) = o; } }
    LDS_WAIT(); asm volatile("" ::: "memory");
}
constexpr int TR_I_E = 16 * 80, TR_I_O = 16 * 32, TR_I_F = 16 * 88, TR_I_OI = 16 * 56, TR_I_EXP = 3 * TR_I_F;
constexpr int TR_NITEMS = TR_I_E + 2 * TR_I_O + 3 * TR_I_F + TR_I_OI + NEXP * TR_I_EXP;
static_assert(TR_I_F == 44 * 32, "item counts of the [1024][2816] and [2816][1024] matrices match");
__device__ __forceinline__ TrItem tr_decode(Frame& F, int it) {
    unsigned char* ws = F.ws; int r = it; TrItem d; d.f8 = 0; d.scale = 1.0f; d.ilv = 0;
    if (r < TR_I_E) { d.W = F.in[I_EWIN]; d.K = D; d.N = E_IN; d.WT = ws + WS_WE; d.item = r; return d; } r -= TR_I_E;
    if (r < TR_I_O) { d.W = F.in[I_WOUT]; d.K = D; d.N = D; d.WT = ws + WS_WO0; d.item = r; return d; } r -= TR_I_O;
    if (r < TR_I_O) { d.W = F.in[I_WOUT] + (size_t)D * D; d.K = D; d.N = D; d.WT = ws + WS_WO1; d.item = r; return d; } r -= TR_I_O;
    if (r < TR_I_F) { d.W = F.in[I_FW1]; d.K = D; d.N = FF; d.WT = ws + WS_WF13; d.ilv = 1; d.f8 = 1; d.scale = MOE_S13; d.item = r; return d; } r -= TR_I_F;
    if (r < TR_I_F) { d.W = F.in[I_FW3]; d.K = D; d.N = FF; d.WT = ws + WS_WF13; d.ilv = 2; d.f8 = 1; d.scale = MOE_S13; d.item = r; return d; } r -= TR_I_F;
    if (r < TR_I_F) { d.W = F.in[I_FW2]; d.K = FF; d.N = D; d.WT = ws + WS_WF2; d.f8 = 1; d.scale = MOE_S2; d.item = r; return d; } r -= TR_I_F;
    if (r < TR_I_OI) { d.W = F.in[I_OWIN]; d.K = D; d.N = O_IN; d.WT = ws + WS_WOI; d.item = r; return d; } r -= TR_I_OI;
    const int e = r / TR_I_EXP, q = r % TR_I_EXP; d.f8 = 1;
    if (q < TR_I_F) { d.W = F.in[I_MW1] + (size_t)e * D * FF; d.K = D; d.N = FF; d.WT = ws + WS_WM13 + (size_t)e * FF2 * D; d.ilv = 1; d.scale = MOE_S13; d.item = q; }
    else if (q < 2 * TR_I_F) { d.W = F.in[I_MW3] + (size_t)e * D * FF; d.K = D; d.N = FF; d.WT = ws + WS_WM13 + (size_t)e * FF2 * D; d.ilv = 2; d.scale = MOE_S13; d.item = q - TR_I_F; }
    else { d.W = F.in[I_MW2] + (size_t)e * FF * D; d.K = FF; d.N = D; d.WT = ws + WS_WM2 + (size_t)e * D * FF; d.scale = MOE_S2; d.item = q - 2 * TR_I_F; }
    return d;
}
constexpr int TR_DENSE = TR_I_E + TR_I_O;
__device__ __forceinline__ void tr_range(Frame& F, int lo, int hi) {
    LAS float* scr = (LAS float*)(F.lds + RING_OFF + F.wave * 16384);
    const int gw = F.vcu * NWAVES + F.wave, NGW = F.G * NWAVES, lane = F.lane;
    f32x4 v0[8], v1[8], v2[8], v3[8]; TrItem d0, d1, d2, d3; int it = lo + gw;
#define TR_ISSUE(d, v, idx) do { const int i_ = (idx); d = tr_decode(F, i_ < hi ? i_ : lo); if (i_ < hi) tr_load(d, lane, v); } while (0)
    TR_ISSUE(d0, v0, it); TR_ISSUE(d1, v1, it + NGW); TR_ISSUE(d2, v2, it + 2 * NGW);
    while (it < hi) {
        TR_ISSUE(d3, v3, it + 3 * NGW); tr_store(d0, lane, v0, scr); if (it + NGW >= hi) break;
        TR_ISSUE(d0, v0, it + 4 * NGW); tr_store(d1, lane, v1, scr); if (it + 2 * NGW >= hi) break;
        TR_ISSUE(d1, v1, it + 5 * NGW); tr_store(d2, lane, v2, scr); if (it + 3 * NGW >= hi) break;
        TR_ISSUE(d2, v2, it + 6 * NGW); tr_store(d3, lane, v3, scr);
        it += 4 * NGW; }
#undef TR_ISSUE
}
__device__ __forceinline__ void ph0_prologue(Frame& F) {
    const int lane = F.lane;
    tr_range(F, 0, TR_DENSE);
    { bf16* WG = (bf16*)(F.ws + WS_WG);
      for (int i = (int)blockIdx.x * 512 + F.tid; i < 2 * 2 * 8 * 64 * 64; i += F.G * 512) {
          const int k = i & 63, o = (i >> 6) & 63, n = (i >> 12) & 7, mat = (i >> 15) & 1, d = (i >> 16) & 1;
          const float* W = mat ? F.in[I_DWX] : F.in[I_DWA];
          WG[i] = f2bf16(W[((size_t)(d * 8 + n) * 64 + k) * 64 + o]); } }
    __syncthreads();
    { float* MOD = (float*)(F.ws + WS_MOD); LAS float* red = (LAS float*)(F.lds + RING_OFF);
      for (int cg = (int)blockIdx.x; cg < 2 * 96; cg += F.G) {
          const int layer = cg / 96, n0 = (cg % 96) * 64, kr = lane >> 4, c4 = lane & 15;
          f32x4 acc[3]; acc[0] = acc[1] = acc[2] = (f32x4){0.f, 0.f, 0.f, 0.f};
          const float* Wl = F.in[I_WMOD] + (size_t)layer * D * 6 * D;
#pragma unroll 4
          for (int it = 0; it < 32; ++it) { const int k = F.wave * 128 + 4 * it + kr;
              const f32x4 w = *(const GAS f32x4*)(Wl + (size_t)k * 6 * D + n0 + 4 * c4);
              const float c0 = F.in[I_C][k], c1 = F.in[I_C][D + k], c2 = F.in[I_CCTX][k];
              acc[0] += (c0 * sigmoid_f(c0)) * w; acc[1] += (c1 * sigmoid_f(c1)) * w; acc[2] += (c2 * sigmoid_f(c2)) * w; }
#pragma unroll
          for (int s = 0; s < 3; ++s)
#pragma unroll
              for (int j = 0; j < 4; ++j) { float v = acc[s][j]; v += __shfl_xor(v, 16); v += __shfl_xor(v, 32); acc[s][j] = v; }
          if (lane < 16) {
#pragma unroll
              for (int s = 0; s < 3; ++s)
#pragma unroll
                  for (int j = 0; j < 4; ++j) red[(F.wave * 3 + s) * 64 + 4 * c4 + j] = acc[s][j]; }
          __syncthreads();
          if (F.tid < 192) { const int s = F.tid >> 6, col = F.tid & 63; float v = F.in[I_BMOD][layer * 6 * D + n0 + col];
#pragma unroll
              for (int w = 0; w < 8; ++w) v += red[(w * 3 + s) * 64 + col];
              MOD[(size_t)(layer * 3 + s) * 6 * D + n0 + col] = v; }
          __syncthreads();
      } }
}
template <bool F8 = false, bool S16 = false> __device__ __forceinline__ void normmod_row(const float* src, const float* g, const float* sc, const float* sh, bf16* dst, int lane, f32x4 (&t)[4]) {
    const GAS f32x4* xr = (const GAS f32x4*)src + lane; float s = 0.f;
#pragma unroll
    for (int j = 0; j < 4; ++j) { if constexpr (S16) { const v2u w = ((const GAS v2u*)src)[lane + 64 * j]; t[j] = (f32x4){bf_lo(w.x), bf_hi(w.x), bf_lo(w.y), bf_hi(w.y)}; } else t[j] = xr[64 * j];
        s += (t[j].x * t[j].x + t[j].y * t[j].y) + (t[j].z * t[j].z + t[j].w * t[j].w); }
    const float rstd = 1.0f / sqrtf(wave_sum(s) * (1.f / D) + EPS);
    GAS v2u* o8 = (GAS v2u*)dst + lane;
#pragma unroll
    for (int j = 0; j < 4; ++j) { const f32x4 gg = ((const GAS f32x4*)g)[lane + 64 * j], cc = ((const GAS f32x4*)sc)[lane + 64 * j], hh = ((const GAS f32x4*)sh)[lane + 64 * j];
        t[j] = t[j] * rstd * gg * (1.0f + cc) + hh;
        if constexpr (F8) ((GAS unsigned*)dst)[lane + 64 * j] = pg8::cvt4_fp8(t[j].x, t[j].y, t[j].z, t[j].w); else { v2u w; w.x = cvtpk(t[j].x, t[j].y); w.y = cvtpk(t[j].z, t[j].w); o8[64 * j] = w; } }
}
template <bool S16> __device__ __forceinline__ void nm_load_row(const float* srcL, const float* srcC, int m, int lane, f32x4 (&t)[4]) {
    if constexpr (S16) { const GAS v2u* p = (const GAS v2u*)((const bf16*)(m < ML ? srcL : srcC) + (size_t)(m < ML ? m : m - ML) * D) + lane;
#pragma unroll
        for (int j = 0; j < 4; ++j) { const v2u w = p[64 * j]; t[j] = (f32x4){bf_lo(w.x), bf_hi(w.x), bf_lo(w.y), bf_hi(w.y)}; } }
    else { const GAS f32x4* p = (const GAS f32x4*)(m < ML ? srcL + (size_t)m * D : srcC + (size_t)(m - ML) * D) + lane;
#pragma unroll
        for (int j = 0; j < 4; ++j) t[j] = p[64 * j]; }
}
template <bool F8 = false, bool S16 = false> __device__ __forceinline__ void ph_normmod(Frame& F, const float* srcL, const float* srcC, int nrows, const float* g, int layer, int sh_off, int sc_off) {
    const int gw = F.vcu * NWAVES + F.wave, NGW = F.G * NWAVES, lane = F.lane; const float* MOD = (const float*)(F.ws + WS_MOD) + (size_t)layer * 3 * 6 * D; bf16* XN = (bf16*)(F.ws + WS_XN);
    int m = gw; if (m >= nrows) return;
    f32x4 tn[4], gm[4], hh[4]; int cur_s = -1; nm_load_row<S16>(srcL, srcC, m, lane, tn);
    for (; m < nrows; m += NGW) { f32x4 t[4]; float q = 0.f;
#pragma unroll
        for (int j = 0; j < 4; ++j) { t[j] = tn[j]; q += (t[j].x * t[j].x + t[j].y * t[j].y) + (t[j].z * t[j].z + t[j].w * t[j].w); }
        if (m + NGW < nrows) nm_load_row<S16>(srcL, srcC, m + NGW, lane, tn);
        const int s = m < SEQ ? 0 : (m < ML ? 1 : 2);
        if (s != cur_s) { cur_s = s; const float* sc = MOD + s * 6 * D + sc_off; const float* sh = MOD + s * 6 * D + sh_off;
#pragma unroll
            for (int j = 0; j < 4; ++j) { gm[j] = ((const GAS f32x4*)g)[lane + 64 * j] * (((const GAS f32x4*)sc)[lane + 64 * j] + 1.0f); hh[j] = ((const GAS f32x4*)sh)[lane + 64 * j]; } }
        const float rstd = __builtin_amdgcn_rsqf(wave_sum(q) * (1.f / D) + EPS);
        bf16* dst = F8 ? (bf16*)((unsigned char*)XN + (size_t)m * D) : XN + (size_t)m * D;
#pragma unroll
        for (int j = 0; j < 4; ++j) { const f32x4 o = t[j] * rstd * gm[j] + hh[j];
            if constexpr (F8) ((GAS unsigned*)dst)[lane + 64 * j] = pg8::cvt4_fp8(o.x, o.y, o.z, o.w); else { v2u w; w.x = cvtpk(o.x, o.y); w.y = cvtpk(o.z, o.w); ((GAS v2u*)dst)[lane + 64 * j] = w; } }
    }
}
struct RopeLane { float fr[8]; float sgn; int useRow; };
__device__ __forceinline__ RopeLane rope_lane(int lane) { RopeLane R; const int j = lane & 7; R.sgn = (j & 2) ? 1.f : -1.f; R.useRow = (j < 4);
#pragma unroll
    for (int e = 0; e < 8; ++e) R.fr[e] = __builtin_amdgcn_exp2f(-(float)((j & 1) * 8 + e) * (13.287712379549449f / 16.f)) * 0.15915494309189535f;
    return R; }
__device__ __forceinline__ void rope_cs(const RopeLane& R, int prow, int pcol, float (&cs)[8], float (&sn)[8]) {
    const float pos = (float)(R.useRow ? prow : pcol);
#pragma unroll
    for (int e = 0; e < 8; ++e) { float rev = pos * R.fr[e]; rev = rev - floorf(rev); cs[e] = __builtin_amdgcn_cosf(rev); sn[e] = R.sgn * __builtin_amdgcn_sinf(rev); }
}
__device__ __forceinline__ void qknorm_rope(float (&f)[8], const float* g, bool rope, const float (&cs)[8], const float (&sn)[8], float outscale, int lane) {
    float ss = 0.f;
#pragma unroll
    for (int e = 0; e < 8; ++e) ss += f[e] * f[e];
    ss = sum8(ss);
    const float rstd = outscale * __builtin_amdgcn_rsqf(ss * (1.f / 64.f) + EPS); const int j = lane & 7;
    const f32x4 g0 = *(const GAS f32x4*)(g + 8 * j), g1 = *(const GAS f32x4*)(g + 8 * j + 4);
    const float gg[8] = {g0.x, g0.y, g0.z, g0.w, g1.x, g1.y, g1.z, g1.w};
#pragma unroll
    for (int e = 0; e < 8; ++e) f[e] = f[e] * (rstd * gg[e]);
    if (rope) {
#pragma unroll
        for (int e = 0; e < 8; ++e) { const float p = dpp_mov<0x4E>(f[e]); f[e] = f[e] * cs[e] + p * sn[e]; }
    }
}
__device__ __forceinline__ void ph3_post0(Frame& F) {
    const int gw = F.vcu * NWAVES + F.wave, NGW = F.G * NWAVES, lane = F.lane; bf16* P0 = (bf16*)(F.ws + WS_P0); bf16* KC = (bf16*)(F.ws + WS_KC0); bf16* VC = (bf16*)(F.ws + WS_VC0); const RopeLane RL = rope_lane(lane);
    for (int m = gw; m < MR; m += NGW) {
        GAS v4u* rowp = (GAS v4u*)(P0 + (size_t)m * E_IN) + lane;
        const v4u u0 = rowp[0], u1 = rowp[64], u2 = rowp[128], u3 = rowp[192];
        float f[8];
        unpack8(u0, f);
#pragma unroll
        for (int e = 0; e < 8; ++e) f[e] = gelu_tanh(f[e]);
        rowp[0] = pack8(f);
        unpack8(u1, f); float ss = 0.f;
#pragma unroll
        for (int e = 0; e < 8; ++e) { f[e] = gelu_tanh(f[e]); ss += f[e] * f[e]; }
        { const float rstd = 1.0f / sqrtf(wave_sum(ss) * (1.f / 512.f) + EPS); const float* g = F.in[I_ANORMG] + 8 * lane;
          const f32x4 g0 = *(const GAS f32x4*)g, g1 = *(const GAS f32x4*)(g + 4); const float gg[8] = {g0.x, g0.y, g0.z, g0.w, g1.x, g1.y, g1.z, g1.w};
#pragma unroll
          for (int e = 0; e < 8; ++e) f[e] = f[e] * rstd * gg[e]; }
        rowp[64] = pack8(f);
        const bool lat = m < ML; const int t = m & (SEQ - 1), prow = t >> 6, pcol = t & 63; float cs[8], sn[8]; if (lat) rope_cs(RL, prow, pcol, cs, sn);
        unpack8(u2, f); qknorm_rope(f, F.in[I_BQNG], lat, cs, sn, QSCALE, lane); rowp[128] = pack8(f);
        unpack8(u3, f); qknorm_rope(f, F.in[I_BKNG], lat, cs, sn, 1.0f, lane);
        { const int b = lat ? (m >> 13) : ((m - ML) >> 8), pos = lat ? CTXL + t : ((m - ML) & (CTXL - 1)); const size_t tb = (size_t)(pos >> 6) * 4096; const int pr = pos & 63;
          *(GAS v4u*)(KC + ((size_t)(b * 8 + (lane >> 3)) * KEYS * 64 + tb + (lane & 7) * 512 + pr * 8)) = pack8(f);
          const v4u u4 = rowp[256];
          *(GAS v4u*)(VC + ((size_t)(b * 8 + (lane >> 3)) * KEYS * 64 + tb + ((((lane & 7) >> 2) * 4 + (pr >> 4)) * 64 + (pr & 15) * 4 + (lane & 3)) * 8)) = u4; }
    }
}
__device__ __forceinline__ void gmlp_unit(Frame& F, int chunk) {
    const int lane = F.lane, r32 = lane & 31, hi = lane >> 5, g = F.wave, r0 = chunk * 128;
    const bf16* P0 = (const bf16*)(F.ws + WS_P0); bf16* Y = (bf16*)(F.ws + WS_Y);
    const float* ws = F.in[I_AWS] + (size_t)g * 128 * 128; const float* bs = F.in[I_ABS] + g * 128;
    bf16x8 afr[2][8];
#pragma unroll
    for (int ct = 0; ct < 2; ++ct)
#pragma unroll
        for (int ks = 0; ks < 8; ++ks)
#pragma unroll
            for (int e = 0; e < 8; ++e) afr[ct][ks][e] = (short)P0[(size_t)(r0 + 16 * ks + 8 * hi + e) * E_IN + 512 + 64 * g + 32 * ct + r32];
#pragma unroll 1
    for (int pt = 0; pt < 4; ++pt) {
        f32x16 acc[2]; acc[0] = f32x16{}; acc[1] = f32x16{};
        const float* wp = ws + (size_t)(32 * pt + r32) * 128 + 8 * hi;
#pragma unroll
        for (int ks = 0; ks < 8; ++ks) { const f32x4 w0 = *(const GAS f32x4*)(wp + 16 * ks), w1 = *(const GAS f32x4*)(wp + 16 * ks + 4);
            v4u pk; pk.x = cvtpk(w0.x, w0.y); pk.y = cvtpk(w0.z, w0.w); pk.z = cvtpk(w1.x, w1.y); pk.w = cvtpk(w1.z, w1.w); const bf16x8 bfr = __builtin_bit_cast(bf16x8, pk);
            acc[0] = __builtin_amdgcn_mfma_f32_32x32x16_bf16(afr[0][ks], bfr, acc[0], 0, 0, 0); acc[1] = __builtin_amdgcn_mfma_f32_32x32x16_bf16(afr[1][ks], bfr, acc[1], 0, 0, 0); }
        const int p = 32 * pt + r32; const float bias = bs[p];
#pragma unroll
        for (int ct = 0; ct < 2; ++ct)
#pragma unroll
            for (int rq = 0; rq < 4; ++rq) { const int c0 = 64 * g + 32 * ct + 8 * rq + 4 * hi;
                const v2u uu = *(const GAS v2u*)(P0 + (size_t)(r0 + p) * E_IN + c0);
                v2u o; o.x = cvtpk(bf_lo(uu.x) * (acc[ct][4 * rq + 0] + bias), bf_hi(uu.x) * (acc[ct][4 * rq + 1] + bias)); o.y = cvtpk(bf_lo(uu.y) * (acc[ct][4 * rq + 2] + bias), bf_hi(uu.y) * (acc[ct][4 * rq + 3] + bias));
                *(GAS v2u*)(Y + (size_t)(r0 + p) * D + c0) = o; }
    }
}
__device__ __forceinline__ void ph5_diffout(Frame& F) {
    const int gw = F.vcu * NWAVES + F.wave, NGW = F.G * NWAVES, lane = F.lane; const bf16* OA = (const bf16*)(F.ws + WS_OATT); bf16* Y = (bf16*)(F.ws + WS_Y);
    const float s1 = wave_sum(F.in[I_LQ1][lane] * F.in[I_LK1][lane]), s2 = wave_sum(F.in[I_LQ2][lane] * F.in[I_LK2][lane]);
    const float lam_init = 0.2f, lam = expf(s1) - expf(s2) + lam_init;
    const int h = lane >> 4, comp = (lane >> 3) & 1, i0 = (lane & 7) * 16;
    float gg[16];
#pragma unroll
    for (int q = 0; q < 4; ++q) { const f32x4 gv = *(const GAS f32x4*)(F.in[I_SUBLNG] + i0 + 4 * q); gg[4 * q] = gv.x; gg[4 * q + 1] = gv.y; gg[4 * q + 2] = gv.z; gg[4 * q + 3] = gv.w; }
    for (int m = gw; m < MR; m += NGW) {
        const GAS v4u* rp = (const GAS v4u*)(OA + (size_t)m * D + 16 * lane);
        const v4u a = rp[0], b = rp[1]; float own[16], d[16];
        { float t8[8]; unpack8(a, t8);
#pragma unroll
          for (int e = 0; e < 8; ++e) own[e] = t8[e];
          unpack8(b, t8);
#pragma unroll
          for (int e = 0; e < 8; ++e) own[8 + e] = t8[e]; }
        float ss = 0.f;
#pragma unroll
        for (int e = 0; e < 16; ++e) { const float oth = __shfl_xor(own[e], 8); const float o1 = comp ? oth : own[e], o2 = comp ? own[e] : oth; d[e] = o1 - lam * o2; ss += d[e] * d[e]; }
        ss += __shfl_xor(ss, 1); ss += __shfl_xor(ss, 2); ss += __shfl_xor(ss, 4);
        const float rstd = (1.0f - lam_init) / sqrtf(ss * (1.f / 128.f) + EPS);
        if (comp == 0) { float o8[8]; GAS v4u* yp = (GAS v4u*)(Y + (size_t)m * D + 512 + 128 * h + i0);
#pragma unroll
            for (int e = 0; e < 8; ++e) o8[e] = d[e] * rstd * gg[e];
            yp[0] = pack8(o8);
#pragma unroll
            for (int e = 0; e < 8; ++e) o8[e] = d[8 + e] * rstd * gg[8 + e];
            yp[1] = pack8(o8); }
    }
}
__device__ __forceinline__ void ph12_post1(Frame& F) {
    const int nskip = (NCHUNK > F.G && NCHUNK - F.G < F.G / 2) ? NCHUNK - F.G : 0;
    if (F.vcu < nskip) return;
    const int gw = (F.vcu - nskip) * NWAVES + F.wave, NGW = (F.G - nskip) * NWAVES, lane = F.lane; bf16* P1 = (bf16*)(F.ws + WS_P1); bf16* KC = (bf16*)(F.ws + WS_KC1); bf16* VC = (bf16*)(F.ws + WS_VC1); const RopeLane RL = rope_lane(lane);
    for (int m = gw; m < MR; m += NGW) {
        GAS v4u* rowp = (GAS v4u*)(P1 + (size_t)m * O_IN) + lane;
        const v4u u0 = rowp[0], u1 = rowp[64];
        const bool lat = m < ML; const int t = m & (SEQ - 1), prow = t >> 6, pcol = t & 63; float f[8]; float cs[8], sn[8]; if (lat) rope_cs(RL, prow, pcol, cs, sn);
        unpack8(u0, f); qknorm_rope(f, F.in[I_CQNG], lat, cs, sn, QSCALE, lane); if (lat) rowp[0] = pack8(f);
        unpack8(u1, f); qknorm_rope(f, F.in[I_CKNG], lat, cs, sn, 1.0f, lane);
        { const int b = lat ? (m >> 13) : ((m - ML) >> 8), pos = lat ? CTXL + t : ((m - ML) & (CTXL - 1)); const size_t tb = (size_t)(pos >> 6) * 4096; const int pr = pos & 63, l2 = lane & 15;
          if (lane < 16) *(GAS v4u*)(KC + ((size_t)(b * 2 + (l2 >> 3)) * KEYS * 64 + tb + (l2 & 7) * 512 + pr * 8)) = pack8(f);
          else if (lane < 32) *(GAS v4u*)(VC + ((size_t)(b * 2 + (l2 >> 3)) * KEYS * 64 + tb + ((((l2 & 7) >> 2) * 4 + (pr >> 4)) * 64 + (pr & 15) * 4 + (l2 & 3)) * 8)) = u1; }
    }
}
__device__ __forceinline__ bool seq_start(int r) { return r < ML ? (r & (SEQ - 1)) == 0 : ((r - ML) & (CTXL - 1)) == 0; }
constexpr int XDS = 520;
__device__ __forceinline__ void conv_to_lds(Frame& F, int r0, LAS bf16* XD) {
    const int cg = F.lane, w = F.wave; const bf16* P1 = (const bf16*)(F.ws + WS_P1);
    const bool st = seq_start(r0), en = seq_start(r0 + 64) || (r0 + 64 == MR);
    float wj[4][8], cb[8];
#pragma unroll
    for (int j = 0; j < 4; ++j) { const f32x4 a = *(const GAS f32x4*)(F.in[I_CONVW] + j * 512 + 8 * cg), b = *(const GAS f32x4*)(F.in[I_CONVW] + j * 512 + 8 * cg + 4);
        wj[j][0] = a.x; wj[j][1] = a.y; wj[j][2] = a.z; wj[j][3] = a.w; wj[j][4] = b.x; wj[j][5] = b.y; wj[j][6] = b.z; wj[j][7] = b.w; }
    { const f32x4 a = *(const GAS f32x4*)(F.in[I_CONVB] + 8 * cg), b = *(const GAS f32x4*)(F.in[I_CONVB] + 8 * cg + 4); cb[0] = a.x; cb[1] = a.y; cb[2] = a.z; cb[3] = a.w; cb[4] = b.x; cb[5] = b.y; cb[6] = b.z; cb[7] = b.w; }
    v4u xr[11];
#pragma unroll
    for (int i = 0; i < 11; ++i) { const int rl = 8 * w + i - 2; const bool ok = !((st && rl < 0) || (en && rl >= 64));
        xr[i] = ok ? *(const GAS v4u*)(P1 + (size_t)(r0 + rl) * O_IN + 1280 + 8 * cg) : (v4u){0u, 0u, 0u, 0u}; }
    float acc[8][8];
#pragma unroll
    for (int o = 0; o < 8; ++o)
#pragma unroll
        for (int e = 0; e < 8; ++e) acc[o][e] = cb[e];
#pragma unroll
    for (int i = 0; i < 11; ++i) { float f[8]; unpack8(xr[i], f);
#pragma unroll
        for (int j = 0; j < 4; ++j) { const int o = i - j; if (o >= 0 && o < 8) {
#pragma unroll
            for (int e = 0; e < 8; ++e) acc[o][e] += wj[j][e] * f[e]; } } }
#pragma unroll
    for (int o = 0; o < 8; ++o) *(LAS v4u*)(XD + (8 * w + o) * XDS + 8 * cg) = pack8(acc[o]);
}
struct LruW { bf16x8 wr[4], wi[4]; float nba, nbx, spl; };
__device__ __forceinline__ void lru_load(Frame& F, int n, int d, int half, LruW& W) {
    const int lane = F.lane, r32 = lane & 31, hi = lane >> 5; const bf16* WG = (const bf16*)(F.ws + WS_WG);
    const bf16* wpr = WG + ((size_t)(((d * 2 + 0) * 8 + n) * 64 + 32 * half + r32)) * 64 + 8 * hi; const bf16* wpi = WG + ((size_t)(((d * 2 + 1) * 8 + n) * 64 + 32 * half + r32)) * 64 + 8 * hi;
#pragma unroll
    for (int ks = 0; ks < 4; ++ks) { W.wr[ks] = *(const GAS bf16x8*)(wpr + 16 * ks); W.wi[ks] = *(const GAS bf16x8*)(wpi + 16 * ks); }
    const int ch = 64 * n + 32 * half + r32;
    W.nba = -1.4426950408889634f * F.in[I_DBA][d * 512 + ch]; W.nbx = -1.4426950408889634f * F.in[I_DBX][d * 512 + ch];
    W.spl = -8.0f * 1.4426950408889634f * log1pf(expf(-F.in[I_DLAM][d * 512 + ch]));
}
__device__ __forceinline__ void lru_gates(Frame& F, const LAS bf16* XD, int n, int half, const LruW& W, f32x16 (&a)[2], f32x16 (&b)[2]) {
    const int lane = F.lane, r32 = lane & 31, hi = lane >> 5;
    f32x16 ai[2]; a[0] = f32x16{}; a[1] = f32x16{}; ai[0] = f32x16{}; ai[1] = f32x16{};
#pragma unroll
    for (int ks = 0; ks < 4; ++ks) {
#pragma unroll
        for (int mt = 0; mt < 2; ++mt) { const bf16x8 af = *(const LAS bf16x8*)(XD + (32 * mt + r32) * XDS + 64 * n + 16 * ks + 8 * hi);
            a[mt] = __builtin_amdgcn_mfma_f32_32x32x16_bf16(af, W.wr[ks], a[mt], 0, 0, 0); ai[mt] = __builtin_amdgcn_mfma_f32_32x32x16_bf16(af, W.wi[ks], ai[mt], 0, 0, 0); } }
    __builtin_amdgcn_sched_barrier(0);
    const int ch = 64 * n + 32 * half + r32; const float nba = W.nba, nbx = W.nbx, spl = W.spl;
#pragma unroll
    for (int mt = 0; mt < 2; ++mt)
#pragma unroll
        for (int r = 0; r < 16; ++r) { const int row = 32 * mt + crow16(r, hi); const float xd = bf2f(XD[row * XDS + ch]);
            const float rr = __builtin_amdgcn_rcpf(1.0f + __builtin_amdgcn_exp2f(fmaf(a[mt][r], -1.4426950408889634f, nba))), ii = __builtin_amdgcn_rcpf(1.0f + __builtin_amdgcn_exp2f(fmaf(ai[mt][r], -1.4426950408889634f, nbx)));
            const float av = __builtin_amdgcn_exp2f(rr * spl), om = fmaxf(fmaf(-av, av, 1.0f), 0.0f);
            a[mt][r] = av; b[mt][r] = __builtin_amdgcn_sqrtf(om) * (ii * xd); if ((r & 3) == 3) __builtin_amdgcn_sched_barrier(0); }
}
template <bool REV, bool FULL> __device__ __forceinline__ void chunk_scan(f32x16 (&a)[2], f32x16 (&b)[2], int hi, float h0, float& Atot, float& Btot) {
    float GA[8], GB[8], pGA[8], pGB[8], carry[8];
#pragma unroll
    for (int j = 0; j < 8; ++j) { const int mt = j >> 2, q = j & 3;
#pragma unroll
        for (int p = 1; p < 4; ++p) { const int k = REV ? 3 - p : p, kp = REV ? k + 1 : k - 1; const float ak = a[mt][4 * q + k];
            b[mt][4 * q + k] = ak * b[mt][4 * q + kp] + b[mt][4 * q + k]; a[mt][4 * q + k] = ak * a[mt][4 * q + kp]; }
        GA[j] = a[mt][4 * q + (REV ? 0 : 3)]; GB[j] = b[mt][4 * q + (REV ? 0 : 3)]; }
#pragma unroll
    for (int j = 0; j < 8; ++j) { const auto ra = __builtin_amdgcn_permlane32_swap(__float_as_uint(GA[j]), __float_as_uint(GA[j]), false, false); pGA[j] = __uint_as_float(hi ? ra[0] : ra[1]);
        const auto rb = __builtin_amdgcn_permlane32_swap(__float_as_uint(GB[j]), __float_as_uint(GB[j]), false, false); pGB[j] = __uint_as_float(hi ? rb[0] : rb[1]); }
    float c = h0, At = 1.0f; const bool firstMine = REV ? (hi == 1) : (hi == 0);
#pragma unroll
    for (int jj = 0; jj < 8; ++jj) { const int j = REV ? 7 - jj : jj;
        const float A1 = firstMine ? GA[j] : pGA[j], B1 = firstMine ? GB[j] : pGB[j], A2 = firstMine ? pGA[j] : GA[j], B2 = firstMine ? pGB[j] : GB[j];
        const float c1 = A1 * c + B1; carry[j] = firstMine ? c : c1; c = A2 * c1 + B2; At *= GA[j] * pGA[j]; }
    Atot = At; Btot = c;
    if constexpr (FULL) {
#pragma unroll
        for (int j = 0; j < 8; ++j) { const int mt = j >> 2, q = j & 3;
#pragma unroll
            for (int k = 0; k < 4; ++k) b[mt][4 * q + k] = a[mt][4 * q + k] * carry[j] + b[mt][4 * q + k]; }
    }
}
__device__ __forceinline__ void scan_prep_unit(Frame& F, int cid) {
    const int r0 = cid * 64, lane = F.lane, r32 = lane & 31, hi = lane >> 5, n = F.wave; LAS bf16* XD = (LAS bf16*)(F.lds + RING_OFF); float* AGG = (float*)(F.ws + WS_AGG);
    conv_to_lds(F, r0, XD);
    LDS_WAIT(); __syncthreads();
    LruW W0, W1; lru_load(F, n, 0, 0, W0);
#pragma unroll
    for (int d = 0; d < 2; ++d)
#pragma unroll
        for (int half = 0; half < 2; ++half) { f32x16 a[2], b[2]; const int nk = 2 * d + half + 1; if (nk < 4) lru_load(F, n, nk >> 1, nk & 1, W1);
            lru_gates(F, XD, n, half, W0, a, b); W0 = W1; float At, Bt;
            if (d == 0) chunk_scan<false, false>(a, b, hi, 0.f, At, Bt); else chunk_scan<true, false>(a, b, hi, 0.f, At, Bt);
            if (hi == 0) { const int ch = 64 * n + 32 * half + r32; AGG[((size_t)(d * NCHUNK + cid) * 2 + 0) * 512 + ch] = At; AGG[((size_t)(d * NCHUNK + cid) * 2 + 1) * 512 + ch] = Bt; } }
    LDS_WAIT(); __syncthreads();
}
__device__ __forceinline__ void scan_fix_unit(Frame& F, int cid) {
    const int b = cid >> 7, j = cid & 127, r0 = cid * 64, lane = F.lane, r32 = lane & 31, hi = lane >> 5, n = F.wave;
    const float* AGG = (const float*)(F.ws + WS_AGG); const bf16* P1 = (const bf16*)(F.ws + WS_P1); bf16* Y = (bf16*)(F.ws + WS_Y);
    LAS bf16* XD = (LAS bf16*)(F.lds + RING_OFF); LAS float* CAR = (LAS float*)(F.lds + RING_OFF + 64 * XDS * 2);
    conv_to_lds(F, r0, XD);
    asm volatile("" ::: "memory"); __builtin_amdgcn_sched_barrier(0);
    { const int ch = F.tid; const float* A0 = AGG + ch; const float* A1 = AGG + (size_t)NCHUNK * 1024 + ch;
      float hf = 0.f, hb = 0.f;
#pragma unroll
      for (int q = 0; q < 4; ++q) { const int c = 256 + 4 * b + q; hf = A0[(size_t)c * 1024] * hf + A0[(size_t)c * 1024 + 512]; }
#pragma unroll 8
      for (int q = 0; q < j; ++q) { const int c = 128 * b + q; hf = A0[(size_t)c * 1024] * hf + A0[(size_t)c * 1024 + 512]; }
#pragma unroll
      for (int q = 3; q >= 0; --q) { const int c = 256 + 4 * b + q; hb = A1[(size_t)c * 1024] * hb + A1[(size_t)c * 1024 + 512]; }
#pragma unroll 8
      for (int q = 127; q > j; --q) { const int c = 128 * b + q; hb = A1[(size_t)c * 1024] * hb + A1[(size_t)c * 1024 + 512]; }
      CAR[ch] = hf; CAR[512 + ch] = hb; }
    LDS_WAIT(); __syncthreads();
#pragma unroll 1
    for (int half = 0; half < 2; ++half) { const int ch = 64 * n + 32 * half + r32; f32x16 a[2], hf[2], hb[2]; float At, Bt;
        LruW W0, W1; lru_load(F, n, 0, half, W0); lru_load(F, n, 1, half, W1);
        lru_gates(F, XD, n, half, W0, a, hf); chunk_scan<false, true>(a, hf, hi, CAR[ch], At, Bt);
        __builtin_amdgcn_sched_barrier(0); lru_gates(F, XD, n, half, W1, a, hb); chunk_scan<true, true>(a, hb, hi, CAR[512 + ch], At, Bt);
        const bf16* gp = P1 + (size_t)r0 * O_IN + 768; bf16* yp = Y + (size_t)r0 * D + 512;
#pragma unroll
        for (int mt = 0; mt < 2; ++mt)
#pragma unroll
            for (int q = 0; q < 4; ++q) {
#pragma unroll
                for (int k = 0; k < 4; ++k) { const unsigned rl = (unsigned)(32 * mt + 8 * q + 4 * hi + k); const float gt = bf2f(gp[rl * (unsigned)O_IN + (unsigned)ch]);
                    yp[rl * (unsigned)D + (unsigned)ch] = f2bf16((hf[mt][4 * q + k] + hb[mt][4 * q + k]) * gelu_tanh(gt)); }
                asm volatile("" ::: "memory"); } }
    LDS_WAIT(); __syncthreads();
}
__device__ __forceinline__ void ph15_router(Frame& F) {
    LAS float* WR = (LAS float*)(F.lds + RING_OFF);
    LAS int* lcnt = (LAS int*)(F.lds + RING_OFF + 32768); LAS int* lbase = lcnt + 8; LAS int* rec = lcnt + 16;
    LAS unsigned char* STG = F.lds + RING_OFF + 40960;
    const int lane = F.lane; const float* MOD = (const float*)(F.ws + WS_MOD) + (size_t)3 * 6 * D; unsigned char* XG = F.ws + WS_XG; int* TOK = (int*)(F.ws + WS_TOK);
    for (int i = F.tid; i < 1024 * 8 / 4; i += NWAVES * 64) { const int c = i >> 1, hf = i & 1; ((LAS f32x4*)WR)[hf * 1024 + ((c >> 8) * 4 + (c & 3)) * 64 + ((c & 255) >> 2)] = ((const GAS f32x4*)F.in[I_RW])[i]; }
    __syncthreads();
    for (int rb = F.vcu; rb < ML / 64; rb += F.G) {
        if (F.tid < 8) lcnt[F.tid] = 0;
        __syncthreads();
        f32x4 tn[4];
        const bf16* X3 = (const bf16*)(F.ws + WS_X3);
        { const GAS v2u* xr0 = (const GAS v2u*)(X3 + (size_t)(rb * 64 + F.wave * 8) * D) + lane;
#pragma unroll
          for (int j = 0; j < 4; ++j) { const v2u w = xr0[64 * j]; tn[j] = (f32x4){bf_lo(w.x), bf_hi(w.x), bf_lo(w.y), bf_hi(w.y)}; } }
#pragma unroll 4
        for (int i = 0; i < 8; ++i) { const int rl = F.wave * 8 + i, m = rb * 64 + rl, s = m >> 13; f32x4 t[4];
            { float q = 0.f;
#pragma unroll
              for (int j = 0; j < 4; ++j) { t[j] = tn[j]; q += (t[j].x * t[j].x + t[j].y * t[j].y) + (t[j].z * t[j].z + t[j].w * t[j].w); }
              if (i < 7) { const GAS v2u* xr = (const GAS v2u*)(X3 + (size_t)(m + 1) * D) + lane;
#pragma unroll
                  for (int j = 0; j < 4; ++j) { const v2u w = xr[64 * j]; tn[j] = (f32x4){bf_lo(w.x), bf_hi(w.x), bf_lo(w.y), bf_hi(w.y)}; } }
              const float rstd = 1.0f / sqrtf(wave_sum(q) * (1.f / D) + EPS); const float* g = F.in[I_NFFNG] + D; const float* sc = MOD + s * 6 * D + 4 * D; const float* sh = MOD + s * 6 * D + 3 * D;
#pragma unroll
              for (int j = 0; j < 4; ++j) { const f32x4 gg = ((const GAS f32x4*)g)[lane + 64 * j], cc = ((const GAS f32x4*)sc)[lane + 64 * j], hh = ((const GAS f32x4*)sh)[lane + 64 * j];
                  t[j] = t[j] * rstd * gg * (1.0f + cc) + hh; ((LAS unsigned*)(STG + rl * 1024))[lane + 64 * j] = pg8::cvt4_fp8(t[j].x, t[j].y, t[j].z, t[j].w); } }
            float lg[8];
#pragma unroll
            for (int e = 0; e < 8; ++e) lg[e] = 0.f;
#pragma unroll
            for (int j = 0; j < 4; ++j)
#pragma unroll
                for (int k = 0; k < 4; ++k) { const f32x4 w0 = ((const LAS f32x4*)WR)[(j * 4 + k) * 64 + lane], w1 = ((const LAS f32x4*)WR)[1024 + (j * 4 + k) * 64 + lane]; const float tv = t[j][k];
                    lg[0] += tv * w0.x; lg[1] += tv * w0.y; lg[2] += tv * w0.z; lg[3] += tv * w0.w; lg[4] += tv * w1.x; lg[5] += tv * w1.y; lg[6] += tv * w1.z; lg[7] += tv * w1.w; }
#pragma unroll
            for (int e = 0; e < 8; ++e) lg[e] = wave_sum(lg[e]) + F.in[I_RB][e];
            int e1 = 0; float v1 = lg[0];
#pragma unroll
            for (int e = 1; e < 8; ++e) if (lg[e] > v1) { v1 = lg[e]; e1 = e; }
            int e2 = -1; float v2 = -INFINITY;
#pragma unroll
            for (int e = 0; e < 8; ++e) if (e != e1 && lg[e] > v2) { v2 = lg[e]; e2 = e; }
            const float g1 = 1.0f / (1.0f + expf(v2 - v1)), g2 = 1.0f - g1;
            if (lane == 0) { LAS int* rc = rec + rl * 6; rc[0] = e1; rc[1] = e2; rc[2] = (int)__hip_atomic_fetch_add((LAS unsigned*)(lcnt + e1), 1u, __ATOMIC_RELAXED, __HIP_MEMORY_SCOPE_WORKGROUP);
                rc[3] = (int)__hip_atomic_fetch_add((LAS unsigned*)(lcnt + e2), 1u, __ATOMIC_RELAXED, __HIP_MEMORY_SCOPE_WORKGROUP); rc[4] = __float_as_int(g1); rc[5] = __float_as_int(g2); }
        }
        LDS_WAIT(); __syncthreads();
        if (F.tid < 8) lbase[F.tid] = (int)__hip_atomic_fetch_add((unsigned*)(F.ctl + CW_CNT + 64 * F.tid), (unsigned)lcnt[F.tid], __ATOMIC_RELAXED, __HIP_MEMORY_SCOPE_AGENT);
        LDS_WAIT(); __syncthreads();
        if (F.tid < 64) { const LAS int* rc = rec + F.tid * 6; int* tk = TOK + (size_t)(rb * 64 + F.tid) * 6;
            tk[0] = rc[0]; tk[1] = rc[1]; tk[2] = lbase[rc[0]] + rc[2]; tk[3] = lbase[rc[1]] + rc[3]; tk[4] = rc[4]; tk[5] = rc[5]; }
#pragma unroll
        for (int i = 0; i < 8; ++i) { const int rl = F.wave * 8 + i; const LAS int* rc = rec + rl * 6; const v4u row = *(const LAS v4u*)(STG + rl * 1024 + 16 * lane);
            const int e1 = rc[0], e2 = rc[1], p1 = lbase[e1] + rc[2], p2 = lbase[e2] + rc[3];
            *(GAS v4u*)(XG + ((size_t)e1 * ML + p1) * D + 16 * lane) = row; *(GAS v4u*)(XG + ((size_t)e2 * ML + p2) * D + 16 * lane) = row; }
        LDS_WAIT(); __syncthreads();
    }
}
__device__ __forceinline__ void moe_offsets(Frame& F, int (&off)[9]) {
    int o = 0;
#pragma unroll
    for (int e = 0; e < 8; ++e) { off[e] = o; const int c = (int)__hip_atomic_load((unsigned*)(F.ctl + CW_CNT + 64 * e), __ATOMIC_RELAXED, __HIP_MEMORY_SCOPE_AGENT); o += (c + 255) & ~255; }
    off[8] = o;
}
__device__ __forceinline__ int moe_tables(Frame& F) {
    int off[9]; moe_offsets(F, off); LAS int* pexp = (LAS int*)(F.lds + PEXP_OFF);
    if (F.tid < MOE_PAN) { const int r = F.tid * 256; int e = 0;
#pragma unroll
        for (int q = 1; q < 8; ++q) e = (r >= off[q]) ? q : e;
        pexp[F.tid] = e; }
    if (F.tid < 8) pexp[140 + F.tid] = off[F.tid] / 256;
    __syncthreads();
    return off[8] / 256;
}
__device__ __forceinline__ void ph19_combine(Frame& F) {
    int off[9]; moe_offsets(F, off);
    const int gw = F.vcu * NWAVES + F.wave, NGW = F.G * NWAVES, lane = F.lane; const bf16* YG = (const bf16*)(F.ws + WS_YG); const int* TOK = (const int*)(F.ws + WS_TOK);
    const float* MOD = (const float*)(F.ws + WS_MOD) + (size_t)3 * 6 * D;
    for (int m = gw; m < ML; m += NGW) { const int* tk = TOK + (size_t)m * 6; const int e1 = tk[0], e2 = tk[1]; int b1 = 0, b2 = 0;
#pragma unroll
        for (int q = 0; q < 8; ++q) { b1 = (e1 == q) ? off[q] : b1; b2 = (e2 == q) ? off[q] : b2; }
        const float g1 = __int_as_float(tk[4]), g2 = __int_as_float(tk[5]); const float* gp = MOD + (m >> 13) * 6 * D + 5 * D;
        const GAS v2u* y1 = (const GAS v2u*)(YG + (size_t)(b1 + tk[2]) * D) + lane; const GAS v2u* y2 = (const GAS v2u*)(YG + (size_t)(b2 + tk[3]) * D) + lane;
        GAS f32x4* o = (GAS f32x4*)(F.out + (size_t)m * D) + lane; const GAS v2u* x3 = (const GAS v2u*)((const bf16*)(F.ws + WS_X3) + (size_t)m * D) + lane;
#pragma unroll
        for (int j = 0; j < 4; ++j) { const v2u a = y1[64 * j], b = y2[64 * j]; const f32x4 gv = ((const GAS f32x4*)gp)[lane + 64 * j]; const v2u xw = x3[64 * j]; f32x4 x = (f32x4){bf_lo(xw.x), bf_hi(xw.x), bf_lo(xw.y), bf_hi(xw.y)};
            x.x += gv.x * (g1 * bf_lo(a.x) + g2 * bf_lo(b.x)); x.y += gv.y * (g1 * bf_hi(a.x) + g2 * bf_hi(b.x)); x.z += gv.z * (g1 * bf_lo(a.y) + g2 * bf_lo(b.y)); x.w += gv.w * (g1 * bf_hi(a.y) + g2 * bf_hi(b.y));
            o[64 * j] = x; } }
}
struct Args { const float* in[38]; float* out; unsigned char* ws; int ph_lo, ph_hi; };
__global__ void __launch_bounds__(NWAVES * 64, 2) mk_fwd(Args args) {
    extern __shared__ __attribute__((aligned(16))) unsigned char lds[];
    Frame F;
    F.lds = (LAS unsigned char*)lds;
    F.MISC = (volatile LAS unsigned*)(F.lds + MISC_OFF);
    F.tid = threadIdx.x; F.lane = F.tid & 63; F.wave = __builtin_amdgcn_readfirstlane(F.tid >> 6);
    F.G = gridDim.x; { const int bx = blockIdx.x; F.vcu = (F.G % 8 == 0) ? (bx % 8) * (F.G / 8) + bx / 8 : bx; }
    F.ws = args.ws; F.out = args.out; F.ctl = (gu32*)(args.ws + WS_CTL);
    for (int u = F.tid; u < (LDS_BYTES - LDSCTL_OFF) / 4; u += NWAVES * 64) ((LAS unsigned*)(F.lds + LDSCTL_OFF))[u] = 0u;
    __syncthreads();
    XcdBarrier bar; bar.bar = (unsigned*)(F.ctl + CW_BAR); bar.x = 0; bar.st = nullptr;
    if (MK_ONE_LAUNCH) bar = xcd_barrier_post((unsigned*)(F.ctl + CW_BAR), F.MISC + 8);
#define GRID_BAR() do { if (MK_ONE_LAUNCH) xcd_barrier(bar); } while (0)
    const int lo = args.ph_lo, hi = args.ph_hi;
#define RELANE() do { int t_ = (int)threadIdx.x; asm volatile("" : "+v"(t_)); F.tid = t_; F.lane = t_ & 63; } while (0)
#ifndef MK_TPROBE
#define MK_TPROBE -1
#endif
#ifndef MK_TPK
#define MK_TPK 4
#endif
    unsigned long long tp0 = 0ull, tp1 = 0ull;
#define TP_BEGIN(k) do { if (MK_TPROBE == (k)) tp0 = __builtin_amdgcn_s_memrealtime(); } while (0)
#define TP_END(k) do { if (MK_TPROBE == (k)) tp1 = __builtin_amdgcn_s_memrealtime(); } while (0)
#define IN(k) (lo <= (k) && (k) < hi)
#define BOTH(k) (IN(k) && IN((k) + 1))
#ifndef MK_REP_MASK
#define MK_REP_MASK 0
#endif
#define REP(k) for (int rep_ = 0; rep_ < (((MK_REP_MASK >> (k)) & 1) ? 2 : 1); ++rep_)
    unsigned char* ws = args.ws;
    bf16* XN = (bf16*)(ws + WS_XN); bf16* Y = (bf16*)(ws + WS_Y); bf16* P0 = (bf16*)(ws + WS_P0); bf16* P1 = (bf16*)(ws + WS_P1); bf16* OA = (bf16*)(ws + WS_OATT); bf16* Hb = (bf16*)(ws + WS_H);
    bf16* XR = (bf16*)(ws + WS_XR); const float* MOD = (const float*)(ws + WS_MOD);
    using ABF = attn_body::bf16;

    if (IN(0)) { RELANE(); TP_BEGIN(0); REP(0) { ph0_prologue(F); __syncthreads(); } if (BOTH(0)) GRID_BAR();  TP_END(0); }
    if (IN(1)) { RELANE(); TP_BEGIN(1); REP(1) ph_normmod(F, F.in[I_X], F.in[I_CTX], MR, F.in[I_NMIXG], 0, 0, D); if (BOTH(1)) GRID_BAR();  TP_END(1); }
    if (IN(2)) { RELANE(); TP_BEGIN(2);
        pg8::Gemm g{XN, (const bf16*)(ws + WS_WE), MR, E_IN, D}; pg8::StaticOrder S; S.init(MR, E_IN, F.G, (int)blockIdx.x);
        pg8::EpiBf16<0> E{P0, E_IN, nullptr, 0, 0, 1.f};
        REP(2) pg8::gemm_phase<pg8::EpiBf16<0>, pg8::StaticOrder, PG8_ALIGN, PG8_SP2>(F.lds + RING_OFF, g, S, E);
        if (BOTH(2)) GRID_BAR();
        TP_END(2);
    }
    if (IN(3)) { RELANE(); TP_BEGIN(3); ph3_post0(F); if (BOTH(3)) GRID_BAR();  TP_END(3); }
    if (IN(4)) { RELANE(); TP_BEGIN(4);
        const bool nomax0 = qk_bounded(F.in[I_BQNG], F.in[I_BKNG], F.lane);
        const int trslot = F.vcu % 3;
        float lam; { const int ln = F.lane; const float s1 = wave_sum(F.in[I_LQ1][ln] * F.in[I_LK1][ln]), s2 = wave_sum(F.in[I_LQ2][ln] * F.in[I_LK2][ln]); lam = expf(s1) - expf(s2) + 0.2f; }
        REP(4) for (int i = 0;; ++i) { const int L = i * F.G + F.vcu; if (L >= 256 + 8) break;
            const bool lat = L < 256; const int bh4 = lat ? (L >> 5) : (L - 256), qb = lat ? (L & 31) : 0, b = bh4 >> 2, h = bh4 & 3;
            const size_t qrow0 = lat ? (size_t)b * SEQ + (size_t)qb * 256 : (size_t)(ML + b * CTXL); const int NT = lat ? 132 : 4, rot = lat ? (F.vcu & 31) * 4 : 0;
            const ABF* Vs = (const ABF*)(ws + WS_VC0) + (size_t)(b * 8 + 2 * h) * KEYS * 64; ABF* O1 = (ABF*)(OA + qrow0 * D + 256 * h); ABF* Yo = (ABF*)(Y + qrow0 * D + 512 + 128 * h);
#pragma unroll 1
            for (int sc = 0; sc < 3; ++sc) {
                if (lat && sc == trslot && rep_ == 0) { tr_range(F, TR_DENSE, TR_NITEMS); LDS_WAIT(); __syncthreads(); }
                if (sc < 2) { const ABF* Ks = (const ABF*)(ws + WS_KC0) + (size_t)(b * 8 + 2 * h + sc) * KEYS * 64; const ABF* Q = (const ABF*)(P0 + qrow0 * E_IN + 1024 + 128 * h + 64 * sc);
                    if (sc == 1) VM_WAIT();
                    if (nomax0) attn_body::attn_unit2<-1>(Q, E_IN, Ks, Vs, Vs + (size_t)KEYS * 64, sc ? Yo : O1, D, NT, rot, (char*)lds + RING_OFF, sc == 1, O1, D, lam, F.in[I_SUBLNG], 0.8f);
                    else attn_body::attn_unit2<8>(Q, E_IN, Ks, Vs, Vs + (size_t)KEYS * 64, sc ? Yo : O1, D, NT, rot, (char*)lds + RING_OFF, sc == 1, O1, D, lam, F.in[I_SUBLNG], 0.8f); } } }
        RELANE();
        REP(4) for (int c = F.vcu - 32; c >= 0 && c < MR / 128; c += F.G) gmlp_unit(F, c);
        if (BOTH(4)) GRID_BAR();
        TP_END(4);
    }
    if (IN(6)) { RELANE(); TP_BEGIN(6);
        pg8::Gemm g{Y, (const bf16*)(ws + WS_WO0), MR, D, D}; pg8::StaticOrder S; S.init(MR, D, F.G, (int)blockIdx.x);
        pg8::EpiResGate<false, true> E{F.in[I_X], F.in[I_CTX], XR, MOD + 2 * D, 1.0f};
        REP(6) pg8::gemm_phase<pg8::EpiResGate<false, true>, pg8::StaticOrder, PG8_ALIGN, PG8_SP2>(F.lds + RING_OFF, g, S, E);
        if (BOTH(6)) GRID_BAR();
        TP_END(6);
    }
    if (IN(7)) { RELANE(); TP_BEGIN(7); REP(7) ph_normmod<true, true>(F, (const float*)XR, (const float*)(XR + (size_t)ML * D), MR, F.in[I_NFFNG], 0, 3 * D, 4 * D); if (BOTH(7)) GRID_BAR();  TP_END(7); }
    if (IN(8)) { RELANE(); TP_BEGIN(8);
        pg8::Gemm g{XN, (const bf16*)(ws + WS_WF13), MR, FF2, D / 2}; pg8::StaticOrder S; S.init(MR, FF2, F.G, (int)blockIdx.x);
        pg8::EpiSwiGLUF8 E{(unsigned char*)Hb, FF, FF2 / 256, 1.0f / MOE_S13};
        REP(8) pg8::gemm_phase<pg8::EpiSwiGLUF8, pg8::StaticOrder, PG8_ALIGN, PG8_SP2, true>(F.lds + RING_OFF, g, S, E);
        if (BOTH(8)) GRID_BAR();
        TP_END(8);
    }
    if (IN(9)) { RELANE(); TP_BEGIN(9);
        pg8::Gemm g{Hb, (const bf16*)(ws + WS_WF2), MR, D, FF / 2}; pg8::StaticOrder S; S.init(MR, D, F.G, (int)blockIdx.x);
        pg8::EpiResGate<true, true> E{XR, XR + (size_t)ML * D, XR, MOD + 5 * D, 1.0f / MOE_S2};
        REP(9) pg8::gemm_phase<pg8::EpiResGate<true, true>, pg8::StaticOrder, PG8_ALIGN, PG8_SP2, true>(F.lds + RING_OFF, g, S, E);
        if (BOTH(9)) GRID_BAR();
        TP_END(9);
    }
    if (IN(10)) { RELANE(); TP_BEGIN(10); REP(10) ph_normmod<false, true>(F, (const float*)XR, (const float*)(XR + (size_t)ML * D), MR, F.in[I_NMIXG] + D, 1, 0, D); if (BOTH(10)) GRID_BAR();  TP_END(10); }
    if (IN(11)) { RELANE(); TP_BEGIN(11);
        pg8::Gemm g{XN, (const bf16*)(ws + WS_WOI), MR, O_IN, D}; pg8::StaticOrder S; S.init(MR, O_IN, F.G, (int)blockIdx.x);
        pg8::EpiBf16<0> E{P1, O_IN, nullptr, 0, 0, 1.f};
        REP(11) pg8::gemm_phase<pg8::EpiBf16<0>, pg8::StaticOrder, PG8_ALIGN, PG8_SP2>(F.lds + RING_OFF, g, S, E);
        if (BOTH(11)) GRID_BAR();
        TP_END(11);
    }
    if (IN(12)) { RELANE(); TP_BEGIN(12);
        ph12_post1(F);
        REP(12) for (int c = F.vcu; c < NCHUNK; c += F.G) scan_prep_unit(F, c);
        if (BOTH(12)) GRID_BAR();
        TP_END(12);
    }
    if (IN(13)) { RELANE(); TP_BEGIN(13);
        REP(13) for (int c = F.vcu; c < ML / 64; c += F.G) scan_fix_unit(F, c);
        const bool nomax1 = qk_bounded(F.in[I_CQNG], F.in[I_CKNG], F.lane);
        REP(13) for (int i = 0;; ++i) { const int L = i * F.G + F.vcu; if (L >= 512) break;
            const int bh = L >> 5, qb = L & 31, b = bh >> 3, hq = bh & 7, kv = hq >> 2;
            const size_t crow0 = (size_t)(ML + b * CTXL), lrow0 = (size_t)b * SEQ, qrow0 = lrow0 + (size_t)qb * 256;
            const ABF* Ks = (const ABF*)(ws + WS_KC1) + (size_t)(b * 2 + kv) * KEYS * 64; const ABF* Vs = (const ABF*)(ws + WS_VC1) + (size_t)(b * 2 + kv) * KEYS * 64;
            if (nomax1) attn_body::attn_unit<-1, true>((const ABF*)(P1 + qrow0 * O_IN + 64 * hq), O_IN, Ks, Ks + 4 * 4096, 64, Vs, Vs + 4 * 4096, 64, (ABF*)(Y + qrow0 * D + 64 * hq), D, 132, 4, (F.vcu & 31) * 4, (char*)lds + RING_OFF);
            else attn_body::attn_unit<8, true>((const ABF*)(P1 + qrow0 * O_IN + 64 * hq), O_IN, Ks, Ks + 4 * 4096, 64, Vs, Vs + 4 * 4096, 64, (ABF*)(Y + qrow0 * D + 64 * hq), D, 132, 4, (F.vcu & 31) * 4, (char*)lds + RING_OFF); }
        if (BOTH(13)) GRID_BAR();
        TP_END(13);
    }
    if (IN(14)) { RELANE(); TP_BEGIN(14);
        pg8::Gemm g{Y, (const bf16*)(ws + WS_WO1), ML, D, D}; pg8::StaticOrder S; S.init(ML, D, F.G, (int)blockIdx.x);
        pg8::EpiResGate<true, true> E{XR, XR, (bf16*)(ws + WS_X3), MOD + 3 * 6 * D + 2 * D, 1.0f};
        REP(14) pg8::gemm_phase<pg8::EpiResGate<true, true>, pg8::StaticOrder, PG8_ALIGN, PG8_SP2>(F.lds + RING_OFF, g, S, E);
        if (BOTH(14)) GRID_BAR();
        TP_END(14);
    }
    if (IN(15)) { RELANE(); TP_BEGIN(15); ph15_router(F); if (BOTH(15)) GRID_BAR();  TP_END(15); }
    if (IN(17)) { RELANE(); TP_BEGIN(17);
        const int npan = moe_tables(F);
        pg8::Gemm g{(const bf16*)(ws + WS_XG), (const bf16*)(ws + WS_WM13), MOE_ROWS, NEXP * FF2, D / 2}; pg8::MoeOrder S{npan, FF2 / 256, F.G, F.vcu, (const LAS int*)(F.lds + PEXP_OFF), true};
        pg8::EpiSwiGLUF8 E{ws + WS_HG, FF, FF2 / 256, 1.0f / MOE_S13};
        REP(17) pg8::gemm_phase<pg8::EpiSwiGLUF8, pg8::MoeOrder, PG8_ALIGN, PG8_SP2, true>(F.lds + RING_OFF, g, S, E);
        if (BOTH(17)) GRID_BAR();
        TP_END(17);
    }
    if (IN(18)) { RELANE(); TP_BEGIN(18);
        const int npan = moe_tables(F);
        pg8::Gemm g{(const bf16*)(ws + WS_HG), (const bf16*)(ws + WS_WM2), MOE_ROWS, NEXP * D, FF / 2}; pg8::MoeOrder S{npan, D / 256, F.G, F.vcu, (const LAS int*)(F.lds + PEXP_OFF), false};
        pg8::EpiBf16S E{(bf16*)(ws + WS_YG), D, D / 256, 1.0f / MOE_S2};
        REP(18) pg8::gemm_phase<pg8::EpiBf16S, pg8::MoeOrder, PG8_ALIGN, PG8_SP2, true>(F.lds + RING_OFF, g, S, E);
        if (BOTH(18)) GRID_BAR();
        TP_END(18);
    }
    if (IN(19)) { RELANE(); TP_BEGIN(19); ph19_combine(F);  TP_END(19); }
    if (MK_TPROBE >= 0 && blockIdx.x == 0 && threadIdx.x == 0) { const unsigned long long tgt = __builtin_amdgcn_s_memrealtime() + (unsigned long long)MK_TPK * (tp1 - tp0); while (__builtin_amdgcn_s_memrealtime() < tgt) __builtin_amdgcn_s_sleep(20); }
#undef IN
#undef BOTH
#undef GRID_BAR
}

extern "C" void kernel_launch(void* const* d_in, const int* in_sizes, int n_in, void* d_out, int out_size, void* d_ws, size_t ws_size, hipStream_t stream) {
    static int grid = 0;
    if (grid == 0) {
        if (n_in != 38 || in_sizes[0] != ML * D || out_size != ML * D || ws_size < WS_END) { fprintf(stderr, "kernel_launch: built for 38 inputs, x/out of %d floats, >= %zu bytes of workspace; got n_in %d, in0 %d, out %d, ws %zu; nothing launched\n", ML * D, (size_t)WS_END, n_in, n_in > 0 ? in_sizes[0] : -1, out_size, ws_size); grid = -1; return; }
        int dev = 0, cus = 0, per_cu = 0;
        if (hipGetDevice(&dev) != hipSuccess || hipDeviceGetAttribute(&cus, hipDeviceAttributeMultiprocessorCount, dev) != hipSuccess) { fprintf(stderr, "kernel_launch: device query failed\n"); grid = -1; return; }
        if (hipFuncSetAttribute((const void*)mk_fwd, hipFuncAttributeMaxDynamicSharedMemorySize, LDS_BYTES) != hipSuccess) { fprintf(stderr, "kernel_launch: hipFuncSetAttribute failed\n"); grid = -1; return; }
        if (hipOccupancyMaxActiveBlocksPerMultiprocessor(&per_cu, (const void*)mk_fwd, NWAVES * 64, LDS_BYTES) != hipSuccess || per_cu < 1) fprintf(stderr, "kernel_launch: note: occupancy query reports %d workgroups per CU\n", per_cu);
        (void)hipGetLastError();
        grid = cus;
    }
    if (grid < 0) return;
    if (hipMemsetAsync((char*)d_ws + WS_CTL, 0, CTL_ZERO_BYTES, stream) != hipSuccess) { fprintf(stderr, "kernel_launch: hipMemsetAsync failed\n"); return; }
    Args a{};
    for (int i = 0; i < 38; ++i) a.in[i] = (const float*)d_in[i];
    a.out = (float*)d_out; a.ws = (unsigned char*)d_ws;
#if MK_ONE_LAUNCH
    a.ph_lo = 0; a.ph_hi = NPH;
    hipLaunchKernelGGL(mk_fwd, dim3(grid), dim3(NWAVES * 64), LDS_BYTES, stream, a);
#else
    for (int ph = 0; ph < NPH; ++ph) { a.ph_lo = ph; a.ph_hi = ph + 1; hipLaunchKernelGGL(mk_fwd, dim3(grid), dim3(NWAVES * 64), LDS_BYTES, stream, a); }
#endif
    const hipError_t le = hipPeekAtLastError();
    if (le != hipSuccess) fprintf(stderr, "kernel_launch: launch failed: %s\n", hipGetErrorName(le));
}
```
